# Optimizing an MI355X kernel written in HIP

```python
import jax, jax.numpy as jnp
from jax import lax
import numpy as np

D_MODEL = 1024
BATCH = 2
SEQ = 8192
DEPTH = 2

GRID_W = 64
CTX_LEN = 256
N_GROUPS = 4
GROUP_HEADS = 4
GROUP_WIDTH = D_MODEL // N_GROUPS
HEAD_DIM = GROUP_WIDTH // GROUP_HEADS
D_MIX = N_GROUPS * GROUP_WIDTH
A_KV_HEADS = 2
B_KV_HEADS = 2
Q_BLOCK = 128
WINDOW = 128
WIN_BLOCK = 128
MLSTM_CHUNK = 64
NA_KH = 8
NA_KW = 16
D_FF = ((8 * D_MODEL // 3 + 127) // 128) * 128
CONV_W = 3
ROPE_THETA = 10000.0
EPS = 1e-6
NEG_INF = -1e30
SPLIT_SIZES = (GROUP_WIDTH, A_KV_HEADS * HEAD_DIM, A_KV_HEADS * HEAD_DIM,
               GROUP_WIDTH, B_KV_HEADS * HEAD_DIM, B_KV_HEADS * HEAD_DIM,
               GROUP_WIDTH, GROUP_WIDTH, GROUP_WIDTH, GROUP_WIDTH, 4 * GROUP_HEADS,
               GROUP_WIDTH, GROUP_WIDTH, GROUP_WIDTH)
D_IN = sum(SPLIT_SIZES)

kernel_name = 'hybrid_parallel_heads_dit_block'


def rms_norm(x, g):
    xf = x.astype(jnp.float32)
    y = xf * lax.rsqrt(jnp.mean(xf * xf, axis=-1, keepdims=True) + EPS)
    return (y * g.astype(jnp.float32)).astype(x.dtype)


def to_heads(x, n):
    b, t, _ = x.shape
    return x.reshape(b, t, n, -1).transpose(0, 2, 1, 3)


def from_heads(x):
    b, h, t, d = x.shape
    return x.transpose(0, 2, 1, 3).reshape(b, t, h * d)


def split_proj(p):
    outs, start = [], 0
    for size in SPLIT_SIZES:
        outs.append(p[..., start:start + size])
        start += size
    return outs


def axial_angles(n_tokens):
    t = jnp.arange(n_tokens)
    row = (t // GRID_W).astype(jnp.float32)
    col = (t % GRID_W).astype(jnp.float32)
    n_freq = HEAD_DIM // 4
    freqs = ROPE_THETA ** (-jnp.arange(n_freq, dtype=jnp.float32) / n_freq)
    return row[:, None] * freqs, col[:, None] * freqs


def _rotate(x, ang):
    x1, x2 = jnp.split(x, 2, axis=-1)
    cos, sin = jnp.cos(ang).astype(x.dtype), jnp.sin(ang).astype(x.dtype)
    return jnp.concatenate([x1 * cos - x2 * sin, x1 * sin + x2 * cos], axis=-1)


def rope_2d(x, ang_r, ang_c):
    xr, xc = jnp.split(x, 2, axis=-1)
    return jnp.concatenate([_rotate(xr, ang_r), _rotate(xc, ang_c)], axis=-1)


def ctx_attend(qc, kc, vc, sink=None):
    b, hq, n, d = qc.shape
    kv = kc.shape[1]
    g = hq // kv
    qg = qc.reshape(b, kv, g, n, d)
    s = jnp.einsum('bkgqd,bksd->bkgqs', qg, kc).astype(jnp.float32) * d ** -0.5
    if sink is not None:
        sk = jnp.broadcast_to(sink.astype(jnp.float32).reshape(1, kv, g, 1, 1), (b, kv, g, n, 1))
        p = jax.nn.softmax(jnp.concatenate([s, sk], axis=-1), axis=-1)[..., :-1]
    else:
        p = jax.nn.softmax(s, axis=-1)
    o = jnp.einsum('bkgqs,bksd->bkgqd', p.astype(vc.dtype), vc)
    return o.reshape(b, hq, n, d)


def mixer_global(q, k, v, qc, kc, vc, gq, gk, ang_r, ang_c, need_ctx):
    q = rope_2d(rms_norm(q, gq), ang_r, ang_c)
    k = rope_2d(rms_norm(k, gk), ang_r, ang_c)
    qc, kc = rms_norm(qc, gq), rms_norm(kc, gk)
    b, h, t, d = q.shape
    kv = k.shape[1]
    g = h // kv
    nb = t // Q_BLOCK
    keys = jnp.concatenate([kc, k], axis=2)
    vals = jnp.concatenate([vc, v], axis=2)
    qb = q.reshape(b, kv, g, nb, Q_BLOCK, d).transpose(3, 0, 1, 2, 4, 5)

    def block(qi):
        s = jnp.einsum('bkgqd,bksd->bkgqs', qi, keys).astype(jnp.float32) * d ** -0.5
        p = jax.nn.softmax(s, axis=-1).astype(vals.dtype)
        return jnp.einsum('bkgqs,bksd->bkgqd', p, vals)

    o = lax.map(block, qb)
    o = o.transpose(1, 2, 3, 0, 4, 5).reshape(b, h, t, d)
    oc = ctx_attend(qc, kc, vc) if need_ctx else None
    return o, oc


def mixer_window(q, k, v, qc, kc, vc, sink, ang_r, ang_c, need_ctx):
    q = rope_2d(q, ang_r, ang_c)
    k = rope_2d(k, ang_r, ang_c)
    b, h, t, d = q.shape
    kv = k.shape[1]
    g = h // kv
    w = WIN_BLOCK
    nb = t // w

    def band(x):
        xb = x.reshape(b, kv, nb, w, d)
        xp = jnp.pad(xb, ((0, 0), (0, 0), (1, 1), (0, 0), (0, 0)))
        return jnp.concatenate([xp[:, :, :-2], xp[:, :, 1:-1], xp[:, :, 2:]], axis=3)

    kb, vb = band(k), band(v)
    qg = q.reshape(b, kv, g, nb, w, d)
    scale = d ** -0.5
    s_loc = jnp.einsum('bkgnqd,bknsd->bkgnqs', qg, kb).astype(jnp.float32) * scale
    q_pos = jnp.arange(nb)[:, None, None] * w + jnp.arange(w)[None, :, None]
    k_pos = jnp.arange(nb)[:, None, None] * w - w + jnp.arange(3 * w)[None, None, :]
    valid = (jnp.abs(k_pos - q_pos) <= WINDOW) & (k_pos >= 0) & (k_pos < t)
    s_loc = jnp.where(valid, s_loc, NEG_INF)
    s_ctx = jnp.einsum('bkgnqd,bkcd->bkgnqc', qg, kc).astype(jnp.float32) * scale
    sk = jnp.broadcast_to(sink.astype(jnp.float32).reshape(1, kv, g, 1, 1, 1), (b, kv, g, nb, w, 1))
    p = jax.nn.softmax(jnp.concatenate([s_loc, s_ctx, sk], axis=-1), axis=-1).astype(v.dtype)
    n_loc, n_ctx = 3 * w, kc.shape[2]
    o = (jnp.einsum('bkgnqs,bknsd->bkgnqd', p[..., :n_loc], vb)
         + jnp.einsum('bkgnqc,bkcd->bkgnqd', p[..., n_loc:n_loc + n_ctx], vc))
    o = o.reshape(b, h, t, d)
    oc = ctx_attend(qc, kc, vc, sink) if need_ctx else None
    return o, oc


def mlstm_chunkwise(q, k, v, log_i, log_f, state):
    b, h, t, d = q.shape
    nc = t // MLSTM_CHUNK
    lc = MLSTM_CHUNK

    def chunks(x):
        return jnp.moveaxis(x.reshape((b, h, nc, lc) + x.shape[3:]), 2, 0)

    causal = jnp.tril(jnp.ones((lc, lc), dtype=bool))

    def step(carry, inp):
        c_mat, n_vec, m = carry
        qb, kb, vb, li, lf = inp
        cum = jnp.cumsum(lf, axis=-1)
        logw = jnp.where(causal, cum[..., :, None] - cum[..., None, :] + li[..., None, :], NEG_INF)
        inter = cum + m[..., None]
        m_t = jnp.maximum(inter, logw.max(axis=-1))
        w_inter = jnp.exp(inter - m_t)
        s = jnp.einsum('bhtk,bhsk->bhts', qb, kb) * jnp.exp(logw - m_t[..., None])
        num = (jnp.einsum('bhts,bhsv->bhtv', s, vb)
               + w_inter[..., None] * jnp.einsum('bhvk,bhtk->bhtv', c_mat, qb))
        den = s.sum(axis=-1) + w_inter * jnp.einsum('bhk,bhtk->bht', n_vec, qb)
        hout = num / jnp.maximum(jnp.abs(den), jnp.exp(-m_t))[..., None]
        cum_end = cum[..., -1]
        log_end = cum_end[..., None] - cum + li
        m_new = jnp.maximum(cum_end + m, log_end.max(axis=-1))
        decay = jnp.exp(cum_end + m - m_new)
        w_end = jnp.exp(log_end - m_new[..., None])
        c_mat = decay[..., None, None] * c_mat + jnp.einsum('bhs,bhsv,bhsk->bhvk', w_end, vb, kb)
        n_vec = decay[..., None] * n_vec + jnp.einsum('bhs,bhsk->bhk', w_end, kb)
        return (c_mat, n_vec, m_new), hout

    state, hs = lax.scan(step, state, (chunks(q), chunks(k), chunks(v), chunks(log_i), chunks(log_f)))
    hs = jnp.moveaxis(hs, 0, 2).reshape(b, h, t, d)
    return hs, state


def mixer_mlstm(q, k, v, o, gates, qc, kc, vc, oc, gates_c, gate_bias, need_ctx):
    b, h, t, d = q.shape
    f32 = jnp.float32

    def prep_gates(g):
        g = (g + gate_bias).astype(f32)
        g = g.reshape(g.shape[0], g.shape[1], 4, h).transpose(2, 0, 3, 1)
        return g[0], jax.nn.log_sigmoid(g[1]), g[2], jax.nn.log_sigmoid(g[3])

    li_f, lf_f, li_b, lf_b = prep_gates(gates)
    lic_f, lfc_f, lic_b, lfc_b = prep_gates(gates_c)
    sc = d ** -0.5
    q32, k32, v32 = (q * sc).astype(f32), k.astype(f32), v.astype(f32)
    qc32, kc32, vc32 = (qc * sc).astype(f32), kc.astype(f32), vc.astype(f32)
    zero = (jnp.zeros((b, h, d, d), f32), jnp.zeros((b, h, d), f32), jnp.zeros((b, h), f32))

    def flip(x):
        return jnp.flip(x, axis=2)

    hc_f, st_f = mlstm_chunkwise(qc32, kc32, vc32, lic_f, lfc_f, zero)
    hc_b, st_b = mlstm_chunkwise(flip(qc32), flip(kc32), flip(vc32), flip(lic_b), flip(lfc_b), zero)
    h_f, _ = mlstm_chunkwise(q32, k32, v32, li_f, lf_f, st_f)
    h_b, _ = mlstm_chunkwise(flip(q32), flip(k32), flip(v32), flip(li_b), flip(lf_b), st_b)
    y = (jax.nn.sigmoid(o.astype(f32)) * (h_f + flip(h_b))).astype(v.dtype)
    yc = (jax.nn.sigmoid(oc.astype(f32)) * (hc_f + flip(hc_b))).astype(vc.dtype) if need_ctx else None
    return y, yc


def mixer_neighbourhood(q, k, v, qc, kc, vc, rpb, need_ctx):
    b, h, t, d = q.shape
    rows = t // GRID_W
    kh, kw = min(NA_KH, rows), NA_KW
    qg = q.reshape(b, h, rows, GRID_W, d)
    kg = k.reshape(b, h, rows, GRID_W, d)
    vg = v.reshape(b, h, rows, GRID_W, d)
    cols = jnp.arange(GRID_W)
    col_start = jnp.clip(cols - kw // 2, 0, GRID_W - kw)
    col_idx = col_start[:, None] + jnp.arange(kw)[None, :]
    dc_idx = col_idx - cols[:, None] + (NA_KW - 1)
    scale = d ** -0.5
    n_nb = kh * kw

    def row_fn(r):
        rs = jnp.clip(r - kh // 2, 0, rows - kh)
        kr = lax.dynamic_slice_in_dim(kg, rs, kh, axis=2)[:, :, :, col_idx]
        vr = lax.dynamic_slice_in_dim(vg, rs, kh, axis=2)[:, :, :, col_idx]
        qr = lax.dynamic_index_in_dim(qg, r, axis=2, keepdims=False)
        dr_idx = rs + jnp.arange(kh) - r + (NA_KH - 1)
        bias = rpb[:, dr_idx][:, :, dc_idx].transpose(0, 2, 1, 3)
        s_nb = jnp.einsum('bhwd,bhiwjd->bhwij', qr, kr).astype(jnp.float32) * scale + bias.astype(jnp.float32)
        s_c = jnp.einsum('bhwd,bhcd->bhwc', qr, kc).astype(jnp.float32) * scale
        p = jax.nn.softmax(jnp.concatenate([s_nb.reshape(b, h, GRID_W, n_nb), s_c], axis=-1), axis=-1)
        p = p.astype(v.dtype)
        p_nb = p[..., :n_nb].reshape(b, h, GRID_W, kh, kw)
        return (jnp.einsum('bhwij,bhiwjd->bhwd', p_nb, vr)
                + jnp.einsum('bhwc,bhcd->bhwd', p[..., n_nb:], vc))

    o = lax.map(row_fn, jnp.arange(rows))
    o = o.transpose(1, 2, 0, 3, 4).reshape(b, h, t, d)
    oc = ctx_attend(qc, kc, vc) if need_ctx else None
    return o, oc


def mix_out(ys, g_group, w_out):
    y = jnp.concatenate([from_heads(t) for t in ys], axis=-1)
    b, t, _ = y.shape
    y = rms_norm(y.reshape(b, t, N_GROUPS, GROUP_WIDTH), g_group.reshape(N_GROUPS, GROUP_WIDTH))
    return y.reshape(b, t, D_MIX) @ w_out


def dwconv_centred(x, w, bias):
    t = x.shape[1]
    xp = jnp.pad(x, ((0, 0), (1, 1), (0, 0)))
    return xp[:, :t] * w[0] + xp[:, 1:t + 1] * w[1] + xp[:, 2:] * w[2] + bias


def conv_ffn(h, w_up, conv_w, conv_b, w_down):
    u = dwconv_centred(h @ w_up, conv_w, conv_b)
    gate, val = jnp.split(u, 2, axis=-1)
    return (jax.nn.silu(gate) * val) @ w_down


def trunk_layer(x, ctx, mod_lat, mod_ctx, g1, g2, w_in, a_qg, a_kg, sink, c_gb, rpb, g_group,
                w_out, w_up, conv_w, conv_b, w_down, ang_r, ang_c, need_ctx):
    sh1, sc1, gt1, sh2, sc2, gt2 = jnp.split(mod_lat, 6, axis=-1)
    sh1c, sc1c, gt1c, sh2c, sc2c, gt2c = jnp.split(mod_ctx, 6, axis=-1)
    h = rms_norm(x, g1) * (1 + sc1) + sh1
    hc = rms_norm(ctx, g1) * (1 + sc1c) + sh1c
    aq, ak, av, bq, bk, bv, cq, ck, cv, co, cg, dq, dk, dv = split_proj(h @ w_in)
    aqc, akc, avc, bqc, bkc, bvc, cqc, ckc, cvc, coc, cgc, dqc, dkc, dvc = split_proj(hc @ w_in)
    nh = GROUP_HEADS
    ya, yac = mixer_global(to_heads(aq, nh), to_heads(ak, A_KV_HEADS), to_heads(av, A_KV_HEADS),
                           to_heads(aqc, nh), to_heads(akc, A_KV_HEADS), to_heads(avc, A_KV_HEADS),
                           a_qg, a_kg, ang_r, ang_c, need_ctx)
    yb, ybc = mixer_window(to_heads(bq, nh), to_heads(bk, B_KV_HEADS), to_heads(bv, B_KV_HEADS),
                           to_heads(bqc, nh), to_heads(bkc, B_KV_HEADS), to_heads(bvc, B_KV_HEADS),
                           sink, ang_r, ang_c, need_ctx)
    yc, ycc = mixer_mlstm(to_heads(cq, nh), to_heads(ck, nh), to_heads(cv, nh), to_heads(co, nh), cg,
                          to_heads(cqc, nh), to_heads(ckc, nh), to_heads(cvc, nh), to_heads(coc, nh), cgc,
                          c_gb, need_ctx)
    yd, ydc = mixer_neighbourhood(to_heads(dq, nh), to_heads(dk, nh), to_heads(dv, nh),
                                  to_heads(dqc, nh), to_heads(dkc, nh), to_heads(dvc, nh), rpb, need_ctx)
    x = x + gt1 * mix_out([ya, yb, yc, yd], g_group, w_out)
    h2 = rms_norm(x, g2) * (1 + sc2) + sh2
    x = x + gt2 * conv_ffn(h2, w_up, conv_w, conv_b, w_down)
    if need_ctx:
        ctx = ctx + gt1c * mix_out([yac, ybc, ycc, ydc], g_group, w_out)
        h2c = rms_norm(ctx, g2) * (1 + sc2c) + sh2c
        ctx = ctx + gt2c * conv_ffn(h2c, w_up, conv_w, conv_b, w_down)
    return x, ctx


def setup_inputs(seed: int = 0) -> dict:
    key = jax.random.key(seed)
    ks = jax.random.split(key, 24)
    nrm = jax.random.normal
    f32 = jnp.float32
    gate_noise = 0.1 * nrm(ks[10], (DEPTH, 4, GROUP_HEADS), f32)
    forget_bias = jnp.linspace(3.0, 6.0, GROUP_HEADS, dtype=f32)
    gate_bias = gate_noise + jnp.array([0.0, 1.0, 0.0, 1.0], f32)[None, :, None] * forget_bias[None, None, :]
    return {
        'x': nrm(ks[0], (BATCH, SEQ, D_MODEL), f32),
        'c': nrm(ks[1], (BATCH, D_MODEL), f32),
        'ctx': nrm(ks[2], (BATCH, CTX_LEN, D_MODEL), f32),
        'c_ctx': nrm(ks[3], (D_MODEL,), f32),
        'w_mod': nrm(ks[4], (DEPTH, D_MODEL, 6 * D_MODEL), f32) * (0.5 * D_MODEL ** -0.5),
        'b_mod': 0.02 * nrm(ks[5], (DEPTH, 6 * D_MODEL), f32),
        'g_norm1': 1.0 + 0.05 * nrm(ks[6], (DEPTH, D_MODEL), f32),
        'g_norm2': 1.0 + 0.05 * nrm(ks[7], (DEPTH, D_MODEL), f32),
        'w_in': nrm(ks[8], (DEPTH, D_MODEL, D_IN), f32) * D_MODEL ** -0.5,
        'a_q_gain': 1.0 + 0.05 * nrm(ks[9], (DEPTH, HEAD_DIM), f32),
        'a_k_gain': 1.0 + 0.05 * nrm(ks[11], (DEPTH, HEAD_DIM), f32),
        'b_sink': 0.5 * nrm(ks[12], (DEPTH, GROUP_HEADS), f32),
        'c_gate_bias': gate_bias.reshape(DEPTH, 4 * GROUP_HEADS),
        'd_rel_bias': 0.2 * nrm(ks[13], (DEPTH, GROUP_HEADS, 2 * NA_KH - 1, 2 * NA_KW - 1), f32),
        'g_group': 1.0 + 0.05 * nrm(ks[14], (DEPTH, D_MIX), f32),
        'w_out': nrm(ks[15], (DEPTH, D_MIX, D_MODEL), f32) * D_MIX ** -0.5,
        'w_up': nrm(ks[16], (DEPTH, D_MODEL, 2 * D_FF), f32) * D_MODEL ** -0.5,
        'conv_w': nrm(ks[17], (DEPTH, CONV_W, 2 * D_FF), f32) * CONV_W ** -0.5,
        'conv_b': 0.02 * nrm(ks[18], (DEPTH, 2 * D_FF), f32),
        'w_down': nrm(ks[19], (DEPTH, D_FF, D_MODEL), f32) * D_FF ** -0.5,
        'g_final': 1.0 + 0.05 * nrm(ks[20], (D_MODEL,), f32),
    }


def reference(x, c, ctx, c_ctx, w_mod, b_mod, g_norm1, g_norm2, w_in, a_q_gain, a_k_gain, b_sink,
              c_gate_bias, d_rel_bias, g_group, w_out, w_up, conv_w, conv_b, w_down, g_final):
    t = x.shape[1]
    ang_r, ang_c = axial_angles(t)
    for layer in range(DEPTH):
        mod_lat = (jax.nn.silu(c) @ w_mod[layer] + b_mod[layer])[:, None, :]
        mod_ctx = (jax.nn.silu(c_ctx) @ w_mod[layer] + b_mod[layer])[None, None, :]
        x, ctx = trunk_layer(x, ctx, mod_lat, mod_ctx, g_norm1[layer], g_norm2[layer], w_in[layer],
                             a_q_gain[layer], a_k_gain[layer], b_sink[layer], c_gate_bias[layer],
                             d_rel_bias[layer], g_group[layer], w_out[layer], w_up[layer],
                             conv_w[layer], conv_b[layer], w_down[layer], ang_r, ang_c,
                             layer < DEPTH - 1)
    return rms_norm(x, g_final)
```

```cpp
#include <hip/hip_runtime.h>
#include <hip/hip_cooperative_groups.h>
#include <cstdio>
#include <cstdint>
namespace cg = cooperative_groups;

#ifndef MK_MULTI
#define MK_MULTI 0
#endif

constexpr int DM = 1024, SEQ = 8192, NBATCH = 2, CTXL = 256, NLAT = NBATCH * SEQ, NROWS = NLAT + NBATCH * CTXL;
constexpr int PP = 2816;
constexpr int DFF = 2816, DFF2 = 5632, DIN = 2832, NLAYER = 2;
constexpr float EPS = 1e-6f;
constexpr float LOG2E = 1.4426950408889634f;
constexpr float QSCALE2 = 0.125f * LOG2E;
constexpr int PC_AQ = 0, PC_AK = 256, PC_AV = 384, PC_BQ = 512, PC_BK = 768, PC_BV = 896, PC_CQ = 1024, PC_CK = 1280, PC_CV = 1536, PC_CO = 1792, PC_DQ = 2048, PC_DK = 2304, PC_DV = 2560;
constexpr int NCHUNK = 132, NCHAIN = 16;

constexpr size_t MiB = 1u << 20;
constexpr size_t WS_CTL = 0, CTL_ZERO_BYTES = 1 * MiB;
constexpr size_t WS_MOD = 1 * MiB;
constexpr size_t WS_ROPE = 1 * MiB + 192 * 1024;
constexpr size_t WS_WG = 1 * MiB + 512 * 1024;
constexpr size_t WS_XC = 2 * MiB;
constexpr size_t WS_WIN = 4 * MiB;
constexpr size_t WS_WOUT = 15 * MiB;
constexpr size_t WS_WUP = 19 * MiB;
constexpr size_t WS_WDN = 41 * MiB;
constexpr size_t WS_H = 52 * MiB;
constexpr size_t WS_PROJ = 85 * MiB;
constexpr size_t WS_GATES = 176 * MiB;
constexpr size_t WS_DS = 178 * MiB;
constexpr size_t WS_SBF = 211 * MiB;
constexpr size_t WS_ZD = 228 * MiB;
constexpr size_t WS_ZC = WS_ZD + 1 * MiB;
constexpr size_t WS_GC = WS_ZC + 1 * MiB;
constexpr size_t WS_ML = WS_GC + 16384;
constexpr size_t WS_MC = WS_ML + 16384;
constexpr size_t WS_END = 232 * MiB;

#define LAS __attribute__((address_space(3)))
#define GAS __attribute__((address_space(1)))
typedef unsigned short bf16_t;
typedef short bf16x8 __attribute__((ext_vector_type(8)));
typedef short s16x4 __attribute__((ext_vector_type(4)));
typedef float f32x4 __attribute__((ext_vector_type(4)));
typedef float f32x16 __attribute__((ext_vector_type(16)));
typedef float f32x2 __attribute__((ext_vector_type(2)));
typedef unsigned u32x4 __attribute__((ext_vector_type(4)));
typedef unsigned u32x2 __attribute__((ext_vector_type(2)));
typedef __bf16 bf16x2_t __attribute__((ext_vector_type(2)));
typedef short v4i16_t __attribute__((ext_vector_type(4)));

__device__ __forceinline__ unsigned cvtpk(float lo, float hi) { f32x2 v = {lo, hi}; bf16x2_t b = __builtin_convertvector(v, bf16x2_t); return __builtin_bit_cast(unsigned, b); }
__device__ __forceinline__ float bf2f(unsigned short b) { return __uint_as_float((unsigned)b << 16); }
__device__ __forceinline__ float bflo(unsigned w) { return __uint_as_float(w << 16); }
__device__ __forceinline__ float bfhi(unsigned w) { return __uint_as_float(w & 0xffff0000u); }
__device__ __forceinline__ float shfl_idx(float v, int src) { return __int_as_float(__builtin_amdgcn_ds_bpermute(src << 2, __float_as_int(v))); }
__device__ __forceinline__ float shfl_x(float v, int o, int lane) { return shfl_idx(v, lane ^ o); }
__device__ __forceinline__ float wave_sum(float v, int lane) {
#pragma unroll
    for (int o = 1; o < 64; o <<= 1) v += shfl_x(v, o, lane);
    return v;
}
__device__ __forceinline__ float wave_max(float v, int lane) {
#pragma unroll
    for (int o = 1; o < 64; o <<= 1) v = fmaxf(v, shfl_x(v, o, lane));
    return v;
}
#define LDS_WAIT() asm volatile("s_waitcnt lgkmcnt(0)" ::: "memory")
#define VM_WAIT() asm volatile("s_waitcnt vmcnt(0)" ::: "memory")

namespace pg8 {
#define PG8_LAS __attribute__((address_space(3)))
constexpr int BM = 256, BK = 64, HALF = 128, HTB = HALF * BK * 2  , STAGE_BYTES = 8 * HTB, NXCD = 8, WGM = 8;
__host__ __device__ __forceinline__ int lds_byte(int r, int c) { const int st = (r >> 4) * 2 + (c >> 5), rr = r & 15, cc = c & 31, ob = rr * 64 + cc * 2; return st * 1024 + (ob ^ (((ob >> 9) & 1) << 5)); }
__host__ __device__ __forceinline__ void stage_rc(int b, int& R, int& C) { const int st = b / 1024, sb = b % 1024, swz = sb ^ (((sb >> 9) & 1) << 5); R = (st >> 1) * 16 + swz / 64; C = (st & 1) * 32 + (swz % 64) / 2; }
__host__ __device__ __forceinline__ int perm32(int rho) { const int n = rho >> 4, i = rho & 15; return 8 * (i >> 2) + 4 * n + (i & 3); }

struct Unit { int pm, pn; };
struct Gemm { const bf16_t* A; const bf16_t* Bt; int M, N, K; };

struct StaticOrder {
    int nM, nN, nwg, G, c;
    __host__ __device__ void init(int M, int N, int G_, int c_) { nM = M / BM; nN = N / BM; nwg = nM * nN; G = G_; c = c_; }
    __host__ __device__ bool next(int i, Unit& u) const {
        const long L = (long)i * G + c; if (L >= nwg) return false;
        int wgid = (int)L; { const int q = nwg / NXCD, r = nwg % NXCD, xcd = wgid % NXCD, off = wgid / NXCD; wgid = (xcd < r ? xcd * (q + 1) : r * (q + 1) + (xcd - r) * q) + off; }
        const int nig = WGM * nN, gid = wgid / nig, fm = gid * WGM, gsz = (nM - fm) < WGM ? (nM - fm) : WGM;
        u.pm = fm + ((wgid % nig) % gsz); u.pn = (wgid % nig) / gsz; return true;
    }
    __device__ __forceinline__ void a_ready(const Unit&) const {}
    __device__ __forceinline__ void done(const Unit&) const {}
};

struct EpiProj {
    static constexpr bool PERM = true, AFTER_DRAIN = false, ROWPERM = false;
    bf16_t* O; int ldc;
    __device__ __forceinline__ void operator()(const f32x4 (&acc)[2][2][4][2], const Unit& u, int wr, int wc, int fr, int fq) const {
        const int row0 = u.pm * BM + wr * 64 + fr, col0 = u.pn * BM + wc * 32 + 8 * fq;
        const float sc = (u.pn == 2 || u.pn == 8) ? QSCALE2 : (u.pn == 4 ? 0.125f : 1.f);
#pragma unroll
        for (int ai = 0; ai < 2; ++ai)
#pragma unroll
            for (int m = 0; m < 4; ++m) { bf16_t* rowp = O + (size_t)(row0 + ai * HALF + m * 16) * ldc + col0;
#pragma unroll
                for (int bj = 0; bj < 2; ++bj) { const f32x4 v0 = acc[ai][bj][m][0] * sc, v1 = acc[ai][bj][m][1] * sc;
                    u32x4 w; w.x = cvtpk(v0[0], v0[1]); w.y = cvtpk(v0[2], v0[3]); w.z = cvtpk(v1[0], v1[1]); w.w = cvtpk(v1[2], v1[3]);
                    *(u32x4*)(rowp + bj * HALF) = w; } }
    }
};
struct EpiResid {
    static constexpr bool PERM = true, AFTER_DRAIN = false, ROWPERM = false;
    const float* xin_lat; const float* xin_ctx; float* xout_lat; float* xout_ctx; const float* gate;
    __device__ __forceinline__ void operator()(const f32x4 (&acc)[2][2][4][2], const Unit& u, int wr, int wc, int fr, int fq) const {
        const int id = u.pm < 32 ? 0 : (u.pm < 64 ? 1 : 2);
        const float* xin = u.pm < 64 ? xin_lat + (size_t)u.pm * BM * DM : xin_ctx + (size_t)(u.pm - 64) * BM * DM;
        float* xout = u.pm < 64 ? xout_lat + (size_t)u.pm * BM * DM : xout_ctx + (size_t)(u.pm - 64) * BM * DM;
        const int rl = wr * 64 + fr, col0 = u.pn * BM + wc * 32 + 8 * fq;
        f32x4 g[2][2];
#pragma unroll
        for (int bj = 0; bj < 2; ++bj)
#pragma unroll
            for (int n = 0; n < 2; ++n) g[bj][n] = *(const f32x4*)(gate + id * 6144 + col0 + bj * HALF + 4 * n);
#pragma unroll
        for (int ai = 0; ai < 2; ++ai)
#pragma unroll
            for (int m = 0; m < 4; ++m) { const size_t off = (size_t)(rl + ai * HALF + m * 16) * DM + col0;
#pragma unroll
                for (int bj = 0; bj < 2; ++bj)
#pragma unroll
                    for (int n = 0; n < 2; ++n) { const f32x4 xv = *(const f32x4*)(xin + off + bj * HALF + 4 * n);
                        *(f32x4*)(xout + off + bj * HALF + 4 * n) = xv + g[bj][n] * acc[ai][bj][m][n]; } }
    }
};
struct EpiUp {
    static constexpr bool PERM = true, AFTER_DRAIN = false, ROWPERM = true;
    bf16_t* act; const float* convw; const float* convb; float* edge;
    __device__ __forceinline__ void operator()(f32x4 (&acc)[2][2][4][2], const Unit& u, int wr, int wc, int fr, int fq) const {
        const int chb = u.pn * 128 + wc * 32 + 8 * fq;
        const int ht = 2 * u.pm + wr;
        const int lm1 = (fq * 16 + fr - 1) & 63, lp1 = (fq * 16 + fr + 1) & 63;
#pragma unroll
        for (int bj = 0; bj < 2; ++bj)
#pragma unroll
            for (int n = 0; n < 2; ++n) {
                const int uc = bj * DFF + chb + 4 * n;
                if (fr == 0) { *(f32x4*)(edge + ((size_t)ht * 4 + 0) * DFF2 + uc) = acc[0][bj][0][n]; *(f32x4*)(edge + ((size_t)ht * 4 + 1) * DFF2 + uc) = acc[0][bj][1][n]; }
                if (fr == 15) { *(f32x4*)(edge + ((size_t)ht * 4 + 2) * DFF2 + uc) = acc[1][bj][2][n]; *(f32x4*)(edge + ((size_t)ht * 4 + 3) * DFF2 + uc) = acc[1][bj][3][n]; }
#pragma unroll
                for (int j = 0; j < 4; ++j) {
                    const float w0 = convw[uc + j], w1 = convw[DFF2 + uc + j], w2 = convw[2 * DFF2 + uc + j], bb = convb[uc + j];
                    float pv = shfl_idx(acc[1][bj][3][n][j], lm1); const float nx = shfl_idx(acc[0][bj][0][n][j], lp1);
#pragma unroll
                    for (int sl = 0; sl < 8; ++sl) { const float cur = acc[sl >> 2][bj][sl & 3][n][j]; const float nxt = sl < 7 ? acc[(sl + 1) >> 2][bj][(sl + 1) & 3][n][j] : nx;
                        acc[sl >> 2][bj][sl & 3][n][j] = w0 * pv + w1 * cur + w2 * nxt + bb; pv = cur; }
                }
            }
        bf16_t* base = act + (size_t)(u.pm * BM + (wr * 16 + fr) * 8) * DFF + chb;
#pragma unroll
        for (int sl = 0; sl < 8; ++sl) {
            const f32x4 g0 = acc[sl >> 2][0][sl & 3][0], g1 = acc[sl >> 2][0][sl & 3][1], v0 = acc[sl >> 2][1][sl & 3][0], v1 = acc[sl >> 2][1][sl & 3][1];
            f32x4 o0, o1;
#pragma unroll
            for (int j = 0; j < 4; ++j) { o0[j] = g0[j] * __builtin_amdgcn_rcpf(1.f + __builtin_amdgcn_exp2f(-LOG2E * g0[j])) * v0[j]; o1[j] = g1[j] * __builtin_amdgcn_rcpf(1.f + __builtin_amdgcn_exp2f(-LOG2E * g1[j])) * v1[j]; }
            u32x4 w; w.x = cvtpk(o0[0], o0[1]); w.y = cvtpk(o0[2], o0[3]); w.z = cvtpk(o1[0], o1[1]); w.w = cvtpk(o1[2], o1[3]);
            const bool skip = (fr == 0 && sl == 0) || (fr == 15 && sl == 7);
            if (!skip) *(u32x4*)(base + (size_t)sl * DFF) = w;
        }
    }
};
template <class Epi, class Sched, bool ALIGN_EPI = false, bool SP2 = false>
__device__ __forceinline__ void gemm_phase(PG8_LAS unsigned char* lds, const Gemm g, const Sched& S, const Epi& E, const int tid) {
    const int wid = __builtin_amdgcn_readfirstlane(tid >> 6), lane = tid & 63, wr = wid >> 2, wc = wid & 3, fr = lane & 15, fq = lane >> 4;
    const int K = g.K, nt = K / BK;
    unsigned voffA[2], voffB[2];
#pragma unroll
    for (int i = 0; i < 2; ++i) { int R, C; stage_rc(tid * 16 + i * 8192, R, C); const int Rb = Epi::PERM ? ((R & ~31) + perm32(R & 31)) : R;
        const int Ra = Epi::ROWPERM ? (((((R >> 6) & 1) * 16 + (R & 15)) << 3) + ((R >> 4) & 3)) : R;
        voffA[i] = (unsigned)(Ra * K + C) * 2u; voffB[i] = (unsigned)(Rb * K + C) * 2u; }
    const size_t kstep = (size_t)(BK * 2);
    const size_t hstep = (size_t)HALF * K * 2;
    const size_t hstepA = Epi::ROWPERM ? (size_t)4 * K * 2 : hstep;
    const size_t tstep = 2 * hstep;
    const unsigned ldsw = (unsigned)wid * 1024u;
    const int aoff = lds_byte(wr * 64 + fr, fq * 8), boff = lds_byte(wc * 32 + fr, fq * 8);
#define PG8_SA(b, h) (((b) * 2 + (h)) * HTB)
#define PG8_SB(b, h) ((4 + (b) * 2 + (h)) * HTB)
#define PG8_STAGE(bufoff, gbase, voff) do { _Pragma("unroll") for (int _i = 0; _i < 2; ++_i) \
        __builtin_amdgcn_global_load_lds((const unsigned*)((const char*)(gbase) + (voff)[_i]), (PG8_LAS unsigned*)(lds + (bufoff) + ldsw + _i * 8192), 16, 0, 0); } while (0)
#define PG8_LDA(dst, b, h) do { _Pragma("unroll") for (int m = 0; m < 4; ++m) _Pragma("unroll") for (int k = 0; k < 2; ++k) dst[m][k] = *(const PG8_LAS bf16x8*)(lds + PG8_SA(b, h) + aoff + m * 2048 + k * 1024); } while (0)
#define PG8_LDB(dst, b, h) do { _Pragma("unroll") for (int n = 0; n < 2; ++n) _Pragma("unroll") for (int k = 0; k < 2; ++k) dst[n][k] = *(const PG8_LAS bf16x8*)(lds + PG8_SB(b, h) + boff + n * 2048 + k * 1024); } while (0)
#define PG8_MMA(ai, bj, At, Bt) do { __builtin_amdgcn_s_setprio(1); _Pragma("unroll") for (int m = 0; m < 4; ++m) _Pragma("unroll") for (int n = 0; n < 2; ++n) _Pragma("unroll") for (int k = 0; k < 2; ++k) \
        acc[ai][bj][m][n] = __builtin_amdgcn_mfma_f32_16x16x32_bf16(Bt[n][k], At[m][k], acc[ai][bj][m][n], 0, 0, 0); __builtin_amdgcn_s_setprio(0); } while (0)
#define PG8_WAIT_V(n) asm volatile("s_waitcnt vmcnt(" #n ")" ::: "memory")
#define PG8_WAIT_L(n) asm volatile("s_waitcnt lgkmcnt(" #n ")" ::: "memory")
#define PG8_BAR __builtin_amdgcn_s_barrier()
#define PG8_SCHED __builtin_amdgcn_sched_barrier(0)
    Unit cur, nxt; int ui = 0;
    if (!S.next(0, cur)) return;
    f32x4 acc[2][2][4][2];
#pragma unroll
    for (int a = 0; a < 2; ++a)
#pragma unroll
        for (int b = 0; b < 2; ++b)
#pragma unroll
            for (int m = 0; m < 4; ++m)
#pragma unroll
                for (int n = 0; n < 2; ++n) acc[a][b][m][n] = (f32x4){0.f, 0.f, 0.f, 0.f};
    bf16x8 At[4][2], B0[2][2], B1[2][2];
    const char* cA = (const char*)g.A + (size_t)cur.pm * tstep; const char* cB = (const char*)g.Bt + (size_t)cur.pn * tstep;
    S.a_ready(cur);
    if constexpr (SP2) {
        PG8_STAGE(PG8_SB(0, 0), cB, voffB); PG8_STAGE(PG8_SB(0, 1), cB + hstep, voffB); PG8_STAGE(PG8_SA(0, 0), cA, voffA); PG8_STAGE(PG8_SA(0, 1), cA + hstepA, voffA);
        if (wr == 1) PG8_BAR;
        PG8_WAIT_V(2); PG8_BAR;
        PG8_STAGE(PG8_SB(1, 0), cB + kstep, voffB); PG8_STAGE(PG8_SA(1, 0), cA + kstep, voffA); PG8_STAGE(PG8_SB(1, 1), cB + hstep + kstep, voffB);
        PG8_WAIT_V(6); PG8_BAR;
    } else {
        PG8_STAGE(PG8_SB(0, 0), cB, voffB); PG8_STAGE(PG8_SA(0, 0), cA, voffA); PG8_STAGE(PG8_SB(0, 1), cB + hstep, voffB); PG8_STAGE(PG8_SA(0, 1), cA + hstepA, voffA);
        if (wr == 1) PG8_BAR;
        PG8_WAIT_V(4); PG8_BAR;
        PG8_STAGE(PG8_SB(1, 0), cB + kstep, voffB); PG8_STAGE(PG8_SA(1, 0), cA + kstep, voffA); PG8_STAGE(PG8_SB(1, 1), cB + hstep + kstep, voffB);
        PG8_WAIT_V(6); PG8_BAR;
    }
    for (;;) {
        const bool has_next = S.next(ui + 1, nxt);
        const char* nA = has_next ? (const char*)g.A + (size_t)nxt.pm * tstep : cA; const char* nB = has_next ? (const char*)g.Bt + (size_t)nxt.pn * tstep : cB;
        for (int t = 0; t < nt; t += 2) {
            const bool last = (t == nt - 2);
            const char* a1 = cA + (size_t)(t + 1) * kstep;
            const char* a2 = last ? nA : cA + (size_t)(t + 2) * kstep; const char* b2 = last ? nB : cB + (size_t)(t + 2) * kstep;
            const char* a3 = a2 + kstep; const char* b3 = b2 + kstep;
            if (last && has_next) S.a_ready(nxt);
            if constexpr (SP2) {
            PG8_LDB(B0, 0, 0); PG8_LDB(B1, 0, 1); PG8_SCHED; PG8_LDA(At, 0, 0); PG8_STAGE(PG8_SA(1, 1), a1 + hstepA, voffA);
            PG8_WAIT_V(8); PG8_WAIT_L(0); PG8_BAR; PG8_MMA(0, 0, At, B0); PG8_MMA(0, 1, At, B1); PG8_BAR; PG8_SCHED;
            PG8_LDA(At, 0, 1); PG8_STAGE(PG8_SB(0, 0), b2, voffB); PG8_STAGE(PG8_SB(0, 1), b2 + hstep, voffB); PG8_STAGE(PG8_SA(0, 0), a2, voffA);
            PG8_WAIT_V(8); PG8_WAIT_L(0); PG8_BAR; PG8_MMA(1, 0, At, B0); PG8_MMA(1, 1, At, B1); PG8_BAR; PG8_SCHED;
            PG8_LDB(B0, 1, 0); PG8_LDB(B1, 1, 1); PG8_SCHED; PG8_LDA(At, 1, 0); PG8_STAGE(PG8_SA(0, 1), a2 + hstepA, voffA);
            PG8_WAIT_V(8); PG8_WAIT_L(0); PG8_BAR; PG8_MMA(0, 0, At, B0); PG8_MMA(0, 1, At, B1); PG8_BAR; PG8_SCHED;
            PG8_LDA(At, 1, 1); PG8_STAGE(PG8_SB(1, 0), b3, voffB); PG8_STAGE(PG8_SB(1, 1), b3 + hstep, voffB); PG8_STAGE(PG8_SA(1, 0), a3, voffA);
            PG8_WAIT_V(8); PG8_WAIT_L(0); PG8_BAR; PG8_MMA(1, 0, At, B0); PG8_MMA(1, 1, At, B1); PG8_BAR; PG8_SCHED;
            } else {
            PG8_LDB(B0, 0, 0); PG8_SCHED; PG8_LDA(At, 0, 0); PG8_STAGE(PG8_SA(1, 1), a1 + hstepA, voffA);
            PG8_WAIT_L(8); PG8_BAR; PG8_WAIT_L(0); PG8_MMA(0, 0, At, B0); PG8_BAR; PG8_SCHED;
            PG8_LDB(B1, 0, 1); PG8_STAGE(PG8_SB(0, 0), b2, voffB);
            PG8_BAR; PG8_WAIT_L(0); PG8_MMA(0, 1, At, B1); PG8_BAR;
            PG8_LDA(At, 0, 1); PG8_STAGE(PG8_SA(0, 0), a2, voffA);
            PG8_BAR; PG8_WAIT_L(0); PG8_MMA(1, 0, At, B0); PG8_BAR; PG8_SCHED;
            PG8_STAGE(PG8_SB(0, 1), b2 + hstep, voffB);
            PG8_WAIT_V(6); PG8_BAR; PG8_MMA(1, 1, At, B1); PG8_BAR;
            PG8_LDB(B0, 1, 0); PG8_SCHED; PG8_LDA(At, 1, 0); PG8_STAGE(PG8_SA(0, 1), a2 + hstepA, voffA);
            PG8_WAIT_L(8); PG8_BAR; PG8_WAIT_L(0); PG8_MMA(0, 0, At, B0); PG8_BAR; PG8_SCHED;
            PG8_LDB(B1, 1, 1); PG8_STAGE(PG8_SB(1, 0), b3, voffB);
            PG8_BAR; PG8_WAIT_L(0); PG8_MMA(0, 1, At, B1); PG8_BAR;
            PG8_LDA(At, 1, 1); PG8_STAGE(PG8_SA(1, 0), a3, voffA);
            PG8_BAR; PG8_WAIT_L(0); PG8_MMA(1, 0, At, B0); PG8_BAR; PG8_SCHED;
            PG8_STAGE(PG8_SB(1, 1), b3 + hstep, voffB);
            PG8_WAIT_V(6); PG8_BAR; PG8_MMA(1, 1, At, B1); PG8_BAR;
            }
        }
        if constexpr (ALIGN_EPI) { if (wr == 0) PG8_BAR; }
        if constexpr (!Epi::AFTER_DRAIN) { E(acc, cur, wr, wc, fr, fq); S.done(cur); }
        if (!has_next) break;
#pragma unroll
        for (int a = 0; a < 2; ++a)
#pragma unroll
            for (int b = 0; b < 2; ++b)
#pragma unroll
                for (int m = 0; m < 4; ++m)
#pragma unroll
                    for (int n = 0; n < 2; ++n) acc[a][b][m][n] = (f32x4){0.f, 0.f, 0.f, 0.f};
        cur = nxt; cA = nA; cB = nB; ++ui;
        if constexpr (ALIGN_EPI) { if (wr == 1) PG8_BAR; }
    }
    PG8_WAIT_V(0);
    if constexpr (!ALIGN_EPI) { if (wr == 0) PG8_BAR; }
    PG8_BAR;
    if constexpr (Epi::AFTER_DRAIN) { E.fused(acc, cur, wr, wc, fr, fq, lds, wid, lane); S.done(cur); }
#undef PG8_SA
#undef PG8_SB
#undef PG8_STAGE
#undef PG8_LDA
#undef PG8_LDB
#undef PG8_MMA
#undef PG8_WAIT_V
#undef PG8_WAIT_L
#undef PG8_BAR
#undef PG8_SCHED
}
}

constexpr int NWAVES = 8, NTHREADS = 512;
constexpr int LDS_BYTES = 155648;
struct Args {
    const float* in[21]; float* out; unsigned char* ws; int ph_lo, ph_hi;
};
struct Frame {
    LAS unsigned char* lds;
    int tid, lane, wave, G, bid;
    const __attribute__((address_space(4))) Args* ka;
    float* out; unsigned char* ws;
};
enum { IN_X = 0, IN_C, IN_CTX, IN_CCTX, IN_WMOD, IN_BMOD, IN_G1, IN_G2, IN_WIN, IN_AQG, IN_AKG, IN_SINK, IN_CGB, IN_RPB, IN_GGRP, IN_WOUT, IN_WUP, IN_CONVW, IN_CONVB, IN_WDN, IN_GFIN };

template <class MapFn>
__device__ __forceinline__ void transpose_item(const float* W, int K, int N, bf16_t* WT, LAS float* scr, int item, int lane, MapFn map) {
    const int nblk = (N + 31) / 32, kb = item / nblk, nb = item % nblk, k0 = 64 * kb, n0 = 32 * nb;
    const int col = n0 + (lane & 31);
#pragma unroll 8
    for (int i = 0; i < 32; ++i) { const int kk = 2 * i + (lane >> 5); scr[kk * 33 + (lane & 31)] = col < N ? W[(size_t)(k0 + kk) * N + col] : 0.f; }
    LDS_WAIT(); asm volatile("" ::: "memory");
    const int c = lane & 7;
#pragma unroll
    for (int j = 0; j < 4; ++j) { const int n = (lane >> 3) + 8 * j; const LAS float* s = scr + (8 * c) * 33 + n;
        u32x4 o; o.x = cvtpk(s[0 * 33], s[1 * 33]); o.y = cvtpk(s[2 * 33], s[3 * 33]); o.z = cvtpk(s[4 * 33], s[5 * 33]); o.w = cvtpk(s[6 * 33], s[7 * 33]);
        const int sc = n0 + n; const int dr = sc < N ? map(sc) : -1;
        if (dr >= 0) *(u32x4*)(WT + (size_t)dr * K + k0 + 8 * c) = o; }
    LDS_WAIT(); asm volatile("" ::: "memory");
}
__device__ __forceinline__ void p0_prologue(Frame& F) {
    const float* c = F.ka->in[IN_C]; const float* cctx = F.ka->in[IN_CCTX];
    {
        LAS float* sv = (LAS float*)F.lds;
        LAS float* red = (LAS float*)(F.lds + 12288);
        for (int i = F.tid; i < 3 * 1024; i += NTHREADS) { const int id = i >> 10, k = i & 1023; const float v = id < 2 ? c[id * 1024 + k] : cctx[k]; sv[i] = v / (1.f + __expf(-v)); }
        __syncthreads();
        float* MOD = (float*)(F.ws + WS_MOD);
        for (int it = F.bid; it < NLAYER * 96; it += F.G) {
            const int l = it / 96, nb = it % 96, n = nb * 64 + F.lane;
            const float* w = F.ka->in[IN_WMOD] + ((size_t)l * 1024 + F.wave * 128) * 6144 + n;
            float a0 = 0.f, a1 = 0.f, a2 = 0.f;
#pragma unroll 16
            for (int k = 0; k < 128; ++k) { const float wv = w[(size_t)k * 6144]; const int kk = F.wave * 128 + k; a0 += sv[kk] * wv; a1 += sv[1024 + kk] * wv; a2 += sv[2048 + kk] * wv; }
            red[(F.wave * 3 + 0) * 64 + F.lane] = a0; red[(F.wave * 3 + 1) * 64 + F.lane] = a1; red[(F.wave * 3 + 2) * 64 + F.lane] = a2;
            __syncthreads();
            if (F.tid < 192) { const int id = F.tid >> 6, ln = F.tid & 63; float s = F.ka->in[IN_BMOD][l * 6144 + nb * 64 + ln];
#pragma unroll
                for (int w8 = 0; w8 < 8; ++w8) s += red[(w8 * 3 + id) * 64 + ln];
                MOD[((size_t)l * 3 + id) * 6144 + nb * 64 + ln] = s; }
            __syncthreads();
        }
    }
    __syncthreads();
    const int gw = F.bid * NWAVES + F.wave, NGW = F.G * NWAVES, gt = F.bid * NTHREADS + F.tid, NGT = F.G * NTHREADS;
    { float* ROPE = (float*)(F.ws + WS_ROPE);
      for (int e = gt; e < 192 * 16; e += NGT) { const int idx = e >> 4, i = e & 15; const float pos = (float)(idx < 128 ? idx : idx - 128);
          const float freq = powf(10000.0f, -(float)i / 16.0f); const float ang = pos * freq; ROPE[2 * e] = cosf(ang); ROPE[2 * e + 1] = sinf(ang); } }
    { float* WG = (float*)(F.ws + WS_WG);
      for (int e = gt; e < NLAYER * 16 * 1024; e += NGT) { const int l = e >> 14, o = (e >> 10) & 15, k = e & 1023; WG[e] = F.ka->in[IN_WIN][((size_t)l * 1024 + k) * DIN + 2048 + o]; } }
    LAS float* scr = (LAS float*)(F.lds + F.wave * 16384);
    constexpr int I_IN = 16 * 89, I_OUT = 16 * 32, I_UP = 16 * 176, I_DN = 44 * 32, I_L = I_IN + I_OUT + I_UP + I_DN;
    for (int it = gw; it < NLAYER * I_L; it += NGW) {
        const int l = it / I_L; int r = it % I_L;
        if (r < I_IN) { transpose_item(F.ka->in[IN_WIN] + (size_t)l * 1024 * DIN, 1024, DIN, (bf16_t*)(F.ws + WS_WIN) + (size_t)l * PP * 1024, scr, r, F.lane,
                                       [](int n) { return n < 2048 ? n : (n < 2064 ? -1 : n - 16); }); continue; } r -= I_IN;
        if (r < I_OUT) { transpose_item(F.ka->in[IN_WOUT] + (size_t)l * 1024 * 1024, 1024, 1024, (bf16_t*)(F.ws + WS_WOUT) + (size_t)l * 1024 * 1024, scr, r, F.lane, [](int n) { return n; }); continue; } r -= I_OUT;
        if (r < I_UP) { transpose_item(F.ka->in[IN_WUP] + (size_t)l * 1024 * DFF2, 1024, DFF2, (bf16_t*)(F.ws + WS_WUP) + (size_t)l * DFF2 * 1024, scr, r, F.lane,
                                       [](int n) { const int m = n < DFF ? n : n - DFF; return (m >> 7) * 256 + (n < DFF ? 0 : 128) + (m & 127); }); continue; } r -= I_UP;
        transpose_item(F.ka->in[IN_WDN] + (size_t)l * DFF * 1024, DFF, 1024, (bf16_t*)(F.ws + WS_WDN) + (size_t)l * 1024 * DFF, scr, r, F.lane, [](int n) { return n; });
    }
}

__device__ __forceinline__ void norm_phase(Frame& F, int layer, int which, int nrows) {
    const int gw = F.bid * NWAVES + F.wave, NGW = F.G * NWAVES;
    const float* gvec = F.ka->in[which ? IN_G2 : IN_G1] + layer * 1024;
    const float* mod = (const float*)(F.ws + WS_MOD) + (size_t)layer * 3 * 6144 + (which ? 3 * 1024 : 0);
    const bool first = (layer == 0 && which == 0);
    const float* xl = first ? F.ka->in[IN_X] : F.out; const float* xc = first ? F.ka->in[IN_CTX] : (const float*)(F.ws + WS_XC);
    bf16_t* H = (bf16_t*)(F.ws + WS_H);
    const float* WG = (const float*)(F.ws + WS_WG) + (size_t)layer * 16 * 1024;
    float* GATES = (float*)(F.ws + WS_GATES);
    f32x4 gv[4];
#pragma unroll
    for (int j = 0; j < 4; ++j) gv[j] = *(const f32x4*)(gvec + 4 * F.lane + 256 * j);
    for (int rg = gw; rg < nrows / 4; rg += NGW) {
        const int row0 = rg * 4; const int id = row0 < SEQ ? 0 : (row0 < NLAT ? 1 : 2);
        const float* sh = mod + id * 6144; const float* sc = sh + 1024;
        f32x4 hv[4][4];
#pragma unroll
        for (int r = 0; r < 4; ++r) { const int row = row0 + r; const float* xr = row < NLAT ? xl + (size_t)row * DM : xc + (size_t)(row - NLAT) * DM;
#pragma unroll
            for (int j = 0; j < 4; ++j) hv[r][j] = *(const f32x4*)(xr + 4 * F.lane + 256 * j); }
#pragma unroll
        for (int r = 0; r < 4; ++r) { float s = 0.f;
#pragma unroll
            for (int j = 0; j < 4; ++j) s += (hv[r][j][0] * hv[r][j][0] + hv[r][j][1] * hv[r][j][1]) + (hv[r][j][2] * hv[r][j][2] + hv[r][j][3] * hv[r][j][3]);
            const float rstd = rsqrtf(wave_sum(s, F.lane) * (1.f / DM) + EPS);
#pragma unroll
            for (int j = 0; j < 4; ++j) { const f32x4 scv = *(const f32x4*)(sc + 4 * F.lane + 256 * j), shv = *(const f32x4*)(sh + 4 * F.lane + 256 * j);
                hv[r][j] = hv[r][j] * rstd * gv[j] * (1.f + scv) + shv;
                u32x2 w; w.x = cvtpk(hv[r][j][0], hv[r][j][1]); w.y = cvtpk(hv[r][j][2], hv[r][j][3]);
                *(u32x2*)(H + (size_t)(row0 + r) * DM + 4 * F.lane + 256 * j) = w; } }
        if (which == 0) {
            float mine[4] = {0.f, 0.f, 0.f, 0.f};
            for (int o = 0; o < 16; ++o) {
                f32x4 wv[4];
#pragma unroll
                for (int j = 0; j < 4; ++j) wv[j] = *(const f32x4*)(WG + o * 1024 + 4 * F.lane + 256 * j);
#pragma unroll
                for (int r = 0; r < 4; ++r) { float p = 0.f;
#pragma unroll
                    for (int j = 0; j < 4; ++j) p += (hv[r][j][0] * wv[j][0] + hv[r][j][1] * wv[j][1]) + (hv[r][j][2] * wv[j][2] + hv[r][j][3] * wv[j][3]);
                    p = wave_sum(p, F.lane); if (F.lane == o) mine[r] = p; }
            }
            if (F.lane < 16) {
#pragma unroll
                for (int r = 0; r < 4; ++r) GATES[(size_t)(row0 + r) * 16 + F.lane] = mine[r]; }
        }
    }
}

__device__ __forceinline__ void postproj_phase(Frame& F, int layer) {
    const int gw = F.bid * NWAVES + F.wave, NGW = F.G * NWAVES;
    bf16_t* PROJ = (bf16_t*)(F.ws + WS_PROJ);
    const float* ROPE = (const float*)(F.ws + WS_ROPE);
    const int sub = F.lane >> 4, l16 = F.lane & 15, d = 4 * l16;
    const f32x4 gq = *(const f32x4*)(F.ka->in[IN_AQG] + layer * 64 + d), gk = *(const f32x4*)(F.ka->in[IN_AKG] + layer * 64 + d);
    for (int row = gw; row < NROWS; row += NGW) {
        const bool lat = row < NLAT; const int t = row & (SEQ - 1);
        bf16_t* pr = PROJ + (size_t)row * PP;
        f32x4 cs0 = {1.f, 0.f, 1.f, 0.f}, cs1 = {1.f, 0.f, 1.f, 0.f};
        if (lat) { const int idx = (d >> 5) ? 128 + (t & 63) : (t >> 6); const float* rp = ROPE + ((size_t)idx * 16 + (d & 15)) * 2; cs0 = *(const f32x4*)rp; cs1 = *(const f32x4*)(rp + 4); }
        const float cz[4] = {cs0[0], cs0[2], cs1[0], cs1[2]}, sz[4] = {cs0[1], cs0[3], cs1[1], cs1[3]};
        const bool x2 = (l16 & 4) != 0;
#pragma unroll
        for (int pass = 0; pass < 3; ++pass) {
            const int col = pass == 0 ? PC_AQ + 64 * sub + d : (pass == 1 ? (sub < 2 ? PC_AK + 64 * sub + d : PC_BK + 64 * (sub - 2) + d) : PC_BQ + 64 * sub + d);
            const bool donorm = pass == 0 || (pass == 1 && sub < 2);
            const bool active = lat || donorm;
            if (!lat && pass == 2) continue;
            const u32x2 w = *(const u32x2*)(pr + col);
            float v[4] = {bflo(w.x), bfhi(w.x), bflo(w.y), bfhi(w.y)};
            float ss = (v[0] * v[0] + v[1] * v[1]) + (v[2] * v[2] + v[3] * v[3]);
            ss += shfl_x(ss, 1, F.lane); ss += shfl_x(ss, 2, F.lane); ss += shfl_x(ss, 4, F.lane); ss += shfl_x(ss, 8, F.lane);
            if (donorm) { const float rstd = rsqrtf(ss * (1.f / 64.f) + EPS) * (pass == 0 ? QSCALE2 : 1.f); const f32x4 g = pass == 0 ? gq : gk;
#pragma unroll
                for (int e = 0; e < 4; ++e) v[e] = v[e] * rstd * g[e]; }
            float o[4];
#pragma unroll
            for (int e = 0; e < 4; ++e) { const float p = shfl_x(v[e], 4, F.lane); o[e] = x2 ? (p * sz[e] + v[e] * cz[e]) : (v[e] * cz[e] - p * sz[e]); }
            if (active) { u32x2 ow; ow.x = cvtpk(o[0], o[1]); ow.y = cvtpk(o[2], o[3]); *(u32x2*)(pr + col) = ow; }
        }
    }
}

__device__ __forceinline__ void groupnorm_phase(Frame& F, int layer, int nrows) {
    const int gw = F.bid * NWAVES + F.wave, NGW = F.G * NWAVES;
    bf16_t* H = (bf16_t*)(F.ws + WS_H);
    const float* gg = F.ka->in[IN_GGRP] + layer * 1024;
    f32x4 gv[4];
#pragma unroll
    for (int j = 0; j < 4; ++j) gv[j] = *(const f32x4*)(gg + 4 * F.lane + 256 * j);
    for (int row = gw; row < nrows; row += NGW) {
        bf16_t* hr = H + (size_t)row * DM + 4 * F.lane;
        u32x2 w[4];
#pragma unroll
        for (int j = 0; j < 4; ++j) w[j] = *(const u32x2*)(hr + 256 * j);
#pragma unroll
        for (int j = 0; j < 4; ++j) { float v[4] = {bflo(w[j].x), bfhi(w[j].x), bflo(w[j].y), bfhi(w[j].y)};
            const float rstd = rsqrtf(wave_sum((v[0] * v[0] + v[1] * v[1]) + (v[2] * v[2] + v[3] * v[3]), F.lane) * (1.f / 256.f) + EPS);
            u32x2 o; o.x = cvtpk(v[0] * rstd * gv[j][0], v[1] * rstd * gv[j][1]); o.y = cvtpk(v[2] * rstd * gv[j][2], v[3] * rstd * gv[j][3]);
            *(u32x2*)(hr + 256 * j) = o; }
    }
}

__device__ __forceinline__ void fixup_phase(Frame& F, int layer, int nht) {
    const int gt = F.bid * NTHREADS + F.tid, NGT = F.G * NTHREADS;
    const float* edge = (const float*)(F.ws + WS_DS);
    const float* cw = F.ka->in[IN_CONVW] + (size_t)layer * 3 * DFF2; const float* cb = F.ka->in[IN_CONVB] + (size_t)layer * DFF2;
    bf16_t* act = (bf16_t*)(F.ws + WS_PROJ);
    const int per_row = DFF / 4;
    for (int it = gt; it < nht * 2 * per_row; it += NGT) {
        const int ch = (it % per_row) * 4, rr = it / per_row, ht = rr >> 1, last = rr & 1;
        const bool seq_start = (ht == 0 || ht == 64 || ht == 128 || ht == 130), seq_end = (ht == 63 || ht == 127 || ht == 129 || ht == 131);
        const int row = ht * 128 + (last ? 127 : 0);
        f32x4 o;
        f32x4 res[2];
#pragma unroll
        for (int gvv = 0; gvv < 2; ++gvv) { const int uc = gvv * DFF + ch;
            const f32x4 z = {0.f, 0.f, 0.f, 0.f};
            f32x4 up, ucur, un;
            if (!last) { up = seq_start ? z : *(const f32x4*)(edge + ((size_t)(ht - 1) * 4 + 3) * DFF2 + uc); ucur = *(const f32x4*)(edge + ((size_t)ht * 4 + 0) * DFF2 + uc); un = *(const f32x4*)(edge + ((size_t)ht * 4 + 1) * DFF2 + uc); }
            else { up = *(const f32x4*)(edge + ((size_t)ht * 4 + 2) * DFF2 + uc); ucur = *(const f32x4*)(edge + ((size_t)ht * 4 + 3) * DFF2 + uc); un = seq_end ? z : *(const f32x4*)(edge + ((size_t)(ht + 1) * 4 + 0) * DFF2 + uc); }
            res[gvv] = *(const f32x4*)(cw + uc) * up + *(const f32x4*)(cw + DFF2 + uc) * ucur + *(const f32x4*)(cw + 2 * DFF2 + uc) * un + *(const f32x4*)(cb + uc); }
#pragma unroll
        for (int j = 0; j < 4; ++j) o[j] = res[0][j] / (1.f + __expf(-res[0][j])) * res[1][j];
        u32x2 w; w.x = cvtpk(o[0], o[1]); w.y = cvtpk(o[2], o[3]);
        *(u32x2*)(act + (size_t)row * DFF + ch) = w;
    }
}

__device__ __forceinline__ void final_phase(Frame& F) {
    const int gw = F.bid * NWAVES + F.wave, NGW = F.G * NWAVES;
    const float* gf = F.ka->in[IN_GFIN];
    f32x4 gv[4];
#pragma unroll
    for (int j = 0; j < 4; ++j) gv[j] = *(const f32x4*)(gf + 4 * F.lane + 256 * j);
    for (int row = gw; row < NLAT; row += NGW) {
        float* xr = F.out + (size_t)row * DM + 4 * F.lane;
        f32x4 v[4]; float s = 0.f;
#pragma unroll
        for (int j = 0; j < 4; ++j) { v[j] = *(const f32x4*)(xr + 256 * j); s += (v[j][0] * v[j][0] + v[j][1] * v[j][1]) + (v[j][2] * v[j][2] + v[j][3] * v[j][3]); }
        const float rstd = rsqrtf(wave_sum(s, F.lane) * (1.f / DM) + EPS);
#pragma unroll
        for (int j = 0; j < 4; ++j) *(f32x4*)(xr + 256 * j) = v[j] * rstd * gv[j];
    }
}

namespace att {
constexpr int SLOTB = 8192;
constexpr int L_K = 0, L_V = 2 * SLOTB, L_WS = 4 * SLOTB, L_OST = L_WS + 8 * 256, L_RPB = L_OST + 8 * 4096, L_END = L_RPB + 2048;
constexpr float THR = 8.0f;
__device__ __forceinline__ int crow(int r, int hi) { return (r & 3) + 8 * (r >> 2) + 4 * hi; }
__device__ __forceinline__ s16x4 vtr(const LAS unsigned char* p) { return __builtin_bit_cast(s16x4, __builtin_amdgcn_ds_read_tr16_b64_v4i16((LAS v4i16_t*)p)); }
__device__ __forceinline__ float rowmax32(const f32x16& p0, const f32x16& p1) {
    float a = fmaxf(p0[0], p1[0]);
#pragma unroll
    for (int r = 1; r < 16; ++r) a = fmaxf(a, fmaxf(p0[r], p1[r]));
    auto rr = __builtin_amdgcn_permlane32_swap(__float_as_uint(a), __float_as_uint(a), false, false);
    return fmaxf(__uint_as_float(rr[0]), __uint_as_float(rr[1]));
}
__device__ __forceinline__ float halfsum(float v) {
    auto rr = __builtin_amdgcn_permlane32_swap(__float_as_uint(v), __float_as_uint(v), false, false);
    return __uint_as_float(rr[0]) + __uint_as_float(rr[1]);
}
#define ATT_WAIT_BAR() asm volatile("s_waitcnt vmcnt(0) lgkmcnt(0)\n\ts_barrier" ::: "memory")

template <int MODE>
__device__ __forceinline__ void attn_unit(Frame& F, int b, int h, int qb, int qcol, int kcol, int vcol, int ycol, float sink2, const float* rpb) {
    LAS unsigned char* lds = F.lds;
    const int lane = F.lane, r32 = lane & 31, hi = lane >> 5, wid = F.wave;
    const bf16_t* PROJ = (const bf16_t*)(F.ws + WS_PROJ); bf16_t* Y = (bf16_t*)(F.ws + WS_H);
    const int ctxrow = NLAT + CTXL * b, latrow = SEQ * b;
    const int qrow0 = (MODE == 3) ? ctxrow : latrow + 256 * qb;
    const int qw0 = 256 * qb + 32 * wid;
    int lt_lo = 0, nloc = 0;
    if (MODE == 0) { lt_lo = 0; nloc = 128; }
    if (MODE == 1) { const int a = (256 * qb - 128) >> 6, e = (256 * qb + 255 + 128) >> 6; lt_lo = a < 0 ? 0 : a; nloc = (e > 127 ? 127 : e) - lt_lo + 1; }
    if (MODE == 2) { const int a = 4 * qb - 4, e0 = 4 * qb - 1; lt_lo = a < 0 ? 0 : (a > 120 ? 120 : a); const int e = (e0 < 0 ? 0 : (e0 > 120 ? 120 : e0)) + 7; nloc = e - lt_lo + 1; }
    const int NT = 4 + nloc;
    const int rw = 4 * qb + (wid >> 1); const int rs = rw - 4 < 0 ? 0 : (rw - 4 > 120 ? 120 : rw - 4);
    const int qc = 32 * (wid & 1) + r32; const int cs = qc - 8 < 0 ? 0 : (qc - 8 > 48 ? 48 : qc - 8);
    LAS float* wsf = (LAS float*)(lds + L_WS) + wid * 64;
    LAS float* rpbL = (LAS float*)(lds + L_RPB);
    if (MODE == 2) { for (int i = F.tid; i < 465; i += NTHREADS) rpbL[i] = rpb[i] * LOG2E; }
    const int vp0 = ((lane >> 4) & 1) * 32 + (lane & 3) * 8 + (4 * hi + ((lane & 15) >> 2)) * 64;
#define ATT_KROW(t) ((t) < 4 ? ctxrow + 64 * (t) : latrow + 64 * (lt_lo + (t) - 4))
#define ATT_DMA(t, slot) do { const int kr_ = ATT_KROW(t); \
        __builtin_amdgcn_global_load_lds((const unsigned*)(PROJ + (size_t)(kr_ + lane) * PP + kcol + wid * 8), (LAS unsigned*)(lds + L_K + (slot) * SLOTB + wid * 1024), 16, 0, 0); \
        __builtin_amdgcn_global_load_lds((const unsigned*)(PROJ + (size_t)(kr_ + 16 * (wid & 3) + (lane >> 2)) * PP + vcol + (wid >> 2) * 32 + (lane & 3) * 8), (LAS unsigned*)(lds + L_V + (slot) * SLOTB + wid * 1024), 16, 0, 0); } while (0)
    ATT_DMA(0, 0);
    bf16x8 qr[4];
#pragma unroll
    for (int d0 = 0; d0 < 4; ++d0) qr[d0] = *(const bf16x8*)(PROJ + (size_t)(qrow0 + 32 * wid + r32) * PP + qcol + d0 * 16 + hi * 8);
    float mhat = 0.f, l = 0.f; f32x16 o0 = {}, o1 = {}, negm = {};
    ATT_WAIT_BAR();
    for (int t = 0; t < NT; ++t) {
        const int slot = t & 1;
        if (t + 1 < NT) ATT_DMA(t + 1, slot ^ 1);
        bool rel = true; int kb0 = 0;
        if (MODE == 1 && t >= 4) { kb0 = 64 * (lt_lo + t - 4); rel = (kb0 + 63 >= qw0 - 128) && (kb0 <= qw0 + 31 + 128); }
        if (MODE == 2 && t >= 4) { kb0 = lt_lo + t - 4; rel = (kb0 >= rs) && (kb0 < rs + 8); }
        if (rel) {
            const LAS unsigned char* kb = lds + L_K + slot * SLOTB + hi * 1024 + r32 * 16;
            f32x16 p0 = negm, p1 = negm;
#pragma unroll
            for (int d0 = 0; d0 < 4; ++d0) {
                const bf16x8 b0 = *(const LAS bf16x8*)(kb + d0 * 2048), b1 = *(const LAS bf16x8*)(kb + d0 * 2048 + 512);
                p0 = __builtin_amdgcn_mfma_f32_32x32x16_bf16(b0, qr[d0], p0, 0, 0, 0);
                p1 = __builtin_amdgcn_mfma_f32_32x32x16_bf16(b1, qr[d0], p1, 0, 0, 0);
            }
            if (MODE == 1 && t >= 4) {
                const int dq = kb0 - (qw0 + r32);
#pragma unroll
                for (int r = 0; r < 16; ++r) { const int kc = crow(r, hi); const int d0_ = dq + kc, d1_ = d0_ + 32;
                    if (d0_ > 128 || d0_ < -128) p0[r] = -INFINITY; if (d1_ > 128 || d1_ < -128) p1[r] = -INFINITY; }
            }
            if (MODE == 2 && t >= 4) {
                const LAS float* bt = rpbL + (kb0 - rw + 7) * 31 + (15 - qc);
#pragma unroll
                for (int r = 0; r < 16; ++r) { const int kc = crow(r, hi);
                    const bool v0 = (kc >= cs) && (kc < cs + 16), v1 = (kc + 32 >= cs) && (kc + 32 < cs + 16);
                    p0[r] = v0 ? p0[r] + bt[v0 ? kc : qc] : -INFINITY; p1[r] = v1 ? p1[r] + bt[v1 ? kc + 32 : qc] : -INFINITY; }
            }
            const float rm = rowmax32(p0, p1);
            if (t == 0 || __any(rm > THR)) {
                const float dl = (t == 0) ? rm : fmaxf(rm, 0.f);
                mhat += dl;
#pragma unroll
                for (int r = 0; r < 16; ++r) { p0[r] -= dl; p1[r] -= dl; negm[r] = -mhat; }
                if (t > 0) { const float f = __builtin_amdgcn_exp2f(-dl); l *= f; if (hi == 0) wsf[r32] = f; LDS_WAIT();
#pragma unroll
                    for (int r = 0; r < 16; ++r) { const float fr_ = wsf[crow(r, hi)]; o0[r] *= fr_; o1[r] *= fr_; }
                    LDS_WAIT(); }
            }
            float ls = 0.f;
#pragma unroll
            for (int r = 0; r < 16; ++r) { p0[r] = __builtin_amdgcn_exp2f(p0[r]); p1[r] = __builtin_amdgcn_exp2f(p1[r]); ls += p0[r] + p1[r]; }
            l += ls;
            u32x4 pw[4];
#pragma unroll
            for (int k = 0; k < 4; ++k) { pw[0][k] = cvtpk(p0[2 * k], p0[2 * k + 1]); pw[1][k] = cvtpk(p0[8 + 2 * k], p0[9 + 2 * k]); pw[2][k] = cvtpk(p1[2 * k], p1[2 * k + 1]); pw[3][k] = cvtpk(p1[8 + 2 * k], p1[9 + 2 * k]); }
            const LAS unsigned char* vb = lds + L_V + slot * SLOTB + vp0;
#pragma unroll
            for (int ks = 0; ks < 4; ++ks) {
                const s16x4 a0 = vtr(vb + ks * 1024), a1 = vtr(vb + ks * 1024 + 512), c0 = vtr(vb + 4096 + ks * 1024), c1 = vtr(vb + 4096 + ks * 1024 + 512);
                const bf16x8 v0 = {a0[0], a0[1], a0[2], a0[3], a1[0], a1[1], a1[2], a1[3]}, v1 = {c0[0], c0[1], c0[2], c0[3], c1[0], c1[1], c1[2], c1[3]};
                o0 = __builtin_amdgcn_mfma_f32_32x32x16_bf16(__builtin_bit_cast(bf16x8, pw[ks]), v0, o0, 0, 0, 0);
                o1 = __builtin_amdgcn_mfma_f32_32x32x16_bf16(__builtin_bit_cast(bf16x8, pw[ks]), v1, o1, 0, 0, 0);
            }
        }
        ATT_WAIT_BAR();
    }
    l = halfsum(l);
    if (MODE == 1 || MODE == 3) l += __builtin_amdgcn_exp2f(sink2 - mhat);
    if (hi == 0) wsf[32 + r32] = l;
    LDS_WAIT();
    bf16_t* stg = (bf16_t*)(lds + L_OST + wid * 4096);
    LAS bf16_t* stgl = (LAS bf16_t*)(lds + L_OST + wid * 4096);
#pragma unroll
    for (int r = 0; r < 16; ++r) { const int orow = crow(r, hi); const float rl = __builtin_amdgcn_rcpf(wsf[32 + orow]);
        stgl[orow * 64 + r32] = (bf16_t)(cvtpk(o0[r] * rl, 0.f) & 0xffffu); stgl[orow * 64 + 32 + r32] = (bf16_t)(cvtpk(o1[r] * rl, 0.f) & 0xffffu); }
    LDS_WAIT();
    (void)stg;
#pragma unroll
    for (int i = 0; i < 4; ++i) { const int row = i * 8 + (lane >> 3), ch = lane & 7; const u32x4 v = *(const LAS u32x4*)(stgl + row * 64 + ch * 8);
        *(u32x4*)(Y + (size_t)(qrow0 + 32 * wid + row) * DM + ycol + ch * 8) = v; }
    LDS_WAIT();
#undef ATT_KROW
#undef ATT_DMA
}
}

namespace ml {
__device__ __forceinline__ float scan_add(float v, int lane, int dir) {
#pragma unroll
    for (int o = 1; o < 64; o <<= 1) { const float t = shfl_idx(v, (dir ? lane + o : lane - o) & 63); const bool ok = dir ? (lane + o < 64) : (lane >= o); v += ok ? t : 0.f; }
    return v;
}
__device__ __forceinline__ float scan_max(float v, int lane, int dir) {
#pragma unroll
    for (int o = 1; o < 64; o <<= 1) { const float t = shfl_idx(v, (dir ? lane + o : lane - o) & 63); const bool ok = dir ? (lane + o < 64) : (lane >= o); v = ok ? fmaxf(v, t) : v; }
    return v;
}
__device__ __forceinline__ float logsigmoid(float x) { return fminf(x, 0.f) - log1pf(__expf(-fabsf(x))); }
__device__ __forceinline__ int img_off(int tok, int d) { return (d >> 5) * 4096 + (tok >> 4) * 1024 + (tok & 15) * 64 + (d & 31) * 2; }
__device__ __forceinline__ int blk_row0(int b, int blk) { return blk < 4 ? NLAT + CTXL * b + 64 * blk : SEQ * b + 64 * (blk - 4); }
__device__ __forceinline__ int chunk_of(int dir, int blk) { return dir == 0 ? blk : (blk < 4 ? 3 - blk : 4 + 127 - (blk - 4)); }

__device__ __forceinline__ void pass1(Frame& F, int layer) {
    const int gw = F.bid * NWAVES + F.wave, NGW = F.G * NWAVES, lane = F.lane, r32 = lane & 31, hi = lane >> 5;
    LAS unsigned char* wl = F.lds + F.wave * 16384;
    const bf16_t* PROJ = (const bf16_t*)(F.ws + WS_PROJ); const float* GATES = (const float*)(F.ws + WS_GATES);
    const float* gb = F.ka->in[IN_CGB] + layer * 16;
    float* DS = (float*)(F.ws + WS_DS); float* ZD = (float*)(F.ws + WS_ZD); float* GC = (float*)(F.ws + WS_GC); float* ML = (float*)(F.ws + WS_ML);
    const int vp0 = ((lane >> 4) & 1) * 32 + (lane & 3) * 8 + (4 * hi + ((lane & 15) >> 2)) * 64;
    for (int wu = gw; wu < NCHAIN * NCHUNK; wu += NGW) {
        const int chain = wu / NCHUNK, c = wu % NCHUNK, dir = chain & 1, h = (chain >> 1) & 3, b = chain >> 3;
        const int row0 = blk_row0(b, chunk_of(dir, c));
        const float gi = GATES[(size_t)(row0 + lane) * 16 + dir * 8 + h] + gb[dir * 8 + h];
        const float lf = logsigmoid(GATES[(size_t)(row0 + lane) * 16 + dir * 8 + 4 + h] + gb[dir * 8 + 4 + h]);
        const float cum = scan_add(lf, lane, dir);
        const float G = wave_sum(lf, lane);
        const float bb = gi - cum, mloc = wave_max(bb, lane), w = __expf(bb - mloc);
#pragma unroll
        for (int it = 0; it < 8; ++it) { const int tok = (lane >> 3) + 8 * it, d = 8 * (lane & 7);
            const u32x4 kv = *(const u32x4*)(PROJ + (size_t)(row0 + tok) * PP + PC_CK + 64 * h + d), vv = *(const u32x4*)(PROJ + (size_t)(row0 + tok) * PP + PC_CV + 64 * h + d);
            const float wt = shfl_idx(w, tok);
            u32x4 ko; ko.x = cvtpk(bflo(kv.x) * wt, bfhi(kv.x) * wt); ko.y = cvtpk(bflo(kv.y) * wt, bfhi(kv.y) * wt); ko.z = cvtpk(bflo(kv.z) * wt, bfhi(kv.z) * wt); ko.w = cvtpk(bflo(kv.w) * wt, bfhi(kv.w) * wt);
            *(LAS u32x4*)(wl + img_off(tok, d)) = vv; *(LAS u32x4*)(wl + 8192 + img_off(tok, d)) = ko; }
        LDS_WAIT();
        f32x16 acc[2][2] = {};
#pragma unroll
        for (int s = 0; s < 4; ++s) {
            bf16x8 af[2], bfr[2];
#pragma unroll
            for (int x = 0; x < 2; ++x) { const s16x4 a0 = att::vtr(wl + vp0 + x * 4096 + s * 1024), a1 = att::vtr(wl + vp0 + x * 4096 + s * 1024 + 512);
                const s16x4 c0 = att::vtr(wl + 8192 + vp0 + x * 4096 + s * 1024), c1 = att::vtr(wl + 8192 + vp0 + x * 4096 + s * 1024 + 512);
                af[x] = (bf16x8){a0[0], a0[1], a0[2], a0[3], a1[0], a1[1], a1[2], a1[3]}; bfr[x] = (bf16x8){c0[0], c0[1], c0[2], c0[3], c1[0], c1[1], c1[2], c1[3]}; }
#pragma unroll
            for (int vb = 0; vb < 2; ++vb)
#pragma unroll
                for (int kb = 0; kb < 2; ++kb) acc[vb][kb] = __builtin_amdgcn_mfma_f32_32x32x16_bf16(af[vb], bfr[kb], acc[vb][kb], 0, 0, 0);
        }
        float* dsp = DS + (size_t)(chain * NCHUNK + c) * 4096;
#pragma unroll
        for (int vb = 0; vb < 2; ++vb)
#pragma unroll
            for (int kb = 0; kb < 2; ++kb)
#pragma unroll
                for (int r = 0; r < 16; ++r) dsp[(32 * vb + att::crow(r, hi)) * 64 + 32 * kb + r32] = acc[vb][kb][r];
        float z = 0.f;
#pragma unroll 8
        for (int tok = 0; tok < 64; ++tok) z += bf2f(*(const LAS bf16_t*)(wl + 8192 + img_off(tok, lane)));
        ZD[(size_t)(chain * NCHUNK + c) * 64 + lane] = z;
        if (lane == 0) { GC[chain * NCHUNK + c] = G; ML[chain * NCHUNK + c] = mloc; }
        LDS_WAIT();
    }
}

__device__ __forceinline__ void pass2(Frame& F) {
    const float* DS = (const float*)(F.ws + WS_DS); const float* ZD = (const float*)(F.ws + WS_ZD); const float* GC = (const float*)(F.ws + WS_GC); const float* ML = (const float*)(F.ws + WS_ML);
    bf16_t* SBF = (bf16_t*)(F.ws + WS_SBF); float* ZC = (float*)(F.ws + WS_ZC); float* MC = (float*)(F.ws + WS_MC);
    LAS float* cf = (LAS float*)F.lds;
    for (int it = F.bid; it < NCHAIN * 16; it += F.G) {
        const int chain = it >> 4, part = it & 15;
        __syncthreads();
        if (F.wave == 0) {
            const int ln = F.lane; const bool valid = ln < 44; float g[3], mlv[3];
#pragma unroll
            for (int j = 0; j < 3; ++j) { g[j] = valid ? GC[chain * NCHUNK + 3 * ln + j] : 0.f; mlv[j] = valid ? ML[chain * NCHUNK + 3 * ln + j] : -INFINITY; }
            const float tot = g[0] + g[1] + g[2]; const float excl = ml::scan_add(tot, ln, 0) - tot;
            const float pg[3] = {excl, excl + g[0], excl + g[0] + g[1]};
            const float a0 = mlv[0] - pg[0], a1 = mlv[1] - pg[1], a2 = mlv[2] - pg[2];
            const float inclm = ml::scan_max(fmaxf(a0, fmaxf(a1, a2)), ln, 0); float exclm = shfl_idx(inclm, (ln - 1) & 63); if (ln == 0) exclm = -INFINITY;
            const float em[3] = {exclm, fmaxf(exclm, a0), fmaxf(fmaxf(exclm, a0), a1)};
#pragma unroll
            for (int j = 0; j < 3; ++j) { const int c = 3 * ln + j; const float m = pg[j] + fmaxf(0.f, em[j]); const float mn = fmaxf(g[j] + m, g[j] + mlv[j]);
                if (valid) { cf[2 * c] = __expf(g[j] + m - mn); cf[2 * c + 1] = __expf(g[j] + mlv[j] - mn); if (part == 0) MC[chain * NCHUNK + c] = m; } }
        }
        __syncthreads();
        if (F.tid < 256) {
            const int e = part * 256 + F.tid; const float* dp = DS + (size_t)chain * NCHUNK * 4096 + e; bf16_t* sp = SBF + (size_t)chain * NCHUNK * 4096 + e;
            float s = 0.f;
            for (int c0 = 0; c0 < NCHUNK; c0 += 12) { float d[12];
#pragma unroll
                for (int j = 0; j < 12; ++j) d[j] = dp[(size_t)(c0 + j) * 4096];
#pragma unroll
                for (int j = 0; j < 12; ++j) { sp[(size_t)(c0 + j) * 4096] = (bf16_t)(cvtpk(s, 0.f) & 0xffffu); s = cf[2 * (c0 + j)] * s + cf[2 * (c0 + j) + 1] * d[j]; } }
        } else if (F.tid < 260) {
            const int e = part * 4 + (F.tid - 256); const float* dp = ZD + (size_t)chain * NCHUNK * 64 + e; float* zp = ZC + (size_t)chain * NCHUNK * 64 + e;
            float s = 0.f;
            for (int c = 0; c < NCHUNK; ++c) { const float d = dp[(size_t)c * 64]; zp[(size_t)c * 64] = s; s = cf[2 * c] * s + cf[2 * c + 1] * d; }
        }
    }
    __syncthreads();
}

__device__ __forceinline__ void pass3(Frame& F, int layer, int blk_lo) {
    const int gw = F.bid * NWAVES + F.wave, NGW = F.G * NWAVES, lane = F.lane, r32_ = lane & 31, hi_ = lane >> 5;
    LAS unsigned char* wl = F.lds + F.wave * 19456;
    LAS float* bvec = (LAS float*)(wl + 16384); LAS float* Apl = bvec + 128; LAS float* efl = bvec + 256; LAS float* fll = bvec + 384; LAS float* zl = bvec + 512; LAS float* rden = bvec + 640;
    LAS float* st = (LAS float*)(wl + 8192);
    const bf16_t* PROJ = (const bf16_t*)(F.ws + WS_PROJ); const float* GATES = (const float*)(F.ws + WS_GATES);
    const float* gb = F.ka->in[IN_CGB] + layer * 16;
    const bf16_t* SBF = (const bf16_t*)(F.ws + WS_SBF); const float* ZC = (const float*)(F.ws + WS_ZC); const float* MC = (const float*)(F.ws + WS_MC);
    bf16_t* Y = (bf16_t*)(F.ws + WS_H);
    const int vp0 = ((lane >> 4) & 1) * 32 + (lane & 3) * 8 + (4 * hi_ + ((lane & 15) >> 2)) * 64;
    const int nblk = NCHUNK - blk_lo;
    for (int wu = gw; wu < 8 * nblk; wu += NGW) {
        const int bh = wu / nblk, blk = blk_lo + wu % nblk, b = bh >> 2, h = bh & 3;
        const int row0 = blk_row0(b, blk);
        LDS_WAIT();
#pragma unroll
        for (int it = 0; it < 8; ++it) { const int tok = (lane >> 3) + 8 * it, d = 8 * (lane & 7);
            *(LAS u32x4*)(wl + img_off(tok, d)) = *(const u32x4*)(PROJ + (size_t)(row0 + tok) * PP + PC_CV + 64 * h + d); }
#pragma unroll
        for (int dir = 0; dir < 2; ++dir) {
            const int c = chunk_of(dir, blk), chain = (b * 4 + h) * 2 + dir;
            const float gi = GATES[(size_t)(row0 + lane) * 16 + dir * 8 + h] + gb[dir * 8 + h];
            const float lf = logsigmoid(GATES[(size_t)(row0 + lane) * 16 + dir * 8 + 4 + h] + gb[dir * 8 + 4 + h]);
            const float cum = scan_add(lf, lane, dir);
            const float bb = gi - cum, pm = scan_max(bb, lane, dir), mc = MC[chain * NCHUNK + c];
            const float Apv = fmaxf(mc, pm);
            zl[dir * 64 + lane] = ZC[(size_t)(chain * NCHUNK + c) * 64 + lane];
            bvec[dir * 64 + lane] = bb; Apl[dir * 64 + lane] = Apv; efl[dir * 64 + lane] = __expf(mc - Apv); fll[dir * 64 + lane] = __expf(-(cum + Apv));
        }
        LDS_WAIT();
#pragma unroll 1
        for (int tb = 0; tb < 2; ++tb) {
            int r32 = r32_, hi = hi_; asm volatile("" : "+v"(r32), "+v"(hi));
            const int t = 32 * tb + r32;
            bf16x8 qf[4];
#pragma unroll
            for (int d0 = 0; d0 < 4; ++d0) qf[d0] = *(const bf16x8*)(PROJ + (size_t)(row0 + t) * PP + PC_CQ + 64 * h + 16 * d0 + 8 * hi);
            f32x16 hs0 = {}, hs1 = {};
#pragma unroll 1
            for (int dir = 0; dir < 2; ++dir) {
                const int c = chunk_of(dir, blk), chain = (b * 4 + h) * 2 + dir;
                const bf16_t* Sp = SBF + (size_t)(chain * NCHUNK + c) * 4096; const LAS float* zp = zl + dir * 64;
                int r32 = r32_, hi = hi_; asm volatile("" : "+v"(r32), "+v"(hi));
                const float Ap_t = Apl[dir * 64 + t], e_t = efl[dir * 64 + t], fl_t = fll[dir * 64 + t];
                f32x16 P0 = {}, P1 = {};
#pragma unroll
                for (int d0 = 0; d0 < 4; ++d0) {
                    const bf16x8 k0 = *(const bf16x8*)(PROJ + (size_t)(row0 + r32) * PP + PC_CK + 64 * h + 16 * d0 + 8 * hi), k1 = *(const bf16x8*)(PROJ + (size_t)(row0 + 32 + r32) * PP + PC_CK + 64 * h + 16 * d0 + 8 * hi);
                    P0 = __builtin_amdgcn_mfma_f32_32x32x16_bf16(k0, qf[d0], P0, 0, 0, 0); P1 = __builtin_amdgcn_mfma_f32_32x32x16_bf16(k1, qf[d0], P1, 0, 0, 0); }
                float den = 0.f;
#pragma unroll
                for (int r = 0; r < 16; ++r) { const int s0 = att::crow(r, hi), s1 = 32 + s0; const bool ok0 = dir ? (s0 >= t) : (s0 <= t), ok1 = dir ? (s1 >= t) : (s1 <= t);
                    const float w0 = ok0 ? __expf(bvec[dir * 64 + s0] - Ap_t) : 0.f, w1 = ok1 ? __expf(bvec[dir * 64 + s1] - Ap_t) : 0.f;
                    P0[r] *= w0; P1[r] *= w1; den += P0[r] + P1[r]; }
                u32x4 pw[4];
#pragma unroll
                for (int k = 0; k < 4; ++k) { pw[0][k] = cvtpk(P0[2 * k], P0[2 * k + 1]); pw[1][k] = cvtpk(P0[8 + 2 * k], P0[9 + 2 * k]); pw[2][k] = cvtpk(P1[2 * k], P1[2 * k + 1]); pw[3][k] = cvtpk(P1[8 + 2 * k], P1[9 + 2 * k]); }

                f32x16 n0 = {}, n1 = {}; float zq = 0.f;
#pragma unroll
                for (int d0 = 0; d0 < 4; ++d0) { const u32x4 qw = __builtin_bit_cast(u32x4, qf[d0]); u32x4 o;
                    const f32x4 za = *(const LAS f32x4*)(zp + 16 * d0 + 8 * hi), zb = *(const LAS f32x4*)(zp + 16 * d0 + 8 * hi + 4);
                    const float q0 = bflo(qw.x), q1 = bfhi(qw.x), q2 = bflo(qw.y), q3 = bfhi(qw.y), q4 = bflo(qw.z), q5 = bfhi(qw.z), q6 = bflo(qw.w), q7 = bfhi(qw.w);
                    zq += (q0 * za[0] + q1 * za[1]) + (q2 * za[2] + q3 * za[3]) + (q4 * zb[0] + q5 * zb[1]) + (q6 * zb[2] + q7 * zb[3]);
                    o.x = cvtpk(q0 * e_t, q1 * e_t); o.y = cvtpk(q2 * e_t, q3 * e_t); o.z = cvtpk(q4 * e_t, q5 * e_t); o.w = cvtpk(q6 * e_t, q7 * e_t);
                    const bf16x8 qs = __builtin_bit_cast(bf16x8, o);
                    const bf16x8 s0 = *(const bf16x8*)(Sp + (size_t)r32 * 64 + 16 * d0 + 8 * hi), s1 = *(const bf16x8*)(Sp + (size_t)(32 + r32) * 64 + 16 * d0 + 8 * hi);
                    n0 = __builtin_amdgcn_mfma_f32_32x32x16_bf16(qs, s0, n0, 0, 0, 0); n1 = __builtin_amdgcn_mfma_f32_32x32x16_bf16(qs, s1, n1, 0, 0, 0); }

                den = att::halfsum(den) + e_t * att::halfsum(zq);
                const float rd = 1.f / fmaxf(fabsf(den), fl_t);
                LDS_WAIT(); if (hi == 0) rden[r32] = rd; LDS_WAIT();
#pragma unroll
                for (int ks = 0; ks < 4; ++ks) {
                    const s16x4 a0 = att::vtr(wl + vp0 + ks * 1024), a1 = att::vtr(wl + vp0 + ks * 1024 + 512), c0 = att::vtr(wl + vp0 + 4096 + ks * 1024), c1 = att::vtr(wl + vp0 + 4096 + ks * 1024 + 512);
                    const bf16x8 v0 = {a0[0], a0[1], a0[2], a0[3], a1[0], a1[1], a1[2], a1[3]}, v1 = {c0[0], c0[1], c0[2], c0[3], c1[0], c1[1], c1[2], c1[3]};
                    n0 = __builtin_amdgcn_mfma_f32_32x32x16_bf16(__builtin_bit_cast(bf16x8, pw[ks]), v0, n0, 0, 0, 0);
                    n1 = __builtin_amdgcn_mfma_f32_32x32x16_bf16(__builtin_bit_cast(bf16x8, pw[ks]), v1, n1, 0, 0, 0); }
#pragma unroll
                for (int r = 0; r < 16; ++r) { const float rr = rden[att::crow(r, hi)]; hs0[r] += n0[r] * rr; hs1[r] += n1[r] * rr; }
            }
            LDS_WAIT();
#pragma unroll
            for (int r = 0; r < 16; ++r) { st[att::crow(r, hi) * 64 + r32] = hs0[r]; st[att::crow(r, hi) * 64 + 32 + r32] = hs1[r]; }
            LDS_WAIT();
#pragma unroll
            for (int it = 0; it < 4; ++it) { const int tk = (lane >> 3) + 8 * it, d = 8 * (lane & 7);
                const u32x4 ow = *(const u32x4*)(PROJ + (size_t)(row0 + 32 * tb + tk) * PP + PC_CO + 64 * h + d);
                const f32x4 ha = *(const LAS f32x4*)(st + tk * 64 + d), hb = *(const LAS f32x4*)(st + tk * 64 + d + 4);
                const float og[8] = {bflo(ow.x), bfhi(ow.x), bflo(ow.y), bfhi(ow.y), bflo(ow.z), bfhi(ow.z), bflo(ow.w), bfhi(ow.w)};
                float yv[8];
#pragma unroll
                for (int j = 0; j < 8; ++j) yv[j] = (j < 4 ? ha[j] : hb[j - 4]) / (1.f + __expf(-og[j]));
                u32x4 w; w.x = cvtpk(yv[0], yv[1]); w.y = cvtpk(yv[2], yv[3]); w.z = cvtpk(yv[4], yv[5]); w.w = cvtpk(yv[6], yv[7]);
                *(u32x4*)(Y + (size_t)(row0 + 32 * tb + tk) * DM + 512 + 64 * h + d) = w; }
            LDS_WAIT();
        }
    }
}
}

constexpr int PH_PER_LAYER = 11, NPHASE = 2 + NLAYER * PH_PER_LAYER;

__device__ __forceinline__ void phase_ids(Frame& F) {
    int lane_;
    asm volatile("v_mbcnt_lo_u32_b32 %0, -1, 0\n\tv_mbcnt_hi_u32_b32 %0, -1, %0" : "=v"(lane_));
    F.lane = lane_; F.tid = F.wave * 64 + lane_;
}
__device__ __forceinline__ void run_phase(const Frame& F0, int ph) {
    Frame F = F0;
    unsigned char* ws = F.ws;
    bf16_t* H = (bf16_t*)(ws + WS_H); bf16_t* PROJ = (bf16_t*)(ws + WS_PROJ);
    float* XC = (float*)(ws + WS_XC);
    const float* MOD = (const float*)(ws + WS_MOD);
    const int vcu = (F0.G % 8 == 0) ? (F0.bid % 8) * (F0.G / 8) + F0.bid / 8 : F0.bid;
#ifdef ONLYK
    if (ONLYK == 100) { if (ph == 0) { phase_ids(F); p0_prologue(F); } return; }
    if (ONLYK == 101) { if (ph == NPHASE - 1) { phase_ids(F); final_phase(F); } return; }
    if (ph == 0 || ph == NPHASE - 1) return;
    const int l = (ph - 1) / PH_PER_LAYER, k = ONLYK;
    if ((ph - 1) % PH_PER_LAYER != ONLYK) return;
#else
    if (ph == 0) { phase_ids(F); p0_prologue(F); return; }
    if (ph == NPHASE - 1) { phase_ids(F); final_phase(F); return; }
    const int l = (ph - 1) / PH_PER_LAYER, k = (ph - 1) % PH_PER_LAYER;
#endif
    const int M = (l == 0) ? NROWS : NLAT;
    switch (k) {
    case 0: phase_ids(F); norm_phase(F, l, 0, NROWS); break;
    case 1: { phase_ids(F); pg8::Gemm g{H, (const bf16_t*)(ws + WS_WIN) + (size_t)l * PP * 1024, NROWS, PP, 1024}; pg8::StaticOrder S; S.init(NROWS, PP, F.G, F.bid);
              pg8::EpiProj E{PROJ, PP}; pg8::gemm_phase<pg8::EpiProj, pg8::StaticOrder, true, true>(F.lds, g, S, E, F.tid); } break;
    case 2: phase_ids(F); postproj_phase(F, l); ml::pass1(F, l); break;
    case 3: {
        phase_ids(F);
        ml::pass2(F);
        for (int u = vcu; u < 256; u += F.G) { const int b = u >> 7, h = (u >> 5) & 3, qb = u & 31;
            att::attn_unit<1>(F, b, h, qb, PC_BQ + 64 * h, PC_BK + 64 * (h >> 1), PC_BV + 64 * (h >> 1), 256 + 64 * h, F.ka->in[IN_SINK][l * 4 + h] * LOG2E, nullptr); }
        for (int u = vcu; u < 256; u += F.G) { const int b = u >> 7, h = (u >> 5) & 3, qb = u & 31;
            att::attn_unit<2>(F, b, h, qb, PC_DQ + 64 * h, PC_DK + 64 * h, PC_DV + 64 * h, 768 + 64 * h, 0.f, F.ka->in[IN_RPB] + (size_t)(l * 4 + h) * 465); }
        if (l == 0) for (int cu = vcu; cu < 24; cu += F.G) { const int mx = cu >> 3, b = (cu >> 2) & 1, h = cu & 3;
            const int qc = mx == 0 ? PC_AQ + 64 * h : (mx == 1 ? PC_BQ + 64 * h : PC_DQ + 64 * h);
            const int kc = mx == 0 ? PC_AK + 64 * (h >> 1) : (mx == 1 ? PC_BK + 64 * (h >> 1) : PC_DK + 64 * h);
            const int vc = mx == 0 ? PC_AV + 64 * (h >> 1) : (mx == 1 ? PC_BV + 64 * (h >> 1) : PC_DV + 64 * h);
            const int yc = (mx == 0 ? 0 : (mx == 1 ? 256 : 768)) + 64 * h;
            const float s2 = mx == 1 ? F.ka->in[IN_SINK][l * 4 + h] * LOG2E : -INFINITY;
            att::attn_unit<3>(F, b, h, 0, qc, kc, vc, yc, s2, nullptr); }
    } break;
    case 4: {
        phase_ids(F);
#ifndef NO_ATTN0
        for (int u = vcu; u < 256; u += F.G) { const int b = u >> 7, h = (u >> 5) & 3, qb = u & 31;
            att::attn_unit<0>(F, b, h, qb, PC_AQ + 64 * h, PC_AK + 64 * (h >> 1), PC_AV + 64 * (h >> 1), 64 * h, 0.f, nullptr); }
#endif
        __syncthreads();
#ifndef NO_PASS3
        ml::pass3(F, l, l == 0 ? 0 : 4);
#endif
    } break;
    case 5: phase_ids(F); groupnorm_phase(F, l, M); break;
    case 6: { phase_ids(F); pg8::Gemm g{H, (const bf16_t*)(ws + WS_WOUT) + (size_t)l * 1024 * 1024, M, 1024, 1024}; pg8::StaticOrder S; S.init(M, 1024, F.G, F.bid);
              pg8::EpiResid E{l == 0 ? F.ka->in[IN_X] : F.out, l == 0 ? F.ka->in[IN_CTX] : XC, F.out, XC, MOD + (size_t)l * 3 * 6144 + 2 * 1024};
              pg8::gemm_phase<pg8::EpiResid, pg8::StaticOrder, true, true>(F.lds, g, S, E, F.tid); } break;
    case 7: phase_ids(F); norm_phase(F, l, 1, M); break;
    case 8: { phase_ids(F); pg8::Gemm g{H, (const bf16_t*)(ws + WS_WUP) + (size_t)l * DFF2 * 1024, M, DFF2, 1024}; pg8::StaticOrder S; S.init(M, DFF2, F.G, F.bid);
              pg8::EpiUp E{PROJ, F.ka->in[IN_CONVW] + (size_t)l * 3 * DFF2, F.ka->in[IN_CONVB] + (size_t)l * DFF2, (float*)(ws + WS_DS)};
              pg8::gemm_phase<pg8::EpiUp, pg8::StaticOrder, true, true>(F.lds, g, S, E, F.tid); } break;
    case 9: phase_ids(F); fixup_phase(F, l, M / 128); break;
    case 10: { phase_ids(F); pg8::Gemm g{PROJ, (const bf16_t*)(ws + WS_WDN) + (size_t)l * 1024 * DFF, M, 1024, DFF}; pg8::StaticOrder S; S.init(M, 1024, F.G, F.bid);
              pg8::EpiResid E{F.out, XC, F.out, XC, MOD + (size_t)l * 3 * 6144 + 5 * 1024};
              pg8::gemm_phase<pg8::EpiResid, pg8::StaticOrder, true, true>(F.lds, g, S, E, F.tid); } break;
    default: break;
    }
}

__global__ void __launch_bounds__(NTHREADS, 2) fwd_kernel(Args args) {
    extern __shared__ __attribute__((aligned(16))) unsigned char lds_raw[];
    Frame F;
    F.lds = (LAS unsigned char*)lds_raw;
    const int wave0 = __builtin_amdgcn_readfirstlane((int)threadIdx.x >> 6);
    F.tid = 0; F.lane = 0; F.wave = wave0;
    F.G = gridDim.x; F.bid = blockIdx.x;
    F.ka = (const __attribute__((address_space(4))) Args*)__builtin_amdgcn_kernarg_segment_ptr();
    F.out = args.out; F.ws = args.ws;
    for (int ph = args.ph_lo; ph < args.ph_hi; ++ph) {
        {
            Frame P = F;
            int wave_ = wave0, bid_ = F.bid, g_ = F.G; unsigned char* ws_ = F.ws; float* out_ = F.out; const __attribute__((address_space(4))) Args* ka_ = F.ka;
            asm volatile("" : "+s"(wave_), "+s"(bid_), "+s"(g_), "+s"(ws_), "+s"(out_), "+s"(ka_));
            P.ka = ka_; P.lane = 0; P.wave = wave_; P.tid = 0; P.bid = bid_; P.G = g_; P.ws = ws_; P.out = out_;
            run_phase(P, ph);
        }
        if (ph + 1 < args.ph_hi) { cg::this_grid().sync(); }
    }
}

extern "C" void kernel_launch(void* const* d_in, const int* in_sizes, int n_in, void* d_out, int out_size, void* d_ws, size_t ws_size, hipStream_t stream) {
    static int grid = 0;
    if (grid == 0) {
        if (n_in != 21 || out_size != NLAT * DM || ws_size < WS_END) { fprintf(stderr, "kernel_launch: unexpected shapes (n_in %d out %d ws %zu)\n", n_in, out_size, ws_size); grid = -1; return; }
        int dev = 0, cus = 0, per_cu = 0;
        if (hipGetDevice(&dev) != hipSuccess || hipDeviceGetAttribute(&cus, hipDeviceAttributeMultiprocessorCount, dev) != hipSuccess) { grid = -1; return; }
        if (hipFuncSetAttribute((const void*)fwd_kernel, hipFuncAttributeMaxDynamicSharedMemorySize, LDS_BYTES) != hipSuccess) { fprintf(stderr, "kernel_launch: hipFuncSetAttribute failed\n"); grid = -1; return; }
        if (hipOccupancyMaxActiveBlocksPerMultiprocessor(&per_cu, (const void*)fwd_kernel, NTHREADS, LDS_BYTES) != hipSuccess || per_cu < 1) { fprintf(stderr, "kernel_launch: occupancy query says %d blocks per CU\n", per_cu); grid = -1; (void)hipGetLastError(); return; }
        grid = cus;
    }
    if (grid < 0) return;
    Args a{};
    for (int i = 0; i < 21; ++i) a.in[i] = (const float*)d_in[i];
    a.out = (float*)d_out; a.ws = (unsigned char*)d_ws;
#if MK_MULTI
    for (int ph = 0; ph < NPHASE; ++ph) { a.ph_lo = ph; a.ph_hi = ph + 1; hipLaunchKernelGGL(fwd_kernel, dim3(grid), dim3(NTHREADS), LDS_BYTES, stream, a); }
#else
    a.ph_lo = 0; a.ph_hi = NPHASE;
    void* kargs[] = {&a};
    hipError_t e = hipLaunchCooperativeKernel((void*)fwd_kernel, dim3(grid), dim3(NTHREADS), kargs, LDS_BYTES, stream);
    if (e != hipSuccess) fprintf(stderr, "kernel_launch: cooperative launch failed: %s (grid %d)\n", hipGetErrorString(e), grid);
#endif
}
```

```cpp
#include <hip/hip_runtime.h>
#include <hip/hip_cooperative_groups.h>
#include <cstdio>
#include <cstdint>
namespace cg = cooperative_groups;

#ifndef MK_MULTI
#define MK_MULTI 0
#endif

constexpr int DM = 1024, SEQ = 8192, NBATCH = 2, CTXL = 256, NLAT = NBATCH * SEQ, NROWS = NLAT + NBATCH * CTXL;
constexpr int PP = 2816;
constexpr int DFF = 2816, DFF2 = 5632, DIN = 2832, NLAYER = 2;
constexpr float EPS = 1e-6f;
constexpr float LOG2E = 1.4426950408889634f;
constexpr float QSCALE2 = 0.125f * LOG2E;
constexpr int PC_AQ = 0, PC_AK = 256, PC_AV = 384, PC_BQ = 512, PC_BK = 768, PC_BV = 896, PC_CQ = 1024, PC_CK = 1280, PC_CV = 1536, PC_CO = 1792, PC_DQ = 2048, PC_DK = 2304, PC_DV = 2560;
constexpr int NCHUNK = 132, NCHAIN = 16;

constexpr size_t MiB = 1u << 20;
constexpr size_t WS_CTL = 0, CTL_ZERO_BYTES = 1 * MiB;
constexpr size_t WS_MOD = 1 * MiB;
constexpr size_t WS_ROPE = 1 * MiB + 192 * 1024;
constexpr size_t WS_WG = 1 * MiB + 512 * 1024;
constexpr size_t WS_XC = 2 * MiB;
constexpr size_t WS_WIN = 4 * MiB;
constexpr size_t WS_WOUT = 15 * MiB;
constexpr size_t WS_WUP = 19 * MiB;
constexpr size_t WS_WDN = 41 * MiB;
constexpr size_t WS_H = 52 * MiB;
constexpr size_t WS_PROJ = 85 * MiB;
constexpr size_t WS_GATES = 176 * MiB;
constexpr size_t WS_DS = 178 * MiB;
constexpr size_t WS_SBF = 211 * MiB;
constexpr size_t WS_ZD = 228 * MiB;
constexpr size_t WS_ZC = WS_ZD + 1 * MiB;
constexpr size_t WS_GC = WS_ZC + 1 * MiB;
constexpr size_t WS_ML = WS_GC + 16384;
constexpr size_t WS_MC = WS_ML + 16384;
constexpr size_t WS_END = 232 * MiB;

#define LAS __attribute__((address_space(3)))
#define GAS __attribute__((address_space(1)))
typedef unsigned short bf16_t;
typedef short bf16x8 __attribute__((ext_vector_type(8)));
typedef short s16x4 __attribute__((ext_vector_type(4)));
typedef float f32x4 __attribute__((ext_vector_type(4)));
typedef float f32x16 __attribute__((ext_vector_type(16)));
typedef float f32x2 __attribute__((ext_vector_type(2)));
typedef unsigned u32x4 __attribute__((ext_vector_type(4)));
typedef unsigned u32x2 __attribute__((ext_vector_type(2)));
typedef __bf16 bf16x2_t __attribute__((ext_vector_type(2)));
typedef short v4i16_t __attribute__((ext_vector_type(4)));

__device__ __forceinline__ unsigned cvtpk(float lo, float hi) { f32x2 v = {lo, hi}; bf16x2_t b = __builtin_convertvector(v, bf16x2_t); return __builtin_bit_cast(unsigned, b); }
__device__ __forceinline__ float bf2f(unsigned short b) { return __uint_as_float((unsigned)b << 16); }
__device__ __forceinline__ float bflo(unsigned w) { return __uint_as_float(w << 16); }
__device__ __forceinline__ float bfhi(unsigned w) { return __uint_as_float(w & 0xffff0000u); }
__device__ __forceinline__ float shfl_idx(float v, int src) { return __int_as_float(__builtin_amdgcn_ds_bpermute(src << 2, __float_as_int(v))); }
__device__ __forceinline__ float shfl_x(float v, int o, int lane) { return shfl_idx(v, lane ^ o); }
__device__ __forceinline__ float wave_sum(float v, int lane) {
#pragma unroll
    for (int o = 1; o < 64; o <<= 1) v += shfl_x(v, o, lane);
    return v;
}
__device__ __forceinline__ float wave_max(float v, int lane) {
#pragma unroll
    for (int o = 1; o < 64; o <<= 1) v = fmaxf(v, shfl_x(v, o, lane));
    return v;
}
#define LDS_WAIT() asm volatile("s_waitcnt lgkmcnt(0)" ::: "memory")
#define VM_WAIT() asm volatile("s_waitcnt vmcnt(0)" ::: "memory")

namespace pg8 {
#define PG8_LAS __attribute__((address_space(3)))
constexpr int BM = 256, BK = 64, HALF = 128, HTB = HALF * BK * 2  , STAGE_BYTES = 8 * HTB, NXCD = 8, WGM = 8;
__host__ __device__ __forceinline__ int lds_byte(int r, int c) { const int st = (r >> 4) * 2 + (c >> 5), rr = r & 15, cc = c & 31, ob = rr * 64 + cc * 2; return st * 1024 + (ob ^ (((ob >> 9) & 1) << 5)); }
__host__ __device__ __forceinline__ void stage_rc(int b, int& R, int& C) { const int st = b / 1024, sb = b % 1024, swz = sb ^ (((sb >> 9) & 1) << 5); R = (st >> 1) * 16 + swz / 64; C = (st & 1) * 32 + (swz % 64) / 2; }
__host__ __device__ __forceinline__ int perm32(int rho) { const int n = rho >> 4, i = rho & 15; return 8 * (i >> 2) + 4 * n + (i & 3); }

struct Unit { int pm, pn; };
struct Gemm { const bf16_t* A; const bf16_t* Bt; int M, N, K; };

struct StaticOrder {
    int nM, nN, nwg, G, c;
    __host__ __device__ void init(int M, int N, int G_, int c_) { nM = M / BM; nN = N / BM; nwg = nM * nN; G = G_; c = c_; }
    __host__ __device__ bool next(int i, Unit& u) const {
        const long L = (long)i * G + c; if (L >= nwg) return false;
        int wgid = (int)L; { const int q = nwg / NXCD, r = nwg % NXCD, xcd = wgid % NXCD, off = wgid / NXCD; wgid = (xcd < r ? xcd * (q + 1) : r * (q + 1) + (xcd - r) * q) + off; }
        const int nig = WGM * nN, gid = wgid / nig, fm = gid * WGM, gsz = (nM - fm) < WGM ? (nM - fm) : WGM;
        u.pm = fm + ((wgid % nig) % gsz); u.pn = (wgid % nig) / gsz; return true;
    }
    __device__ __forceinline__ void a_ready(const Unit&) const {}
    __device__ __forceinline__ void done(const Unit&) const {}
};

struct EpiProj {
    static constexpr bool PERM = true, AFTER_DRAIN = false, ROWPERM = false;
    bf16_t* O; int ldc;
    __device__ __forceinline__ void operator()(const f32x4 (&acc)[2][2][4][2], const Unit& u, int wr, int wc, int fr, int fq) const {
        const int row0 = u.pm * BM + wr * 64 + fr, col0 = u.pn * BM + wc * 32 + 8 * fq;
        const float sc = (u.pn == 2 || u.pn == 8) ? QSCALE2 : (u.pn == 4 ? 0.125f : 1.f);
#pragma unroll
        for (int ai = 0; ai < 2; ++ai)
#pragma unroll
            for (int m = 0; m < 4; ++m) { bf16_t* rowp = O + (size_t)(row0 + ai * HALF + m * 16) * ldc + col0;
#pragma unroll
                for (int bj = 0; bj < 2; ++bj) { const f32x4 v0 = acc[ai][bj][m][0] * sc, v1 = acc[ai][bj][m][1] * sc;
                    u32x4 w; w.x = cvtpk(v0[0], v0[1]); w.y = cvtpk(v0[2], v0[3]); w.z = cvtpk(v1[0], v1[1]); w.w = cvtpk(v1[2], v1[3]);
                    *(u32x4*)(rowp + bj * HALF) = w; } }
    }
};
struct EpiResid {
    static constexpr bool PERM = true, AFTER_DRAIN = false, ROWPERM = false;
    const float* xin_lat; const float* xin_ctx; float* xout_lat; float* xout_ctx; const float* gate;
    __device__ __forceinline__ void operator()(const f32x4 (&acc)[2][2][4][2], const Unit& u, int wr, int wc, int fr, int fq) const {
        const int id = u.pm < 32 ? 0 : (u.pm < 64 ? 1 : 2);
        const float* xin = u.pm < 64 ? xin_lat + (size_t)u.pm * BM * DM : xin_ctx + (size_t)(u.pm - 64) * BM * DM;
        float* xout = u.pm < 64 ? xout_lat + (size_t)u.pm * BM * DM : xout_ctx + (size_t)(u.pm - 64) * BM * DM;
        const int rl = wr * 64 + fr, col0 = u.pn * BM + wc * 32 + 8 * fq;
        f32x4 g[2][2];
#pragma unroll
        for (int bj = 0; bj < 2; ++bj)
#pragma unroll
            for (int n = 0; n < 2; ++n) g[bj][n] = *(const f32x4*)(gate + id * 6144 + col0 + bj * HALF + 4 * n);
#pragma unroll
        for (int ai = 0; ai < 2; ++ai)
#pragma unroll
            for (int m = 0; m < 4; ++m) { const size_t off = (size_t)(rl + ai * HALF + m * 16) * DM + col0;
#pragma unroll
                for (int bj = 0; bj < 2; ++bj)
#pragma unroll
                    for (int n = 0; n < 2; ++n) { const f32x4 xv = *(const f32x4*)(xin + off + bj * HALF + 4 * n);
                        *(f32x4*)(xout + off + bj * HALF + 4 * n) = xv + g[bj][n] * acc[ai][bj][m][n]; } }
    }
};
struct EpiUp {
    static constexpr bool PERM = true, AFTER_DRAIN = false, ROWPERM = true;
    bf16_t* act; const float* convw; const float* convb; float* edge;
    __device__ __forceinline__ void operator()(f32x4 (&acc)[2][2][4][2], const Unit& u, int wr, int wc, int fr, int fq) const {
        const int chb = u.pn * 128 + wc * 32 + 8 * fq;
        const int ht = 2 * u.pm + wr;
        const int lm1 = (fq * 16 + fr - 1) & 63, lp1 = (fq * 16 + fr + 1) & 63;
#pragma unroll
        for (int bj = 0; bj < 2; ++bj)
#pragma unroll
            for (int n = 0; n < 2; ++n) {
                const int uc = bj * DFF + chb + 4 * n;
                if (fr == 0) { *(f32x4*)(edge + ((size_t)ht * 4 + 0) * DFF2 + uc) = acc[0][bj][0][n]; *(f32x4*)(edge + ((size_t)ht * 4 + 1) * DFF2 + uc) = acc[0][bj][1][n]; }
                if (fr == 15) { *(f32x4*)(edge + ((size_t)ht * 4 + 2) * DFF2 + uc) = acc[1][bj][2][n]; *(f32x4*)(edge + ((size_t)ht * 4 + 3) * DFF2 + uc) = acc[1][bj][3][n]; }
#pragma unroll
                for (int j = 0; j < 4; ++j) {
                    const float w0 = convw[uc + j], w1 = convw[DFF2 + uc + j], w2 = convw[2 * DFF2 + uc + j], bb = convb[uc + j];
                    float pv = shfl_idx(acc[1][bj][3][n][j], lm1); const float nx = shfl_idx(acc[0][bj][0][n][j], lp1);
#pragma unroll
                    for (int sl = 0; sl < 8; ++sl) { const float cur = acc[sl >> 2][bj][sl & 3][n][j]; const float nxt = sl < 7 ? acc[(sl + 1) >> 2][bj][(sl + 1) & 3][n][j] : nx;
                        acc[sl >> 2][bj][sl & 3][n][j] = w0 * pv + w1 * cur + w2 * nxt + bb; pv = cur; }
                }
            }
        bf16_t* base = act + (size_t)(u.pm * BM + (wr * 16 + fr) * 8) * DFF + chb;
#pragma unroll
        for (int sl = 0; sl < 8; ++sl) {
            const f32x4 g0 = acc[sl >> 2][0][sl & 3][0], g1 = acc[sl >> 2][0][sl & 3][1], v0 = acc[sl >> 2][1][sl & 3][0], v1 = acc[sl >> 2][1][sl & 3][1];
            f32x4 o0, o1;
#pragma unroll
            for (int j = 0; j < 4; ++j) { o0[j] = g0[j] * __builtin_amdgcn_rcpf(1.f + __builtin_amdgcn_exp2f(-LOG2E * g0[j])) * v0[j]; o1[j] = g1[j] * __builtin_amdgcn_rcpf(1.f + __builtin_amdgcn_exp2f(-LOG2E * g1[j])) * v1[j]; }
            u32x4 w; w.x = cvtpk(o0[0], o0[1]); w.y = cvtpk(o0[2], o0[3]); w.z = cvtpk(o1[0], o1[1]); w.w = cvtpk(o1[2], o1[3]);
            const bool skip = (fr == 0 && sl == 0) || (fr == 15 && sl == 7);
            if (!skip) *(u32x4*)(base + (size_t)sl * DFF) = w;
        }
    }
};
template <class Epi, class Sched, bool ALIGN_EPI = false, bool SP2 = false>
__device__ __forceinline__ void gemm_phase(PG8_LAS unsigned char* lds, const Gemm g, const Sched& S, const Epi& E, const int tid) {
    const int wid = __builtin_amdgcn_readfirstlane(tid >> 6), lane = tid & 63, wr = wid >> 2, wc = wid & 3, fr = lane & 15, fq = lane >> 4;
    const int K = g.K, nt = K / BK;
    unsigned voffA[2], voffB[2];
#pragma unroll
    for (int i = 0; i < 2; ++i) { int R, C; stage_rc(tid * 16 + i * 8192, R, C); const int Rb = Epi::PERM ? ((R & ~31) + perm32(R & 31)) : R;
        const int Ra = Epi::ROWPERM ? (((((R >> 6) & 1) * 16 + (R & 15)) << 3) + ((R >> 4) & 3)) : R;
        voffA[i] = (unsigned)(Ra * K + C) * 2u; voffB[i] = (unsigned)(Rb * K + C) * 2u; }
    const size_t kstep = (size_t)(BK * 2);
    const size_t hstep = (size_t)HALF * K * 2;
    const size_t hstepA = Epi::ROWPERM ? (size_t)4 * K * 2 : hstep;
    const size_t tstep = 2 * hstep;
    const unsigned ldsw = (unsigned)wid * 1024u;
    const int aoff = lds_byte(wr * 64 + fr, fq * 8), boff = lds_byte(wc * 32 + fr, fq * 8);
#define PG8_SA(b, h) (((b) * 2 + (h)) * HTB)
#define PG8_SB(b, h) ((4 + (b) * 2 + (h)) * HTB)
#define PG8_STAGE(bufoff, gbase, voff) do { _Pragma("unroll") for (int _i = 0; _i < 2; ++_i) \
        __builtin_amdgcn_global_load_lds((const unsigned*)((const char*)(gbase) + (voff)[_i]), (PG8_LAS unsigned*)(lds + (bufoff) + ldsw + _i * 8192), 16, 0, 0); } while (0)
#define PG8_LDA(dst, b, h) do { _Pragma("unroll") for (int m = 0; m < 4; ++m) _Pragma("unroll") for (int k = 0; k < 2; ++k) dst[m][k] = *(const PG8_LAS bf16x8*)(lds + PG8_SA(b, h) + aoff + m * 2048 + k * 1024); } while (0)
#define PG8_LDB(dst, b, h) do { _Pragma("unroll") for (int n = 0; n < 2; ++n) _Pragma("unroll") for (int k = 0; k < 2; ++k) dst[n][k] = *(const PG8_LAS bf16x8*)(lds + PG8_SB(b, h) + boff + n * 2048 + k * 1024); } while (0)
#define PG8_MMA(ai, bj, At, Bt) do { __builtin_amdgcn_s_setprio(1); _Pragma("unroll") for (int m = 0; m < 4; ++m) _Pragma("unroll") for (int n = 0; n < 2; ++n) _Pragma("unroll") for (int k = 0; k < 2; ++k) \
        acc[ai][bj][m][n] = __builtin_amdgcn_mfma_f32_16x16x32_bf16(Bt[n][k], At[m][k], acc[ai][bj][m][n], 0, 0, 0); __builtin_amdgcn_s_setprio(0); } while (0)
#define PG8_WAIT_V(n) asm volatile("s_waitcnt vmcnt(" #n ")" ::: "memory")
#define PG8_WAIT_L(n) asm volatile("s_waitcnt lgkmcnt(" #n ")" ::: "memory")
#define PG8_BAR __builtin_amdgcn_s_barrier()
#define PG8_SCHED __builtin_amdgcn_sched_barrier(0)
    Unit cur, nxt; int ui = 0;
    if (!S.next(0, cur)) return;
    f32x4 acc[2][2][4][2];
#pragma unroll
    for (int a = 0; a < 2; ++a)
#pragma unroll
        for (int b = 0; b < 2; ++b)
#pragma unroll
            for (int m = 0; m < 4; ++m)
#pragma unroll
                for (int n = 0; n < 2; ++n) acc[a][b][m][n] = (f32x4){0.f, 0.f, 0.f, 0.f};
    bf16x8 At[4][2], B0[2][2], B1[2][2];
    const char* cA = (const char*)g.A + (size_t)cur.pm * tstep; const char* cB = (const char*)g.Bt + (size_t)cur.pn * tstep;
    S.a_ready(cur);
    if constexpr (SP2) {
        PG8_STAGE(PG8_SB(0, 0), cB, voffB); PG8_STAGE(PG8_SB(0, 1), cB + hstep, voffB); PG8_STAGE(PG8_SA(0, 0), cA, voffA); PG8_STAGE(PG8_SA(0, 1), cA + hstepA, voffA);
        if (wr == 1) PG8_BAR;
        PG8_WAIT_V(2); PG8_BAR;
        PG8_STAGE(PG8_SB(1, 0), cB + kstep, voffB); PG8_STAGE(PG8_SA(1, 0), cA + kstep, voffA); PG8_STAGE(PG8_SB(1, 1), cB + hstep + kstep, voffB);
        PG8_WAIT_V(6); PG8_BAR;
    } else {
        PG8_STAGE(PG8_SB(0, 0), cB, voffB); PG8_STAGE(PG8_SA(0, 0), cA, voffA); PG8_STAGE(PG8_SB(0, 1), cB + hstep, voffB); PG8_STAGE(PG8_SA(0, 1), cA + hstepA, voffA);
        if (wr == 1) PG8_BAR;
        PG8_WAIT_V(4); PG8_BAR;
        PG8_STAGE(PG8_SB(1, 0), cB + kstep, voffB); PG8_STAGE(PG8_SA(1, 0), cA + kstep, voffA); PG8_STAGE(PG8_SB(1, 1), cB + hstep + kstep, voffB);
        PG8_WAIT_V(6); PG8_BAR;
    }
    for (;;) {
        const bool has_next = S.next(ui + 1, nxt);
        const char* nA = has_next ? (const char*)g.A + (size_t)nxt.pm * tstep : cA; const char* nB = has_next ? (const char*)g.Bt + (size_t)nxt.pn * tstep : cB;
        for (int t = 0; t < nt; t += 2) {
            const bool last = (t == nt - 2);
            const char* a1 = cA + (size_t)(t + 1) * kstep;
            const char* a2 = last ? nA : cA + (size_t)(t + 2) * kstep; const char* b2 = last ? nB : cB + (size_t)(t + 2) * kstep;
            const char* a3 = a2 + kstep; const char* b3 = b2 + kstep;
            if (last && has_next) S.a_ready(nxt);
            if constexpr (SP2) {
            PG8_LDB(B0, 0, 0); PG8_LDB(B1, 0, 1); PG8_SCHED; PG8_LDA(At, 0, 0); PG8_STAGE(PG8_SA(1, 1), a1 + hstepA, voffA);
            PG8_WAIT_V(8); PG8_WAIT_L(0); PG8_BAR; PG8_MMA(0, 0, At, B0); PG8_MMA(0, 1, At, B1); PG8_BAR; PG8_SCHED;
            PG8_LDA(At, 0, 1); PG8_STAGE(PG8_SB(0, 0), b2, voffB); PG8_STAGE(PG8_SB(0, 1), b2 + hstep, voffB); PG8_STAGE(PG8_SA(0, 0), a2, voffA);
            PG8_WAIT_V(8); PG8_WAIT_L(0); PG8_BAR; PG8_MMA(1, 0, At, B0); PG8_MMA(1, 1, At, B1); PG8_BAR; PG8_SCHED;
            PG8_LDB(B0, 1, 0); PG8_LDB(B1, 1, 1); PG8_SCHED; PG8_LDA(At, 1, 0); PG8_STAGE(PG8_SA(0, 1), a2 + hstepA, voffA);
            PG8_WAIT_V(8); PG8_WAIT_L(0); PG8_BAR; PG8_MMA(0, 0, At, B0); PG8_MMA(0, 1, At, B1); PG8_BAR; PG8_SCHED;
            PG8_LDA(At, 1, 1); PG8_STAGE(PG8_SB(1, 0), b3, voffB); PG8_STAGE(PG8_SB(1, 1), b3 + hstep, voffB); PG8_STAGE(PG8_SA(1, 0), a3, voffA);
            PG8_WAIT_V(8); PG8_WAIT_L(0); PG8_BAR; PG8_MMA(1, 0, At, B0); PG8_MMA(1, 1, At, B1); PG8_BAR; PG8_SCHED;
            } else {
            PG8_LDB(B0, 0, 0); PG8_SCHED; PG8_LDA(At, 0, 0); PG8_STAGE(PG8_SA(1, 1), a1 + hstepA, voffA);
            PG8_WAIT_L(8); PG8_BAR; PG8_WAIT_L(0); PG8_MMA(0, 0, At, B0); PG8_BAR; PG8_SCHED;
            PG8_LDB(B1, 0, 1); PG8_STAGE(PG8_SB(0, 0), b2, voffB);
            PG8_BAR; PG8_WAIT_L(0); PG8_MMA(0, 1, At, B1); PG8_BAR;
            PG8_LDA(At, 0, 1); PG8_STAGE(PG8_SA(0, 0), a2, voffA);
            PG8_BAR; PG8_WAIT_L(0); PG8_MMA(1, 0, At, B0); PG8_BAR; PG8_SCHED;
            PG8_STAGE(PG8_SB(0, 1), b2 + hstep, voffB);
            PG8_WAIT_V(6); PG8_BAR; PG8_MMA(1, 1, At, B1); PG8_BAR;
            PG8_LDB(B0, 1, 0); PG8_SCHED; PG8_LDA(At, 1, 0); PG8_STAGE(PG8_SA(0, 1), a2 + hstepA, voffA);
            PG8_WAIT_L(8); PG8_BAR; PG8_WAIT_L(0); PG8_MMA(0, 0, At, B0); PG8_BAR; PG8_SCHED;
            PG8_LDB(B1, 1, 1); PG8_STAGE(PG8_SB(1, 0), b3, voffB);
            PG8_BAR; PG8_WAIT_L(0); PG8_MMA(0, 1, At, B1); PG8_BAR;
            PG8_LDA(At, 1, 1); PG8_STAGE(PG8_SA(1, 0), a3, voffA);
            PG8_BAR; PG8_WAIT_L(0); PG8_MMA(1, 0, At, B0); PG8_BAR; PG8_SCHED;
            PG8_STAGE(PG8_SB(1, 1), b3 + hstep, voffB);
            PG8_WAIT_V(6); PG8_BAR; PG8_MMA(1, 1, At, B1); PG8_BAR;
            }
        }
        if constexpr (ALIGN_EPI) { if (wr == 0) PG8_BAR; }
        if constexpr (!Epi::AFTER_DRAIN) { E(acc, cur, wr, wc, fr, fq); S.done(cur); }
        if (!has_next) break;
#pragma unroll
        for (int a = 0; a < 2; ++a)
#pragma unroll
            for (int b = 0; b < 2; ++b)
#pragma unroll
                for (int m = 0; m < 4; ++m)
#pragma unroll
                    for (int n = 0; n < 2; ++n) acc[a][b][m][n] = (f32x4){0.f, 0.f, 0.f, 0.f};
        cur = nxt; cA = nA; cB = nB; ++ui;
        if constexpr (ALIGN_EPI) { if (wr == 1) PG8_BAR; }
    }
    PG8_WAIT_V(0);
    if constexpr (!ALIGN_EPI) { if (wr == 0) PG8_BAR; }
    PG8_BAR;
    if constexpr (Epi::AFTER_DRAIN) { E.fused(acc, cur, wr, wc, fr, fq, lds, wid, lane); S.done(cur); }
#undef PG8_SA
#undef PG8_SB
#undef PG8_STAGE
#undef PG8_LDA
#undef PG8_LDB
#undef PG8_MMA
#undef PG8_WAIT_V
#undef PG8_WAIT_L
#undef PG8_BAR
#undef PG8_SCHED
}
}

constexpr int NWAVES = 8, NTHREADS = 512;
constexpr int LDSCTL_OFF = 155648;
constexpr int LDS_BYTES = LDSCTL_OFF + 256;
struct Args {
    const float* in[21]; float* out; unsigned char* ws; int ph_lo, ph_hi;
};
struct Frame {
    LAS unsigned char* lds;
    int tid, lane, wave, G, bid;
    const __attribute__((address_space(4))) Args* ka;
    float* out; unsigned char* ws;
};
enum { IN_X = 0, IN_C, IN_CTX, IN_CCTX, IN_WMOD, IN_BMOD, IN_G1, IN_G2, IN_WIN, IN_AQG, IN_AKG, IN_SINK, IN_CGB, IN_RPB, IN_GGRP, IN_WOUT, IN_WUP, IN_CONVW, IN_CONVB, IN_WDN, IN_GFIN };

template <class MapFn>
__device__ __forceinline__ void transpose_item(const float* W, int K, int N, bf16_t* WT, LAS float* scr, int item, int lane, MapFn map) {
    const int nblk = (N + 31) / 32, kb = item / nblk, nb = item % nblk, k0 = 64 * kb, n0 = 32 * nb;
    const int col = n0 + (lane & 31);
#pragma unroll 8
    for (int i = 0; i < 32; ++i) { const int kk = 2 * i + (lane >> 5); scr[kk * 33 + (lane & 31)] = col < N ? W[(size_t)(k0 + kk) * N + col] : 0.f; }
    LDS_WAIT(); asm volatile("" ::: "memory");
    const int c = lane & 7;
#pragma unroll
    for (int j = 0; j < 4; ++j) { const int n = (lane >> 3) + 8 * j; const LAS float* s = scr + (8 * c) * 33 + n;
        u32x4 o; o.x = cvtpk(s[0 * 33], s[1 * 33]); o.y = cvtpk(s[2 * 33], s[3 * 33]); o.z = cvtpk(s[4 * 33], s[5 * 33]); o.w = cvtpk(s[6 * 33], s[7 * 33]);
        const int sc = n0 + n; const int dr = sc < N ? map(sc) : -1;
        if (dr >= 0) *(u32x4*)(WT + (size_t)dr * K + k0 + 8 * c) = o; }
    LDS_WAIT(); asm volatile("" ::: "memory");
}
__device__ __forceinline__ void p0_prologue(Frame& F) {
    const float* c = F.ka->in[IN_C]; const float* cctx = F.ka->in[IN_CCTX];
    {
        LAS float* sv = (LAS float*)F.lds;
        LAS float* red = (LAS float*)(F.lds + 12288);
        for (int i = F.tid; i < 3 * 1024; i += NTHREADS) { const int id = i >> 10, k = i & 1023; const float v = id < 2 ? c[id * 1024 + k] : cctx[k]; sv[i] = v / (1.f + __expf(-v)); }
        __syncthreads();
        float* MOD = (float*)(F.ws + WS_MOD);
        for (int it = F.bid; it < NLAYER * 96; it += F.G) {
            const int l = it / 96, nb = it % 96, n = nb * 64 + F.lane;
            const float* w = F.ka->in[IN_WMOD] + ((size_t)l * 1024 + F.wave * 128) * 6144 + n;
            float a0 = 0.f, a1 = 0.f, a2 = 0.f;
#pragma unroll 16
            for (int k = 0; k < 128; ++k) { const float wv = w[(size_t)k * 6144]; const int kk = F.wave * 128 + k; a0 += sv[kk] * wv; a1 += sv[1024 + kk] * wv; a2 += sv[2048 + kk] * wv; }
            red[(F.wave * 3 + 0) * 64 + F.lane] = a0; red[(F.wave * 3 + 1) * 64 + F.lane] = a1; red[(F.wave * 3 + 2) * 64 + F.lane] = a2;
            __syncthreads();
            if (F.tid < 192) { const int id = F.tid >> 6, ln = F.tid & 63; float s = F.ka->in[IN_BMOD][l * 6144 + nb * 64 + ln];
#pragma unroll
                for (int w8 = 0; w8 < 8; ++w8) s += red[(w8 * 3 + id) * 64 + ln];
                MOD[((size_t)l * 3 + id) * 6144 + nb * 64 + ln] = s; }
            __syncthreads();
        }
    }
    __syncthreads();
    const int gw = F.bid * NWAVES + F.wave, NGW = F.G * NWAVES, gt = F.bid * NTHREADS + F.tid, NGT = F.G * NTHREADS;
    { float* ROPE = (float*)(F.ws + WS_ROPE);
      for (int e = gt; e < 192 * 16; e += NGT) { const int idx = e >> 4, i = e & 15; const float pos = (float)(idx < 128 ? idx : idx - 128);
          const float freq = powf(10000.0f, -(float)i / 16.0f); const float ang = pos * freq; ROPE[2 * e] = cosf(ang); ROPE[2 * e + 1] = sinf(ang); } }
    { float* WG = (float*)(F.ws + WS_WG);
      for (int e = gt; e < NLAYER * 16 * 1024; e += NGT) { const int l = e >> 14, o = (e >> 10) & 15, k = e & 1023; WG[e] = F.ka->in[IN_WIN][((size_t)l * 1024 + k) * DIN + 2048 + o]; } }
    LAS float* scr = (LAS float*)(F.lds + F.wave * 16384);
    constexpr int I_IN = 16 * 89, I_OUT = 16 * 32, I_UP = 16 * 176, I_DN = 44 * 32, I_L = I_IN + I_OUT + I_UP + I_DN;
    for (int it = gw; it < NLAYER * I_L; it += NGW) {
        const int l = it / I_L; int r = it % I_L;
        if (r < I_IN) { transpose_item(F.ka->in[IN_WIN] + (size_t)l * 1024 * DIN, 1024, DIN, (bf16_t*)(F.ws + WS_WIN) + (size_t)l * PP * 1024, scr, r, F.lane,
                                       [](int n) { return n < 2048 ? n : (n < 2064 ? -1 : n - 16); }); continue; } r -= I_IN;
        if (r < I_OUT) { transpose_item(F.ka->in[IN_WOUT] + (size_t)l * 1024 * 1024, 1024, 1024, (bf16_t*)(F.ws + WS_WOUT) + (size_t)l * 1024 * 1024, scr, r, F.lane, [](int n) { return n; }); continue; } r -= I_OUT;
        if (r < I_UP) { transpose_item(F.ka->in[IN_WUP] + (size_t)l * 1024 * DFF2, 1024, DFF2, (bf16_t*)(F.ws + WS_WUP) + (size_t)l * DFF2 * 1024, scr, r, F.lane,
                                       [](int n) { const int m = n < DFF ? n : n - DFF; return (m >> 7) * 256 + (n < DFF ? 0 : 128) + (m & 127); }); continue; } r -= I_UP;
        transpose_item(F.ka->in[IN_WDN] + (size_t)l * DFF * 1024, DFF, 1024, (bf16_t*)(F.ws + WS_WDN) + (size_t)l * 1024 * DFF, scr, r, F.lane, [](int n) { return n; });
    }
}

__device__ __forceinline__ void norm_phase(Frame& F, int layer, int which, int nrows) {
    const int gw = F.bid * NWAVES + F.wave, NGW = F.G * NWAVES;
    const float* gvec = F.ka->in[which ? IN_G2 : IN_G1] + layer * 1024;
    const float* mod = (const float*)(F.ws + WS_MOD) + (size_t)layer * 3 * 6144 + (which ? 3 * 1024 : 0);
    const bool first = (layer == 0 && which == 0);
    const float* xl = first ? F.ka->in[IN_X] : F.out; const float* xc = first ? F.ka->in[IN_CTX] : (const float*)(F.ws + WS_XC);
    bf16_t* H = (bf16_t*)(F.ws + WS_H);
    const float* WG = (const float*)(F.ws + WS_WG) + (size_t)layer * 16 * 1024;
    float* GATES = (float*)(F.ws + WS_GATES);
    f32x4 gv[4];
#pragma unroll
    for (int j = 0; j < 4; ++j) gv[j] = *(const f32x4*)(gvec + 4 * F.lane + 256 * j);
    for (int rg = gw; rg < nrows / 4; rg += NGW) {
        const int row0 = rg * 4; const int id = row0 < SEQ ? 0 : (row0 < NLAT ? 1 : 2);
        const float* sh = mod + id * 6144; const float* sc = sh + 1024;
        f32x4 hv[4][4];
#pragma unroll
        for (int r = 0; r < 4; ++r) { const int row = row0 + r; const float* xr = row < NLAT ? xl + (size_t)row * DM : xc + (size_t)(row - NLAT) * DM;
#pragma unroll
            for (int j = 0; j < 4; ++j) hv[r][j] = *(const f32x4*)(xr + 4 * F.lane + 256 * j); }
#pragma unroll
        for (int r = 0; r < 4; ++r) { float s = 0.f;
#pragma unroll
            for (int j = 0; j < 4; ++j) s += (hv[r][j][0] * hv[r][j][0] + hv[r][j][1] * hv[r][j][1]) + (hv[r][j][2] * hv[r][j][2] + hv[r][j][3] * hv[r][j][3]);
            const float rstd = rsqrtf(wave_sum(s, F.lane) * (1.f / DM) + EPS);
#pragma unroll
            for (int j = 0; j < 4; ++j) { const f32x4 scv = *(const f32x4*)(sc + 4 * F.lane + 256 * j), shv = *(const f32x4*)(sh + 4 * F.lane + 256 * j);
                hv[r][j] = hv[r][j] * rstd * gv[j] * (1.f + scv) + shv;
                u32x2 w; w.x = cvtpk(hv[r][j][0], hv[r][j][1]); w.y = cvtpk(hv[r][j][2], hv[r][j][3]);
                *(u32x2*)(H + (size_t)(row0 + r) * DM + 4 * F.lane + 256 * j) = w; } }
        if (which == 0) {
            float mine[4] = {0.f, 0.f, 0.f, 0.f};
            for (int o = 0; o < 16; ++o) {
                f32x4 wv[4];
#pragma unroll
                for (int j = 0; j < 4; ++j) wv[j] = *(const f32x4*)(WG + o * 1024 + 4 * F.lane + 256 * j);
#pragma unroll
                for (int r = 0; r < 4; ++r) { float p = 0.f;
#pragma unroll
                    for (int j = 0; j < 4; ++j) p += (hv[r][j][0] * wv[j][0] + hv[r][j][1] * wv[j][1]) + (hv[r][j][2] * wv[j][2] + hv[r][j][3] * wv[j][3]);
                    p = wave_sum(p, F.lane); if (F.lane == o) mine[r] = p; }
            }
            if (F.lane < 16) {
#pragma unroll
                for (int r = 0; r < 4; ++r) GATES[(size_t)(row0 + r) * 16 + F.lane] = mine[r]; }
        }
    }
}

__device__ __forceinline__ void postproj_phase(Frame& F, int layer) {
    const int gw = F.bid * NWAVES + F.wave, NGW = F.G * NWAVES;
    bf16_t* PROJ = (bf16_t*)(F.ws + WS_PROJ);
    const float* ROPE = (const float*)(F.ws + WS_ROPE);
    const int sub = F.lane >> 4, l16 = F.lane & 15, d = 4 * l16;
    const f32x4 gq = *(const f32x4*)(F.ka->in[IN_AQG] + layer * 64 + d), gk = *(const f32x4*)(F.ka->in[IN_AKG] + layer * 64 + d);
    for (int row = gw; row < NROWS; row += NGW) {
        const bool lat = row < NLAT; const int t = row & (SEQ - 1);
        bf16_t* pr = PROJ + (size_t)row * PP;
        f32x4 cs0 = {1.f, 0.f, 1.f, 0.f}, cs1 = {1.f, 0.f, 1.f, 0.f};
        if (lat) { const int idx = (d >> 5) ? 128 + (t & 63) : (t >> 6); const float* rp = ROPE + ((size_t)idx * 16 + (d & 15)) * 2; cs0 = *(const f32x4*)rp; cs1 = *(const f32x4*)(rp + 4); }
        const float cz[4] = {cs0[0], cs0[2], cs1[0], cs1[2]}, sz[4] = {cs0[1], cs0[3], cs1[1], cs1[3]};
        const bool x2 = (l16 & 4) != 0;
#pragma unroll
        for (int pass = 0; pass < 3; ++pass) {
            const int col = pass == 0 ? PC_AQ + 64 * sub + d : (pass == 1 ? (sub < 2 ? PC_AK + 64 * sub + d : PC_BK + 64 * (sub - 2) + d) : PC_BQ + 64 * sub + d);
            const bool donorm = pass == 0 || (pass == 1 && sub < 2);
            const bool active = lat || donorm;
            if (!lat && pass == 2) continue;
            const u32x2 w = *(const u32x2*)(pr + col);
            float v[4] = {bflo(w.x), bfhi(w.x), bflo(w.y), bfhi(w.y)};
            float ss = (v[0] * v[0] + v[1] * v[1]) + (v[2] * v[2] + v[3] * v[3]);
            ss += shfl_x(ss, 1, F.lane); ss += shfl_x(ss, 2, F.lane); ss += shfl_x(ss, 4, F.lane); ss += shfl_x(ss, 8, F.lane);
            if (donorm) { const float rstd = rsqrtf(ss * (1.f / 64.f) + EPS) * (pass == 0 ? QSCALE2 : 1.f); const f32x4 g = pass == 0 ? gq : gk;
#pragma unroll
                for (int e = 0; e < 4; ++e) v[e] = v[e] * rstd * g[e]; }
            float o[4];
#pragma unroll
            for (int e = 0; e < 4; ++e) { const float p = shfl_x(v[e], 4, F.lane); o[e] = x2 ? (p * sz[e] + v[e] * cz[e]) : (v[e] * cz[e] - p * sz[e]); }
            if (active) { u32x2 ow; ow.x = cvtpk(o[0], o[1]); ow.y = cvtpk(o[2], o[3]); *(u32x2*)(pr + col) = ow; }
        }
    }
}

__device__ __forceinline__ void groupnorm_phase(Frame& F, int layer, int nrows) {
    const int gw = F.bid * NWAVES + F.wave, NGW = F.G * NWAVES;
    bf16_t* H = (bf16_t*)(F.ws + WS_H);
    const float* gg = F.ka->in[IN_GGRP] + layer * 1024;
    f32x4 gv[4];
#pragma unroll
    for (int j = 0; j < 4; ++j) gv[j] = *(const f32x4*)(gg + 4 * F.lane + 256 * j);
    for (int row = gw; row < nrows; row += NGW) {
        bf16_t* hr = H + (size_t)row * DM + 4 * F.lane;
        u32x2 w[4];
#pragma unroll
        for (int j = 0; j < 4; ++j) w[j] = *(const u32x2*)(hr + 256 * j);
#pragma unroll
        for (int j = 0; j < 4; ++j) { float v[4] = {bflo(w[j].x), bfhi(w[j].x), bflo(w[j].y), bfhi(w[j].y)};
            const float rstd = rsqrtf(wave_sum((v[0] * v[0] + v[1] * v[1]) + (v[2] * v[2] + v[3] * v[3]), F.lane) * (1.f / 256.f) + EPS);
            u32x2 o; o.x = cvtpk(v[0] * rstd * gv[j][0], v[1] * rstd * gv[j][1]); o.y = cvtpk(v[2] * rstd * gv[j][2], v[3] * rstd * gv[j][3]);
            *(u32x2*)(hr + 256 * j) = o; }
    }
}

__device__ __forceinline__ void fixup_phase(Frame& F, int layer, int nht) {
    const int gt = F.bid * NTHREADS + F.tid, NGT = F.G * NTHREADS;
    const float* edge = (const float*)(F.ws + WS_DS);
    const float* cw = F.ka->in[IN_CONVW] + (size_t)layer * 3 * DFF2; const float* cb = F.ka->in[IN_CONVB] + (size_t)layer * DFF2;
    bf16_t* act = (bf16_t*)(F.ws + WS_PROJ);
    const int per_row = DFF / 4;
    for (int it = gt; it < nht * 2 * per_row; it += NGT) {
        const int ch = (it % per_row) * 4, rr = it / per_row, ht = rr >> 1, last = rr & 1;
        const bool seq_start = (ht == 0 || ht == 64 || ht == 128 || ht == 130), seq_end = (ht == 63 || ht == 127 || ht == 129 || ht == 131);
        const int row = ht * 128 + (last ? 127 : 0);
        f32x4 o;
        f32x4 res[2];
#pragma unroll
        for (int gvv = 0; gvv < 2; ++gvv) { const int uc = gvv * DFF + ch;
            const f32x4 z = {0.f, 0.f, 0.f, 0.f};
            f32x4 up, ucur, un;
            if (!last) { up = seq_start ? z : *(const f32x4*)(edge + ((size_t)(ht - 1) * 4 + 3) * DFF2 + uc); ucur = *(const f32x4*)(edge + ((size_t)ht * 4 + 0) * DFF2 + uc); un = *(const f32x4*)(edge + ((size_t)ht * 4 + 1) * DFF2 + uc); }
            else { up = *(const f32x4*)(edge + ((size_t)ht * 4 + 2) * DFF2 + uc); ucur = *(const f32x4*)(edge + ((size_t)ht * 4 + 3) * DFF2 + uc); un = seq_end ? z : *(const f32x4*)(edge + ((size_t)(ht + 1) * 4 + 0) * DFF2 + uc); }
            res[gvv] = *(const f32x4*)(cw + uc) * up + *(const f32x4*)(cw + DFF2 + uc) * ucur + *(const f32x4*)(cw + 2 * DFF2 + uc) * un + *(const f32x4*)(cb + uc); }
#pragma unroll
        for (int j = 0; j < 4; ++j) o[j] = res[0][j] / (1.f + __expf(-res[0][j])) * res[1][j];
        u32x2 w; w.x = cvtpk(o[0], o[1]); w.y = cvtpk(o[2], o[3]);
        *(u32x2*)(act + (size_t)row * DFF + ch) = w;
    }
}

__device__ __forceinline__ void final_phase(Frame& F) {
    const int gw = F.bid * NWAVES + F.wave, NGW = F.G * NWAVES;
    const float* gf = F.ka->in[IN_GFIN];
    f32x4 gv[4];
#pragma unroll
    for (int j = 0; j < 4; ++j) gv[j] = *(const f32x4*)(gf + 4 * F.lane + 256 * j);
    for (int row = gw; row < NLAT; row += NGW) {
        float* xr = F.out + (size_t)row * DM + 4 * F.lane;
        f32x4 v[4]; float s = 0.f;
#pragma unroll
        for (int j = 0; j < 4; ++j) { v[j] = *(const f32x4*)(xr + 256 * j); s += (v[j][0] * v[j][0] + v[j][1] * v[j][1]) + (v[j][2] * v[j][2] + v[j][3] * v[j][3]); }
        const float rstd = rsqrtf(wave_sum(s, F.lane) * (1.f / DM) + EPS);
#pragma unroll
        for (int j = 0; j < 4; ++j) *(f32x4*)(xr + 256 * j) = v[j] * rstd * gv[j];
    }
}

typedef GAS unsigned gu32;
#define RLX_AGENT __ATOMIC_RELAXED, __HIP_MEMORY_SCOPE_AGENT
constexpr int CW_BAR = 4096;
#define XB_TMO      128
#define XB_XCNT(j)  (256  + 64 * (j))
#define XB_XSUB(j)  (1280 + 64 * (j))
#define XB_XGEN(j)  (2304 + 64 * (j))
#define XB_TOP      3328
#define XB_TOPGEN   3392
#define XCD_BAR_WORDS 3456
#define XB_SPIN_CAP (1u << 18)

__device__ __forceinline__ unsigned xb_ld(unsigned* p)              { return __hip_atomic_load(p, __ATOMIC_RELAXED, __HIP_MEMORY_SCOPE_AGENT); }
__device__ __forceinline__ unsigned xb_add(unsigned* p, unsigned v) { return __hip_atomic_fetch_add(p, v, __ATOMIC_RELAXED, __HIP_MEMORY_SCOPE_AGENT); }
__device__ __forceinline__ unsigned xb_xcc_id() { return (unsigned)__builtin_amdgcn_s_getreg((3 << 11) | 20) & 0xFu; }
#define XB_SPIN(cond, bar) do { unsigned _sp = 0; while (cond) { __builtin_amdgcn_s_sleep(1); \
    if ((++_sp & 255u) == 0u) { if (xb_ld(&(bar)[XB_TMO])) break; if (_sp > XB_SPIN_CAP) { atomicAdd(&(bar)[XB_TMO], 1u); break; } } } } while (0)

struct XcdBarrier {
    unsigned* bar; unsigned x;
    volatile LAS unsigned* st;
};

__device__ __forceinline__ XcdBarrier xcd_barrier_post(unsigned* bar, volatile LAS unsigned* st, bool is_t0) {
    XcdBarrier b; b.bar = bar; b.x = xb_xcc_id(); b.st = st;
    if (is_t0) (void)xb_add(&bar[XB_XCNT(b.x)], 1u);
    return b;
}
__device__ __forceinline__ void xcd_barrier_complete(unsigned* bar, unsigned x, unsigned& nloc, unsigned& nx) {
    const unsigned G = gridDim.x * gridDim.y * gridDim.z;
    unsigned sum, cnt, mine, sp = 0u;
    for (;;) {
        sum = 0u; cnt = 0u; mine = 0u;
#pragma unroll
        for (unsigned j = 0; j < 16; ++j) { const unsigned c = xb_ld(&bar[XB_XCNT(j)]); sum += c; cnt += (c > 0u) ? 1u : 0u; mine = (j == x) ? c : mine; }
        if (sum == G) break;
        __builtin_amdgcn_s_sleep(1);
        if ((++sp & 255u) == 0u) { if (xb_ld(&bar[XB_TMO])) break; if (sp > XB_SPIN_CAP) { atomicAdd(&bar[XB_TMO], 1u); break; } }
    }
    nloc = mine > 0u ? mine : 1u; nx = cnt > 0u ? cnt : 1u;
}

__device__ __forceinline__ void xcd_barrier(const XcdBarrier& b, bool is_t0) {
    asm volatile("s_waitcnt vmcnt(0)" ::: "memory");
    __syncthreads();
    if (is_t0) {
        unsigned* bar = b.bar;
        __builtin_amdgcn_s_waitcnt(0);
        unsigned nloc = b.st[0], nx = b.st[1];
        if (nloc == 0u) { xcd_barrier_complete(bar, b.x, nloc, nx); b.st[0] = nloc; b.st[1] = nx; }
        const unsigned old = xb_add(&bar[XB_XSUB(b.x)], 1u);
        const unsigned gen = old / nloc;
        if (old + 1u == (gen + 1u) * nloc) {
            __builtin_amdgcn_fence(__ATOMIC_RELEASE, "agent");
            asm volatile("s_waitcnt vmcnt(0)" ::: "memory");
            const unsigned og = xb_add(&bar[XB_TOP], 1u);
            const unsigned tg = og / nx;
            if (og + 1u == (tg + 1u) * nx) xb_add(&bar[XB_TOPGEN], 1u);
            else XB_SPIN(xb_ld(&bar[XB_TOPGEN]) == tg, bar);
            __builtin_amdgcn_fence(__ATOMIC_ACQUIRE, "agent");
            xb_add(&bar[XB_XGEN(b.x)], 1u);
            asm volatile("s_waitcnt vmcnt(0)" ::: "memory");
        } else {
            XB_SPIN(xb_ld(&bar[XB_XGEN(b.x)]) == gen, bar);
            __builtin_amdgcn_fence(__ATOMIC_ACQUIRE, "agent");
            asm volatile("s_waitcnt vmcnt(0)" ::: "memory");
        }
    }
    __syncthreads();
}

namespace att {
constexpr int SLOTB = 8192;
constexpr int L_K = 0, L_V = 2 * SLOTB, L_WS = 4 * SLOTB, L_OST = L_WS + 8 * 256, L_RPB = L_OST + 8 * 4096, L_END = L_RPB + 2048;
constexpr float THR = 8.0f;
__device__ __forceinline__ int crow(int r, int hi) { return (r & 3) + 8 * (r >> 2) + 4 * hi; }
__device__ __forceinline__ s16x4 vtr(const LAS unsigned char* p) { return __builtin_bit_cast(s16x4, __builtin_amdgcn_ds_read_tr16_b64_v4i16((LAS v4i16_t*)p)); }
__device__ __forceinline__ float rowmax32(const f32x16& p0, const f32x16& p1) {
    float a = fmaxf(p0[0], p1[0]);
#pragma unroll
    for (int r = 1; r < 16; ++r) a = fmaxf(a, fmaxf(p0[r], p1[r]));
    auto rr = __builtin_amdgcn_permlane32_swap(__float_as_uint(a), __float_as_uint(a), false, false);
    return fmaxf(__uint_as_float(rr[0]), __uint_as_float(rr[1]));
}
__device__ __forceinline__ float halfsum(float v) {
    auto rr = __builtin_amdgcn_permlane32_swap(__float_as_uint(v), __float_as_uint(v), false, false);
    return __uint_as_float(rr[0]) + __uint_as_float(rr[1]);
}
#define ATT_WAIT_BAR() asm volatile("s_waitcnt vmcnt(0) lgkmcnt(0)\n\ts_barrier" ::: "memory")

template <int MODE>
__device__ __forceinline__ void attn_unit(Frame& F, int b, int h, int qb, int qcol, int kcol, int vcol, int ycol, float sink2, const float* rpb) {
    LAS unsigned char* lds = F.lds;
    const int lane = F.lane, r32 = lane & 31, hi = lane >> 5, wid = F.wave;
    const bf16_t* PROJ = (const bf16_t*)(F.ws + WS_PROJ); bf16_t* Y = (bf16_t*)(F.ws + WS_H);
    const int ctxrow = NLAT + CTXL * b, latrow = SEQ * b;
    const int qrow0 = (MODE == 3) ? ctxrow : latrow + 256 * qb;
    const int qw0 = 256 * qb + 32 * wid;
    int lt_lo = 0, nloc = 0;
    if (MODE == 0) { lt_lo = 0; nloc = 128; }
    if (MODE == 1) { const int a = (256 * qb - 128) >> 6, e = (256 * qb + 255 + 128) >> 6; lt_lo = a < 0 ? 0 : a; nloc = (e > 127 ? 127 : e) - lt_lo + 1; }
    if (MODE == 2) { const int a = 4 * qb - 4, e0 = 4 * qb - 1; lt_lo = a < 0 ? 0 : (a > 120 ? 120 : a); const int e = (e0 < 0 ? 0 : (e0 > 120 ? 120 : e0)) + 7; nloc = e - lt_lo + 1; }
    const int NT = 4 + nloc;
    const int rw = 4 * qb + (wid >> 1); const int rs = rw - 4 < 0 ? 0 : (rw - 4 > 120 ? 120 : rw - 4);
    const int qc = 32 * (wid & 1) + r32; const int cs = qc - 8 < 0 ? 0 : (qc - 8 > 48 ? 48 : qc - 8);
    LAS float* wsf = (LAS float*)(lds + L_WS) + wid * 64;
    LAS float* rpbL = (LAS float*)(lds + L_RPB);
    if (MODE == 2) { for (int i = F.tid; i < 465; i += NTHREADS) rpbL[i] = rpb[i] * LOG2E; }
    const int vp0 = ((lane >> 4) & 1) * 32 + (lane & 3) * 8 + (4 * hi + ((lane & 15) >> 2)) * 64;
#define ATT_KROW(t) ((t) < 4 ? ctxrow + 64 * (t) : latrow + 64 * (lt_lo + (t) - 4))
#define ATT_DMA(t, slot) do { const int kr_ = ATT_KROW(t); \
        __builtin_amdgcn_global_load_lds((const unsigned*)(PROJ + (size_t)(kr_ + lane) * PP + kcol + wid * 8), (LAS unsigned*)(lds + L_K + (slot) * SLOTB + wid * 1024), 16, 0, 0); \
        __builtin_amdgcn_global_load_lds((const unsigned*)(PROJ + (size_t)(kr_ + 16 * (wid & 3) + (lane >> 2)) * PP + vcol + (wid >> 2) * 32 + (lane & 3) * 8), (LAS unsigned*)(lds + L_V + (slot) * SLOTB + wid * 1024), 16, 0, 0); } while (0)
    ATT_DMA(0, 0);
    bf16x8 qr[4];
#pragma unroll
    for (int d0 = 0; d0 < 4; ++d0) qr[d0] = *(const bf16x8*)(PROJ + (size_t)(qrow0 + 32 * wid + r32) * PP + qcol + d0 * 16 + hi * 8);
    float mhat = 0.f, l = 0.f; f32x16 o0 = {}, o1 = {}, negm = {};
    ATT_WAIT_BAR();
    for (int t = 0; t < NT; ++t) {
        const int slot = t & 1;
        if (t + 1 < NT) ATT_DMA(t + 1, slot ^ 1);
        bool rel = true; int kb0 = 0;
        if (MODE == 1 && t >= 4) { kb0 = 64 * (lt_lo + t - 4); rel = (kb0 + 63 >= qw0 - 128) && (kb0 <= qw0 + 31 + 128); }
        if (MODE == 2 && t >= 4) { kb0 = lt_lo + t - 4; rel = (kb0 >= rs) && (kb0 < rs + 8); }
        if (rel) {
            const LAS unsigned char* kb = lds + L_K + slot * SLOTB + hi * 1024 + r32 * 16;
            f32x16 p0 = negm, p1 = negm;
#pragma unroll
            for (int d0 = 0; d0 < 4; ++d0) {
                const bf16x8 b0 = *(const LAS bf16x8*)(kb + d0 * 2048), b1 = *(const LAS bf16x8*)(kb + d0 * 2048 + 512);
                p0 = __builtin_amdgcn_mfma_f32_32x32x16_bf16(b0, qr[d0], p0, 0, 0, 0);
                p1 = __builtin_amdgcn_mfma_f32_32x32x16_bf16(b1, qr[d0], p1, 0, 0, 0);
            }
            if (MODE == 1 && t >= 4) {
                const int dq = kb0 - (qw0 + r32);
#pragma unroll
                for (int r = 0; r < 16; ++r) { const int kc = crow(r, hi); const int d0_ = dq + kc, d1_ = d0_ + 32;
                    if (d0_ > 128 || d0_ < -128) p0[r] = -INFINITY; if (d1_ > 128 || d1_ < -128) p1[r] = -INFINITY; }
            }
            if (MODE == 2 && t >= 4) {
                const LAS float* bt = rpbL + (kb0 - rw + 7) * 31 + (15 - qc);
#pragma unroll
                for (int r = 0; r < 16; ++r) { const int kc = crow(r, hi);
                    const bool v0 = (kc >= cs) && (kc < cs + 16), v1 = (kc + 32 >= cs) && (kc + 32 < cs + 16);
                    p0[r] = v0 ? p0[r] + bt[v0 ? kc : qc] : -INFINITY; p1[r] = v1 ? p1[r] + bt[v1 ? kc + 32 : qc] : -INFINITY; }
            }
            const float rm = rowmax32(p0, p1);
            if (t == 0 || __any(rm > THR)) {
                const float dl = (t == 0) ? rm : fmaxf(rm, 0.f);
                mhat += dl;
#pragma unroll
                for (int r = 0; r < 16; ++r) { p0[r] -= dl; p1[r] -= dl; negm[r] = -mhat; }
                if (t > 0) { const float f = __builtin_amdgcn_exp2f(-dl); l *= f; if (hi == 0) wsf[r32] = f; LDS_WAIT();
#pragma unroll
                    for (int r = 0; r < 16; ++r) { const float fr_ = wsf[crow(r, hi)]; o0[r] *= fr_; o1[r] *= fr_; }
                    LDS_WAIT(); }
            }
            float ls = 0.f;
#pragma unroll
            for (int r = 0; r < 16; ++r) { p0[r] = __builtin_amdgcn_exp2f(p0[r]); p1[r] = __builtin_amdgcn_exp2f(p1[r]); ls += p0[r] + p1[r]; }
            l += ls;
            u32x4 pw[4];
#pragma unroll
            for (int k = 0; k < 4; ++k) { pw[0][k] = cvtpk(p0[2 * k], p0[2 * k + 1]); pw[1][k] = cvtpk(p0[8 + 2 * k], p0[9 + 2 * k]); pw[2][k] = cvtpk(p1[2 * k], p1[2 * k + 1]); pw[3][k] = cvtpk(p1[8 + 2 * k], p1[9 + 2 * k]); }
            const LAS unsigned char* vb = lds + L_V + slot * SLOTB + vp0;
#pragma unroll
            for (int ks = 0; ks < 4; ++ks) {
                const s16x4 a0 = vtr(vb + ks * 1024), a1 = vtr(vb + ks * 1024 + 512), c0 = vtr(vb + 4096 + ks * 1024), c1 = vtr(vb + 4096 + ks * 1024 + 512);
                const bf16x8 v0 = {a0[0], a0[1], a0[2], a0[3], a1[0], a1[1], a1[2], a1[3]}, v1 = {c0[0], c0[1], c0[2], c0[3], c1[0], c1[1], c1[2], c1[3]};
                o0 = __builtin_amdgcn_mfma_f32_32x32x16_bf16(__builtin_bit_cast(bf16x8, pw[ks]), v0, o0, 0, 0, 0);
                o1 = __builtin_amdgcn_mfma_f32_32x32x16_bf16(__builtin_bit_cast(bf16x8, pw[ks]), v1, o1, 0, 0, 0);
            }
        }
        ATT_WAIT_BAR();
    }
    l = halfsum(l);
    if (MODE == 1 || MODE == 3) l += __builtin_amdgcn_exp2f(sink2 - mhat);
    if (hi == 0) wsf[32 + r32] = l;
    LDS_WAIT();
    bf16_t* stg = (bf16_t*)(lds + L_OST + wid * 4096);
    LAS bf16_t* stgl = (LAS bf16_t*)(lds + L_OST + wid * 4096);
#pragma unroll
    for (int r = 0; r < 16; ++r) { const int orow = crow(r, hi); const float rl = __builtin_amdgcn_rcpf(wsf[32 + orow]);
        stgl[orow * 64 + r32] = (bf16_t)(cvtpk(o0[r] * rl, 0.f) & 0xffffu); stgl[orow * 64 + 32 + r32] = (bf16_t)(cvtpk(o1[r] * rl, 0.f) & 0xffffu); }
    LDS_WAIT();
    (void)stg;
#pragma unroll
    for (int i = 0; i < 4; ++i) { const int row = i * 8 + (lane >> 3), ch = lane & 7; const u32x4 v = *(const LAS u32x4*)(stgl + row * 64 + ch * 8);
        *(u32x4*)(Y + (size_t)(qrow0 + 32 * wid + row) * DM + ycol + ch * 8) = v; }
    LDS_WAIT();
#undef ATT_KROW
#undef ATT_DMA
}
}

namespace ml {
__device__ __forceinline__ float scan_add(float v, int lane, int dir) {
#pragma unroll
    for (int o = 1; o < 64; o <<= 1) { const float t = shfl_idx(v, (dir ? lane + o : lane - o) & 63); const bool ok = dir ? (lane + o < 64) : (lane >= o); v += ok ? t : 0.f; }
    return v;
}
__device__ __forceinline__ float scan_max(float v, int lane, int dir) {
#pragma unroll
    for (int o = 1; o < 64; o <<= 1) { const float t = shfl_idx(v, (dir ? lane + o : lane - o) & 63); const bool ok = dir ? (lane + o < 64) : (lane >= o); v = ok ? fmaxf(v, t) : v; }
    return v;
}
__device__ __forceinline__ float logsigmoid(float x) { return fminf(x, 0.f) - log1pf(__expf(-fabsf(x))); }
__device__ __forceinline__ int img_off(int tok, int d) { return (d >> 5) * 4096 + (tok >> 4) * 1024 + (tok & 15) * 64 + (d & 31) * 2; }
__device__ __forceinline__ int blk_row0(int b, int blk) { return blk < 4 ? NLAT + CTXL * b + 64 * blk : SEQ * b + 64 * (blk - 4); }
__device__ __forceinline__ int chunk_of(int dir, int blk) { return dir == 0 ? blk : (blk < 4 ? 3 - blk : 4 + 127 - (blk - 4)); }

__device__ __forceinline__ void pass1(Frame& F, int layer) {
    const int gw = F.bid * NWAVES + F.wave, NGW = F.G * NWAVES, lane = F.lane, r32 = lane & 31, hi = lane >> 5;
    LAS unsigned char* wl = F.lds + F.wave * 16384;
    const bf16_t* PROJ = (const bf16_t*)(F.ws + WS_PROJ); const float* GATES = (const float*)(F.ws + WS_GATES);
    const float* gb = F.ka->in[IN_CGB] + layer * 16;
    float* DS = (float*)(F.ws + WS_DS); float* ZD = (float*)(F.ws + WS_ZD); float* GC = (float*)(F.ws + WS_GC); float* ML = (float*)(F.ws + WS_ML);
    const int vp0 = ((lane >> 4) & 1) * 32 + (lane & 3) * 8 + (4 * hi + ((lane & 15) >> 2)) * 64;
    for (int wu = gw; wu < NCHAIN * NCHUNK; wu += NGW) {
        const int chain = wu / NCHUNK, c = wu % NCHUNK, dir = chain & 1, h = (chain >> 1) & 3, b = chain >> 3;
        const int row0 = blk_row0(b, chunk_of(dir, c));
        const float gi = GATES[(size_t)(row0 + lane) * 16 + dir * 8 + h] + gb[dir * 8 + h];
        const float lf = logsigmoid(GATES[(size_t)(row0 + lane) * 16 + dir * 8 + 4 + h] + gb[dir * 8 + 4 + h]);
        const float cum = scan_add(lf, lane, dir);
        const float G = wave_sum(lf, lane);
        const float bb = gi - cum, mloc = wave_max(bb, lane), w = __expf(bb - mloc);
#pragma unroll
        for (int it = 0; it < 8; ++it) { const int tok = (lane >> 3) + 8 * it, d = 8 * (lane & 7);
            const u32x4 kv = *(const u32x4*)(PROJ + (size_t)(row0 + tok) * PP + PC_CK + 64 * h + d), vv = *(const u32x4*)(PROJ + (size_t)(row0 + tok) * PP + PC_CV + 64 * h + d);
            const float wt = shfl_idx(w, tok);
            u32x4 ko; ko.x = cvtpk(bflo(kv.x) * wt, bfhi(kv.x) * wt); ko.y = cvtpk(bflo(kv.y) * wt, bfhi(kv.y) * wt); ko.z = cvtpk(bflo(kv.z) * wt, bfhi(kv.z) * wt); ko.w = cvtpk(bflo(kv.w) * wt, bfhi(kv.w) * wt);
            *(LAS u32x4*)(wl + img_off(tok, d)) = vv; *(LAS u32x4*)(wl + 8192 + img_off(tok, d)) = ko; }
        LDS_WAIT();
        f32x16 acc[2][2] = {};
#pragma unroll
        for (int s = 0; s < 4; ++s) {
            bf16x8 af[2], bfr[2];
#pragma unroll
            for (int x = 0; x < 2; ++x) { const s16x4 a0 = att::vtr(wl + vp0 + x * 4096 + s * 1024), a1 = att::vtr(wl + vp0 + x * 4096 + s * 1024 + 512);
                const s16x4 c0 = att::vtr(wl + 8192 + vp0 + x * 4096 + s * 1024), c1 = att::vtr(wl + 8192 + vp0 + x * 4096 + s * 1024 + 512);
                af[x] = (bf16x8){a0[0], a0[1], a0[2], a0[3], a1[0], a1[1], a1[2], a1[3]}; bfr[x] = (bf16x8){c0[0], c0[1], c0[2], c0[3], c1[0], c1[1], c1[2], c1[3]}; }
#pragma unroll
            for (int vb = 0; vb < 2; ++vb)
#pragma unroll
                for (int kb = 0; kb < 2; ++kb) acc[vb][kb] = __builtin_amdgcn_mfma_f32_32x32x16_bf16(af[vb], bfr[kb], acc[vb][kb], 0, 0, 0);
        }
        float* dsp = DS + (size_t)(chain * NCHUNK + c) * 4096;
#pragma unroll
        for (int vb = 0; vb < 2; ++vb)
#pragma unroll
            for (int kb = 0; kb < 2; ++kb)
#pragma unroll
                for (int r = 0; r < 16; ++r) dsp[(32 * vb + att::crow(r, hi)) * 64 + 32 * kb + r32] = acc[vb][kb][r];
        float z = 0.f;
#pragma unroll 8
        for (int tok = 0; tok < 64; ++tok) z += bf2f(*(const LAS bf16_t*)(wl + 8192 + img_off(tok, lane)));
        ZD[(size_t)(chain * NCHUNK + c) * 64 + lane] = z;
        if (lane == 0) { GC[chain * NCHUNK + c] = G; ML[chain * NCHUNK + c] = mloc; }
        LDS_WAIT();
    }
}

__device__ __forceinline__ void pass2(Frame& F) {
    const float* DS = (const float*)(F.ws + WS_DS); const float* ZD = (const float*)(F.ws + WS_ZD); const float* GC = (const float*)(F.ws + WS_GC); const float* ML = (const float*)(F.ws + WS_ML);
    bf16_t* SBF = (bf16_t*)(F.ws + WS_SBF); float* ZC = (float*)(F.ws + WS_ZC); float* MC = (float*)(F.ws + WS_MC);
    LAS float* cf = (LAS float*)F.lds;
    for (int it = F.bid; it < NCHAIN * 16; it += F.G) {
        const int chain = it >> 4, part = it & 15;
        __syncthreads();
        if (F.wave == 0) {
            const int ln = F.lane; const bool valid = ln < 44; float g[3], mlv[3];
#pragma unroll
            for (int j = 0; j < 3; ++j) { g[j] = valid ? GC[chain * NCHUNK + 3 * ln + j] : 0.f; mlv[j] = valid ? ML[chain * NCHUNK + 3 * ln + j] : -INFINITY; }
            const float tot = g[0] + g[1] + g[2]; const float excl = ml::scan_add(tot, ln, 0) - tot;
            const float pg[3] = {excl, excl + g[0], excl + g[0] + g[1]};
            const float a0 = mlv[0] - pg[0], a1 = mlv[1] - pg[1], a2 = mlv[2] - pg[2];
            const float inclm = ml::scan_max(fmaxf(a0, fmaxf(a1, a2)), ln, 0); float exclm = shfl_idx(inclm, (ln - 1) & 63); if (ln == 0) exclm = -INFINITY;
            const float em[3] = {exclm, fmaxf(exclm, a0), fmaxf(fmaxf(exclm, a0), a1)};
#pragma unroll
            for (int j = 0; j < 3; ++j) { const int c = 3 * ln + j; const float m = pg[j] + fmaxf(0.f, em[j]); const float mn = fmaxf(g[j] + m, g[j] + mlv[j]);
                if (valid) { cf[2 * c] = __expf(g[j] + m - mn); cf[2 * c + 1] = __expf(g[j] + mlv[j] - mn); if (part == 0) MC[chain * NCHUNK + c] = m; } }
        }
        __syncthreads();
        if (F.tid < 256) {
            const int e = part * 256 + F.tid; const float* dp = DS + (size_t)chain * NCHUNK * 4096 + e; bf16_t* sp = SBF + (size_t)chain * NCHUNK * 4096 + e;
            float s = 0.f;
            for (int c0 = 0; c0 < NCHUNK; c0 += 12) { float d[12];
#pragma unroll
                for (int j = 0; j < 12; ++j) d[j] = dp[(size_t)(c0 + j) * 4096];
#pragma unroll
                for (int j = 0; j < 12; ++j) { sp[(size_t)(c0 + j) * 4096] = (bf16_t)(cvtpk(s, 0.f) & 0xffffu); s = cf[2 * (c0 + j)] * s + cf[2 * (c0 + j) + 1] * d[j]; } }
        } else if (F.tid < 260) {
            const int e = part * 4 + (F.tid - 256); const float* dp = ZD + (size_t)chain * NCHUNK * 64 + e; float* zp = ZC + (size_t)chain * NCHUNK * 64 + e;
            float s = 0.f;
            for (int c = 0; c < NCHUNK; ++c) { const float d = dp[(size_t)c * 64]; zp[(size_t)c * 64] = s; s = cf[2 * c] * s + cf[2 * c + 1] * d; }
        }
    }
    __syncthreads();
}

__device__ __forceinline__ void pass3(Frame& F, int layer, int blk_lo) {
    const int gw = F.bid * NWAVES + F.wave, NGW = F.G * NWAVES, lane = F.lane, r32_ = lane & 31, hi_ = lane >> 5;
    LAS unsigned char* wl = F.lds + F.wave * 19456;
    LAS float* bvec = (LAS float*)(wl + 16384); LAS float* Apl = bvec + 128; LAS float* efl = bvec + 256; LAS float* fll = bvec + 384; LAS float* zl = bvec + 512; LAS float* rden = bvec + 640;
    LAS float* st = (LAS float*)(wl + 8192);
    const bf16_t* PROJ = (const bf16_t*)(F.ws + WS_PROJ); const float* GATES = (const float*)(F.ws + WS_GATES);
    const float* gb = F.ka->in[IN_CGB] + layer * 16;
    const bf16_t* SBF = (const bf16_t*)(F.ws + WS_SBF); const float* ZC = (const float*)(F.ws + WS_ZC); const float* MC = (const float*)(F.ws + WS_MC);
    bf16_t* Y = (bf16_t*)(F.ws + WS_H);
    const int vp0 = ((lane >> 4) & 1) * 32 + (lane & 3) * 8 + (4 * hi_ + ((lane & 15) >> 2)) * 64;
    const int nblk = NCHUNK - blk_lo;
    for (int wu = gw; wu < 8 * nblk; wu += NGW) {
        const int bh = wu / nblk, blk = blk_lo + wu % nblk, b = bh >> 2, h = bh & 3;
        const int row0 = blk_row0(b, blk);
        LDS_WAIT();
#pragma unroll
        for (int it = 0; it < 8; ++it) { const int tok = (lane >> 3) + 8 * it, d = 8 * (lane & 7);
            *(LAS u32x4*)(wl + img_off(tok, d)) = *(const u32x4*)(PROJ + (size_t)(row0 + tok) * PP + PC_CV + 64 * h + d); }
#pragma unroll
        for (int dir = 0; dir < 2; ++dir) {
            const int c = chunk_of(dir, blk), chain = (b * 4 + h) * 2 + dir;
            const float gi = GATES[(size_t)(row0 + lane) * 16 + dir * 8 + h] + gb[dir * 8 + h];
            const float lf = logsigmoid(GATES[(size_t)(row0 + lane) * 16 + dir * 8 + 4 + h] + gb[dir * 8 + 4 + h]);
            const float cum = scan_add(lf, lane, dir);
            const float bb = gi - cum, pm = scan_max(bb, lane, dir), mc = MC[chain * NCHUNK + c];
            const float Apv = fmaxf(mc, pm);
            zl[dir * 64 + lane] = ZC[(size_t)(chain * NCHUNK + c) * 64 + lane];
            bvec[dir * 64 + lane] = bb; Apl[dir * 64 + lane] = Apv; efl[dir * 64 + lane] = __expf(mc - Apv); fll[dir * 64 + lane] = __expf(-(cum + Apv));
        }
        LDS_WAIT();
#pragma unroll 1
        for (int tb = 0; tb < 2; ++tb) {
            int r32 = r32_, hi = hi_; asm volatile("" : "+v"(r32), "+v"(hi));
            const int t = 32 * tb + r32;
            bf16x8 qf[4];
#pragma unroll
            for (int d0 = 0; d0 < 4; ++d0) qf[d0] = *(const bf16x8*)(PROJ + (size_t)(row0 + t) * PP + PC_CQ + 64 * h + 16 * d0 + 8 * hi);
            f32x16 hs0 = {}, hs1 = {};
#pragma unroll 1
            for (int dir = 0; dir < 2; ++dir) {
                const int c = chunk_of(dir, blk), chain = (b * 4 + h) * 2 + dir;
                const bf16_t* Sp = SBF + (size_t)(chain * NCHUNK + c) * 4096; const LAS float* zp = zl + dir * 64;
                int r32 = r32_, hi = hi_; asm volatile("" : "+v"(r32), "+v"(hi));
                const float Ap_t = Apl[dir * 64 + t], e_t = efl[dir * 64 + t], fl_t = fll[dir * 64 + t];
                f32x16 P0 = {}, P1 = {};
#pragma unroll
                for (int d0 = 0; d0 < 4; ++d0) {
                    const bf16x8 k0 = *(const bf16x8*)(PROJ + (size_t)(row0 + r32) * PP + PC_CK + 64 * h + 16 * d0 + 8 * hi), k1 = *(const bf16x8*)(PROJ + (size_t)(row0 + 32 + r32) * PP + PC_CK + 64 * h + 16 * d0 + 8 * hi);
                    P0 = __builtin_amdgcn_mfma_f32_32x32x16_bf16(k0, qf[d0], P0, 0, 0, 0); P1 = __builtin_amdgcn_mfma_f32_32x32x16_bf16(k1, qf[d0], P1, 0, 0, 0); }
                float den = 0.f;
#pragma unroll
                for (int r = 0; r < 16; ++r) { const int s0 = att::crow(r, hi), s1 = 32 + s0; const bool ok0 = dir ? (s0 >= t) : (s0 <= t), ok1 = dir ? (s1 >= t) : (s1 <= t);
                    const float w0 = ok0 ? __expf(bvec[dir * 64 + s0] - Ap_t) : 0.f, w1 = ok1 ? __expf(bvec[dir * 64 + s1] - Ap_t) : 0.f;
                    P0[r] *= w0; P1[r] *= w1; den += P0[r] + P1[r]; }
                u32x4 pw[4];
#pragma unroll
                for (int k = 0; k < 4; ++k) { pw[0][k] = cvtpk(P0[2 * k], P0[2 * k + 1]); pw[1][k] = cvtpk(P0[8 + 2 * k], P0[9 + 2 * k]); pw[2][k] = cvtpk(P1[2 * k], P1[2 * k + 1]); pw[3][k] = cvtpk(P1[8 + 2 * k], P1[9 + 2 * k]); }

                f32x16 n0 = {}, n1 = {}; float zq = 0.f;
#pragma unroll
                for (int d0 = 0; d0 < 4; ++d0) { const u32x4 qw = __builtin_bit_cast(u32x4, qf[d0]); u32x4 o;
                    const f32x4 za = *(const LAS f32x4*)(zp + 16 * d0 + 8 * hi), zb = *(const LAS f32x4*)(zp + 16 * d0 + 8 * hi + 4);
                    const float q0 = bflo(qw.x), q1 = bfhi(qw.x), q2 = bflo(qw.y), q3 = bfhi(qw.y), q4 = bflo(qw.z), q5 = bfhi(qw.z), q6 = bflo(qw.w), q7 = bfhi(qw.w);
                    zq += (q0 * za[0] + q1 * za[1]) + (q2 * za[2] + q3 * za[3]) + (q4 * zb[0] + q5 * zb[1]) + (q6 * zb[2] + q7 * zb[3]);
                    o.x = cvtpk(q0 * e_t, q1 * e_t); o.y = cvtpk(q2 * e_t, q3 * e_t); o.z = cvtpk(q4 * e_t, q5 * e_t); o.w = cvtpk(q6 * e_t, q7 * e_t);
                    const bf16x8 qs = __builtin_bit_cast(bf16x8, o);
                    const bf16x8 s0 = *(const bf16x8*)(Sp + (size_t)r32 * 64 + 16 * d0 + 8 * hi), s1 = *(const bf16x8*)(Sp + (size_t)(32 + r32) * 64 + 16 * d0 + 8 * hi);
                    n0 = __builtin_amdgcn_mfma_f32_32x32x16_bf16(qs, s0, n0, 0, 0, 0); n1 = __builtin_amdgcn_mfma_f32_32x32x16_bf16(qs, s1, n1, 0, 0, 0); }

                den = att::halfsum(den) + e_t * att::halfsum(zq);
                const float rd = 1.f / fmaxf(fabsf(den), fl_t);
                LDS_WAIT(); if (hi == 0) rden[r32] = rd; LDS_WAIT();
#pragma unroll
                for (int ks = 0; ks < 4; ++ks) {
                    const s16x4 a0 = att::vtr(wl + vp0 + ks * 1024), a1 = att::vtr(wl + vp0 + ks * 1024 + 512), c0 = att::vtr(wl + vp0 + 4096 + ks * 1024), c1 = att::vtr(wl + vp0 + 4096 + ks * 1024 + 512);
                    const bf16x8 v0 = {a0[0], a0[1], a0[2], a0[3], a1[0], a1[1], a1[2], a1[3]}, v1 = {c0[0], c0[1], c0[2], c0[3], c1[0], c1[1], c1[2], c1[3]};
                    n0 = __builtin_amdgcn_mfma_f32_32x32x16_bf16(__builtin_bit_cast(bf16x8, pw[ks]), v0, n0, 0, 0, 0);
                    n1 = __builtin_amdgcn_mfma_f32_32x32x16_bf16(__builtin_bit_cast(bf16x8, pw[ks]), v1, n1, 0, 0, 0); }
#pragma unroll
                for (int r = 0; r < 16; ++r) { const float rr = rden[att::crow(r, hi)]; hs0[r] += n0[r] * rr; hs1[r] += n1[r] * rr; }
            }
            LDS_WAIT();
#pragma unroll
            for (int r = 0; r < 16; ++r) { st[att::crow(r, hi) * 64 + r32] = hs0[r]; st[att::crow(r, hi) * 64 + 32 + r32] = hs1[r]; }
            LDS_WAIT();
#pragma unroll
            for (int it = 0; it < 4; ++it) { const int tk = (lane >> 3) + 8 * it, d = 8 * (lane & 7);
                const u32x4 ow = *(const u32x4*)(PROJ + (size_t)(row0 + 32 * tb + tk) * PP + PC_CO + 64 * h + d);
                const f32x4 ha = *(const LAS f32x4*)(st + tk * 64 + d), hb = *(const LAS f32x4*)(st + tk * 64 + d + 4);
                const float og[8] = {bflo(ow.x), bfhi(ow.x), bflo(ow.y), bfhi(ow.y), bflo(ow.z), bfhi(ow.z), bflo(ow.w), bfhi(ow.w)};
                float yv[8];
#pragma unroll
                for (int j = 0; j < 8; ++j) yv[j] = (j < 4 ? ha[j] : hb[j - 4]) / (1.f + __expf(-og[j]));
                u32x4 w; w.x = cvtpk(yv[0], yv[1]); w.y = cvtpk(yv[2], yv[3]); w.z = cvtpk(yv[4], yv[5]); w.w = cvtpk(yv[6], yv[7]);
                *(u32x4*)(Y + (size_t)(row0 + 32 * tb + tk) * DM + 512 + 64 * h + d) = w; }
            LDS_WAIT();
        }
    }
}
}

constexpr int PH_PER_LAYER = 11, NPHASE = 2 + NLAYER * PH_PER_LAYER;

__device__ __forceinline__ void phase_ids(Frame& F) {
    int lane_;
    asm volatile("v_mbcnt_lo_u32_b32 %0, -1, 0\n\tv_mbcnt_hi_u32_b32 %0, -1, %0" : "=v"(lane_));
    F.lane = lane_; F.tid = F.wave * 64 + lane_;
}
__device__ __forceinline__ void run_phase(const Frame& F0, int ph) {
    Frame F = F0;
    unsigned char* ws = F.ws;
    bf16_t* H = (bf16_t*)(ws + WS_H); bf16_t* PROJ = (bf16_t*)(ws + WS_PROJ);
    float* XC = (float*)(ws + WS_XC);
    const float* MOD = (const float*)(ws + WS_MOD);
    const int vcu = (F0.G % 8 == 0) ? (F0.bid % 8) * (F0.G / 8) + F0.bid / 8 : F0.bid;
#ifdef ONLYK
    if (ONLYK == 100) { if (ph == 0) { phase_ids(F); p0_prologue(F); } return; }
    if (ONLYK == 101) { if (ph == NPHASE - 1) { phase_ids(F); final_phase(F); } return; }
    if (ph == 0 || ph == NPHASE - 1) return;
    const int l = (ph - 1) / PH_PER_LAYER, k = ONLYK;
    if ((ph - 1) % PH_PER_LAYER != ONLYK) return;
#else
    if (ph == 0) { phase_ids(F); p0_prologue(F); return; }
    if (ph == NPHASE - 1) { phase_ids(F); final_phase(F); return; }
    const int l = (ph - 1) / PH_PER_LAYER, k = (ph - 1) % PH_PER_LAYER;
#endif
    const int M = (l == 0) ? NROWS : NLAT;
    switch (k) {
    case 0: phase_ids(F); norm_phase(F, l, 0, NROWS); break;
    case 1: { phase_ids(F); pg8::Gemm g{H, (const bf16_t*)(ws + WS_WIN) + (size_t)l * PP * 1024, NROWS, PP, 1024}; pg8::StaticOrder S; S.init(NROWS, PP, F.G, F.bid);
              pg8::EpiProj E{PROJ, PP}; pg8::gemm_phase<pg8::EpiProj, pg8::StaticOrder, true, true>(F.lds, g, S, E, F.tid); } break;
    case 2: phase_ids(F); postproj_phase(F, l); ml::pass1(F, l); break;
    case 3: {
        phase_ids(F);
        ml::pass2(F);
        for (int u = vcu; u < 256; u += F.G) { const int b = u >> 7, h = (u >> 5) & 3, qb = u & 31;
            att::attn_unit<1>(F, b, h, qb, PC_BQ + 64 * h, PC_BK + 64 * (h >> 1), PC_BV + 64 * (h >> 1), 256 + 64 * h, F.ka->in[IN_SINK][l * 4 + h] * LOG2E, nullptr); }
        for (int u = vcu; u < 256; u += F.G) { const int b = u >> 7, h = (u >> 5) & 3, qb = u & 31;
            att::attn_unit<2>(F, b, h, qb, PC_DQ + 64 * h, PC_DK + 64 * h, PC_DV + 64 * h, 768 + 64 * h, 0.f, F.ka->in[IN_RPB] + (size_t)(l * 4 + h) * 465); }
        if (l == 0) for (int cu = vcu; cu < 24; cu += F.G) { const int mx = cu >> 3, b = (cu >> 2) & 1, h = cu & 3;
            const int qc = mx == 0 ? PC_AQ + 64 * h : (mx == 1 ? PC_BQ + 64 * h : PC_DQ + 64 * h);
            const int kc = mx == 0 ? PC_AK + 64 * (h >> 1) : (mx == 1 ? PC_BK + 64 * (h >> 1) : PC_DK + 64 * h);
            const int vc = mx == 0 ? PC_AV + 64 * (h >> 1) : (mx == 1 ? PC_BV + 64 * (h >> 1) : PC_DV + 64 * h);
            const int yc = (mx == 0 ? 0 : (mx == 1 ? 256 : 768)) + 64 * h;
            const float s2 = mx == 1 ? F.ka->in[IN_SINK][l * 4 + h] * LOG2E : -INFINITY;
            att::attn_unit<3>(F, b, h, 0, qc, kc, vc, yc, s2, nullptr); }
    } break;
    case 4: {
        phase_ids(F);
#ifndef NO_ATTN0
        for (int u = vcu; u < 256; u += F.G) { const int b = u >> 7, h = (u >> 5) & 3, qb = u & 31;
            att::attn_unit<0>(F, b, h, qb, PC_AQ + 64 * h, PC_AK + 64 * (h >> 1), PC_AV + 64 * (h >> 1), 64 * h, 0.f, nullptr); }
#endif
        __syncthreads();
#ifndef NO_PASS3
        ml::pass3(F, l, l == 0 ? 0 : 4);
#endif
    } break;
    case 5: phase_ids(F); groupnorm_phase(F, l, M); break;
    case 6: { phase_ids(F); pg8::Gemm g{H, (const bf16_t*)(ws + WS_WOUT) + (size_t)l * 1024 * 1024, M, 1024, 1024}; pg8::StaticOrder S; S.init(M, 1024, F.G, F.bid);
              pg8::EpiResid E{l == 0 ? F.ka->in[IN_X] : F.out, l == 0 ? F.ka->in[IN_CTX] : XC, F.out, XC, MOD + (size_t)l * 3 * 6144 + 2 * 1024};
              pg8::gemm_phase<pg8::EpiResid, pg8::StaticOrder, true, true>(F.lds, g, S, E, F.tid); } break;
    case 7: phase_ids(F); norm_phase(F, l, 1, M); break;
    case 8: { phase_ids(F); pg8::Gemm g{H, (const bf16_t*)(ws + WS_WUP) + (size_t)l * DFF2 * 1024, M, DFF2, 1024}; pg8::StaticOrder S; S.init(M, DFF2, F.G, F.bid);
              pg8::EpiUp E{PROJ, F.ka->in[IN_CONVW] + (size_t)l * 3 * DFF2, F.ka->in[IN_CONVB] + (size_t)l * DFF2, (float*)(ws + WS_DS)};
              pg8::gemm_phase<pg8::EpiUp, pg8::StaticOrder, true, true>(F.lds, g, S, E, F.tid); } break;
    case 9: phase_ids(F); fixup_phase(F, l, M / 128); break;
    case 10: { phase_ids(F); pg8::Gemm g{PROJ, (const bf16_t*)(ws + WS_WDN) + (size_t)l * 1024 * DFF, M, 1024, DFF}; pg8::StaticOrder S; S.init(M, 1024, F.G, F.bid);
              pg8::EpiResid E{F.out, XC, F.out, XC, MOD + (size_t)l * 3 * 6144 + 5 * 1024};
              pg8::gemm_phase<pg8::EpiResid, pg8::StaticOrder, true, true>(F.lds, g, S, E, F.tid); } break;
    default: break;
    }
}

__global__ void __launch_bounds__(NTHREADS, 2) fwd_kernel(Args args) {
    extern __shared__ __attribute__((aligned(16))) unsigned char lds_raw[];
    Frame F;
    F.lds = (LAS unsigned char*)lds_raw;
    const int wave0 = __builtin_amdgcn_readfirstlane((int)threadIdx.x >> 6);
    F.tid = 0; F.lane = 0; F.wave = wave0;
    F.G = gridDim.x; F.bid = blockIdx.x;
    F.ka = (const __attribute__((address_space(4))) Args*)__builtin_amdgcn_kernarg_segment_ptr();
    F.out = args.out; F.ws = args.ws;
#define MK_LANE(x) int x; asm volatile("v_mbcnt_lo_u32_b32 %0, -1, 0\n\tv_mbcnt_hi_u32_b32 %0, -1, %0" : "=v"(x))
#if !MK_MULTI
    { MK_LANE(l0_); if (wave0 == 0) ((LAS unsigned*)(F.lds + LDSCTL_OFF))[l0_] = 0u; }
    __syncthreads();
    XcdBarrier bar;
    { MK_LANE(l0_); bar = xcd_barrier_post((unsigned*)(args.ws + WS_CTL) + CW_BAR, (volatile LAS unsigned*)(F.lds + LDSCTL_OFF) + 8, wave0 == 0 && l0_ == 0); }
#endif
    for (int ph = args.ph_lo; ph < args.ph_hi; ++ph) {
        {
            Frame P = F;
            int wave_ = wave0, bid_ = F.bid, g_ = F.G; unsigned char* ws_ = F.ws; float* out_ = F.out; const __attribute__((address_space(4))) Args* ka_ = F.ka;
            asm volatile("" : "+s"(wave_), "+s"(bid_), "+s"(g_), "+s"(ws_), "+s"(out_), "+s"(ka_));
            P.ka = ka_; P.lane = 0; P.wave = wave_; P.tid = 0; P.bid = bid_; P.G = g_; P.ws = ws_; P.out = out_;
            run_phase(P, ph);
        }
#if !MK_MULTI
        if (ph + 1 < args.ph_hi) {
            if (ph == args.ph_lo) cg::this_grid().sync();
            else { MK_LANE(l1_); xcd_barrier(bar, wave0 == 0 && l1_ == 0); }
        }
#endif
    }
}

extern "C" void kernel_launch(void* const* d_in, const int* in_sizes, int n_in, void* d_out, int out_size, void* d_ws, size_t ws_size, hipStream_t stream) {
    static int grid = 0;
    if (grid == 0) {
        if (n_in != 21 || out_size != NLAT * DM || ws_size < WS_END) { fprintf(stderr, "kernel_launch: unexpected shapes (n_in %d out %d ws %zu)\n", n_in, out_size, ws_size); grid = -1; return; }
        int dev = 0, cus = 0, per_cu = 0;
        if (hipGetDevice(&dev) != hipSuccess || hipDeviceGetAttribute(&cus, hipDeviceAttributeMultiprocessorCount, dev) != hipSuccess) { grid = -1; return; }
        if (hipFuncSetAttribute((const void*)fwd_kernel, hipFuncAttributeMaxDynamicSharedMemorySize, LDS_BYTES) != hipSuccess) { fprintf(stderr, "kernel_launch: hipFuncSetAttribute failed\n"); grid = -1; return; }
        if (hipOccupancyMaxActiveBlocksPerMultiprocessor(&per_cu, (const void*)fwd_kernel, NTHREADS, LDS_BYTES) != hipSuccess || per_cu < 1) { fprintf(stderr, "kernel_launch: occupancy query says %d blocks per CU\n", per_cu); grid = -1; (void)hipGetLastError(); return; }
        grid = cus;
    }
    if (grid < 0) return;
#if !MK_MULTI
    if (hipMemsetAsync((char*)d_ws + WS_CTL, 0, 65536, stream) != hipSuccess) { fprintf(stderr, "kernel_launch: hipMemsetAsync failed\n"); return; }
#endif
    Args a{};
    for (int i = 0; i < 21; ++i) a.in[i] = (const float*)d_in[i];
    a.out = (float*)d_out; a.ws = (unsigned char*)d_ws;
#if MK_MULTI
    for (int ph = 0; ph < NPHASE; ++ph) { a.ph_lo = ph; a.ph_hi = ph + 1; hipLaunchKernelGGL(fwd_kernel, dim3(grid), dim3(NTHREADS), LDS_BYTES, stream, a); }
#else
    a.ph_lo = 0; a.ph_hi = NPHASE;
    void* kargs[] = {&a};
    hipError_t e = hipLaunchCooperativeKernel((void*)fwd_kernel, dim3(grid), dim3(NTHREADS), kargs, LDS_BYTES, stream);
    if (e != hipSuccess) fprintf(stderr, "kernel_launch: cooperative launch failed: %s (grid %d)\n", hipGetErrorString(e), grid);
#endif
}
```

```cpp
#include <hip/hip_runtime.h>
#include <hip/hip_cooperative_groups.h>
#include <cstdio>
#include <cstdint>
namespace cg = cooperative_groups;

#ifndef MK_MULTI
#define MK_MULTI 0
#endif

constexpr int DM = 1024, SEQ = 8192, NBATCH = 2, CTXL = 256, NLAT = NBATCH * SEQ, NROWS = NLAT + NBATCH * CTXL;
constexpr int PP = 2816;
constexpr int DFF = 2816, DFF2 = 5632, DIN = 2832, NLAYER = 2;
constexpr float EPS = 1e-6f;
constexpr float LOG2E = 1.4426950408889634f;
constexpr float QSCALE2 = 0.125f * LOG2E;
constexpr int PC_AQ = 0, PC_AK = 256, PC_AV = 384, PC_BQ = 512, PC_BK = 768, PC_BV = 896, PC_CQ = 1024, PC_CK = 1280, PC_CV = 1536, PC_CO = 1792, PC_DQ = 2048, PC_DK = 2304, PC_DV = 2560;
constexpr int NCHUNK = 132, NCHAIN = 16;

constexpr size_t MiB = 1u << 20;
constexpr size_t WS_CTL = 0, CTL_ZERO_BYTES = 1 * MiB;
constexpr size_t WS_MOD = 1 * MiB;
constexpr size_t WS_ROPE = 1 * MiB + 192 * 1024;
constexpr size_t WS_WG = 1 * MiB + 512 * 1024;
constexpr size_t WS_XC = 2 * MiB;
constexpr size_t WS_WIN = 4 * MiB;
constexpr size_t WS_WOUT = 15 * MiB;
constexpr size_t WS_WUP = 19 * MiB;
constexpr size_t WS_WDN = 41 * MiB;
constexpr size_t WS_H = 52 * MiB;
constexpr size_t WS_PROJ = 85 * MiB;
constexpr size_t WS_GATES = 176 * MiB;
constexpr size_t WS_DS = 178 * MiB;
constexpr size_t WS_SBF = 211 * MiB;
constexpr size_t WS_ZD = 228 * MiB;
constexpr size_t WS_ZC = WS_ZD + 1 * MiB;
constexpr size_t WS_GC = WS_ZC + 1 * MiB;
constexpr size_t WS_ML = WS_GC + 16384;
constexpr size_t WS_MC = WS_ML + 16384;
constexpr size_t WS_SSQ1 = 231 * MiB;
constexpr size_t WS_SSQ2 = 232 * MiB + 512 * 1024;
constexpr size_t WS_BIASUP = 234 * MiB;
constexpr size_t WS_BIASIN = 234 * MiB + 256 * 1024;
constexpr size_t WS_XG = WS_DS;
constexpr size_t WS_EDGE = WS_SBF;
constexpr size_t WS_END = 235 * MiB;

#define LAS __attribute__((address_space(3)))
#define GAS __attribute__((address_space(1)))
typedef unsigned short bf16_t;
typedef short bf16x8 __attribute__((ext_vector_type(8)));
typedef short s16x4 __attribute__((ext_vector_type(4)));
typedef float f32x4 __attribute__((ext_vector_type(4)));
typedef float f32x16 __attribute__((ext_vector_type(16)));
typedef float f32x2 __attribute__((ext_vector_type(2)));
typedef unsigned u32x4 __attribute__((ext_vector_type(4)));
typedef unsigned u32x2 __attribute__((ext_vector_type(2)));
typedef __bf16 bf16x2_t __attribute__((ext_vector_type(2)));
typedef short v4i16_t __attribute__((ext_vector_type(4)));

__device__ __forceinline__ unsigned cvtpk(float lo, float hi) { f32x2 v = {lo, hi}; bf16x2_t b = __builtin_convertvector(v, bf16x2_t); return __builtin_bit_cast(unsigned, b); }
__device__ __forceinline__ float bf2f(unsigned short b) { return __uint_as_float((unsigned)b << 16); }
__device__ __forceinline__ float bflo(unsigned w) { return __uint_as_float(w << 16); }
__device__ __forceinline__ float bfhi(unsigned w) { return __uint_as_float(w & 0xffff0000u); }
__device__ __forceinline__ float shfl_idx(float v, int src) { return __int_as_float(__builtin_amdgcn_ds_bpermute(src << 2, __float_as_int(v))); }
__device__ __forceinline__ float shfl_x(float v, int o, int lane) { return shfl_idx(v, lane ^ o); }
__device__ __forceinline__ float wave_sum(float v, int lane) {
#pragma unroll
    for (int o = 1; o < 64; o <<= 1) v += shfl_x(v, o, lane);
    return v;
}
__device__ __forceinline__ float wave_max(float v, int lane) {
#pragma unroll
    for (int o = 1; o < 64; o <<= 1) v = fmaxf(v, shfl_x(v, o, lane));
    return v;
}
#define LDS_WAIT() asm volatile("s_waitcnt lgkmcnt(0)" ::: "memory")
#define VM_WAIT() asm volatile("s_waitcnt vmcnt(0)" ::: "memory")

namespace pg8 {
#define PG8_LAS __attribute__((address_space(3)))
constexpr int BM = 256, BK = 64, HALF = 128, HTB = HALF * BK * 2  , STAGE_BYTES = 8 * HTB, NXCD = 8, WGM = 8;
__host__ __device__ __forceinline__ int lds_byte(int r, int c) { const int st = (r >> 4) * 2 + (c >> 5), rr = r & 15, cc = c & 31, ob = rr * 64 + cc * 2; return st * 1024 + (ob ^ (((ob >> 9) & 1) << 5)); }
__host__ __device__ __forceinline__ void stage_rc(int b, int& R, int& C) { const int st = b / 1024, sb = b % 1024, swz = sb ^ (((sb >> 9) & 1) << 5); R = (st >> 1) * 16 + swz / 64; C = (st & 1) * 32 + (swz % 64) / 2; }
__host__ __device__ __forceinline__ int perm32(int rho) { const int n = rho >> 4, i = rho & 15; return 8 * (i >> 2) + 4 * n + (i & 3); }

struct Unit { int pm, pn, ui; };
struct Gemm { const bf16_t* A; const bf16_t* Bt; int M, N, K; };

struct StaticOrder {
    int nM, nN, nwg, G, c;
    __host__ __device__ void init(int M, int N, int G_, int c_) { nM = M / BM; nN = N / BM; nwg = nM * nN; G = G_; c = c_; }
    __host__ __device__ bool next(int i, Unit& u) const {
        const long L = (long)i * G + c; if (L >= nwg) return false;
        int wgid = (int)L; { const int q = nwg / NXCD, r = nwg % NXCD, xcd = wgid % NXCD, off = wgid / NXCD; wgid = (xcd < r ? xcd * (q + 1) : r * (q + 1) + (xcd - r) * q) + off; }
        const int nig = WGM * nN, gid = wgid / nig, fm = gid * WGM, gsz = (nM - fm) < WGM ? (nM - fm) : WGM;
        u.pm = fm + ((wgid % nig) % gsz); u.pn = (wgid % nig) / gsz; u.ui = i; return true;
    }
    __device__ __forceinline__ void a_ready(const Unit&) const {}
    __device__ __forceinline__ void done(const Unit&) const {}
};

constexpr int RTAB_OFF = 131072;
struct EpiProj {
    static constexpr bool PERM = true, AFTER_DRAIN = false, ROWPERM = false;
    bf16_t* O; int ldc; const LAS float* rtab; const float* bias;
    __device__ __forceinline__ void operator()(const f32x4 (&acc)[2][2][4][2], const Unit& u, int wr, int wc, int fr, int fq) const {
        asm volatile("" : "+v"(fr), "+v"(fq));
        const int row0 = u.pm * BM + wr * 64 + fr, col0 = u.pn * BM + wc * 32 + 8 * fq;
        const float sc = (u.pn == 2 || u.pn == 8) ? QSCALE2 : (u.pn == 4 ? 0.125f : 1.f);
        float rs[8] = {1.f, 1.f, 1.f, 1.f, 1.f, 1.f, 1.f, 1.f}; f32x4 bv[2][2] = {};
        if (rtab) {
#pragma unroll
            for (int i = 0; i < 8; ++i) rs[i] = rtab[u.ui * 256 + wr * 64 + fr + (i >> 2) * HALF + (i & 3) * 16];
            const int id = u.pm < 32 ? 0 : (u.pm < 64 ? 1 : 2);
#pragma unroll
            for (int bj = 0; bj < 2; ++bj)
#pragma unroll
                for (int n = 0; n < 2; ++n) bv[bj][n] = *(const f32x4*)(bias + id * PP + col0 + bj * HALF + 4 * n); }
#pragma unroll
        for (int ai = 0; ai < 2; ++ai)
#pragma unroll
            for (int m = 0; m < 4; ++m) { bf16_t* rowp = O + (size_t)(row0 + ai * HALF + m * 16) * ldc + col0; const float r = rs[ai * 4 + m];
#pragma unroll
                for (int bj = 0; bj < 2; ++bj) { const f32x4 v0 = (acc[ai][bj][m][0] * r + bv[bj][0]) * sc, v1 = (acc[ai][bj][m][1] * r + bv[bj][1]) * sc;
                    u32x4 w; w.x = cvtpk(v0[0], v0[1]); w.y = cvtpk(v0[2], v0[3]); w.z = cvtpk(v1[0], v1[1]); w.w = cvtpk(v1[2], v1[3]);
                    *(u32x4*)(rowp + bj * HALF) = w; } }
    }
};
struct EpiResid {
    static constexpr bool PERM = true, AFTER_DRAIN = false, ROWPERM = false;
    const float* xin_lat; const float* xin_ctx; float* xout_lat; float* xout_ctx; const float* gate;
    bf16_t* xg; const float* gn; const float* scn; float* ssq;
    __device__ __forceinline__ void operator()(const f32x4 (&acc)[2][2][4][2], const Unit& u, int wr, int wc, int fr, int fq) const {
        asm volatile("" : "+v"(fr), "+v"(fq));
        const int id = u.pm < 32 ? 0 : (u.pm < 64 ? 1 : 2);
        const float* xin = u.pm < 64 ? xin_lat + (size_t)u.pm * BM * DM : xin_ctx + (size_t)(u.pm - 64) * BM * DM;
        float* xout = u.pm < 64 ? xout_lat + (size_t)u.pm * BM * DM : xout_ctx + (size_t)(u.pm - 64) * BM * DM;
        const int rl = wr * 64 + fr, col0 = u.pn * BM + wc * 32 + 8 * fq;
        f32x4 g[2][2], gs[2][2];
#pragma unroll
        for (int bj = 0; bj < 2; ++bj)
#pragma unroll
            for (int n = 0; n < 2; ++n) { g[bj][n] = *(const f32x4*)(gate + id * 6144 + col0 + bj * HALF + 4 * n);
                if (xg) gs[bj][n] = *(const f32x4*)(gn + col0 + bj * HALF + 4 * n) * (1.f + *(const f32x4*)(scn + id * 6144 + col0 + bj * HALF + 4 * n)); }
#pragma unroll
        for (int ai = 0; ai < 2; ++ai)
#pragma unroll
            for (int m = 0; m < 4; ++m) { const size_t off = (size_t)(rl + ai * HALF + m * 16) * DM + col0; float s = 0.f;
#pragma unroll
                for (int bj = 0; bj < 2; ++bj) { f32x4 o[2];
#pragma unroll
                    for (int n = 0; n < 2; ++n) { const f32x4 xv = *(const f32x4*)(xin + off + bj * HALF + 4 * n); o[n] = xv + g[bj][n] * acc[ai][bj][m][n];
                        *(f32x4*)(xout + off + bj * HALF + 4 * n) = o[n]; s += (o[n][0] * o[n][0] + o[n][1] * o[n][1]) + (o[n][2] * o[n][2] + o[n][3] * o[n][3]); }
                    if (xg) { const f32x4 a = o[0] * gs[bj][0], b = o[1] * gs[bj][1]; u32x4 w; w.x = cvtpk(a[0], a[1]); w.y = cvtpk(a[2], a[3]); w.z = cvtpk(b[0], b[1]); w.w = cvtpk(b[2], b[3]);
                        *(u32x4*)(xg + (size_t)u.pm * BM * DM + off + bj * HALF) = w; } }
                if (xg) { s += shfl_idx(s, (fq * 16 + fr) ^ 16); s += shfl_idx(s, (fq * 16 + fr) ^ 32);
                    if (fq == 0) ssq[(size_t)(u.pm * BM + rl + ai * HALF + m * 16) * 16 + u.pn * 4 + wc] = s; } }
    }
};
struct EpiUp {
    static constexpr bool PERM = true, AFTER_DRAIN = false, ROWPERM = true;
    bf16_t* act; const float* convw; const float* convb; float* edge; const LAS float* rtab; const float* bias;
    __device__ __forceinline__ void operator()(f32x4 (&acc)[2][2][4][2], const Unit& u, int wr, int wc, int fr, int fq) const {
        asm volatile("" : "+v"(fr), "+v"(fq));
        const int chb = u.pn * 128 + wc * 32 + 8 * fq;
        const int ht = 2 * u.pm + wr;
        {
            const f32x4 ra = *(const LAS f32x4*)(rtab + u.ui * 256 + (wr * 16 + fr) * 8), rb = *(const LAS f32x4*)(rtab + u.ui * 256 + (wr * 16 + fr) * 8 + 4);
            const float rs[8] = {ra[0], ra[1], ra[2], ra[3], rb[0], rb[1], rb[2], rb[3]};
            const int id = u.pm < 32 ? 0 : (u.pm < 64 ? 1 : 2);
#pragma unroll
            for (int bj = 0; bj < 2; ++bj)
#pragma unroll
                for (int n = 0; n < 2; ++n) { const f32x4 bv = *(const f32x4*)(bias + id * DFF2 + bj * DFF + chb + 4 * n);
#pragma unroll
                    for (int sl = 0; sl < 8; ++sl) { acc[sl >> 2][bj][sl & 3][n] = acc[sl >> 2][bj][sl & 3][n] * rs[sl] + bv; asm volatile("" : "+v"(acc[sl >> 2][bj][sl & 3][n])); } }
        }
        const int lm1 = (fq * 16 + fr - 1) & 63, lp1 = (fq * 16 + fr + 1) & 63;
#pragma unroll
        for (int bj = 0; bj < 2; ++bj)
#pragma unroll
            for (int n = 0; n < 2; ++n) {
                const int uc = bj * DFF + chb + 4 * n;
                if (fr == 0) { *(f32x4*)(edge + ((size_t)ht * 4 + 0) * DFF2 + uc) = acc[0][bj][0][n]; *(f32x4*)(edge + ((size_t)ht * 4 + 1) * DFF2 + uc) = acc[0][bj][1][n]; }
                if (fr == 15) { *(f32x4*)(edge + ((size_t)ht * 4 + 2) * DFF2 + uc) = acc[1][bj][2][n]; *(f32x4*)(edge + ((size_t)ht * 4 + 3) * DFF2 + uc) = acc[1][bj][3][n]; }
#pragma unroll
                for (int j = 0; j < 4; ++j) {
                    const float w0 = convw[uc + j], w1 = convw[DFF2 + uc + j], w2 = convw[2 * DFF2 + uc + j], bb = convb[uc + j];
                    float pv = shfl_idx(acc[1][bj][3][n][j], lm1); const float nx = shfl_idx(acc[0][bj][0][n][j], lp1);
#pragma unroll
                    for (int sl = 0; sl < 8; ++sl) { const float cur = acc[sl >> 2][bj][sl & 3][n][j]; const float nxt = sl < 7 ? acc[(sl + 1) >> 2][bj][(sl + 1) & 3][n][j] : nx;
                        acc[sl >> 2][bj][sl & 3][n][j] = w0 * pv + w1 * cur + w2 * nxt + bb; pv = cur; }
                }
#pragma unroll
                for (int sl = 0; sl < 8; ++sl) asm volatile("" : "+v"(acc[sl >> 2][bj][sl & 3][n]));
            }
        bf16_t* base = act + (size_t)(u.pm * BM + (wr * 16 + fr) * 8) * DFF + chb;
#pragma unroll
        for (int sl = 0; sl < 8; ++sl) {
            const f32x4 g0 = acc[sl >> 2][0][sl & 3][0], g1 = acc[sl >> 2][0][sl & 3][1], v0 = acc[sl >> 2][1][sl & 3][0], v1 = acc[sl >> 2][1][sl & 3][1];
            f32x4 o0, o1;
#pragma unroll
            for (int j = 0; j < 4; ++j) { o0[j] = g0[j] * __builtin_amdgcn_rcpf(1.f + __builtin_amdgcn_exp2f(-LOG2E * g0[j])) * v0[j]; o1[j] = g1[j] * __builtin_amdgcn_rcpf(1.f + __builtin_amdgcn_exp2f(-LOG2E * g1[j])) * v1[j]; }
            u32x4 w; w.x = cvtpk(o0[0], o0[1]); w.y = cvtpk(o0[2], o0[3]); w.z = cvtpk(o1[0], o1[1]); w.w = cvtpk(o1[2], o1[3]);
            const bool skip = (fr == 0 && sl == 0) || (fr == 15 && sl == 7);
            if (!skip) *(u32x4*)(base + (size_t)sl * DFF) = w;
        }
    }
};
template <class Epi, class Sched, bool ALIGN_EPI = false, bool SP2 = false>
__device__ __forceinline__ void gemm_phase(PG8_LAS unsigned char* lds, const Gemm g, const Sched& S, const Epi& E, const int tid) {
    const int wid = __builtin_amdgcn_readfirstlane(tid >> 6), lane = tid & 63, wr = wid >> 2, wc = wid & 3, fr = lane & 15, fq = lane >> 4;
    const int K = g.K, nt = K / BK;
    unsigned voffA[2], voffB[2];
#pragma unroll
    for (int i = 0; i < 2; ++i) { int R, C; stage_rc(tid * 16 + i * 8192, R, C); const int Rb = Epi::PERM ? ((R & ~31) + perm32(R & 31)) : R;
        const int Ra = Epi::ROWPERM ? (((((R >> 6) & 1) * 16 + (R & 15)) << 3) + ((R >> 4) & 3)) : R;
        voffA[i] = (unsigned)(Ra * K + C) * 2u; voffB[i] = (unsigned)(Rb * K + C) * 2u; }
    const size_t kstep = (size_t)(BK * 2);
    const size_t hstep = (size_t)HALF * K * 2;
    const size_t hstepA = Epi::ROWPERM ? (size_t)4 * K * 2 : hstep;
    const size_t tstep = 2 * hstep;
    const unsigned ldsw = (unsigned)wid * 1024u;
    const int aoff = lds_byte(wr * 64 + fr, fq * 8), boff = lds_byte(wc * 32 + fr, fq * 8);
#define PG8_SA(b, h) (((b) * 2 + (h)) * HTB)
#define PG8_SB(b, h) ((4 + (b) * 2 + (h)) * HTB)
#define PG8_STAGE(bufoff, gbase, voff) do { _Pragma("unroll") for (int _i = 0; _i < 2; ++_i) \
        __builtin_amdgcn_global_load_lds((const unsigned*)((const char*)(gbase) + (voff)[_i]), (PG8_LAS unsigned*)(lds + (bufoff) + ldsw + _i * 8192), 16, 0, 0); } while (0)
#define PG8_LDA(dst, b, h) do { _Pragma("unroll") for (int m = 0; m < 4; ++m) _Pragma("unroll") for (int k = 0; k < 2; ++k) dst[m][k] = *(const PG8_LAS bf16x8*)(lds + PG8_SA(b, h) + aoff + m * 2048 + k * 1024); } while (0)
#define PG8_LDB(dst, b, h) do { _Pragma("unroll") for (int n = 0; n < 2; ++n) _Pragma("unroll") for (int k = 0; k < 2; ++k) dst[n][k] = *(const PG8_LAS bf16x8*)(lds + PG8_SB(b, h) + boff + n * 2048 + k * 1024); } while (0)
#define PG8_MMA(ai, bj, At, Bt) do { __builtin_amdgcn_s_setprio(1); _Pragma("unroll") for (int m = 0; m < 4; ++m) _Pragma("unroll") for (int n = 0; n < 2; ++n) _Pragma("unroll") for (int k = 0; k < 2; ++k) \
        acc[ai][bj][m][n] = __builtin_amdgcn_mfma_f32_16x16x32_bf16(Bt[n][k], At[m][k], acc[ai][bj][m][n], 0, 0, 0); __builtin_amdgcn_s_setprio(0); } while (0)
#define PG8_WAIT_V(n) asm volatile("s_waitcnt vmcnt(" #n ")" ::: "memory")
#define PG8_WAIT_L(n) asm volatile("s_waitcnt lgkmcnt(" #n ")" ::: "memory")
#define PG8_BAR __builtin_amdgcn_s_barrier()
#define PG8_SCHED __builtin_amdgcn_sched_barrier(0)
    Unit cur, nxt; int ui = 0;
    if (!S.next(0, cur)) return;
    f32x4 acc[2][2][4][2];
#pragma unroll
    for (int a = 0; a < 2; ++a)
#pragma unroll
        for (int b = 0; b < 2; ++b)
#pragma unroll
            for (int m = 0; m < 4; ++m)
#pragma unroll
                for (int n = 0; n < 2; ++n) acc[a][b][m][n] = (f32x4){0.f, 0.f, 0.f, 0.f};
    bf16x8 At[4][2], B0[2][2], B1[2][2];
    const char* cA = (const char*)g.A + (size_t)cur.pm * tstep; const char* cB = (const char*)g.Bt + (size_t)cur.pn * tstep;
    S.a_ready(cur);
    if constexpr (SP2) {
        PG8_STAGE(PG8_SB(0, 0), cB, voffB); PG8_STAGE(PG8_SB(0, 1), cB + hstep, voffB); PG8_STAGE(PG8_SA(0, 0), cA, voffA); PG8_STAGE(PG8_SA(0, 1), cA + hstepA, voffA);
        if (wr == 1) PG8_BAR;
        PG8_WAIT_V(2); PG8_BAR;
        PG8_STAGE(PG8_SB(1, 0), cB + kstep, voffB); PG8_STAGE(PG8_SA(1, 0), cA + kstep, voffA); PG8_STAGE(PG8_SB(1, 1), cB + hstep + kstep, voffB);
        PG8_WAIT_V(6); PG8_BAR;
    } else {
        PG8_STAGE(PG8_SB(0, 0), cB, voffB); PG8_STAGE(PG8_SA(0, 0), cA, voffA); PG8_STAGE(PG8_SB(0, 1), cB + hstep, voffB); PG8_STAGE(PG8_SA(0, 1), cA + hstepA, voffA);
        if (wr == 1) PG8_BAR;
        PG8_WAIT_V(4); PG8_BAR;
        PG8_STAGE(PG8_SB(1, 0), cB + kstep, voffB); PG8_STAGE(PG8_SA(1, 0), cA + kstep, voffA); PG8_STAGE(PG8_SB(1, 1), cB + hstep + kstep, voffB);
        PG8_WAIT_V(6); PG8_BAR;
    }
    for (;;) {
        const bool has_next = S.next(ui + 1, nxt);
        const char* nA = has_next ? (const char*)g.A + (size_t)nxt.pm * tstep : cA; const char* nB = has_next ? (const char*)g.Bt + (size_t)nxt.pn * tstep : cB;
        for (int t = 0; t < nt; t += 2) {
            const bool last = (t == nt - 2);
            const char* a1 = cA + (size_t)(t + 1) * kstep;
            const char* a2 = last ? nA : cA + (size_t)(t + 2) * kstep; const char* b2 = last ? nB : cB + (size_t)(t + 2) * kstep;
            const char* a3 = a2 + kstep; const char* b3 = b2 + kstep;
            if (last && has_next) S.a_ready(nxt);
            if constexpr (SP2) {
            PG8_LDB(B0, 0, 0); PG8_LDB(B1, 0, 1); PG8_SCHED; PG8_LDA(At, 0, 0); PG8_STAGE(PG8_SA(1, 1), a1 + hstepA, voffA);
            PG8_WAIT_V(8); PG8_WAIT_L(0); PG8_BAR; PG8_MMA(0, 0, At, B0); PG8_MMA(0, 1, At, B1); PG8_BAR; PG8_SCHED;
            PG8_LDA(At, 0, 1); PG8_STAGE(PG8_SB(0, 0), b2, voffB); PG8_STAGE(PG8_SB(0, 1), b2 + hstep, voffB); PG8_STAGE(PG8_SA(0, 0), a2, voffA);
            PG8_WAIT_V(8); PG8_WAIT_L(0); PG8_BAR; PG8_MMA(1, 0, At, B0); PG8_MMA(1, 1, At, B1); PG8_BAR; PG8_SCHED;
            PG8_LDB(B0, 1, 0); PG8_LDB(B1, 1, 1); PG8_SCHED; PG8_LDA(At, 1, 0); PG8_STAGE(PG8_SA(0, 1), a2 + hstepA, voffA);
            PG8_WAIT_V(8); PG8_WAIT_L(0); PG8_BAR; PG8_MMA(0, 0, At, B0); PG8_MMA(0, 1, At, B1); PG8_BAR; PG8_SCHED;
            PG8_LDA(At, 1, 1); PG8_STAGE(PG8_SB(1, 0), b3, voffB); PG8_STAGE(PG8_SB(1, 1), b3 + hstep, voffB); PG8_STAGE(PG8_SA(1, 0), a3, voffA);
            PG8_WAIT_V(8); PG8_WAIT_L(0); PG8_BAR; PG8_MMA(1, 0, At, B0); PG8_MMA(1, 1, At, B1); PG8_BAR; PG8_SCHED;
            } else {
            PG8_LDB(B0, 0, 0); PG8_SCHED; PG8_LDA(At, 0, 0); PG8_STAGE(PG8_SA(1, 1), a1 + hstepA, voffA);
            PG8_WAIT_L(8); PG8_BAR; PG8_WAIT_L(0); PG8_MMA(0, 0, At, B0); PG8_BAR; PG8_SCHED;
            PG8_LDB(B1, 0, 1); PG8_STAGE(PG8_SB(0, 0), b2, voffB);
            PG8_BAR; PG8_WAIT_L(0); PG8_MMA(0, 1, At, B1); PG8_BAR;
            PG8_LDA(At, 0, 1); PG8_STAGE(PG8_SA(0, 0), a2, voffA);
            PG8_BAR; PG8_WAIT_L(0); PG8_MMA(1, 0, At, B0); PG8_BAR; PG8_SCHED;
            PG8_STAGE(PG8_SB(0, 1), b2 + hstep, voffB);
            PG8_WAIT_V(6); PG8_BAR; PG8_MMA(1, 1, At, B1); PG8_BAR;
            PG8_LDB(B0, 1, 0); PG8_SCHED; PG8_LDA(At, 1, 0); PG8_STAGE(PG8_SA(0, 1), a2 + hstepA, voffA);
            PG8_WAIT_L(8); PG8_BAR; PG8_WAIT_L(0); PG8_MMA(0, 0, At, B0); PG8_BAR; PG8_SCHED;
            PG8_LDB(B1, 1, 1); PG8_STAGE(PG8_SB(1, 0), b3, voffB);
            PG8_BAR; PG8_WAIT_L(0); PG8_MMA(0, 1, At, B1); PG8_BAR;
            PG8_LDA(At, 1, 1); PG8_STAGE(PG8_SA(1, 0), a3, voffA);
            PG8_BAR; PG8_WAIT_L(0); PG8_MMA(1, 0, At, B0); PG8_BAR; PG8_SCHED;
            PG8_STAGE(PG8_SB(1, 1), b3 + hstep, voffB);
            PG8_WAIT_V(6); PG8_BAR; PG8_MMA(1, 1, At, B1); PG8_BAR;
            }
        }
        if constexpr (ALIGN_EPI) { if (wr == 0) PG8_BAR; }
        if constexpr (!Epi::AFTER_DRAIN) { E(acc, cur, wr, wc, fr, fq); S.done(cur); }
        if (!has_next) break;
#pragma unroll
        for (int a = 0; a < 2; ++a)
#pragma unroll
            for (int b = 0; b < 2; ++b)
#pragma unroll
                for (int m = 0; m < 4; ++m)
#pragma unroll
                    for (int n = 0; n < 2; ++n) acc[a][b][m][n] = (f32x4){0.f, 0.f, 0.f, 0.f};
        cur = nxt; cA = nA; cB = nB; ++ui;
        if constexpr (ALIGN_EPI) { if (wr == 1) PG8_BAR; }
    }
    PG8_WAIT_V(0);
    if constexpr (!ALIGN_EPI) { if (wr == 0) PG8_BAR; }
    PG8_BAR;
    if constexpr (Epi::AFTER_DRAIN) { E.fused(acc, cur, wr, wc, fr, fq, lds, wid, lane); S.done(cur); }
#undef PG8_SA
#undef PG8_SB
#undef PG8_STAGE
#undef PG8_LDA
#undef PG8_LDB
#undef PG8_MMA
#undef PG8_WAIT_V
#undef PG8_WAIT_L
#undef PG8_BAR
#undef PG8_SCHED
}
}

constexpr int NWAVES = 8, NTHREADS = 512;
constexpr int LDSCTL_OFF = 155648;
constexpr int LDS_BYTES = LDSCTL_OFF + 256;
struct Args {
    const float* in[21]; float* out; unsigned char* ws; int ph_lo, ph_hi;
};
struct Frame {
    LAS unsigned char* lds;
    int tid, lane, wave, G, bid;
    const __attribute__((address_space(4))) Args* ka;
    float* out; unsigned char* ws;
};
enum { IN_X = 0, IN_C, IN_CTX, IN_CCTX, IN_WMOD, IN_BMOD, IN_G1, IN_G2, IN_WIN, IN_AQG, IN_AKG, IN_SINK, IN_CGB, IN_RPB, IN_GGRP, IN_WOUT, IN_WUP, IN_CONVW, IN_CONVB, IN_WDN, IN_GFIN };

template <class MapFn>
__device__ __forceinline__ void transpose_item(const float* W, int K, int N, bf16_t* WT, LAS float* scr, int item, int lane, MapFn map) {
    const int nblk = (N + 31) / 32, kb = item / nblk, nb = item % nblk, k0 = 64 * kb, n0 = 32 * nb;
    const int col = n0 + (lane & 31);
#pragma unroll 8
    for (int i = 0; i < 32; ++i) { const int kk = 2 * i + (lane >> 5); scr[kk * 33 + (lane & 31)] = col < N ? W[(size_t)(k0 + kk) * N + col] : 0.f; }
    LDS_WAIT(); asm volatile("" ::: "memory");
    const int c = lane & 7;
#pragma unroll
    for (int j = 0; j < 4; ++j) { const int n = (lane >> 3) + 8 * j; const LAS float* s = scr + (8 * c) * 33 + n;
        u32x4 o; o.x = cvtpk(s[0 * 33], s[1 * 33]); o.y = cvtpk(s[2 * 33], s[3 * 33]); o.z = cvtpk(s[4 * 33], s[5 * 33]); o.w = cvtpk(s[6 * 33], s[7 * 33]);
        const int sc = n0 + n; const int dr = sc < N ? map(sc) : -1;
        if (dr >= 0) *(u32x4*)(WT + (size_t)dr * K + k0 + 8 * c) = o; }
    LDS_WAIT(); asm volatile("" ::: "memory");
}
__device__ __forceinline__ void p0_prologue(Frame& F) {
    const float* c = F.ka->in[IN_C]; const float* cctx = F.ka->in[IN_CCTX];
    {
        LAS float* sv = (LAS float*)F.lds;
        LAS float* red = (LAS float*)(F.lds + 12288);
        for (int i = F.tid; i < 3 * 1024; i += NTHREADS) { const int id = i >> 10, k = i & 1023; const float v = id < 2 ? c[id * 1024 + k] : cctx[k]; sv[i] = v / (1.f + __expf(-v)); }
        __syncthreads();
        float* MOD = (float*)(F.ws + WS_MOD);
        for (int it = F.bid; it < NLAYER * 96; it += F.G) {
            const int l = it / 96, nb = it % 96, n = nb * 64 + F.lane;
            const float* w = F.ka->in[IN_WMOD] + ((size_t)l * 1024 + F.wave * 128) * 6144 + n;
            float a0 = 0.f, a1 = 0.f, a2 = 0.f;
#pragma unroll 16
            for (int k = 0; k < 128; ++k) { const float wv = w[(size_t)k * 6144]; const int kk = F.wave * 128 + k; a0 += sv[kk] * wv; a1 += sv[1024 + kk] * wv; a2 += sv[2048 + kk] * wv; }
            red[(F.wave * 3 + 0) * 64 + F.lane] = a0; red[(F.wave * 3 + 1) * 64 + F.lane] = a1; red[(F.wave * 3 + 2) * 64 + F.lane] = a2;
            __syncthreads();
            if (F.tid < 192) { const int id = F.tid >> 6, ln = F.tid & 63; float s = F.ka->in[IN_BMOD][l * 6144 + nb * 64 + ln];
#pragma unroll
                for (int w8 = 0; w8 < 8; ++w8) s += red[(w8 * 3 + id) * 64 + ln];
                MOD[((size_t)l * 3 + id) * 6144 + nb * 64 + ln] = s; }
            __syncthreads();
        }
    }
    __syncthreads();
    const int gw = F.bid * NWAVES + F.wave, NGW = F.G * NWAVES, gt = F.bid * NTHREADS + F.tid, NGT = F.G * NTHREADS;
    { float* ROPE = (float*)(F.ws + WS_ROPE);
      for (int e = gt; e < 192 * 16; e += NGT) { const int idx = e >> 4, i = e & 15; const float pos = (float)(idx < 128 ? idx : idx - 128);
          const float freq = powf(10000.0f, -(float)i / 16.0f); const float ang = pos * freq; ROPE[2 * e] = cosf(ang); ROPE[2 * e + 1] = sinf(ang); } }
    { float* WG = (float*)(F.ws + WS_WG);
      for (int e = gt; e < NLAYER * 16 * 1024; e += NGT) { const int l = e >> 14, o = (e >> 10) & 15, k = e & 1023; WG[e] = F.ka->in[IN_WIN][((size_t)l * 1024 + k) * DIN + 2048 + o]; } }
    LAS float* scr = (LAS float*)(F.lds + F.wave * 16384);
    constexpr int I_IN = 16 * 89, I_OUT = 16 * 32, I_UP = 16 * 176, I_DN = 44 * 32, I_L = I_IN + I_OUT + I_UP + I_DN;
    for (int it = gw; it < NLAYER * I_L; it += NGW) {
        const int l = it / I_L; int r = it % I_L;
        if (r < I_IN) { transpose_item(F.ka->in[IN_WIN] + (size_t)l * 1024 * DIN, 1024, DIN, (bf16_t*)(F.ws + WS_WIN) + (size_t)l * PP * 1024, scr, r, F.lane,
                                       [](int n) { return n < 2048 ? n : (n < 2064 ? -1 : n - 16); }); continue; } r -= I_IN;
        if (r < I_OUT) { transpose_item(F.ka->in[IN_WOUT] + (size_t)l * 1024 * 1024, 1024, 1024, (bf16_t*)(F.ws + WS_WOUT) + (size_t)l * 1024 * 1024, scr, r, F.lane, [](int n) { return n; }); continue; } r -= I_OUT;
        if (r < I_UP) { transpose_item(F.ka->in[IN_WUP] + (size_t)l * 1024 * DFF2, 1024, DFF2, (bf16_t*)(F.ws + WS_WUP) + (size_t)l * DFF2 * 1024, scr, r, F.lane,
                                       [](int n) { const int m = n < DFF ? n : n - DFF; return (m >> 7) * 256 + (n < DFF ? 0 : 128) + (m & 127); }); continue; } r -= I_UP;
        transpose_item(F.ka->in[IN_WDN] + (size_t)l * DFF * 1024, DFF, 1024, (bf16_t*)(F.ws + WS_WDN) + (size_t)l * 1024 * DFF, scr, r, F.lane, [](int n) { return n; });
    }
}

__device__ __forceinline__ void norm_phase(Frame& F, int layer, int which, int nrows) {
    const int gw = F.bid * NWAVES + F.wave, NGW = F.G * NWAVES;
    const float* gvec = F.ka->in[which ? IN_G2 : IN_G1] + layer * 1024;
    const float* mod = (const float*)(F.ws + WS_MOD) + (size_t)layer * 3 * 6144 + (which ? 3 * 1024 : 0);
    const bool first = (layer == 0 && which == 0);
    const float* xl = first ? F.ka->in[IN_X] : F.out; const float* xc = first ? F.ka->in[IN_CTX] : (const float*)(F.ws + WS_XC);
    bf16_t* H = (bf16_t*)(F.ws + WS_H);
    const float* WG = (const float*)(F.ws + WS_WG) + (size_t)layer * 16 * 1024;
    float* GATES = (float*)(F.ws + WS_GATES);
    f32x4 gv[4];
#pragma unroll
    for (int j = 0; j < 4; ++j) gv[j] = *(const f32x4*)(gvec + 4 * F.lane + 256 * j);
    for (int rg = gw; rg < nrows / 4; rg += NGW) {
        const int row0 = rg * 4; const int id = row0 < SEQ ? 0 : (row0 < NLAT ? 1 : 2);
        const float* sh = mod + id * 6144; const float* sc = sh + 1024;
        f32x4 hv[4][4];
#pragma unroll
        for (int r = 0; r < 4; ++r) { const int row = row0 + r; const float* xr = row < NLAT ? xl + (size_t)row * DM : xc + (size_t)(row - NLAT) * DM;
#pragma unroll
            for (int j = 0; j < 4; ++j) hv[r][j] = *(const f32x4*)(xr + 4 * F.lane + 256 * j); }
#pragma unroll
        for (int r = 0; r < 4; ++r) { float s = 0.f;
#pragma unroll
            for (int j = 0; j < 4; ++j) s += (hv[r][j][0] * hv[r][j][0] + hv[r][j][1] * hv[r][j][1]) + (hv[r][j][2] * hv[r][j][2] + hv[r][j][3] * hv[r][j][3]);
            const float rstd = rsqrtf(wave_sum(s, F.lane) * (1.f / DM) + EPS);
#pragma unroll
            for (int j = 0; j < 4; ++j) { const f32x4 scv = *(const f32x4*)(sc + 4 * F.lane + 256 * j), shv = *(const f32x4*)(sh + 4 * F.lane + 256 * j);
                hv[r][j] = hv[r][j] * rstd * gv[j] * (1.f + scv) + shv;
                u32x2 w; w.x = cvtpk(hv[r][j][0], hv[r][j][1]); w.y = cvtpk(hv[r][j][2], hv[r][j][3]);
                *(u32x2*)(H + (size_t)(row0 + r) * DM + 4 * F.lane + 256 * j) = w; } }
        if (which == 0) {
            float mine[4] = {0.f, 0.f, 0.f, 0.f};
            for (int o = 0; o < 16; ++o) {
                f32x4 wv[4];
#pragma unroll
                for (int j = 0; j < 4; ++j) wv[j] = *(const f32x4*)(WG + o * 1024 + 4 * F.lane + 256 * j);
#pragma unroll
                for (int r = 0; r < 4; ++r) { float p = 0.f;
#pragma unroll
                    for (int j = 0; j < 4; ++j) p += (hv[r][j][0] * wv[j][0] + hv[r][j][1] * wv[j][1]) + (hv[r][j][2] * wv[j][2] + hv[r][j][3] * wv[j][3]);
                    p = wave_sum(p, F.lane); if (F.lane == o) mine[r] = p; }
            }
            if (F.lane < 16) {
#pragma unroll
                for (int r = 0; r < 4; ++r) GATES[(size_t)(row0 + r) * 16 + F.lane] = mine[r]; }
        }
    }
}

constexpr size_t WS_BIASG = WS_BIASIN + 64 * 1024;
__device__ __forceinline__ void bias_phase(Frame& F) {
    const int gw = F.bid * NWAVES + F.wave, NGW = F.G * NWAVES;
    const float* MOD = (const float*)(F.ws + WS_MOD);
    float* BUP = (float*)(F.ws + WS_BIASUP); float* BIN = (float*)(F.ws + WS_BIASIN); float* BG = (float*)(F.ws + WS_BIASG);
    for (int it = gw; it < 2 * DFF2 + PP + 16; it += NGW) {
        const bool isup = it < 2 * DFF2, isin = !isup && it < 2 * DFF2 + PP; const int l = isup ? it / DFF2 : 1, r = isup ? it % DFF2 : (isin ? it - 2 * DFF2 : it - 2 * DFF2 - PP);
        float wv[16];
        if (isup || isin) { const bf16_t* wrow = isup ? (const bf16_t*)(F.ws + WS_WUP) + ((size_t)l * DFF2 + r) * 1024 : (const bf16_t*)(F.ws + WS_WIN) + ((size_t)PP + r) * 1024;
            const u32x4 a = *(const u32x4*)(wrow + 16 * F.lane), b = *(const u32x4*)(wrow + 16 * F.lane + 8);
            wv[0] = bflo(a.x); wv[1] = bfhi(a.x); wv[2] = bflo(a.y); wv[3] = bfhi(a.y); wv[4] = bflo(a.z); wv[5] = bfhi(a.z); wv[6] = bflo(a.w); wv[7] = bfhi(a.w);
            wv[8] = bflo(b.x); wv[9] = bfhi(b.x); wv[10] = bflo(b.y); wv[11] = bfhi(b.y); wv[12] = bflo(b.z); wv[13] = bfhi(b.z); wv[14] = bflo(b.w); wv[15] = bfhi(b.w); }
        else { const float* wrow = (const float*)(F.ws + WS_WG) + (size_t)(16 + r) * 1024 + 16 * F.lane;
#pragma unroll
            for (int j = 0; j < 4; ++j) { const f32x4 t = *(const f32x4*)(wrow + 4 * j); wv[4 * j] = t[0]; wv[4 * j + 1] = t[1]; wv[4 * j + 2] = t[2]; wv[4 * j + 3] = t[3]; } }
        float res[3];
#pragma unroll
        for (int id = 0; id < 3; ++id) { const float* sh = MOD + ((size_t)l * 3 + id) * 6144 + (isup ? 3 * 1024 : 0) + 16 * F.lane; float p = 0.f;
#pragma unroll
            for (int j = 0; j < 4; ++j) { const f32x4 t = *(const f32x4*)(sh + 4 * j); p += (t[0] * wv[4 * j] + t[1] * wv[4 * j + 1]) + (t[2] * wv[4 * j + 2] + t[3] * wv[4 * j + 3]); }
            res[id] = wave_sum(p, F.lane); }
        if (F.lane == 0) {
            if (isup) { const int pn = r >> 8, i = r & 255; const int uc = i < 128 ? pn * 128 + i : DFF + pn * 128 + (i - 128);
                BUP[((size_t)l * 3 + 0) * DFF2 + uc] = res[0]; BUP[((size_t)l * 3 + 1) * DFF2 + uc] = res[1]; BUP[((size_t)l * 3 + 2) * DFF2 + uc] = res[2]; }
            else if (isin) { BIN[r] = res[0]; BIN[PP + r] = res[1]; BIN[2 * PP + r] = res[2]; }
            else { BG[r] = res[0]; BG[16 + r] = res[1]; BG[32 + r] = res[2]; }
        }
    }
}
__device__ __forceinline__ void gates_phase(Frame& F, int layer) {
    const int gw = F.bid * NWAVES + F.wave, NGW = F.G * NWAVES;
    const bf16_t* H = (const bf16_t*)(F.ws + WS_H); const float* SSQ = (const float*)(F.ws + WS_SSQ1);
    const float* WG = (const float*)(F.ws + WS_WG) + (size_t)layer * 16 * 1024; const float* BG = (const float*)(F.ws + WS_BIASG);
    float* GATES = (float*)(F.ws + WS_GATES);
    for (int rg = gw; rg < NROWS / 4; rg += NGW) {
        const int row0 = rg * 4; const int id = row0 < SEQ ? 0 : (row0 < NLAT ? 1 : 2);
        float hv[4][16], rs[4];
#pragma unroll
        for (int r = 0; r < 4; ++r) { const bf16_t* hr = H + (size_t)(row0 + r) * DM + 4 * F.lane;
#pragma unroll
            for (int j = 0; j < 4; ++j) { const u32x2 w = *(const u32x2*)(hr + 256 * j); hv[r][4 * j] = bflo(w.x); hv[r][4 * j + 1] = bfhi(w.x); hv[r][4 * j + 2] = bflo(w.y); hv[r][4 * j + 3] = bfhi(w.y); }
            rs[r] = rsqrtf(wave_sum(F.lane < 16 ? SSQ[(size_t)(row0 + r) * 16 + F.lane] : 0.f, F.lane) * (1.f / DM) + EPS); }
        float mine[4] = {0.f, 0.f, 0.f, 0.f};
        for (int o = 0; o < 16; ++o) {
            f32x4 wv[4];
#pragma unroll
            for (int j = 0; j < 4; ++j) wv[j] = *(const f32x4*)(WG + o * 1024 + 4 * F.lane + 256 * j);
            const float bo = BG[id * 16 + o];
#pragma unroll
            for (int r = 0; r < 4; ++r) { float p = 0.f;
#pragma unroll
                for (int j = 0; j < 4; ++j) p += (hv[r][4 * j] * wv[j][0] + hv[r][4 * j + 1] * wv[j][1]) + (hv[r][4 * j + 2] * wv[j][2] + hv[r][4 * j + 3] * wv[j][3]);
                p = wave_sum(p, F.lane) * rs[r] + bo; if (F.lane == o) mine[r] = p; }
        }
        if (F.lane < 16) {
#pragma unroll
            for (int r = 0; r < 4; ++r) GATES[(size_t)(row0 + r) * 16 + F.lane] = mine[r]; }
    }
}

__device__ __forceinline__ void postproj_phase(Frame& F, int layer) {
    const int gw = F.bid * NWAVES + F.wave, NGW = F.G * NWAVES;
    bf16_t* PROJ = (bf16_t*)(F.ws + WS_PROJ);
    const float* ROPE = (const float*)(F.ws + WS_ROPE);
    const int sub = F.lane >> 4, l16 = F.lane & 15, d = 4 * l16;
    const f32x4 gq = *(const f32x4*)(F.ka->in[IN_AQG] + layer * 64 + d), gk = *(const f32x4*)(F.ka->in[IN_AKG] + layer * 64 + d);
    for (int row = gw; row < NROWS; row += NGW) {
        const bool lat = row < NLAT; const int t = row & (SEQ - 1);
        bf16_t* pr = PROJ + (size_t)row * PP;
        f32x4 cs0 = {1.f, 0.f, 1.f, 0.f}, cs1 = {1.f, 0.f, 1.f, 0.f};
        if (lat) { const int idx = (d >> 5) ? 128 + (t & 63) : (t >> 6); const float* rp = ROPE + ((size_t)idx * 16 + (d & 15)) * 2; cs0 = *(const f32x4*)rp; cs1 = *(const f32x4*)(rp + 4); }
        const float cz[4] = {cs0[0], cs0[2], cs1[0], cs1[2]}, sz[4] = {cs0[1], cs0[3], cs1[1], cs1[3]};
        const bool x2 = (l16 & 4) != 0;
#pragma unroll
        for (int pass = 0; pass < 3; ++pass) {
            const int col = pass == 0 ? PC_AQ + 64 * sub + d : (pass == 1 ? (sub < 2 ? PC_AK + 64 * sub + d : PC_BK + 64 * (sub - 2) + d) : PC_BQ + 64 * sub + d);
            const bool donorm = pass == 0 || (pass == 1 && sub < 2);
            const bool active = lat || donorm;
            if (!lat && pass == 2) continue;
            const u32x2 w = *(const u32x2*)(pr + col);
            float v[4] = {bflo(w.x), bfhi(w.x), bflo(w.y), bfhi(w.y)};
            float ss = (v[0] * v[0] + v[1] * v[1]) + (v[2] * v[2] + v[3] * v[3]);
            ss += shfl_x(ss, 1, F.lane); ss += shfl_x(ss, 2, F.lane); ss += shfl_x(ss, 4, F.lane); ss += shfl_x(ss, 8, F.lane);
            if (donorm) { const float rstd = rsqrtf(ss * (1.f / 64.f) + EPS) * (pass == 0 ? QSCALE2 : 1.f); const f32x4 g = pass == 0 ? gq : gk;
#pragma unroll
                for (int e = 0; e < 4; ++e) v[e] = v[e] * rstd * g[e]; }
            float o[4];
#pragma unroll
            for (int e = 0; e < 4; ++e) { const float p = shfl_x(v[e], 4, F.lane); o[e] = x2 ? (p * sz[e] + v[e] * cz[e]) : (v[e] * cz[e] - p * sz[e]); }
            if (active) { u32x2 ow; ow.x = cvtpk(o[0], o[1]); ow.y = cvtpk(o[2], o[3]); *(u32x2*)(pr + col) = ow; }
        }
    }
}

__device__ __forceinline__ void groupnorm_phase(Frame& F, int layer, int nrows) {
    const int gw = F.bid * NWAVES + F.wave, NGW = F.G * NWAVES;
    bf16_t* H = (bf16_t*)(F.ws + WS_H);
    const float* gg = F.ka->in[IN_GGRP] + layer * 1024;
    f32x4 gv[4];
#pragma unroll
    for (int j = 0; j < 4; ++j) gv[j] = *(const f32x4*)(gg + 4 * F.lane + 256 * j);
    for (int row = gw; row < nrows; row += NGW) {
        bf16_t* hr = H + (size_t)row * DM + 4 * F.lane;
        u32x2 w[4];
#pragma unroll
        for (int j = 0; j < 4; ++j) w[j] = *(const u32x2*)(hr + 256 * j);
#pragma unroll
        for (int j = 0; j < 4; ++j) { float v[4] = {bflo(w[j].x), bfhi(w[j].x), bflo(w[j].y), bfhi(w[j].y)};
            const float rstd = rsqrtf(wave_sum((v[0] * v[0] + v[1] * v[1]) + (v[2] * v[2] + v[3] * v[3]), F.lane) * (1.f / 256.f) + EPS);
            u32x2 o; o.x = cvtpk(v[0] * rstd * gv[j][0], v[1] * rstd * gv[j][1]); o.y = cvtpk(v[2] * rstd * gv[j][2], v[3] * rstd * gv[j][3]);
            *(u32x2*)(hr + 256 * j) = o; }
    }
}

__device__ __forceinline__ void fixup_phase(Frame& F, int layer, int nht) {
    const int gt = F.bid * NTHREADS + F.tid, NGT = F.G * NTHREADS;
    const float* edge = (const float*)(F.ws + WS_EDGE);
    const float* cw = F.ka->in[IN_CONVW] + (size_t)layer * 3 * DFF2; const float* cb = F.ka->in[IN_CONVB] + (size_t)layer * DFF2;
    bf16_t* act = (bf16_t*)(F.ws + WS_PROJ);
    const int per_row = DFF / 4;
    for (int it = gt; it < nht * 2 * per_row; it += NGT) {
        const int ch = (it % per_row) * 4, rr = it / per_row, ht = rr >> 1, last = rr & 1;
        const bool seq_start = (ht == 0 || ht == 64 || ht == 128 || ht == 130), seq_end = (ht == 63 || ht == 127 || ht == 129 || ht == 131);
        const int row = ht * 128 + (last ? 127 : 0);
        f32x4 o;
        f32x4 res[2];
#pragma unroll
        for (int gvv = 0; gvv < 2; ++gvv) { const int uc = gvv * DFF + ch;
            const f32x4 z = {0.f, 0.f, 0.f, 0.f};
            f32x4 up, ucur, un;
            if (!last) { up = seq_start ? z : *(const f32x4*)(edge + ((size_t)(ht - 1) * 4 + 3) * DFF2 + uc); ucur = *(const f32x4*)(edge + ((size_t)ht * 4 + 0) * DFF2 + uc); un = *(const f32x4*)(edge + ((size_t)ht * 4 + 1) * DFF2 + uc); }
            else { up = *(const f32x4*)(edge + ((size_t)ht * 4 + 2) * DFF2 + uc); ucur = *(const f32x4*)(edge + ((size_t)ht * 4 + 3) * DFF2 + uc); un = seq_end ? z : *(const f32x4*)(edge + ((size_t)(ht + 1) * 4 + 0) * DFF2 + uc); }
            res[gvv] = *(const f32x4*)(cw + uc) * up + *(const f32x4*)(cw + DFF2 + uc) * ucur + *(const f32x4*)(cw + 2 * DFF2 + uc) * un + *(const f32x4*)(cb + uc); }
#pragma unroll
        for (int j = 0; j < 4; ++j) o[j] = res[0][j] / (1.f + __expf(-res[0][j])) * res[1][j];
        u32x2 w; w.x = cvtpk(o[0], o[1]); w.y = cvtpk(o[2], o[3]);
        *(u32x2*)(act + (size_t)row * DFF + ch) = w;
    }
}

__device__ __forceinline__ void final_phase(Frame& F) {
    const int gw = F.bid * NWAVES + F.wave, NGW = F.G * NWAVES;
    const float* gf = F.ka->in[IN_GFIN];
    f32x4 gv[4];
#pragma unroll
    for (int j = 0; j < 4; ++j) gv[j] = *(const f32x4*)(gf + 4 * F.lane + 256 * j);
    for (int row = gw; row < NLAT; row += NGW) {
        float* xr = F.out + (size_t)row * DM + 4 * F.lane;
        f32x4 v[4]; float s = 0.f;
#pragma unroll
        for (int j = 0; j < 4; ++j) { v[j] = *(const f32x4*)(xr + 256 * j); s += (v[j][0] * v[j][0] + v[j][1] * v[j][1]) + (v[j][2] * v[j][2] + v[j][3] * v[j][3]); }
        const float rstd = rsqrtf(wave_sum(s, F.lane) * (1.f / DM) + EPS);
#pragma unroll
        for (int j = 0; j < 4; ++j) *(f32x4*)(xr + 256 * j) = v[j] * rstd * gv[j];
    }
}

typedef GAS unsigned gu32;
#define RLX_AGENT __ATOMIC_RELAXED, __HIP_MEMORY_SCOPE_AGENT
constexpr int CW_BAR = 4096;
#define XB_TMO      128
#define XB_XCNT(j)  (256  + 64 * (j))
#define XB_XSUB(j)  (1280 + 64 * (j))
#define XB_XGEN(j)  (2304 + 64 * (j))
#define XB_TOP      3328
#define XB_TOPGEN   3392
#define XCD_BAR_WORDS 3456
#define XB_SPIN_CAP (1u << 18)

__device__ __forceinline__ unsigned xb_ld(unsigned* p)              { return __hip_atomic_load(p, __ATOMIC_RELAXED, __HIP_MEMORY_SCOPE_AGENT); }
__device__ __forceinline__ unsigned xb_add(unsigned* p, unsigned v) { return __hip_atomic_fetch_add(p, v, __ATOMIC_RELAXED, __HIP_MEMORY_SCOPE_AGENT); }
__device__ __forceinline__ unsigned xb_xcc_id() { return (unsigned)__builtin_amdgcn_s_getreg((3 << 11) | 20) & 0xFu; }
#define XB_SPIN(cond, bar) do { unsigned _sp = 0; while (cond) { __builtin_amdgcn_s_sleep(1); \
    if ((++_sp & 255u) == 0u) { if (xb_ld(&(bar)[XB_TMO])) break; if (_sp > XB_SPIN_CAP) { atomicAdd(&(bar)[XB_TMO], 1u); break; } } } } while (0)

struct XcdBarrier {
    unsigned* bar; unsigned x;
    volatile LAS unsigned* st;
};

__device__ __forceinline__ XcdBarrier xcd_barrier_post(unsigned* bar, volatile LAS unsigned* st, bool is_t0) {
    XcdBarrier b; b.bar = bar; b.x = xb_xcc_id(); b.st = st;
    if (is_t0) (void)xb_add(&bar[XB_XCNT(b.x)], 1u);
    return b;
}
__device__ __forceinline__ void xcd_barrier_complete(unsigned* bar, unsigned x, unsigned& nloc, unsigned& nx) {
    const unsigned G = gridDim.x * gridDim.y * gridDim.z;
    unsigned sum, cnt, mine, sp = 0u;
    for (;;) {
        sum = 0u; cnt = 0u; mine = 0u;
#pragma unroll
        for (unsigned j = 0; j < 16; ++j) { const unsigned c = xb_ld(&bar[XB_XCNT(j)]); sum += c; cnt += (c > 0u) ? 1u : 0u; mine = (j == x) ? c : mine; }
        if (sum == G) break;
        __builtin_amdgcn_s_sleep(1);
        if ((++sp & 255u) == 0u) { if (xb_ld(&bar[XB_TMO])) break; if (sp > XB_SPIN_CAP) { atomicAdd(&bar[XB_TMO], 1u); break; } }
    }
    nloc = mine > 0u ? mine : 1u; nx = cnt > 0u ? cnt : 1u;
}

__device__ __forceinline__ void xcd_barrier(const XcdBarrier& b, bool is_t0) {
    asm volatile("s_waitcnt vmcnt(0)" ::: "memory");
    __syncthreads();
    if (is_t0) {
        unsigned* bar = b.bar;
        __builtin_amdgcn_s_waitcnt(0);
        unsigned nloc = b.st[0], nx = b.st[1];
        if (nloc == 0u) { xcd_barrier_complete(bar, b.x, nloc, nx); b.st[0] = nloc; b.st[1] = nx; }
        const unsigned old = xb_add(&bar[XB_XSUB(b.x)], 1u);
        const unsigned gen = old / nloc;
        if (old + 1u == (gen + 1u) * nloc) {
            __builtin_amdgcn_fence(__ATOMIC_RELEASE, "agent");
            asm volatile("s_waitcnt vmcnt(0)" ::: "memory");
            const unsigned og = xb_add(&bar[XB_TOP], 1u);
            const unsigned tg = og / nx;
            if (og + 1u == (tg + 1u) * nx) xb_add(&bar[XB_TOPGEN], 1u);
            else XB_SPIN(xb_ld(&bar[XB_TOPGEN]) == tg, bar);
            __builtin_amdgcn_fence(__ATOMIC_ACQUIRE, "agent");
            xb_add(&bar[XB_XGEN(b.x)], 1u);
            asm volatile("s_waitcnt vmcnt(0)" ::: "memory");
        } else {
            XB_SPIN(xb_ld(&bar[XB_XGEN(b.x)]) == gen, bar);
            __builtin_amdgcn_fence(__ATOMIC_ACQUIRE, "agent");
            asm volatile("s_waitcnt vmcnt(0)" ::: "memory");
        }
    }
    __syncthreads();
}

namespace att {
constexpr int SLOTB = 8192;
constexpr int L_K = 0, L_V = 2 * SLOTB, L_WS = 4 * SLOTB, L_OST = L_WS + 8 * 256, L_RPB = L_OST + 8 * 4096, L_END = L_RPB + 2048;
constexpr float THR = 8.0f;
__device__ __forceinline__ int crow(int r, int hi) { return (r & 3) + 8 * (r >> 2) + 4 * hi; }
__device__ __forceinline__ s16x4 vtr(const LAS unsigned char* p) { return __builtin_bit_cast(s16x4, __builtin_amdgcn_ds_read_tr16_b64_v4i16((LAS v4i16_t*)p)); }
__device__ __forceinline__ float rowmax32(const f32x16& p0, const f32x16& p1) {
    float a = fmaxf(p0[0], p1[0]);
#pragma unroll
    for (int r = 1; r < 16; ++r) a = fmaxf(a, fmaxf(p0[r], p1[r]));
    auto rr = __builtin_amdgcn_permlane32_swap(__float_as_uint(a), __float_as_uint(a), false, false);
    return fmaxf(__uint_as_float(rr[0]), __uint_as_float(rr[1]));
}
__device__ __forceinline__ float halfsum(float v) {
    auto rr = __builtin_amdgcn_permlane32_swap(__float_as_uint(v), __float_as_uint(v), false, false);
    return __uint_as_float(rr[0]) + __uint_as_float(rr[1]);
}
#define ATT_WAIT_BAR() asm volatile("s_waitcnt vmcnt(0) lgkmcnt(0)\n\ts_barrier" ::: "memory")

template <int MODE>
__device__ __forceinline__ void attn_unit(Frame& F, int b, int h, int qb, int qcol, int kcol, int vcol, int ycol, float sink2, const float* rpb) {
    LAS unsigned char* lds = F.lds;
    const int lane = F.lane, r32 = lane & 31, hi = lane >> 5, wid = F.wave;
    const bf16_t* PROJ = (const bf16_t*)(F.ws + WS_PROJ); bf16_t* Y = (bf16_t*)(F.ws + WS_H);
    const int ctxrow = NLAT + CTXL * b, latrow = SEQ * b;
    const int qrow0 = (MODE == 3) ? ctxrow : latrow + 256 * qb;
    const int qw0 = 256 * qb + 32 * wid;
    int lt_lo = 0, nloc = 0;
    if (MODE == 0) { lt_lo = 0; nloc = 128; }
    if (MODE == 1) { const int a = (256 * qb - 128) >> 6, e = (256 * qb + 255 + 128) >> 6; lt_lo = a < 0 ? 0 : a; nloc = (e > 127 ? 127 : e) - lt_lo + 1; }
    if (MODE == 2) { const int a = 4 * qb - 4, e0 = 4 * qb - 1; lt_lo = a < 0 ? 0 : (a > 120 ? 120 : a); const int e = (e0 < 0 ? 0 : (e0 > 120 ? 120 : e0)) + 7; nloc = e - lt_lo + 1; }
    const int NT = 4 + nloc;
    const int rw = 4 * qb + (wid >> 1); const int rs = rw - 4 < 0 ? 0 : (rw - 4 > 120 ? 120 : rw - 4);
    const int qc = 32 * (wid & 1) + r32; const int cs = qc - 8 < 0 ? 0 : (qc - 8 > 48 ? 48 : qc - 8);
    LAS float* wsf = (LAS float*)(lds + L_WS) + wid * 64;
    LAS float* rpbL = (LAS float*)(lds + L_RPB);
    if (MODE == 2) { for (int i = F.tid; i < 465; i += NTHREADS) rpbL[i] = rpb[i] * LOG2E; }
    const int vp0 = ((lane >> 4) & 1) * 32 + (lane & 3) * 8 + (4 * hi + ((lane & 15) >> 2)) * 64;
#define ATT_KROW(t) ((t) < 4 ? ctxrow + 64 * (t) : latrow + 64 * (lt_lo + (t) - 4))
#define ATT_DMA(t, slot) do { const int kr_ = ATT_KROW(t); \
        __builtin_amdgcn_global_load_lds((const unsigned*)(PROJ + (size_t)(kr_ + lane) * PP + kcol + wid * 8), (LAS unsigned*)(lds + L_K + (slot) * SLOTB + wid * 1024), 16, 0, 0); \
        __builtin_amdgcn_global_load_lds((const unsigned*)(PROJ + (size_t)(kr_ + 16 * (wid & 3) + (lane >> 2)) * PP + vcol + (wid >> 2) * 32 + (lane & 3) * 8), (LAS unsigned*)(lds + L_V + (slot) * SLOTB + wid * 1024), 16, 0, 0); } while (0)
    ATT_DMA(0, 0);
    bf16x8 qr[4];
#pragma unroll
    for (int d0 = 0; d0 < 4; ++d0) qr[d0] = *(const bf16x8*)(PROJ + (size_t)(qrow0 + 32 * wid + r32) * PP + qcol + d0 * 16 + hi * 8);
    float mhat = 0.f, l = 0.f; f32x16 o0 = {}, o1 = {}, negm = {};
    ATT_WAIT_BAR();
    for (int t = 0; t < NT; ++t) {
        const int slot = t & 1;
        if (t + 1 < NT) ATT_DMA(t + 1, slot ^ 1);
        bool rel = true; int kb0 = 0;
        if (MODE == 1 && t >= 4) { kb0 = 64 * (lt_lo + t - 4); rel = (kb0 + 63 >= qw0 - 128) && (kb0 <= qw0 + 31 + 128); }
        if (MODE == 2 && t >= 4) { kb0 = lt_lo + t - 4; rel = (kb0 >= rs) && (kb0 < rs + 8); }
        if (rel) {
            const LAS unsigned char* kb = lds + L_K + slot * SLOTB + hi * 1024 + r32 * 16;
            f32x16 p0 = negm, p1 = negm;
#pragma unroll
            for (int d0 = 0; d0 < 4; ++d0) {
                const bf16x8 b0 = *(const LAS bf16x8*)(kb + d0 * 2048), b1 = *(const LAS bf16x8*)(kb + d0 * 2048 + 512);
                p0 = __builtin_amdgcn_mfma_f32_32x32x16_bf16(b0, qr[d0], p0, 0, 0, 0);
                p1 = __builtin_amdgcn_mfma_f32_32x32x16_bf16(b1, qr[d0], p1, 0, 0, 0);
            }
            if (MODE == 1 && t >= 4) {
                const int dq = kb0 - (qw0 + r32);
#pragma unroll
                for (int r = 0; r < 16; ++r) { const int kc = crow(r, hi); const int d0_ = dq + kc, d1_ = d0_ + 32;
                    if (d0_ > 128 || d0_ < -128) p0[r] = -INFINITY; if (d1_ > 128 || d1_ < -128) p1[r] = -INFINITY; }
            }
            if (MODE == 2 && t >= 4) {
                const LAS float* bt = rpbL + (kb0 - rw + 7) * 31 + (15 - qc);
#pragma unroll
                for (int r = 0; r < 16; ++r) { const int kc = crow(r, hi);
                    const bool v0 = (kc >= cs) && (kc < cs + 16), v1 = (kc + 32 >= cs) && (kc + 32 < cs + 16);
                    p0[r] = v0 ? p0[r] + bt[v0 ? kc : qc] : -INFINITY; p1[r] = v1 ? p1[r] + bt[v1 ? kc + 32 : qc] : -INFINITY; }
            }
            const float rm = rowmax32(p0, p1);
            if (t == 0 || __any(rm > THR)) {
                const float dl = (t == 0) ? rm : fmaxf(rm, 0.f);
                mhat += dl;
#pragma unroll
                for (int r = 0; r < 16; ++r) { p0[r] -= dl; p1[r] -= dl; negm[r] = -mhat; }
                if (t > 0) { const float f = __builtin_amdgcn_exp2f(-dl); l *= f; if (hi == 0) wsf[r32] = f; LDS_WAIT();
#pragma unroll
                    for (int r = 0; r < 16; ++r) { const float fr_ = wsf[crow(r, hi)]; o0[r] *= fr_; o1[r] *= fr_; }
                    LDS_WAIT(); }
            }
            float ls = 0.f;
#pragma unroll
            for (int r = 0; r < 16; ++r) { p0[r] = __builtin_amdgcn_exp2f(p0[r]); p1[r] = __builtin_amdgcn_exp2f(p1[r]); ls += p0[r] + p1[r]; }
            l += ls;
            u32x4 pw[4];
#pragma unroll
            for (int k = 0; k < 4; ++k) { pw[0][k] = cvtpk(p0[2 * k], p0[2 * k + 1]); pw[1][k] = cvtpk(p0[8 + 2 * k], p0[9 + 2 * k]); pw[2][k] = cvtpk(p1[2 * k], p1[2 * k + 1]); pw[3][k] = cvtpk(p1[8 + 2 * k], p1[9 + 2 * k]); }
            const LAS unsigned char* vb = lds + L_V + slot * SLOTB + vp0;
#pragma unroll
            for (int ks = 0; ks < 4; ++ks) {
                const s16x4 a0 = vtr(vb + ks * 1024), a1 = vtr(vb + ks * 1024 + 512), c0 = vtr(vb + 4096 + ks * 1024), c1 = vtr(vb + 4096 + ks * 1024 + 512);
                const bf16x8 v0 = {a0[0], a0[1], a0[2], a0[3], a1[0], a1[1], a1[2], a1[3]}, v1 = {c0[0], c0[1], c0[2], c0[3], c1[0], c1[1], c1[2], c1[3]};
                o0 = __builtin_amdgcn_mfma_f32_32x32x16_bf16(__builtin_bit_cast(bf16x8, pw[ks]), v0, o0, 0, 0, 0);
                o1 = __builtin_amdgcn_mfma_f32_32x32x16_bf16(__builtin_bit_cast(bf16x8, pw[ks]), v1, o1, 0, 0, 0);
            }
        }
        ATT_WAIT_BAR();
    }
    l = halfsum(l);
    if (MODE == 1 || MODE == 3) l += __builtin_amdgcn_exp2f(sink2 - mhat);
    if (hi == 0) wsf[32 + r32] = l;
    LDS_WAIT();
    bf16_t* stg = (bf16_t*)(lds + L_OST + wid * 4096);
    LAS bf16_t* stgl = (LAS bf16_t*)(lds + L_OST + wid * 4096);
#pragma unroll
    for (int r = 0; r < 16; ++r) { const int orow = crow(r, hi); const float rl = __builtin_amdgcn_rcpf(wsf[32 + orow]);
        stgl[orow * 64 + r32] = (bf16_t)(cvtpk(o0[r] * rl, 0.f) & 0xffffu); stgl[orow * 64 + 32 + r32] = (bf16_t)(cvtpk(o1[r] * rl, 0.f) & 0xffffu); }
    LDS_WAIT();
    (void)stg;
#pragma unroll
    for (int i = 0; i < 4; ++i) { const int row = i * 8 + (lane >> 3), ch = lane & 7; const u32x4 v = *(const LAS u32x4*)(stgl + row * 64 + ch * 8);
        *(u32x4*)(Y + (size_t)(qrow0 + 32 * wid + row) * DM + ycol + ch * 8) = v; }
    LDS_WAIT();
#undef ATT_KROW
#undef ATT_DMA
}
}

namespace ml {
__device__ __forceinline__ float scan_add(float v, int lane, int dir) {
#pragma unroll
    for (int o = 1; o < 64; o <<= 1) { const float t = shfl_idx(v, (dir ? lane + o : lane - o) & 63); const bool ok = dir ? (lane + o < 64) : (lane >= o); v += ok ? t : 0.f; }
    return v;
}
__device__ __forceinline__ float scan_max(float v, int lane, int dir) {
#pragma unroll
    for (int o = 1; o < 64; o <<= 1) { const float t = shfl_idx(v, (dir ? lane + o : lane - o) & 63); const bool ok = dir ? (lane + o < 64) : (lane >= o); v = ok ? fmaxf(v, t) : v; }
    return v;
}
__device__ __forceinline__ float logsigmoid(float x) { return fminf(x, 0.f) - log1pf(__expf(-fabsf(x))); }
__device__ __forceinline__ int img_off(int tok, int d) { return (d >> 5) * 4096 + (tok >> 4) * 1024 + (tok & 15) * 64 + (d & 31) * 2; }
__device__ __forceinline__ int blk_row0(int b, int blk) { return blk < 4 ? NLAT + CTXL * b + 64 * blk : SEQ * b + 64 * (blk - 4); }
__device__ __forceinline__ int chunk_of(int dir, int blk) { return dir == 0 ? blk : (blk < 4 ? 3 - blk : 4 + 127 - (blk - 4)); }

__device__ __forceinline__ void pass1(Frame& F, int layer) {
    const int gw = F.bid * NWAVES + F.wave, NGW = F.G * NWAVES, lane = F.lane, r32 = lane & 31, hi = lane >> 5;
    LAS unsigned char* wl = F.lds + F.wave * 16384;
    const bf16_t* PROJ = (const bf16_t*)(F.ws + WS_PROJ); const float* GATES = (const float*)(F.ws + WS_GATES);
    const float* gb = F.ka->in[IN_CGB] + layer * 16;
    float* DS = (float*)(F.ws + WS_DS); float* ZD = (float*)(F.ws + WS_ZD); float* GC = (float*)(F.ws + WS_GC); float* ML = (float*)(F.ws + WS_ML);
    const int vp0 = ((lane >> 4) & 1) * 32 + (lane & 3) * 8 + (4 * hi + ((lane & 15) >> 2)) * 64;
    for (int wu = gw; wu < NCHAIN * NCHUNK; wu += NGW) {
        const int chain = wu / NCHUNK, c = wu % NCHUNK, dir = chain & 1, h = (chain >> 1) & 3, b = chain >> 3;
        const int row0 = blk_row0(b, chunk_of(dir, c));
        const float gi = GATES[(size_t)(row0 + lane) * 16 + dir * 8 + h] + gb[dir * 8 + h];
        const float lf = logsigmoid(GATES[(size_t)(row0 + lane) * 16 + dir * 8 + 4 + h] + gb[dir * 8 + 4 + h]);
        const float cum = scan_add(lf, lane, dir);
        const float G = wave_sum(lf, lane);
        const float bb = gi - cum, mloc = wave_max(bb, lane), w = __expf(bb - mloc);
#pragma unroll
        for (int it = 0; it < 8; ++it) { const int tok = (lane >> 3) + 8 * it, d = 8 * (lane & 7);
            const u32x4 kv = *(const u32x4*)(PROJ + (size_t)(row0 + tok) * PP + PC_CK + 64 * h + d), vv = *(const u32x4*)(PROJ + (size_t)(row0 + tok) * PP + PC_CV + 64 * h + d);
            const float wt = shfl_idx(w, tok);
            u32x4 ko; ko.x = cvtpk(bflo(kv.x) * wt, bfhi(kv.x) * wt); ko.y = cvtpk(bflo(kv.y) * wt, bfhi(kv.y) * wt); ko.z = cvtpk(bflo(kv.z) * wt, bfhi(kv.z) * wt); ko.w = cvtpk(bflo(kv.w) * wt, bfhi(kv.w) * wt);
            *(LAS u32x4*)(wl + img_off(tok, d)) = vv; *(LAS u32x4*)(wl + 8192 + img_off(tok, d)) = ko; }
        LDS_WAIT();
        f32x16 acc[2][2] = {};
#pragma unroll
        for (int s = 0; s < 4; ++s) {
            bf16x8 af[2], bfr[2];
#pragma unroll
            for (int x = 0; x < 2; ++x) { const s16x4 a0 = att::vtr(wl + vp0 + x * 4096 + s * 1024), a1 = att::vtr(wl + vp0 + x * 4096 + s * 1024 + 512);
                const s16x4 c0 = att::vtr(wl + 8192 + vp0 + x * 4096 + s * 1024), c1 = att::vtr(wl + 8192 + vp0 + x * 4096 + s * 1024 + 512);
                af[x] = (bf16x8){a0[0], a0[1], a0[2], a0[3], a1[0], a1[1], a1[2], a1[3]}; bfr[x] = (bf16x8){c0[0], c0[1], c0[2], c0[3], c1[0], c1[1], c1[2], c1[3]}; }
#pragma unroll
            for (int vb = 0; vb < 2; ++vb)
#pragma unroll
                for (int kb = 0; kb < 2; ++kb) acc[vb][kb] = __builtin_amdgcn_mfma_f32_32x32x16_bf16(af[vb], bfr[kb], acc[vb][kb], 0, 0, 0);
        }
        float* dsp = DS + (size_t)(chain * NCHUNK + c) * 4096;
#pragma unroll
        for (int vb = 0; vb < 2; ++vb)
#pragma unroll
            for (int kb = 0; kb < 2; ++kb)
#pragma unroll
                for (int r = 0; r < 16; ++r) dsp[(32 * vb + att::crow(r, hi)) * 64 + 32 * kb + r32] = acc[vb][kb][r];
        float z = 0.f;
#pragma unroll 8
        for (int tok = 0; tok < 64; ++tok) z += bf2f(*(const LAS bf16_t*)(wl + 8192 + img_off(tok, lane)));
        ZD[(size_t)(chain * NCHUNK + c) * 64 + lane] = z;
        if (lane == 0) { GC[chain * NCHUNK + c] = G; ML[chain * NCHUNK + c] = mloc; }
        LDS_WAIT();
    }
}

__device__ __forceinline__ void pass2(Frame& F) {
    const float* DS = (const float*)(F.ws + WS_DS); const float* ZD = (const float*)(F.ws + WS_ZD); const float* GC = (const float*)(F.ws + WS_GC); const float* ML = (const float*)(F.ws + WS_ML);
    bf16_t* SBF = (bf16_t*)(F.ws + WS_SBF); float* ZC = (float*)(F.ws + WS_ZC); float* MC = (float*)(F.ws + WS_MC);
    LAS float* cf = (LAS float*)F.lds;
    for (int it = F.bid; it < NCHAIN * 16; it += F.G) {
        const int chain = it >> 4, part = it & 15;
        __syncthreads();
        if (F.wave == 0) {
            const int ln = F.lane; const bool valid = ln < 44; float g[3], mlv[3];
#pragma unroll
            for (int j = 0; j < 3; ++j) { g[j] = valid ? GC[chain * NCHUNK + 3 * ln + j] : 0.f; mlv[j] = valid ? ML[chain * NCHUNK + 3 * ln + j] : -INFINITY; }
            const float tot = g[0] + g[1] + g[2]; const float excl = ml::scan_add(tot, ln, 0) - tot;
            const float pg[3] = {excl, excl + g[0], excl + g[0] + g[1]};
            const float a0 = mlv[0] - pg[0], a1 = mlv[1] - pg[1], a2 = mlv[2] - pg[2];
            const float inclm = ml::scan_max(fmaxf(a0, fmaxf(a1, a2)), ln, 0); float exclm = shfl_idx(inclm, (ln - 1) & 63); if (ln == 0) exclm = -INFINITY;
            const float em[3] = {exclm, fmaxf(exclm, a0), fmaxf(fmaxf(exclm, a0), a1)};
#pragma unroll
            for (int j = 0; j < 3; ++j) { const int c = 3 * ln + j; const float m = pg[j] + fmaxf(0.f, em[j]); const float mn = fmaxf(g[j] + m, g[j] + mlv[j]);
                if (valid) { cf[2 * c] = __expf(g[j] + m - mn); cf[2 * c + 1] = __expf(g[j] + mlv[j] - mn); if (part == 0) MC[chain * NCHUNK + c] = m; } }
        }
        __syncthreads();
        if (F.tid < 256) {
            const int e = part * 256 + F.tid; const float* dp = DS + (size_t)chain * NCHUNK * 4096 + e; bf16_t* sp = SBF + (size_t)chain * NCHUNK * 4096 + e;
            float s = 0.f;
            for (int c0 = 0; c0 < NCHUNK; c0 += 12) { float d[12];
#pragma unroll
                for (int j = 0; j < 12; ++j) d[j] = dp[(size_t)(c0 + j) * 4096];
#pragma unroll
                for (int j = 0; j < 12; ++j) { sp[(size_t)(c0 + j) * 4096] = (bf16_t)(cvtpk(s, 0.f) & 0xffffu); s = cf[2 * (c0 + j)] * s + cf[2 * (c0 + j) + 1] * d[j]; } }
        } else if (F.tid < 260) {
            const int e = part * 4 + (F.tid - 256); const float* dp = ZD + (size_t)chain * NCHUNK * 64 + e; float* zp = ZC + (size_t)chain * NCHUNK * 64 + e;
            float s = 0.f;
            for (int c = 0; c < NCHUNK; ++c) { const float d = dp[(size_t)c * 64]; zp[(size_t)c * 64] = s; s = cf[2 * c] * s + cf[2 * c + 1] * d; }
        }
    }
    __syncthreads();
}

__device__ __forceinline__ void pass3(Frame& F, int layer, int blk_lo) {
    const int gw = F.bid * NWAVES + F.wave, NGW = F.G * NWAVES, lane = F.lane, r32_ = lane & 31, hi_ = lane >> 5;
    LAS unsigned char* wl = F.lds + F.wave * 19456;
    LAS float* bvec = (LAS float*)(wl + 16384); LAS float* Apl = bvec + 128; LAS float* efl = bvec + 256; LAS float* fll = bvec + 384; LAS float* zl = bvec + 512; LAS float* rden = bvec + 640;
    LAS float* st = (LAS float*)(wl + 8192);
    const bf16_t* PROJ = (const bf16_t*)(F.ws + WS_PROJ); const float* GATES = (const float*)(F.ws + WS_GATES);
    const float* gb = F.ka->in[IN_CGB] + layer * 16;
    const bf16_t* SBF = (const bf16_t*)(F.ws + WS_SBF); const float* ZC = (const float*)(F.ws + WS_ZC); const float* MC = (const float*)(F.ws + WS_MC);
    bf16_t* Y = (bf16_t*)(F.ws + WS_H);
    const int vp0 = ((lane >> 4) & 1) * 32 + (lane & 3) * 8 + (4 * hi_ + ((lane & 15) >> 2)) * 64;
    const int nblk = NCHUNK - blk_lo;
    for (int wu = gw; wu < 8 * nblk; wu += NGW) {
        const int bh = wu / nblk, blk = blk_lo + wu % nblk, b = bh >> 2, h = bh & 3;
        const int row0 = blk_row0(b, blk);
        LDS_WAIT();
#pragma unroll
        for (int it = 0; it < 8; ++it) { const int tok = (lane >> 3) + 8 * it, d = 8 * (lane & 7);
            *(LAS u32x4*)(wl + img_off(tok, d)) = *(const u32x4*)(PROJ + (size_t)(row0 + tok) * PP + PC_CV + 64 * h + d); }
#pragma unroll
        for (int dir = 0; dir < 2; ++dir) {
            const int c = chunk_of(dir, blk), chain = (b * 4 + h) * 2 + dir;
            const float gi = GATES[(size_t)(row0 + lane) * 16 + dir * 8 + h] + gb[dir * 8 + h];
            const float lf = logsigmoid(GATES[(size_t)(row0 + lane) * 16 + dir * 8 + 4 + h] + gb[dir * 8 + 4 + h]);
            const float cum = scan_add(lf, lane, dir);
            const float bb = gi - cum, pm = scan_max(bb, lane, dir), mc = MC[chain * NCHUNK + c];
            const float Apv = fmaxf(mc, pm);
            zl[dir * 64 + lane] = ZC[(size_t)(chain * NCHUNK + c) * 64 + lane];
            bvec[dir * 64 + lane] = bb; Apl[dir * 64 + lane] = Apv; efl[dir * 64 + lane] = __expf(mc - Apv); fll[dir * 64 + lane] = __expf(-(cum + Apv));
        }
        LDS_WAIT();
#pragma unroll 1
        for (int tb = 0; tb < 2; ++tb) {
            int r32 = r32_, hi = hi_; asm volatile("" : "+v"(r32), "+v"(hi));
            const int t = 32 * tb + r32;
            bf16x8 qf[4];
#pragma unroll
            for (int d0 = 0; d0 < 4; ++d0) qf[d0] = *(const bf16x8*)(PROJ + (size_t)(row0 + t) * PP + PC_CQ + 64 * h + 16 * d0 + 8 * hi);
            f32x16 hs0 = {}, hs1 = {};
#pragma unroll 1
            for (int dir = 0; dir < 2; ++dir) {
                const int c = chunk_of(dir, blk), chain = (b * 4 + h) * 2 + dir;
                const bf16_t* Sp = SBF + (size_t)(chain * NCHUNK + c) * 4096; const LAS float* zp = zl + dir * 64;
                int r32 = r32_, hi = hi_; asm volatile("" : "+v"(r32), "+v"(hi));
                const float Ap_t = Apl[dir * 64 + t], e_t = efl[dir * 64 + t], fl_t = fll[dir * 64 + t];
                f32x16 P0 = {}, P1 = {};
#pragma unroll
                for (int d0 = 0; d0 < 4; ++d0) {
                    const bf16x8 k0 = *(const bf16x8*)(PROJ + (size_t)(row0 + r32) * PP + PC_CK + 64 * h + 16 * d0 + 8 * hi), k1 = *(const bf16x8*)(PROJ + (size_t)(row0 + 32 + r32) * PP + PC_CK + 64 * h + 16 * d0 + 8 * hi);
                    P0 = __builtin_amdgcn_mfma_f32_32x32x16_bf16(k0, qf[d0], P0, 0, 0, 0); P1 = __builtin_amdgcn_mfma_f32_32x32x16_bf16(k1, qf[d0], P1, 0, 0, 0); }
                float den = 0.f;
#pragma unroll
                for (int r = 0; r < 16; ++r) { const int s0 = att::crow(r, hi), s1 = 32 + s0; const bool ok0 = dir ? (s0 >= t) : (s0 <= t), ok1 = dir ? (s1 >= t) : (s1 <= t);
                    const float w0 = ok0 ? __expf(bvec[dir * 64 + s0] - Ap_t) : 0.f, w1 = ok1 ? __expf(bvec[dir * 64 + s1] - Ap_t) : 0.f;
                    P0[r] *= w0; P1[r] *= w1; den += P0[r] + P1[r]; }
                u32x4 pw[4];
#pragma unroll
                for (int k = 0; k < 4; ++k) { pw[0][k] = cvtpk(P0[2 * k], P0[2 * k + 1]); pw[1][k] = cvtpk(P0[8 + 2 * k], P0[9 + 2 * k]); pw[2][k] = cvtpk(P1[2 * k], P1[2 * k + 1]); pw[3][k] = cvtpk(P1[8 + 2 * k], P1[9 + 2 * k]); }

                f32x16 n0 = {}, n1 = {}; float zq = 0.f;
#pragma unroll
                for (int d0 = 0; d0 < 4; ++d0) { const u32x4 qw = __builtin_bit_cast(u32x4, qf[d0]); u32x4 o;
                    const f32x4 za = *(const LAS f32x4*)(zp + 16 * d0 + 8 * hi), zb = *(const LAS f32x4*)(zp + 16 * d0 + 8 * hi + 4);
                    const float q0 = bflo(qw.x), q1 = bfhi(qw.x), q2 = bflo(qw.y), q3 = bfhi(qw.y), q4 = bflo(qw.z), q5 = bfhi(qw.z), q6 = bflo(qw.w), q7 = bfhi(qw.w);
                    zq += (q0 * za[0] + q1 * za[1]) + (q2 * za[2] + q3 * za[3]) + (q4 * zb[0] + q5 * zb[1]) + (q6 * zb[2] + q7 * zb[3]);
                    o.x = cvtpk(q0 * e_t, q1 * e_t); o.y = cvtpk(q2 * e_t, q3 * e_t); o.z = cvtpk(q4 * e_t, q5 * e_t); o.w = cvtpk(q6 * e_t, q7 * e_t);
                    const bf16x8 qs = __builtin_bit_cast(bf16x8, o);
                    const bf16x8 s0 = *(const bf16x8*)(Sp + (size_t)r32 * 64 + 16 * d0 + 8 * hi), s1 = *(const bf16x8*)(Sp + (size_t)(32 + r32) * 64 + 16 * d0 + 8 * hi);
                    n0 = __builtin_amdgcn_mfma_f32_32x32x16_bf16(qs, s0, n0, 0, 0, 0); n1 = __builtin_amdgcn_mfma_f32_32x32x16_bf16(qs, s1, n1, 0, 0, 0); }

                den = att::halfsum(den) + e_t * att::halfsum(zq);
                const float rd = 1.f / fmaxf(fabsf(den), fl_t);
                LDS_WAIT(); if (hi == 0) rden[r32] = rd; LDS_WAIT();
#pragma unroll
                for (int ks = 0; ks < 4; ++ks) {
                    const s16x4 a0 = att::vtr(wl + vp0 + ks * 1024), a1 = att::vtr(wl + vp0 + ks * 1024 + 512), c0 = att::vtr(wl + vp0 + 4096 + ks * 1024), c1 = att::vtr(wl + vp0 + 4096 + ks * 1024 + 512);
                    const bf16x8 v0 = {a0[0], a0[1], a0[2], a0[3], a1[0], a1[1], a1[2], a1[3]}, v1 = {c0[0], c0[1], c0[2], c0[3], c1[0], c1[1], c1[2], c1[3]};
                    n0 = __builtin_amdgcn_mfma_f32_32x32x16_bf16(__builtin_bit_cast(bf16x8, pw[ks]), v0, n0, 0, 0, 0);
                    n1 = __builtin_amdgcn_mfma_f32_32x32x16_bf16(__builtin_bit_cast(bf16x8, pw[ks]), v1, n1, 0, 0, 0); }
#pragma unroll
                for (int r = 0; r < 16; ++r) { const float rr = rden[att::crow(r, hi)]; hs0[r] += n0[r] * rr; hs1[r] += n1[r] * rr; }
            }
            LDS_WAIT();
#pragma unroll
            for (int r = 0; r < 16; ++r) { st[att::crow(r, hi) * 64 + r32] = hs0[r]; st[att::crow(r, hi) * 64 + 32 + r32] = hs1[r]; }
            LDS_WAIT();
#pragma unroll
            for (int it = 0; it < 4; ++it) { const int tk = (lane >> 3) + 8 * it, d = 8 * (lane & 7);
                const u32x4 ow = *(const u32x4*)(PROJ + (size_t)(row0 + 32 * tb + tk) * PP + PC_CO + 64 * h + d);
                const f32x4 ha = *(const LAS f32x4*)(st + tk * 64 + d), hb = *(const LAS f32x4*)(st + tk * 64 + d + 4);
                const float og[8] = {bflo(ow.x), bfhi(ow.x), bflo(ow.y), bfhi(ow.y), bflo(ow.z), bfhi(ow.z), bflo(ow.w), bfhi(ow.w)};
                float yv[8];
#pragma unroll
                for (int j = 0; j < 8; ++j) yv[j] = (j < 4 ? ha[j] : hb[j - 4]) / (1.f + __expf(-og[j]));
                u32x4 w; w.x = cvtpk(yv[0], yv[1]); w.y = cvtpk(yv[2], yv[3]); w.z = cvtpk(yv[4], yv[5]); w.w = cvtpk(yv[6], yv[7]);
                *(u32x4*)(Y + (size_t)(row0 + 32 * tb + tk) * DM + 512 + 64 * h + d) = w; }
            LDS_WAIT();
        }
    }
}
}

constexpr int NPHASE = 21;
__device__ __forceinline__ void ph_decode(int ph, int& l, int& k) { if (ph <= 10) { l = 0; const int j = ph - 1; k = j < 7 ? j : j + 1; } else { l = 1; const int j = ph - 10; k = j < 7 ? j : j + 1; } }

__device__ __forceinline__ void fill_rtab(Frame& F, const pg8::StaticOrder& S, const float* ssq) {
    LAS float* tab = (LAS float*)(F.lds + pg8::RTAB_OFF); pg8::Unit u;
    for (int i = 0; i < 8 && S.next(i, u); ++i) if (F.tid < 256) { const float* p = ssq + (size_t)(u.pm * 256 + F.tid) * 16; const f32x4 a = *(const f32x4*)p, b = *(const f32x4*)(p + 4), c = *(const f32x4*)(p + 8), d = *(const f32x4*)(p + 12);
        const float s = ((a[0] + a[1]) + (a[2] + a[3])) + ((b[0] + b[1]) + (b[2] + b[3])) + ((c[0] + c[1]) + (c[2] + c[3])) + ((d[0] + d[1]) + (d[2] + d[3]));
        tab[i * 256 + F.tid] = rsqrtf(s * (1.f / DM) + EPS); }
    __syncthreads();
}
__device__ __forceinline__ void phase_ids(Frame& F) {
    int lane_;
    asm volatile("v_mbcnt_lo_u32_b32 %0, -1, 0\n\tv_mbcnt_hi_u32_b32 %0, -1, %0" : "=v"(lane_));
    F.lane = lane_; F.tid = F.wave * 64 + lane_;
}
__device__ __forceinline__ void run_phase(const Frame& F0, int ph) {
    Frame F = F0;
    unsigned char* ws = F.ws;
    bf16_t* H = (bf16_t*)(ws + WS_H); bf16_t* PROJ = (bf16_t*)(ws + WS_PROJ);
    float* XC = (float*)(ws + WS_XC);
    const float* MOD = (const float*)(ws + WS_MOD);
    const int vcu = (F0.G % 8 == 0) ? (F0.bid % 8) * (F0.G / 8) + F0.bid / 8 : F0.bid;
#ifdef ONLYK
    if (ONLYK == 100) { if (ph == 0) { phase_ids(F); p0_prologue(F); } return; }
    if (ONLYK == 101) { if (ph == NPHASE - 1) { phase_ids(F); final_phase(F); } return; }
    if (ph == 0 || ph == NPHASE - 1) return;
    int l, k; ph_decode(ph, l, k);
    if (k != ONLYK) return;
#else
    if (ph == 0) { phase_ids(F); p0_prologue(F); return; }
    if (ph == NPHASE - 1) { phase_ids(F); final_phase(F); return; }
    int l, k; ph_decode(ph, l, k);
#endif
    const int M = (l == 0) ? NROWS : NLAT;
    switch (k) {
    case 0: phase_ids(F); norm_phase(F, l, 0, NROWS); bias_phase(F); break;
    case 1: { phase_ids(F); pg8::Gemm g{H, (const bf16_t*)(ws + WS_WIN) + (size_t)l * PP * 1024, NROWS, PP, 1024}; pg8::StaticOrder S; S.init(NROWS, PP, F.G, F.bid);
              if (l > 0) { gates_phase(F, l); fill_rtab(F, S, (const float*)(ws + WS_SSQ1)); }
              pg8::EpiProj E{PROJ, PP, l == 0 ? nullptr : (const LAS float*)(F.lds + pg8::RTAB_OFF), (const float*)(ws + WS_BIASIN)}; pg8::gemm_phase<pg8::EpiProj, pg8::StaticOrder, true, true>(F.lds, g, S, E, F.tid); } break;
    case 2: phase_ids(F); postproj_phase(F, l); ml::pass1(F, l); break;
    case 3: {
        phase_ids(F);
        ml::pass2(F);
        for (int u = vcu; u < 256; u += F.G) { const int b = u >> 7, h = (u >> 5) & 3, qb = u & 31;
            att::attn_unit<1>(F, b, h, qb, PC_BQ + 64 * h, PC_BK + 64 * (h >> 1), PC_BV + 64 * (h >> 1), 256 + 64 * h, F.ka->in[IN_SINK][l * 4 + h] * LOG2E, nullptr); }
        for (int u = vcu; u < 256; u += F.G) { const int b = u >> 7, h = (u >> 5) & 3, qb = u & 31;
            att::attn_unit<2>(F, b, h, qb, PC_DQ + 64 * h, PC_DK + 64 * h, PC_DV + 64 * h, 768 + 64 * h, 0.f, F.ka->in[IN_RPB] + (size_t)(l * 4 + h) * 465); }
        if (l == 0) for (int cu = vcu; cu < 24; cu += F.G) { const int mx = cu >> 3, b = (cu >> 2) & 1, h = cu & 3;
            const int qc = mx == 0 ? PC_AQ + 64 * h : (mx == 1 ? PC_BQ + 64 * h : PC_DQ + 64 * h);
            const int kc = mx == 0 ? PC_AK + 64 * (h >> 1) : (mx == 1 ? PC_BK + 64 * (h >> 1) : PC_DK + 64 * h);
            const int vc = mx == 0 ? PC_AV + 64 * (h >> 1) : (mx == 1 ? PC_BV + 64 * (h >> 1) : PC_DV + 64 * h);
            const int yc = (mx == 0 ? 0 : (mx == 1 ? 256 : 768)) + 64 * h;
            const float s2 = mx == 1 ? F.ka->in[IN_SINK][l * 4 + h] * LOG2E : -INFINITY;
            att::attn_unit<3>(F, b, h, 0, qc, kc, vc, yc, s2, nullptr); }
    } break;
    case 4: {
        phase_ids(F);
#ifndef NO_ATTN0
        for (int u = vcu; u < 256; u += F.G) { const int b = u >> 7, h = (u >> 5) & 3, qb = u & 31;
            att::attn_unit<0>(F, b, h, qb, PC_AQ + 64 * h, PC_AK + 64 * (h >> 1), PC_AV + 64 * (h >> 1), 64 * h, 0.f, nullptr); }
#endif
        __syncthreads();
#ifndef NO_PASS3
        ml::pass3(F, l, l == 0 ? 0 : 4);
#endif
    } break;
    case 5: phase_ids(F); groupnorm_phase(F, l, M); break;
    case 6: { phase_ids(F); pg8::Gemm g{H, (const bf16_t*)(ws + WS_WOUT) + (size_t)l * 1024 * 1024, M, 1024, 1024}; pg8::StaticOrder S; S.init(M, 1024, F.G, F.bid);
              pg8::EpiResid E{l == 0 ? F.ka->in[IN_X] : F.out, l == 0 ? F.ka->in[IN_CTX] : XC, F.out, XC, MOD + (size_t)l * 3 * 6144 + 2 * 1024,
                               (bf16_t*)(ws + WS_XG), F.ka->in[IN_G2] + l * 1024, MOD + (size_t)l * 3 * 6144 + 4 * 1024, (float*)(ws + WS_SSQ2)};
              pg8::gemm_phase<pg8::EpiResid, pg8::StaticOrder, true, true>(F.lds, g, S, E, F.tid); } break;
    case 8: { phase_ids(F); pg8::Gemm g{(const bf16_t*)(ws + WS_XG), (const bf16_t*)(ws + WS_WUP) + (size_t)l * DFF2 * 1024, M, DFF2, 1024}; pg8::StaticOrder S; S.init(M, DFF2, F.G, F.bid);
              fill_rtab(F, S, (const float*)(ws + WS_SSQ2));
              pg8::EpiUp E{PROJ, F.ka->in[IN_CONVW] + (size_t)l * 3 * DFF2, F.ka->in[IN_CONVB] + (size_t)l * DFF2, (float*)(ws + WS_EDGE), (const LAS float*)(F.lds + pg8::RTAB_OFF), (const float*)(ws + WS_BIASUP) + (size_t)l * 3 * DFF2};
              pg8::gemm_phase<pg8::EpiUp, pg8::StaticOrder, true, true>(F.lds, g, S, E, F.tid); } break;
    case 9: phase_ids(F); fixup_phase(F, l, M / 128); break;
    case 10: { phase_ids(F); pg8::Gemm g{PROJ, (const bf16_t*)(ws + WS_WDN) + (size_t)l * 1024 * DFF, M, 1024, DFF}; pg8::StaticOrder S; S.init(M, 1024, F.G, F.bid);
              pg8::EpiResid E{F.out, XC, F.out, XC, MOD + (size_t)l * 3 * 6144 + 5 * 1024,
                               l == 0 ? H : nullptr, F.ka->in[IN_G1] + 1024, MOD + (size_t)3 * 6144 + 1 * 1024, (float*)(ws + WS_SSQ1)};
              pg8::gemm_phase<pg8::EpiResid, pg8::StaticOrder, true, true>(F.lds, g, S, E, F.tid); } break;
    default: break;
    }
}

__global__ void __launch_bounds__(NTHREADS, 2) fwd_kernel(Args args) {
    extern __shared__ __attribute__((aligned(16))) unsigned char lds_raw[];
    Frame F;
    F.lds = (LAS unsigned char*)lds_raw;
    const int wave0 = __builtin_amdgcn_readfirstlane((int)threadIdx.x >> 6);
    F.tid = 0; F.lane = 0; F.wave = wave0;
    F.G = gridDim.x; F.bid = blockIdx.x;
    F.ka = (const __attribute__((address_space(4))) Args*)__builtin_amdgcn_kernarg_segment_ptr();
    F.out = args.out; F.ws = args.ws;
#define MK_LANE(x) int x; asm volatile("v_mbcnt_lo_u32_b32 %0, -1, 0\n\tv_mbcnt_hi_u32_b32 %0, -1, %0" : "=v"(x))
#if !MK_MULTI
    { MK_LANE(l0_); if (wave0 == 0) ((LAS unsigned*)(F.lds + LDSCTL_OFF))[l0_] = 0u; }
    __syncthreads();
    XcdBarrier bar;
    { MK_LANE(l0_); bar = xcd_barrier_post((unsigned*)(args.ws + WS_CTL) + CW_BAR, (volatile LAS unsigned*)(F.lds + LDSCTL_OFF) + 8, wave0 == 0 && l0_ == 0); }
#endif
    for (int ph = args.ph_lo; ph < args.ph_hi; ++ph) {
        {
            Frame P = F;
            int wave_ = wave0, bid_ = F.bid, g_ = F.G; unsigned char* ws_ = F.ws; float* out_ = F.out; const __attribute__((address_space(4))) Args* ka_ = F.ka;
            asm volatile("" : "+s"(wave_), "+s"(bid_), "+s"(g_), "+s"(ws_), "+s"(out_), "+s"(ka_));
            P.ka = ka_; P.lane = 0; P.wave = wave_; P.tid = 0; P.bid = bid_; P.G = g_; P.ws = ws_; P.out = out_;
            run_phase(P, ph);
#ifdef DUP_PH
            if (DUP_PH(ph)) { asm volatile("s_waitcnt vmcnt(0) lgkmcnt(0)" ::: "memory"); __syncthreads(); run_phase(P, ph); }
#endif
        }
#if !MK_MULTI
        if (ph + 1 < args.ph_hi) {
            if (args.ph_lo < 0) cg::this_grid().sync();
            else { MK_LANE(l1_); xcd_barrier(bar, wave0 == 0 && l1_ == 0); }
        }
#endif
    }
}

extern "C" void kernel_launch(void* const* d_in, const int* in_sizes, int n_in, void* d_out, int out_size, void* d_ws, size_t ws_size, hipStream_t stream) {
    static int grid = 0;
    if (grid == 0) {
        if (n_in != 21 || out_size != NLAT * DM || ws_size < WS_END) { fprintf(stderr, "kernel_launch: unexpected shapes (n_in %d out %d ws %zu)\n", n_in, out_size, ws_size); grid = -1; return; }
        int dev = 0, cus = 0, per_cu = 0;
        if (hipGetDevice(&dev) != hipSuccess || hipDeviceGetAttribute(&cus, hipDeviceAttributeMultiprocessorCount, dev) != hipSuccess) { grid = -1; return; }
        if (hipFuncSetAttribute((const void*)fwd_kernel, hipFuncAttributeMaxDynamicSharedMemorySize, LDS_BYTES) != hipSuccess) { fprintf(stderr, "kernel_launch: hipFuncSetAttribute failed\n"); grid = -1; return; }
        if (hipOccupancyMaxActiveBlocksPerMultiprocessor(&per_cu, (const void*)fwd_kernel, NTHREADS, LDS_BYTES) != hipSuccess || per_cu < 1) { fprintf(stderr, "kernel_launch: occupancy query says %d blocks per CU\n", per_cu); grid = -1; (void)hipGetLastError(); return; }
        grid = cus;
    }
    if (grid < 0) return;
#if !MK_MULTI
    if (hipMemsetAsync((char*)d_ws + WS_CTL, 0, 65536, stream) != hipSuccess) { fprintf(stderr, "kernel_launch: hipMemsetAsync failed\n"); return; }
#endif
    Args a{};
    for (int i = 0; i < 21; ++i) a.in[i] = (const float*)d_in[i];
    a.out = (float*)d_out; a.ws = (unsigned char*)d_ws;
#if MK_MULTI
    for (int ph = 0; ph < NPHASE; ++ph) { a.ph_lo = ph; a.ph_hi = ph + 1; hipLaunchKernelGGL(fwd_kernel, dim3(grid), dim3(NTHREADS), LDS_BYTES, stream, a); }
#else
    a.ph_lo = 0; a.ph_hi = NPHASE;
    void* kargs[] = {&a};
    hipError_t e = hipLaunchCooperativeKernel((void*)fwd_kernel, dim3(grid), dim3(NTHREADS), kargs, LDS_BYTES, stream);
    if (e != hipSuccess) fprintf(stderr, "kernel_launch: cooperative launch failed: %s (grid %d)\n", hipGetErrorString(e), grid);
#endif
}
```

```cpp
#include <hip/hip_runtime.h>
#include <hip/hip_cooperative_groups.h>
#include <cstdio>
#include <cstdint>
namespace cg = cooperative_groups;

#ifndef MK_MULTI
#define MK_MULTI 0
#endif

constexpr int DM = 1024, SEQ = 8192, NBATCH = 2, CTXL = 256, NLAT = NBATCH * SEQ, NROWS = NLAT + NBATCH * CTXL;
constexpr int PP = 2816;
constexpr int DFF = 2816, DFF2 = 5632, DIN = 2832, NLAYER = 2;
constexpr float EPS = 1e-6f;
constexpr float LOG2E = 1.4426950408889634f;
constexpr float QSCALE2 = 0.125f * LOG2E;
constexpr int PC_AQ = 0, PC_AK = 256, PC_AV = 384, PC_BQ = 512, PC_BK = 768, PC_BV = 896, PC_CQ = 1024, PC_CK = 1280, PC_CV = 1536, PC_CO = 1792, PC_DQ = 2048, PC_DK = 2304, PC_DV = 2560;
constexpr int NCHUNK = 132, NCHAIN = 16;

constexpr size_t MiB = 1u << 20;
constexpr size_t WS_CTL = 0, CTL_ZERO_BYTES = 1 * MiB;
constexpr size_t WS_MOD = 1 * MiB;
constexpr size_t WS_ROPE = 1 * MiB + 192 * 1024;
constexpr size_t WS_WG = 1 * MiB + 512 * 1024;
constexpr size_t WS_XC = 2 * MiB;
constexpr size_t WS_WIN = 4 * MiB;
constexpr size_t WS_WOUT = 15 * MiB;
constexpr size_t WS_WUP = 19 * MiB;
constexpr size_t WS_WDN = 41 * MiB;
constexpr size_t WS_H = 52 * MiB;
constexpr size_t WS_PROJ = 85 * MiB;
constexpr size_t WS_GATES = 176 * MiB;
constexpr size_t WS_DS = 178 * MiB;
constexpr size_t WS_SBF = 211 * MiB;
constexpr size_t WS_ZD = 228 * MiB;
constexpr size_t WS_ZC = WS_ZD + 1 * MiB;
constexpr size_t WS_GC = WS_ZC + 1 * MiB;
constexpr size_t WS_ML = WS_GC + 16384;
constexpr size_t WS_MC = WS_ML + 16384;
constexpr size_t WS_SSQ1 = 231 * MiB;
constexpr size_t WS_SSQ2 = 232 * MiB + 512 * 1024;
constexpr size_t WS_BIASUP = 234 * MiB;
constexpr size_t WS_BIASIN = 234 * MiB + 256 * 1024;
constexpr size_t WS_XG = WS_DS;
constexpr size_t WS_EDGE = WS_SBF;
constexpr size_t WS_SSQC1 = 234 * MiB + 512 * 1024;
constexpr size_t WS_SSQC2 = 234 * MiB + 768 * 1024;
constexpr size_t WS_END = 237 * MiB;

#define LAS __attribute__((address_space(3)))
#define GAS __attribute__((address_space(1)))
typedef unsigned short bf16_t;
typedef short bf16x8 __attribute__((ext_vector_type(8)));
typedef short s16x4 __attribute__((ext_vector_type(4)));
typedef float f32x4 __attribute__((ext_vector_type(4)));
typedef float f32x16 __attribute__((ext_vector_type(16)));
typedef float f32x2 __attribute__((ext_vector_type(2)));
typedef unsigned u32x4 __attribute__((ext_vector_type(4)));
typedef unsigned u32x2 __attribute__((ext_vector_type(2)));
typedef __bf16 bf16x2_t __attribute__((ext_vector_type(2)));
typedef short v4i16_t __attribute__((ext_vector_type(4)));

__device__ __forceinline__ unsigned cvtpk(float lo, float hi) { f32x2 v = {lo, hi}; bf16x2_t b = __builtin_convertvector(v, bf16x2_t); return __builtin_bit_cast(unsigned, b); }
__device__ __forceinline__ float bf2f(unsigned short b) { return __uint_as_float((unsigned)b << 16); }
__device__ __forceinline__ float bflo(unsigned w) { return __uint_as_float(w << 16); }
__device__ __forceinline__ float bfhi(unsigned w) { return __uint_as_float(w & 0xffff0000u); }
__device__ __forceinline__ float shfl_idx(float v, int src) { return __int_as_float(__builtin_amdgcn_ds_bpermute(src << 2, __float_as_int(v))); }
__device__ __forceinline__ float shfl_x(float v, int o, int lane) { return shfl_idx(v, lane ^ o); }
__device__ __forceinline__ float wave_sum(float v, int lane) {
#pragma unroll
    for (int o = 1; o < 64; o <<= 1) v += shfl_x(v, o, lane);
    return v;
}
__device__ __forceinline__ float wave_max(float v, int lane) {
#pragma unroll
    for (int o = 1; o < 64; o <<= 1) v = fmaxf(v, shfl_x(v, o, lane));
    return v;
}
#ifdef PROBE_PH
#define PROBE_PT(ldsbase, id) do { if (*(volatile LAS unsigned*)((ldsbase) + 155648 + 64)) *(volatile LAS unsigned long long*)((ldsbase) + 155648 + 72 + 8 * (id)) = __builtin_amdgcn_s_memrealtime(); } while (0)
#else
#define PROBE_PT(ldsbase, id) do { } while (0)
#endif
#define LDS_WAIT() asm volatile("s_waitcnt lgkmcnt(0)" ::: "memory")
#define VM_WAIT() asm volatile("s_waitcnt vmcnt(0)" ::: "memory")

namespace pg8 {
#define PG8_LAS __attribute__((address_space(3)))
constexpr int BM = 256, BK = 64, HALF = 128, HTB = HALF * BK * 2  , STAGE_BYTES = 8 * HTB, NXCD = 8, WGM = 8;
__host__ __device__ __forceinline__ int lds_byte(int r, int c) { const int st = (r >> 4) * 2 + (c >> 5), rr = r & 15, cc = c & 31, ob = rr * 64 + cc * 2; return st * 1024 + (ob ^ (((ob >> 9) & 1) << 5)); }
__host__ __device__ __forceinline__ void stage_rc(int b, int& R, int& C) { const int st = b / 1024, sb = b % 1024, swz = sb ^ (((sb >> 9) & 1) << 5); R = (st >> 1) * 16 + swz / 64; C = (st & 1) * 32 + (swz % 64) / 2; }
__host__ __device__ __forceinline__ int perm32(int rho) { const int n = rho >> 4, i = rho & 15; return 8 * (i >> 2) + 4 * n + (i & 3); }

struct Unit { int pm, pn, ui; };
struct Gemm { const bf16_t* A; const bf16_t* Bt; int M, N, K; };

struct StaticOrder {
    int nM, nN, nwg, G, c;
    __host__ __device__ __forceinline__ void init(int M, int N, int G_, int c_) { nM = M / BM; nN = N / BM; nwg = nM * nN; G = G_; c = c_; }
    __host__ __device__ __forceinline__ bool next(int i, Unit& u) const {
        const long L = (long)i * G + c; if (L >= nwg) return false;
        int wgid = (int)L; { const int q = nwg / NXCD, r = nwg % NXCD, xcd = wgid % NXCD, off = wgid / NXCD; wgid = (xcd < r ? xcd * (q + 1) : r * (q + 1) + (xcd - r) * q) + off; }
        const int nig = WGM * nN, gid = wgid / nig, fm = gid * WGM, gsz = (nM - fm) < WGM ? (nM - fm) : WGM;
        u.pm = fm + ((wgid % nig) % gsz); u.pn = (wgid % nig) / gsz; u.ui = i; return true;
    }
    __device__ __forceinline__ void a_ready(const Unit&) const {}
    __device__ __forceinline__ void done(const Unit&) const {}
};

constexpr int RTAB_OFF = 131072;
struct EpiProj {
    static constexpr bool PERM = true, AFTER_DRAIN = false, ROWPERM = false;
    bf16_t* O; int ldc; const LAS float* rtab; const float* bias;
    __device__ __forceinline__ void operator()(const f32x4 (&acc)[2][2][4][2], const Unit& u, int wr, int wc, int fr, int fq) const {
        asm volatile("" : "+v"(fr), "+v"(fq));
        const int row0 = u.pm * BM + wr * 64 + fr, col0 = u.pn * BM + wc * 32 + 8 * fq;
        const float sc = (u.pn == 2 || u.pn == 8) ? QSCALE2 : (u.pn == 4 ? 0.125f : 1.f);
        float rs[8] = {1.f, 1.f, 1.f, 1.f, 1.f, 1.f, 1.f, 1.f}; f32x4 bv[2][2] = {};
        if (rtab) {
#pragma unroll
            for (int i = 0; i < 8; ++i) rs[i] = rtab[u.ui * 256 + wr * 64 + fr + (i >> 2) * HALF + (i & 3) * 16];
            const int id = u.pm < 32 ? 0 : (u.pm < 64 ? 1 : 2);
#pragma unroll
            for (int bj = 0; bj < 2; ++bj)
#pragma unroll
                for (int n = 0; n < 2; ++n) bv[bj][n] = *(const f32x4*)(bias + id * PP + col0 + bj * HALF + 4 * n); }
#pragma unroll
        for (int ai = 0; ai < 2; ++ai)
#pragma unroll
            for (int m = 0; m < 4; ++m) { bf16_t* rowp = O + (size_t)(row0 + ai * HALF + m * 16) * ldc + col0; const float r = rs[ai * 4 + m];
#pragma unroll
                for (int bj = 0; bj < 2; ++bj) { const f32x4 v0 = (acc[ai][bj][m][0] * r + bv[bj][0]) * sc, v1 = (acc[ai][bj][m][1] * r + bv[bj][1]) * sc;
                    u32x4 w; w.x = cvtpk(v0[0], v0[1]); w.y = cvtpk(v0[2], v0[3]); w.z = cvtpk(v1[0], v1[1]); w.w = cvtpk(v1[2], v1[3]);
                    *(u32x4*)(rowp + bj * HALF) = w; } }
    }
};
struct EpiResid {
    static constexpr bool PERM = true, AFTER_DRAIN = false, ROWPERM = false;
    const float* xin_lat; const float* xin_ctx; float* xout_lat; float* xout_ctx; const float* gate;
    bf16_t* xg; const float* gn; const float* scn; float* ssq;
    __device__ __forceinline__ void operator()(const f32x4 (&acc)[2][2][4][2], const Unit& u, int wr, int wc, int fr, int fq) const {
        asm volatile("" : "+v"(fr), "+v"(fq));
        const int id = u.pm < 32 ? 0 : (u.pm < 64 ? 1 : 2);
        const float* xin = u.pm < 64 ? xin_lat + (size_t)u.pm * BM * DM : xin_ctx + (size_t)(u.pm - 64) * BM * DM;
        float* xout = u.pm < 64 ? xout_lat + (size_t)u.pm * BM * DM : xout_ctx + (size_t)(u.pm - 64) * BM * DM;
        const int rl = wr * 64 + fr, col0 = u.pn * BM + wc * 32 + 8 * fq;
        f32x4 g[2][2], gs[2][2];
#pragma unroll
        for (int bj = 0; bj < 2; ++bj)
#pragma unroll
            for (int n = 0; n < 2; ++n) { g[bj][n] = *(const f32x4*)(gate + id * 6144 + col0 + bj * HALF + 4 * n);
                if (xg) gs[bj][n] = *(const f32x4*)(gn + col0 + bj * HALF + 4 * n) * (1.f + *(const f32x4*)(scn + id * 6144 + col0 + bj * HALF + 4 * n)); }
#pragma unroll
        for (int ai = 0; ai < 2; ++ai)
#pragma unroll
            for (int m = 0; m < 4; ++m) { const size_t off = (size_t)(rl + ai * HALF + m * 16) * DM + col0; float s = 0.f;
#pragma unroll
                for (int bj = 0; bj < 2; ++bj) { f32x4 o[2];
#pragma unroll
                    for (int n = 0; n < 2; ++n) { const f32x4 xv = *(const f32x4*)(xin + off + bj * HALF + 4 * n); o[n] = xv + g[bj][n] * acc[ai][bj][m][n];
                        *(f32x4*)(xout + off + bj * HALF + 4 * n) = o[n]; s += (o[n][0] * o[n][0] + o[n][1] * o[n][1]) + (o[n][2] * o[n][2] + o[n][3] * o[n][3]); }
                    if (xg) { const f32x4 a = o[0] * gs[bj][0], b = o[1] * gs[bj][1]; u32x4 w; w.x = cvtpk(a[0], a[1]); w.y = cvtpk(a[2], a[3]); w.z = cvtpk(b[0], b[1]); w.w = cvtpk(b[2], b[3]);
                        *(u32x4*)(xg + (size_t)u.pm * BM * DM + off + bj * HALF) = w; } }
                if (xg) { s += shfl_idx(s, (fq * 16 + fr) ^ 16); s += shfl_idx(s, (fq * 16 + fr) ^ 32);
                    if (fq == 0) ssq[(size_t)(u.pm * BM + rl + ai * HALF + m * 16) * 16 + u.pn * 4 + wc] = s; } }
    }
};
struct EpiResidStaged {
    static constexpr bool PERM = true, AFTER_DRAIN = true, ROWPERM = false;
    const float* xin_lat; const float* xin_ctx; float* xout_lat; float* xout_ctx; const float* gate;
    bf16_t* xg; const float* gn; const float* scn; float* ssq;
    static constexpr int RS = 1040;
    __device__ __forceinline__ void operator()(const f32x4 (&)[2][2][4][2], const Unit&, int, int, int, int) const {}
    __device__ __forceinline__ void fused(const f32x4 (&acc)[2][2][4][2], const Unit& u, int wr, int wc, int fr, int fq, PG8_LAS unsigned char* lds, int wid, int lane) const {
        const int id = u.pm < 32 ? 0 : (u.pm < 64 ? 1 : 2);
        const float* xin = u.pm < 64 ? xin_lat + (size_t)u.pm * BM * DM : xin_ctx + (size_t)(u.pm - 64) * BM * DM;
        float* xout = u.pm < 64 ? xout_lat + (size_t)u.pm * BM * DM : xout_ctx + (size_t)(u.pm - 64) * BM * DM;
        const int colg = u.pn * BM + 4 * lane;
        const f32x4 gv = *(const f32x4*)(gate + id * 6144 + colg);
        f32x4 gsv = {0.f, 0.f, 0.f, 0.f}; if (xg) gsv = *(const f32x4*)(gn + colg) * (1.f + *(const f32x4*)(scn + id * 6144 + colg));
#pragma unroll
        for (int ai = 0; ai < 2; ++ai) {
#pragma unroll
            for (int m = 0; m < 4; ++m)
#pragma unroll
                for (int bj = 0; bj < 2; ++bj)
#pragma unroll
                    for (int n = 0; n < 2; ++n) *(PG8_LAS f32x4*)(lds + (wr * 64 + m * 16 + fr) * RS + (bj * HALF + wc * 32 + 8 * fq + 4 * n) * 4) = acc[ai][bj][m][n];
            asm volatile("s_waitcnt lgkmcnt(0)\n\ts_barrier" ::: "memory");
#pragma unroll
            for (int r8 = 0; r8 < 2; ++r8) {
                f32x4 xv[8], av[8]; float s[8];
#pragma unroll
                for (int q = 0; q < 8; ++q) { const int row = wid * 16 + r8 * 8 + q; xv[q] = *(const f32x4*)(xin + (size_t)(ai * HALF + row) * DM + colg); av[q] = *(const PG8_LAS f32x4*)(lds + row * RS + lane * 16); }
#pragma unroll
                for (int q = 0; q < 8; ++q) { const int row = wid * 16 + r8 * 8 + q; const f32x4 o = xv[q] + gv * av[q];
                    *(f32x4*)(xout + (size_t)(ai * HALF + row) * DM + colg) = o; s[q] = (o[0] * o[0] + o[1] * o[1]) + (o[2] * o[2] + o[3] * o[3]);
                    if (xg) { const f32x4 a = o * gsv; u32x2 w; w.x = cvtpk(a[0], a[1]); w.y = cvtpk(a[2], a[3]); *(u32x2*)(xg + (size_t)(u.pm * BM + ai * HALF + row) * DM + colg) = w; } }
                if (xg) {
#pragma unroll
                    for (int o_ = 1; o_ < 64; o_ <<= 1)
#pragma unroll
                        for (int q = 0; q < 8; ++q) s[q] += shfl_x(s[q], o_, lane);
                    float sv = s[0];
#pragma unroll
                    for (int q = 1; q < 8; ++q) sv = lane == q ? s[q] : sv;
                    if (lane < 8) *(f32x4*)(ssq + (size_t)(u.pm * BM + ai * HALF + wid * 16 + r8 * 8 + lane) * 16 + u.pn * 4) = (f32x4){sv, 0.f, 0.f, 0.f}; }
            }
            asm volatile("s_waitcnt lgkmcnt(0)\n\ts_barrier" ::: "memory");
        }
    }
};
struct EpiUp {
    static constexpr bool PERM = true, AFTER_DRAIN = false, ROWPERM = true;
    bf16_t* act; const float* convw; const float* convb; float* edge; const LAS float* rtab; const float* bias;
    __device__ __forceinline__ void operator()(f32x4 (&acc)[2][2][4][2], const Unit& u, int wr, int wc, int fr, int fq) const {
        asm volatile("" : "+v"(fr), "+v"(fq));
        const int chb = u.pn * 128 + wc * 32 + 8 * fq;
        const int ht = 2 * u.pm + wr;
        {
            const f32x4 ra = *(const LAS f32x4*)(rtab + u.ui * 256 + (wr * 16 + fr) * 8), rb = *(const LAS f32x4*)(rtab + u.ui * 256 + (wr * 16 + fr) * 8 + 4);
            const float rs[8] = {ra[0], ra[1], ra[2], ra[3], rb[0], rb[1], rb[2], rb[3]};
            const int id = u.pm < 32 ? 0 : (u.pm < 64 ? 1 : 2);
#pragma unroll
            for (int bj = 0; bj < 2; ++bj)
#pragma unroll
                for (int n = 0; n < 2; ++n) { const f32x4 bv = *(const f32x4*)(bias + id * DFF2 + bj * DFF + chb + 4 * n);
#pragma unroll
                    for (int sl = 0; sl < 8; ++sl) { acc[sl >> 2][bj][sl & 3][n] = acc[sl >> 2][bj][sl & 3][n] * rs[sl] + bv; asm volatile("" : "+v"(acc[sl >> 2][bj][sl & 3][n])); } }
        }
        const int lm1 = (fq * 16 + fr - 1) & 63, lp1 = (fq * 16 + fr + 1) & 63;
#pragma unroll
        for (int bj = 0; bj < 2; ++bj)
#pragma unroll
            for (int n = 0; n < 2; ++n) {
                const int uc = bj * DFF + chb + 4 * n;
                if (fr == 0) { *(f32x4*)(edge + ((size_t)ht * 4 + 0) * DFF2 + uc) = acc[0][bj][0][n]; *(f32x4*)(edge + ((size_t)ht * 4 + 1) * DFF2 + uc) = acc[0][bj][1][n]; }
                if (fr == 15) { *(f32x4*)(edge + ((size_t)ht * 4 + 2) * DFF2 + uc) = acc[1][bj][2][n]; *(f32x4*)(edge + ((size_t)ht * 4 + 3) * DFF2 + uc) = acc[1][bj][3][n]; }
#pragma unroll
                for (int j = 0; j < 4; ++j) {
                    const float w0 = convw[uc + j], w1 = convw[DFF2 + uc + j], w2 = convw[2 * DFF2 + uc + j], bb = convb[uc + j];
                    float pv = shfl_idx(acc[1][bj][3][n][j], lm1); const float nx = shfl_idx(acc[0][bj][0][n][j], lp1);
#pragma unroll
                    for (int sl = 0; sl < 8; ++sl) { const float cur = acc[sl >> 2][bj][sl & 3][n][j]; const float nxt = sl < 7 ? acc[(sl + 1) >> 2][bj][(sl + 1) & 3][n][j] : nx;
                        acc[sl >> 2][bj][sl & 3][n][j] = w0 * pv + w1 * cur + w2 * nxt + bb; pv = cur; }
                }
#pragma unroll
                for (int sl = 0; sl < 8; ++sl) asm volatile("" : "+v"(acc[sl >> 2][bj][sl & 3][n]));
            }
        bf16_t* base = act + (size_t)(u.pm * BM + (wr * 16 + fr) * 8) * DFF + chb;
#pragma unroll
        for (int sl = 0; sl < 8; ++sl) {
            const f32x4 g0 = acc[sl >> 2][0][sl & 3][0], g1 = acc[sl >> 2][0][sl & 3][1], v0 = acc[sl >> 2][1][sl & 3][0], v1 = acc[sl >> 2][1][sl & 3][1];
            f32x4 o0, o1;
#pragma unroll
            for (int j = 0; j < 4; ++j) { o0[j] = g0[j] * __builtin_amdgcn_rcpf(1.f + __builtin_amdgcn_exp2f(-LOG2E * g0[j])) * v0[j]; o1[j] = g1[j] * __builtin_amdgcn_rcpf(1.f + __builtin_amdgcn_exp2f(-LOG2E * g1[j])) * v1[j]; }
            u32x4 w; w.x = cvtpk(o0[0], o0[1]); w.y = cvtpk(o0[2], o0[3]); w.z = cvtpk(o1[0], o1[1]); w.w = cvtpk(o1[2], o1[3]);
            const bool skip = (fr == 0 && sl == 0) || (fr == 15 && sl == 7);
            if (!skip) *(u32x4*)(base + (size_t)sl * DFF) = w;
        }
    }
};
template <class Epi, class Sched, bool ALIGN_EPI = false, bool SP2 = false>
__device__ __forceinline__ void gemm_phase(PG8_LAS unsigned char* lds, const Gemm g, const Sched& S, const Epi& E, const int tid) {
    const int wid = __builtin_amdgcn_readfirstlane(tid >> 6), lane = tid & 63, wr = wid >> 2, wc = wid & 3, fr = lane & 15, fq = lane >> 4;
    const int K = g.K, nt = K / BK;
    unsigned voffA[2], voffB[2];
#pragma unroll
    for (int i = 0; i < 2; ++i) { int R, C; stage_rc(tid * 16 + i * 8192, R, C); const int Rb = Epi::PERM ? ((R & ~31) + perm32(R & 31)) : R;
        const int Ra = Epi::ROWPERM ? (((((R >> 6) & 1) * 16 + (R & 15)) << 3) + ((R >> 4) & 3)) : R;
        voffA[i] = (unsigned)(Ra * K + C) * 2u; voffB[i] = (unsigned)(Rb * K + C) * 2u; }
    const size_t kstep = (size_t)(BK * 2);
    const size_t hstep = (size_t)HALF * K * 2;
    const size_t hstepA = Epi::ROWPERM ? (size_t)4 * K * 2 : hstep;
    const size_t tstep = 2 * hstep;
    const unsigned ldsw = (unsigned)wid * 1024u;
    const int aoff = lds_byte(wr * 64 + fr, fq * 8), boff = lds_byte(wc * 32 + fr, fq * 8);
#define PG8_SA(b, h) (((b) * 2 + (h)) * HTB)
#define PG8_SB(b, h) ((4 + (b) * 2 + (h)) * HTB)
#define PG8_STAGE(bufoff, gbase, voff) do { _Pragma("unroll") for (int _i = 0; _i < 2; ++_i) \
        __builtin_amdgcn_global_load_lds((const unsigned*)((const char*)(gbase) + (voff)[_i]), (PG8_LAS unsigned*)(lds + (bufoff) + ldsw + _i * 8192), 16, 0, 0); } while (0)
#define PG8_LDA(dst, b, h) do { _Pragma("unroll") for (int m = 0; m < 4; ++m) _Pragma("unroll") for (int k = 0; k < 2; ++k) dst[m][k] = *(const PG8_LAS bf16x8*)(lds + PG8_SA(b, h) + aoff + m * 2048 + k * 1024); } while (0)
#define PG8_LDB(dst, b, h) do { _Pragma("unroll") for (int n = 0; n < 2; ++n) _Pragma("unroll") for (int k = 0; k < 2; ++k) dst[n][k] = *(const PG8_LAS bf16x8*)(lds + PG8_SB(b, h) + boff + n * 2048 + k * 1024); } while (0)
#define PG8_MMA(ai, bj, At, Bt) do { __builtin_amdgcn_s_setprio(1); _Pragma("unroll") for (int m = 0; m < 4; ++m) _Pragma("unroll") for (int n = 0; n < 2; ++n) _Pragma("unroll") for (int k = 0; k < 2; ++k) \
        acc[ai][bj][m][n] = __builtin_amdgcn_mfma_f32_16x16x32_bf16(Bt[n][k], At[m][k], acc[ai][bj][m][n], 0, 0, 0); __builtin_amdgcn_s_setprio(0); } while (0)
#define PG8_WAIT_V(n) asm volatile("s_waitcnt vmcnt(" #n ")" ::: "memory")
#define PG8_WAIT_L(n) asm volatile("s_waitcnt lgkmcnt(" #n ")" ::: "memory")
#define PG8_BAR __builtin_amdgcn_s_barrier()
#define PG8_SCHED __builtin_amdgcn_sched_barrier(0)
    Unit cur, nxt; int ui = 0;
    if (!S.next(0, cur)) return;
    f32x4 acc[2][2][4][2];
#pragma unroll
    for (int a = 0; a < 2; ++a)
#pragma unroll
        for (int b = 0; b < 2; ++b)
#pragma unroll
            for (int m = 0; m < 4; ++m)
#pragma unroll
                for (int n = 0; n < 2; ++n) acc[a][b][m][n] = (f32x4){0.f, 0.f, 0.f, 0.f};
    bf16x8 At[4][2], B0[2][2], B1[2][2];
    const char* cA = (const char*)g.A + (size_t)cur.pm * tstep; const char* cB = (const char*)g.Bt + (size_t)cur.pn * tstep;
    S.a_ready(cur);
    if constexpr (SP2) {
        PG8_STAGE(PG8_SB(0, 0), cB, voffB); PG8_STAGE(PG8_SB(0, 1), cB + hstep, voffB); PG8_STAGE(PG8_SA(0, 0), cA, voffA); PG8_STAGE(PG8_SA(0, 1), cA + hstepA, voffA);
        if (wr == 1) PG8_BAR;
        PG8_WAIT_V(2); PG8_BAR;
        PG8_STAGE(PG8_SB(1, 0), cB + kstep, voffB); PG8_STAGE(PG8_SA(1, 0), cA + kstep, voffA); PG8_STAGE(PG8_SB(1, 1), cB + hstep + kstep, voffB);
        PG8_WAIT_V(6); PG8_BAR;
    } else {
        PG8_STAGE(PG8_SB(0, 0), cB, voffB); PG8_STAGE(PG8_SA(0, 0), cA, voffA); PG8_STAGE(PG8_SB(0, 1), cB + hstep, voffB); PG8_STAGE(PG8_SA(0, 1), cA + hstepA, voffA);
        if (wr == 1) PG8_BAR;
        PG8_WAIT_V(4); PG8_BAR;
        PG8_STAGE(PG8_SB(1, 0), cB + kstep, voffB); PG8_STAGE(PG8_SA(1, 0), cA + kstep, voffA); PG8_STAGE(PG8_SB(1, 1), cB + hstep + kstep, voffB);
        PG8_WAIT_V(6); PG8_BAR;
    }
    PROBE_PT(lds, 1);
    for (;;) {
        const bool has_next = S.next(ui + 1, nxt);
        const char* nA = has_next ? (const char*)g.A + (size_t)nxt.pm * tstep : cA; const char* nB = has_next ? (const char*)g.Bt + (size_t)nxt.pn * tstep : cB;
        for (int t = 0; t < nt; t += 2) {
            const bool last = (t == nt - 2);
            const char* a1 = cA + (size_t)(t + 1) * kstep;
            const char* a2 = last ? nA : cA + (size_t)(t + 2) * kstep; const char* b2 = last ? nB : cB + (size_t)(t + 2) * kstep;
            const char* a3 = a2 + kstep; const char* b3 = b2 + kstep;
            if (last && has_next) S.a_ready(nxt);
            if constexpr (SP2) {
            PG8_LDB(B0, 0, 0); PG8_LDB(B1, 0, 1); PG8_SCHED; PG8_LDA(At, 0, 0); PG8_STAGE(PG8_SA(1, 1), a1 + hstepA, voffA);
            PG8_WAIT_V(8); PG8_WAIT_L(0); PG8_BAR; PG8_MMA(0, 0, At, B0); PG8_MMA(0, 1, At, B1); PG8_BAR; PG8_SCHED;
            PG8_LDA(At, 0, 1); PG8_STAGE(PG8_SB(0, 0), b2, voffB); PG8_STAGE(PG8_SB(0, 1), b2 + hstep, voffB); PG8_STAGE(PG8_SA(0, 0), a2, voffA);
            PG8_WAIT_V(8); PG8_WAIT_L(0); PG8_BAR; PG8_MMA(1, 0, At, B0); PG8_MMA(1, 1, At, B1); PG8_BAR; PG8_SCHED;
            PG8_LDB(B0, 1, 0); PG8_LDB(B1, 1, 1); PG8_SCHED; PG8_LDA(At, 1, 0); PG8_STAGE(PG8_SA(0, 1), a2 + hstepA, voffA);
            PG8_WAIT_V(8); PG8_WAIT_L(0); PG8_BAR; PG8_MMA(0, 0, At, B0); PG8_MMA(0, 1, At, B1); PG8_BAR; PG8_SCHED;
            PG8_LDA(At, 1, 1); PG8_STAGE(PG8_SB(1, 0), b3, voffB); PG8_STAGE(PG8_SB(1, 1), b3 + hstep, voffB); PG8_STAGE(PG8_SA(1, 0), a3, voffA);
            PG8_WAIT_V(8); PG8_WAIT_L(0); PG8_BAR; PG8_MMA(1, 0, At, B0); PG8_MMA(1, 1, At, B1); PG8_BAR; PG8_SCHED;
            } else {
            PG8_LDB(B0, 0, 0); PG8_SCHED; PG8_LDA(At, 0, 0); PG8_STAGE(PG8_SA(1, 1), a1 + hstepA, voffA);
            PG8_WAIT_L(8); PG8_BAR; PG8_WAIT_L(0); PG8_MMA(0, 0, At, B0); PG8_BAR; PG8_SCHED;
            PG8_LDB(B1, 0, 1); PG8_STAGE(PG8_SB(0, 0), b2, voffB);
            PG8_BAR; PG8_WAIT_L(0); PG8_MMA(0, 1, At, B1); PG8_BAR;
            PG8_LDA(At, 0, 1); PG8_STAGE(PG8_SA(0, 0), a2, voffA);
            PG8_BAR; PG8_WAIT_L(0); PG8_MMA(1, 0, At, B0); PG8_BAR; PG8_SCHED;
            PG8_STAGE(PG8_SB(0, 1), b2 + hstep, voffB);
            PG8_WAIT_V(6); PG8_BAR; PG8_MMA(1, 1, At, B1); PG8_BAR;
            PG8_LDB(B0, 1, 0); PG8_SCHED; PG8_LDA(At, 1, 0); PG8_STAGE(PG8_SA(0, 1), a2 + hstepA, voffA);
            PG8_WAIT_L(8); PG8_BAR; PG8_WAIT_L(0); PG8_MMA(0, 0, At, B0); PG8_BAR; PG8_SCHED;
            PG8_LDB(B1, 1, 1); PG8_STAGE(PG8_SB(1, 0), b3, voffB);
            PG8_BAR; PG8_WAIT_L(0); PG8_MMA(0, 1, At, B1); PG8_BAR;
            PG8_LDA(At, 1, 1); PG8_STAGE(PG8_SA(1, 0), a3, voffA);
            PG8_BAR; PG8_WAIT_L(0); PG8_MMA(1, 0, At, B0); PG8_BAR; PG8_SCHED;
            PG8_STAGE(PG8_SB(1, 1), b3 + hstep, voffB);
            PG8_WAIT_V(6); PG8_BAR; PG8_MMA(1, 1, At, B1); PG8_BAR;
            }
        }
        PROBE_PT(lds, 2);
        if constexpr (ALIGN_EPI) { if (wr == 0) PG8_BAR; }
        if constexpr (!Epi::AFTER_DRAIN) { E(acc, cur, wr, wc, fr, fq); S.done(cur); }
        PROBE_PT(lds, 3);
        if (!has_next) break;
#pragma unroll
        for (int a = 0; a < 2; ++a)
#pragma unroll
            for (int b = 0; b < 2; ++b)
#pragma unroll
                for (int m = 0; m < 4; ++m)
#pragma unroll
                    for (int n = 0; n < 2; ++n) acc[a][b][m][n] = (f32x4){0.f, 0.f, 0.f, 0.f};
        cur = nxt; cA = nA; cB = nB; ++ui;
        if constexpr (ALIGN_EPI) { if (wr == 1) PG8_BAR; }
    }
    PG8_WAIT_V(0);
    if constexpr (!ALIGN_EPI) { if (wr == 0) PG8_BAR; }
    PG8_BAR;
    if constexpr (Epi::AFTER_DRAIN) { E.fused(acc, cur, wr, wc, fr, fq, lds, wid, lane); S.done(cur); }
#undef PG8_SA
#undef PG8_SB
#undef PG8_STAGE
#undef PG8_LDA
#undef PG8_LDB
#undef PG8_MMA
#undef PG8_WAIT_V
#undef PG8_WAIT_L
#undef PG8_BAR
#undef PG8_SCHED
}
}

constexpr size_t WS_WGB = WS_WG + 192 * 1024;
constexpr size_t WS_MODP = 235 * MiB;
constexpr int NWAVES = 8, NTHREADS = 512;
constexpr int LDSCTL_OFF = 155648;
constexpr int LDS_BYTES = LDSCTL_OFF + 256;
struct Args {
    const float* in[21]; float* out; unsigned char* ws; int ph_lo, ph_hi;
};
struct Frame {
    LAS unsigned char* lds;
    int tid, lane, wave, G, bid;
    const __attribute__((address_space(4))) Args* ka;
    float* out; unsigned char* ws;
};
enum { IN_X = 0, IN_C, IN_CTX, IN_CCTX, IN_WMOD, IN_BMOD, IN_G1, IN_G2, IN_WIN, IN_AQG, IN_AKG, IN_SINK, IN_CGB, IN_RPB, IN_GGRP, IN_WOUT, IN_WUP, IN_CONVW, IN_CONVB, IN_WDN, IN_GFIN };

template <class MapFn>
__device__ __forceinline__ void transpose_item(const float* W, int K, int N, bf16_t* WT, LAS float* scr, int item, int lane, MapFn map) {
    const int nblk = (N + 63) / 64, kb = item / nblk, nb = item % nblk, k0 = 64 * kb, n0 = 64 * nb;
    const int nc = n0 + 4 * (lane & 15);
    f32x4 v[16];
#pragma unroll
    for (int i = 0; i < 16; ++i) { const int kk = (lane >> 4) + 4 * i; v[i] = nc < N ? *(const f32x4*)(W + (size_t)(k0 + kk) * N + nc) : (f32x4){0.f, 0.f, 0.f, 0.f}; }
#pragma unroll
    for (int i = 0; i < 16; ++i) { const int kk = (lane >> 4) + 4 * i; LAS float* d = scr + kk * 65 + 4 * (lane & 15); d[0] = v[i][0]; d[1] = v[i][1]; d[2] = v[i][2]; d[3] = v[i][3]; }
    LDS_WAIT(); asm volatile("" ::: "memory");
    const int c = lane & 7;
#pragma unroll
    for (int j = 0; j < 8; ++j) { const int n = (lane >> 3) + 8 * j; const LAS float* s = scr + (8 * c) * 65 + n;
        u32x4 o; o.x = cvtpk(s[0 * 65], s[1 * 65]); o.y = cvtpk(s[2 * 65], s[3 * 65]); o.z = cvtpk(s[4 * 65], s[5 * 65]); o.w = cvtpk(s[6 * 65], s[7 * 65]);
        const int sc = n0 + n; const int dr = sc < N ? map(sc) : -1;
        if (dr >= 0) *(u32x4*)(WT + (size_t)dr * K + k0 + 8 * c) = o; }
    LDS_WAIT(); asm volatile("" ::: "memory");
}
__device__ __forceinline__ void p0_prologue(Frame& F) {
    const float* c = F.ka->in[IN_C]; const float* cctx = F.ka->in[IN_CCTX];
    const int gw = F.bid * NWAVES + F.wave, NGW = F.G * NWAVES;
    if (F.bid < NLAYER * 48 || F.G < NLAYER * 48 + 8) {
        LAS float* sv = (LAS float*)F.lds;
        LAS float* red = (LAS float*)(F.lds + 12288);
        for (int i = F.tid; i < 3 * 1024; i += NTHREADS) { const int id = i >> 10, k = i & 1023; const float v = id < 2 ? c[id * 1024 + k] : cctx[k]; sv[i] = v / (1.f + __expf(-v)); }
        __syncthreads();
        float* MOD = (float*)(F.ws + WS_MOD);
        for (int it = F.bid; it < NLAYER * 48; it += F.G) {
            const int l = it / 48, nb = it % 48, n = nb * 128 + 2 * F.lane;
            const float* w = F.ka->in[IN_WMOD] + ((size_t)l * 1024 + F.wave * 128) * 6144 + n;
            f32x2 a0 = {0.f, 0.f}, a1 = {0.f, 0.f}, a2 = {0.f, 0.f};
#pragma unroll 16
            for (int k = 0; k < 128; ++k) { const f32x2 wv = *(const f32x2*)(w + (size_t)k * 6144); const int kk = F.wave * 128 + k; a0 += sv[kk] * wv; a1 += sv[1024 + kk] * wv; a2 += sv[2048 + kk] * wv; }
            *(LAS f32x2*)(red + (F.wave * 3 + 0) * 128 + 2 * F.lane) = a0; *(LAS f32x2*)(red + (F.wave * 3 + 1) * 128 + 2 * F.lane) = a1; *(LAS f32x2*)(red + (F.wave * 3 + 2) * 128 + 2 * F.lane) = a2;
            __syncthreads();
            if (F.tid < 384) { const int id = F.tid >> 7, ln = F.tid & 127; float s = F.ka->in[IN_BMOD][l * 6144 + nb * 128 + ln];
#pragma unroll
                for (int w8 = 0; w8 < 8; ++w8) s += red[(w8 * 3 + id) * 128 + ln];
                MOD[((size_t)l * 3 + id) * 6144 + nb * 128 + ln] = s; }
            __syncthreads();
        }
    }
    PROBE_PT(F.lds, 1);
    { const int b0 = F.G >= NLAYER * 48 + 8 ? NLAYER * 48 : 0, nb_ = F.G - b0;
      if (F.bid >= b0) { const int gt2 = (F.bid - b0) * NTHREADS + F.tid, NGT2 = nb_ * NTHREADS;
        float* ROPE = (float*)(F.ws + WS_ROPE); float* WG = (float*)(F.ws + WS_WG); bf16_t* WGB = (bf16_t*)(F.ws + WS_WGB);
        for (int e = gt2; e < 192 * 16 + NLAYER * 16 * 1024; e += NGT2) {
            if (e < 192 * 16) { const int idx = e >> 4, i = e & 15; const float pos = (float)(idx < 128 ? idx : idx - 128);
                const float freq = powf(10000.0f, -(float)i / 16.0f); const float ang = pos * freq; ROPE[2 * e] = cosf(ang); ROPE[2 * e + 1] = sinf(ang); }
            else { const int e2 = e - 192 * 16, l = e2 >> 14, o = (e2 >> 10) & 15, k = e2 & 1023; const float v = F.ka->in[IN_WIN][((size_t)l * 1024 + k) * DIN + 2048 + o]; WG[e2] = v; WGB[e2] = (bf16_t)(cvtpk(v, 0.f) & 0xffffu); } } } }
    PROBE_PT(F.lds, 2);
    LAS float* scr = (LAS float*)(F.lds + F.wave * 16896);
    constexpr int I_IN = 16 * 45, I_OUT = 16 * 16, I_UP = 16 * 88, I_DN = 44 * 16, I_L = I_IN + I_OUT + I_UP + I_DN;
    for (int it = gw; it < NLAYER * I_L; it += NGW) {
        const int l = it / I_L; int r = it % I_L;
        if (r < I_IN) { transpose_item(F.ka->in[IN_WIN] + (size_t)l * 1024 * DIN, 1024, DIN, (bf16_t*)(F.ws + WS_WIN) + (size_t)l * PP * 1024, scr, r, F.lane,
                                       [](int n) { return n < 2048 ? n : (n < 2064 ? -1 : n - 16); }); continue; } r -= I_IN;
        if (r < I_OUT) { transpose_item(F.ka->in[IN_WOUT] + (size_t)l * 1024 * 1024, 1024, 1024, (bf16_t*)(F.ws + WS_WOUT) + (size_t)l * 1024 * 1024, scr, r, F.lane, [](int n) { return n; }); continue; } r -= I_OUT;
        if (r < I_UP) { transpose_item(F.ka->in[IN_WUP] + (size_t)l * 1024 * DFF2, 1024, DFF2, (bf16_t*)(F.ws + WS_WUP) + (size_t)l * DFF2 * 1024, scr, r, F.lane,
                                       [](int n) { const int m = n < DFF ? n : n - DFF; return (m >> 7) * 256 + (n < DFF ? 0 : 128) + (m & 127); }); continue; } r -= I_UP;
        transpose_item(F.ka->in[IN_WDN] + (size_t)l * DFF * 1024, DFF, 1024, (bf16_t*)(F.ws + WS_WDN) + (size_t)l * 1024 * DFF, scr, r, F.lane, [](int n) { return n; });
    }
}

template <int R>
__device__ __forceinline__ void norm_rows(Frame& F, const float* xbase, int row0, const float* sh, const float* sc, const f32x4 (&gv)[4]) {
    bf16_t* H = (bf16_t*)(F.ws + WS_H);
    f32x4 hv[R][4]; float ss[R];
#pragma unroll
    for (int r = 0; r < R; ++r)
#pragma unroll
        for (int j = 0; j < 4; ++j) hv[r][j] = *(const f32x4*)(xbase + (size_t)r * DM + 4 * F.lane + 256 * j);
#pragma unroll
    for (int r = 0; r < R; ++r) { float s = 0.f;
#pragma unroll
        for (int j = 0; j < 4; ++j) s += (hv[r][j][0] * hv[r][j][0] + hv[r][j][1] * hv[r][j][1]) + (hv[r][j][2] * hv[r][j][2] + hv[r][j][3] * hv[r][j][3]);
        ss[r] = s; }
#pragma unroll
    for (int o = 1; o < 64; o <<= 1)
#pragma unroll
        for (int r = 0; r < R; ++r) ss[r] += shfl_x(ss[r], o, F.lane);
#pragma unroll
    for (int j = 0; j < 4; ++j) { const f32x4 scv = 1.f + *(const f32x4*)(sc + 4 * F.lane + 256 * j), shv = *(const f32x4*)(sh + 4 * F.lane + 256 * j);
#pragma unroll
        for (int r = 0; r < R; ++r) { const f32x4 v = hv[r][j] * rsqrtf(ss[r] * (1.f / DM) + EPS) * gv[j] * scv + shv;
            u32x2 w; w.x = cvtpk(v[0], v[1]); w.y = cvtpk(v[2], v[3]);
            *(u32x2*)(H + (size_t)(row0 + r) * DM + 4 * F.lane + 256 * j) = w; } }
}
__device__ __forceinline__ void norm_phase(Frame& F, int layer) {
    const int gw = F.bid * NWAVES + F.wave, NGW = F.G * NWAVES;
    const float* gvec = F.ka->in[IN_G1] + layer * 1024;
    const float* mod = (const float*)(F.ws + WS_MOD) + (size_t)layer * 3 * 6144;
    const float* xl = F.ka->in[IN_X]; const float* xc = F.ka->in[IN_CTX];
    f32x4 gv[4];
#pragma unroll
    for (int j = 0; j < 4; ++j) gv[j] = *(const f32x4*)(gvec + 4 * F.lane + 256 * j);
    for (int rg = gw; rg < NLAT / 8; rg += NGW) { const int row0 = rg * 8, id = row0 < SEQ ? 0 : 1; norm_rows<8>(F, xl + (size_t)row0 * DM, row0, mod + id * 6144, mod + id * 6144 + 1024, gv); }
    for (int rg = gw; rg < NBATCH * CTXL / 2; rg += NGW) { const int row0 = rg * 2; norm_rows<2>(F, xc + (size_t)row0 * DM, NLAT + row0, mod + 2 * 6144, mod + 2 * 6144 + 1024, gv); }
}

constexpr size_t WS_BIASG = WS_BIASIN + 64 * 1024;
__device__ __forceinline__ void bias_phase(Frame& F, int bslot, int nslots) {
    if (bslot < 0 && nslots > 0) return;
    if (nslots <= 0) { bslot = F.bid; nslots = F.G; }
    const int gw = bslot * NWAVES + F.wave, NGW = nslots * NWAVES, lane = F.lane, fr = lane & 15, fq = lane >> 4;
    const float* MOD = (const float*)(F.ws + WS_MOD);
    float* BUP = (float*)(F.ws + WS_BIASUP); float* BIN = (float*)(F.ws + WS_BIASIN); float* BG = (float*)(F.ws + WS_BIASG);
    constexpr int J_UP = DFF2 / 16, J_IN = PP / 16;
    for (int job = gw; job < 2 * J_UP + J_IN + 1; job += NGW) {
        const bool isup = job < 2 * J_UP, isin = !isup && job < 2 * J_UP + J_IN; const int l = isup ? job / J_UP : 1, r0 = 16 * (isup ? job % J_UP : (isin ? job - 2 * J_UP : 0));
        const bf16_t* wrow = isup ? (const bf16_t*)(F.ws + WS_WUP) + ((size_t)l * DFF2 + r0 + fr) * 1024 : (isin ? (const bf16_t*)(F.ws + WS_WIN) + ((size_t)PP + r0 + fr) * 1024 : (const bf16_t*)(F.ws + WS_WGB) + (size_t)(16 + fr) * 1024);
        const float* sh = MOD + ((size_t)l * 3 + (fr < 3 ? fr : 0)) * 6144 + (isup ? 3 * 1024 : 0) + 8 * fq;
        const bf16_t* bp = wrow + 8 * fq;
        f32x4 acc = {0.f, 0.f, 0.f, 0.f};
        for (int k0 = 0; k0 < DM / 32; k0 += 8) { f32x4 a0[8], a1[8]; bf16x8 bv[8];
#pragma unroll
            for (int j = 0; j < 8; ++j) { a0[j] = *(const f32x4*)(sh + 32 * (k0 + j)); a1[j] = *(const f32x4*)(sh + 32 * (k0 + j) + 4); bv[j] = *(const bf16x8*)(bp + 32 * (k0 + j)); }
#pragma unroll
            for (int j = 0; j < 8; ++j) { u32x4 aw; aw.x = cvtpk(a0[j][0], a0[j][1]); aw.y = cvtpk(a0[j][2], a0[j][3]); aw.z = cvtpk(a1[j][0], a1[j][1]); aw.w = cvtpk(a1[j][2], a1[j][3]);
                acc = __builtin_amdgcn_mfma_f32_16x16x32_bf16(__builtin_bit_cast(bf16x8, aw), bv[j], acc, 0, 0, 0); } }
        if (fq == 0) { const int r = r0 + fr;
            if (isup) { const int pn = r >> 8, i = r & 255; const int uc = i < 128 ? pn * 128 + i : DFF + pn * 128 + (i - 128);
                BUP[((size_t)l * 3 + 0) * DFF2 + uc] = acc[0]; BUP[((size_t)l * 3 + 1) * DFF2 + uc] = acc[1]; BUP[((size_t)l * 3 + 2) * DFF2 + uc] = acc[2]; }
            else if (isin) { BIN[r] = acc[0]; BIN[PP + r] = acc[1]; BIN[2 * PP + r] = acc[2]; }
            else { BG[fr] = acc[0]; BG[16 + fr] = acc[1]; BG[32 + fr] = acc[2]; } }
    }
}
__device__ __forceinline__ void gates_phase(Frame& F, int layer) {
    const int gw = F.bid * NWAVES + F.wave, NGW = F.G * NWAVES, lane = F.lane, fr = lane & 15, fq = lane >> 4;
    const bf16_t* H = (const bf16_t*)(F.ws + WS_H); const float* SSQ = (const float*)(F.ws + WS_SSQ1); const float* SSQC = (const float*)(F.ws + WS_SSQC1);
    const bf16_t* WGB = (const bf16_t*)(F.ws + WS_WGB) + (size_t)layer * 16 * 1024; const float* BG = (const float*)(F.ws + WS_BIASG);
    float* GATES = (float*)(F.ws + WS_GATES);
    for (int job = gw; job < NROWS / 16; job += NGW) {
        const int r0 = 16 * job; const int id = r0 < SEQ ? 0 : (r0 < NLAT ? 1 : 2);
        const bf16_t* ap = H + (size_t)(r0 + fr) * DM + 8 * fq; const bf16_t* bp = WGB + (size_t)fr * DM + 8 * fq;
        f32x4 acc = {0.f, 0.f, 0.f, 0.f};
        for (int k0 = 0; k0 < DM / 32; k0 += 16) { bf16x8 av[16], bv[16];
#pragma unroll
            for (int j = 0; j < 16; ++j) { av[j] = *(const bf16x8*)(ap + 32 * (k0 + j)); bv[j] = *(const bf16x8*)(bp + 32 * (k0 + j)); }
#pragma unroll
            for (int j = 0; j < 16; ++j) acc = __builtin_amdgcn_mfma_f32_16x16x32_bf16(av[j], bv[j], acc, 0, 0, 0); }
        float rs[4] = {1.f, 1.f, 1.f, 1.f}, bo = 0.f;
        if (layer > 0) {
            float s = 0.f;
            if (r0 < NLAT) { const f32x4 a = *(const f32x4*)(SSQ + (size_t)(r0 + (lane >> 2)) * 16 + 4 * (lane & 3)); s = (a[0] + a[1]) + (a[2] + a[3]); }
            else { const float* p = SSQC + (size_t)(r0 - NLAT + (lane >> 2)) * 64 + 16 * (lane & 3);
#pragma unroll
                for (int j = 0; j < 4; ++j) { const f32x4 a = *(const f32x4*)(p + 4 * j); s += (a[0] + a[1]) + (a[2] + a[3]); } }
            s += shfl_x(s, 1, lane); s += shfl_x(s, 2, lane);
            const float rr = rsqrtf(s * (1.f / DM) + EPS);
#pragma unroll
            for (int r = 0; r < 4; ++r) rs[r] = shfl_idx(rr, 4 * (4 * fq + r));
            bo = BG[id * 16 + fr];
        }
#pragma unroll
        for (int r = 0; r < 4; ++r) GATES[(size_t)(r0 + 4 * fq + r) * 16 + fr] = acc[r] * rs[r] + bo;
    }
}

__device__ __forceinline__ void postproj_phase(Frame& F, int layer) {
    const int gw = F.bid * NWAVES + F.wave, NGW = F.G * NWAVES;
    bf16_t* PROJ = (bf16_t*)(F.ws + WS_PROJ);
    const float* ROPE = (const float*)(F.ws + WS_ROPE);
    const int sub = F.lane >> 4, l16 = F.lane & 15, d = 4 * l16;
    const f32x4 gq = *(const f32x4*)(F.ka->in[IN_AQG] + layer * 64 + d), gk = *(const f32x4*)(F.ka->in[IN_AKG] + layer * 64 + d);
    const bool x2 = (l16 & 4) != 0;
    for (int rg = gw; rg < NROWS / 4; rg += NGW) {
        const int row0 = 4 * rg; const bool lat = row0 < NLAT;
        u32x2 w[4][3]; f32x4 cs0[4], cs1[4];
#pragma unroll
        for (int q = 0; q < 4; ++q) { const bf16_t* pr = PROJ + (size_t)(row0 + q) * PP; const int t = (row0 + q) & (SEQ - 1);
            cs0[q] = (f32x4){1.f, 0.f, 1.f, 0.f}; cs1[q] = cs0[q];
            if (lat) { const int idx = (d >> 5) ? 128 + (t & 63) : (t >> 6); const float* rp = ROPE + ((size_t)idx * 16 + (d & 15)) * 2; cs0[q] = *(const f32x4*)rp; cs1[q] = *(const f32x4*)(rp + 4); }
#pragma unroll
            for (int pass = 0; pass < 3; ++pass) { const int col = pass == 0 ? PC_AQ + 64 * sub + d : (pass == 1 ? (sub < 2 ? PC_AK + 64 * sub + d : PC_BK + 64 * (sub - 2) + d) : PC_BQ + 64 * sub + d);
                w[q][pass] = *(const u32x2*)(pr + col); } }
#pragma unroll
        for (int q = 0; q < 4; ++q) { bf16_t* pr = PROJ + (size_t)(row0 + q) * PP;
            const float cz[4] = {cs0[q][0], cs0[q][2], cs1[q][0], cs1[q][2]}, sz[4] = {cs0[q][1], cs0[q][3], cs1[q][1], cs1[q][3]};
#pragma unroll
            for (int pass = 0; pass < 3; ++pass) {
                const int col = pass == 0 ? PC_AQ + 64 * sub + d : (pass == 1 ? (sub < 2 ? PC_AK + 64 * sub + d : PC_BK + 64 * (sub - 2) + d) : PC_BQ + 64 * sub + d);
                const bool donorm = pass == 0 || (pass == 1 && sub < 2);
                const bool active = lat || donorm;
                if (!lat && pass == 2) continue;
                float v[4] = {bflo(w[q][pass].x), bfhi(w[q][pass].x), bflo(w[q][pass].y), bfhi(w[q][pass].y)};
                float ss = (v[0] * v[0] + v[1] * v[1]) + (v[2] * v[2] + v[3] * v[3]);
                ss += shfl_x(ss, 1, F.lane); ss += shfl_x(ss, 2, F.lane); ss += shfl_x(ss, 4, F.lane); ss += shfl_x(ss, 8, F.lane);
                if (donorm) { const float rstd = rsqrtf(ss * (1.f / 64.f) + EPS) * (pass == 0 ? QSCALE2 : 1.f); const f32x4 g = pass == 0 ? gq : gk;
#pragma unroll
                    for (int e = 0; e < 4; ++e) v[e] = v[e] * rstd * g[e]; }
                float o[4];
#pragma unroll
                for (int e = 0; e < 4; ++e) { const float p = shfl_x(v[e], 4, F.lane); o[e] = x2 ? (p * sz[e] + v[e] * cz[e]) : (v[e] * cz[e] - p * sz[e]); }
                if (active) { u32x2 ow; ow.x = cvtpk(o[0], o[1]); ow.y = cvtpk(o[2], o[3]); *(u32x2*)(pr + col) = ow; }
            } }
    }
}

template <bool WT = false>
__device__ __forceinline__ void groupnorm_rows(Frame& F, int layer, int row0, int nrows, int wv, int nw) {
    const bf16_t* H = (const bf16_t*)(F.ws + WS_H); bf16_t* YN = (bf16_t*)(F.ws + WS_PROJ);
    const float* gg = F.ka->in[IN_GGRP] + layer * 1024;
    f32x4 gv[4];
#pragma unroll
    for (int j = 0; j < 4; ++j) gv[j] = *(const f32x4*)(gg + 4 * F.lane + 256 * j);
    for (int r = 4 * wv; r < nrows; r += 4 * nw) {
        u32x2 w[4][4]; float ss[4][4];
#pragma unroll
        for (int q = 0; q < 4; ++q)
#pragma unroll
            for (int j = 0; j < 4; ++j) w[q][j] = *(const u32x2*)(H + (size_t)(row0 + r + q) * DM + 4 * F.lane + 256 * j);
#pragma unroll
        for (int q = 0; q < 4; ++q)
#pragma unroll
            for (int j = 0; j < 4; ++j) { const float v0 = bflo(w[q][j].x), v1 = bfhi(w[q][j].x), v2 = bflo(w[q][j].y), v3 = bfhi(w[q][j].y); ss[q][j] = (v0 * v0 + v1 * v1) + (v2 * v2 + v3 * v3); }
#pragma unroll
        for (int o = 1; o < 64; o <<= 1)
#pragma unroll
            for (int q = 0; q < 4; ++q)
#pragma unroll
                for (int j = 0; j < 4; ++j) ss[q][j] += shfl_x(ss[q][j], o, F.lane);
#pragma unroll
        for (int q = 0; q < 4; ++q)
#pragma unroll
            for (int j = 0; j < 4; ++j) { const float rstd = rsqrtf(ss[q][j] * (1.f / 256.f) + EPS);
                u32x2 o; o.x = cvtpk(bflo(w[q][j].x) * rstd * gv[j][0], bfhi(w[q][j].x) * rstd * gv[j][1]); o.y = cvtpk(bflo(w[q][j].y) * rstd * gv[j][2], bfhi(w[q][j].y) * rstd * gv[j][3]);
                if (WT) __hip_atomic_store((unsigned long long*)(YN + (size_t)(row0 + r + q) * DM + 4 * F.lane + 256 * j), (unsigned long long)o.x | ((unsigned long long)o.y << 32), __ATOMIC_RELAXED, __HIP_MEMORY_SCOPE_AGENT);
                else *(u32x2*)(YN + (size_t)(row0 + r + q) * DM + 4 * F.lane + 256 * j) = o; }
    }
}

__device__ __forceinline__ void fixup_hts(Frame& F, int layer, int ht0, int nht) {
    const float* edge = (const float*)(F.ws + WS_EDGE);
    const float* cw = F.ka->in[IN_CONVW] + (size_t)layer * 3 * DFF2; const float* cb = F.ka->in[IN_CONVB] + (size_t)layer * DFF2;
    bf16_t* act = (bf16_t*)(F.ws + WS_PROJ);
    const int per_row = DFF / 4;
    for (int it = F.tid; it < nht * 2 * per_row; it += NTHREADS) {
        const int ch = (it % per_row) * 4, rr = it / per_row, ht = ht0 + (rr >> 1), last = rr & 1;
        const bool seq_start = (ht == 0 || ht == 64 || ht == 128 || ht == 130), seq_end = (ht == 63 || ht == 127 || ht == 129 || ht == 131);
        const int row = ht * 128 + (last ? 127 : 0);
        f32x4 o;
        f32x4 res[2];
#pragma unroll
        for (int gvv = 0; gvv < 2; ++gvv) { const int uc = gvv * DFF + ch;
            const f32x4 z = {0.f, 0.f, 0.f, 0.f};
            f32x4 up, ucur, un;
            if (!last) { up = seq_start ? z : *(const f32x4*)(edge + ((size_t)(ht - 1) * 4 + 3) * DFF2 + uc); ucur = *(const f32x4*)(edge + ((size_t)ht * 4 + 0) * DFF2 + uc); un = *(const f32x4*)(edge + ((size_t)ht * 4 + 1) * DFF2 + uc); }
            else { up = *(const f32x4*)(edge + ((size_t)ht * 4 + 2) * DFF2 + uc); ucur = *(const f32x4*)(edge + ((size_t)ht * 4 + 3) * DFF2 + uc); un = seq_end ? z : *(const f32x4*)(edge + ((size_t)(ht + 1) * 4 + 0) * DFF2 + uc); }
            res[gvv] = *(const f32x4*)(cw + uc) * up + *(const f32x4*)(cw + DFF2 + uc) * ucur + *(const f32x4*)(cw + 2 * DFF2 + uc) * un + *(const f32x4*)(cb + uc); }
#pragma unroll
        for (int j = 0; j < 4; ++j) o[j] = res[0][j] / (1.f + __expf(-res[0][j])) * res[1][j];
        u32x2 w; w.x = cvtpk(o[0], o[1]); w.y = cvtpk(o[2], o[3]);
        *(u32x2*)(act + (size_t)row * DFF + ch) = w;
    }
}

template <int KDIM>
__device__ __forceinline__ void skinny_ctx(Frame& F, const bf16_t* A  , const bf16_t* Wt  , const float* xin, float* xout, const float* gate  ,
                                           bf16_t* xg  , const float* gn, const float* scn  , float* ssqc) {
    const int lane = F.lane, fr = lane & 15, fq = lane >> 4, t = F.tid, ldrow = t >> 3, chunk = t & 7;
    const int rf = F.wave >> 1, cp = F.wave & 1;
    constexpr int RSB = 144, BUFB = 64 * RSB, NKB = KDIM / 64;
    for (int p = F.bid; p < 128; p += F.G) {
        const int rg = p >> 4, cg = p & 15;
        if (KDIM == DM) { groupnorm_rows<false>(F, 0, NLAT + 64 * rg, 64, F.wave, NWAVES); VM_WAIT(); __syncthreads(); }
        const bf16_t* asrc = A + (size_t)(64 * rg + ldrow) * KDIM + 8 * chunk; const bf16_t* bsrc = Wt + (size_t)(64 * cg + ldrow) * KDIM + 8 * chunk;
        u32x4 ra[4], rb[4];
#pragma unroll
        for (int i = 0; i < 4; ++i) { ra[i] = *(const u32x4*)(asrc + 64 * i); rb[i] = *(const u32x4*)(bsrc + 64 * i); }
        f32x4 acc[2] = {{0.f, 0.f, 0.f, 0.f}, {0.f, 0.f, 0.f, 0.f}};
        __syncthreads();
        for (int kb0 = 0; kb0 < NKB; kb0 += 4) {
#pragma unroll
            for (int i = 0; i < 4; ++i) { const int kb = kb0 + i; LAS unsigned char* ba = F.lds + (kb & 1) * 2 * BUFB; LAS unsigned char* bb = ba + BUFB;
                *(LAS u32x4*)(ba + ldrow * RSB + 16 * chunk) = ra[i]; *(LAS u32x4*)(bb + ldrow * RSB + 16 * chunk) = rb[i];
                if (kb + 4 < NKB) { ra[i] = *(const u32x4*)(asrc + 64 * (kb + 4)); rb[i] = *(const u32x4*)(bsrc + 64 * (kb + 4)); }
                __syncthreads();
#pragma unroll
                for (int ks = 0; ks < 2; ++ks) { const bf16x8 af = *(const LAS bf16x8*)(ba + (16 * rf + fr) * RSB + 64 * ks + 16 * fq);
#pragma unroll
                    for (int j = 0; j < 2; ++j) { const bf16x8 bf = *(const LAS bf16x8*)(bb + (32 * cp + 16 * j + fr) * RSB + 64 * ks + 16 * fq); acc[j] = __builtin_amdgcn_mfma_f32_16x16x32_bf16(af, bf, acc[j], 0, 0, 0); } }
            }
        }
        float ss[4] = {0.f, 0.f, 0.f, 0.f};
#pragma unroll
        for (int j = 0; j < 2; ++j) { const int n = 64 * cg + 32 * cp + 16 * j + fr; const float g = gate[n], gs = gn[n] * (1.f + scn[n]);
#pragma unroll
            for (int r = 0; r < 4; ++r) { const int row = 64 * rg + 16 * rf + 4 * fq + r; const float o = xin[(size_t)row * DM + n] + g * acc[j][r];
                xout[(size_t)row * DM + n] = o; xg[(size_t)row * DM + n] = (bf16_t)(cvtpk(o * gs, 0.f) & 0xffffu); ss[r] += o * o; } }
#pragma unroll
        for (int r = 0; r < 4; ++r) { float s = ss[r]; s += shfl_x(s, 1, lane); s += shfl_x(s, 2, lane); s += shfl_x(s, 4, lane); s += shfl_x(s, 8, lane);
            if (fr == 0) { float* sp = ssqc + (size_t)(64 * rg + 16 * rf + 4 * fq + r) * 64 + cg * 2 + cp; sp[0] = s; sp[32] = 0.f; } }
        __syncthreads();
    }
}

__device__ __forceinline__ void final_phase(Frame& F) {
    const int gw = F.bid * NWAVES + F.wave, NGW = F.G * NWAVES;
    const float* gf = F.ka->in[IN_GFIN];
    f32x4 gv[4];
#pragma unroll
    for (int j = 0; j < 4; ++j) gv[j] = *(const f32x4*)(gf + 4 * F.lane + 256 * j);
    for (int row = gw; row < NLAT; row += NGW) {
        float* xr = F.out + (size_t)row * DM + 4 * F.lane;
        f32x4 v[4]; float s = 0.f;
#pragma unroll
        for (int j = 0; j < 4; ++j) { v[j] = *(const f32x4*)(xr + 256 * j); s += (v[j][0] * v[j][0] + v[j][1] * v[j][1]) + (v[j][2] * v[j][2] + v[j][3] * v[j][3]); }
        const float rstd = rsqrtf(wave_sum(s, F.lane) * (1.f / DM) + EPS);
#pragma unroll
        for (int j = 0; j < 4; ++j) *(f32x4*)(xr + 256 * j) = v[j] * rstd * gv[j];
    }
}

typedef GAS unsigned gu32;
#define RLX_AGENT __ATOMIC_RELAXED, __HIP_MEMORY_SCOPE_AGENT
constexpr int CW_BAR = 4096;
#define XB_TMO      128
#define XB_XCNT(j)  (256  + 64 * (j))
#define XB_XSUB(j)  (1280 + 64 * (j))
#define XB_XGEN(j)  (2304 + 64 * (j))
#define XB_TOP      3328
#define XB_TOPGEN   3392
#define XCD_BAR_WORDS 3456
#define XB_SPIN_CAP (1u << 18)

__device__ __forceinline__ unsigned xb_ld(unsigned* p)              { return __hip_atomic_load(p, __ATOMIC_RELAXED, __HIP_MEMORY_SCOPE_AGENT); }
__device__ __forceinline__ unsigned xb_add(unsigned* p, unsigned v) { return __hip_atomic_fetch_add(p, v, __ATOMIC_RELAXED, __HIP_MEMORY_SCOPE_AGENT); }
__device__ __forceinline__ unsigned xb_xcc_id() { return (unsigned)__builtin_amdgcn_s_getreg((3 << 11) | 20) & 0xFu; }
#define XB_SPIN(cond, bar) do { unsigned _sp = 0; while (cond) { __builtin_amdgcn_s_sleep(1); \
    if ((++_sp & 255u) == 0u) { if (xb_ld(&(bar)[XB_TMO])) break; if (_sp > XB_SPIN_CAP) { atomicAdd(&(bar)[XB_TMO], 1u); break; } } } } while (0)

struct XcdBarrier {
    unsigned* bar; unsigned x;
    volatile LAS unsigned* st;
};

__device__ __forceinline__ XcdBarrier xcd_barrier_post(unsigned* bar, volatile LAS unsigned* st, bool is_t0) {
    XcdBarrier b; b.bar = bar; b.x = xb_xcc_id(); b.st = st;
    if (is_t0) (void)xb_add(&bar[XB_XCNT(b.x)], 1u);
    return b;
}
__device__ __forceinline__ void xcd_barrier_complete(unsigned* bar, unsigned x, unsigned& nloc, unsigned& nx) {
    const unsigned G = gridDim.x * gridDim.y * gridDim.z;
    unsigned sum, cnt, mine, sp = 0u;
    for (;;) {
        sum = 0u; cnt = 0u; mine = 0u;
#pragma unroll
        for (unsigned j = 0; j < 16; ++j) { const unsigned c = xb_ld(&bar[XB_XCNT(j)]); sum += c; cnt += (c > 0u) ? 1u : 0u; mine = (j == x) ? c : mine; }
        if (sum == G) break;
        __builtin_amdgcn_s_sleep(1);
        if ((++sp & 255u) == 0u) { if (xb_ld(&bar[XB_TMO])) break; if (sp > XB_SPIN_CAP) { atomicAdd(&bar[XB_TMO], 1u); break; } }
    }
    nloc = mine > 0u ? mine : 1u; nx = cnt > 0u ? cnt : 1u;
}

__device__ __forceinline__ void xcd_barrier(const XcdBarrier& b, bool is_t0) {
    asm volatile("s_waitcnt vmcnt(0)" ::: "memory");
    __syncthreads();
    if (is_t0) {
        unsigned* bar = b.bar;
        __builtin_amdgcn_s_waitcnt(0);
        unsigned nloc = b.st[0], nx = b.st[1];
        if (nloc == 0u) { xcd_barrier_complete(bar, b.x, nloc, nx); b.st[0] = nloc; b.st[1] = nx; }
        const unsigned old = xb_add(&bar[XB_XSUB(b.x)], 1u);
        const unsigned gen = old / nloc;
        if (old + 1u == (gen + 1u) * nloc) {
            __builtin_amdgcn_fence(__ATOMIC_RELEASE, "agent");
            asm volatile("s_waitcnt vmcnt(0)" ::: "memory");
            const unsigned og = xb_add(&bar[XB_TOP], 1u);
            const unsigned tg = og / nx;
            if (og + 1u == (tg + 1u) * nx) xb_add(&bar[XB_TOPGEN], 1u);
            else XB_SPIN(xb_ld(&bar[XB_TOPGEN]) == tg, bar);
            __builtin_amdgcn_fence(__ATOMIC_ACQUIRE, "agent");
            xb_add(&bar[XB_XGEN(b.x)], 1u);
            asm volatile("s_waitcnt vmcnt(0)" ::: "memory");
        } else {
            XB_SPIN(xb_ld(&bar[XB_XGEN(b.x)]) == gen, bar);
            __builtin_amdgcn_fence(__ATOMIC_ACQUIRE, "agent");
            asm volatile("s_waitcnt vmcnt(0)" ::: "memory");
        }
    }
    __syncthreads();
}

namespace att {
constexpr int SLOTB = 8192;
constexpr int L_K = 0, L_V = 2 * SLOTB, L_WS = 4 * SLOTB, L_OST = L_WS + 8 * 256, L_RPB = L_OST + 8 * 4096, L_END = L_RPB + 2048;
constexpr float THR = 8.0f;
__device__ __forceinline__ int crow(int r, int hi) { return (r & 3) + 8 * (r >> 2) + 4 * hi; }
__device__ __forceinline__ s16x4 vtr(const LAS unsigned char* p) { return __builtin_bit_cast(s16x4, __builtin_amdgcn_ds_read_tr16_b64_v4i16((LAS v4i16_t*)p)); }
__device__ __forceinline__ float rowmax32(const f32x16& p0, const f32x16& p1) {
    float a = fmaxf(p0[0], p1[0]);
#pragma unroll
    for (int r = 1; r < 16; ++r) a = fmaxf(a, fmaxf(p0[r], p1[r]));
    auto rr = __builtin_amdgcn_permlane32_swap(__float_as_uint(a), __float_as_uint(a), false, false);
    return fmaxf(__uint_as_float(rr[0]), __uint_as_float(rr[1]));
}
__device__ __forceinline__ float halfsum(float v) {
    auto rr = __builtin_amdgcn_permlane32_swap(__float_as_uint(v), __float_as_uint(v), false, false);
    return __uint_as_float(rr[0]) + __uint_as_float(rr[1]);
}
#define ATT_WAIT_BAR() asm volatile("s_waitcnt vmcnt(0) lgkmcnt(0)\n\ts_barrier" ::: "memory")

template <int MODE>
__device__ __forceinline__ void attn_unit(Frame& F, int b, int h, int qb, int qcol, int kcol, int vcol, int ycol, float sink2, const float* rpb) {
    LAS unsigned char* lds = F.lds;
    const int lane = F.lane, r32 = lane & 31, hi = lane >> 5, wid = F.wave;
    const bf16_t* PROJ = (const bf16_t*)(F.ws + WS_PROJ); bf16_t* Y = (bf16_t*)(F.ws + WS_H);
    const int ctxrow = NLAT + CTXL * b, latrow = SEQ * b;
    const int qrow0 = (MODE == 3) ? ctxrow : latrow + 256 * qb;
    const int qw0 = 256 * qb + 32 * wid;
    int lt_lo = 0, nloc = 0;
    if (MODE == 0) { lt_lo = 0; nloc = 128; }
    if (MODE == 1) { const int a = (256 * qb - 128) >> 6, e = (256 * qb + 255 + 128) >> 6; lt_lo = a < 0 ? 0 : a; nloc = (e > 127 ? 127 : e) - lt_lo + 1; }
    if (MODE == 2) { const int a = 4 * qb - 4, e0 = 4 * qb - 1; lt_lo = a < 0 ? 0 : (a > 120 ? 120 : a); const int e = (e0 < 0 ? 0 : (e0 > 120 ? 120 : e0)) + 7; nloc = e - lt_lo + 1; }
    const int NT = 4 + nloc;
    const int rw = 4 * qb + (wid >> 1); const int rs = rw - 4 < 0 ? 0 : (rw - 4 > 120 ? 120 : rw - 4);
    const int qc = 32 * (wid & 1) + r32; const int cs = qc - 8 < 0 ? 0 : (qc - 8 > 48 ? 48 : qc - 8);
    LAS float* wsf = (LAS float*)(lds + L_WS) + wid * 64;
    LAS float* rpbL = (LAS float*)(lds + L_RPB);
    if (MODE == 2) { for (int i = F.tid; i < 465; i += NTHREADS) rpbL[i] = rpb[i] * LOG2E; }
    const int vp0 = ((lane >> 4) & 1) * 32 + (lane & 3) * 8 + (4 * hi + ((lane & 15) >> 2)) * 64;
#define ATT_KROW(t) ((t) < 4 ? ctxrow + 64 * (t) : latrow + 64 * (lt_lo + (t) - 4))
#define ATT_DMA(t, slot) do { const int kr_ = ATT_KROW(t); \
        __builtin_amdgcn_global_load_lds((const unsigned*)(PROJ + (size_t)(kr_ + lane) * PP + kcol + wid * 8), (LAS unsigned*)(lds + L_K + (slot) * SLOTB + wid * 1024), 16, 0, 0); \
        __builtin_amdgcn_global_load_lds((const unsigned*)(PROJ + (size_t)(kr_ + 16 * (wid & 3) + (lane >> 2)) * PP + vcol + (wid >> 2) * 32 + (lane & 3) * 8), (LAS unsigned*)(lds + L_V + (slot) * SLOTB + wid * 1024), 16, 0, 0); } while (0)
    ATT_DMA(0, 0);
    bf16x8 qr[4];
#pragma unroll
    for (int d0 = 0; d0 < 4; ++d0) qr[d0] = *(const bf16x8*)(PROJ + (size_t)(qrow0 + 32 * wid + r32) * PP + qcol + d0 * 16 + hi * 8);
    float mhat = 0.f, l = 0.f; f32x16 o0 = {}, o1 = {}, negm = {};
    ATT_WAIT_BAR();
    for (int t = 0; t < NT; ++t) {
        const int slot = t & 1;
        if (t + 1 < NT) ATT_DMA(t + 1, slot ^ 1);
        bool rel = true; int kb0 = 0;
        if (MODE == 1 && t >= 4) { kb0 = 64 * (lt_lo + t - 4); rel = (kb0 + 63 >= qw0 - 128) && (kb0 <= qw0 + 31 + 128); }
        if (MODE == 2 && t >= 4) { kb0 = lt_lo + t - 4; rel = (kb0 >= rs) && (kb0 < rs + 8); }
        if (rel) {
            const LAS unsigned char* kb = lds + L_K + slot * SLOTB + hi * 1024 + r32 * 16;
            f32x16 p0 = negm, p1 = negm;
#pragma unroll
            for (int d0 = 0; d0 < 4; ++d0) {
                const bf16x8 b0 = *(const LAS bf16x8*)(kb + d0 * 2048), b1 = *(const LAS bf16x8*)(kb + d0 * 2048 + 512);
                p0 = __builtin_amdgcn_mfma_f32_32x32x16_bf16(b0, qr[d0], p0, 0, 0, 0);
                p1 = __builtin_amdgcn_mfma_f32_32x32x16_bf16(b1, qr[d0], p1, 0, 0, 0);
            }
            if (MODE == 1 && t >= 4) {
                const int dq = kb0 - (qw0 + r32);
#pragma unroll
                for (int r = 0; r < 16; ++r) { const int kc = crow(r, hi); const int d0_ = dq + kc, d1_ = d0_ + 32;
                    if (d0_ > 128 || d0_ < -128) p0[r] = -INFINITY; if (d1_ > 128 || d1_ < -128) p1[r] = -INFINITY; }
            }
            if (MODE == 2 && t >= 4) {
                const LAS float* bt = rpbL + (kb0 - rw + 7) * 31 + (15 - qc);
#pragma unroll
                for (int r = 0; r < 16; ++r) { const int kc = crow(r, hi);
                    const bool v0 = (kc >= cs) && (kc < cs + 16), v1 = (kc + 32 >= cs) && (kc + 32 < cs + 16);
                    p0[r] = v0 ? p0[r] + bt[v0 ? kc : qc] : -INFINITY; p1[r] = v1 ? p1[r] + bt[v1 ? kc + 32 : qc] : -INFINITY; }
            }
            const float rm = rowmax32(p0, p1);
            if (t == 0 || __any(rm > THR)) {
                const float dl = (t == 0) ? rm : fmaxf(rm, 0.f);
                mhat += dl;
#pragma unroll
                for (int r = 0; r < 16; ++r) { p0[r] -= dl; p1[r] -= dl; negm[r] = -mhat; }
                if (t > 0) { const float f = __builtin_amdgcn_exp2f(-dl); l *= f; if (hi == 0) wsf[r32] = f; LDS_WAIT();
#pragma unroll
                    for (int r = 0; r < 16; ++r) { const float fr_ = wsf[crow(r, hi)]; o0[r] *= fr_; o1[r] *= fr_; }
                    LDS_WAIT(); }
            }
            float ls = 0.f;
#pragma unroll
            for (int r = 0; r < 16; ++r) { p0[r] = __builtin_amdgcn_exp2f(p0[r]); p1[r] = __builtin_amdgcn_exp2f(p1[r]); ls += p0[r] + p1[r]; }
            l += ls;
            u32x4 pw[4];
#pragma unroll
            for (int k = 0; k < 4; ++k) { pw[0][k] = cvtpk(p0[2 * k], p0[2 * k + 1]); pw[1][k] = cvtpk(p0[8 + 2 * k], p0[9 + 2 * k]); pw[2][k] = cvtpk(p1[2 * k], p1[2 * k + 1]); pw[3][k] = cvtpk(p1[8 + 2 * k], p1[9 + 2 * k]); }
            const LAS unsigned char* vb = lds + L_V + slot * SLOTB + vp0;
#pragma unroll
            for (int ks = 0; ks < 4; ++ks) {
                const s16x4 a0 = vtr(vb + ks * 1024), a1 = vtr(vb + ks * 1024 + 512), c0 = vtr(vb + 4096 + ks * 1024), c1 = vtr(vb + 4096 + ks * 1024 + 512);
                const bf16x8 v0 = {a0[0], a0[1], a0[2], a0[3], a1[0], a1[1], a1[2], a1[3]}, v1 = {c0[0], c0[1], c0[2], c0[3], c1[0], c1[1], c1[2], c1[3]};
                o0 = __builtin_amdgcn_mfma_f32_32x32x16_bf16(__builtin_bit_cast(bf16x8, pw[ks]), v0, o0, 0, 0, 0);
                o1 = __builtin_amdgcn_mfma_f32_32x32x16_bf16(__builtin_bit_cast(bf16x8, pw[ks]), v1, o1, 0, 0, 0);
            }
        }
        ATT_WAIT_BAR();
    }
    l = halfsum(l);
    if (MODE == 1 || MODE == 3) l += __builtin_amdgcn_exp2f(sink2 - mhat);
    if (hi == 0) wsf[32 + r32] = l;
    LDS_WAIT();
    bf16_t* stg = (bf16_t*)(lds + L_OST + wid * 4096);
    LAS bf16_t* stgl = (LAS bf16_t*)(lds + L_OST + wid * 4096);
#pragma unroll
    for (int r = 0; r < 16; ++r) { const int orow = crow(r, hi); const float rl = __builtin_amdgcn_rcpf(wsf[32 + orow]);
        stgl[orow * 64 + r32] = (bf16_t)(cvtpk(o0[r] * rl, 0.f) & 0xffffu); stgl[orow * 64 + 32 + r32] = (bf16_t)(cvtpk(o1[r] * rl, 0.f) & 0xffffu); }
    LDS_WAIT();
    (void)stg;
#pragma unroll
    for (int i = 0; i < 4; ++i) { const int row = i * 8 + (lane >> 3), ch = lane & 7; const u32x4 v = *(const LAS u32x4*)(stgl + row * 64 + ch * 8);
        *(u32x4*)(Y + (size_t)(qrow0 + 32 * wid + row) * DM + ycol + ch * 8) = v; }
    LDS_WAIT();
#undef ATT_KROW
#undef ATT_DMA
}
}

namespace ml {
__device__ __forceinline__ float scan_add(float v, int lane, int dir) {
#pragma unroll
    for (int o = 1; o < 64; o <<= 1) { const float t = shfl_idx(v, (dir ? lane + o : lane - o) & 63); const bool ok = dir ? (lane + o < 64) : (lane >= o); v += ok ? t : 0.f; }
    return v;
}
__device__ __forceinline__ float scan_max(float v, int lane, int dir) {
#pragma unroll
    for (int o = 1; o < 64; o <<= 1) { const float t = shfl_idx(v, (dir ? lane + o : lane - o) & 63); const bool ok = dir ? (lane + o < 64) : (lane >= o); v = ok ? fmaxf(v, t) : v; }
    return v;
}
__device__ __forceinline__ float logsigmoid(float x) { return fminf(x, 0.f) - log1pf(__expf(-fabsf(x))); }
__device__ __forceinline__ int img_off(int tok, int d) { return (d >> 5) * 4096 + (tok >> 4) * 1024 + (tok & 15) * 64 + (d & 31) * 2; }
__device__ __forceinline__ int blk_row0(int b, int blk) { return blk < 4 ? NLAT + CTXL * b + 64 * blk : SEQ * b + 64 * (blk - 4); }
__device__ __forceinline__ int chunk_of(int dir, int blk) { return dir == 0 ? blk : (blk < 4 ? 3 - blk : 4 + 127 - (blk - 4)); }

__device__ __forceinline__ void pass1(Frame& F, int layer) {
    const int gw = F.bid * NWAVES + F.wave, NGW = F.G * NWAVES, lane = F.lane, r32 = lane & 31, hi = lane >> 5;
    LAS unsigned char* wl = F.lds + F.wave * 16384;
    const bf16_t* PROJ = (const bf16_t*)(F.ws + WS_PROJ); const float* GATES = (const float*)(F.ws + WS_GATES);
    const float* gb = F.ka->in[IN_CGB] + layer * 16;
    float* DS = (float*)(F.ws + WS_DS); float* ZD = (float*)(F.ws + WS_ZD); float* GC = (float*)(F.ws + WS_GC); float* ML = (float*)(F.ws + WS_ML);
    const int vp0 = ((lane >> 4) & 1) * 32 + (lane & 3) * 8 + (4 * hi + ((lane & 15) >> 2)) * 64;
    for (int wu = gw; wu < NCHAIN * NCHUNK; wu += NGW) {
        const int chain = wu / NCHUNK, c = wu % NCHUNK, dir = chain & 1, h = (chain >> 1) & 3, b = chain >> 3;
        const int row0 = blk_row0(b, chunk_of(dir, c));
        const float gi = GATES[(size_t)(row0 + lane) * 16 + dir * 8 + h] + gb[dir * 8 + h];
        const float lf = logsigmoid(GATES[(size_t)(row0 + lane) * 16 + dir * 8 + 4 + h] + gb[dir * 8 + 4 + h]);
        const float cum = scan_add(lf, lane, dir);
        const float G = wave_sum(lf, lane);
        const float bb = gi - cum, mloc = wave_max(bb, lane), w = __expf(bb - mloc);
#pragma unroll
        for (int it = 0; it < 8; ++it) { const int tok = (lane >> 3) + 8 * it, d = 8 * (lane & 7);
            const u32x4 kv = *(const u32x4*)(PROJ + (size_t)(row0 + tok) * PP + PC_CK + 64 * h + d), vv = *(const u32x4*)(PROJ + (size_t)(row0 + tok) * PP + PC_CV + 64 * h + d);
            const float wt = shfl_idx(w, tok);
            u32x4 ko; ko.x = cvtpk(bflo(kv.x) * wt, bfhi(kv.x) * wt); ko.y = cvtpk(bflo(kv.y) * wt, bfhi(kv.y) * wt); ko.z = cvtpk(bflo(kv.z) * wt, bfhi(kv.z) * wt); ko.w = cvtpk(bflo(kv.w) * wt, bfhi(kv.w) * wt);
            *(LAS u32x4*)(wl + img_off(tok, d)) = vv; *(LAS u32x4*)(wl + 8192 + img_off(tok, d)) = ko; }
        LDS_WAIT();
        f32x16 acc[2][2] = {};
#pragma unroll
        for (int s = 0; s < 4; ++s) {
            bf16x8 af[2], bfr[2];
#pragma unroll
            for (int x = 0; x < 2; ++x) { const s16x4 a0 = att::vtr(wl + vp0 + x * 4096 + s * 1024), a1 = att::vtr(wl + vp0 + x * 4096 + s * 1024 + 512);
                const s16x4 c0 = att::vtr(wl + 8192 + vp0 + x * 4096 + s * 1024), c1 = att::vtr(wl + 8192 + vp0 + x * 4096 + s * 1024 + 512);
                af[x] = (bf16x8){a0[0], a0[1], a0[2], a0[3], a1[0], a1[1], a1[2], a1[3]}; bfr[x] = (bf16x8){c0[0], c0[1], c0[2], c0[3], c1[0], c1[1], c1[2], c1[3]}; }
#pragma unroll
            for (int vb = 0; vb < 2; ++vb)
#pragma unroll
                for (int kb = 0; kb < 2; ++kb) acc[vb][kb] = __builtin_amdgcn_mfma_f32_32x32x16_bf16(af[vb], bfr[kb], acc[vb][kb], 0, 0, 0);
        }
        float* dsp = DS + (size_t)(chain * NCHUNK + c) * 4096;
#pragma unroll
        for (int vb = 0; vb < 2; ++vb)
#pragma unroll
            for (int kb = 0; kb < 2; ++kb)
#pragma unroll
                for (int r = 0; r < 16; ++r) dsp[(32 * vb + att::crow(r, hi)) * 64 + 32 * kb + r32] = acc[vb][kb][r];
        float z = 0.f;
#pragma unroll 8
        for (int tok = 0; tok < 64; ++tok) z += bf2f(*(const LAS bf16_t*)(wl + 8192 + img_off(tok, lane)));
        ZD[(size_t)(chain * NCHUNK + c) * 64 + lane] = z;
        if (lane == 0) { GC[chain * NCHUNK + c] = G; ML[chain * NCHUNK + c] = mloc; }
        LDS_WAIT();
    }
}

__device__ __forceinline__ void pass2(Frame& F) {
    const float* DS = (const float*)(F.ws + WS_DS); const float* ZD = (const float*)(F.ws + WS_ZD); const float* GC = (const float*)(F.ws + WS_GC); const float* ML = (const float*)(F.ws + WS_ML);
    bf16_t* SBF = (bf16_t*)(F.ws + WS_SBF); float* ZC = (float*)(F.ws + WS_ZC); float* MC = (float*)(F.ws + WS_MC);
    LAS float* cf = (LAS float*)F.lds;
    for (int it = F.bid; it < NCHAIN * 16; it += F.G) {
        const int chain = it >> 4, part = it & 15;
        __syncthreads();
        if (F.wave == 0) {
            const int ln = F.lane; const bool valid = ln < 44; float g[3], mlv[3];
#pragma unroll
            for (int j = 0; j < 3; ++j) { g[j] = valid ? GC[chain * NCHUNK + 3 * ln + j] : 0.f; mlv[j] = valid ? ML[chain * NCHUNK + 3 * ln + j] : -INFINITY; }
            const float tot = g[0] + g[1] + g[2]; const float excl = ml::scan_add(tot, ln, 0) - tot;
            const float pg[3] = {excl, excl + g[0], excl + g[0] + g[1]};
            const float a0 = mlv[0] - pg[0], a1 = mlv[1] - pg[1], a2 = mlv[2] - pg[2];
            const float inclm = ml::scan_max(fmaxf(a0, fmaxf(a1, a2)), ln, 0); float exclm = shfl_idx(inclm, (ln - 1) & 63); if (ln == 0) exclm = -INFINITY;
            const float em[3] = {exclm, fmaxf(exclm, a0), fmaxf(fmaxf(exclm, a0), a1)};
#pragma unroll
            for (int j = 0; j < 3; ++j) { const int c = 3 * ln + j; const float m = pg[j] + fmaxf(0.f, em[j]); const float mn = fmaxf(g[j] + m, g[j] + mlv[j]);
                if (valid) { cf[2 * c] = __expf(g[j] + m - mn); cf[2 * c + 1] = __expf(g[j] + mlv[j] - mn); if (part == 0) MC[chain * NCHUNK + c] = m; } }
        }
        __syncthreads();
        if (F.tid < 256) {
            const int e = part * 256 + F.tid; const float* dp = DS + (size_t)chain * NCHUNK * 4096 + e; bf16_t* sp = SBF + (size_t)chain * NCHUNK * 4096 + e;
            float s = 0.f;
            for (int c0 = 0; c0 < NCHUNK; c0 += 66) { float d[66];
#pragma unroll
                for (int j = 0; j < 66; ++j) d[j] = dp[(size_t)(c0 + j) * 4096];
#pragma unroll
                for (int j = 0; j < 66; ++j) { sp[(size_t)(c0 + j) * 4096] = (bf16_t)(cvtpk(s, 0.f) & 0xffffu); s = cf[2 * (c0 + j)] * s + cf[2 * (c0 + j) + 1] * d[j]; } }
        } else if (F.tid < 260) {
            const int e = part * 4 + (F.tid - 256); const float* dp = ZD + (size_t)chain * NCHUNK * 64 + e; float* zp = ZC + (size_t)chain * NCHUNK * 64 + e;
            float s = 0.f;
            for (int c = 0; c < NCHUNK; ++c) { const float d = dp[(size_t)c * 64]; zp[(size_t)c * 64] = s; s = cf[2 * c] * s + cf[2 * c + 1] * d; }
        }
    }
    __syncthreads();
}

__device__ __forceinline__ void pass3(Frame& F, int layer, int blk_lo) {
    const int gw = F.bid * NWAVES + F.wave, NGW = F.G * NWAVES, lane = F.lane, r32_ = lane & 31, hi_ = lane >> 5;
    LAS unsigned char* wl = F.lds + F.wave * 19456;
    LAS float* bvec = (LAS float*)(wl + 16384); LAS float* Apl = bvec + 128; LAS float* efl = bvec + 256; LAS float* fll = bvec + 384; LAS float* zl = bvec + 512; LAS float* rden = bvec + 640;
    LAS float* st = (LAS float*)(wl + 8192);
    const bf16_t* PROJ = (const bf16_t*)(F.ws + WS_PROJ); const float* GATES = (const float*)(F.ws + WS_GATES);
    const float* gb = F.ka->in[IN_CGB] + layer * 16;
    const bf16_t* SBF = (const bf16_t*)(F.ws + WS_SBF); const float* ZC = (const float*)(F.ws + WS_ZC); const float* MC = (const float*)(F.ws + WS_MC);
    bf16_t* Y = (bf16_t*)(F.ws + WS_H);
    const int vp0 = ((lane >> 4) & 1) * 32 + (lane & 3) * 8 + (4 * hi_ + ((lane & 15) >> 2)) * 64;
    const int nblk = NCHUNK - blk_lo;
    for (int wu2 = gw; wu2 < 16 * nblk; wu2 += NGW) {
        const int wu = wu2 >> 1, tbsel = wu2 & 1;
        const int bh = wu / nblk, blk = blk_lo + wu % nblk, b = bh >> 2, h = bh & 3;
        const int row0 = blk_row0(b, blk);
        LDS_WAIT();
#pragma unroll
        for (int it = 0; it < 8; ++it) { const int tok = (lane >> 3) + 8 * it, d = 8 * (lane & 7);
            *(LAS u32x4*)(wl + img_off(tok, d)) = *(const u32x4*)(PROJ + (size_t)(row0 + tok) * PP + PC_CV + 64 * h + d); }
#pragma unroll
        for (int dir = 0; dir < 2; ++dir) {
            const int c = chunk_of(dir, blk), chain = (b * 4 + h) * 2 + dir;
            const float gi = GATES[(size_t)(row0 + lane) * 16 + dir * 8 + h] + gb[dir * 8 + h];
            const float lf = logsigmoid(GATES[(size_t)(row0 + lane) * 16 + dir * 8 + 4 + h] + gb[dir * 8 + 4 + h]);
            const float cum = scan_add(lf, lane, dir);
            const float bb = gi - cum, pm = scan_max(bb, lane, dir), mc = MC[chain * NCHUNK + c];
            const float Apv = fmaxf(mc, pm);
            zl[dir * 64 + lane] = ZC[(size_t)(chain * NCHUNK + c) * 64 + lane];
            bvec[dir * 64 + lane] = bb; Apl[dir * 64 + lane] = Apv; efl[dir * 64 + lane] = __expf(mc - Apv); fll[dir * 64 + lane] = __expf(-(cum + Apv));
        }
        LDS_WAIT();
#pragma unroll 1
        for (int tb = tbsel; tb <= tbsel; ++tb) {
            int r32 = r32_, hi = hi_; asm volatile("" : "+v"(r32), "+v"(hi));
            const int t = 32 * tb + r32;
            bf16x8 qf[4];
#pragma unroll
            for (int d0 = 0; d0 < 4; ++d0) qf[d0] = *(const bf16x8*)(PROJ + (size_t)(row0 + t) * PP + PC_CQ + 64 * h + 16 * d0 + 8 * hi);
            f32x16 hs0 = {}, hs1 = {};
#pragma unroll 1
            for (int dir = 0; dir < 2; ++dir) {
                const int c = chunk_of(dir, blk), chain = (b * 4 + h) * 2 + dir;
                const bf16_t* Sp = SBF + (size_t)(chain * NCHUNK + c) * 4096; const LAS float* zp = zl + dir * 64;
                int r32 = r32_, hi = hi_; asm volatile("" : "+v"(r32), "+v"(hi));
                const float Ap_t = Apl[dir * 64 + t], e_t = efl[dir * 64 + t], fl_t = fll[dir * 64 + t];
                f32x16 P0 = {}, P1 = {};
#pragma unroll
                for (int d0 = 0; d0 < 4; ++d0) {
                    const bf16x8 k0 = *(const bf16x8*)(PROJ + (size_t)(row0 + r32) * PP + PC_CK + 64 * h + 16 * d0 + 8 * hi), k1 = *(const bf16x8*)(PROJ + (size_t)(row0 + 32 + r32) * PP + PC_CK + 64 * h + 16 * d0 + 8 * hi);
                    P0 = __builtin_amdgcn_mfma_f32_32x32x16_bf16(k0, qf[d0], P0, 0, 0, 0); P1 = __builtin_amdgcn_mfma_f32_32x32x16_bf16(k1, qf[d0], P1, 0, 0, 0); }
                float den = 0.f;
#pragma unroll
                for (int r = 0; r < 16; ++r) { const int s0 = att::crow(r, hi), s1 = 32 + s0; const bool ok0 = dir ? (s0 >= t) : (s0 <= t), ok1 = dir ? (s1 >= t) : (s1 <= t);
                    const float w0 = ok0 ? __expf(bvec[dir * 64 + s0] - Ap_t) : 0.f, w1 = ok1 ? __expf(bvec[dir * 64 + s1] - Ap_t) : 0.f;
                    P0[r] *= w0; P1[r] *= w1; den += P0[r] + P1[r]; }
                u32x4 pw[4];
#pragma unroll
                for (int k = 0; k < 4; ++k) { pw[0][k] = cvtpk(P0[2 * k], P0[2 * k + 1]); pw[1][k] = cvtpk(P0[8 + 2 * k], P0[9 + 2 * k]); pw[2][k] = cvtpk(P1[2 * k], P1[2 * k + 1]); pw[3][k] = cvtpk(P1[8 + 2 * k], P1[9 + 2 * k]); }

                f32x16 n0 = {}, n1 = {}; float zq = 0.f;
#pragma unroll
                for (int d0 = 0; d0 < 4; ++d0) { const u32x4 qw = __builtin_bit_cast(u32x4, qf[d0]); u32x4 o;
                    const f32x4 za = *(const LAS f32x4*)(zp + 16 * d0 + 8 * hi), zb = *(const LAS f32x4*)(zp + 16 * d0 + 8 * hi + 4);
                    const float q0 = bflo(qw.x), q1 = bfhi(qw.x), q2 = bflo(qw.y), q3 = bfhi(qw.y), q4 = bflo(qw.z), q5 = bfhi(qw.z), q6 = bflo(qw.w), q7 = bfhi(qw.w);
                    zq += (q0 * za[0] + q1 * za[1]) + (q2 * za[2] + q3 * za[3]) + (q4 * zb[0] + q5 * zb[1]) + (q6 * zb[2] + q7 * zb[3]);
                    o.x = cvtpk(q0 * e_t, q1 * e_t); o.y = cvtpk(q2 * e_t, q3 * e_t); o.z = cvtpk(q4 * e_t, q5 * e_t); o.w = cvtpk(q6 * e_t, q7 * e_t);
                    const bf16x8 qs = __builtin_bit_cast(bf16x8, o);
                    const bf16x8 s0 = *(const bf16x8*)(Sp + (size_t)r32 * 64 + 16 * d0 + 8 * hi), s1 = *(const bf16x8*)(Sp + (size_t)(32 + r32) * 64 + 16 * d0 + 8 * hi);
                    n0 = __builtin_amdgcn_mfma_f32_32x32x16_bf16(qs, s0, n0, 0, 0, 0); n1 = __builtin_amdgcn_mfma_f32_32x32x16_bf16(qs, s1, n1, 0, 0, 0); }

                den = att::halfsum(den) + e_t * att::halfsum(zq);
                const float rd = 1.f / fmaxf(fabsf(den), fl_t);
                LDS_WAIT(); if (hi == 0) rden[r32] = rd; LDS_WAIT();
#pragma unroll
                for (int ks = 0; ks < 4; ++ks) {
                    const s16x4 a0 = att::vtr(wl + vp0 + ks * 1024), a1 = att::vtr(wl + vp0 + ks * 1024 + 512), c0 = att::vtr(wl + vp0 + 4096 + ks * 1024), c1 = att::vtr(wl + vp0 + 4096 + ks * 1024 + 512);
                    const bf16x8 v0 = {a0[0], a0[1], a0[2], a0[3], a1[0], a1[1], a1[2], a1[3]}, v1 = {c0[0], c0[1], c0[2], c0[3], c1[0], c1[1], c1[2], c1[3]};
                    n0 = __builtin_amdgcn_mfma_f32_32x32x16_bf16(__builtin_bit_cast(bf16x8, pw[ks]), v0, n0, 0, 0, 0);
                    n1 = __builtin_amdgcn_mfma_f32_32x32x16_bf16(__builtin_bit_cast(bf16x8, pw[ks]), v1, n1, 0, 0, 0); }
#pragma unroll
                for (int r = 0; r < 16; ++r) { const float rr = rden[att::crow(r, hi)]; hs0[r] += n0[r] * rr; hs1[r] += n1[r] * rr; }
            }
            LDS_WAIT();
#pragma unroll
            for (int r = 0; r < 16; ++r) { st[att::crow(r, hi) * 64 + r32] = hs0[r]; st[att::crow(r, hi) * 64 + 32 + r32] = hs1[r]; }
            LDS_WAIT();
#pragma unroll
            for (int it = 0; it < 4; ++it) { const int tk = (lane >> 3) + 8 * it, d = 8 * (lane & 7);
                const u32x4 ow = *(const u32x4*)(PROJ + (size_t)(row0 + 32 * tb + tk) * PP + PC_CO + 64 * h + d);
                const f32x4 ha = *(const LAS f32x4*)(st + tk * 64 + d), hb = *(const LAS f32x4*)(st + tk * 64 + d + 4);
                const float og[8] = {bflo(ow.x), bfhi(ow.x), bflo(ow.y), bfhi(ow.y), bflo(ow.z), bfhi(ow.z), bflo(ow.w), bfhi(ow.w)};
                float yv[8];
#pragma unroll
                for (int j = 0; j < 8; ++j) yv[j] = (j < 4 ? ha[j] : hb[j - 4]) / (1.f + __expf(-og[j]));
                u32x4 w; w.x = cvtpk(yv[0], yv[1]); w.y = cvtpk(yv[2], yv[3]); w.z = cvtpk(yv[4], yv[5]); w.w = cvtpk(yv[6], yv[7]);
                *(u32x4*)(Y + (size_t)(row0 + 32 * tb + tk) * DM + 512 + 64 * h + d) = w; }
            LDS_WAIT();
        }
    }
}
}

namespace attp {
typedef __attribute__((address_space(3))) const char* lds_cptr;
#define SBAR() __builtin_amdgcn_sched_barrier(0)
__device__ __forceinline__ int crow(int r,int hi){return (r&3)+8*(r>>2)+4*hi;}
constexpr int NSLOT=3, SLOTB=8192;
constexpr int NW=8, QBLK=32, KVBLK=64; constexpr int LDS_K=0, LDS_V=NSLOT*SLOTB, LDS_WS=2*NSLOT*SLOTB, LDS_OST=LDS_WS+NW*64*4, LDS_BYTES=LDS_OST+NW*4096;
__device__ __forceinline__ void glds16(const void*gsrc,unsigned lds_dst){unsigned keep;
  asm volatile("s_mov_b32 %0, m0\n\ts_mov_b32 m0, %2\n\ts_nop 0\n\tglobal_load_lds_dwordx4 %1, off\n\ts_mov_b32 m0, %0":"=&s"(keep):"v"(gsrc),"s"(lds_dst):"memory");}
__device__ __forceinline__ float max3f(float a,float b,float c){float r;asm("v_max3_f32 %0, %1, %2, %3":"=v"(r):"v"(a),"v"(b),"v"(c));return r;}
__device__ __forceinline__ float max2f(float a,float b){float r;asm("v_max_f32_e32 %0, %1, %2":"=v"(r):"v"(a),"v"(b));return r;}
__device__ __forceinline__ float fadd_s(float a,float b){float r;asm("v_add_f32_e32 %0, %1, %2":"=v"(r):"v"(a),"v"(b));return r;}
__device__ __forceinline__ float fsub_s(float a,float b){float r;asm("v_sub_f32_e32 %0, %1, %2":"=v"(r):"v"(a),"v"(b));return r;}
__device__ __forceinline__ unsigned cvtpk_s(float lo,float hi){return cvtpk(lo,hi);}
#define WAIT_BAR(N) asm volatile("s_waitcnt vmcnt(" #N ") lgkmcnt(0)\n\ts_barrier":::"memory")

template<bool ZC> __device__ __forceinline__ void qkt(f32x16&p0,f32x16&p1,lds_cptr Kslot,const bf16x8*qr,const f32x16&negm,int r32,int hi){
  lds_cptr kb=Kslot+hi*1024+r32*16;
  #pragma unroll
  for(int d0=0;d0<4;++d0){
    const bf16x8 b0=*(const __attribute__((address_space(3))) bf16x8*)(kb+d0*2048);
    const bf16x8 b1=*(const __attribute__((address_space(3))) bf16x8*)(kb+d0*2048+512);
    if(d0==0){ if(ZC){p0=__builtin_amdgcn_mfma_f32_32x32x16_bf16(b0,qr[0],(f32x16){},0,0,0);p1=__builtin_amdgcn_mfma_f32_32x32x16_bf16(b1,qr[0],(f32x16){},0,0,0);} else {p0=__builtin_amdgcn_mfma_f32_32x32x16_bf16(b0,qr[0],negm,0,0,0);p1=__builtin_amdgcn_mfma_f32_32x32x16_bf16(b1,qr[0],negm,0,0,0);} }
    else{p0=__builtin_amdgcn_mfma_f32_32x32x16_bf16(b0,qr[d0],p0,0,0,0);p1=__builtin_amdgcn_mfma_f32_32x32x16_bf16(b1,qr[d0],p1,0,0,0);}}
}
__device__ __forceinline__ void kload8(bf16x8*kf,lds_cptr kp){
  kf[0]=*(const __attribute__((address_space(3))) bf16x8*)(kp);      kf[1]=*(const __attribute__((address_space(3))) bf16x8*)(kp+512);
  kf[2]=*(const __attribute__((address_space(3))) bf16x8*)(kp+2048); kf[3]=*(const __attribute__((address_space(3))) bf16x8*)(kp+2560);
  kf[4]=*(const __attribute__((address_space(3))) bf16x8*)(kp+4096); kf[5]=*(const __attribute__((address_space(3))) bf16x8*)(kp+4608);
  kf[6]=*(const __attribute__((address_space(3))) bf16x8*)(kp+6144); kf[7]=*(const __attribute__((address_space(3))) bf16x8*)(kp+6656);
}
__device__ __forceinline__ void kload2(bf16x8*kf,lds_cptr kp,int j){ kf[2*j]=*(const __attribute__((address_space(3))) bf16x8*)(kp+j*2048); kf[2*j+1]=*(const __attribute__((address_space(3))) bf16x8*)(kp+j*2048+512); }
__device__ __forceinline__ s16x4 vtr(lds_cptr p){ return __builtin_bit_cast(s16x4,__builtin_amdgcn_ds_read_tr16_b64_v4i16((__attribute__((address_space(3))) v4i16_t*)p)); }
__device__ __forceinline__ float rowmax(const f32x16&p0,const f32x16&p1){
  float a=max3f(p0[0],p0[1],p1[0]),b=max3f(p0[2],p0[3],p1[1]);a=max3f(a,p1[2],p1[3]);
  #pragma unroll
  for(int r=4;r<16;r+=4){a=max3f(a,p0[r],p0[r+1]);b=max3f(b,p0[r+2],p0[r+3]);a=max3f(a,p1[r],p1[r+1]);b=max3f(b,p1[r+2],p1[r+3]);}
  const float m=max2f(a,b);
  auto rr=__builtin_amdgcn_permlane32_swap(__float_as_uint(m),__float_as_uint(m),false,false);
  return max2f(__uint_as_float(rr[0]),__uint_as_float(rr[1]));
}
__device__ __forceinline__ void pv(f32x16*o,int vb,bf16x8 pa0,bf16x8 pa1,bf16x8 pa2,bf16x8 pa3){
  #pragma unroll
  for(int d0=0;d0<2;++d0){s16x4 lo[4],hi[4];
    #pragma unroll
    for(int ks=0;ks<4;++ks){
      asm volatile("ds_read_b64_tr_b16 %0,%1 offset:%c2":"=&v"(lo[ks]):"v"(vb),"i"(d0*4096+ks*1024):"memory");
      asm volatile("ds_read_b64_tr_b16 %0,%1 offset:%c2":"=&v"(hi[ks]):"v"(vb),"i"(d0*4096+ks*1024+512):"memory");}
    asm volatile("s_waitcnt lgkmcnt(0)":::"memory");SBAR();
    #define PK(k) (bf16x8){lo[k][0],lo[k][1],lo[k][2],lo[k][3],hi[k][0],hi[k][1],hi[k][2],hi[k][3]}
    o[d0]=__builtin_amdgcn_mfma_f32_32x32x16_bf16(pa0,PK(0),o[d0],0,0,0);
    o[d0]=__builtin_amdgcn_mfma_f32_32x32x16_bf16(pa1,PK(1),o[d0],0,0,0);
    o[d0]=__builtin_amdgcn_mfma_f32_32x32x16_bf16(pa2,PK(2),o[d0],0,0,0);
    o[d0]=__builtin_amdgcn_mfma_f32_32x32x16_bf16(pa3,PK(3),o[d0],0,0,0);
    #undef PK
  }
}


template<int THRL,int MODE> __device__ __forceinline__ void attn_unit_pipe(Frame& F,int b,int h,int qb,int qcol,int kcol,int vcol,int ycol,float sink2,const float*rpb){
  int lane_=F.lane; asm volatile("":"+v"(lane_));
  const int lane=lane_,r32=lane&31,hi=lane>>5; const int wid=F.wave; (void)h;
  const bf16_t*PROJ=(const bf16_t*)(F.ws+WS_PROJ); bf16_t*Yb=(bf16_t*)(F.ws+WS_H);
  const int ctxrow=NLAT+CTXL*b,latrow=SEQ*b; LAS unsigned char*shm=F.lds;
  const int qrow0=(MODE==3)?ctxrow:latrow+256*qb;
  int lt_lo=0,nloc=0;
  if(MODE==0){nloc=128;}
  if(MODE==1){const int a_=(256*qb-128)>>6,e_=(256*qb+255+128)>>6; lt_lo=a_<0?0:a_; nloc=(e_>127?127:e_)-lt_lo+1;}
  if(MODE==2){const int a_=4*qb-4,e0_=4*qb-1; lt_lo=a_<0?0:(a_>120?120:a_); int e_=(e0_<0?0:(e0_>120?120:e0_))+7; nloc=e_-lt_lo+1; if(nloc&1)++nloc;}
  const int qw0=256*qb+32*wid;
  const int rw=4*qb+(wid>>1); const int rs=rw-4<0?0:(rw-4>120?120:rw-4);
  const int qc=32*(wid&1)+r32; const int cs=qc-8<0?0:(qc-8>48?48:qc-8);
  LAS float*rpbL=(LAS float*)(shm+LDS_BYTES);
  if(MODE==2){ for(int i=wid*64+lane;i<465;i+=512) rpbL[i]=rpb[i]*LOG2E; }
  unsigned vm0=0u,vm1=0u;
  if(MODE==2){ _Pragma("unroll") for(int r=0;r<16;++r){ const int kc_=crow(r,hi); if(kc_>=cs&&kc_<cs+16)vm0|=1u<<r; if(kc_+32>=cs&&kc_+32<cs+16)vm1|=1u<<r; } }
  const bf16_t*Qw=PROJ+(size_t)(qrow0+wid*QBLK)*PP+qcol;
  const unsigned lds0=(unsigned)(uintptr_t)shm;
  LAS float*wsf=(LAS float*)(shm+LDS_WS)+wid*64;
  const bf16_t*ksrc=PROJ+(size_t)lane*PP+kcol+wid*8;
  const bf16_t*vsrc=PROJ+(size_t)(16*(wid&3)+(lane>>2))*PP+vcol+(wid>>2)*32+(lane&3)*8;
  #define KROW(t) ((size_t)((t)<4?ctxrow+64*(t):latrow+64*(lt_lo+(t)-4))*PP)
  const unsigned kdst=lds0+LDS_K+wid*1024, vdst=lds0+LDS_V+wid*1024;
  #define DMA_K(t,slot) glds16(ksrc+KROW(t),(unsigned)__builtin_amdgcn_readfirstlane(kdst+(slot)))
  #define DMA_V(t,slot) glds16(vsrc+KROW(t),(unsigned)__builtin_amdgcn_readfirstlane(vdst+(slot)))
  const int vb0=(int)(lds0+LDS_V)+((lane>>4)&1)*32+(lane&3)*8+(4*hi+((lane&15)>>2))*64;
  const lds_cptr Kbase=(lds_cptr)shm+LDS_K; bf16x8 kf[8];
  const lds_cptr shm3=(lds_cptr)shm; const lds_cptr kp0=shm3+LDS_K+hi*1024+r32*16; const lds_cptr vp0=shm3+LDS_V+((lane>>4)&1)*32+(lane&3)*8+(4*hi+((lane&15)>>2))*64;
  const int NT=4+nloc;
  DMA_K(0,0);DMA_V(0,0);DMA_K(1,SLOTB);
  bf16x8 qr[4];
  #pragma unroll
  for(int d0=0;d0<4;++d0)qr[d0]=*reinterpret_cast<const bf16x8*>(&Qw[(size_t)r32*PP+d0*16+hi*8]);
  float mhat=0.f,l_reg=0.f;f32x16 o[2],negm;
  { float z_=0.f; asm volatile("":"+v"(z_));
    _Pragma("unroll") for(int r=0;r<16;++r){o[0][r]=z_;o[1][r]=z_;if(MODE==0)negm[r]=z_;} }
  if(MODE==0)asm volatile("":"+v"(negm));
  #define NEGMC (MODE==0?negm:(f32x16){})
  #define CMASK(P0,P1,t) do{ if(MODE==1&&(t)>=4){ const int dq_=64*(lt_lo+(t)-4)-(qw0+r32); \
      _Pragma("unroll") for(int r=0;r<16;++r){ const int d0_=dq_+crow(r,hi),d1_=d0_+32; if(d0_>128||d0_<-128)P0[r]=-INFINITY; if(d1_>128||d1_<-128)P1[r]=-INFINITY; } } \
    if(MODE==2&&(t)>=4){ const int gr_=lt_lo+(t)-4; const bool rel_=(gr_>=rs)&&(gr_<rs+8); const LAS float*bt_=rpbL+(rel_?gr_-rw+7:7)*31+(15-qc)+4*hi; const unsigned m0_=rel_?vm0:0u,m1_=rel_?vm1:0u; \
      _Pragma("unroll") for(int r=0;r<16;++r){ const int kc_=(r&3)+8*(r>>2);   \
        P0[r]=((m0_>>r)&1u)?P0[r]+bt_[kc_]:-INFINITY; P1[r]=((m1_>>r)&1u)?P1[r]+bt_[kc_+32]:-INFINITY; } } }while(0)
  bool resc=false;
  #define START(P0,P1) do{ const float rm=rowmax(P0,P1); resc=false; \
    { const float dl=rm; mhat=fadd_s(mhat,dl); \
      _Pragma("unroll") for(int r=0;r<16;++r){P0[r]=fsub_s(P0[r],dl);P1[r]=fsub_s(P1[r],dl);} \
      if(MODE==0){ _Pragma("unroll") for(int r=0;r<16;++r)negm[r]=-mhat; asm volatile("":"+v"(negm)); } } \
    _Pragma("unroll") for(int r=0;r<16;++r)P0[r]=__builtin_amdgcn_exp2f(P0[r]); }while(0)
  #define RESC() do{ if(resc){ asm volatile("s_waitcnt lgkmcnt(0)":::"memory"); \
      _Pragma("unroll") for(int d_=0;d_<2;++d_) _Pragma("unroll") for(int r=0;r<16;++r)o[d_][r]*=wsf[crow(r,hi)]; } }while(0)
  f32x16 pA0,pA1,pB0,pB1;
  int sl_prev=0,sl_cur=0,sl_next=SLOTB;
  #define ROT() do{sl_prev=sl_cur;sl_cur=sl_next;sl_next=(sl_next==(NSLOT-1)*SLOTB)?0:sl_next+SLOTB;}while(0)
  DMA_K(2,2*SLOTB);
  WAIT_BAR(3);
  qkt<MODE!=0>(pA0,pA1,Kbase,qr,negm,r32,hi);asm volatile("s_nop 15\n\ts_nop 7":"+v"(pA0),"+v"(pA1));CMASK(pA0,pA1,0);
  START(pA0,pA1);
  _Pragma("unroll") for(int r=0;r<16;++r)pA1[r]=__builtin_amdgcn_exp2f(pA1[r]);
  WAIT_BAR(0);
  DMA_K(3,0);DMA_V(1,SLOTB);
  ROT();
  kload8(kf,kp0+sl_cur);
  WAIT_BAR(2);
  s16x4 vlo[8],vhi[8]; u32x4 pw0,pw1,pw2,pw3;
  #define PKW(P,B) cvtpk_s(P[B],P[B+1])
  #define PAF(k) __builtin_bit_cast(bf16x8,pw##k)
  #define VFR(i) (bf16x8){vlo[i][0],vlo[i][1],vlo[i][2],vlo[i][3],vhi[i][0],vhi[i][1],vhi[i][2],vhi[i][3]}
  #define PIN(x) asm volatile("":"+v"(x))
  #define MX3(a,b,c) __builtin_fmaxf(__builtin_fmaxf((a),(b)),(c))
  #define GAPA(MF,A0,A1,A2,A3,W0,W1,PW) do{ MF; sacc+=A0; sacc+=A1; sacc+=A2; sacc+=A3; PIN(sacc); W0; W1; PIN(PW); SBAR(); }while(0)
  #define EX(v) __builtin_amdgcn_exp2f(v)
  #define GAPB(MF,X,B) do{ MF; X[B]=EX(X[B]); X[B+1]=EX(X[B+1]); X[B+2]=EX(X[B+2]); X[B+3]=EX(X[B+3]); PIN(X); SBAR(); }while(0)
  #define VRD(i) do{ vlo[i]=vtr(vp_+(((i)>>2)*4096+((i)&3)*1024)); vhi[i]=vtr(vp_+(((i)>>2)*4096+((i)&3)*1024+512)); }while(0)
  #define KRD(G,j) do{ if(G){ kload2(kf,kp0+sl_next,j); SBAR(); } }while(0)
  #define STEP(C0,C1,P0,P1,t,GK,GV,GL) do{ SBAR(); \
    const lds_cptr vp_=vp0+sl_prev; \
    VRD(0); SBAR(); float sacc=(P0[0]+P0[1]); \
    GAPA(C0=__builtin_amdgcn_mfma_f32_32x32x16_bf16(kf[0],qr[0],NEGMC,0,0,0), P0[2],P0[3],P0[4],P0[5],     pw0[0]=PKW(P0,0), pw0[1]=PKW(P0,2), pw0); \
    VRD(4); SBAR(); GAPA(C1=__builtin_amdgcn_mfma_f32_32x32x16_bf16(kf[1],qr[0],NEGMC,0,0,0), P0[6],P0[7],P0[8],P0[9],     pw0[2]=PKW(P0,4), pw0[3]=PKW(P0,6), pw0); \
    VRD(1); SBAR(); GAPA(C0=__builtin_amdgcn_mfma_f32_32x32x16_bf16(kf[2],qr[1],C0,0,0,0),   P0[10],P0[11],P0[12],P0[13], pw1[0]=PKW(P0,8), pw1[1]=PKW(P0,10), pw1); \
    VRD(5); SBAR(); GAPA(C1=__builtin_amdgcn_mfma_f32_32x32x16_bf16(kf[3],qr[1],C1,0,0,0),   P0[14],P0[15],P1[0],P1[1],   pw1[2]=PKW(P0,12),pw1[3]=PKW(P0,14), pw1); \
    VRD(2); SBAR(); GAPA(C0=__builtin_amdgcn_mfma_f32_32x32x16_bf16(kf[4],qr[2],C0,0,0,0),   P1[2],P1[3],P1[4],P1[5],     pw2[0]=PKW(P1,0), pw2[1]=PKW(P1,2), pw2); \
    VRD(6); SBAR(); GAPA(C1=__builtin_amdgcn_mfma_f32_32x32x16_bf16(kf[5],qr[2],C1,0,0,0),   P1[6],P1[7],P1[8],P1[9],     pw2[2]=PKW(P1,4), pw2[3]=PKW(P1,6), pw2); \
    VRD(3); SBAR(); GAPA(C0=__builtin_amdgcn_mfma_f32_32x32x16_bf16(kf[6],qr[3],C0,0,0,0),   P1[10],P1[11],P1[12],P1[13], pw3[0]=PKW(P1,8), pw3[1]=PKW(P1,10), pw3); \
    VRD(7); SBAR(); GAPA(C1=__builtin_amdgcn_mfma_f32_32x32x16_bf16(kf[7],qr[3],C1,0,0,0),   P1[14],P1[15],0.f,0.f,       pw3[2]=PKW(P1,12),pw3[3]=PKW(P1,14), pw3); \
    l_reg+=sacc; \
    if(GK){DMA_K((t)+3,sl_cur);} if(GV){DMA_V((t)+1,sl_next);} \
    if(MODE!=0){ _Pragma("unroll") for(int r=0;r<16;++r){C0[r]-=mhat;C1[r]-=mhat;} } \
    CMASK(C0,C1,t); \
    { float a=MX3(C0[0],C0[1],C1[0]),b=MX3(C0[2],C0[3],C1[1]); a=MX3(a,C1[2],C1[3]); \
      _Pragma("unroll") for(int r=4;r<16;r+=4){a=MX3(a,C0[r],C0[r+1]);b=MX3(b,C0[r+2],C0[r+3]);a=MX3(a,C1[r],C1[r+1]);b=MX3(b,C1[r+2],C1[r+3]);} \
      float rm=__builtin_fmaxf(a,b); { auto rr=__builtin_amdgcn_permlane32_swap(__float_as_uint(rm),__float_as_uint(rm),false,false); rm=__builtin_fmaxf(__uint_as_float(rr[0]),__uint_as_float(rr[1])); } \
      resc=false; \
      if(__builtin_expect(__any(rm>(float)THRL),0)){ const float dl=__builtin_fmaxf(rm,0.f); mhat+=dl; \
        _Pragma("unroll") for(int r=0;r<16;++r){C0[r]-=dl;C1[r]-=dl;} \
        if(MODE==0){ _Pragma("unroll") for(int r=0;r<16;++r)negm[r]=-mhat; asm volatile("":"+v"(negm)); } \
        const float f=__builtin_amdgcn_exp2f(-dl); l_reg*=f; if(hi==0)wsf[r32]=f; resc=true; } } \
    SBAR(); \
    GAPB(o[0]=__builtin_amdgcn_mfma_f32_32x32x16_bf16(PAF(0),VFR(0),o[0],0,0,0), C0,0); \
    GAPB(o[1]=__builtin_amdgcn_mfma_f32_32x32x16_bf16(PAF(0),VFR(4),o[1],0,0,0), C0,4); \
    KRD(GL,0); GAPB(o[0]=__builtin_amdgcn_mfma_f32_32x32x16_bf16(PAF(1),VFR(1),o[0],0,0,0), C0,8); \
    KRD(GL,1); GAPB(o[1]=__builtin_amdgcn_mfma_f32_32x32x16_bf16(PAF(1),VFR(5),o[1],0,0,0), C0,12); \
    KRD(GL,2); GAPB(o[0]=__builtin_amdgcn_mfma_f32_32x32x16_bf16(PAF(2),VFR(2),o[0],0,0,0), C1,0); \
    KRD(GL,3); GAPB(o[1]=__builtin_amdgcn_mfma_f32_32x32x16_bf16(PAF(2),VFR(6),o[1],0,0,0), C1,4); \
    GAPB(o[0]=__builtin_amdgcn_mfma_f32_32x32x16_bf16(PAF(3),VFR(3),o[0],0,0,0), C1,8); \
    GAPB(o[1]=__builtin_amdgcn_mfma_f32_32x32x16_bf16(PAF(3),VFR(7),o[1],0,0,0), C1,12); \
    }while(0)
  int t=1;
  for(;t+5<NT;t+=2){
    STEP(pB0,pB1,pA0,pA1,t,true,true,true);     WAIT_BAR(2); RESC(); ROT();
    STEP(pA0,pA1,pB0,pB1,t+1,true,true,true);   WAIT_BAR(2); RESC(); ROT();
  }
  #define ENDW(tt) do{ if((tt)+3<NT){WAIT_BAR(2);} else if((tt)+2<NT){WAIT_BAR(1);} else {WAIT_BAR(0);} }while(0)
  for(;t+1<NT;t+=2){
    STEP(pB0,pB1,pA0,pA1,t,(t+3<NT),(t+1<NT),(t+1<NT));       ENDW(t);   RESC(); ROT();
    STEP(pA0,pA1,pB0,pB1,t+1,(t+4<NT),(t+2<NT),(t+2<NT));     ENDW(t+1); RESC(); ROT();
  }
  STEP(pB0,pB1,pA0,pA1,NT-1,false,false,false); RESC();
  { float sacc=pB0[0]+pB0[1]; _Pragma("unroll") for(int r=2;r<16;++r)sacc+=pB0[r]; _Pragma("unroll") for(int r=0;r<16;++r)sacc+=pB1[r]; l_reg+=sacc;
    pw0=(u32x4){PKW(pB0,0),PKW(pB0,2),PKW(pB0,4),PKW(pB0,6)};pw1=(u32x4){PKW(pB0,8),PKW(pB0,10),PKW(pB0,12),PKW(pB0,14)};pw2=(u32x4){PKW(pB1,0),PKW(pB1,2),PKW(pB1,4),PKW(pB1,6)};pw3=(u32x4){PKW(pB1,8),PKW(pB1,10),PKW(pB1,12),PKW(pB1,14)};
    SBAR(); pv(o,vb0+sl_cur,PAF(0),PAF(1),PAF(2),PAF(3)); }
  #undef PKW
  #undef PAF
  #undef VFR
  #undef PIN
  #undef MX3
  #undef GAPA
  #undef GAPB
  #undef EX
  #undef VRD
  #undef KRD
  #undef STEP
  #undef ENDW
  {auto rr=__builtin_amdgcn_permlane32_swap(__float_as_uint(l_reg),__float_as_uint(l_reg),false,false);l_reg=__uint_as_float(rr[0])+__uint_as_float(rr[1]);}
  if(MODE==1||MODE==3)l_reg+=__builtin_amdgcn_exp2f(sink2-mhat);
  if(hi==0)wsf[32+r32]=l_reg;asm volatile("s_waitcnt lgkmcnt(0)":::"memory");
  float rli[16];
  #pragma unroll
  for(int r=0;r<16;++r)rli[r]=__builtin_amdgcn_rcpf(wsf[32+crow(r,hi)]);
  bf16_t*Ow=Yb+(size_t)(qrow0+wid*QBLK)*DM+ycol;
  { LAS bf16_t*stg=(LAS bf16_t*)(shm+LDS_OST)+wid*2048;
    #pragma unroll
    for(int r=0;r<16;++r){const int orow=crow(r,hi);
      #pragma unroll
      for(int d0=0;d0<2;++d0)stg[orow*64+d0*32+r32]=(bf16_t)(cvtpk(o[d0][r]*rli[r],0.f)&0xffffu);}
    asm volatile("s_waitcnt lgkmcnt(0)":::"memory");
    #pragma unroll
    for(int i=0;i<4;++i){const int row=i*8+(lane>>3),ch=lane&7; const u32x4 v=*(const LAS u32x4*)(stg+row*64+ch*8); *(u32x4*)(Ow+(size_t)row*DM+ch*8)=v;} }
  asm volatile("s_waitcnt lgkmcnt(0)\n\ts_barrier":::"memory");
  #undef DMA_K
  #undef DMA_V
  #undef KROW
  #undef NEGMC
  #undef CMASK
  #undef START
  #undef RESC
  #undef ROT
}

#undef SBAR
#undef WAIT_BAR
}

constexpr int NPHASE = 19;
__device__ __forceinline__ void ph_decode(int ph, int& l, int& k) { const unsigned tab = 0xA9864321u;
    if (ph == 1) { l = 0; k = 0; } else { const int j = ph - 2; l = j >= 8 ? 1 : 0; k = (int)((tab >> (4 * (j >= 8 ? j - 8 : j))) & 15u); } }

__device__ __forceinline__ void fill_rtab(Frame& F, const pg8::StaticOrder& S, const float* ssq, const float* ssqc) {
    LAS float* tab = (LAS float*)(F.lds + pg8::RTAB_OFF); pg8::Unit u;
    for (int i = 0; i < 8 && S.next(i, u); ++i) if (F.tid < 256) { float s = 0.f;
        if (u.pm < 64) { const float* p = ssq + (size_t)(u.pm * 256 + F.tid) * 16; const f32x4 a = *(const f32x4*)p, b = *(const f32x4*)(p + 4), c = *(const f32x4*)(p + 8), d = *(const f32x4*)(p + 12);
            s = ((a[0] + a[1]) + (a[2] + a[3])) + ((b[0] + b[1]) + (b[2] + b[3])) + ((c[0] + c[1]) + (c[2] + c[3])) + ((d[0] + d[1]) + (d[2] + d[3])); }
        else { const float* p = ssqc + (size_t)((u.pm - 64) * 256 + F.tid) * 64;
#pragma unroll
            for (int j = 0; j < 16; ++j) { const f32x4 a = *(const f32x4*)(p + 4 * j); s += (a[0] + a[1]) + (a[2] + a[3]); } }
        tab[i * 256 + F.tid] = rsqrtf(s * (1.f / DM) + EPS); }
    __syncthreads();
}
__device__ __forceinline__ void phase_ids(Frame& F) {
    int lane_;
    asm volatile("v_mbcnt_lo_u32_b32 %0, -1, 0\n\tv_mbcnt_hi_u32_b32 %0, -1, %0" : "=v"(lane_));
    F.lane = lane_; F.tid = F.wave * 64 + lane_;
}
__device__ __forceinline__ void run_phase(const Frame& F0, int ph) {
    Frame F = F0;
    unsigned char* ws = F.ws;
#define H ((bf16_t*)(F.ws + WS_H))
#define PROJ ((bf16_t*)(F.ws + WS_PROJ))
#define XC ((float*)(F.ws + WS_XC))
#define MOD ((const float*)(F.ws + WS_MOD))
#define vcu ((F.G % 8 == 0) ? (F.bid % 8) * (F.G / 8) + F.bid / 8 : F.bid)
#ifdef ONLYK
    if (ONLYK == 100) { if (ph == 0) { phase_ids(F); p0_prologue(F); } return; }
    if (ONLYK == 101) { if (ph == NPHASE - 1) { phase_ids(F); final_phase(F); } return; }
    if (ph == 0 || ph == NPHASE - 1) return;
    int l, k; ph_decode(ph, l, k);
    if (k != ONLYK) return;
#else
    if (ph == 0) { phase_ids(F); p0_prologue(F); return; }
    if (ph == NPHASE - 1) { phase_ids(F); final_phase(F); return; }
    int l, k; ph_decode(ph, l, k);
#endif
    const int M = (l == 0) ? NROWS : NLAT;
    switch (k) {
    case 0: phase_ids(F); norm_phase(F, l); break;
    case 1: { phase_ids(F); pg8::Gemm g{H, (const bf16_t*)(ws + WS_WIN) + (size_t)l * PP * 1024, NROWS, PP, 1024}; pg8::StaticOrder S; S.init(NROWS, PP, F.G, F.bid);
              gates_phase(F, l); if (l > 0) fill_rtab(F, S, (const float*)(ws + WS_SSQ1), (const float*)(ws + WS_SSQC1));
              pg8::EpiProj E{PROJ, PP, l == 0 ? nullptr : (const LAS float*)(F.lds + pg8::RTAB_OFF), (const float*)(ws + WS_BIASIN)}; pg8::gemm_phase<pg8::EpiProj, pg8::StaticOrder, true, true>(F.lds, g, S, E, F.tid); } break;
    case 2: phase_ids(F); postproj_phase(F, l); ml::pass1(F, l); break;
    case 3: {
        phase_ids(F);
        ml::pass2(F);
#ifndef NO_B
        for (int u = vcu; u < 256; u += F.G) { const int b = u >> 7, h = (u >> 5) & 3, qb = u & 31;
            attp::attn_unit_pipe<8, 1>(F, b, h, qb, PC_BQ + 64 * h, PC_BK + 64 * (h >> 1), PC_BV + 64 * (h >> 1), 256 + 64 * h, F.ka->in[IN_SINK][l * 4 + h] * LOG2E, nullptr); }
#endif
#ifndef NO_D
        for (int u = vcu; u < 256; u += F.G) { const int b = u >> 7, h = (u >> 5) & 3, qb = u & 31;
            attp::attn_unit_pipe<8, 2>(F, b, h, qb, PC_DQ + 64 * h, PC_DK + 64 * h, PC_DV + 64 * h, 768 + 64 * h, 0.f, F.ka->in[IN_RPB] + (size_t)(l * 4 + h) * 465); }
#endif
#ifndef NO_C3
        if (l == 0) for (int cu = vcu; cu < 24; cu += F.G) { const int mx = cu >> 3, b = (cu >> 2) & 1, h = cu & 3;
            const int qc = mx == 0 ? PC_AQ + 64 * h : (mx == 1 ? PC_BQ + 64 * h : PC_DQ + 64 * h);
            const int kc = mx == 0 ? PC_AK + 64 * (h >> 1) : (mx == 1 ? PC_BK + 64 * (h >> 1) : PC_DK + 64 * h);
            const int vc = mx == 0 ? PC_AV + 64 * (h >> 1) : (mx == 1 ? PC_BV + 64 * (h >> 1) : PC_DV + 64 * h);
            const int yc = (mx == 0 ? 0 : (mx == 1 ? 256 : 768)) + 64 * h;
            const float s2 = mx == 1 ? F.ka->in[IN_SINK][l * 4 + h] * LOG2E : -INFINITY;
            attp::attn_unit_pipe<8, 3>(F, b, h, 0, qc, kc, vc, yc, s2, nullptr); }
#endif
        if (l == 0) bias_phase(F, vcu >= 24 ? vcu - 24 : -1, F.G - 24);
    } break;
    case 4: {
        phase_ids(F);
#ifndef NO_ATTN0
        for (int u = vcu; u < 256; u += F.G) { const int b = u >> 7, h = (u >> 5) & 3, qb = u & 31;
            attp::attn_unit_pipe<8, 0>(F, b, h, qb, PC_AQ + 64 * h, PC_AK + 64 * (h >> 1), PC_AV + 64 * (h >> 1), 64 * h, 0.f, nullptr); }
#endif
        __syncthreads();
#ifndef NO_PASS3
        ml::pass3(F, l, l == 0 ? 0 : 4);
#endif
    } break;
    case 6: { phase_ids(F); pg8::Gemm g{PROJ  , (const bf16_t*)(ws + WS_WOUT) + (size_t)l * 1024 * 1024, NLAT, 1024, 1024}; pg8::StaticOrder S; S.init(NLAT, 1024, F.G, F.bid);
              { pg8::Unit u;
                if (F.G >= 256) { if (S.next(0, u)) {
                    groupnorm_rows<true>(F, l, u.pm * 256 + u.pn * 64, 64, F.wave, NWAVES);
                    asm volatile("s_waitcnt vmcnt(0)" ::: "memory"); __syncthreads();
                    if (F.tid == 0) { unsigned* cnt = (unsigned*)(ws + WS_CTL + 40960) + l * 64 + u.pm;
                        __hip_atomic_fetch_add(cnt, 1u, __ATOMIC_RELAXED, __HIP_MEMORY_SCOPE_AGENT);
                        unsigned sp = 0; while (__hip_atomic_load(cnt, __ATOMIC_RELAXED, __HIP_MEMORY_SCOPE_AGENT) < 4u && ++sp < (1u << 22)) __builtin_amdgcn_s_sleep(1);
                        __builtin_amdgcn_fence(__ATOMIC_ACQUIRE, "agent"); asm volatile("s_waitcnt vmcnt(0)" ::: "memory"); }
                    __syncthreads(); } }
                else { for (int i = 0; S.next(i, u); ++i) groupnorm_rows<false>(F, l, u.pm * 256, 256, F.wave, NWAVES); VM_WAIT(); __syncthreads(); } }
              pg8::EpiResid E{l == 0 ? F.ka->in[IN_X] : F.out, l == 0 ? F.ka->in[IN_CTX] : XC, F.out, XC, MOD + (size_t)l * 3 * 6144 + 2 * 1024,
                               (bf16_t*)(ws + WS_XG), F.ka->in[IN_G2] + l * 1024, MOD + (size_t)l * 3 * 6144 + 4 * 1024, (float*)(ws + WS_SSQ2)};
              if (F.G >= 256) { pg8::EpiResidStaged E2{E.xin_lat, E.xin_ctx, E.xout_lat, E.xout_ctx, E.gate, E.xg, E.gn, E.scn, E.ssq}; pg8::gemm_phase<pg8::EpiResidStaged, pg8::StaticOrder, true, true>(F.lds, g, S, E2, F.tid); }
              else pg8::gemm_phase<pg8::EpiResid, pg8::StaticOrder, true, true>(F.lds, g, S, E, F.tid);
              PROBE_PT(F.lds, 5);
              if (l == 0) skinny_ctx<1024>(F, PROJ + (size_t)NLAT * DM, (const bf16_t*)(ws + WS_WOUT), F.ka->in[IN_CTX], XC, MOD + 2 * 6144 + 2 * 1024,
                                           (bf16_t*)(ws + WS_XG) + (size_t)NLAT * DM, F.ka->in[IN_G2], MOD + 2 * 6144 + 4 * 1024, (float*)(ws + WS_SSQC2)); } break;
    case 8: { phase_ids(F); pg8::Gemm g{(const bf16_t*)(ws + WS_XG), (const bf16_t*)(ws + WS_WUP) + (size_t)l * DFF2 * 1024, M, DFF2, 1024}; pg8::StaticOrder S; S.init(M, DFF2, F.G, F.bid);
              fill_rtab(F, S, (const float*)(ws + WS_SSQ2), (const float*)(ws + WS_SSQC2));
              pg8::EpiUp E{PROJ, F.ka->in[IN_CONVW] + (size_t)l * 3 * DFF2, F.ka->in[IN_CONVB] + (size_t)l * DFF2, (float*)(ws + WS_EDGE), (const LAS float*)(F.lds + pg8::RTAB_OFF), (const float*)(ws + WS_BIASUP) + (size_t)l * 3 * DFF2};
              pg8::gemm_phase<pg8::EpiUp, pg8::StaticOrder, true, true>(F.lds, g, S, E, F.tid); } break;
    case 9: phase_ids(F); for (int ht = F.bid; ht < M / 128; ht += F.G) fixup_hts(F, l, ht, 1); break;
    case 10: { phase_ids(F); pg8::Gemm g{PROJ, (const bf16_t*)(ws + WS_WDN) + (size_t)l * 1024 * DFF, NLAT, 1024, DFF}; pg8::StaticOrder S; S.init(NLAT, 1024, F.G, F.bid);
              pg8::EpiResid E{F.out, XC, F.out, XC, MOD + (size_t)l * 3 * 6144 + 5 * 1024,
                               l == 0 ? H : nullptr, F.ka->in[IN_G1] + 1024, MOD + (size_t)3 * 6144 + 1 * 1024, (float*)(ws + WS_SSQ1)};
              if (F.G >= 256) { pg8::EpiResidStaged E2{E.xin_lat, E.xin_ctx, E.xout_lat, E.xout_ctx, E.gate, E.xg, E.gn, E.scn, E.ssq}; pg8::gemm_phase<pg8::EpiResidStaged, pg8::StaticOrder, true, true>(F.lds, g, S, E2, F.tid); }
              else pg8::gemm_phase<pg8::EpiResid, pg8::StaticOrder, true, true>(F.lds, g, S, E, F.tid);
              PROBE_PT(F.lds, 5);
              if (l == 0) skinny_ctx<DFF>(F, PROJ + (size_t)NLAT * DFF, (const bf16_t*)(ws + WS_WDN), XC, XC, MOD + 2 * 6144 + 5 * 1024,
                                          H + (size_t)NLAT * DM, F.ka->in[IN_G1] + 1024, MOD + (size_t)(3 + 2) * 6144 + 1 * 1024, (float*)(ws + WS_SSQC1)); } break;
    default: break;
    }
#undef H
#undef PROJ
#undef XC
#undef MOD
#undef vcu
}

__global__ void __launch_bounds__(NTHREADS, 2) fwd_kernel(Args args) {
    extern __shared__ __attribute__((aligned(16))) unsigned char lds_raw[];
    Frame F;
    F.lds = (LAS unsigned char*)lds_raw;
    const int wave0 = __builtin_amdgcn_readfirstlane((int)threadIdx.x >> 6);
    F.tid = 0; F.lane = 0; F.wave = wave0;
    F.G = gridDim.x; F.bid = blockIdx.x;
    F.ka = (const __attribute__((address_space(4))) Args*)__builtin_amdgcn_kernarg_segment_ptr();
    F.out = args.out; F.ws = args.ws;
#define MK_LANE(x) int x; asm volatile("v_mbcnt_lo_u32_b32 %0, -1, 0\n\tv_mbcnt_hi_u32_b32 %0, -1, %0" : "=v"(x))
#if !MK_MULTI
    { MK_LANE(l0_); if (wave0 == 0) ((LAS unsigned*)(F.lds + LDSCTL_OFF))[l0_] = 0u; }
    __syncthreads();
    XcdBarrier bar;
    { MK_LANE(l0_); bar = xcd_barrier_post((unsigned*)(args.ws + WS_CTL) + CW_BAR, (volatile LAS unsigned*)(F.lds + LDSCTL_OFF) + 8, wave0 == 0 && l0_ == 0); }
#endif
#ifdef PROBE_MASK
    unsigned long long pr_acc = 0ull;
#endif
    for (int ph = args.ph_lo; ph < args.ph_hi; ++ph) {
#ifdef PROBE_MASK
        const unsigned long long pr_t0 = __builtin_amdgcn_s_memrealtime();
#endif
#ifdef PROBE_PH
        *(volatile LAS unsigned*)(F.lds + LDSCTL_OFF + 64) = (ph == PROBE_PH) ? 1u : 0u; __syncthreads();
        PROBE_PT(F.lds, 0);
#endif
        {
            Frame P = F;
            int wave_ = wave0, bid_ = F.bid, g_ = F.G; unsigned char* ws_ = F.ws; float* out_ = F.out; const __attribute__((address_space(4))) Args* ka_ = F.ka;
            asm volatile("" : "+s"(wave_), "+s"(bid_), "+s"(g_), "+s"(ws_), "+s"(out_), "+s"(ka_));
            P.ka = ka_; P.lane = 0; P.wave = wave_; P.tid = 0; P.bid = bid_; P.G = g_; P.ws = ws_; P.out = out_;
            run_phase(P, ph);
#ifdef DUP_PH
            if (DUP_PH(ph)) { asm volatile("s_waitcnt vmcnt(0) lgkmcnt(0)" ::: "memory"); __syncthreads(); run_phase(P, ph); }
#endif
        }
#if !MK_MULTI
        if (ph + 1 < args.ph_hi) {
            if (args.ph_lo < 0) cg::this_grid().sync();
            else { MK_LANE(l1_); xcd_barrier(bar, wave0 == 0 && l1_ == 0); }
        }
#endif
#ifdef PROBE_PH
        PROBE_PT(F.lds, 4);
#endif
#ifdef PROBE_MASK
        if ((PROBE_MASK >> ph) & 1u) pr_acc += __builtin_amdgcn_s_memrealtime() - pr_t0;
#endif
    }
#ifdef PROBE_PH
    if (blockIdx.x == 0) { __syncthreads(); const unsigned long long d_ = *(volatile LAS unsigned long long*)(F.lds + LDSCTL_OFF + 72 + 8 * PROBE_B) - *(volatile LAS unsigned long long*)(F.lds + LDSCTL_OFF + 72 + 8 * PROBE_A);
        const unsigned long long t1 = __builtin_amdgcn_s_memrealtime(); while (__builtin_amdgcn_s_memrealtime() - t1 < d_) __builtin_amdgcn_s_sleep(8); }
#endif
#ifdef PROBE_MASK
    if (blockIdx.x == 0) { const unsigned long long t1 = __builtin_amdgcn_s_memrealtime(); while (__builtin_amdgcn_s_memrealtime() - t1 < pr_acc) __builtin_amdgcn_s_sleep(8); }
#endif
}

extern "C" void kernel_launch(void* const* d_in, const int* in_sizes, int n_in, void* d_out, int out_size, void* d_ws, size_t ws_size, hipStream_t stream) {
    static int grid = 0;
    if (grid == 0) {
        if (n_in != 21 || out_size != NLAT * DM || ws_size < WS_END) { fprintf(stderr, "kernel_launch: unexpected shapes (n_in %d out %d ws %zu)\n", n_in, out_size, ws_size); grid = -1; return; }
        int dev = 0, cus = 0, per_cu = 0;
        if (hipGetDevice(&dev) != hipSuccess || hipDeviceGetAttribute(&cus, hipDeviceAttributeMultiprocessorCount, dev) != hipSuccess) { grid = -1; return; }
        if (hipFuncSetAttribute((const void*)fwd_kernel, hipFuncAttributeMaxDynamicSharedMemorySize, LDS_BYTES) != hipSuccess) { fprintf(stderr, "kernel_launch: hipFuncSetAttribute failed\n"); grid = -1; return; }
        if (hipOccupancyMaxActiveBlocksPerMultiprocessor(&per_cu, (const void*)fwd_kernel, NTHREADS, LDS_BYTES) != hipSuccess || per_cu < 1) { fprintf(stderr, "kernel_launch: occupancy query says %d blocks per CU\n", per_cu); grid = -1; (void)hipGetLastError(); return; }
        grid = cus;
    }
    if (grid < 0) return;
#if !MK_MULTI
    if (hipMemsetAsync((char*)d_ws + WS_CTL, 0, 65536, stream) != hipSuccess) { fprintf(stderr, "kernel_launch: hipMemsetAsync failed\n"); return; }
#endif
    Args a{};
    for (int i = 0; i < 21; ++i) a.in[i] = (const float*)d_in[i];
    a.out = (float*)d_out; a.ws = (unsigned char*)d_ws;
#if MK_MULTI
    for (int ph = 0; ph < NPHASE; ++ph) { a.ph_lo = ph; a.ph_hi = ph + 1; hipLaunchKernelGGL(fwd_kernel, dim3(grid), dim3(NTHREADS), LDS_BYTES, stream, a); }
#else
    a.ph_lo = 0; a.ph_hi = NPHASE;
    void* kargs[] = {&a};
    hipError_t e = hipLaunchCooperativeKernel((void*)fwd_kernel, dim3(grid), dim3(NTHREADS), kargs, LDS_BYTES, stream);
    if (e != hipSuccess) fprintf(stderr, "kernel_launch: cooperative launch failed: %s (grid %d)\n", hipGetErrorString(e), grid);
#endif
}
```

```cpp
#include <hip/hip_runtime.h>
#include <hip/hip_cooperative_groups.h>
#include <cstdio>
#include <cstdint>
namespace cg = cooperative_groups;

#ifndef MK_MULTI
#define MK_MULTI 0
#endif

constexpr int DM = 1024, SEQ = 8192, NBATCH = 2, CTXL = 256, NLAT = NBATCH * SEQ, NROWS = NLAT + NBATCH * CTXL;
constexpr int PP = 2816;
constexpr int DFF = 2816, DFF2 = 5632, DIN = 2832, NLAYER = 2;
constexpr float EPS = 1e-6f;
constexpr float LOG2E = 1.4426950408889634f;
constexpr float QSCALE2 = 0.125f * LOG2E;
constexpr int PC_AQ = 0, PC_AK = 256, PC_AV = 384, PC_BQ = 512, PC_BK = 768, PC_BV = 896, PC_CQ = 1024, PC_CK = 1280, PC_CV = 1536, PC_CO = 1792, PC_DQ = 2048, PC_DK = 2304, PC_DV = 2560;
constexpr int NCHUNK = 132, NCHAIN = 16;

constexpr size_t MiB = 1u << 20;
constexpr size_t WS_CTL = 0, CTL_ZERO_BYTES = 1 * MiB;
constexpr size_t WS_MOD = 1 * MiB;
constexpr size_t WS_ROPE = 1 * MiB + 192 * 1024;
constexpr size_t WS_WG = 1 * MiB + 512 * 1024;
constexpr size_t WS_XC = 2 * MiB;
constexpr size_t WS_WIN = 4 * MiB;
constexpr size_t WS_WOUT = 15 * MiB;
constexpr size_t WS_WUP = 19 * MiB;
constexpr size_t WS_WDN = 41 * MiB;
constexpr size_t WS_H = 52 * MiB;
constexpr size_t WS_PROJ = 85 * MiB;
constexpr size_t WS_GATES = 176 * MiB;
constexpr size_t WS_DS = 178 * MiB;
constexpr size_t WS_SBF = 211 * MiB;
constexpr size_t WS_ZD = 228 * MiB;
constexpr size_t WS_ZC = WS_ZD + 1 * MiB;
constexpr size_t WS_GC = WS_ZC + 1 * MiB;
constexpr size_t WS_ML = WS_GC + 16384;
constexpr size_t WS_MC = WS_ML + 16384;
constexpr size_t WS_SSQ1 = 231 * MiB;
constexpr size_t WS_SSQ2 = 232 * MiB + 512 * 1024;
constexpr size_t WS_BIASUP = 234 * MiB;
constexpr size_t WS_BIASIN = 234 * MiB + 256 * 1024;
constexpr size_t WS_XG = WS_DS;
constexpr size_t WS_EDGE = WS_SBF;
constexpr size_t WS_SSQC1 = 234 * MiB + 512 * 1024;
constexpr size_t WS_SSQC2 = 234 * MiB + 768 * 1024;
constexpr size_t WS_END = 237 * MiB;

#define LAS __attribute__((address_space(3)))
#define GAS __attribute__((address_space(1)))
typedef unsigned short bf16_t;
typedef short bf16x8 __attribute__((ext_vector_type(8)));
typedef short s16x4 __attribute__((ext_vector_type(4)));
typedef float f32x4 __attribute__((ext_vector_type(4)));
typedef float f32x16 __attribute__((ext_vector_type(16)));
typedef float f32x2 __attribute__((ext_vector_type(2)));
typedef unsigned u32x4 __attribute__((ext_vector_type(4)));
typedef unsigned u32x2 __attribute__((ext_vector_type(2)));
typedef __bf16 bf16x2_t __attribute__((ext_vector_type(2)));
typedef short v4i16_t __attribute__((ext_vector_type(4)));

__device__ __forceinline__ unsigned cvtpk(float lo, float hi) { f32x2 v = {lo, hi}; bf16x2_t b = __builtin_convertvector(v, bf16x2_t); return __builtin_bit_cast(unsigned, b); }
__device__ __forceinline__ float bf2f(unsigned short b) { return __uint_as_float((unsigned)b << 16); }
__device__ __forceinline__ float bflo(unsigned w) { return __uint_as_float(w << 16); }
__device__ __forceinline__ float bfhi(unsigned w) { return __uint_as_float(w & 0xffff0000u); }
__device__ __forceinline__ float shfl_idx(float v, int src) { return __int_as_float(__builtin_amdgcn_ds_bpermute(src << 2, __float_as_int(v))); }
__device__ __forceinline__ float shfl_x(float v, int o, int lane) { return shfl_idx(v, lane ^ o); }
__device__ __forceinline__ float wave_sum(float v, int lane) {
#pragma unroll
    for (int o = 1; o < 64; o <<= 1) v += shfl_x(v, o, lane);
    return v;
}
__device__ __forceinline__ float wave_max(float v, int lane) {
#pragma unroll
    for (int o = 1; o < 64; o <<= 1) v = fmaxf(v, shfl_x(v, o, lane));
    return v;
}
#ifdef PROBE_PH
#define PROBE_PT(ldsbase, id) do { if (*(volatile LAS unsigned*)((ldsbase) + 155648 + 64)) *(volatile LAS unsigned long long*)((ldsbase) + 155648 + 72 + 8 * (id)) = __builtin_amdgcn_s_memrealtime(); } while (0)
#else
#define PROBE_PT(ldsbase, id) do { } while (0)
#endif
#define LDS_WAIT() asm volatile("s_waitcnt lgkmcnt(0)" ::: "memory")
#define VM_WAIT() asm volatile("s_waitcnt vmcnt(0)" ::: "memory")

namespace pg8 {
#define PG8_LAS __attribute__((address_space(3)))
constexpr int BM = 256, BK = 64, HALF = 128, HTB = HALF * BK * 2  , STAGE_BYTES = 8 * HTB, NXCD = 8, WGM = 8;
__host__ __device__ __forceinline__ int lds_byte(int r, int c) { const int st = (r >> 4) * 2 + (c >> 5), rr = r & 15, cc = c & 31, ob = rr * 64 + cc * 2; return st * 1024 + (ob ^ (((ob >> 9) & 1) << 5)); }
__host__ __device__ __forceinline__ void stage_rc(int b, int& R, int& C) { const int st = b / 1024, sb = b % 1024, swz = sb ^ (((sb >> 9) & 1) << 5); R = (st >> 1) * 16 + swz / 64; C = (st & 1) * 32 + (swz % 64) / 2; }
__host__ __device__ __forceinline__ int perm32(int rho) { const int n = rho >> 4, i = rho & 15; return 8 * (i >> 2) + 4 * n + (i & 3); }

struct Unit { int pm, pn, ui; };
struct Gemm { const bf16_t* A; const bf16_t* Bt; int M, N, K; };

struct StaticOrder {
    int nM, nN, nwg, G, c;
    __host__ __device__ __forceinline__ void init(int M, int N, int G_, int c_) { nM = M / BM; nN = N / BM; nwg = nM * nN; G = G_; c = c_; }
    __host__ __device__ __forceinline__ bool next(int i, Unit& u) const {
        const long L = (long)i * G + c; if (L >= nwg) return false;
        int wgid = (int)L; { const int q = nwg / NXCD, r = nwg % NXCD, xcd = wgid % NXCD, off = wgid / NXCD; wgid = (xcd < r ? xcd * (q + 1) : r * (q + 1) + (xcd - r) * q) + off; }
        const int nig = WGM * nN, gid = wgid / nig, fm = gid * WGM, gsz = (nM - fm) < WGM ? (nM - fm) : WGM;
        u.pm = fm + ((wgid % nig) % gsz); u.pn = (wgid % nig) / gsz; u.ui = i; return true;
    }
    __device__ __forceinline__ void a_ready(const Unit&) const {}
    __device__ __forceinline__ void done(const Unit&) const {}
};

constexpr int RTAB_OFF = 131072;
struct EpiProj {
    static constexpr bool PERM = true, AFTER_DRAIN = false, ROWPERM = false;
    bf16_t* O; int ldc; const LAS float* rtab; const float* bias;
    __device__ __forceinline__ void operator()(const f32x4 (&acc)[2][2][4][2], const Unit& u, int wr, int wc, int fr, int fq) const {
        asm volatile("" : "+v"(fr), "+v"(fq));
        const int row0 = u.pm * BM + wr * 64 + fr, col0 = u.pn * BM + wc * 32 + 8 * fq;
        const float sc = (u.pn == 2 || u.pn == 8) ? QSCALE2 : (u.pn == 4 ? 0.125f : 1.f);
        float rs[8] = {1.f, 1.f, 1.f, 1.f, 1.f, 1.f, 1.f, 1.f}; f32x4 bv[2][2] = {};
        if (rtab) {
#pragma unroll
            for (int i = 0; i < 8; ++i) rs[i] = rtab[u.ui * 256 + wr * 64 + fr + (i >> 2) * HALF + (i & 3) * 16];
            const int id = u.pm < 32 ? 0 : (u.pm < 64 ? 1 : 2);
#pragma unroll
            for (int bj = 0; bj < 2; ++bj)
#pragma unroll
                for (int n = 0; n < 2; ++n) bv[bj][n] = *(const f32x4*)(bias + id * PP + col0 + bj * HALF + 4 * n); }
#pragma unroll
        for (int ai = 0; ai < 2; ++ai)
#pragma unroll
            for (int m = 0; m < 4; ++m) { bf16_t* rowp = O + (size_t)(row0 + ai * HALF + m * 16) * ldc + col0; const float r = rs[ai * 4 + m];
#pragma unroll
                for (int bj = 0; bj < 2; ++bj) { const f32x4 v0 = (acc[ai][bj][m][0] * r + bv[bj][0]) * sc, v1 = (acc[ai][bj][m][1] * r + bv[bj][1]) * sc;
                    u32x4 w; w.x = cvtpk(v0[0], v0[1]); w.y = cvtpk(v0[2], v0[3]); w.z = cvtpk(v1[0], v1[1]); w.w = cvtpk(v1[2], v1[3]);
                    *(u32x4*)(rowp + bj * HALF) = w; } }
    }
};
struct EpiResid {
    static constexpr bool PERM = true, AFTER_DRAIN = false, ROWPERM = false;
    const float* xin_lat; const float* xin_ctx; float* xout_lat; float* xout_ctx; const float* gate;
    bf16_t* xg; const float* gn; const float* scn; float* ssq;
    __device__ __forceinline__ void operator()(const f32x4 (&acc)[2][2][4][2], const Unit& u, int wr, int wc, int fr, int fq) const {
        asm volatile("" : "+v"(fr), "+v"(fq));
        const int id = u.pm < 32 ? 0 : (u.pm < 64 ? 1 : 2);
        const float* xin = u.pm < 64 ? xin_lat + (size_t)u.pm * BM * DM : xin_ctx + (size_t)(u.pm - 64) * BM * DM;
        float* xout = u.pm < 64 ? xout_lat + (size_t)u.pm * BM * DM : xout_ctx + (size_t)(u.pm - 64) * BM * DM;
        const int rl = wr * 64 + fr, col0 = u.pn * BM + wc * 32 + 8 * fq;
        f32x4 g[2][2], gs[2][2];
#pragma unroll
        for (int bj = 0; bj < 2; ++bj)
#pragma unroll
            for (int n = 0; n < 2; ++n) { g[bj][n] = *(const f32x4*)(gate + id * 6144 + col0 + bj * HALF + 4 * n);
                if (xg) gs[bj][n] = *(const f32x4*)(gn + col0 + bj * HALF + 4 * n) * (1.f + *(const f32x4*)(scn + id * 6144 + col0 + bj * HALF + 4 * n)); }
#pragma unroll
        for (int ai = 0; ai < 2; ++ai)
#pragma unroll
            for (int m = 0; m < 4; ++m) { const size_t off = (size_t)(rl + ai * HALF + m * 16) * DM + col0; float s = 0.f;
#pragma unroll
                for (int bj = 0; bj < 2; ++bj) { f32x4 o[2];
#pragma unroll
                    for (int n = 0; n < 2; ++n) { const f32x4 xv = *(const f32x4*)(xin + off + bj * HALF + 4 * n); o[n] = xv + g[bj][n] * acc[ai][bj][m][n];
                        *(f32x4*)(xout + off + bj * HALF + 4 * n) = o[n]; s += (o[n][0] * o[n][0] + o[n][1] * o[n][1]) + (o[n][2] * o[n][2] + o[n][3] * o[n][3]); }
                    if (xg) { const f32x4 a = o[0] * gs[bj][0], b = o[1] * gs[bj][1]; u32x4 w; w.x = cvtpk(a[0], a[1]); w.y = cvtpk(a[2], a[3]); w.z = cvtpk(b[0], b[1]); w.w = cvtpk(b[2], b[3]);
                        *(u32x4*)(xg + (size_t)u.pm * BM * DM + off + bj * HALF) = w; } }
                if (xg) { s += shfl_idx(s, (fq * 16 + fr) ^ 16); s += shfl_idx(s, (fq * 16 + fr) ^ 32);
                    if (fq == 0) ssq[(size_t)(u.pm * BM + rl + ai * HALF + m * 16) * 16 + u.pn * 4 + wc] = s; } }
    }
};
struct EpiResidStaged {
    static constexpr bool PERM = true, AFTER_DRAIN = true, ROWPERM = false;
    const float* xin_lat; const float* xin_ctx; float* xout_lat; float* xout_ctx; const float* gate;
    bf16_t* xg; const float* gn; const float* scn; float* ssq;
    static constexpr int RS = 1040;
    __device__ __forceinline__ void operator()(const f32x4 (&)[2][2][4][2], const Unit&, int, int, int, int) const {}
    __device__ __forceinline__ void fused(const f32x4 (&acc)[2][2][4][2], const Unit& u, int wr, int wc, int fr, int fq, PG8_LAS unsigned char* lds, int wid, int lane) const {
        const int id = u.pm < 32 ? 0 : (u.pm < 64 ? 1 : 2);
        const float* xin = u.pm < 64 ? xin_lat + (size_t)u.pm * BM * DM : xin_ctx + (size_t)(u.pm - 64) * BM * DM;
        float* xout = u.pm < 64 ? xout_lat + (size_t)u.pm * BM * DM : xout_ctx + (size_t)(u.pm - 64) * BM * DM;
        const int colg = u.pn * BM + 4 * lane;
        const f32x4 gv = *(const f32x4*)(gate + id * 6144 + colg);
        f32x4 gsv = {0.f, 0.f, 0.f, 0.f}; if (xg) gsv = *(const f32x4*)(gn + colg) * (1.f + *(const f32x4*)(scn + id * 6144 + colg));
#pragma unroll
        for (int ai = 0; ai < 2; ++ai) {
#pragma unroll
            for (int m = 0; m < 4; ++m)
#pragma unroll
                for (int bj = 0; bj < 2; ++bj)
#pragma unroll
                    for (int n = 0; n < 2; ++n) *(PG8_LAS f32x4*)(lds + (wr * 64 + m * 16 + fr) * RS + (bj * HALF + wc * 32 + 8 * fq + 4 * n) * 4) = acc[ai][bj][m][n];
            asm volatile("s_waitcnt lgkmcnt(0)\n\ts_barrier" ::: "memory");
#pragma unroll
            for (int r8 = 0; r8 < 2; ++r8) {
                f32x4 xv[8], av[8]; float s[8];
#pragma unroll
                for (int q = 0; q < 8; ++q) { const int row = wid * 16 + r8 * 8 + q; xv[q] = *(const f32x4*)(xin + (size_t)(ai * HALF + row) * DM + colg); av[q] = *(const PG8_LAS f32x4*)(lds + row * RS + lane * 16); }
#pragma unroll
                for (int q = 0; q < 8; ++q) { const int row = wid * 16 + r8 * 8 + q; const f32x4 o = xv[q] + gv * av[q];
                    *(f32x4*)(xout + (size_t)(ai * HALF + row) * DM + colg) = o; s[q] = (o[0] * o[0] + o[1] * o[1]) + (o[2] * o[2] + o[3] * o[3]);
                    if (xg) { const f32x4 a = o * gsv; u32x2 w; w.x = cvtpk(a[0], a[1]); w.y = cvtpk(a[2], a[3]); *(u32x2*)(xg + (size_t)(u.pm * BM + ai * HALF + row) * DM + colg) = w; } }
                if (xg) {
#pragma unroll
                    for (int o_ = 1; o_ < 64; o_ <<= 1)
#pragma unroll
                        for (int q = 0; q < 8; ++q) s[q] += shfl_x(s[q], o_, lane);
                    float sv = s[0];
#pragma unroll
                    for (int q = 1; q < 8; ++q) sv = lane == q ? s[q] : sv;
                    if (lane < 8) *(f32x4*)(ssq + (size_t)(u.pm * BM + ai * HALF + wid * 16 + r8 * 8 + lane) * 16 + u.pn * 4) = (f32x4){sv, 0.f, 0.f, 0.f}; }
            }
            asm volatile("s_waitcnt lgkmcnt(0)\n\ts_barrier" ::: "memory");
        }
    }
};
struct EpiUp {
    static constexpr bool PERM = true, AFTER_DRAIN = false, ROWPERM = true;
    bf16_t* act; const float* convw; const float* convb; float* edge; const LAS float* rtab; const float* bias;
    __device__ __forceinline__ void operator()(f32x4 (&acc)[2][2][4][2], const Unit& u, int wr, int wc, int fr, int fq) const {
        asm volatile("" : "+v"(fr), "+v"(fq));
        const int chb = u.pn * 128 + wc * 32 + 8 * fq;
        const int ht = 2 * u.pm + wr;
        {
            const f32x4 ra = *(const LAS f32x4*)(rtab + u.ui * 256 + (wr * 16 + fr) * 8), rb = *(const LAS f32x4*)(rtab + u.ui * 256 + (wr * 16 + fr) * 8 + 4);
            const float rs[8] = {ra[0], ra[1], ra[2], ra[3], rb[0], rb[1], rb[2], rb[3]};
            const int id = u.pm < 32 ? 0 : (u.pm < 64 ? 1 : 2);
#pragma unroll
            for (int bj = 0; bj < 2; ++bj)
#pragma unroll
                for (int n = 0; n < 2; ++n) { const f32x4 bv = *(const f32x4*)(bias + id * DFF2 + bj * DFF + chb + 4 * n);
#pragma unroll
                    for (int sl = 0; sl < 8; ++sl) { acc[sl >> 2][bj][sl & 3][n] = acc[sl >> 2][bj][sl & 3][n] * rs[sl] + bv; asm volatile("" : "+v"(acc[sl >> 2][bj][sl & 3][n])); } }
        }
        const int lm1 = (fq * 16 + fr - 1) & 63, lp1 = (fq * 16 + fr + 1) & 63;
#pragma unroll
        for (int bj = 0; bj < 2; ++bj)
#pragma unroll
            for (int n = 0; n < 2; ++n) {
                const int uc = bj * DFF + chb + 4 * n;
                if (fr == 0) { *(f32x4*)(edge + ((size_t)ht * 4 + 0) * DFF2 + uc) = acc[0][bj][0][n]; *(f32x4*)(edge + ((size_t)ht * 4 + 1) * DFF2 + uc) = acc[0][bj][1][n]; }
                if (fr == 15) { *(f32x4*)(edge + ((size_t)ht * 4 + 2) * DFF2 + uc) = acc[1][bj][2][n]; *(f32x4*)(edge + ((size_t)ht * 4 + 3) * DFF2 + uc) = acc[1][bj][3][n]; }
#pragma unroll
                for (int j = 0; j < 4; ++j) {
                    const float w0 = convw[uc + j], w1 = convw[DFF2 + uc + j], w2 = convw[2 * DFF2 + uc + j], bb = convb[uc + j];
                    float pv = shfl_idx(acc[1][bj][3][n][j], lm1); const float nx = shfl_idx(acc[0][bj][0][n][j], lp1);
#pragma unroll
                    for (int sl = 0; sl < 8; ++sl) { const float cur = acc[sl >> 2][bj][sl & 3][n][j]; const float nxt = sl < 7 ? acc[(sl + 1) >> 2][bj][(sl + 1) & 3][n][j] : nx;
                        acc[sl >> 2][bj][sl & 3][n][j] = w0 * pv + w1 * cur + w2 * nxt + bb; pv = cur; }
                }
#pragma unroll
                for (int sl = 0; sl < 8; ++sl) asm volatile("" : "+v"(acc[sl >> 2][bj][sl & 3][n]));
            }
        bf16_t* base = act + (size_t)(u.pm * BM + (wr * 16 + fr) * 8) * DFF + chb;
#pragma unroll
        for (int sl = 0; sl < 8; ++sl) {
            const f32x4 g0 = acc[sl >> 2][0][sl & 3][0], g1 = acc[sl >> 2][0][sl & 3][1], v0 = acc[sl >> 2][1][sl & 3][0], v1 = acc[sl >> 2][1][sl & 3][1];
            f32x4 o0, o1;
#pragma unroll
            for (int j = 0; j < 4; ++j) { o0[j] = g0[j] * __builtin_amdgcn_rcpf(1.f + __builtin_amdgcn_exp2f(-LOG2E * g0[j])) * v0[j]; o1[j] = g1[j] * __builtin_amdgcn_rcpf(1.f + __builtin_amdgcn_exp2f(-LOG2E * g1[j])) * v1[j]; }
            u32x4 w; w.x = cvtpk(o0[0], o0[1]); w.y = cvtpk(o0[2], o0[3]); w.z = cvtpk(o1[0], o1[1]); w.w = cvtpk(o1[2], o1[3]);
            const bool skip = (fr == 0 && sl == 0) || (fr == 15 && sl == 7);
            if (!skip) *(u32x4*)(base + (size_t)sl * DFF) = w;
        }
    }
};
template <class Epi, class Sched, bool ALIGN_EPI = false, bool SP2 = false>
__device__ __forceinline__ void gemm_phase(PG8_LAS unsigned char* lds, const Gemm g, const Sched& S, const Epi& E, const int tid) {
    const int wid = __builtin_amdgcn_readfirstlane(tid >> 6), lane = tid & 63, wr = wid >> 2, wc = wid & 3, fr = lane & 15, fq = lane >> 4;
    const int K = g.K, nt = K / BK;
    unsigned voffA[2], voffB[2];
#pragma unroll
    for (int i = 0; i < 2; ++i) { int R, C; stage_rc(tid * 16 + i * 8192, R, C); const int Rb = Epi::PERM ? ((R & ~31) + perm32(R & 31)) : R;
        const int Ra = Epi::ROWPERM ? (((((R >> 6) & 1) * 16 + (R & 15)) << 3) + ((R >> 4) & 3)) : R;
        voffA[i] = (unsigned)(Ra * K + C) * 2u; voffB[i] = (unsigned)(Rb * K + C) * 2u; }
    const size_t kstep = (size_t)(BK * 2);
    const size_t hstep = (size_t)HALF * K * 2;
    const size_t hstepA = Epi::ROWPERM ? (size_t)4 * K * 2 : hstep;
    const size_t tstep = 2 * hstep;
    const unsigned ldsw = (unsigned)wid * 1024u;
    const int aoff = lds_byte(wr * 64 + fr, fq * 8), boff = lds_byte(wc * 32 + fr, fq * 8);
#define PG8_SA(b, h) (((b) * 2 + (h)) * HTB)
#define PG8_SB(b, h) ((4 + (b) * 2 + (h)) * HTB)
#define PG8_STAGE(bufoff, gbase, voff) do { _Pragma("unroll") for (int _i = 0; _i < 2; ++_i) \
        __builtin_amdgcn_global_load_lds((const unsigned*)((const char*)(gbase) + (voff)[_i]), (PG8_LAS unsigned*)(lds + (bufoff) + ldsw + _i * 8192), 16, 0, 0); } while (0)
#define PG8_LDA(dst, b, h) do { _Pragma("unroll") for (int m = 0; m < 4; ++m) _Pragma("unroll") for (int k = 0; k < 2; ++k) dst[m][k] = *(const PG8_LAS bf16x8*)(lds + PG8_SA(b, h) + aoff + m * 2048 + k * 1024); } while (0)
#define PG8_LDB(dst, b, h) do { _Pragma("unroll") for (int n = 0; n < 2; ++n) _Pragma("unroll") for (int k = 0; k < 2; ++k) dst[n][k] = *(const PG8_LAS bf16x8*)(lds + PG8_SB(b, h) + boff + n * 2048 + k * 1024); } while (0)
#define PG8_MMA(ai, bj, At, Bt) do { __builtin_amdgcn_s_setprio(1); _Pragma("unroll") for (int m = 0; m < 4; ++m) _Pragma("unroll") for (int n = 0; n < 2; ++n) _Pragma("unroll") for (int k = 0; k < 2; ++k) \
        acc[ai][bj][m][n] = __builtin_amdgcn_mfma_f32_16x16x32_bf16(Bt[n][k], At[m][k], acc[ai][bj][m][n], 0, 0, 0); __builtin_amdgcn_s_setprio(0); } while (0)
#define PG8_WAIT_V(n) asm volatile("s_waitcnt vmcnt(" #n ")" ::: "memory")
#define PG8_WAIT_L(n) asm volatile("s_waitcnt lgkmcnt(" #n ")" ::: "memory")
#define PG8_BAR __builtin_amdgcn_s_barrier()
#define PG8_SCHED __builtin_amdgcn_sched_barrier(0)
    Unit cur, nxt; int ui = 0;
    if (!S.next(0, cur)) return;
    f32x4 acc[2][2][4][2];
#pragma unroll
    for (int a = 0; a < 2; ++a)
#pragma unroll
        for (int b = 0; b < 2; ++b)
#pragma unroll
            for (int m = 0; m < 4; ++m)
#pragma unroll
                for (int n = 0; n < 2; ++n) acc[a][b][m][n] = (f32x4){0.f, 0.f, 0.f, 0.f};
    bf16x8 At[4][2], B0[2][2], B1[2][2];
    const char* cA = (const char*)g.A + (size_t)cur.pm * tstep; const char* cB = (const char*)g.Bt + (size_t)cur.pn * tstep;
    S.a_ready(cur);
    if constexpr (SP2) {
        PG8_STAGE(PG8_SB(0, 0), cB, voffB); PG8_STAGE(PG8_SB(0, 1), cB + hstep, voffB); PG8_STAGE(PG8_SA(0, 0), cA, voffA); PG8_STAGE(PG8_SA(0, 1), cA + hstepA, voffA);
        if (wr == 1) PG8_BAR;
        PG8_WAIT_V(2); PG8_BAR;
        PG8_STAGE(PG8_SB(1, 0), cB + kstep, voffB); PG8_STAGE(PG8_SA(1, 0), cA + kstep, voffA); PG8_STAGE(PG8_SB(1, 1), cB + hstep + kstep, voffB);
        PG8_WAIT_V(6); PG8_BAR;
    } else {
        PG8_STAGE(PG8_SB(0, 0), cB, voffB); PG8_STAGE(PG8_SA(0, 0), cA, voffA); PG8_STAGE(PG8_SB(0, 1), cB + hstep, voffB); PG8_STAGE(PG8_SA(0, 1), cA + hstepA, voffA);
        if (wr == 1) PG8_BAR;
        PG8_WAIT_V(4); PG8_BAR;
        PG8_STAGE(PG8_SB(1, 0), cB + kstep, voffB); PG8_STAGE(PG8_SA(1, 0), cA + kstep, voffA); PG8_STAGE(PG8_SB(1, 1), cB + hstep + kstep, voffB);
        PG8_WAIT_V(6); PG8_BAR;
    }
    PROBE_PT(lds, 1);
    for (;;) {
        const bool has_next = S.next(ui + 1, nxt);
        const char* nA = has_next ? (const char*)g.A + (size_t)nxt.pm * tstep : cA; const char* nB = has_next ? (const char*)g.Bt + (size_t)nxt.pn * tstep : cB;
        for (int t = 0; t < nt; t += 2) {
            const bool last = (t == nt - 2);
            const char* a1 = cA + (size_t)(t + 1) * kstep;
            const char* a2 = last ? nA : cA + (size_t)(t + 2) * kstep; const char* b2 = last ? nB : cB + (size_t)(t + 2) * kstep;
            const char* a3 = a2 + kstep; const char* b3 = b2 + kstep;
            if (last && has_next) S.a_ready(nxt);
            if constexpr (SP2) {
            PG8_LDB(B0, 0, 0); PG8_LDB(B1, 0, 1); PG8_SCHED; PG8_LDA(At, 0, 0); PG8_STAGE(PG8_SA(1, 1), a1 + hstepA, voffA);
            PG8_WAIT_V(8); PG8_WAIT_L(0); PG8_BAR; PG8_MMA(0, 0, At, B0); PG8_MMA(0, 1, At, B1); PG8_BAR; PG8_SCHED;
            PG8_LDA(At, 0, 1); PG8_STAGE(PG8_SB(0, 0), b2, voffB); PG8_STAGE(PG8_SB(0, 1), b2 + hstep, voffB); PG8_STAGE(PG8_SA(0, 0), a2, voffA);
            PG8_WAIT_V(8); PG8_WAIT_L(0); PG8_BAR; PG8_MMA(1, 0, At, B0); PG8_MMA(1, 1, At, B1); PG8_BAR; PG8_SCHED;
            PG8_LDB(B0, 1, 0); PG8_LDB(B1, 1, 1); PG8_SCHED; PG8_LDA(At, 1, 0); PG8_STAGE(PG8_SA(0, 1), a2 + hstepA, voffA);
            PG8_WAIT_V(8); PG8_WAIT_L(0); PG8_BAR; PG8_MMA(0, 0, At, B0); PG8_MMA(0, 1, At, B1); PG8_BAR; PG8_SCHED;
            PG8_LDA(At, 1, 1); PG8_STAGE(PG8_SB(1, 0), b3, voffB); PG8_STAGE(PG8_SB(1, 1), b3 + hstep, voffB); PG8_STAGE(PG8_SA(1, 0), a3, voffA);
            PG8_WAIT_V(8); PG8_WAIT_L(0); PG8_BAR; PG8_MMA(1, 0, At, B0); PG8_MMA(1, 1, At, B1); PG8_BAR; PG8_SCHED;
            } else {
            PG8_LDB(B0, 0, 0); PG8_SCHED; PG8_LDA(At, 0, 0); PG8_STAGE(PG8_SA(1, 1), a1 + hstepA, voffA);
            PG8_WAIT_L(8); PG8_BAR; PG8_WAIT_L(0); PG8_MMA(0, 0, At, B0); PG8_BAR; PG8_SCHED;
            PG8_LDB(B1, 0, 1); PG8_STAGE(PG8_SB(0, 0), b2, voffB);
            PG8_BAR; PG8_WAIT_L(0); PG8_MMA(0, 1, At, B1); PG8_BAR;
            PG8_LDA(At, 0, 1); PG8_STAGE(PG8_SA(0, 0), a2, voffA);
            PG8_BAR; PG8_WAIT_L(0); PG8_MMA(1, 0, At, B0); PG8_BAR; PG8_SCHED;
            PG8_STAGE(PG8_SB(0, 1), b2 + hstep, voffB);
            PG8_WAIT_V(6); PG8_BAR; PG8_MMA(1, 1, At, B1); PG8_BAR;
            PG8_LDB(B0, 1, 0); PG8_SCHED; PG8_LDA(At, 1, 0); PG8_STAGE(PG8_SA(0, 1), a2 + hstepA, voffA);
            PG8_WAIT_L(8); PG8_BAR; PG8_WAIT_L(0); PG8_MMA(0, 0, At, B0); PG8_BAR; PG8_SCHED;
            PG8_LDB(B1, 1, 1); PG8_STAGE(PG8_SB(1, 0), b3, voffB);
            PG8_BAR; PG8_WAIT_L(0); PG8_MMA(0, 1, At, B1); PG8_BAR;
            PG8_LDA(At, 1, 1); PG8_STAGE(PG8_SA(1, 0), a3, voffA);
            PG8_BAR; PG8_WAIT_L(0); PG8_MMA(1, 0, At, B0); PG8_BAR; PG8_SCHED;
            PG8_STAGE(PG8_SB(1, 1), b3 + hstep, voffB);
            PG8_WAIT_V(6); PG8_BAR; PG8_MMA(1, 1, At, B1); PG8_BAR;
            }
        }
        PROBE_PT(lds, 2);
        if constexpr (ALIGN_EPI) { if (wr == 0) PG8_BAR; }
        if constexpr (!Epi::AFTER_DRAIN) { E(acc, cur, wr, wc, fr, fq); S.done(cur); }
        PROBE_PT(lds, 3);
        if (!has_next) break;
#pragma unroll
        for (int a = 0; a < 2; ++a)
#pragma unroll
            for (int b = 0; b < 2; ++b)
#pragma unroll
                for (int m = 0; m < 4; ++m)
#pragma unroll
                    for (int n = 0; n < 2; ++n) acc[a][b][m][n] = (f32x4){0.f, 0.f, 0.f, 0.f};
        cur = nxt; cA = nA; cB = nB; ++ui;
        if constexpr (ALIGN_EPI) { if (wr == 1) PG8_BAR; }
    }
    PG8_WAIT_V(0);
    if constexpr (!ALIGN_EPI) { if (wr == 0) PG8_BAR; }
    PG8_BAR;
    if constexpr (Epi::AFTER_DRAIN) { E.fused(acc, cur, wr, wc, fr, fq, lds, wid, lane); S.done(cur); }
#undef PG8_SA
#undef PG8_SB
#undef PG8_STAGE
#undef PG8_LDA
#undef PG8_LDB
#undef PG8_MMA
#undef PG8_WAIT_V
#undef PG8_WAIT_L
#undef PG8_BAR
#undef PG8_SCHED
}
}

constexpr size_t WS_WGB = WS_WG + 192 * 1024;
constexpr size_t WS_MODP = 235 * MiB;
constexpr int NWAVES = 8, NTHREADS = 512;
constexpr int LDSCTL_OFF = 155648;
constexpr int LDS_BYTES = LDSCTL_OFF + 256;
struct Args {
    const float* in[21]; float* out; unsigned char* ws; int ph_lo, ph_hi;
};
struct Frame {
    LAS unsigned char* lds;
    int tid, lane, wave, G, bid;
    const __attribute__((address_space(4))) Args* ka;
    float* out; unsigned char* ws;
};
enum { IN_X = 0, IN_C, IN_CTX, IN_CCTX, IN_WMOD, IN_BMOD, IN_G1, IN_G2, IN_WIN, IN_AQG, IN_AKG, IN_SINK, IN_CGB, IN_RPB, IN_GGRP, IN_WOUT, IN_WUP, IN_CONVW, IN_CONVB, IN_WDN, IN_GFIN };

template <class MapFn>
__device__ __forceinline__ void transpose_item(const float* W, int K, int N, bf16_t* WT, LAS float* scr, int item, int lane, MapFn map) {
    const int nblk = (N + 63) / 64, kb = item / nblk, nb = item % nblk, k0 = 64 * kb, n0 = 64 * nb;
    const int nc = n0 + 4 * (lane & 15);
    f32x4 v[16];
#pragma unroll
    for (int i = 0; i < 16; ++i) { const int kk = (lane >> 4) + 4 * i; v[i] = nc < N ? *(const f32x4*)(W + (size_t)(k0 + kk) * N + nc) : (f32x4){0.f, 0.f, 0.f, 0.f}; }
#pragma unroll
    for (int i = 0; i < 16; ++i) { const int kk = (lane >> 4) + 4 * i; LAS float* d = scr + kk * 65 + 4 * (lane & 15); d[0] = v[i][0]; d[1] = v[i][1]; d[2] = v[i][2]; d[3] = v[i][3]; }
    LDS_WAIT(); asm volatile("" ::: "memory");
    const int c = lane & 7;
#pragma unroll
    for (int j = 0; j < 8; ++j) { const int n = (lane >> 3) + 8 * j; const LAS float* s = scr + (8 * c) * 65 + n;
        u32x4 o; o.x = cvtpk(s[0 * 65], s[1 * 65]); o.y = cvtpk(s[2 * 65], s[3 * 65]); o.z = cvtpk(s[4 * 65], s[5 * 65]); o.w = cvtpk(s[6 * 65], s[7 * 65]);
        const int sc = n0 + n; const int dr = sc < N ? map(sc) : -1;
        if (dr >= 0) *(u32x4*)(WT + (size_t)dr * K + k0 + 8 * c) = o; }
    LDS_WAIT(); asm volatile("" ::: "memory");
}
__device__ __forceinline__ void p0_prologue(Frame& F) {
    const float* c = F.ka->in[IN_C]; const float* cctx = F.ka->in[IN_CCTX];
    const int gw = F.bid * NWAVES + F.wave, NGW = F.G * NWAVES;
    if (F.bid < NLAYER * 48 || F.G < NLAYER * 48 + 8) {
        LAS float* sv = (LAS float*)F.lds;
        LAS float* red = (LAS float*)(F.lds + 12288);
        for (int i = F.tid; i < 3 * 1024; i += NTHREADS) { const int id = i >> 10, k = i & 1023; const float v = id < 2 ? c[id * 1024 + k] : cctx[k]; sv[i] = v / (1.f + __expf(-v)); }
        __syncthreads();
        float* MOD = (float*)(F.ws + WS_MOD);
        for (int it = F.bid; it < NLAYER * 48; it += F.G) {
            const int l = it / 48, nb = it % 48, n = nb * 128 + 2 * F.lane;
            const float* w = F.ka->in[IN_WMOD] + ((size_t)l * 1024 + F.wave * 128) * 6144 + n;
            f32x2 a0 = {0.f, 0.f}, a1 = {0.f, 0.f}, a2 = {0.f, 0.f};
#pragma unroll 16
            for (int k = 0; k < 128; ++k) { const f32x2 wv = *(const f32x2*)(w + (size_t)k * 6144); const int kk = F.wave * 128 + k; a0 += sv[kk] * wv; a1 += sv[1024 + kk] * wv; a2 += sv[2048 + kk] * wv; }
            *(LAS f32x2*)(red + (F.wave * 3 + 0) * 128 + 2 * F.lane) = a0; *(LAS f32x2*)(red + (F.wave * 3 + 1) * 128 + 2 * F.lane) = a1; *(LAS f32x2*)(red + (F.wave * 3 + 2) * 128 + 2 * F.lane) = a2;
            __syncthreads();
            if (F.tid < 384) { const int id = F.tid >> 7, ln = F.tid & 127; float s = F.ka->in[IN_BMOD][l * 6144 + nb * 128 + ln];
#pragma unroll
                for (int w8 = 0; w8 < 8; ++w8) s += red[(w8 * 3 + id) * 128 + ln];
                MOD[((size_t)l * 3 + id) * 6144 + nb * 128 + ln] = s; }
            __syncthreads();
        }
    }
    PROBE_PT(F.lds, 1);
    { const int b0 = F.G >= NLAYER * 48 + 8 ? NLAYER * 48 : 0, nb_ = F.G - b0;
      if (F.bid >= b0) { const int gt2 = (F.bid - b0) * NTHREADS + F.tid, NGT2 = nb_ * NTHREADS;
        float* ROPE = (float*)(F.ws + WS_ROPE); float* WG = (float*)(F.ws + WS_WG); bf16_t* WGB = (bf16_t*)(F.ws + WS_WGB);
        for (int e = gt2; e < 192 * 16 + NLAYER * 16 * 1024; e += NGT2) {
            if (e < 192 * 16) { const int idx = e >> 4, i = e & 15; const float pos = (float)(idx < 128 ? idx : idx - 128);
                const float freq = powf(10000.0f, -(float)i / 16.0f); const float ang = pos * freq; ROPE[2 * e] = cosf(ang); ROPE[2 * e + 1] = sinf(ang); }
            else { const int e2 = e - 192 * 16, l = e2 >> 14, o = (e2 >> 10) & 15, k = e2 & 1023; const float v = F.ka->in[IN_WIN][((size_t)l * 1024 + k) * DIN + 2048 + o]; WG[e2] = v; WGB[e2] = (bf16_t)(cvtpk(v, 0.f) & 0xffffu); } } } }
    PROBE_PT(F.lds, 2);
    LAS float* scr = (LAS float*)(F.lds + F.wave * 16896);
    constexpr int I_IN = 16 * 45, I_OUT = 16 * 16, I_UP = 16 * 88, I_DN = 44 * 16, I_L = I_IN + I_OUT + I_UP + I_DN;
    for (int it = gw; it < NLAYER * I_L; it += NGW) {
        const int l = it / I_L; int r = it % I_L;
        if (r < I_IN) { transpose_item(F.ka->in[IN_WIN] + (size_t)l * 1024 * DIN, 1024, DIN, (bf16_t*)(F.ws + WS_WIN) + (size_t)l * PP * 1024, scr, r, F.lane,
                                       [](int n) { return n < 2048 ? n : (n < 2064 ? -1 : n - 16); }); continue; } r -= I_IN;
        if (r < I_OUT) { transpose_item(F.ka->in[IN_WOUT] + (size_t)l * 1024 * 1024, 1024, 1024, (bf16_t*)(F.ws + WS_WOUT) + (size_t)l * 1024 * 1024, scr, r, F.lane, [](int n) { return n; }); continue; } r -= I_OUT;
        if (r < I_UP) { transpose_item(F.ka->in[IN_WUP] + (size_t)l * 1024 * DFF2, 1024, DFF2, (bf16_t*)(F.ws + WS_WUP) + (size_t)l * DFF2 * 1024, scr, r, F.lane,
                                       [](int n) { const int m = n < DFF ? n : n - DFF; return (m >> 7) * 256 + (n < DFF ? 0 : 128) + (m & 127); }); continue; } r -= I_UP;
        transpose_item(F.ka->in[IN_WDN] + (size_t)l * DFF * 1024, DFF, 1024, (bf16_t*)(F.ws + WS_WDN) + (size_t)l * 1024 * DFF, scr, r, F.lane, [](int n) { return n; });
    }
}

template <int R>
__device__ __forceinline__ void norm_rows(Frame& F, const float* xbase, int row0, const float* sh, const float* sc, const f32x4 (&gv)[4]) {
    bf16_t* H = (bf16_t*)(F.ws + WS_H);
    f32x4 hv[R][4]; float ss[R];
#pragma unroll
    for (int r = 0; r < R; ++r)
#pragma unroll
        for (int j = 0; j < 4; ++j) hv[r][j] = *(const f32x4*)(xbase + (size_t)r * DM + 4 * F.lane + 256 * j);
#pragma unroll
    for (int r = 0; r < R; ++r) { float s = 0.f;
#pragma unroll
        for (int j = 0; j < 4; ++j) s += (hv[r][j][0] * hv[r][j][0] + hv[r][j][1] * hv[r][j][1]) + (hv[r][j][2] * hv[r][j][2] + hv[r][j][3] * hv[r][j][3]);
        ss[r] = s; }
#pragma unroll
    for (int o = 1; o < 64; o <<= 1)
#pragma unroll
        for (int r = 0; r < R; ++r) ss[r] += shfl_x(ss[r], o, F.lane);
#pragma unroll
    for (int j = 0; j < 4; ++j) { const f32x4 scv = 1.f + *(const f32x4*)(sc + 4 * F.lane + 256 * j), shv = *(const f32x4*)(sh + 4 * F.lane + 256 * j);
#pragma unroll
        for (int r = 0; r < R; ++r) { const f32x4 v = hv[r][j] * rsqrtf(ss[r] * (1.f / DM) + EPS) * gv[j] * scv + shv;
            u32x2 w; w.x = cvtpk(v[0], v[1]); w.y = cvtpk(v[2], v[3]);
            *(u32x2*)(H + (size_t)(row0 + r) * DM + 4 * F.lane + 256 * j) = w; } }
}
__device__ __forceinline__ void norm_phase(Frame& F, int layer) {
    const int gw = F.bid * NWAVES + F.wave, NGW = F.G * NWAVES;
    const float* gvec = F.ka->in[IN_G1] + layer * 1024;
    const float* mod = (const float*)(F.ws + WS_MOD) + (size_t)layer * 3 * 6144;
    const float* xl = F.ka->in[IN_X]; const float* xc = F.ka->in[IN_CTX];
    f32x4 gv[4];
#pragma unroll
    for (int j = 0; j < 4; ++j) gv[j] = *(const f32x4*)(gvec + 4 * F.lane + 256 * j);
    for (int rg = gw; rg < NLAT / 8; rg += NGW) { const int row0 = rg * 8, id = row0 < SEQ ? 0 : 1; norm_rows<8>(F, xl + (size_t)row0 * DM, row0, mod + id * 6144, mod + id * 6144 + 1024, gv); }
    for (int rg = gw; rg < NBATCH * CTXL / 2; rg += NGW) { const int row0 = rg * 2; norm_rows<2>(F, xc + (size_t)row0 * DM, NLAT + row0, mod + 2 * 6144, mod + 2 * 6144 + 1024, gv); }
}

constexpr size_t WS_BIASG = WS_BIASIN + 64 * 1024;
__device__ __forceinline__ void bias_phase(Frame& F, int bslot, int nslots) {
    if (bslot < 0 && nslots > 0) return;
    if (nslots <= 0) { bslot = F.bid; nslots = F.G; }
    const int gw = bslot * NWAVES + F.wave, NGW = nslots * NWAVES, lane = F.lane, fr = lane & 15, fq = lane >> 4;
    const float* MOD = (const float*)(F.ws + WS_MOD);
    float* BUP = (float*)(F.ws + WS_BIASUP); float* BIN = (float*)(F.ws + WS_BIASIN); float* BG = (float*)(F.ws + WS_BIASG);
    constexpr int J_UP = DFF2 / 16, J_IN = PP / 16;
    for (int job = gw; job < 2 * J_UP + J_IN + 1; job += NGW) {
        const bool isup = job < 2 * J_UP, isin = !isup && job < 2 * J_UP + J_IN; const int l = isup ? job / J_UP : 1, r0 = 16 * (isup ? job % J_UP : (isin ? job - 2 * J_UP : 0));
        const bf16_t* wrow = isup ? (const bf16_t*)(F.ws + WS_WUP) + ((size_t)l * DFF2 + r0 + fr) * 1024 : (isin ? (const bf16_t*)(F.ws + WS_WIN) + ((size_t)PP + r0 + fr) * 1024 : (const bf16_t*)(F.ws + WS_WGB) + (size_t)(16 + fr) * 1024);
        const float* sh = MOD + ((size_t)l * 3 + (fr < 3 ? fr : 0)) * 6144 + (isup ? 3 * 1024 : 0) + 8 * fq;
        const bf16_t* bp = wrow + 8 * fq;
        f32x4 acc = {0.f, 0.f, 0.f, 0.f};
        for (int k0 = 0; k0 < DM / 32; k0 += 8) { f32x4 a0[8], a1[8]; bf16x8 bv[8];
#pragma unroll
            for (int j = 0; j < 8; ++j) { a0[j] = *(const f32x4*)(sh + 32 * (k0 + j)); a1[j] = *(const f32x4*)(sh + 32 * (k0 + j) + 4); bv[j] = *(const bf16x8*)(bp + 32 * (k0 + j)); }
#pragma unroll
            for (int j = 0; j < 8; ++j) { u32x4 aw; aw.x = cvtpk(a0[j][0], a0[j][1]); aw.y = cvtpk(a0[j][2], a0[j][3]); aw.z = cvtpk(a1[j][0], a1[j][1]); aw.w = cvtpk(a1[j][2], a1[j][3]);
                acc = __builtin_amdgcn_mfma_f32_16x16x32_bf16(__builtin_bit_cast(bf16x8, aw), bv[j], acc, 0, 0, 0); } }
        if (fq == 0) { const int r = r0 + fr;
            if (isup) { const int pn = r >> 8, i = r & 255; const int uc = i < 128 ? pn * 128 + i : DFF + pn * 128 + (i - 128);
                BUP[((size_t)l * 3 + 0) * DFF2 + uc] = acc[0]; BUP[((size_t)l * 3 + 1) * DFF2 + uc] = acc[1]; BUP[((size_t)l * 3 + 2) * DFF2 + uc] = acc[2]; }
            else if (isin) { BIN[r] = acc[0]; BIN[PP + r] = acc[1]; BIN[2 * PP + r] = acc[2]; }
            else { BG[fr] = acc[0]; BG[16 + fr] = acc[1]; BG[32 + fr] = acc[2]; } }
    }
}
__device__ __forceinline__ void gates_phase(Frame& F, int layer) {
    const int gw = F.bid * NWAVES + F.wave, NGW = F.G * NWAVES, lane = F.lane, fr = lane & 15, fq = lane >> 4;
    const bf16_t* H = (const bf16_t*)(F.ws + WS_H); const float* SSQ = (const float*)(F.ws + WS_SSQ1); const float* SSQC = (const float*)(F.ws + WS_SSQC1);
    const bf16_t* WGB = (const bf16_t*)(F.ws + WS_WGB) + (size_t)layer * 16 * 1024; const float* BG = (const float*)(F.ws + WS_BIASG);
    float* GATES = (float*)(F.ws + WS_GATES);
    for (int job = gw; job < NROWS / 16; job += NGW) {
        const int r0 = 16 * job; const int id = r0 < SEQ ? 0 : (r0 < NLAT ? 1 : 2);
        const bf16_t* ap = H + (size_t)(r0 + fr) * DM + 8 * fq; const bf16_t* bp = WGB + (size_t)fr * DM + 8 * fq;
        f32x4 acc = {0.f, 0.f, 0.f, 0.f};
        for (int k0 = 0; k0 < DM / 32; k0 += 16) { bf16x8 av[16], bv[16];
#pragma unroll
            for (int j = 0; j < 16; ++j) { av[j] = *(const bf16x8*)(ap + 32 * (k0 + j)); bv[j] = *(const bf16x8*)(bp + 32 * (k0 + j)); }
#pragma unroll
            for (int j = 0; j < 16; ++j) acc = __builtin_amdgcn_mfma_f32_16x16x32_bf16(av[j], bv[j], acc, 0, 0, 0); }
        float rs[4] = {1.f, 1.f, 1.f, 1.f}, bo = 0.f;
        if (layer > 0) {
            float s = 0.f;
            if (r0 < NLAT) { const f32x4 a = *(const f32x4*)(SSQ + (size_t)(r0 + (lane >> 2)) * 16 + 4 * (lane & 3)); s = (a[0] + a[1]) + (a[2] + a[3]); }
            else { const float* p = SSQC + (size_t)(r0 - NLAT + (lane >> 2)) * 64 + 16 * (lane & 3);
#pragma unroll
                for (int j = 0; j < 4; ++j) { const f32x4 a = *(const f32x4*)(p + 4 * j); s += (a[0] + a[1]) + (a[2] + a[3]); } }
            s += shfl_x(s, 1, lane); s += shfl_x(s, 2, lane);
            const float rr = rsqrtf(s * (1.f / DM) + EPS);
#pragma unroll
            for (int r = 0; r < 4; ++r) rs[r] = shfl_idx(rr, 4 * (4 * fq + r));
            bo = BG[id * 16 + fr];
        }
#pragma unroll
        for (int r = 0; r < 4; ++r) GATES[(size_t)(r0 + 4 * fq + r) * 16 + fr] = acc[r] * rs[r] + bo;
    }
}

__device__ __forceinline__ void postproj_phase(Frame& F, int layer) {
    const int gw = F.bid * NWAVES + F.wave, NGW = F.G * NWAVES;
    bf16_t* PROJ = (bf16_t*)(F.ws + WS_PROJ);
    const float* ROPE = (const float*)(F.ws + WS_ROPE);
    const int sub = F.lane >> 4, l16 = F.lane & 15, d = 4 * l16;
    const f32x4 gq = *(const f32x4*)(F.ka->in[IN_AQG] + layer * 64 + d), gk = *(const f32x4*)(F.ka->in[IN_AKG] + layer * 64 + d);
    const bool x2 = (l16 & 4) != 0;
    for (int rg = gw; rg < NROWS / 4; rg += NGW) {
        const int row0 = 4 * rg; const bool lat = row0 < NLAT;
        u32x2 w[4][3]; f32x4 cs0[4], cs1[4];
#pragma unroll
        for (int q = 0; q < 4; ++q) { const bf16_t* pr = PROJ + (size_t)(row0 + q) * PP; const int t = (row0 + q) & (SEQ - 1);
            cs0[q] = (f32x4){1.f, 0.f, 1.f, 0.f}; cs1[q] = cs0[q];
            if (lat) { const int idx = (d >> 5) ? 128 + (t & 63) : (t >> 6); const float* rp = ROPE + ((size_t)idx * 16 + (d & 15)) * 2; cs0[q] = *(const f32x4*)rp; cs1[q] = *(const f32x4*)(rp + 4); }
#pragma unroll
            for (int pass = 0; pass < 3; ++pass) { const int col = pass == 0 ? PC_AQ + 64 * sub + d : (pass == 1 ? (sub < 2 ? PC_AK + 64 * sub + d : PC_BK + 64 * (sub - 2) + d) : PC_BQ + 64 * sub + d);
                w[q][pass] = *(const u32x2*)(pr + col); } }
#pragma unroll
        for (int q = 0; q < 4; ++q) { bf16_t* pr = PROJ + (size_t)(row0 + q) * PP;
            const float cz[4] = {cs0[q][0], cs0[q][2], cs1[q][0], cs1[q][2]}, sz[4] = {cs0[q][1], cs0[q][3], cs1[q][1], cs1[q][3]};
#pragma unroll
            for (int pass = 0; pass < 3; ++pass) {
                const int col = pass == 0 ? PC_AQ + 64 * sub + d : (pass == 1 ? (sub < 2 ? PC_AK + 64 * sub + d : PC_BK + 64 * (sub - 2) + d) : PC_BQ + 64 * sub + d);
                const bool donorm = pass == 0 || (pass == 1 && sub < 2);
                const bool active = lat || donorm;
                if (!lat && pass == 2) continue;
                float v[4] = {bflo(w[q][pass].x), bfhi(w[q][pass].x), bflo(w[q][pass].y), bfhi(w[q][pass].y)};
                float ss = (v[0] * v[0] + v[1] * v[1]) + (v[2] * v[2] + v[3] * v[3]);
                ss += shfl_x(ss, 1, F.lane); ss += shfl_x(ss, 2, F.lane); ss += shfl_x(ss, 4, F.lane); ss += shfl_x(ss, 8, F.lane);
                if (donorm) { const float rstd = rsqrtf(ss * (1.f / 64.f) + EPS) * (pass == 0 ? QSCALE2 : 1.f); const f32x4 g = pass == 0 ? gq : gk;
#pragma unroll
                    for (int e = 0; e < 4; ++e) v[e] = v[e] * rstd * g[e]; }
                float o[4];
#pragma unroll
                for (int e = 0; e < 4; ++e) { const float p = shfl_x(v[e], 4, F.lane); o[e] = x2 ? (p * sz[e] + v[e] * cz[e]) : (v[e] * cz[e] - p * sz[e]); }
                if (active) { u32x2 ow; ow.x = cvtpk(o[0], o[1]); ow.y = cvtpk(o[2], o[3]); *(u32x2*)(pr + col) = ow; }
            } }
    }
}

template <bool WT = false>
__device__ __forceinline__ void groupnorm_rows(Frame& F, int layer, int row0, int nrows, int wv, int nw) {
    const bf16_t* H = (const bf16_t*)(F.ws + WS_H); bf16_t* YN = (bf16_t*)(F.ws + WS_PROJ);
    const float* gg = F.ka->in[IN_GGRP] + layer * 1024;
    f32x4 gv[4];
#pragma unroll
    for (int j = 0; j < 4; ++j) gv[j] = *(const f32x4*)(gg + 4 * F.lane + 256 * j);
    for (int r = 4 * wv; r < nrows; r += 4 * nw) {
        u32x2 w[4][4]; float ss[4][4];
#pragma unroll
        for (int q = 0; q < 4; ++q)
#pragma unroll
            for (int j = 0; j < 4; ++j) w[q][j] = *(const u32x2*)(H + (size_t)(row0 + r + q) * DM + 4 * F.lane + 256 * j);
#pragma unroll
        for (int q = 0; q < 4; ++q)
#pragma unroll
            for (int j = 0; j < 4; ++j) { const float v0 = bflo(w[q][j].x), v1 = bfhi(w[q][j].x), v2 = bflo(w[q][j].y), v3 = bfhi(w[q][j].y); ss[q][j] = (v0 * v0 + v1 * v1) + (v2 * v2 + v3 * v3); }
#pragma unroll
        for (int o = 1; o < 64; o <<= 1)
#pragma unroll
            for (int q = 0; q < 4; ++q)
#pragma unroll
                for (int j = 0; j < 4; ++j) ss[q][j] += shfl_x(ss[q][j], o, F.lane);
#pragma unroll
        for (int q = 0; q < 4; ++q)
#pragma unroll
            for (int j = 0; j < 4; ++j) { const float rstd = rsqrtf(ss[q][j] * (1.f / 256.f) + EPS);
                u32x2 o; o.x = cvtpk(bflo(w[q][j].x) * rstd * gv[j][0], bfhi(w[q][j].x) * rstd * gv[j][1]); o.y = cvtpk(bflo(w[q][j].y) * rstd * gv[j][2], bfhi(w[q][j].y) * rstd * gv[j][3]);
                if (WT) __hip_atomic_store((unsigned long long*)(YN + (size_t)(row0 + r + q) * DM + 4 * F.lane + 256 * j), (unsigned long long)o.x | ((unsigned long long)o.y << 32), __ATOMIC_RELAXED, __HIP_MEMORY_SCOPE_AGENT);
                else *(u32x2*)(YN + (size_t)(row0 + r + q) * DM + 4 * F.lane + 256 * j) = o; }
    }
}

__device__ __forceinline__ void fixup_hts(Frame& F, int layer, int ht0, int nht) {
    const float* edge = (const float*)(F.ws + WS_EDGE);
    const float* cw = F.ka->in[IN_CONVW] + (size_t)layer * 3 * DFF2; const float* cb = F.ka->in[IN_CONVB] + (size_t)layer * DFF2;
    bf16_t* act = (bf16_t*)(F.ws + WS_PROJ);
    const int per_row = DFF / 4;
    for (int it = F.tid; it < nht * 2 * per_row; it += NTHREADS) {
        const int ch = (it % per_row) * 4, rr = it / per_row, ht = ht0 + (rr >> 1), last = rr & 1;
        const bool seq_start = (ht == 0 || ht == 64 || ht == 128 || ht == 130), seq_end = (ht == 63 || ht == 127 || ht == 129 || ht == 131);
        const int row = ht * 128 + (last ? 127 : 0);
        f32x4 o;
        f32x4 res[2];
#pragma unroll
        for (int gvv = 0; gvv < 2; ++gvv) { const int uc = gvv * DFF + ch;
            const f32x4 z = {0.f, 0.f, 0.f, 0.f};
            f32x4 up, ucur, un;
            if (!last) { up = seq_start ? z : *(const f32x4*)(edge + ((size_t)(ht - 1) * 4 + 3) * DFF2 + uc); ucur = *(const f32x4*)(edge + ((size_t)ht * 4 + 0) * DFF2 + uc); un = *(const f32x4*)(edge + ((size_t)ht * 4 + 1) * DFF2 + uc); }
            else { up = *(const f32x4*)(edge + ((size_t)ht * 4 + 2) * DFF2 + uc); ucur = *(const f32x4*)(edge + ((size_t)ht * 4 + 3) * DFF2 + uc); un = seq_end ? z : *(const f32x4*)(edge + ((size_t)(ht + 1) * 4 + 0) * DFF2 + uc); }
            res[gvv] = *(const f32x4*)(cw + uc) * up + *(const f32x4*)(cw + DFF2 + uc) * ucur + *(const f32x4*)(cw + 2 * DFF2 + uc) * un + *(const f32x4*)(cb + uc); }
#pragma unroll
        for (int j = 0; j < 4; ++j) o[j] = res[0][j] / (1.f + __expf(-res[0][j])) * res[1][j];
        u32x2 w; w.x = cvtpk(o[0], o[1]); w.y = cvtpk(o[2], o[3]);
        *(u32x2*)(act + (size_t)row * DFF + ch) = w;
    }
}

template <int KDIM>
__device__ __forceinline__ void skinny_ctx(Frame& F, const bf16_t* A  , const bf16_t* Wt  , const float* xin, float* xout, const float* gate  ,
                                           bf16_t* xg  , const float* gn, const float* scn  , float* ssqc) {
    const int lane = F.lane, fr = lane & 15, fq = lane >> 4, t = F.tid, ldrow = t >> 3, chunk = t & 7;
    const int rf = F.wave >> 1, cp = F.wave & 1;
    constexpr int RSB = 144, BUFB = 64 * RSB, NKB = KDIM / 64;
    for (int p = F.bid; p < 128; p += F.G) {
        const int rg = p >> 4, cg = p & 15;
        if (KDIM == DM) { groupnorm_rows<false>(F, 0, NLAT + 64 * rg, 64, F.wave, NWAVES); VM_WAIT(); __syncthreads(); }
        const bf16_t* asrc = A + (size_t)(64 * rg + ldrow) * KDIM + 8 * chunk; const bf16_t* bsrc = Wt + (size_t)(64 * cg + ldrow) * KDIM + 8 * chunk;
        u32x4 ra[4], rb[4];
#pragma unroll
        for (int i = 0; i < 4; ++i) { ra[i] = *(const u32x4*)(asrc + 64 * i); rb[i] = *(const u32x4*)(bsrc + 64 * i); }
        f32x4 acc[2] = {{0.f, 0.f, 0.f, 0.f}, {0.f, 0.f, 0.f, 0.f}};
        __syncthreads();
        for (int kb0 = 0; kb0 < NKB; kb0 += 4) {
#pragma unroll
            for (int i = 0; i < 4; ++i) { const int kb = kb0 + i; LAS unsigned char* ba = F.lds + (kb & 1) * 2 * BUFB; LAS unsigned char* bb = ba + BUFB;
                *(LAS u32x4*)(ba + ldrow * RSB + 16 * chunk) = ra[i]; *(LAS u32x4*)(bb + ldrow * RSB + 16 * chunk) = rb[i];
                if (kb + 4 < NKB) { ra[i] = *(const u32x4*)(asrc + 64 * (kb + 4)); rb[i] = *(const u32x4*)(bsrc + 64 * (kb + 4)); }
                __syncthreads();
#pragma unroll
                for (int ks = 0; ks < 2; ++ks) { const bf16x8 af = *(const LAS bf16x8*)(ba + (16 * rf + fr) * RSB + 64 * ks + 16 * fq);
#pragma unroll
                    for (int j = 0; j < 2; ++j) { const bf16x8 bf = *(const LAS bf16x8*)(bb + (32 * cp + 16 * j + fr) * RSB + 64 * ks + 16 * fq); acc[j] = __builtin_amdgcn_mfma_f32_16x16x32_bf16(af, bf, acc[j], 0, 0, 0); } }
            }
        }
        float ss[4] = {0.f, 0.f, 0.f, 0.f};
#pragma unroll
        for (int j = 0; j < 2; ++j) { const int n = 64 * cg + 32 * cp + 16 * j + fr; const float g = gate[n], gs = gn[n] * (1.f + scn[n]);
#pragma unroll
            for (int r = 0; r < 4; ++r) { const int row = 64 * rg + 16 * rf + 4 * fq + r; const float o = xin[(size_t)row * DM + n] + g * acc[j][r];
                xout[(size_t)row * DM + n] = o; xg[(size_t)row * DM + n] = (bf16_t)(cvtpk(o * gs, 0.f) & 0xffffu); ss[r] += o * o; } }
#pragma unroll
        for (int r = 0; r < 4; ++r) { float s = ss[r]; s += shfl_x(s, 1, lane); s += shfl_x(s, 2, lane); s += shfl_x(s, 4, lane); s += shfl_x(s, 8, lane);
            if (fr == 0) { float* sp = ssqc + (size_t)(64 * rg + 16 * rf + 4 * fq + r) * 64 + cg * 2 + cp; sp[0] = s; sp[32] = 0.f; } }
        __syncthreads();
    }
}

__device__ __forceinline__ void final_phase(Frame& F) {
    const int gw = F.bid * NWAVES + F.wave, NGW = F.G * NWAVES;
    const float* gf = F.ka->in[IN_GFIN];
    f32x4 gv[4];
#pragma unroll
    for (int j = 0; j < 4; ++j) gv[j] = *(const f32x4*)(gf + 4 * F.lane + 256 * j);
    for (int row = gw; row < NLAT; row += NGW) {
        float* xr = F.out + (size_t)row * DM + 4 * F.lane;
        f32x4 v[4]; float s = 0.f;
#pragma unroll
        for (int j = 0; j < 4; ++j) { v[j] = *(const f32x4*)(xr + 256 * j); s += (v[j][0] * v[j][0] + v[j][1] * v[j][1]) + (v[j][2] * v[j][2] + v[j][3] * v[j][3]); }
        const float rstd = rsqrtf(wave_sum(s, F.lane) * (1.f / DM) + EPS);
#pragma unroll
        for (int j = 0; j < 4; ++j) *(f32x4*)(xr + 256 * j) = v[j] * rstd * gv[j];
    }
}

typedef GAS unsigned gu32;
#define RLX_AGENT __ATOMIC_RELAXED, __HIP_MEMORY_SCOPE_AGENT
constexpr int CW_BAR = 4096;
#define XB_TMO      128
#define XB_XCNT(j)  (256  + 64 * (j))
#define XB_XSUB(j)  (1280 + 64 * (j))
#define XB_XGEN(j)  (2304 + 64 * (j))
#define XB_TOP      3328
#define XB_TOPGEN   3392
#define XCD_BAR_WORDS 3456
#define XB_SPIN_CAP (1u << 18)

__device__ __forceinline__ unsigned xb_ld(unsigned* p)              { return __hip_atomic_load(p, __ATOMIC_RELAXED, __HIP_MEMORY_SCOPE_AGENT); }
__device__ __forceinline__ unsigned xb_add(unsigned* p, unsigned v) { return __hip_atomic_fetch_add(p, v, __ATOMIC_RELAXED, __HIP_MEMORY_SCOPE_AGENT); }
__device__ __forceinline__ unsigned xb_xcc_id() { return (unsigned)__builtin_amdgcn_s_getreg((3 << 11) | 20) & 0xFu; }
#define XB_SPIN(cond, bar) do { unsigned _sp = 0; while (cond) { __builtin_amdgcn_s_sleep(1); \
    if ((++_sp & 255u) == 0u) { if (xb_ld(&(bar)[XB_TMO])) break; if (_sp > XB_SPIN_CAP) { atomicAdd(&(bar)[XB_TMO], 1u); break; } } } } while (0)

struct XcdBarrier {
    unsigned* bar; unsigned x;
    volatile LAS unsigned* st;
};

__device__ __forceinline__ XcdBarrier xcd_barrier_post(unsigned* bar, volatile LAS unsigned* st, bool is_t0) {
    XcdBarrier b; b.bar = bar; b.x = xb_xcc_id(); b.st = st;
    if (is_t0) (void)xb_add(&bar[XB_XCNT(b.x)], 1u);
    return b;
}
__device__ __forceinline__ void xcd_barrier_complete(unsigned* bar, unsigned x, unsigned& nloc, unsigned& nx) {
    const unsigned G = gridDim.x * gridDim.y * gridDim.z;
    unsigned sum, cnt, mine, sp = 0u;
    for (;;) {
        sum = 0u; cnt = 0u; mine = 0u;
#pragma unroll
        for (unsigned j = 0; j < 16; ++j) { const unsigned c = xb_ld(&bar[XB_XCNT(j)]); sum += c; cnt += (c > 0u) ? 1u : 0u; mine = (j == x) ? c : mine; }
        if (sum == G) break;
        __builtin_amdgcn_s_sleep(1);
        if ((++sp & 255u) == 0u) { if (xb_ld(&bar[XB_TMO])) break; if (sp > XB_SPIN_CAP) { atomicAdd(&bar[XB_TMO], 1u); break; } }
    }
    nloc = mine > 0u ? mine : 1u; nx = cnt > 0u ? cnt : 1u;
}

__device__ __forceinline__ void xcd_barrier(const XcdBarrier& b, bool is_t0) {
    asm volatile("s_waitcnt vmcnt(0)" ::: "memory");
    __syncthreads();
    if (is_t0) {
        unsigned* bar = b.bar;
        __builtin_amdgcn_s_waitcnt(0);
        unsigned nloc = b.st[0], nx = b.st[1];
        if (nloc == 0u) { xcd_barrier_complete(bar, b.x, nloc, nx); b.st[0] = nloc; b.st[1] = nx; }
        const unsigned old = xb_add(&bar[XB_XSUB(b.x)], 1u);
        const unsigned gen = old / nloc;
        if (old + 1u == (gen + 1u) * nloc) {
            __builtin_amdgcn_fence(__ATOMIC_RELEASE, "agent");
            asm volatile("s_waitcnt vmcnt(0)" ::: "memory");
            const unsigned og = xb_add(&bar[XB_TOP], 1u);
            const unsigned tg = og / nx;
            if (og + 1u == (tg + 1u) * nx) xb_add(&bar[XB_TOPGEN], 1u);
            else XB_SPIN(xb_ld(&bar[XB_TOPGEN]) == tg, bar);
            __builtin_amdgcn_fence(__ATOMIC_ACQUIRE, "agent");
            xb_add(&bar[XB_XGEN(b.x)], 1u);
            asm volatile("s_waitcnt vmcnt(0)" ::: "memory");
        } else {
            XB_SPIN(xb_ld(&bar[XB_XGEN(b.x)]) == gen, bar);
            __builtin_amdgcn_fence(__ATOMIC_ACQUIRE, "agent");
            asm volatile("s_waitcnt vmcnt(0)" ::: "memory");
        }
    }
    __syncthreads();
}

namespace att {
constexpr int SLOTB = 8192;
constexpr int L_K = 0, L_V = 2 * SLOTB, L_WS = 4 * SLOTB, L_OST = L_WS + 8 * 256, L_RPB = L_OST + 8 * 4096, L_END = L_RPB + 2048;
constexpr float THR = 8.0f;
__device__ __forceinline__ int crow(int r, int hi) { return (r & 3) + 8 * (r >> 2) + 4 * hi; }
__device__ __forceinline__ s16x4 vtr(const LAS unsigned char* p) { return __builtin_bit_cast(s16x4, __builtin_amdgcn_ds_read_tr16_b64_v4i16((LAS v4i16_t*)p)); }
__device__ __forceinline__ float rowmax32(const f32x16& p0, const f32x16& p1) {
    float a = fmaxf(p0[0], p1[0]);
#pragma unroll
    for (int r = 1; r < 16; ++r) a = fmaxf(a, fmaxf(p0[r], p1[r]));
    auto rr = __builtin_amdgcn_permlane32_swap(__float_as_uint(a), __float_as_uint(a), false, false);
    return fmaxf(__uint_as_float(rr[0]), __uint_as_float(rr[1]));
}
__device__ __forceinline__ float halfsum(float v) {
    auto rr = __builtin_amdgcn_permlane32_swap(__float_as_uint(v), __float_as_uint(v), false, false);
    return __uint_as_float(rr[0]) + __uint_as_float(rr[1]);
}
#define ATT_WAIT_BAR() asm volatile("s_waitcnt vmcnt(0) lgkmcnt(0)\n\ts_barrier" ::: "memory")

template <int MODE>
__device__ __forceinline__ void attn_unit(Frame& F, int b, int h, int qb, int qcol, int kcol, int vcol, int ycol, float sink2, const float* rpb) {
    LAS unsigned char* lds = F.lds;
    const int lane = F.lane, r32 = lane & 31, hi = lane >> 5, wid = F.wave;
    const bf16_t* PROJ = (const bf16_t*)(F.ws + WS_PROJ); bf16_t* Y = (bf16_t*)(F.ws + WS_H);
    const int ctxrow = NLAT + CTXL * b, latrow = SEQ * b;
    const int qrow0 = (MODE == 3) ? ctxrow : latrow + 256 * qb;
    const int qw0 = 256 * qb + 32 * wid;
    int lt_lo = 0, nloc = 0;
    if (MODE == 0) { lt_lo = 0; nloc = 128; }
    if (MODE == 1) { const int a = (256 * qb - 128) >> 6, e = (256 * qb + 255 + 128) >> 6; lt_lo = a < 0 ? 0 : a; nloc = (e > 127 ? 127 : e) - lt_lo + 1; }
    if (MODE == 2) { const int a = 4 * qb - 4, e0 = 4 * qb - 1; lt_lo = a < 0 ? 0 : (a > 120 ? 120 : a); const int e = (e0 < 0 ? 0 : (e0 > 120 ? 120 : e0)) + 7; nloc = e - lt_lo + 1; }
    const int NT = 4 + nloc;
    const int rw = 4 * qb + (wid >> 1); const int rs = rw - 4 < 0 ? 0 : (rw - 4 > 120 ? 120 : rw - 4);
    const int qc = 32 * (wid & 1) + r32; const int cs = qc - 8 < 0 ? 0 : (qc - 8 > 48 ? 48 : qc - 8);
    LAS float* wsf = (LAS float*)(lds + L_WS) + wid * 64;
    LAS float* rpbL = (LAS float*)(lds + L_RPB);
    if (MODE == 2) { for (int i = F.tid; i < 465; i += NTHREADS) rpbL[i] = rpb[i] * LOG2E; }
    const int vp0 = ((lane >> 4) & 1) * 32 + (lane & 3) * 8 + (4 * hi + ((lane & 15) >> 2)) * 64;
#define ATT_KROW(t) ((t) < 4 ? ctxrow + 64 * (t) : latrow + 64 * (lt_lo + (t) - 4))
#define ATT_DMA(t, slot) do { const int kr_ = ATT_KROW(t); \
        __builtin_amdgcn_global_load_lds((const unsigned*)(PROJ + (size_t)(kr_ + lane) * PP + kcol + wid * 8), (LAS unsigned*)(lds + L_K + (slot) * SLOTB + wid * 1024), 16, 0, 0); \
        __builtin_amdgcn_global_load_lds((const unsigned*)(PROJ + (size_t)(kr_ + 16 * (wid & 3) + (lane >> 2)) * PP + vcol + (wid >> 2) * 32 + (lane & 3) * 8), (LAS unsigned*)(lds + L_V + (slot) * SLOTB + wid * 1024), 16, 0, 0); } while (0)
    ATT_DMA(0, 0);
    bf16x8 qr[4];
#pragma unroll
    for (int d0 = 0; d0 < 4; ++d0) qr[d0] = *(const bf16x8*)(PROJ + (size_t)(qrow0 + 32 * wid + r32) * PP + qcol + d0 * 16 + hi * 8);
    float mhat = 0.f, l = 0.f; f32x16 o0 = {}, o1 = {}, negm = {};
    ATT_WAIT_BAR();
    for (int t = 0; t < NT; ++t) {
        const int slot = t & 1;
        if (t + 1 < NT) ATT_DMA(t + 1, slot ^ 1);
        bool rel = true; int kb0 = 0;
        if (MODE == 1 && t >= 4) { kb0 = 64 * (lt_lo + t - 4); rel = (kb0 + 63 >= qw0 - 128) && (kb0 <= qw0 + 31 + 128); }
        if (MODE == 2 && t >= 4) { kb0 = lt_lo + t - 4; rel = (kb0 >= rs) && (kb0 < rs + 8); }
        if (rel) {
            const LAS unsigned char* kb = lds + L_K + slot * SLOTB + hi * 1024 + r32 * 16;
            f32x16 p0 = negm, p1 = negm;
#pragma unroll
            for (int d0 = 0; d0 < 4; ++d0) {
                const bf16x8 b0 = *(const LAS bf16x8*)(kb + d0 * 2048), b1 = *(const LAS bf16x8*)(kb + d0 * 2048 + 512);
                p0 = __builtin_amdgcn_mfma_f32_32x32x16_bf16(b0, qr[d0], p0, 0, 0, 0);
                p1 = __builtin_amdgcn_mfma_f32_32x32x16_bf16(b1, qr[d0], p1, 0, 0, 0);
            }
            if (MODE == 1 && t >= 4) {
                const int dq = kb0 - (qw0 + r32);
#pragma unroll
                for (int r = 0; r < 16; ++r) { const int kc = crow(r, hi); const int d0_ = dq + kc, d1_ = d0_ + 32;
                    if (d0_ > 128 || d0_ < -128) p0[r] = -INFINITY; if (d1_ > 128 || d1_ < -128) p1[r] = -INFINITY; }
            }
            if (MODE == 2 && t >= 4) {
                const LAS float* bt = rpbL + (kb0 - rw + 7) * 31 + (15 - qc);
#pragma unroll
                for (int r = 0; r < 16; ++r) { const int kc = crow(r, hi);
                    const bool v0 = (kc >= cs) && (kc < cs + 16), v1 = (kc + 32 >= cs) && (kc + 32 < cs + 16);
                    p0[r] = v0 ? p0[r] + bt[v0 ? kc : qc] : -INFINITY; p1[r] = v1 ? p1[r] + bt[v1 ? kc + 32 : qc] : -INFINITY; }
            }
            const float rm = rowmax32(p0, p1);
            if (t == 0 || __any(rm > THR)) {
                const float dl = (t == 0) ? rm : fmaxf(rm, 0.f);
                mhat += dl;
#pragma unroll
                for (int r = 0; r < 16; ++r) { p0[r] -= dl; p1[r] -= dl; negm[r] = -mhat; }
                if (t > 0) { const float f = __builtin_amdgcn_exp2f(-dl); l *= f; if (hi == 0) wsf[r32] = f; LDS_WAIT();
#pragma unroll
                    for (int r = 0; r < 16; ++r) { const float fr_ = wsf[crow(r, hi)]; o0[r] *= fr_; o1[r] *= fr_; }
                    LDS_WAIT(); }
            }
            float ls = 0.f;
#pragma unroll
            for (int r = 0; r < 16; ++r) { p0[r] = __builtin_amdgcn_exp2f(p0[r]); p1[r] = __builtin_amdgcn_exp2f(p1[r]); ls += p0[r] + p1[r]; }
            l += ls;
            u32x4 pw[4];
#pragma unroll
            for (int k = 0; k < 4; ++k) { pw[0][k] = cvtpk(p0[2 * k], p0[2 * k + 1]); pw[1][k] = cvtpk(p0[8 + 2 * k], p0[9 + 2 * k]); pw[2][k] = cvtpk(p1[2 * k], p1[2 * k + 1]); pw[3][k] = cvtpk(p1[8 + 2 * k], p1[9 + 2 * k]); }
            const LAS unsigned char* vb = lds + L_V + slot * SLOTB + vp0;
#pragma unroll
            for (int ks = 0; ks < 4; ++ks) {
                const s16x4 a0 = vtr(vb + ks * 1024), a1 = vtr(vb + ks * 1024 + 512), c0 = vtr(vb + 4096 + ks * 1024), c1 = vtr(vb + 4096 + ks * 1024 + 512);
                const bf16x8 v0 = {a0[0], a0[1], a0[2], a0[3], a1[0], a1[1], a1[2], a1[3]}, v1 = {c0[0], c0[1], c0[2], c0[3], c1[0], c1[1], c1[2], c1[3]};
                o0 = __builtin_amdgcn_mfma_f32_32x32x16_bf16(__builtin_bit_cast(bf16x8, pw[ks]), v0, o0, 0, 0, 0);
                o1 = __builtin_amdgcn_mfma_f32_32x32x16_bf16(__builtin_bit_cast(bf16x8, pw[ks]), v1, o1, 0, 0, 0);
            }
        }
        ATT_WAIT_BAR();
    }
    l = halfsum(l);
    if (MODE == 1 || MODE == 3) l += __builtin_amdgcn_exp2f(sink2 - mhat);
    if (hi == 0) wsf[32 + r32] = l;
    LDS_WAIT();
    bf16_t* stg = (bf16_t*)(lds + L_OST + wid * 4096);
    LAS bf16_t* stgl = (LAS bf16_t*)(lds + L_OST + wid * 4096);
#pragma unroll
    for (int r = 0; r < 16; ++r) { const int orow = crow(r, hi); const float rl = __builtin_amdgcn_rcpf(wsf[32 + orow]);
        stgl[orow * 64 + r32] = (bf16_t)(cvtpk(o0[r] * rl, 0.f) & 0xffffu); stgl[orow * 64 + 32 + r32] = (bf16_t)(cvtpk(o1[r] * rl, 0.f) & 0xffffu); }
    LDS_WAIT();
    (void)stg;
#pragma unroll
    for (int i = 0; i < 4; ++i) { const int row = i * 8 + (lane >> 3), ch = lane & 7; const u32x4 v = *(const LAS u32x4*)(stgl + row * 64 + ch * 8);
        *(u32x4*)(Y + (size_t)(qrow0 + 32 * wid + row) * DM + ycol + ch * 8) = v; }
    LDS_WAIT();
#undef ATT_KROW
#undef ATT_DMA
}
}

namespace ml {
__device__ __forceinline__ float scan_add(float v, int lane, int dir) {
#pragma unroll
    for (int o = 1; o < 64; o <<= 1) { const float t = shfl_idx(v, (dir ? lane + o : lane - o) & 63); const bool ok = dir ? (lane + o < 64) : (lane >= o); v += ok ? t : 0.f; }
    return v;
}
__device__ __forceinline__ float scan_max(float v, int lane, int dir) {
#pragma unroll
    for (int o = 1; o < 64; o <<= 1) { const float t = shfl_idx(v, (dir ? lane + o : lane - o) & 63); const bool ok = dir ? (lane + o < 64) : (lane >= o); v = ok ? fmaxf(v, t) : v; }
    return v;
}
__device__ __forceinline__ float logsigmoid(float x) { return fminf(x, 0.f) - log1pf(__expf(-fabsf(x))); }
__device__ __forceinline__ int img_off(int tok, int d) { return (d >> 5) * 4096 + (tok >> 4) * 1024 + (tok & 15) * 64 + (d & 31) * 2; }
__device__ __forceinline__ int blk_row0(int b, int blk) { return blk < 4 ? NLAT + CTXL * b + 64 * blk : SEQ * b + 64 * (blk - 4); }
__device__ __forceinline__ int chunk_of(int dir, int blk) { return dir == 0 ? blk : (blk < 4 ? 3 - blk : 4 + 127 - (blk - 4)); }

__device__ __forceinline__ void pass1(Frame& F, int layer) {
    const int gw = F.bid * NWAVES + F.wave, NGW = F.G * NWAVES, lane = F.lane, r32 = lane & 31, hi = lane >> 5;
    LAS unsigned char* wl = F.lds + F.wave * 16384;
    const bf16_t* PROJ = (const bf16_t*)(F.ws + WS_PROJ); const float* GATES = (const float*)(F.ws + WS_GATES);
    const float* gb = F.ka->in[IN_CGB] + layer * 16;
    float* DS = (float*)(F.ws + WS_DS); float* ZD = (float*)(F.ws + WS_ZD); float* GC = (float*)(F.ws + WS_GC); float* ML = (float*)(F.ws + WS_ML);
    const int vp0 = ((lane >> 4) & 1) * 32 + (lane & 3) * 8 + (4 * hi + ((lane & 15) >> 2)) * 64;
    for (int wu = gw; wu < NCHAIN * NCHUNK; wu += NGW) {
        const int chain = wu / NCHUNK, c = wu % NCHUNK, dir = chain & 1, h = (chain >> 1) & 3, b = chain >> 3;
        const int row0 = blk_row0(b, chunk_of(dir, c));
        const float gi = GATES[(size_t)(row0 + lane) * 16 + dir * 8 + h] + gb[dir * 8 + h];
        const float lf = logsigmoid(GATES[(size_t)(row0 + lane) * 16 + dir * 8 + 4 + h] + gb[dir * 8 + 4 + h]);
        const float cum = scan_add(lf, lane, dir);
        const float G = wave_sum(lf, lane);
        const float bb = gi - cum, mloc = wave_max(bb, lane), w = __expf(bb - mloc);
#pragma unroll
        for (int it = 0; it < 8; ++it) { const int tok = (lane >> 3) + 8 * it, d = 8 * (lane & 7);
            const u32x4 kv = *(const u32x4*)(PROJ + (size_t)(row0 + tok) * PP + PC_CK + 64 * h + d), vv = *(const u32x4*)(PROJ + (size_t)(row0 + tok) * PP + PC_CV + 64 * h + d);
            const float wt = shfl_idx(w, tok);
            u32x4 ko; ko.x = cvtpk(bflo(kv.x) * wt, bfhi(kv.x) * wt); ko.y = cvtpk(bflo(kv.y) * wt, bfhi(kv.y) * wt); ko.z = cvtpk(bflo(kv.z) * wt, bfhi(kv.z) * wt); ko.w = cvtpk(bflo(kv.w) * wt, bfhi(kv.w) * wt);
            *(LAS u32x4*)(wl + img_off(tok, d)) = vv; *(LAS u32x4*)(wl + 8192 + img_off(tok, d)) = ko; }
        LDS_WAIT();
        f32x16 acc[2][2] = {};
#pragma unroll
        for (int s = 0; s < 4; ++s) {
            bf16x8 af[2], bfr[2];
#pragma unroll
            for (int x = 0; x < 2; ++x) { const s16x4 a0 = att::vtr(wl + vp0 + x * 4096 + s * 1024), a1 = att::vtr(wl + vp0 + x * 4096 + s * 1024 + 512);
                const s16x4 c0 = att::vtr(wl + 8192 + vp0 + x * 4096 + s * 1024), c1 = att::vtr(wl + 8192 + vp0 + x * 4096 + s * 1024 + 512);
                af[x] = (bf16x8){a0[0], a0[1], a0[2], a0[3], a1[0], a1[1], a1[2], a1[3]}; bfr[x] = (bf16x8){c0[0], c0[1], c0[2], c0[3], c1[0], c1[1], c1[2], c1[3]}; }
#pragma unroll
            for (int vb = 0; vb < 2; ++vb)
#pragma unroll
                for (int kb = 0; kb < 2; ++kb) acc[vb][kb] = __builtin_amdgcn_mfma_f32_32x32x16_bf16(af[vb], bfr[kb], acc[vb][kb], 0, 0, 0);
        }
        float* dsp = DS + (size_t)(chain * NCHUNK + c) * 4096;
#pragma unroll
        for (int vb = 0; vb < 2; ++vb)
#pragma unroll
            for (int kb = 0; kb < 2; ++kb)
#pragma unroll
                for (int r = 0; r < 16; ++r) dsp[(32 * vb + att::crow(r, hi)) * 64 + 32 * kb + r32] = acc[vb][kb][r];
        float z = 0.f;
#pragma unroll 8
        for (int tok = 0; tok < 64; ++tok) z += bf2f(*(const LAS bf16_t*)(wl + 8192 + img_off(tok, lane)));
        ZD[(size_t)(chain * NCHUNK + c) * 64 + lane] = z;
        if (lane == 0) { GC[chain * NCHUNK + c] = G; ML[chain * NCHUNK + c] = mloc; }
        LDS_WAIT();
    }
}

__device__ __forceinline__ void pass2(Frame& F) {
    const float* DS = (const float*)(F.ws + WS_DS); const float* ZD = (const float*)(F.ws + WS_ZD); const float* GC = (const float*)(F.ws + WS_GC); const float* ML = (const float*)(F.ws + WS_ML);
    bf16_t* SBF = (bf16_t*)(F.ws + WS_SBF); float* ZC = (float*)(F.ws + WS_ZC); float* MC = (float*)(F.ws + WS_MC);
    LAS float* cf = (LAS float*)F.lds;
    for (int it = F.bid; it < NCHAIN * 16; it += F.G) {
        const int chain = it >> 4, part = it & 15;
        __syncthreads();
        if (F.wave == 0) {
            const int ln = F.lane; const bool valid = ln < 44; float g[3], mlv[3];
#pragma unroll
            for (int j = 0; j < 3; ++j) { g[j] = valid ? GC[chain * NCHUNK + 3 * ln + j] : 0.f; mlv[j] = valid ? ML[chain * NCHUNK + 3 * ln + j] : -INFINITY; }
            const float tot = g[0] + g[1] + g[2]; const float excl = ml::scan_add(tot, ln, 0) - tot;
            const float pg[3] = {excl, excl + g[0], excl + g[0] + g[1]};
            const float a0 = mlv[0] - pg[0], a1 = mlv[1] - pg[1], a2 = mlv[2] - pg[2];
            const float inclm = ml::scan_max(fmaxf(a0, fmaxf(a1, a2)), ln, 0); float exclm = shfl_idx(inclm, (ln - 1) & 63); if (ln == 0) exclm = -INFINITY;
            const float em[3] = {exclm, fmaxf(exclm, a0), fmaxf(fmaxf(exclm, a0), a1)};
#pragma unroll
            for (int j = 0; j < 3; ++j) { const int c = 3 * ln + j; const float m = pg[j] + fmaxf(0.f, em[j]); const float mn = fmaxf(g[j] + m, g[j] + mlv[j]);
                if (valid) { cf[2 * c] = __expf(g[j] + m - mn); cf[2 * c + 1] = __expf(g[j] + mlv[j] - mn); if (part == 0) MC[chain * NCHUNK + c] = m; } }
        }
        __syncthreads();
        if (F.tid < 256) {
            const int e = part * 256 + F.tid; const float* dp = DS + (size_t)chain * NCHUNK * 4096 + e; bf16_t* sp = SBF + (size_t)chain * NCHUNK * 4096 + e;
            float s = 0.f;
            for (int c0 = 0; c0 < NCHUNK; c0 += 66) { float d[66];
#pragma unroll
                for (int j = 0; j < 66; ++j) d[j] = dp[(size_t)(c0 + j) * 4096];
#pragma unroll
                for (int j = 0; j < 66; ++j) { sp[(size_t)(c0 + j) * 4096] = (bf16_t)(cvtpk(s, 0.f) & 0xffffu); s = cf[2 * (c0 + j)] * s + cf[2 * (c0 + j) + 1] * d[j]; } }
        } else if (F.tid < 260) {
            const int e = part * 4 + (F.tid - 256); const float* dp = ZD + (size_t)chain * NCHUNK * 64 + e; float* zp = ZC + (size_t)chain * NCHUNK * 64 + e;
            float s = 0.f;
            for (int c = 0; c < NCHUNK; ++c) { const float d = dp[(size_t)c * 64]; zp[(size_t)c * 64] = s; s = cf[2 * c] * s + cf[2 * c + 1] * d; }
        }
    }
    __syncthreads();
}

__device__ __forceinline__ void pass3(Frame& F, int layer, int blk_lo) {
    const int gw = F.bid * NWAVES + F.wave, NGW = F.G * NWAVES, lane = F.lane, r32_ = lane & 31, hi_ = lane >> 5;
    LAS unsigned char* wl = F.lds + F.wave * 19456;
    LAS float* bvec = (LAS float*)(wl + 16384); LAS float* Apl = bvec + 128; LAS float* efl = bvec + 256; LAS float* fll = bvec + 384; LAS float* zl = bvec + 512; LAS float* rden = bvec + 640;
    LAS float* st = (LAS float*)(wl + 8192);
    const bf16_t* PROJ = (const bf16_t*)(F.ws + WS_PROJ); const float* GATES = (const float*)(F.ws + WS_GATES);
    const float* gb = F.ka->in[IN_CGB] + layer * 16;
    const bf16_t* SBF = (const bf16_t*)(F.ws + WS_SBF); const float* ZC = (const float*)(F.ws + WS_ZC); const float* MC = (const float*)(F.ws + WS_MC);
    bf16_t* Y = (bf16_t*)(F.ws + WS_H);
    const int vp0 = ((lane >> 4) & 1) * 32 + (lane & 3) * 8 + (4 * hi_ + ((lane & 15) >> 2)) * 64;
    const int nblk = NCHUNK - blk_lo;
    for (int wu2 = gw; wu2 < 16 * nblk; wu2 += NGW) {
        const int wu = wu2 >> 1, tbsel = wu2 & 1;
        const int bh = wu / nblk, blk = blk_lo + wu % nblk, b = bh >> 2, h = bh & 3;
        const int row0 = blk_row0(b, blk);
        LDS_WAIT();
#pragma unroll
        for (int it = 0; it < 8; ++it) { const int tok = (lane >> 3) + 8 * it, d = 8 * (lane & 7);
            *(LAS u32x4*)(wl + img_off(tok, d)) = *(const u32x4*)(PROJ + (size_t)(row0 + tok) * PP + PC_CV + 64 * h + d); }
#pragma unroll
        for (int dir = 0; dir < 2; ++dir) {
            const int c = chunk_of(dir, blk), chain = (b * 4 + h) * 2 + dir;
            const float gi = GATES[(size_t)(row0 + lane) * 16 + dir * 8 + h] + gb[dir * 8 + h];
            const float lf = logsigmoid(GATES[(size_t)(row0 + lane) * 16 + dir * 8 + 4 + h] + gb[dir * 8 + 4 + h]);
            const float cum = scan_add(lf, lane, dir);
            const float bb = gi - cum, pm = scan_max(bb, lane, dir), mc = MC[chain * NCHUNK + c];
            const float Apv = fmaxf(mc, pm);
            zl[dir * 64 + lane] = ZC[(size_t)(chain * NCHUNK + c) * 64 + lane];
            bvec[dir * 64 + lane] = bb; Apl[dir * 64 + lane] = Apv; efl[dir * 64 + lane] = __expf(mc - Apv); fll[dir * 64 + lane] = __expf(-(cum + Apv));
        }
        LDS_WAIT();
#pragma unroll 1
        for (int tb = tbsel; tb <= tbsel; ++tb) {
            int r32 = r32_, hi = hi_; asm volatile("" : "+v"(r32), "+v"(hi));
            const int t = 32 * tb + r32;
            bf16x8 qf[4];
#pragma unroll
            for (int d0 = 0; d0 < 4; ++d0) qf[d0] = *(const bf16x8*)(PROJ + (size_t)(row0 + t) * PP + PC_CQ + 64 * h + 16 * d0 + 8 * hi);
            f32x16 hs0 = {}, hs1 = {};
#pragma unroll 1
            for (int dir = 0; dir < 2; ++dir) {
                const int c = chunk_of(dir, blk), chain = (b * 4 + h) * 2 + dir;
                const bf16_t* Sp = SBF + (size_t)(chain * NCHUNK + c) * 4096; const LAS float* zp = zl + dir * 64;
                int r32 = r32_, hi = hi_; asm volatile("" : "+v"(r32), "+v"(hi));
                const float Ap_t = Apl[dir * 64 + t], e_t = efl[dir * 64 + t], fl_t = fll[dir * 64 + t];
                f32x16 P0 = {}, P1 = {};
#pragma unroll
                for (int d0 = 0; d0 < 4; ++d0) {
                    const bf16x8 k0 = *(const bf16x8*)(PROJ + (size_t)(row0 + r32) * PP + PC_CK + 64 * h + 16 * d0 + 8 * hi), k1 = *(const bf16x8*)(PROJ + (size_t)(row0 + 32 + r32) * PP + PC_CK + 64 * h + 16 * d0 + 8 * hi);
                    P0 = __builtin_amdgcn_mfma_f32_32x32x16_bf16(k0, qf[d0], P0, 0, 0, 0); P1 = __builtin_amdgcn_mfma_f32_32x32x16_bf16(k1, qf[d0], P1, 0, 0, 0); }
                float den = 0.f;
#pragma unroll
                for (int r = 0; r < 16; ++r) { const int s0 = att::crow(r, hi), s1 = 32 + s0; const bool ok0 = dir ? (s0 >= t) : (s0 <= t), ok1 = dir ? (s1 >= t) : (s1 <= t);
                    const float w0 = ok0 ? __expf(bvec[dir * 64 + s0] - Ap_t) : 0.f, w1 = ok1 ? __expf(bvec[dir * 64 + s1] - Ap_t) : 0.f;
                    P0[r] *= w0; P1[r] *= w1; den += P0[r] + P1[r]; }
                u32x4 pw[4];
#pragma unroll
                for (int k = 0; k < 4; ++k) { pw[0][k] = cvtpk(P0[2 * k], P0[2 * k + 1]); pw[1][k] = cvtpk(P0[8 + 2 * k], P0[9 + 2 * k]); pw[2][k] = cvtpk(P1[2 * k], P1[2 * k + 1]); pw[3][k] = cvtpk(P1[8 + 2 * k], P1[9 + 2 * k]); }

                f32x16 n0 = {}, n1 = {}; float zq = 0.f;
#pragma unroll
                for (int d0 = 0; d0 < 4; ++d0) { const u32x4 qw = __builtin_bit_cast(u32x4, qf[d0]); u32x4 o;
                    const f32x4 za = *(const LAS f32x4*)(zp + 16 * d0 + 8 * hi), zb = *(const LAS f32x4*)(zp + 16 * d0 + 8 * hi + 4);
                    const float q0 = bflo(qw.x), q1 = bfhi(qw.x), q2 = bflo(qw.y), q3 = bfhi(qw.y), q4 = bflo(qw.z), q5 = bfhi(qw.z), q6 = bflo(qw.w), q7 = bfhi(qw.w);
                    zq += (q0 * za[0] + q1 * za[1]) + (q2 * za[2] + q3 * za[3]) + (q4 * zb[0] + q5 * zb[1]) + (q6 * zb[2] + q7 * zb[3]);
                    o.x = cvtpk(q0 * e_t, q1 * e_t); o.y = cvtpk(q2 * e_t, q3 * e_t); o.z = cvtpk(q4 * e_t, q5 * e_t); o.w = cvtpk(q6 * e_t, q7 * e_t);
                    const bf16x8 qs = __builtin_bit_cast(bf16x8, o);
                    const bf16x8 s0 = *(const bf16x8*)(Sp + (size_t)r32 * 64 + 16 * d0 + 8 * hi), s1 = *(const bf16x8*)(Sp + (size_t)(32 + r32) * 64 + 16 * d0 + 8 * hi);
                    n0 = __builtin_amdgcn_mfma_f32_32x32x16_bf16(qs, s0, n0, 0, 0, 0); n1 = __builtin_amdgcn_mfma_f32_32x32x16_bf16(qs, s1, n1, 0, 0, 0); }

                den = att::halfsum(den) + e_t * att::halfsum(zq);
                const float rd = 1.f / fmaxf(fabsf(den), fl_t);
                LDS_WAIT(); if (hi == 0) rden[r32] = rd; LDS_WAIT();
#pragma unroll
                for (int ks = 0; ks < 4; ++ks) {
                    const s16x4 a0 = att::vtr(wl + vp0 + ks * 1024), a1 = att::vtr(wl + vp0 + ks * 1024 + 512), c0 = att::vtr(wl + vp0 + 4096 + ks * 1024), c1 = att::vtr(wl + vp0 + 4096 + ks * 1024 + 512);
                    const bf16x8 v0 = {a0[0], a0[1], a0[2], a0[3], a1[0], a1[1], a1[2], a1[3]}, v1 = {c0[0], c0[1], c0[2], c0[3], c1[0], c1[1], c1[2], c1[3]};
                    n0 = __builtin_amdgcn_mfma_f32_32x32x16_bf16(__builtin_bit_cast(bf16x8, pw[ks]), v0, n0, 0, 0, 0);
                    n1 = __builtin_amdgcn_mfma_f32_32x32x16_bf16(__builtin_bit_cast(bf16x8, pw[ks]), v1, n1, 0, 0, 0); }
#pragma unroll
                for (int r = 0; r < 16; ++r) { const float rr = rden[att::crow(r, hi)]; hs0[r] += n0[r] * rr; hs1[r] += n1[r] * rr; }
            }
            LDS_WAIT();
#pragma unroll
            for (int r = 0; r < 16; ++r) { st[att::crow(r, hi) * 64 + r32] = hs0[r]; st[att::crow(r, hi) * 64 + 32 + r32] = hs1[r]; }
            LDS_WAIT();
#pragma unroll
            for (int it = 0; it < 4; ++it) { const int tk = (lane >> 3) + 8 * it, d = 8 * (lane & 7);
                const u32x4 ow = *(const u32x4*)(PROJ + (size_t)(row0 + 32 * tb + tk) * PP + PC_CO + 64 * h + d);
                const f32x4 ha = *(const LAS f32x4*)(st + tk * 64 + d), hb = *(const LAS f32x4*)(st + tk * 64 + d + 4);
                const float og[8] = {bflo(ow.x), bfhi(ow.x), bflo(ow.y), bfhi(ow.y), bflo(ow.z), bfhi(ow.z), bflo(ow.w), bfhi(ow.w)};
                float yv[8];
#pragma unroll
                for (int j = 0; j < 8; ++j) yv[j] = (j < 4 ? ha[j] : hb[j - 4]) / (1.f + __expf(-og[j]));
                u32x4 w; w.x = cvtpk(yv[0], yv[1]); w.y = cvtpk(yv[2], yv[3]); w.z = cvtpk(yv[4], yv[5]); w.w = cvtpk(yv[6], yv[7]);
                *(u32x4*)(Y + (size_t)(row0 + 32 * tb + tk) * DM + 512 + 64 * h + d) = w; }
            LDS_WAIT();
        }
    }
}
}

namespace attp {
typedef __attribute__((address_space(3))) const char* lds_cptr;
#define SBAR() __builtin_amdgcn_sched_barrier(0)
__device__ __forceinline__ int crow(int r,int hi){return (r&3)+8*(r>>2)+4*hi;}
constexpr int NSLOT=3, SLOTB=8192;
constexpr int NW=8, QBLK=32, KVBLK=64; constexpr int LDS_K=0, LDS_V=NSLOT*SLOTB, LDS_WS=2*NSLOT*SLOTB, LDS_OST=LDS_WS+NW*64*4, LDS_BYTES=LDS_OST+NW*4096;
__device__ __forceinline__ void glds16(const void*gsrc,unsigned lds_dst){unsigned keep;
  asm volatile("s_mov_b32 %0, m0\n\ts_mov_b32 m0, %2\n\ts_nop 0\n\tglobal_load_lds_dwordx4 %1, off\n\ts_mov_b32 m0, %0":"=&s"(keep):"v"(gsrc),"s"(lds_dst):"memory");}
__device__ __forceinline__ float max3f(float a,float b,float c){float r;asm("v_max3_f32 %0, %1, %2, %3":"=v"(r):"v"(a),"v"(b),"v"(c));return r;}
__device__ __forceinline__ float max2f(float a,float b){float r;asm("v_max_f32_e32 %0, %1, %2":"=v"(r):"v"(a),"v"(b));return r;}
__device__ __forceinline__ float fadd_s(float a,float b){float r;asm("v_add_f32_e32 %0, %1, %2":"=v"(r):"v"(a),"v"(b));return r;}
__device__ __forceinline__ float fsub_s(float a,float b){float r;asm("v_sub_f32_e32 %0, %1, %2":"=v"(r):"v"(a),"v"(b));return r;}
__device__ __forceinline__ unsigned cvtpk_s(float lo,float hi){return cvtpk(lo,hi);}
#define WAIT_BAR(N) asm volatile("s_waitcnt vmcnt(" #N ") lgkmcnt(0)\n\ts_barrier":::"memory")

template<bool ZC> __device__ __forceinline__ void qkt(f32x16&p0,f32x16&p1,lds_cptr Kslot,const bf16x8*qr,const f32x16&negm,int r32,int hi){
  lds_cptr kb=Kslot+hi*1024+r32*16;
  #pragma unroll
  for(int d0=0;d0<4;++d0){
    const bf16x8 b0=*(const __attribute__((address_space(3))) bf16x8*)(kb+d0*2048);
    const bf16x8 b1=*(const __attribute__((address_space(3))) bf16x8*)(kb+d0*2048+512);
    if(d0==0){ if(ZC){p0=__builtin_amdgcn_mfma_f32_32x32x16_bf16(b0,qr[0],(f32x16){},0,0,0);p1=__builtin_amdgcn_mfma_f32_32x32x16_bf16(b1,qr[0],(f32x16){},0,0,0);} else {p0=__builtin_amdgcn_mfma_f32_32x32x16_bf16(b0,qr[0],negm,0,0,0);p1=__builtin_amdgcn_mfma_f32_32x32x16_bf16(b1,qr[0],negm,0,0,0);} }
    else{p0=__builtin_amdgcn_mfma_f32_32x32x16_bf16(b0,qr[d0],p0,0,0,0);p1=__builtin_amdgcn_mfma_f32_32x32x16_bf16(b1,qr[d0],p1,0,0,0);}}
}
__device__ __forceinline__ void kload8(bf16x8*kf,lds_cptr kp){
  kf[0]=*(const __attribute__((address_space(3))) bf16x8*)(kp);      kf[1]=*(const __attribute__((address_space(3))) bf16x8*)(kp+512);
  kf[2]=*(const __attribute__((address_space(3))) bf16x8*)(kp+2048); kf[3]=*(const __attribute__((address_space(3))) bf16x8*)(kp+2560);
  kf[4]=*(const __attribute__((address_space(3))) bf16x8*)(kp+4096); kf[5]=*(const __attribute__((address_space(3))) bf16x8*)(kp+4608);
  kf[6]=*(const __attribute__((address_space(3))) bf16x8*)(kp+6144); kf[7]=*(const __attribute__((address_space(3))) bf16x8*)(kp+6656);
}
__device__ __forceinline__ void kload2(bf16x8*kf,lds_cptr kp,int j){ kf[2*j]=*(const __attribute__((address_space(3))) bf16x8*)(kp+j*2048); kf[2*j+1]=*(const __attribute__((address_space(3))) bf16x8*)(kp+j*2048+512); }
__device__ __forceinline__ s16x4 vtr(lds_cptr p){ return __builtin_bit_cast(s16x4,__builtin_amdgcn_ds_read_tr16_b64_v4i16((__attribute__((address_space(3))) v4i16_t*)p)); }
__device__ __forceinline__ float rowmax(const f32x16&p0,const f32x16&p1){
  float a=max3f(p0[0],p0[1],p1[0]),b=max3f(p0[2],p0[3],p1[1]);a=max3f(a,p1[2],p1[3]);
  #pragma unroll
  for(int r=4;r<16;r+=4){a=max3f(a,p0[r],p0[r+1]);b=max3f(b,p0[r+2],p0[r+3]);a=max3f(a,p1[r],p1[r+1]);b=max3f(b,p1[r+2],p1[r+3]);}
  const float m=max2f(a,b);
  auto rr=__builtin_amdgcn_permlane32_swap(__float_as_uint(m),__float_as_uint(m),false,false);
  return max2f(__uint_as_float(rr[0]),__uint_as_float(rr[1]));
}
__device__ __forceinline__ void pv(f32x16*o,int vb,bf16x8 pa0,bf16x8 pa1,bf16x8 pa2,bf16x8 pa3){
  #pragma unroll
  for(int d0=0;d0<2;++d0){s16x4 lo[4],hi[4];
    #pragma unroll
    for(int ks=0;ks<4;++ks){
      asm volatile("ds_read_b64_tr_b16 %0,%1 offset:%c2":"=&v"(lo[ks]):"v"(vb),"i"(d0*4096+ks*1024):"memory");
      asm volatile("ds_read_b64_tr_b16 %0,%1 offset:%c2":"=&v"(hi[ks]):"v"(vb),"i"(d0*4096+ks*1024+512):"memory");}
    asm volatile("s_waitcnt lgkmcnt(0)":::"memory");SBAR();
    #define PK(k) (bf16x8){lo[k][0],lo[k][1],lo[k][2],lo[k][3],hi[k][0],hi[k][1],hi[k][2],hi[k][3]}
    o[d0]=__builtin_amdgcn_mfma_f32_32x32x16_bf16(pa0,PK(0),o[d0],0,0,0);
    o[d0]=__builtin_amdgcn_mfma_f32_32x32x16_bf16(pa1,PK(1),o[d0],0,0,0);
    o[d0]=__builtin_amdgcn_mfma_f32_32x32x16_bf16(pa2,PK(2),o[d0],0,0,0);
    o[d0]=__builtin_amdgcn_mfma_f32_32x32x16_bf16(pa3,PK(3),o[d0],0,0,0);
    #undef PK
  }
}


template<int THRL,int MODE> __device__ __forceinline__ void attn_unit_pipe(Frame& F,int b,int h,int qb,int qcol,int kcol,int vcol,int ycol,float sink2,const float*rpb){
  constexpr bool NOMAX=(MODE==0), USE_NEGM=false;
  int lane_=F.lane; asm volatile("":"+v"(lane_));
  const int lane=lane_,r32=lane&31,hi=lane>>5; const int wid=F.wave; (void)h;
  const bf16_t*PROJ=(const bf16_t*)(F.ws+WS_PROJ); bf16_t*Yb=(bf16_t*)(F.ws+WS_H);
  const int ctxrow=NLAT+CTXL*b,latrow=SEQ*b; LAS unsigned char*shm=F.lds;
  const int qrow0=(MODE==3)?ctxrow:latrow+256*qb;
  int lt_lo=0,nloc=0;
  if(MODE==0){nloc=128;}
  if(MODE==1){const int a_=(256*qb-128)>>6,e_=(256*qb+255+128)>>6; lt_lo=a_<0?0:a_; nloc=(e_>127?127:e_)-lt_lo+1;}
  if(MODE==2){const int a_=4*qb-4,e0_=4*qb-1; lt_lo=a_<0?0:(a_>120?120:a_); int e_=(e0_<0?0:(e0_>120?120:e0_))+7; nloc=e_-lt_lo+1; if(nloc&1)++nloc;}
  const int qw0=256*qb+32*wid;
  const int rw=4*qb+(wid>>1); const int rs=rw-4<0?0:(rw-4>120?120:rw-4);
  const int qc=32*(wid&1)+r32; const int cs=qc-8<0?0:(qc-8>48?48:qc-8);
  LAS float*rpbL=(LAS float*)(shm+LDS_BYTES);
  if(MODE==2){ for(int i=wid*64+lane;i<465;i+=512) rpbL[i]=rpb[i]*LOG2E; }
  unsigned vm0=0u,vm1=0u;
  if(MODE==2){ _Pragma("unroll") for(int r=0;r<16;++r){ const int kc_=crow(r,hi); if(kc_>=cs&&kc_<cs+16)vm0|=1u<<r; if(kc_+32>=cs&&kc_+32<cs+16)vm1|=1u<<r; } }
  const bf16_t*Qw=PROJ+(size_t)(qrow0+wid*QBLK)*PP+qcol;
  const unsigned lds0=(unsigned)(uintptr_t)shm;
  LAS float*wsf=(LAS float*)(shm+LDS_WS)+wid*64;
  const bf16_t*ksrc=PROJ+(size_t)lane*PP+kcol+wid*8;
  const bf16_t*vsrc=PROJ+(size_t)(16*(wid&3)+(lane>>2))*PP+vcol+(wid>>2)*32+(lane&3)*8;
  #define KROW(t) ((size_t)((t)<4?ctxrow+64*(t):latrow+64*(lt_lo+(t)-4))*PP)
  const unsigned kdst=lds0+LDS_K+wid*1024, vdst=lds0+LDS_V+wid*1024;
  #define DMA_K(t,slot) glds16(ksrc+KROW(t),(unsigned)__builtin_amdgcn_readfirstlane(kdst+(slot)))
  #define DMA_V(t,slot) glds16(vsrc+KROW(t),(unsigned)__builtin_amdgcn_readfirstlane(vdst+(slot)))
  const int vb0=(int)(lds0+LDS_V)+((lane>>4)&1)*32+(lane&3)*8+(4*hi+((lane&15)>>2))*64;
  const lds_cptr Kbase=(lds_cptr)shm+LDS_K; bf16x8 kf[8];
  const lds_cptr shm3=(lds_cptr)shm; const lds_cptr kp0=shm3+LDS_K+hi*1024+r32*16; const lds_cptr vp0=shm3+LDS_V+((lane>>4)&1)*32+(lane&3)*8+(4*hi+((lane&15)>>2))*64;
  const int NT=4+nloc;
  DMA_K(0,0);DMA_V(0,0);DMA_K(1,SLOTB);
  bf16x8 qr[4];
  #pragma unroll
  for(int d0=0;d0<4;++d0)qr[d0]=*reinterpret_cast<const bf16x8*>(&Qw[(size_t)r32*PP+d0*16+hi*8]);
  float mhat=0.f,l_reg=0.f;f32x16 o[2],negm;
  { float z_=0.f; asm volatile("":"+v"(z_));
    _Pragma("unroll") for(int r=0;r<16;++r){o[0][r]=z_;o[1][r]=z_;if(USE_NEGM)negm[r]=z_;} }
  if(USE_NEGM)asm volatile("":"+v"(negm));
  #define NEGMC (USE_NEGM?negm:(f32x16){})
  #define CMASK(P0,P1,t) do{ if(MODE==1&&(t)>=4){ const int dq_=64*(lt_lo+(t)-4)-(qw0+r32); \
      _Pragma("unroll") for(int r=0;r<16;++r){ const int d0_=dq_+crow(r,hi),d1_=d0_+32; if(d0_>128||d0_<-128)P0[r]=-INFINITY; if(d1_>128||d1_<-128)P1[r]=-INFINITY; } } \
    if(MODE==2&&(t)>=4){ const int gr_=lt_lo+(t)-4; const bool rel_=(gr_>=rs)&&(gr_<rs+8); const LAS float*bt_=rpbL+(rel_?gr_-rw+7:7)*31+(15-qc)+4*hi; const unsigned m0_=rel_?vm0:0u,m1_=rel_?vm1:0u; \
      _Pragma("unroll") for(int r=0;r<16;++r){ const int kc_=(r&3)+8*(r>>2);   \
        P0[r]=((m0_>>r)&1u)?P0[r]+bt_[kc_]:-INFINITY; P1[r]=((m1_>>r)&1u)?P1[r]+bt_[kc_+32]:-INFINITY; } } }while(0)
  bool resc=false;
  #define START(P0,P1) do{ resc=false; \
    if(!NOMAX){ const float rm=rowmax(P0,P1); const float dl=rm; mhat=fadd_s(mhat,dl); \
      _Pragma("unroll") for(int r=0;r<16;++r){P0[r]=fsub_s(P0[r],dl);P1[r]=fsub_s(P1[r],dl);} \
      if(USE_NEGM){ _Pragma("unroll") for(int r=0;r<16;++r)negm[r]=-mhat; asm volatile("":"+v"(negm)); } } \
    _Pragma("unroll") for(int r=0;r<16;++r)P0[r]=__builtin_amdgcn_exp2f(P0[r]); }while(0)
  #define RESC() do{ if(resc){ asm volatile("s_waitcnt lgkmcnt(0)":::"memory"); \
      _Pragma("unroll") for(int d_=0;d_<2;++d_) _Pragma("unroll") for(int r=0;r<16;++r)o[d_][r]*=wsf[crow(r,hi)]; } }while(0)
  f32x16 pA0,pA1,pB0,pB1;
  int sl_prev=0,sl_cur=0,sl_next=SLOTB;
  #define ROT() do{sl_prev=sl_cur;sl_cur=sl_next;sl_next=(sl_next==(NSLOT-1)*SLOTB)?0:sl_next+SLOTB;}while(0)
  DMA_K(2,2*SLOTB);
  WAIT_BAR(3);
  qkt<!USE_NEGM>(pA0,pA1,Kbase,qr,negm,r32,hi);asm volatile("s_nop 15\n\ts_nop 7":"+v"(pA0),"+v"(pA1));CMASK(pA0,pA1,0);
  START(pA0,pA1);
  _Pragma("unroll") for(int r=0;r<16;++r)pA1[r]=__builtin_amdgcn_exp2f(pA1[r]);
  WAIT_BAR(0);
  DMA_K(3,0);DMA_V(1,SLOTB);
  ROT();
  kload8(kf,kp0+sl_cur);
  WAIT_BAR(2);
  s16x4 vlo[8],vhi[8]; u32x4 pw0,pw1,pw2,pw3;
  #define PKW(P,B) cvtpk_s(P[B],P[B+1])
  #define PAF(k) __builtin_bit_cast(bf16x8,pw##k)
  #define VFR(i) (bf16x8){vlo[i][0],vlo[i][1],vlo[i][2],vlo[i][3],vhi[i][0],vhi[i][1],vhi[i][2],vhi[i][3]}
  #define PIN(x) asm volatile("":"+v"(x))
  #define MX3(a,b,c) __builtin_fmaxf(__builtin_fmaxf((a),(b)),(c))
  #define GAPA(MF,A0,A1,A2,A3,W0,W1,PW) do{ MF; sacc+=A0; sacc+=A1; sacc+=A2; sacc+=A3; PIN(sacc); W0; W1; PIN(PW); SBAR(); }while(0)
  #define EX(v) __builtin_amdgcn_exp2f(v)
  #define GAPB(MF,X,B) do{ MF; X[B]=EX(X[B]); X[B+1]=EX(X[B+1]); X[B+2]=EX(X[B+2]); X[B+3]=EX(X[B+3]); PIN(X); SBAR(); }while(0)
  #define VRD(i) do{ vlo[i]=vtr(vp_+(((i)>>2)*4096+((i)&3)*1024)); vhi[i]=vtr(vp_+(((i)>>2)*4096+((i)&3)*1024+512)); }while(0)
  #define KRD(G,j) do{ if(G){ kload2(kf,kp0+sl_next,j); SBAR(); } }while(0)
  #define STEP(C0,C1,P0,P1,t,GK,GV,GL) do{ SBAR(); \
    const lds_cptr vp_=vp0+sl_prev; \
    VRD(0); SBAR(); float sacc=(P0[0]+P0[1]); \
    GAPA(C0=__builtin_amdgcn_mfma_f32_32x32x16_bf16(kf[0],qr[0],NEGMC,0,0,0), P0[2],P0[3],P0[4],P0[5],     pw0[0]=PKW(P0,0), pw0[1]=PKW(P0,2), pw0); \
    VRD(4); SBAR(); GAPA(C1=__builtin_amdgcn_mfma_f32_32x32x16_bf16(kf[1],qr[0],NEGMC,0,0,0), P0[6],P0[7],P0[8],P0[9],     pw0[2]=PKW(P0,4), pw0[3]=PKW(P0,6), pw0); \
    VRD(1); SBAR(); GAPA(C0=__builtin_amdgcn_mfma_f32_32x32x16_bf16(kf[2],qr[1],C0,0,0,0),   P0[10],P0[11],P0[12],P0[13], pw1[0]=PKW(P0,8), pw1[1]=PKW(P0,10), pw1); \
    VRD(5); SBAR(); GAPA(C1=__builtin_amdgcn_mfma_f32_32x32x16_bf16(kf[3],qr[1],C1,0,0,0),   P0[14],P0[15],P1[0],P1[1],   pw1[2]=PKW(P0,12),pw1[3]=PKW(P0,14), pw1); \
    VRD(2); SBAR(); GAPA(C0=__builtin_amdgcn_mfma_f32_32x32x16_bf16(kf[4],qr[2],C0,0,0,0),   P1[2],P1[3],P1[4],P1[5],     pw2[0]=PKW(P1,0), pw2[1]=PKW(P1,2), pw2); \
    VRD(6); SBAR(); GAPA(C1=__builtin_amdgcn_mfma_f32_32x32x16_bf16(kf[5],qr[2],C1,0,0,0),   P1[6],P1[7],P1[8],P1[9],     pw2[2]=PKW(P1,4), pw2[3]=PKW(P1,6), pw2); \
    VRD(3); SBAR(); GAPA(C0=__builtin_amdgcn_mfma_f32_32x32x16_bf16(kf[6],qr[3],C0,0,0,0),   P1[10],P1[11],P1[12],P1[13], pw3[0]=PKW(P1,8), pw3[1]=PKW(P1,10), pw3); \
    VRD(7); SBAR(); GAPA(C1=__builtin_amdgcn_mfma_f32_32x32x16_bf16(kf[7],qr[3],C1,0,0,0),   P1[14],P1[15],0.f,0.f,       pw3[2]=PKW(P1,12),pw3[3]=PKW(P1,14), pw3); \
    l_reg+=sacc; \
    if(GK){DMA_K((t)+3,sl_cur);} if(GV){DMA_V((t)+1,sl_next);} \
    if(!USE_NEGM&&!NOMAX){ _Pragma("unroll") for(int r=0;r<16;++r){C0[r]-=mhat;C1[r]-=mhat;} } \
    CMASK(C0,C1,t); \
    if(!NOMAX){ float a=MX3(C0[0],C0[1],C1[0]),b=MX3(C0[2],C0[3],C1[1]); a=MX3(a,C1[2],C1[3]); \
      _Pragma("unroll") for(int r=4;r<16;r+=4){a=MX3(a,C0[r],C0[r+1]);b=MX3(b,C0[r+2],C0[r+3]);a=MX3(a,C1[r],C1[r+1]);b=MX3(b,C1[r+2],C1[r+3]);} \
      float rm=__builtin_fmaxf(a,b); { auto rr=__builtin_amdgcn_permlane32_swap(__float_as_uint(rm),__float_as_uint(rm),false,false); rm=__builtin_fmaxf(__uint_as_float(rr[0]),__uint_as_float(rr[1])); } \
      resc=false; \
      if(__builtin_expect(__any(rm>(float)THRL),0)){ const float dl=__builtin_fmaxf(rm,0.f); mhat+=dl; \
        _Pragma("unroll") for(int r=0;r<16;++r){C0[r]-=dl;C1[r]-=dl;} \
        if(USE_NEGM){ _Pragma("unroll") for(int r=0;r<16;++r)negm[r]=-mhat; asm volatile("":"+v"(negm)); } \
        const float f=__builtin_amdgcn_exp2f(-dl); l_reg*=f; if(hi==0)wsf[r32]=f; resc=true; } } \
    SBAR(); \
    GAPB(o[0]=__builtin_amdgcn_mfma_f32_32x32x16_bf16(PAF(0),VFR(0),o[0],0,0,0), C0,0); \
    GAPB(o[1]=__builtin_amdgcn_mfma_f32_32x32x16_bf16(PAF(0),VFR(4),o[1],0,0,0), C0,4); \
    KRD(GL,0); GAPB(o[0]=__builtin_amdgcn_mfma_f32_32x32x16_bf16(PAF(1),VFR(1),o[0],0,0,0), C0,8); \
    KRD(GL,1); GAPB(o[1]=__builtin_amdgcn_mfma_f32_32x32x16_bf16(PAF(1),VFR(5),o[1],0,0,0), C0,12); \
    KRD(GL,2); GAPB(o[0]=__builtin_amdgcn_mfma_f32_32x32x16_bf16(PAF(2),VFR(2),o[0],0,0,0), C1,0); \
    KRD(GL,3); GAPB(o[1]=__builtin_amdgcn_mfma_f32_32x32x16_bf16(PAF(2),VFR(6),o[1],0,0,0), C1,4); \
    GAPB(o[0]=__builtin_amdgcn_mfma_f32_32x32x16_bf16(PAF(3),VFR(3),o[0],0,0,0), C1,8); \
    GAPB(o[1]=__builtin_amdgcn_mfma_f32_32x32x16_bf16(PAF(3),VFR(7),o[1],0,0,0), C1,12); \
    }while(0)
  int t=1;
  for(;t+5<NT;t+=2){
    STEP(pB0,pB1,pA0,pA1,t,true,true,true);     WAIT_BAR(2); RESC(); ROT();
    STEP(pA0,pA1,pB0,pB1,t+1,true,true,true);   WAIT_BAR(2); RESC(); ROT();
  }
  #define ENDW(tt) do{ if((tt)+3<NT){WAIT_BAR(2);} else if((tt)+2<NT){WAIT_BAR(1);} else {WAIT_BAR(0);} }while(0)
  for(;t+1<NT;t+=2){
    STEP(pB0,pB1,pA0,pA1,t,(t+3<NT),(t+1<NT),(t+1<NT));       ENDW(t);   RESC(); ROT();
    STEP(pA0,pA1,pB0,pB1,t+1,(t+4<NT),(t+2<NT),(t+2<NT));     ENDW(t+1); RESC(); ROT();
  }
  STEP(pB0,pB1,pA0,pA1,NT-1,false,false,false); RESC();
  { float sacc=pB0[0]+pB0[1]; _Pragma("unroll") for(int r=2;r<16;++r)sacc+=pB0[r]; _Pragma("unroll") for(int r=0;r<16;++r)sacc+=pB1[r]; l_reg+=sacc;
    pw0=(u32x4){PKW(pB0,0),PKW(pB0,2),PKW(pB0,4),PKW(pB0,6)};pw1=(u32x4){PKW(pB0,8),PKW(pB0,10),PKW(pB0,12),PKW(pB0,14)};pw2=(u32x4){PKW(pB1,0),PKW(pB1,2),PKW(pB1,4),PKW(pB1,6)};pw3=(u32x4){PKW(pB1,8),PKW(pB1,10),PKW(pB1,12),PKW(pB1,14)};
    SBAR(); pv(o,vb0+sl_cur,PAF(0),PAF(1),PAF(2),PAF(3)); }
  #undef PKW
  #undef PAF
  #undef VFR
  #undef PIN
  #undef MX3
  #undef GAPA
  #undef GAPB
  #undef EX
  #undef VRD
  #undef KRD
  #undef STEP
  #undef ENDW
  {auto rr=__builtin_amdgcn_permlane32_swap(__float_as_uint(l_reg),__float_as_uint(l_reg),false,false);l_reg=__uint_as_float(rr[0])+__uint_as_float(rr[1]);}
  if(MODE==1||MODE==3)l_reg+=__builtin_amdgcn_exp2f(sink2-mhat);
  if(hi==0)wsf[32+r32]=l_reg;asm volatile("s_waitcnt lgkmcnt(0)":::"memory");
  float rli[16];
  #pragma unroll
  for(int r=0;r<16;++r)rli[r]=__builtin_amdgcn_rcpf(wsf[32+crow(r,hi)]);
  bf16_t*Ow=Yb+(size_t)(qrow0+wid*QBLK)*DM+ycol;
  { LAS bf16_t*stg=(LAS bf16_t*)(shm+LDS_OST)+wid*2048;
    #pragma unroll
    for(int r=0;r<16;++r){const int orow=crow(r,hi);
      #pragma unroll
      for(int d0=0;d0<2;++d0)stg[orow*64+d0*32+r32]=(bf16_t)(cvtpk(o[d0][r]*rli[r],0.f)&0xffffu);}
    asm volatile("s_waitcnt lgkmcnt(0)":::"memory");
    #pragma unroll
    for(int i=0;i<4;++i){const int row=i*8+(lane>>3),ch=lane&7; const u32x4 v=*(const LAS u32x4*)(stg+row*64+ch*8); *(u32x4*)(Ow+(size_t)row*DM+ch*8)=v;} }
  asm volatile("s_waitcnt lgkmcnt(0)\n\ts_barrier":::"memory");
  #undef DMA_K
  #undef DMA_V
  #undef KROW
  #undef NEGMC
  #undef CMASK
  #undef START
  #undef RESC
  #undef ROT
}

#undef SBAR
#undef WAIT_BAR
}

constexpr int NPHASE = 19;
__device__ __forceinline__ void ph_decode(int ph, int& l, int& k) { const unsigned tab = 0xA9864321u;
    if (ph == 1) { l = 0; k = 0; } else { const int j = ph - 2; l = j >= 8 ? 1 : 0; k = (int)((tab >> (4 * (j >= 8 ? j - 8 : j))) & 15u); } }

__device__ __forceinline__ void fill_rtab(Frame& F, const pg8::StaticOrder& S, const float* ssq, const float* ssqc) {
    LAS float* tab = (LAS float*)(F.lds + pg8::RTAB_OFF); pg8::Unit u;
    for (int i = 0; i < 8 && S.next(i, u); ++i) if (F.tid < 256) { float s = 0.f;
        if (u.pm < 64) { const float* p = ssq + (size_t)(u.pm * 256 + F.tid) * 16; const f32x4 a = *(const f32x4*)p, b = *(const f32x4*)(p + 4), c = *(const f32x4*)(p + 8), d = *(const f32x4*)(p + 12);
            s = ((a[0] + a[1]) + (a[2] + a[3])) + ((b[0] + b[1]) + (b[2] + b[3])) + ((c[0] + c[1]) + (c[2] + c[3])) + ((d[0] + d[1]) + (d[2] + d[3])); }
        else { const float* p = ssqc + (size_t)((u.pm - 64) * 256 + F.tid) * 64;
#pragma unroll
            for (int j = 0; j < 16; ++j) { const f32x4 a = *(const f32x4*)(p + 4 * j); s += (a[0] + a[1]) + (a[2] + a[3]); } }
        tab[i * 256 + F.tid] = rsqrtf(s * (1.f / DM) + EPS); }
    __syncthreads();
}
__device__ __forceinline__ void phase_ids(Frame& F) {
    int lane_;
    asm volatile("v_mbcnt_lo_u32_b32 %0, -1, 0\n\tv_mbcnt_hi_u32_b32 %0, -1, %0" : "=v"(lane_));
    F.lane = lane_; F.tid = F.wave * 64 + lane_;
}
__device__ __forceinline__ void run_phase(const Frame& F0, int ph) {
    Frame F = F0;
    unsigned char* ws = F.ws;
#define H ((bf16_t*)(F.ws + WS_H))
#define PROJ ((bf16_t*)(F.ws + WS_PROJ))
#define XC ((float*)(F.ws + WS_XC))
#define MOD ((const float*)(F.ws + WS_MOD))
#define vcu ((F.G % 8 == 0) ? (F.bid % 8) * (F.G / 8) + F.bid / 8 : F.bid)
#ifdef ONLYK
    if (ONLYK == 100) { if (ph == 0) { phase_ids(F); p0_prologue(F); } return; }
    if (ONLYK == 101) { if (ph == NPHASE - 1) { phase_ids(F); final_phase(F); } return; }
    if (ph == 0 || ph == NPHASE - 1) return;
    int l, k; ph_decode(ph, l, k);
    if (k != ONLYK) return;
#else
    if (ph == 0) { phase_ids(F); p0_prologue(F); return; }
    if (ph == NPHASE - 1) { phase_ids(F); final_phase(F); return; }
    int l, k; ph_decode(ph, l, k);
#endif
    const int M = (l == 0) ? NROWS : NLAT;
    switch (k) {
    case 0: phase_ids(F); norm_phase(F, l); break;
    case 1: { phase_ids(F); pg8::Gemm g{H, (const bf16_t*)(ws + WS_WIN) + (size_t)l * PP * 1024, NROWS, PP, 1024}; pg8::StaticOrder S; S.init(NROWS, PP, F.G, F.bid);
              gates_phase(F, l); if (l > 0) fill_rtab(F, S, (const float*)(ws + WS_SSQ1), (const float*)(ws + WS_SSQC1));
              pg8::EpiProj E{PROJ, PP, l == 0 ? nullptr : (const LAS float*)(F.lds + pg8::RTAB_OFF), (const float*)(ws + WS_BIASIN)}; pg8::gemm_phase<pg8::EpiProj, pg8::StaticOrder, true, true>(F.lds, g, S, E, F.tid); } break;
    case 2: phase_ids(F); postproj_phase(F, l); ml::pass1(F, l); break;
    case 3: {
        phase_ids(F);
        ml::pass2(F);
#ifndef NO_B
        for (int u = vcu; u < 256; u += F.G) { const int b = u >> 7, h = (u >> 5) & 3, qb = u & 31;
            attp::attn_unit_pipe<8, 1>(F, b, h, qb, PC_BQ + 64 * h, PC_BK + 64 * (h >> 1), PC_BV + 64 * (h >> 1), 256 + 64 * h, F.ka->in[IN_SINK][l * 4 + h] * LOG2E, nullptr); }
#endif
#ifndef NO_D
        for (int u = vcu; u < 256; u += F.G) { const int b = u >> 7, h = (u >> 5) & 3, qb = u & 31;
            attp::attn_unit_pipe<8, 2>(F, b, h, qb, PC_DQ + 64 * h, PC_DK + 64 * h, PC_DV + 64 * h, 768 + 64 * h, 0.f, F.ka->in[IN_RPB] + (size_t)(l * 4 + h) * 465); }
#endif
#ifndef NO_C3
        if (l == 0) for (int cu = vcu; cu < 24; cu += F.G) { const int mx = cu >> 3, b = (cu >> 2) & 1, h = cu & 3;
            const int qc = mx == 0 ? PC_AQ + 64 * h : (mx == 1 ? PC_BQ + 64 * h : PC_DQ + 64 * h);
            const int kc = mx == 0 ? PC_AK + 64 * (h >> 1) : (mx == 1 ? PC_BK + 64 * (h >> 1) : PC_DK + 64 * h);
            const int vc = mx == 0 ? PC_AV + 64 * (h >> 1) : (mx == 1 ? PC_BV + 64 * (h >> 1) : PC_DV + 64 * h);
            const int yc = (mx == 0 ? 0 : (mx == 1 ? 256 : 768)) + 64 * h;
            const float s2 = mx == 1 ? F.ka->in[IN_SINK][l * 4 + h] * LOG2E : -INFINITY;
            attp::attn_unit_pipe<8, 3>(F, b, h, 0, qc, kc, vc, yc, s2, nullptr); }
#endif
        if (l == 0) bias_phase(F, vcu >= 24 ? vcu - 24 : -1, F.G - 24);
    } break;
    case 4: {
        phase_ids(F);
#ifndef NO_ATTN0
        for (int u = vcu; u < 256; u += F.G) { const int b = u >> 7, h = (u >> 5) & 3, qb = u & 31;
            attp::attn_unit_pipe<8, 0>(F, b, h, qb, PC_AQ + 64 * h, PC_AK + 64 * (h >> 1), PC_AV + 64 * (h >> 1), 64 * h, 0.f, nullptr); }
#endif
        __syncthreads();
#ifndef NO_PASS3
        ml::pass3(F, l, l == 0 ? 0 : 4);
#endif
    } break;
    case 6: { phase_ids(F); pg8::Gemm g{PROJ  , (const bf16_t*)(ws + WS_WOUT) + (size_t)l * 1024 * 1024, NLAT, 1024, 1024}; pg8::StaticOrder S; S.init(NLAT, 1024, F.G, F.bid);
              { pg8::Unit u;
                if (F.G >= 256) { if (S.next(0, u)) {
                    groupnorm_rows<true>(F, l, u.pm * 256 + u.pn * 64, 64, F.wave, NWAVES);
                    asm volatile("s_waitcnt vmcnt(0)" ::: "memory"); __syncthreads();
                    if (F.tid == 0) { unsigned* cnt = (unsigned*)(ws + WS_CTL + 40960) + l * 64 + u.pm;
                        __hip_atomic_fetch_add(cnt, 1u, __ATOMIC_RELAXED, __HIP_MEMORY_SCOPE_AGENT);
                        unsigned sp = 0; while (__hip_atomic_load(cnt, __ATOMIC_RELAXED, __HIP_MEMORY_SCOPE_AGENT) < 4u && ++sp < (1u << 22)) __builtin_amdgcn_s_sleep(1);
                        __builtin_amdgcn_fence(__ATOMIC_ACQUIRE, "agent"); asm volatile("s_waitcnt vmcnt(0)" ::: "memory"); }
                    __syncthreads(); } }
                else { for (int i = 0; S.next(i, u); ++i) groupnorm_rows<false>(F, l, u.pm * 256, 256, F.wave, NWAVES); VM_WAIT(); __syncthreads(); } }
              pg8::EpiResid E{l == 0 ? F.ka->in[IN_X] : F.out, l == 0 ? F.ka->in[IN_CTX] : XC, F.out, XC, MOD + (size_t)l * 3 * 6144 + 2 * 1024,
                               (bf16_t*)(ws + WS_XG), F.ka->in[IN_G2] + l * 1024, MOD + (size_t)l * 3 * 6144 + 4 * 1024, (float*)(ws + WS_SSQ2)};
              if (F.G >= 256) { pg8::EpiResidStaged E2{E.xin_lat, E.xin_ctx, E.xout_lat, E.xout_ctx, E.gate, E.xg, E.gn, E.scn, E.ssq}; pg8::gemm_phase<pg8::EpiResidStaged, pg8::StaticOrder, true, true>(F.lds, g, S, E2, F.tid); }
              else pg8::gemm_phase<pg8::EpiResid, pg8::StaticOrder, true, true>(F.lds, g, S, E, F.tid);
              PROBE_PT(F.lds, 5);
              if (l == 0) skinny_ctx<1024>(F, PROJ + (size_t)NLAT * DM, (const bf16_t*)(ws + WS_WOUT), F.ka->in[IN_CTX], XC, MOD + 2 * 6144 + 2 * 1024,
                                           (bf16_t*)(ws + WS_XG) + (size_t)NLAT * DM, F.ka->in[IN_G2], MOD + 2 * 6144 + 4 * 1024, (float*)(ws + WS_SSQC2)); } break;
    case 8: { phase_ids(F); pg8::Gemm g{(const bf16_t*)(ws + WS_XG), (const bf16_t*)(ws + WS_WUP) + (size_t)l * DFF2 * 1024, M, DFF2, 1024}; pg8::StaticOrder S; S.init(M, DFF2, F.G, F.bid);
              fill_rtab(F, S, (const float*)(ws + WS_SSQ2), (const float*)(ws + WS_SSQC2));
              pg8::EpiUp E{PROJ, F.ka->in[IN_CONVW] + (size_t)l * 3 * DFF2, F.ka->in[IN_CONVB] + (size_t)l * DFF2, (float*)(ws + WS_EDGE), (const LAS float*)(F.lds + pg8::RTAB_OFF), (const float*)(ws + WS_BIASUP) + (size_t)l * 3 * DFF2};
              pg8::gemm_phase<pg8::EpiUp, pg8::StaticOrder, true, true>(F.lds, g, S, E, F.tid); } break;
    case 9: phase_ids(F); for (int ht = F.bid; ht < M / 128; ht += F.G) fixup_hts(F, l, ht, 1); break;
    case 10: { phase_ids(F); pg8::Gemm g{PROJ, (const bf16_t*)(ws + WS_WDN) + (size_t)l * 1024 * DFF, NLAT, 1024, DFF}; pg8::StaticOrder S; S.init(NLAT, 1024, F.G, F.bid);
              pg8::EpiResid E{F.out, XC, F.out, XC, MOD + (size_t)l * 3 * 6144 + 5 * 1024,
                               l == 0 ? H : nullptr, F.ka->in[IN_G1] + 1024, MOD + (size_t)3 * 6144 + 1 * 1024, (float*)(ws + WS_SSQ1)};
              if (F.G >= 256) { pg8::EpiResidStaged E2{E.xin_lat, E.xin_ctx, E.xout_lat, E.xout_ctx, E.gate, E.xg, E.gn, E.scn, E.ssq}; pg8::gemm_phase<pg8::EpiResidStaged, pg8::StaticOrder, true, true>(F.lds, g, S, E2, F.tid); }
              else pg8::gemm_phase<pg8::EpiResid, pg8::StaticOrder, true, true>(F.lds, g, S, E, F.tid);
              PROBE_PT(F.lds, 5);
              if (l == 0) skinny_ctx<DFF>(F, PROJ + (size_t)NLAT * DFF, (const bf16_t*)(ws + WS_WDN), XC, XC, MOD + 2 * 6144 + 5 * 1024,
                                          H + (size_t)NLAT * DM, F.ka->in[IN_G1] + 1024, MOD + (size_t)(3 + 2) * 6144 + 1 * 1024, (float*)(ws + WS_SSQC1)); } break;
    default: break;
    }
#undef H
#undef PROJ
#undef XC
#undef MOD
#undef vcu
}

__global__ void __launch_bounds__(NTHREADS, 2) fwd_kernel(Args args) {
    extern __shared__ __attribute__((aligned(16))) unsigned char lds_raw[];
    Frame F;
    F.lds = (LAS unsigned char*)lds_raw;
    const int wave0 = __builtin_amdgcn_readfirstlane((int)threadIdx.x >> 6);
    F.tid = 0; F.lane = 0; F.wave = wave0;
    F.G = gridDim.x; F.bid = blockIdx.x;
    F.ka = (const __attribute__((address_space(4))) Args*)__builtin_amdgcn_kernarg_segment_ptr();
    F.out = args.out; F.ws = args.ws;
#define MK_LANE(x) int x; asm volatile("v_mbcnt_lo_u32_b32 %0, -1, 0\n\tv_mbcnt_hi_u32_b32 %0, -1, %0" : "=v"(x))
#if !MK_MULTI
    { MK_LANE(l0_); if (wave0 == 0) ((LAS unsigned*)(F.lds + LDSCTL_OFF))[l0_] = 0u; }
    __syncthreads();
    XcdBarrier bar;
    { MK_LANE(l0_); bar = xcd_barrier_post((unsigned*)(args.ws + WS_CTL) + CW_BAR, (volatile LAS unsigned*)(F.lds + LDSCTL_OFF) + 8, wave0 == 0 && l0_ == 0); }
#endif
#ifdef PROBE_MASK
    unsigned long long pr_acc = 0ull;
#endif
    for (int ph = args.ph_lo; ph < args.ph_hi; ++ph) {
#ifdef PROBE_MASK
        const unsigned long long pr_t0 = __builtin_amdgcn_s_memrealtime();
#endif
#ifdef PROBE_PH
        *(volatile LAS unsigned*)(F.lds + LDSCTL_OFF + 64) = (ph == PROBE_PH) ? 1u : 0u; __syncthreads();
        PROBE_PT(F.lds, 0);
#endif
        {
            Frame P = F;
            int wave_ = wave0, bid_ = F.bid, g_ = F.G; unsigned char* ws_ = F.ws; float* out_ = F.out; const __attribute__((address_space(4))) Args* ka_ = F.ka;
            asm volatile("" : "+s"(wave_), "+s"(bid_), "+s"(g_), "+s"(ws_), "+s"(out_), "+s"(ka_));
            P.ka = ka_; P.lane = 0; P.wave = wave_; P.tid = 0; P.bid = bid_; P.G = g_; P.ws = ws_; P.out = out_;
            run_phase(P, ph);
#ifdef DUP_PH
            if (DUP_PH(ph)) { asm volatile("s_waitcnt vmcnt(0) lgkmcnt(0)" ::: "memory"); __syncthreads(); run_phase(P, ph); }
#endif
        }
#if !MK_MULTI
        if (ph + 1 < args.ph_hi) {
            if (args.ph_lo < 0) cg::this_grid().sync();
            else { MK_LANE(l1_); xcd_barrier(bar, wave0 == 0 && l1_ == 0); }
        }
#endif
#ifdef PROBE_PH
        PROBE_PT(F.lds, 4);
#endif
#ifdef PROBE_MASK
        if ((PROBE_MASK >> ph) & 1u) pr_acc += __builtin_amdgcn_s_memrealtime() - pr_t0;
#endif
    }
#ifdef PROBE_PH
    if (blockIdx.x == 0) { __syncthreads(); const unsigned long long d_ = *(volatile LAS unsigned long long*)(F.lds + LDSCTL_OFF + 72 + 8 * PROBE_B) - *(volatile LAS unsigned long long*)(F.lds + LDSCTL_OFF + 72 + 8 * PROBE_A);
        const unsigned long long t1 = __builtin_amdgcn_s_memrealtime(); while (__builtin_amdgcn_s_memrealtime() - t1 < d_) __builtin_amdgcn_s_sleep(8); }
#endif
#ifdef PROBE_MASK
    if (blockIdx.x == 0) { const unsigned long long t1 = __builtin_amdgcn_s_memrealtime(); while (__builtin_amdgcn_s_memrealtime() - t1 < pr_acc) __builtin_amdgcn_s_sleep(8); }
#endif
}

extern "C" void kernel_launch(void* const* d_in, const int* in_sizes, int n_in, void* d_out, int out_size, void* d_ws, size_t ws_size, hipStream_t stream) {
    static int grid = 0;
    if (grid == 0) {
        if (n_in != 21 || out_size != NLAT * DM || ws_size < WS_END) { fprintf(stderr, "kernel_launch: unexpected shapes (n_in %d out %d ws %zu)\n", n_in, out_size, ws_size); grid = -1; return; }
        int dev = 0, cus = 0, per_cu = 0;
        if (hipGetDevice(&dev) != hipSuccess || hipDeviceGetAttribute(&cus, hipDeviceAttributeMultiprocessorCount, dev) != hipSuccess) { grid = -1; return; }
        if (hipFuncSetAttribute((const void*)fwd_kernel, hipFuncAttributeMaxDynamicSharedMemorySize, LDS_BYTES) != hipSuccess) { fprintf(stderr, "kernel_launch: hipFuncSetAttribute failed\n"); grid = -1; return; }
        if (hipOccupancyMaxActiveBlocksPerMultiprocessor(&per_cu, (const void*)fwd_kernel, NTHREADS, LDS_BYTES) != hipSuccess || per_cu < 1) { fprintf(stderr, "kernel_launch: occupancy query says %d blocks per CU\n", per_cu); grid = -1; (void)hipGetLastError(); return; }
        grid = cus;
    }
    if (grid < 0) return;
#if !MK_MULTI
    if (hipMemsetAsync((char*)d_ws + WS_CTL, 0, 65536, stream) != hipSuccess) { fprintf(stderr, "kernel_launch: hipMemsetAsync failed\n"); return; }
#endif
    Args a{};
    for (int i = 0; i < 21; ++i) a.in[i] = (const float*)d_in[i];
    a.out = (float*)d_out; a.ws = (unsigned char*)d_ws;
#if MK_MULTI
    for (int ph = 0; ph < NPHASE; ++ph) { a.ph_lo = ph; a.ph_hi = ph + 1; hipLaunchKernelGGL(fwd_kernel, dim3(grid), dim3(NTHREADS), LDS_BYTES, stream, a); }
#else
    a.ph_lo = 0; a.ph_hi = NPHASE;
    void* kargs[] = {&a};
    hipError_t e = hipLaunchCooperativeKernel((void*)fwd_kernel, dim3(grid), dim3(NTHREADS), kargs, LDS_BYTES, stream);
    if (e != hipSuccess) fprintf(stderr, "kernel_launch: cooperative launch failed: %s (grid %d)\n", hipGetErrorString(e), grid);
#endif
}
```

```cpp
#include <hip/hip_runtime.h>
#include <hip/hip_cooperative_groups.h>
#include <cstdio>
#include <cstdint>
namespace cg = cooperative_groups;

#ifndef MK_MULTI
#define MK_MULTI 0
#endif

constexpr int DM = 1024, SEQ = 8192, NBATCH = 2, CTXL = 256, NLAT = NBATCH * SEQ, NROWS = NLAT + NBATCH * CTXL;
constexpr int PP = 2816;
constexpr int DFF = 2816, DFF2 = 5632, DIN = 2832, NLAYER = 2;
constexpr float EPS = 1e-6f;
constexpr float LOG2E = 1.4426950408889634f;
constexpr float QSCALE2 = 0.125f * LOG2E;
constexpr int PC_AQ = 0, PC_AK = 256, PC_AV = 384, PC_BQ = 512, PC_BK = 768, PC_BV = 896, PC_CQ = 1024, PC_CK = 1280, PC_CV = 1536, PC_CO = 1792, PC_DQ = 2048, PC_DK = 2304, PC_DV = 2560;
constexpr int NCHUNK = 132, NCHAIN = 16;

constexpr size_t MiB = 1u << 20;
constexpr size_t WS_CTL = 0, CTL_ZERO_BYTES = 1 * MiB;
constexpr size_t WS_MOD = 1 * MiB;
constexpr size_t WS_ROPE = 1 * MiB + 192 * 1024;
constexpr size_t WS_WG = 1 * MiB + 512 * 1024;
constexpr size_t WS_XC = 2 * MiB;
constexpr size_t WS_WIN = 4 * MiB;
constexpr size_t WS_WOUT = 15 * MiB;
constexpr size_t WS_WUP = 19 * MiB;
constexpr size_t WS_WDN = 41 * MiB;
constexpr size_t WS_H = 52 * MiB;
constexpr size_t WS_PROJ = 85 * MiB;
constexpr size_t WS_GATES = 176 * MiB;
constexpr size_t WS_DS = 178 * MiB;
constexpr size_t WS_SBF = 211 * MiB;
constexpr size_t WS_ZD = 228 * MiB;
constexpr size_t WS_ZC = WS_ZD + 1 * MiB;
constexpr size_t WS_GC = WS_ZC + 1 * MiB;
constexpr size_t WS_ML = WS_GC + 16384;
constexpr size_t WS_MC = WS_ML + 16384;
constexpr size_t WS_SSQ1 = 231 * MiB;
constexpr size_t WS_SSQ2 = 232 * MiB + 512 * 1024;
constexpr size_t WS_BIASUP = 234 * MiB;
constexpr size_t WS_BIASIN = 234 * MiB + 256 * 1024;
constexpr size_t WS_XG = WS_DS;
constexpr size_t WS_EDGE = WS_SBF;
constexpr size_t WS_SSQC1 = 234 * MiB + 512 * 1024;
constexpr size_t WS_SSQC2 = 234 * MiB + 768 * 1024;
constexpr size_t WS_END = 237 * MiB;

#define LAS __attribute__((address_space(3)))
#define GAS __attribute__((address_space(1)))
typedef unsigned short bf16_t;
typedef short bf16x8 __attribute__((ext_vector_type(8)));
typedef short s16x4 __attribute__((ext_vector_type(4)));
typedef float f32x4 __attribute__((ext_vector_type(4)));
typedef float f32x16 __attribute__((ext_vector_type(16)));
typedef float f32x2 __attribute__((ext_vector_type(2)));
typedef unsigned u32x4 __attribute__((ext_vector_type(4)));
typedef unsigned u32x2 __attribute__((ext_vector_type(2)));
typedef __bf16 bf16x2_t __attribute__((ext_vector_type(2)));
typedef short v4i16_t __attribute__((ext_vector_type(4)));

__device__ __forceinline__ unsigned cvtpk(float lo, float hi) { f32x2 v = {lo, hi}; bf16x2_t b = __builtin_convertvector(v, bf16x2_t); return __builtin_bit_cast(unsigned, b); }
__device__ __forceinline__ float bf2f(unsigned short b) { return __uint_as_float((unsigned)b << 16); }
__device__ __forceinline__ float bflo(unsigned w) { return __uint_as_float(w << 16); }
__device__ __forceinline__ float bfhi(unsigned w) { return __uint_as_float(w & 0xffff0000u); }
__device__ __forceinline__ float shfl_idx(float v, int src) { return __int_as_float(__builtin_amdgcn_ds_bpermute(src << 2, __float_as_int(v))); }
__device__ __forceinline__ float shfl_x(float v, int o, int lane) { return shfl_idx(v, lane ^ o); }
__device__ __forceinline__ float wave_sum(float v, int lane) {
#pragma unroll
    for (int o = 1; o < 64; o <<= 1) v += shfl_x(v, o, lane);
    return v;
}
__device__ __forceinline__ float wave_max(float v, int lane) {
#pragma unroll
    for (int o = 1; o < 64; o <<= 1) v = fmaxf(v, shfl_x(v, o, lane));
    return v;
}
#ifdef PROBE_PH
#define PROBE_PT(ldsbase, id) do { if (*(volatile LAS unsigned*)((ldsbase) + 155648 + 64)) *(volatile LAS unsigned long long*)((ldsbase) + 155648 + 72 + 8 * (id)) = __builtin_amdgcn_s_memrealtime(); } while (0)
#else
#define PROBE_PT(ldsbase, id) do { } while (0)
#endif
#define LDS_WAIT() asm volatile("s_waitcnt lgkmcnt(0)" ::: "memory")
#define VM_WAIT() asm volatile("s_waitcnt vmcnt(0)" ::: "memory")

namespace pg8 {
#define PG8_LAS __attribute__((address_space(3)))
constexpr int BM = 256, BK = 64, HALF = 128, HTB = HALF * BK * 2  , STAGE_BYTES = 8 * HTB, NXCD = 8, WGM = 8;
__host__ __device__ __forceinline__ int lds_byte(int r, int c) { const int st = (r >> 4) * 2 + (c >> 5), rr = r & 15, cc = c & 31, ob = rr * 64 + cc * 2; return st * 1024 + (ob ^ (((ob >> 9) & 1) << 5)); }
__host__ __device__ __forceinline__ void stage_rc(int b, int& R, int& C) { const int st = b / 1024, sb = b % 1024, swz = sb ^ (((sb >> 9) & 1) << 5); R = (st >> 1) * 16 + swz / 64; C = (st & 1) * 32 + (swz % 64) / 2; }
__host__ __device__ __forceinline__ int perm32(int rho) { const int n = rho >> 4, i = rho & 15; return 8 * (i >> 2) + 4 * n + (i & 3); }

struct Unit { int pm, pn, ui; };
struct Gemm { const bf16_t* A; const bf16_t* Bt; int M, N, K; };

struct StaticOrder {
    int nM, nN, nwg, G, c;
    __host__ __device__ __forceinline__ void init(int M, int N, int G_, int c_) { nM = M / BM; nN = N / BM; nwg = nM * nN; G = G_; c = c_; }
    __host__ __device__ __forceinline__ bool next(int i, Unit& u) const {
        const long L = (long)i * G + c; if (L >= nwg) return false;
        int wgid = (int)L; { const int q = nwg / NXCD, r = nwg % NXCD, xcd = wgid % NXCD, off = wgid / NXCD; wgid = (xcd < r ? xcd * (q + 1) : r * (q + 1) + (xcd - r) * q) + off; }
        const int nig = WGM * nN, gid = wgid / nig, fm = gid * WGM, gsz = (nM - fm) < WGM ? (nM - fm) : WGM;
        u.pm = fm + ((wgid % nig) % gsz); u.pn = (wgid % nig) / gsz; u.ui = i; return true;
    }
    __device__ __forceinline__ void a_ready(const Unit&) const {}
    __device__ __forceinline__ void done(const Unit&) const {}
};

constexpr int RTAB_OFF = 131072;
struct EpiProj {
    static constexpr bool PERM = true, AFTER_DRAIN = false, ROWPERM = false;
    bf16_t* O; int ldc; const LAS float* rtab; const float* bias;
    __device__ __forceinline__ void operator()(const f32x4 (&acc)[2][2][4][2], const Unit& u, int wr, int wc, int fr, int fq) const {
        asm volatile("" : "+v"(fr), "+v"(fq));
        const int row0 = u.pm * BM + wr * 64 + fr, col0 = u.pn * BM + wc * 32 + 8 * fq;
        const float sc = (u.pn == 2 || u.pn == 8) ? QSCALE2 : (u.pn == 4 ? 0.125f : 1.f);
        float rs[8] = {1.f, 1.f, 1.f, 1.f, 1.f, 1.f, 1.f, 1.f}; f32x4 bv[2][2] = {};
        if (rtab) {
#pragma unroll
            for (int i = 0; i < 8; ++i) rs[i] = rtab[u.ui * 256 + wr * 64 + fr + (i >> 2) * HALF + (i & 3) * 16];
            const int id = u.pm < 32 ? 0 : (u.pm < 64 ? 1 : 2);
#pragma unroll
            for (int bj = 0; bj < 2; ++bj)
#pragma unroll
                for (int n = 0; n < 2; ++n) bv[bj][n] = *(const f32x4*)(bias + id * PP + col0 + bj * HALF + 4 * n); }
#pragma unroll
        for (int ai = 0; ai < 2; ++ai)
#pragma unroll
            for (int m = 0; m < 4; ++m) { bf16_t* rowp = O + (size_t)(row0 + ai * HALF + m * 16) * ldc + col0; const float r = rs[ai * 4 + m];
#pragma unroll
                for (int bj = 0; bj < 2; ++bj) { const f32x4 v0 = (acc[ai][bj][m][0] * r + bv[bj][0]) * sc, v1 = (acc[ai][bj][m][1] * r + bv[bj][1]) * sc;
                    u32x4 w; w.x = cvtpk(v0[0], v0[1]); w.y = cvtpk(v0[2], v0[3]); w.z = cvtpk(v1[0], v1[1]); w.w = cvtpk(v1[2], v1[3]);
                    *(u32x4*)(rowp + bj * HALF) = w; } }
    }
};
struct EpiResid {
    static constexpr bool PERM = true, AFTER_DRAIN = false, ROWPERM = false;
    const float* xin_lat; const float* xin_ctx; float* xout_lat; float* xout_ctx; const float* gate;
    bf16_t* xg; const float* gn; const float* scn; float* ssq;
    __device__ __forceinline__ void operator()(const f32x4 (&acc)[2][2][4][2], const Unit& u, int wr, int wc, int fr, int fq) const {
        asm volatile("" : "+v"(fr), "+v"(fq));
        const int id = u.pm < 32 ? 0 : (u.pm < 64 ? 1 : 2);
        const float* xin = u.pm < 64 ? xin_lat + (size_t)u.pm * BM * DM : xin_ctx + (size_t)(u.pm - 64) * BM * DM;
        float* xout = u.pm < 64 ? xout_lat + (size_t)u.pm * BM * DM : xout_ctx + (size_t)(u.pm - 64) * BM * DM;
        const int rl = wr * 64 + fr, col0 = u.pn * BM + wc * 32 + 8 * fq;
        f32x4 g[2][2], gs[2][2];
#pragma unroll
        for (int bj = 0; bj < 2; ++bj)
#pragma unroll
            for (int n = 0; n < 2; ++n) { g[bj][n] = *(const f32x4*)(gate + id * 6144 + col0 + bj * HALF + 4 * n);
                if (xg) gs[bj][n] = *(const f32x4*)(gn + col0 + bj * HALF + 4 * n) * (1.f + *(const f32x4*)(scn + id * 6144 + col0 + bj * HALF + 4 * n)); }
#pragma unroll
        for (int ai = 0; ai < 2; ++ai)
#pragma unroll
            for (int m = 0; m < 4; ++m) { const size_t off = (size_t)(rl + ai * HALF + m * 16) * DM + col0; float s = 0.f;
#pragma unroll
                for (int bj = 0; bj < 2; ++bj) { f32x4 o[2];
#pragma unroll
                    for (int n = 0; n < 2; ++n) { const f32x4 xv = *(const f32x4*)(xin + off + bj * HALF + 4 * n); o[n] = xv + g[bj][n] * acc[ai][bj][m][n];
                        *(f32x4*)(xout + off + bj * HALF + 4 * n) = o[n]; s += (o[n][0] * o[n][0] + o[n][1] * o[n][1]) + (o[n][2] * o[n][2] + o[n][3] * o[n][3]); }
                    if (xg) { const f32x4 a = o[0] * gs[bj][0], b = o[1] * gs[bj][1]; u32x4 w; w.x = cvtpk(a[0], a[1]); w.y = cvtpk(a[2], a[3]); w.z = cvtpk(b[0], b[1]); w.w = cvtpk(b[2], b[3]);
                        *(u32x4*)(xg + (size_t)u.pm * BM * DM + off + bj * HALF) = w; } }
                if (xg) { s += shfl_idx(s, (fq * 16 + fr) ^ 16); s += shfl_idx(s, (fq * 16 + fr) ^ 32);
                    if (fq == 0) ssq[(size_t)(u.pm * BM + rl + ai * HALF + m * 16) * 16 + u.pn * 4 + wc] = s; } }
    }
};
struct EpiResidStaged {
    static constexpr bool PERM = true, AFTER_DRAIN = true, ROWPERM = false;
    const float* xin_lat; const float* xin_ctx; float* xout_lat; float* xout_ctx; const float* gate;
    bf16_t* xg; const float* gn; const float* scn; float* ssq;
    static constexpr int RS = 1040;
    __device__ __forceinline__ void operator()(const f32x4 (&)[2][2][4][2], const Unit&, int, int, int, int) const {}
    __device__ __forceinline__ void fused(const f32x4 (&acc)[2][2][4][2], const Unit& u, int wr, int wc, int fr, int fq, PG8_LAS unsigned char* lds, int wid, int lane) const {
        const int id = u.pm < 32 ? 0 : (u.pm < 64 ? 1 : 2);
        const float* xin = u.pm < 64 ? xin_lat + (size_t)u.pm * BM * DM : xin_ctx + (size_t)(u.pm - 64) * BM * DM;
        float* xout = u.pm < 64 ? xout_lat + (size_t)u.pm * BM * DM : xout_ctx + (size_t)(u.pm - 64) * BM * DM;
        const int colg = u.pn * BM + 4 * lane;
        const f32x4 gv = *(const f32x4*)(gate + id * 6144 + colg);
        f32x4 gsv = {0.f, 0.f, 0.f, 0.f}; if (xg) gsv = *(const f32x4*)(gn + colg) * (1.f + *(const f32x4*)(scn + id * 6144 + colg));
#pragma unroll
        for (int ai = 0; ai < 2; ++ai) {
#pragma unroll
            for (int m = 0; m < 4; ++m)
#pragma unroll
                for (int bj = 0; bj < 2; ++bj)
#pragma unroll
                    for (int n = 0; n < 2; ++n) *(PG8_LAS f32x4*)(lds + (wr * 64 + m * 16 + fr) * RS + (bj * HALF + wc * 32 + 8 * fq + 4 * n) * 4) = acc[ai][bj][m][n];
            asm volatile("s_waitcnt lgkmcnt(0)\n\ts_barrier" ::: "memory");
#pragma unroll
            for (int r8 = 0; r8 < 2; ++r8) {
                f32x4 xv[8], av[8]; float s[8];
#pragma unroll
                for (int q = 0; q < 8; ++q) { const int row = wid * 16 + r8 * 8 + q; xv[q] = *(const f32x4*)(xin + (size_t)(ai * HALF + row) * DM + colg); av[q] = *(const PG8_LAS f32x4*)(lds + row * RS + lane * 16); }
#pragma unroll
                for (int q = 0; q < 8; ++q) { const int row = wid * 16 + r8 * 8 + q; const f32x4 o = xv[q] + gv * av[q];
                    *(f32x4*)(xout + (size_t)(ai * HALF + row) * DM + colg) = o; s[q] = (o[0] * o[0] + o[1] * o[1]) + (o[2] * o[2] + o[3] * o[3]);
                    if (xg) { const f32x4 a = o * gsv; u32x2 w; w.x = cvtpk(a[0], a[1]); w.y = cvtpk(a[2], a[3]); *(u32x2*)(xg + (size_t)(u.pm * BM + ai * HALF + row) * DM + colg) = w; } }
                if (xg) {
#pragma unroll
                    for (int o_ = 1; o_ < 64; o_ <<= 1)
#pragma unroll
                        for (int q = 0; q < 8; ++q) s[q] += shfl_x(s[q], o_, lane);
                    float sv = s[0];
#pragma unroll
                    for (int q = 1; q < 8; ++q) sv = lane == q ? s[q] : sv;
                    if (lane < 8) *(f32x4*)(ssq + (size_t)(u.pm * BM + ai * HALF + wid * 16 + r8 * 8 + lane) * 16 + u.pn * 4) = (f32x4){sv, 0.f, 0.f, 0.f}; }
            }
            asm volatile("s_waitcnt lgkmcnt(0)\n\ts_barrier" ::: "memory");
        }
    }
};
struct EpiUp {
    static constexpr bool PERM = true, AFTER_DRAIN = false, ROWPERM = true;
    bf16_t* act; const float* convw; const float* convb; float* edge; const LAS float* rtab; const float* bias;
    __device__ __forceinline__ void operator()(f32x4 (&acc)[2][2][4][2], const Unit& u, int wr, int wc, int fr, int fq) const {
        asm volatile("" : "+v"(fr), "+v"(fq));
        const int chb = u.pn * 128 + wc * 32 + 8 * fq;
        const int ht = 2 * u.pm + wr;
        {
            const f32x4 ra = *(const LAS f32x4*)(rtab + u.ui * 256 + (wr * 16 + fr) * 8), rb = *(const LAS f32x4*)(rtab + u.ui * 256 + (wr * 16 + fr) * 8 + 4);
            const float rs[8] = {ra[0], ra[1], ra[2], ra[3], rb[0], rb[1], rb[2], rb[3]};
            const int id = u.pm < 32 ? 0 : (u.pm < 64 ? 1 : 2);
#pragma unroll
            for (int bj = 0; bj < 2; ++bj)
#pragma unroll
                for (int n = 0; n < 2; ++n) { const f32x4 bv = *(const f32x4*)(bias + id * DFF2 + bj * DFF + chb + 4 * n);
#pragma unroll
                    for (int sl = 0; sl < 8; ++sl) { acc[sl >> 2][bj][sl & 3][n] = acc[sl >> 2][bj][sl & 3][n] * rs[sl] + bv; asm volatile("" : "+v"(acc[sl >> 2][bj][sl & 3][n])); } }
        }
        const int lm1 = (fq * 16 + fr - 1) & 63, lp1 = (fq * 16 + fr + 1) & 63;
#pragma unroll
        for (int bj = 0; bj < 2; ++bj)
#pragma unroll
            for (int n = 0; n < 2; ++n) {
                const int uc = bj * DFF + chb + 4 * n;
                if (fr == 0) { *(f32x4*)(edge + ((size_t)ht * 4 + 0) * DFF2 + uc) = acc[0][bj][0][n]; *(f32x4*)(edge + ((size_t)ht * 4 + 1) * DFF2 + uc) = acc[0][bj][1][n]; }
                if (fr == 15) { *(f32x4*)(edge + ((size_t)ht * 4 + 2) * DFF2 + uc) = acc[1][bj][2][n]; *(f32x4*)(edge + ((size_t)ht * 4 + 3) * DFF2 + uc) = acc[1][bj][3][n]; }
#pragma unroll
                for (int j = 0; j < 4; ++j) {
                    const float w0 = convw[uc + j], w1 = convw[DFF2 + uc + j], w2 = convw[2 * DFF2 + uc + j], bb = convb[uc + j];
                    float pv = shfl_idx(acc[1][bj][3][n][j], lm1); const float nx = shfl_idx(acc[0][bj][0][n][j], lp1);
#pragma unroll
                    for (int sl = 0; sl < 8; ++sl) { const float cur = acc[sl >> 2][bj][sl & 3][n][j]; const float nxt = sl < 7 ? acc[(sl + 1) >> 2][bj][(sl + 1) & 3][n][j] : nx;
                        acc[sl >> 2][bj][sl & 3][n][j] = w0 * pv + w1 * cur + w2 * nxt + bb; pv = cur; }
                }
#pragma unroll
                for (int sl = 0; sl < 8; ++sl) asm volatile("" : "+v"(acc[sl >> 2][bj][sl & 3][n]));
            }
        bf16_t* base = act + (size_t)(u.pm * BM + (wr * 16 + fr) * 8) * DFF + chb;
#pragma unroll
        for (int sl = 0; sl < 8; ++sl) {
            const f32x4 g0 = acc[sl >> 2][0][sl & 3][0], g1 = acc[sl >> 2][0][sl & 3][1], v0 = acc[sl >> 2][1][sl & 3][0], v1 = acc[sl >> 2][1][sl & 3][1];
            f32x4 o0, o1;
#pragma unroll
            for (int j = 0; j < 4; ++j) { o0[j] = g0[j] * __builtin_amdgcn_rcpf(1.f + __builtin_amdgcn_exp2f(-LOG2E * g0[j])) * v0[j]; o1[j] = g1[j] * __builtin_amdgcn_rcpf(1.f + __builtin_amdgcn_exp2f(-LOG2E * g1[j])) * v1[j]; }
            u32x4 w; w.x = cvtpk(o0[0], o0[1]); w.y = cvtpk(o0[2], o0[3]); w.z = cvtpk(o1[0], o1[1]); w.w = cvtpk(o1[2], o1[3]);
            const bool skip = (fr == 0 && sl == 0) || (fr == 15 && sl == 7);
            if (!skip) *(u32x4*)(base + (size_t)sl * DFF) = w;
        }
    }
};
template <class Epi, class Sched, bool ALIGN_EPI = false, bool SP2 = false>
__device__ __forceinline__ void gemm_phase(PG8_LAS unsigned char* lds, const Gemm g, const Sched& S, const Epi& E, const int tid) {
    const int wid = __builtin_amdgcn_readfirstlane(tid >> 6), lane = tid & 63, wr = wid >> 2, wc = wid & 3, fr = lane & 15, fq = lane >> 4;
    const int K = g.K, nt = K / BK;
    unsigned voffA[2], voffB[2];
#pragma unroll
    for (int i = 0; i < 2; ++i) { int R, C; stage_rc(tid * 16 + i * 8192, R, C); const int Rb = Epi::PERM ? ((R & ~31) + perm32(R & 31)) : R;
        const int Ra = Epi::ROWPERM ? (((((R >> 6) & 1) * 16 + (R & 15)) << 3) + ((R >> 4) & 3)) : R;
        voffA[i] = (unsigned)(Ra * K + C) * 2u; voffB[i] = (unsigned)(Rb * K + C) * 2u; }
    const size_t kstep = (size_t)(BK * 2);
    const size_t hstep = (size_t)HALF * K * 2;
    const size_t hstepA = Epi::ROWPERM ? (size_t)4 * K * 2 : hstep;
    const size_t tstep = 2 * hstep;
    const unsigned ldsw = (unsigned)wid * 1024u;
    const int aoff = lds_byte(wr * 64 + fr, fq * 8), boff = lds_byte(wc * 32 + fr, fq * 8);
#define PG8_SA(b, h) (((b) * 2 + (h)) * HTB)
#define PG8_SB(b, h) ((4 + (b) * 2 + (h)) * HTB)
#define PG8_STAGE(bufoff, gbase, voff) do { _Pragma("unroll") for (int _i = 0; _i < 2; ++_i) \
        __builtin_amdgcn_global_load_lds((const unsigned*)((const char*)(gbase) + (voff)[_i]), (PG8_LAS unsigned*)(lds + (bufoff) + ldsw + _i * 8192), 16, 0, 0); } while (0)
#define PG8_LDA(dst, b, h) do { _Pragma("unroll") for (int m = 0; m < 4; ++m) _Pragma("unroll") for (int k = 0; k < 2; ++k) dst[m][k] = *(const PG8_LAS bf16x8*)(lds + PG8_SA(b, h) + aoff + m * 2048 + k * 1024); } while (0)
#define PG8_LDB(dst, b, h) do { _Pragma("unroll") for (int n = 0; n < 2; ++n) _Pragma("unroll") for (int k = 0; k < 2; ++k) dst[n][k] = *(const PG8_LAS bf16x8*)(lds + PG8_SB(b, h) + boff + n * 2048 + k * 1024); } while (0)
#define PG8_MMA(ai, bj, At, Bt) do { __builtin_amdgcn_s_setprio(1); _Pragma("unroll") for (int m = 0; m < 4; ++m) _Pragma("unroll") for (int n = 0; n < 2; ++n) _Pragma("unroll") for (int k = 0; k < 2; ++k) \
        acc[ai][bj][m][n] = __builtin_amdgcn_mfma_f32_16x16x32_bf16(Bt[n][k], At[m][k], acc[ai][bj][m][n], 0, 0, 0); __builtin_amdgcn_s_setprio(0); } while (0)
#define PG8_WAIT_V(n) asm volatile("s_waitcnt vmcnt(" #n ")" ::: "memory")
#define PG8_WAIT_L(n) asm volatile("s_waitcnt lgkmcnt(" #n ")" ::: "memory")
#define PG8_BAR __builtin_amdgcn_s_barrier()
#define PG8_SCHED __builtin_amdgcn_sched_barrier(0)
    Unit cur, nxt; int ui = 0;
    if (!S.next(0, cur)) return;
    f32x4 acc[2][2][4][2];
#pragma unroll
    for (int a = 0; a < 2; ++a)
#pragma unroll
        for (int b = 0; b < 2; ++b)
#pragma unroll
            for (int m = 0; m < 4; ++m)
#pragma unroll
                for (int n = 0; n < 2; ++n) acc[a][b][m][n] = (f32x4){0.f, 0.f, 0.f, 0.f};
    bf16x8 At[4][2], B0[2][2], B1[2][2];
    const char* cA = (const char*)g.A + (size_t)cur.pm * tstep; const char* cB = (const char*)g.Bt + (size_t)cur.pn * tstep;
    S.a_ready(cur);
    if constexpr (SP2) {
        PG8_STAGE(PG8_SB(0, 0), cB, voffB); PG8_STAGE(PG8_SB(0, 1), cB + hstep, voffB); PG8_STAGE(PG8_SA(0, 0), cA, voffA); PG8_STAGE(PG8_SA(0, 1), cA + hstepA, voffA);
        if (wr == 1) PG8_BAR;
        PG8_WAIT_V(2); PG8_BAR;
        PG8_STAGE(PG8_SB(1, 0), cB + kstep, voffB); PG8_STAGE(PG8_SA(1, 0), cA + kstep, voffA); PG8_STAGE(PG8_SB(1, 1), cB + hstep + kstep, voffB);
        PG8_WAIT_V(6); PG8_BAR;
    } else {
        PG8_STAGE(PG8_SB(0, 0), cB, voffB); PG8_STAGE(PG8_SA(0, 0), cA, voffA); PG8_STAGE(PG8_SB(0, 1), cB + hstep, voffB); PG8_STAGE(PG8_SA(0, 1), cA + hstepA, voffA);
        if (wr == 1) PG8_BAR;
        PG8_WAIT_V(4); PG8_BAR;
        PG8_STAGE(PG8_SB(1, 0), cB + kstep, voffB); PG8_STAGE(PG8_SA(1, 0), cA + kstep, voffA); PG8_STAGE(PG8_SB(1, 1), cB + hstep + kstep, voffB);
        PG8_WAIT_V(6); PG8_BAR;
    }
    PROBE_PT(lds, 1);
    for (;;) {
        const bool has_next = S.next(ui + 1, nxt);
        const char* nA = has_next ? (const char*)g.A + (size_t)nxt.pm * tstep : cA; const char* nB = has_next ? (const char*)g.Bt + (size_t)nxt.pn * tstep : cB;
        for (int t = 0; t < nt; t += 2) {
            const bool last = (t == nt - 2);
            const char* a1 = cA + (size_t)(t + 1) * kstep;
            const char* a2 = last ? nA : cA + (size_t)(t + 2) * kstep; const char* b2 = last ? nB : cB + (size_t)(t + 2) * kstep;
            const char* a3 = a2 + kstep; const char* b3 = b2 + kstep;
            if (last && has_next) S.a_ready(nxt);
            if constexpr (SP2) {
            PG8_LDB(B0, 0, 0); PG8_LDB(B1, 0, 1); PG8_SCHED; PG8_LDA(At, 0, 0); PG8_STAGE(PG8_SA(1, 1), a1 + hstepA, voffA);
            PG8_WAIT_V(8); PG8_WAIT_L(0); PG8_BAR; PG8_MMA(0, 0, At, B0); PG8_MMA(0, 1, At, B1); PG8_BAR; PG8_SCHED;
            PG8_LDA(At, 0, 1); PG8_STAGE(PG8_SB(0, 0), b2, voffB); PG8_STAGE(PG8_SB(0, 1), b2 + hstep, voffB); PG8_STAGE(PG8_SA(0, 0), a2, voffA);
            PG8_WAIT_V(8); PG8_WAIT_L(0); PG8_BAR; PG8_MMA(1, 0, At, B0); PG8_MMA(1, 1, At, B1); PG8_BAR; PG8_SCHED;
            PG8_LDB(B0, 1, 0); PG8_LDB(B1, 1, 1); PG8_SCHED; PG8_LDA(At, 1, 0); PG8_STAGE(PG8_SA(0, 1), a2 + hstepA, voffA);
            PG8_WAIT_V(8); PG8_WAIT_L(0); PG8_BAR; PG8_MMA(0, 0, At, B0); PG8_MMA(0, 1, At, B1); PG8_BAR; PG8_SCHED;
            PG8_LDA(At, 1, 1); PG8_STAGE(PG8_SB(1, 0), b3, voffB); PG8_STAGE(PG8_SB(1, 1), b3 + hstep, voffB); PG8_STAGE(PG8_SA(1, 0), a3, voffA);
            PG8_WAIT_V(8); PG8_WAIT_L(0); PG8_BAR; PG8_MMA(1, 0, At, B0); PG8_MMA(1, 1, At, B1); PG8_BAR; PG8_SCHED;
            } else {
            PG8_LDB(B0, 0, 0); PG8_SCHED; PG8_LDA(At, 0, 0); PG8_STAGE(PG8_SA(1, 1), a1 + hstepA, voffA);
            PG8_WAIT_L(8); PG8_BAR; PG8_WAIT_L(0); PG8_MMA(0, 0, At, B0); PG8_BAR; PG8_SCHED;
            PG8_LDB(B1, 0, 1); PG8_STAGE(PG8_SB(0, 0), b2, voffB);
            PG8_BAR; PG8_WAIT_L(0); PG8_MMA(0, 1, At, B1); PG8_BAR;
            PG8_LDA(At, 0, 1); PG8_STAGE(PG8_SA(0, 0), a2, voffA);
            PG8_BAR; PG8_WAIT_L(0); PG8_MMA(1, 0, At, B0); PG8_BAR; PG8_SCHED;
            PG8_STAGE(PG8_SB(0, 1), b2 + hstep, voffB);
            PG8_WAIT_V(6); PG8_BAR; PG8_MMA(1, 1, At, B1); PG8_BAR;
            PG8_LDB(B0, 1, 0); PG8_SCHED; PG8_LDA(At, 1, 0); PG8_STAGE(PG8_SA(0, 1), a2 + hstepA, voffA);
            PG8_WAIT_L(8); PG8_BAR; PG8_WAIT_L(0); PG8_MMA(0, 0, At, B0); PG8_BAR; PG8_SCHED;
            PG8_LDB(B1, 1, 1); PG8_STAGE(PG8_SB(1, 0), b3, voffB);
            PG8_BAR; PG8_WAIT_L(0); PG8_MMA(0, 1, At, B1); PG8_BAR;
            PG8_LDA(At, 1, 1); PG8_STAGE(PG8_SA(1, 0), a3, voffA);
            PG8_BAR; PG8_WAIT_L(0); PG8_MMA(1, 0, At, B0); PG8_BAR; PG8_SCHED;
            PG8_STAGE(PG8_SB(1, 1), b3 + hstep, voffB);
            PG8_WAIT_V(6); PG8_BAR; PG8_MMA(1, 1, At, B1); PG8_BAR;
            }
        }
        PROBE_PT(lds, 2);
        if constexpr (ALIGN_EPI) { if (wr == 0) PG8_BAR; }
        if constexpr (!Epi::AFTER_DRAIN) { E(acc, cur, wr, wc, fr, fq); S.done(cur); }
        PROBE_PT(lds, 3);
        if (!has_next) break;
#pragma unroll
        for (int a = 0; a < 2; ++a)
#pragma unroll
            for (int b = 0; b < 2; ++b)
#pragma unroll
                for (int m = 0; m < 4; ++m)
#pragma unroll
                    for (int n = 0; n < 2; ++n) acc[a][b][m][n] = (f32x4){0.f, 0.f, 0.f, 0.f};
        cur = nxt; cA = nA; cB = nB; ++ui;
        if constexpr (ALIGN_EPI) { if (wr == 1) PG8_BAR; }
    }
    PG8_WAIT_V(0);
    if constexpr (!ALIGN_EPI) { if (wr == 0) PG8_BAR; }
    PG8_BAR;
    if constexpr (Epi::AFTER_DRAIN) { E.fused(acc, cur, wr, wc, fr, fq, lds, wid, lane); S.done(cur); }
#undef PG8_SA
#undef PG8_SB
#undef PG8_STAGE
#undef PG8_LDA
#undef PG8_LDB
#undef PG8_MMA
#undef PG8_WAIT_V
#undef PG8_WAIT_L
#undef PG8_BAR
#undef PG8_SCHED
}
}

constexpr size_t WS_WGB = WS_WG + 192 * 1024;
constexpr size_t WS_MODP = 235 * MiB;
constexpr int NWAVES = 8, NTHREADS = 512;
constexpr int LDSCTL_OFF = 155648;
constexpr int LDS_BYTES = LDSCTL_OFF + 256;
struct Args {
    const float* in[21]; float* out; unsigned char* ws; int ph_lo, ph_hi;
};
struct Frame {
    LAS unsigned char* lds;
    int tid, lane, wave, G, bid;
    const __attribute__((address_space(4))) Args* ka;
    float* out; unsigned char* ws;
};
enum { IN_X = 0, IN_C, IN_CTX, IN_CCTX, IN_WMOD, IN_BMOD, IN_G1, IN_G2, IN_WIN, IN_AQG, IN_AKG, IN_SINK, IN_CGB, IN_RPB, IN_GGRP, IN_WOUT, IN_WUP, IN_CONVW, IN_CONVB, IN_WDN, IN_GFIN };

template <class MapFn>
__device__ __forceinline__ void transpose_item(const float* W, int K, int N, bf16_t* WT, LAS float* scr, int item, int lane, MapFn map) {
    const int nblk = (N + 63) / 64, kb = item / nblk, nb = item % nblk, k0 = 64 * kb, n0 = 64 * nb;
    const int nc = n0 + 4 * (lane & 15);
    f32x4 v[16];
#pragma unroll
    for (int i = 0; i < 16; ++i) { const int kk = (lane >> 4) + 4 * i; v[i] = nc < N ? *(const f32x4*)(W + (size_t)(k0 + kk) * N + nc) : (f32x4){0.f, 0.f, 0.f, 0.f}; }
#pragma unroll
    for (int i = 0; i < 16; ++i) { const int kk = (lane >> 4) + 4 * i; LAS float* d = scr + kk * 65 + 4 * (lane & 15); d[0] = v[i][0]; d[1] = v[i][1]; d[2] = v[i][2]; d[3] = v[i][3]; }
    LDS_WAIT(); asm volatile("" ::: "memory");
    const int c = lane & 7;
#pragma unroll
    for (int j = 0; j < 8; ++j) { const int n = (lane >> 3) + 8 * j; const LAS float* s = scr + (8 * c) * 65 + n;
        u32x4 o; o.x = cvtpk(s[0 * 65], s[1 * 65]); o.y = cvtpk(s[2 * 65], s[3 * 65]); o.z = cvtpk(s[4 * 65], s[5 * 65]); o.w = cvtpk(s[6 * 65], s[7 * 65]);
        const int sc = n0 + n; const int dr = sc < N ? map(sc) : -1;
        if (dr >= 0) *(u32x4*)(WT + (size_t)dr * K + k0 + 8 * c) = o; }
    LDS_WAIT(); asm volatile("" ::: "memory");
}
__device__ __forceinline__ void p0_prologue(Frame& F) {
    const float* c = F.ka->in[IN_C]; const float* cctx = F.ka->in[IN_CCTX];
    const int gw = F.bid * NWAVES + F.wave, NGW = F.G * NWAVES;
    if (F.bid < NLAYER * 48 || F.G < NLAYER * 48 + 8) {
        LAS float* sv = (LAS float*)F.lds;
        LAS float* red = (LAS float*)(F.lds + 12288);
        for (int i = F.tid; i < 3 * 1024; i += NTHREADS) { const int id = i >> 10, k = i & 1023; const float v = id < 2 ? c[id * 1024 + k] : cctx[k]; sv[i] = v / (1.f + __expf(-v)); }
        __syncthreads();
        float* MOD = (float*)(F.ws + WS_MOD);
        for (int it = F.bid; it < NLAYER * 48; it += F.G) {
            const int l = it / 48, nb = it % 48, n = nb * 128 + 2 * F.lane;
            const float* w = F.ka->in[IN_WMOD] + ((size_t)l * 1024 + F.wave * 128) * 6144 + n;
            f32x2 a0 = {0.f, 0.f}, a1 = {0.f, 0.f}, a2 = {0.f, 0.f};
#pragma unroll 32
            for (int k = 0; k < 128; ++k) { const f32x2 wv = *(const f32x2*)(w + (size_t)k * 6144); const int kk = F.wave * 128 + k; a0 += sv[kk] * wv; a1 += sv[1024 + kk] * wv; a2 += sv[2048 + kk] * wv; }
            *(LAS f32x2*)(red + (F.wave * 3 + 0) * 128 + 2 * F.lane) = a0; *(LAS f32x2*)(red + (F.wave * 3 + 1) * 128 + 2 * F.lane) = a1; *(LAS f32x2*)(red + (F.wave * 3 + 2) * 128 + 2 * F.lane) = a2;
            __syncthreads();
            if (F.tid < 384) { const int id = F.tid >> 7, ln = F.tid & 127; float s = F.ka->in[IN_BMOD][l * 6144 + nb * 128 + ln];
#pragma unroll
                for (int w8 = 0; w8 < 8; ++w8) s += red[(w8 * 3 + id) * 128 + ln];
                MOD[((size_t)l * 3 + id) * 6144 + nb * 128 + ln] = s; }
            __syncthreads();
        }
    }
    PROBE_PT(F.lds, 1);
    { const int b0 = F.G >= NLAYER * 48 + 8 ? NLAYER * 48 : 0, nb_ = F.G - b0;
      if (F.bid >= b0) { const int gt2 = (F.bid - b0) * NTHREADS + F.tid, NGT2 = nb_ * NTHREADS;
        float* ROPE = (float*)(F.ws + WS_ROPE); float* WG = (float*)(F.ws + WS_WG); bf16_t* WGB = (bf16_t*)(F.ws + WS_WGB);
        for (int e = gt2; e < 192 * 16 + NLAYER * 16 * 1024; e += NGT2) {
            if (e < 192 * 16) { const int idx = e >> 4, i = e & 15; const float pos = (float)(idx < 128 ? idx : idx - 128);
                const float freq = powf(10000.0f, -(float)i / 16.0f); const float ang = pos * freq; ROPE[2 * e] = cosf(ang); ROPE[2 * e + 1] = sinf(ang); }
            else { const int e2 = e - 192 * 16, l = e2 >> 14, o = (e2 >> 10) & 15, k = e2 & 1023; const float v = F.ka->in[IN_WIN][((size_t)l * 1024 + k) * DIN + 2048 + o]; WG[e2] = v; WGB[e2] = (bf16_t)(cvtpk(v, 0.f) & 0xffffu); } } } }
    PROBE_PT(F.lds, 2);
    LAS float* scr = (LAS float*)(F.lds + F.wave * 16896);
    constexpr int I_IN = 16 * 45, I_OUT = 16 * 16, I_UP = 16 * 88, I_DN = 44 * 16, I_L = I_IN + I_OUT + I_UP + I_DN;
    for (int it = gw; it < NLAYER * I_L; it += NGW) {
        const int l = it / I_L; int r = it % I_L;
        if (r < I_IN) { transpose_item(F.ka->in[IN_WIN] + (size_t)l * 1024 * DIN, 1024, DIN, (bf16_t*)(F.ws + WS_WIN) + (size_t)l * PP * 1024, scr, r, F.lane,
                                       [](int n) { return n < 2048 ? n : (n < 2064 ? -1 : n - 16); }); continue; } r -= I_IN;
        if (r < I_OUT) { transpose_item(F.ka->in[IN_WOUT] + (size_t)l * 1024 * 1024, 1024, 1024, (bf16_t*)(F.ws + WS_WOUT) + (size_t)l * 1024 * 1024, scr, r, F.lane, [](int n) { return n; }); continue; } r -= I_OUT;
        if (r < I_UP) { transpose_item(F.ka->in[IN_WUP] + (size_t)l * 1024 * DFF2, 1024, DFF2, (bf16_t*)(F.ws + WS_WUP) + (size_t)l * DFF2 * 1024, scr, r, F.lane,
                                       [](int n) { const int m = n < DFF ? n : n - DFF; return (m >> 7) * 256 + (n < DFF ? 0 : 128) + (m & 127); }); continue; } r -= I_UP;
        transpose_item(F.ka->in[IN_WDN] + (size_t)l * DFF * 1024, DFF, 1024, (bf16_t*)(F.ws + WS_WDN) + (size_t)l * 1024 * DFF, scr, r, F.lane, [](int n) { return n; });
    }
}

template <int R>
__device__ __forceinline__ void norm_rows(Frame& F, const float* xbase, int row0, const float* sh, const float* sc, const f32x4 (&gv)[4]) {
    bf16_t* H = (bf16_t*)(F.ws + WS_H);
    f32x4 hv[R][4]; float ss[R];
#pragma unroll
    for (int r = 0; r < R; ++r)
#pragma unroll
        for (int j = 0; j < 4; ++j) hv[r][j] = *(const f32x4*)(xbase + (size_t)r * DM + 4 * F.lane + 256 * j);
#pragma unroll
    for (int r = 0; r < R; ++r) { float s = 0.f;
#pragma unroll
        for (int j = 0; j < 4; ++j) s += (hv[r][j][0] * hv[r][j][0] + hv[r][j][1] * hv[r][j][1]) + (hv[r][j][2] * hv[r][j][2] + hv[r][j][3] * hv[r][j][3]);
        ss[r] = s; }
#pragma unroll
    for (int o = 1; o < 64; o <<= 1)
#pragma unroll
        for (int r = 0; r < R; ++r) ss[r] += shfl_x(ss[r], o, F.lane);
#pragma unroll
    for (int j = 0; j < 4; ++j) { const f32x4 scv = 1.f + *(const f32x4*)(sc + 4 * F.lane + 256 * j), shv = *(const f32x4*)(sh + 4 * F.lane + 256 * j);
#pragma unroll
        for (int r = 0; r < R; ++r) { const f32x4 v = hv[r][j] * rsqrtf(ss[r] * (1.f / DM) + EPS) * gv[j] * scv + shv;
            u32x2 w; w.x = cvtpk(v[0], v[1]); w.y = cvtpk(v[2], v[3]);
            *(u32x2*)(H + (size_t)(row0 + r) * DM + 4 * F.lane + 256 * j) = w; } }
}
__device__ __forceinline__ void norm_phase(Frame& F, int layer) {
    const int gw = F.bid * NWAVES + F.wave, NGW = F.G * NWAVES;
    const float* gvec = F.ka->in[IN_G1] + layer * 1024;
    const float* mod = (const float*)(F.ws + WS_MOD) + (size_t)layer * 3 * 6144;
    const float* xl = F.ka->in[IN_X]; const float* xc = F.ka->in[IN_CTX];
    f32x4 gv[4];
#pragma unroll
    for (int j = 0; j < 4; ++j) gv[j] = *(const f32x4*)(gvec + 4 * F.lane + 256 * j);
    for (int rg = gw; rg < NLAT / 8; rg += NGW) { const int row0 = rg * 8, id = row0 < SEQ ? 0 : 1; norm_rows<8>(F, xl + (size_t)row0 * DM, row0, mod + id * 6144, mod + id * 6144 + 1024, gv); }
    for (int rg = gw; rg < NBATCH * CTXL / 2; rg += NGW) { const int row0 = rg * 2; norm_rows<2>(F, xc + (size_t)row0 * DM, NLAT + row0, mod + 2 * 6144, mod + 2 * 6144 + 1024, gv); }
}

constexpr size_t WS_BIASG = WS_BIASIN + 64 * 1024;
__device__ __forceinline__ void bias_phase(Frame& F, int bslot, int nslots) {
    if (bslot < 0 && nslots > 0) return;
    if (nslots <= 0) { bslot = F.bid; nslots = F.G; }
    const int gw = bslot * NWAVES + F.wave, NGW = nslots * NWAVES, lane = F.lane, fr = lane & 15, fq = lane >> 4;
    const float* MOD = (const float*)(F.ws + WS_MOD);
    float* BUP = (float*)(F.ws + WS_BIASUP); float* BIN = (float*)(F.ws + WS_BIASIN); float* BG = (float*)(F.ws + WS_BIASG);
    constexpr int J_UP = DFF2 / 16, J_IN = PP / 16;
    for (int job = gw; job < 2 * J_UP + J_IN + 1; job += NGW) {
        const bool isup = job < 2 * J_UP, isin = !isup && job < 2 * J_UP + J_IN; const int l = isup ? job / J_UP : 1, r0 = 16 * (isup ? job % J_UP : (isin ? job - 2 * J_UP : 0));
        const bf16_t* wrow = isup ? (const bf16_t*)(F.ws + WS_WUP) + ((size_t)l * DFF2 + r0 + fr) * 1024 : (isin ? (const bf16_t*)(F.ws + WS_WIN) + ((size_t)PP + r0 + fr) * 1024 : (const bf16_t*)(F.ws + WS_WGB) + (size_t)(16 + fr) * 1024);
        const float* sh = MOD + ((size_t)l * 3 + (fr < 3 ? fr : 0)) * 6144 + (isup ? 3 * 1024 : 0) + 8 * fq;
        const bf16_t* bp = wrow + 8 * fq;
        f32x4 acc = {0.f, 0.f, 0.f, 0.f};
        for (int k0 = 0; k0 < DM / 32; k0 += 8) { f32x4 a0[8], a1[8]; bf16x8 bv[8];
#pragma unroll
            for (int j = 0; j < 8; ++j) { a0[j] = *(const f32x4*)(sh + 32 * (k0 + j)); a1[j] = *(const f32x4*)(sh + 32 * (k0 + j) + 4); bv[j] = *(const bf16x8*)(bp + 32 * (k0 + j)); }
#pragma unroll
            for (int j = 0; j < 8; ++j) { u32x4 aw; aw.x = cvtpk(a0[j][0], a0[j][1]); aw.y = cvtpk(a0[j][2], a0[j][3]); aw.z = cvtpk(a1[j][0], a1[j][1]); aw.w = cvtpk(a1[j][2], a1[j][3]);
                acc = __builtin_amdgcn_mfma_f32_16x16x32_bf16(__builtin_bit_cast(bf16x8, aw), bv[j], acc, 0, 0, 0); } }
        if (fq == 0) { const int r = r0 + fr;
            if (isup) { const int pn = r >> 8, i = r & 255; const int uc = i < 128 ? pn * 128 + i : DFF + pn * 128 + (i - 128);
                BUP[((size_t)l * 3 + 0) * DFF2 + uc] = acc[0]; BUP[((size_t)l * 3 + 1) * DFF2 + uc] = acc[1]; BUP[((size_t)l * 3 + 2) * DFF2 + uc] = acc[2]; }
            else if (isin) { BIN[r] = acc[0]; BIN[PP + r] = acc[1]; BIN[2 * PP + r] = acc[2]; }
            else { BG[fr] = acc[0]; BG[16 + fr] = acc[1]; BG[32 + fr] = acc[2]; } }
    }
}
__device__ __forceinline__ void gates_phase(Frame& F, int layer) {
    const int gw = F.bid * NWAVES + F.wave, NGW = F.G * NWAVES, lane = F.lane, fr = lane & 15, fq = lane >> 4;
    const bf16_t* H = (const bf16_t*)(F.ws + WS_H); const float* SSQ = (const float*)(F.ws + WS_SSQ1); const float* SSQC = (const float*)(F.ws + WS_SSQC1);
    const bf16_t* WGB = (const bf16_t*)(F.ws + WS_WGB) + (size_t)layer * 16 * 1024; const float* BG = (const float*)(F.ws + WS_BIASG);
    float* GATES = (float*)(F.ws + WS_GATES);
    for (int job = gw; job < NROWS / 16; job += NGW) {
        const int r0 = 16 * job; const int id = r0 < SEQ ? 0 : (r0 < NLAT ? 1 : 2);
        const bf16_t* ap = H + (size_t)(r0 + fr) * DM + 8 * fq; const bf16_t* bp = WGB + (size_t)fr * DM + 8 * fq;
        f32x4 acc = {0.f, 0.f, 0.f, 0.f};
        for (int k0 = 0; k0 < DM / 32; k0 += 16) { bf16x8 av[16], bv[16];
#pragma unroll
            for (int j = 0; j < 16; ++j) { av[j] = *(const bf16x8*)(ap + 32 * (k0 + j)); bv[j] = *(const bf16x8*)(bp + 32 * (k0 + j)); }
#pragma unroll
            for (int j = 0; j < 16; ++j) acc = __builtin_amdgcn_mfma_f32_16x16x32_bf16(av[j], bv[j], acc, 0, 0, 0); }
        float rs[4] = {1.f, 1.f, 1.f, 1.f}, bo = 0.f;
        if (layer > 0) {
            float s = 0.f;
            if (r0 < NLAT) { const f32x4 a = *(const f32x4*)(SSQ + (size_t)(r0 + (lane >> 2)) * 16 + 4 * (lane & 3)); s = (a[0] + a[1]) + (a[2] + a[3]); }
            else { const float* p = SSQC + (size_t)(r0 - NLAT + (lane >> 2)) * 64 + 16 * (lane & 3);
#pragma unroll
                for (int j = 0; j < 4; ++j) { const f32x4 a = *(const f32x4*)(p + 4 * j); s += (a[0] + a[1]) + (a[2] + a[3]); } }
            s += shfl_x(s, 1, lane); s += shfl_x(s, 2, lane);
            const float rr = rsqrtf(s * (1.f / DM) + EPS);
#pragma unroll
            for (int r = 0; r < 4; ++r) rs[r] = shfl_idx(rr, 4 * (4 * fq + r));
            bo = BG[id * 16 + fr];
        }
#pragma unroll
        for (int r = 0; r < 4; ++r) GATES[(size_t)(r0 + 4 * fq + r) * 16 + fr] = acc[r] * rs[r] + bo;
    }
}

__device__ __forceinline__ void postproj_phase(Frame& F, int layer) {
    const int gw = F.bid * NWAVES + F.wave, NGW = F.G * NWAVES;
    bf16_t* PROJ = (bf16_t*)(F.ws + WS_PROJ);
    const float* ROPE = (const float*)(F.ws + WS_ROPE);
    const int sub = F.lane >> 4, l16 = F.lane & 15, d = 4 * l16;
    const f32x4 gq = *(const f32x4*)(F.ka->in[IN_AQG] + layer * 64 + d), gk = *(const f32x4*)(F.ka->in[IN_AKG] + layer * 64 + d);
    const bool x2 = (l16 & 4) != 0;
    for (int rg = gw; rg < NROWS / 4; rg += NGW) {
        const int row0 = 4 * rg; const bool lat = row0 < NLAT;
        u32x2 w[4][3]; f32x4 cs0[4], cs1[4];
#pragma unroll
        for (int q = 0; q < 4; ++q) { const bf16_t* pr = PROJ + (size_t)(row0 + q) * PP; const int t = (row0 + q) & (SEQ - 1);
            cs0[q] = (f32x4){1.f, 0.f, 1.f, 0.f}; cs1[q] = cs0[q];
            if (lat) { const int idx = (d >> 5) ? 128 + (t & 63) : (t >> 6); const float* rp = ROPE + ((size_t)idx * 16 + (d & 15)) * 2; cs0[q] = *(const f32x4*)rp; cs1[q] = *(const f32x4*)(rp + 4); }
#pragma unroll
            for (int pass = 0; pass < 3; ++pass) { const int col = pass == 0 ? PC_AQ + 64 * sub + d : (pass == 1 ? (sub < 2 ? PC_AK + 64 * sub + d : PC_BK + 64 * (sub - 2) + d) : PC_BQ + 64 * sub + d);
                w[q][pass] = *(const u32x2*)(pr + col); } }
#pragma unroll
        for (int q = 0; q < 4; ++q) { bf16_t* pr = PROJ + (size_t)(row0 + q) * PP;
            const float cz[4] = {cs0[q][0], cs0[q][2], cs1[q][0], cs1[q][2]}, sz[4] = {cs0[q][1], cs0[q][3], cs1[q][1], cs1[q][3]};
#pragma unroll
            for (int pass = 0; pass < 3; ++pass) {
                const int col = pass == 0 ? PC_AQ + 64 * sub + d : (pass == 1 ? (sub < 2 ? PC_AK + 64 * sub + d : PC_BK + 64 * (sub - 2) + d) : PC_BQ + 64 * sub + d);
                const bool donorm = pass == 0 || (pass == 1 && sub < 2);
                const bool active = lat || donorm;
                if (!lat && pass == 2) continue;
                float v[4] = {bflo(w[q][pass].x), bfhi(w[q][pass].x), bflo(w[q][pass].y), bfhi(w[q][pass].y)};
                float ss = (v[0] * v[0] + v[1] * v[1]) + (v[2] * v[2] + v[3] * v[3]);
                ss += shfl_x(ss, 1, F.lane); ss += shfl_x(ss, 2, F.lane); ss += shfl_x(ss, 4, F.lane); ss += shfl_x(ss, 8, F.lane);
                if (donorm) { const float rstd = rsqrtf(ss * (1.f / 64.f) + EPS) * (pass == 0 ? QSCALE2 : 1.f); const f32x4 g = pass == 0 ? gq : gk;
#pragma unroll
                    for (int e = 0; e < 4; ++e) v[e] = v[e] * rstd * g[e]; }
                float o[4];
#pragma unroll
                for (int e = 0; e < 4; ++e) { const float p = shfl_x(v[e], 4, F.lane); o[e] = x2 ? (p * sz[e] + v[e] * cz[e]) : (v[e] * cz[e] - p * sz[e]); }
                if (active) { u32x2 ow; ow.x = cvtpk(o[0], o[1]); ow.y = cvtpk(o[2], o[3]); *(u32x2*)(pr + col) = ow; }
            } }
    }
}

template <bool WT = false>
__device__ __forceinline__ void groupnorm_rows(Frame& F, int layer, int row0, int nrows, int wv, int nw) {
    const bf16_t* H = (const bf16_t*)(F.ws + WS_H); bf16_t* YN = (bf16_t*)(F.ws + WS_PROJ);
    const float* gg = F.ka->in[IN_GGRP] + layer * 1024;
    f32x4 gv[4];
#pragma unroll
    for (int j = 0; j < 4; ++j) gv[j] = *(const f32x4*)(gg + 4 * F.lane + 256 * j);
    for (int r = 4 * wv; r < nrows; r += 4 * nw) {
        u32x2 w[4][4]; float ss[4][4];
#pragma unroll
        for (int q = 0; q < 4; ++q)
#pragma unroll
            for (int j = 0; j < 4; ++j) w[q][j] = *(const u32x2*)(H + (size_t)(row0 + r + q) * DM + 4 * F.lane + 256 * j);
#pragma unroll
        for (int q = 0; q < 4; ++q)
#pragma unroll
            for (int j = 0; j < 4; ++j) { const float v0 = bflo(w[q][j].x), v1 = bfhi(w[q][j].x), v2 = bflo(w[q][j].y), v3 = bfhi(w[q][j].y); ss[q][j] = (v0 * v0 + v1 * v1) + (v2 * v2 + v3 * v3); }
#pragma unroll
        for (int o = 1; o < 64; o <<= 1)
#pragma unroll
            for (int q = 0; q < 4; ++q)
#pragma unroll
                for (int j = 0; j < 4; ++j) ss[q][j] += shfl_x(ss[q][j], o, F.lane);
#pragma unroll
        for (int q = 0; q < 4; ++q)
#pragma unroll
            for (int j = 0; j < 4; ++j) { const float rstd = rsqrtf(ss[q][j] * (1.f / 256.f) + EPS);
                u32x2 o; o.x = cvtpk(bflo(w[q][j].x) * rstd * gv[j][0], bfhi(w[q][j].x) * rstd * gv[j][1]); o.y = cvtpk(bflo(w[q][j].y) * rstd * gv[j][2], bfhi(w[q][j].y) * rstd * gv[j][3]);
                if (WT) __hip_atomic_store((unsigned long long*)(YN + (size_t)(row0 + r + q) * DM + 4 * F.lane + 256 * j), (unsigned long long)o.x | ((unsigned long long)o.y << 32), __ATOMIC_RELAXED, __HIP_MEMORY_SCOPE_AGENT);
                else *(u32x2*)(YN + (size_t)(row0 + r + q) * DM + 4 * F.lane + 256 * j) = o; }
    }
}

__device__ __forceinline__ void fixup_hts(Frame& F, int layer, int ht0, int nht) {
    const float* edge = (const float*)(F.ws + WS_EDGE);
    const float* cw = F.ka->in[IN_CONVW] + (size_t)layer * 3 * DFF2; const float* cb = F.ka->in[IN_CONVB] + (size_t)layer * DFF2;
    bf16_t* act = (bf16_t*)(F.ws + WS_PROJ);
    const int per_row = DFF / 4;
    for (int it = F.tid; it < nht * 2 * per_row; it += NTHREADS) {
        const int ch = (it % per_row) * 4, rr = it / per_row, ht = ht0 + (rr >> 1), last = rr & 1;
        const bool seq_start = (ht == 0 || ht == 64 || ht == 128 || ht == 130), seq_end = (ht == 63 || ht == 127 || ht == 129 || ht == 131);
        const int row = ht * 128 + (last ? 127 : 0);
        f32x4 o;
        f32x4 res[2];
#pragma unroll
        for (int gvv = 0; gvv < 2; ++gvv) { const int uc = gvv * DFF + ch;
            const f32x4 z = {0.f, 0.f, 0.f, 0.f};
            f32x4 up, ucur, un;
            if (!last) { up = seq_start ? z : *(const f32x4*)(edge + ((size_t)(ht - 1) * 4 + 3) * DFF2 + uc); ucur = *(const f32x4*)(edge + ((size_t)ht * 4 + 0) * DFF2 + uc); un = *(const f32x4*)(edge + ((size_t)ht * 4 + 1) * DFF2 + uc); }
            else { up = *(const f32x4*)(edge + ((size_t)ht * 4 + 2) * DFF2 + uc); ucur = *(const f32x4*)(edge + ((size_t)ht * 4 + 3) * DFF2 + uc); un = seq_end ? z : *(const f32x4*)(edge + ((size_t)(ht + 1) * 4 + 0) * DFF2 + uc); }
            res[gvv] = *(const f32x4*)(cw + uc) * up + *(const f32x4*)(cw + DFF2 + uc) * ucur + *(const f32x4*)(cw + 2 * DFF2 + uc) * un + *(const f32x4*)(cb + uc); }
#pragma unroll
        for (int j = 0; j < 4; ++j) o[j] = res[0][j] / (1.f + __expf(-res[0][j])) * res[1][j];
        u32x2 w; w.x = cvtpk(o[0], o[1]); w.y = cvtpk(o[2], o[3]);
        *(u32x2*)(act + (size_t)row * DFF + ch) = w;
    }
}

template <int KDIM>
__device__ __forceinline__ void skinny_ctx(Frame& F, const bf16_t* A  , const bf16_t* Wt  , const float* xin, float* xout, const float* gate  ,
                                           bf16_t* xg  , const float* gn, const float* scn  , float* ssqc) {
    const int lane = F.lane, fr = lane & 15, fq = lane >> 4, t = F.tid, ldrow = t >> 3, chunk = t & 7;
    const int rf = F.wave >> 1, cp = F.wave & 1;
    constexpr int RSB = 144, BUFB = 64 * RSB, NKB = KDIM / 64;
    for (int p = F.bid; p < 128; p += F.G) {
        const int rg = p >> 4, cg = p & 15;
        if (KDIM == DM) { groupnorm_rows<false>(F, 0, NLAT + 64 * rg, 64, F.wave, NWAVES); VM_WAIT(); __syncthreads(); }
        const bf16_t* asrc = A + (size_t)(64 * rg + ldrow) * KDIM + 8 * chunk; const bf16_t* bsrc = Wt + (size_t)(64 * cg + ldrow) * KDIM + 8 * chunk;
        u32x4 ra[4], rb[4];
#pragma unroll
        for (int i = 0; i < 4; ++i) { ra[i] = *(const u32x4*)(asrc + 64 * i); rb[i] = *(const u32x4*)(bsrc + 64 * i); }
        f32x4 acc[2] = {{0.f, 0.f, 0.f, 0.f}, {0.f, 0.f, 0.f, 0.f}};
        __syncthreads();
        for (int kb0 = 0; kb0 < NKB; kb0 += 4) {
#pragma unroll
            for (int i = 0; i < 4; ++i) { const int kb = kb0 + i; LAS unsigned char* ba = F.lds + (kb & 1) * 2 * BUFB; LAS unsigned char* bb = ba + BUFB;
                *(LAS u32x4*)(ba + ldrow * RSB + 16 * chunk) = ra[i]; *(LAS u32x4*)(bb + ldrow * RSB + 16 * chunk) = rb[i];
                if (kb + 4 < NKB) { ra[i] = *(const u32x4*)(asrc + 64 * (kb + 4)); rb[i] = *(const u32x4*)(bsrc + 64 * (kb + 4)); }
                __syncthreads();
#pragma unroll
                for (int ks = 0; ks < 2; ++ks) { const bf16x8 af = *(const LAS bf16x8*)(ba + (16 * rf + fr) * RSB + 64 * ks + 16 * fq);
#pragma unroll
                    for (int j = 0; j < 2; ++j) { const bf16x8 bf = *(const LAS bf16x8*)(bb + (32 * cp + 16 * j + fr) * RSB + 64 * ks + 16 * fq); acc[j] = __builtin_amdgcn_mfma_f32_16x16x32_bf16(af, bf, acc[j], 0, 0, 0); } }
            }
        }
        float ss[4] = {0.f, 0.f, 0.f, 0.f};
#pragma unroll
        for (int j = 0; j < 2; ++j) { const int n = 64 * cg + 32 * cp + 16 * j + fr; const float g = gate[n], gs = gn[n] * (1.f + scn[n]);
#pragma unroll
            for (int r = 0; r < 4; ++r) { const int row = 64 * rg + 16 * rf + 4 * fq + r; const float o = xin[(size_t)row * DM + n] + g * acc[j][r];
                xout[(size_t)row * DM + n] = o; xg[(size_t)row * DM + n] = (bf16_t)(cvtpk(o * gs, 0.f) & 0xffffu); ss[r] += o * o; } }
#pragma unroll
        for (int r = 0; r < 4; ++r) { float s = ss[r]; s += shfl_x(s, 1, lane); s += shfl_x(s, 2, lane); s += shfl_x(s, 4, lane); s += shfl_x(s, 8, lane);
            if (fr == 0) { float* sp = ssqc + (size_t)(64 * rg + 16 * rf + 4 * fq + r) * 64 + cg * 2 + cp; sp[0] = s; sp[32] = 0.f; } }
        __syncthreads();
    }
}

__device__ __forceinline__ void final_phase(Frame& F) {
    const int gw = F.bid * NWAVES + F.wave, NGW = F.G * NWAVES;
    const float* gf = F.ka->in[IN_GFIN];
    f32x4 gv[4];
#pragma unroll
    for (int j = 0; j < 4; ++j) gv[j] = *(const f32x4*)(gf + 4 * F.lane + 256 * j);
    for (int rg = gw; rg < NLAT / 8; rg += NGW) {
        float* xr = F.out + (size_t)rg * 8 * DM + 4 * F.lane;
        f32x4 v[8][4]; float ss[8];
#pragma unroll
        for (int r = 0; r < 8; ++r)
#pragma unroll
            for (int j = 0; j < 4; ++j) v[r][j] = *(const f32x4*)(xr + (size_t)r * DM + 256 * j);
#pragma unroll
        for (int r = 0; r < 8; ++r) { float s = 0.f;
#pragma unroll
            for (int j = 0; j < 4; ++j) s += (v[r][j][0] * v[r][j][0] + v[r][j][1] * v[r][j][1]) + (v[r][j][2] * v[r][j][2] + v[r][j][3] * v[r][j][3]);
            ss[r] = s; }
#pragma unroll
        for (int o = 1; o < 64; o <<= 1)
#pragma unroll
            for (int r = 0; r < 8; ++r) ss[r] += shfl_x(ss[r], o, F.lane);
#pragma unroll
        for (int r = 0; r < 8; ++r) { const float rstd = rsqrtf(ss[r] * (1.f / DM) + EPS);
#pragma unroll
            for (int j = 0; j < 4; ++j) *(f32x4*)(xr + (size_t)r * DM + 256 * j) = v[r][j] * rstd * gv[j]; }
    }
}

typedef GAS unsigned gu32;
#define RLX_AGENT __ATOMIC_RELAXED, __HIP_MEMORY_SCOPE_AGENT
constexpr int CW_BAR = 4096;
#define XB_TMO      128
#define XB_XCNT(j)  (256  + 64 * (j))
#define XB_XSUB(j)  (1280 + 64 * (j))
#define XB_XGEN(j)  (2304 + 64 * (j))
#define XB_TOP      3328
#define XB_TOPGEN   3392
#define XCD_BAR_WORDS 3456
#define XB_SPIN_CAP (1u << 18)

__device__ __forceinline__ unsigned xb_ld(unsigned* p)              { return __hip_atomic_load(p, __ATOMIC_RELAXED, __HIP_MEMORY_SCOPE_AGENT); }
__device__ __forceinline__ unsigned xb_add(unsigned* p, unsigned v) { return __hip_atomic_fetch_add(p, v, __ATOMIC_RELAXED, __HIP_MEMORY_SCOPE_AGENT); }
__device__ __forceinline__ unsigned xb_xcc_id() { return (unsigned)__builtin_amdgcn_s_getreg((3 << 11) | 20) & 0xFu; }
#define XB_SPIN(cond, bar) do { unsigned _sp = 0; while (cond) { __builtin_amdgcn_s_sleep(1); \
    if ((++_sp & 255u) == 0u) { if (xb_ld(&(bar)[XB_TMO])) break; if (_sp > XB_SPIN_CAP) { atomicAdd(&(bar)[XB_TMO], 1u); break; } } } } while (0)

struct XcdBarrier {
    unsigned* bar; unsigned x;
    volatile LAS unsigned* st;
};

__device__ __forceinline__ XcdBarrier xcd_barrier_post(unsigned* bar, volatile LAS unsigned* st, bool is_t0) {
    XcdBarrier b; b.bar = bar; b.x = xb_xcc_id(); b.st = st;
    if (is_t0) (void)xb_add(&bar[XB_XCNT(b.x)], 1u);
    return b;
}
__device__ __forceinline__ void xcd_barrier_complete(unsigned* bar, unsigned x, unsigned& nloc, unsigned& nx) {
    const unsigned G = gridDim.x * gridDim.y * gridDim.z;
    unsigned sum, cnt, mine, sp = 0u;
    for (;;) {
        sum = 0u; cnt = 0u; mine = 0u;
#pragma unroll
        for (unsigned j = 0; j < 16; ++j) { const unsigned c = xb_ld(&bar[XB_XCNT(j)]); sum += c; cnt += (c > 0u) ? 1u : 0u; mine = (j == x) ? c : mine; }
        if (sum == G) break;
        __builtin_amdgcn_s_sleep(1);
        if ((++sp & 255u) == 0u) { if (xb_ld(&bar[XB_TMO])) break; if (sp > XB_SPIN_CAP) { atomicAdd(&bar[XB_TMO], 1u); break; } }
    }
    nloc = mine > 0u ? mine : 1u; nx = cnt > 0u ? cnt : 1u;
}

__device__ __forceinline__ void xcd_barrier(const XcdBarrier& b, bool is_t0) {
    asm volatile("s_waitcnt vmcnt(0)" ::: "memory");
    __syncthreads();
    if (is_t0) {
        unsigned* bar = b.bar;
        __builtin_amdgcn_s_waitcnt(0);
        unsigned nloc = b.st[0], nx = b.st[1];
        if (nloc == 0u) { xcd_barrier_complete(bar, b.x, nloc, nx); b.st[0] = nloc; b.st[1] = nx; }
        const unsigned old = xb_add(&bar[XB_XSUB(b.x)], 1u);
        const unsigned gen = old / nloc;
        if (old + 1u == (gen + 1u) * nloc) {
            __builtin_amdgcn_fence(__ATOMIC_RELEASE, "agent");
            asm volatile("s_waitcnt vmcnt(0)" ::: "memory");
            const unsigned og = xb_add(&bar[XB_TOP], 1u);
            const unsigned tg = og / nx;
            if (og + 1u == (tg + 1u) * nx) xb_add(&bar[XB_TOPGEN], 1u);
            else XB_SPIN(xb_ld(&bar[XB_TOPGEN]) == tg, bar);
            __builtin_amdgcn_fence(__ATOMIC_ACQUIRE, "agent");
            xb_add(&bar[XB_XGEN(b.x)], 1u);
            asm volatile("s_waitcnt vmcnt(0)" ::: "memory");
        } else {
            XB_SPIN(xb_ld(&bar[XB_XGEN(b.x)]) == gen, bar);
            __builtin_amdgcn_fence(__ATOMIC_ACQUIRE, "agent");
            asm volatile("s_waitcnt vmcnt(0)" ::: "memory");
        }
    }
    __syncthreads();
}

namespace att {
constexpr int SLOTB = 8192;
constexpr int L_K = 0, L_V = 2 * SLOTB, L_WS = 4 * SLOTB, L_OST = L_WS + 8 * 256, L_RPB = L_OST + 8 * 4096, L_END = L_RPB + 2048;
constexpr float THR = 8.0f;
__device__ __forceinline__ int crow(int r, int hi) { return (r & 3) + 8 * (r >> 2) + 4 * hi; }
__device__ __forceinline__ s16x4 vtr(const LAS unsigned char* p) { return __builtin_bit_cast(s16x4, __builtin_amdgcn_ds_read_tr16_b64_v4i16((LAS v4i16_t*)p)); }
__device__ __forceinline__ float rowmax32(const f32x16& p0, const f32x16& p1) {
    float a = fmaxf(p0[0], p1[0]);
#pragma unroll
    for (int r = 1; r < 16; ++r) a = fmaxf(a, fmaxf(p0[r], p1[r]));
    auto rr = __builtin_amdgcn_permlane32_swap(__float_as_uint(a), __float_as_uint(a), false, false);
    return fmaxf(__uint_as_float(rr[0]), __uint_as_float(rr[1]));
}
__device__ __forceinline__ float halfsum(float v) {
    auto rr = __builtin_amdgcn_permlane32_swap(__float_as_uint(v), __float_as_uint(v), false, false);
    return __uint_as_float(rr[0]) + __uint_as_float(rr[1]);
}
#define ATT_WAIT_BAR() asm volatile("s_waitcnt vmcnt(0) lgkmcnt(0)\n\ts_barrier" ::: "memory")

template <int MODE>
__device__ __forceinline__ void attn_unit(Frame& F, int b, int h, int qb, int qcol, int kcol, int vcol, int ycol, float sink2, const float* rpb) {
    LAS unsigned char* lds = F.lds;
    const int lane = F.lane, r32 = lane & 31, hi = lane >> 5, wid = F.wave;
    const bf16_t* PROJ = (const bf16_t*)(F.ws + WS_PROJ); bf16_t* Y = (bf16_t*)(F.ws + WS_H);
    const int ctxrow = NLAT + CTXL * b, latrow = SEQ * b;
    const int qrow0 = (MODE == 3) ? ctxrow : latrow + 256 * qb;
    const int qw0 = 256 * qb + 32 * wid;
    int lt_lo = 0, nloc = 0;
    if (MODE == 0) { lt_lo = 0; nloc = 128; }
    if (MODE == 1) { const int a = (256 * qb - 128) >> 6, e = (256 * qb + 255 + 128) >> 6; lt_lo = a < 0 ? 0 : a; nloc = (e > 127 ? 127 : e) - lt_lo + 1; }
    if (MODE == 2) { const int a = 4 * qb - 4, e0 = 4 * qb - 1; lt_lo = a < 0 ? 0 : (a > 120 ? 120 : a); const int e = (e0 < 0 ? 0 : (e0 > 120 ? 120 : e0)) + 7; nloc = e - lt_lo + 1; }
    const int NT = 4 + nloc;
    const int rw = 4 * qb + (wid >> 1); const int rs = rw - 4 < 0 ? 0 : (rw - 4 > 120 ? 120 : rw - 4);
    const int qc = 32 * (wid & 1) + r32; const int cs = qc - 8 < 0 ? 0 : (qc - 8 > 48 ? 48 : qc - 8);
    LAS float* wsf = (LAS float*)(lds + L_WS) + wid * 64;
    LAS float* rpbL = (LAS float*)(lds + L_RPB);
    if (MODE == 2) { for (int i = F.tid; i < 465; i += NTHREADS) rpbL[i] = rpb[i] * LOG2E; }
    const int vp0 = ((lane >> 4) & 1) * 32 + (lane & 3) * 8 + (4 * hi + ((lane & 15) >> 2)) * 64;
#define ATT_KROW(t) ((t) < 4 ? ctxrow + 64 * (t) : latrow + 64 * (lt_lo + (t) - 4))
#define ATT_DMA(t, slot) do { const int kr_ = ATT_KROW(t); \
        __builtin_amdgcn_global_load_lds((const unsigned*)(PROJ + (size_t)(kr_ + lane) * PP + kcol + wid * 8), (LAS unsigned*)(lds + L_K + (slot) * SLOTB + wid * 1024), 16, 0, 0); \
        __builtin_amdgcn_global_load_lds((const unsigned*)(PROJ + (size_t)(kr_ + 16 * (wid & 3) + (lane >> 2)) * PP + vcol + (wid >> 2) * 32 + (lane & 3) * 8), (LAS unsigned*)(lds + L_V + (slot) * SLOTB + wid * 1024), 16, 0, 0); } while (0)
    ATT_DMA(0, 0);
    bf16x8 qr[4];
#pragma unroll
    for (int d0 = 0; d0 < 4; ++d0) qr[d0] = *(const bf16x8*)(PROJ + (size_t)(qrow0 + 32 * wid + r32) * PP + qcol + d0 * 16 + hi * 8);
    float mhat = 0.f, l = 0.f; f32x16 o0 = {}, o1 = {}, negm = {};
    ATT_WAIT_BAR();
    for (int t = 0; t < NT; ++t) {
        const int slot = t & 1;
        if (t + 1 < NT) ATT_DMA(t + 1, slot ^ 1);
        bool rel = true; int kb0 = 0;
        if (MODE == 1 && t >= 4) { kb0 = 64 * (lt_lo + t - 4); rel = (kb0 + 63 >= qw0 - 128) && (kb0 <= qw0 + 31 + 128); }
        if (MODE == 2 && t >= 4) { kb0 = lt_lo + t - 4; rel = (kb0 >= rs) && (kb0 < rs + 8); }
        if (rel) {
            const LAS unsigned char* kb = lds + L_K + slot * SLOTB + hi * 1024 + r32 * 16;
            f32x16 p0 = negm, p1 = negm;
#pragma unroll
            for (int d0 = 0; d0 < 4; ++d0) {
                const bf16x8 b0 = *(const LAS bf16x8*)(kb + d0 * 2048), b1 = *(const LAS bf16x8*)(kb + d0 * 2048 + 512);
                p0 = __builtin_amdgcn_mfma_f32_32x32x16_bf16(b0, qr[d0], p0, 0, 0, 0);
                p1 = __builtin_amdgcn_mfma_f32_32x32x16_bf16(b1, qr[d0], p1, 0, 0, 0);
            }
            if (MODE == 1 && t >= 4) {
                const int dq = kb0 - (qw0 + r32);
#pragma unroll
                for (int r = 0; r < 16; ++r) { const int kc = crow(r, hi); const int d0_ = dq + kc, d1_ = d0_ + 32;
                    if (d0_ > 128 || d0_ < -128) p0[r] = -INFINITY; if (d1_ > 128 || d1_ < -128) p1[r] = -INFINITY; }
            }
            if (MODE == 2 && t >= 4) {
                const LAS float* bt = rpbL + (kb0 - rw + 7) * 31 + (15 - qc);
#pragma unroll
                for (int r = 0; r < 16; ++r) { const int kc = crow(r, hi);
                    const bool v0 = (kc >= cs) && (kc < cs + 16), v1 = (kc + 32 >= cs) && (kc + 32 < cs + 16);
                    p0[r] = v0 ? p0[r] + bt[v0 ? kc : qc] : -INFINITY; p1[r] = v1 ? p1[r] + bt[v1 ? kc + 32 : qc] : -INFINITY; }
            }
            const float rm = rowmax32(p0, p1);
            if (t == 0 || __any(rm > THR)) {
                const float dl = (t == 0) ? rm : fmaxf(rm, 0.f);
                mhat += dl;
#pragma unroll
                for (int r = 0; r < 16; ++r) { p0[r] -= dl; p1[r] -= dl; negm[r] = -mhat; }
                if (t > 0) { const float f = __builtin_amdgcn_exp2f(-dl); l *= f; if (hi == 0) wsf[r32] = f; LDS_WAIT();
#pragma unroll
                    for (int r = 0; r < 16; ++r) { const float fr_ = wsf[crow(r, hi)]; o0[r] *= fr_; o1[r] *= fr_; }
                    LDS_WAIT(); }
            }
            float ls = 0.f;
#pragma unroll
            for (int r = 0; r < 16; ++r) { p0[r] = __builtin_amdgcn_exp2f(p0[r]); p1[r] = __builtin_amdgcn_exp2f(p1[r]); ls += p0[r] + p1[r]; }
            l += ls;
            u32x4 pw[4];
#pragma unroll
            for (int k = 0; k < 4; ++k) { pw[0][k] = cvtpk(p0[2 * k], p0[2 * k + 1]); pw[1][k] = cvtpk(p0[8 + 2 * k], p0[9 + 2 * k]); pw[2][k] = cvtpk(p1[2 * k], p1[2 * k + 1]); pw[3][k] = cvtpk(p1[8 + 2 * k], p1[9 + 2 * k]); }
            const LAS unsigned char* vb = lds + L_V + slot * SLOTB + vp0;
#pragma unroll
            for (int ks = 0; ks < 4; ++ks) {
                const s16x4 a0 = vtr(vb + ks * 1024), a1 = vtr(vb + ks * 1024 + 512), c0 = vtr(vb + 4096 + ks * 1024), c1 = vtr(vb + 4096 + ks * 1024 + 512);
                const bf16x8 v0 = {a0[0], a0[1], a0[2], a0[3], a1[0], a1[1], a1[2], a1[3]}, v1 = {c0[0], c0[1], c0[2], c0[3], c1[0], c1[1], c1[2], c1[3]};
                o0 = __builtin_amdgcn_mfma_f32_32x32x16_bf16(__builtin_bit_cast(bf16x8, pw[ks]), v0, o0, 0, 0, 0);
                o1 = __builtin_amdgcn_mfma_f32_32x32x16_bf16(__builtin_bit_cast(bf16x8, pw[ks]), v1, o1, 0, 0, 0);
            }
        }
        ATT_WAIT_BAR();
    }
    l = halfsum(l);
    if (MODE == 1 || MODE == 3) l += __builtin_amdgcn_exp2f(sink2 - mhat);
    if (hi == 0) wsf[32 + r32] = l;
    LDS_WAIT();
    bf16_t* stg = (bf16_t*)(lds + L_OST + wid * 4096);
    LAS bf16_t* stgl = (LAS bf16_t*)(lds + L_OST + wid * 4096);
#pragma unroll
    for (int r = 0; r < 16; ++r) { const int orow = crow(r, hi); const float rl = __builtin_amdgcn_rcpf(wsf[32 + orow]);
        stgl[orow * 64 + r32] = (bf16_t)(cvtpk(o0[r] * rl, 0.f) & 0xffffu); stgl[orow * 64 + 32 + r32] = (bf16_t)(cvtpk(o1[r] * rl, 0.f) & 0xffffu); }
    LDS_WAIT();
    (void)stg;
#pragma unroll
    for (int i = 0; i < 4; ++i) { const int row = i * 8 + (lane >> 3), ch = lane & 7; const u32x4 v = *(const LAS u32x4*)(stgl + row * 64 + ch * 8);
        *(u32x4*)(Y + (size_t)(qrow0 + 32 * wid + row) * DM + ycol + ch * 8) = v; }
    LDS_WAIT();
#undef ATT_KROW
#undef ATT_DMA
}
}

namespace ml {
__device__ __forceinline__ float scan_add(float v, int lane, int dir) {
#pragma unroll
    for (int o = 1; o < 64; o <<= 1) { const float t = shfl_idx(v, (dir ? lane + o : lane - o) & 63); const bool ok = dir ? (lane + o < 64) : (lane >= o); v += ok ? t : 0.f; }
    return v;
}
__device__ __forceinline__ float scan_max(float v, int lane, int dir) {
#pragma unroll
    for (int o = 1; o < 64; o <<= 1) { const float t = shfl_idx(v, (dir ? lane + o : lane - o) & 63); const bool ok = dir ? (lane + o < 64) : (lane >= o); v = ok ? fmaxf(v, t) : v; }
    return v;
}
__device__ __forceinline__ float logsigmoid(float x) { return fminf(x, 0.f) - log1pf(__expf(-fabsf(x))); }
__device__ __forceinline__ int img_off(int tok, int d) { return (d >> 5) * 4096 + (tok >> 4) * 1024 + (tok & 15) * 64 + (d & 31) * 2; }
__device__ __forceinline__ int blk_row0(int b, int blk) { return blk < 4 ? NLAT + CTXL * b + 64 * blk : SEQ * b + 64 * (blk - 4); }
__device__ __forceinline__ int chunk_of(int dir, int blk) { return dir == 0 ? blk : (blk < 4 ? 3 - blk : 4 + 127 - (blk - 4)); }

__device__ __forceinline__ void pass1(Frame& F, int layer) {
    const int gw = F.bid * NWAVES + F.wave, NGW = F.G * NWAVES, lane = F.lane, r32 = lane & 31, hi = lane >> 5;
    LAS unsigned char* wl = F.lds + F.wave * 16384;
    const bf16_t* PROJ = (const bf16_t*)(F.ws + WS_PROJ); const float* GATES = (const float*)(F.ws + WS_GATES);
    const float* gb = F.ka->in[IN_CGB] + layer * 16;
    float* DS = (float*)(F.ws + WS_DS); float* ZD = (float*)(F.ws + WS_ZD); float* GC = (float*)(F.ws + WS_GC); float* ML = (float*)(F.ws + WS_ML);
    const int vp0 = ((lane >> 4) & 1) * 32 + (lane & 3) * 8 + (4 * hi + ((lane & 15) >> 2)) * 64;
    for (int wu = gw; wu < NCHAIN * NCHUNK; wu += NGW) {
        const int chain = wu / NCHUNK, c = wu % NCHUNK, dir = chain & 1, h = (chain >> 1) & 3, b = chain >> 3;
        const int row0 = blk_row0(b, chunk_of(dir, c));
        const float gi = GATES[(size_t)(row0 + lane) * 16 + dir * 8 + h] + gb[dir * 8 + h];
        const float lf = logsigmoid(GATES[(size_t)(row0 + lane) * 16 + dir * 8 + 4 + h] + gb[dir * 8 + 4 + h]);
        const float cum = scan_add(lf, lane, dir);
        const float G = wave_sum(lf, lane);
        const float bb = gi - cum, mloc = wave_max(bb, lane), w = __expf(bb - mloc);
#pragma unroll
        for (int it = 0; it < 8; ++it) { const int tok = (lane >> 3) + 8 * it, d = 8 * (lane & 7);
            const u32x4 kv = *(const u32x4*)(PROJ + (size_t)(row0 + tok) * PP + PC_CK + 64 * h + d), vv = *(const u32x4*)(PROJ + (size_t)(row0 + tok) * PP + PC_CV + 64 * h + d);
            const float wt = shfl_idx(w, tok);
            u32x4 ko; ko.x = cvtpk(bflo(kv.x) * wt, bfhi(kv.x) * wt); ko.y = cvtpk(bflo(kv.y) * wt, bfhi(kv.y) * wt); ko.z = cvtpk(bflo(kv.z) * wt, bfhi(kv.z) * wt); ko.w = cvtpk(bflo(kv.w) * wt, bfhi(kv.w) * wt);
            *(LAS u32x4*)(wl + img_off(tok, d)) = vv; *(LAS u32x4*)(wl + 8192 + img_off(tok, d)) = ko; }
        LDS_WAIT();
        f32x16 acc[2][2] = {};
#pragma unroll
        for (int s = 0; s < 4; ++s) {
            bf16x8 af[2], bfr[2];
#pragma unroll
            for (int x = 0; x < 2; ++x) { const s16x4 a0 = att::vtr(wl + vp0 + x * 4096 + s * 1024), a1 = att::vtr(wl + vp0 + x * 4096 + s * 1024 + 512);
                const s16x4 c0 = att::vtr(wl + 8192 + vp0 + x * 4096 + s * 1024), c1 = att::vtr(wl + 8192 + vp0 + x * 4096 + s * 1024 + 512);
                af[x] = (bf16x8){a0[0], a0[1], a0[2], a0[3], a1[0], a1[1], a1[2], a1[3]}; bfr[x] = (bf16x8){c0[0], c0[1], c0[2], c0[3], c1[0], c1[1], c1[2], c1[3]}; }
#pragma unroll
            for (int vb = 0; vb < 2; ++vb)
#pragma unroll
                for (int kb = 0; kb < 2; ++kb) acc[vb][kb] = __builtin_amdgcn_mfma_f32_32x32x16_bf16(af[vb], bfr[kb], acc[vb][kb], 0, 0, 0);
        }
        float* dsp = DS + (size_t)(chain * NCHUNK + c) * 4096;
#pragma unroll
        for (int vb = 0; vb < 2; ++vb)
#pragma unroll
            for (int kb = 0; kb < 2; ++kb)
#pragma unroll
                for (int r = 0; r < 16; ++r) dsp[(32 * vb + att::crow(r, hi)) * 64 + 32 * kb + r32] = acc[vb][kb][r];
        float z = 0.f;
#pragma unroll 8
        for (int tok = 0; tok < 64; ++tok) z += bf2f(*(const LAS bf16_t*)(wl + 8192 + img_off(tok, lane)));
        ZD[(size_t)(chain * NCHUNK + c) * 64 + lane] = z;
        if (lane == 0) { GC[chain * NCHUNK + c] = G; ML[chain * NCHUNK + c] = mloc; }
        LDS_WAIT();
    }
}

__device__ __forceinline__ void pass2(Frame& F) {
    const float* DS = (const float*)(F.ws + WS_DS); const float* ZD = (const float*)(F.ws + WS_ZD); const float* GC = (const float*)(F.ws + WS_GC); const float* ML = (const float*)(F.ws + WS_ML);
    bf16_t* SBF = (bf16_t*)(F.ws + WS_SBF); float* ZC = (float*)(F.ws + WS_ZC); float* MC = (float*)(F.ws + WS_MC);
    LAS float* cf = (LAS float*)F.lds;
    for (int it = F.bid; it < NCHAIN * 16; it += F.G) {
        const int chain = it >> 4, part = it & 15;
        __syncthreads();
        if (F.wave == 0) {
            const int ln = F.lane; const bool valid = ln < 44; float g[3], mlv[3];
#pragma unroll
            for (int j = 0; j < 3; ++j) { g[j] = valid ? GC[chain * NCHUNK + 3 * ln + j] : 0.f; mlv[j] = valid ? ML[chain * NCHUNK + 3 * ln + j] : -INFINITY; }
            const float tot = g[0] + g[1] + g[2]; const float excl = ml::scan_add(tot, ln, 0) - tot;
            const float pg[3] = {excl, excl + g[0], excl + g[0] + g[1]};
            const float a0 = mlv[0] - pg[0], a1 = mlv[1] - pg[1], a2 = mlv[2] - pg[2];
            const float inclm = ml::scan_max(fmaxf(a0, fmaxf(a1, a2)), ln, 0); float exclm = shfl_idx(inclm, (ln - 1) & 63); if (ln == 0) exclm = -INFINITY;
            const float em[3] = {exclm, fmaxf(exclm, a0), fmaxf(fmaxf(exclm, a0), a1)};
#pragma unroll
            for (int j = 0; j < 3; ++j) { const int c = 3 * ln + j; const float m = pg[j] + fmaxf(0.f, em[j]); const float mn = fmaxf(g[j] + m, g[j] + mlv[j]);
                if (valid) { cf[2 * c] = __expf(g[j] + m - mn); cf[2 * c + 1] = __expf(g[j] + mlv[j] - mn); if (part == 0) MC[chain * NCHUNK + c] = m; } }
        }
        __syncthreads();
        if (F.tid < 256) {
            const int e = part * 256 + F.tid; const float* dp = DS + (size_t)chain * NCHUNK * 4096 + e; bf16_t* sp = SBF + (size_t)chain * NCHUNK * 4096 + e;
            float s = 0.f;
            for (int c0 = 0; c0 < NCHUNK; c0 += 66) { float d[66];
#pragma unroll
                for (int j = 0; j < 66; ++j) d[j] = dp[(size_t)(c0 + j) * 4096];
#pragma unroll
                for (int j = 0; j < 66; ++j) { sp[(size_t)(c0 + j) * 4096] = (bf16_t)(cvtpk(s, 0.f) & 0xffffu); s = cf[2 * (c0 + j)] * s + cf[2 * (c0 + j) + 1] * d[j]; } }
        } else if (F.tid < 260) {
            const int e = part * 4 + (F.tid - 256); const float* dp = ZD + (size_t)chain * NCHUNK * 64 + e; float* zp = ZC + (size_t)chain * NCHUNK * 64 + e;
            float s = 0.f;
            for (int c0 = 0; c0 < NCHUNK; c0 += 66) { float d[66];
#pragma unroll
                for (int j = 0; j < 66; ++j) d[j] = dp[(size_t)(c0 + j) * 64];
#pragma unroll
                for (int j = 0; j < 66; ++j) { zp[(size_t)(c0 + j) * 64] = s; s = cf[2 * (c0 + j)] * s + cf[2 * (c0 + j) + 1] * d[j]; } }
        }
    }
    __syncthreads();
}

__device__ __forceinline__ void pass3(Frame& F, int layer, int blk_lo) {
    const int gw = F.bid * NWAVES + F.wave, NGW = F.G * NWAVES, lane = F.lane, r32_ = lane & 31, hi_ = lane >> 5;
    LAS unsigned char* wl = F.lds + F.wave * 19456;
    LAS float* bvec = (LAS float*)(wl + 16384); LAS float* Apl = bvec + 128; LAS float* efl = bvec + 256; LAS float* fll = bvec + 384; LAS float* zl = bvec + 512; LAS float* rden = bvec + 640;
    LAS float* st = (LAS float*)(wl + 8192);
    const bf16_t* PROJ = (const bf16_t*)(F.ws + WS_PROJ); const float* GATES = (const float*)(F.ws + WS_GATES);
    const float* gb = F.ka->in[IN_CGB] + layer * 16;
    const bf16_t* SBF = (const bf16_t*)(F.ws + WS_SBF); const float* ZC = (const float*)(F.ws + WS_ZC); const float* MC = (const float*)(F.ws + WS_MC);
    bf16_t* Y = (bf16_t*)(F.ws + WS_H);
    const int vp0 = ((lane >> 4) & 1) * 32 + (lane & 3) * 8 + (4 * hi_ + ((lane & 15) >> 2)) * 64;
    const int nblk = NCHUNK - blk_lo;
    for (int wu2 = gw; wu2 < 16 * nblk; wu2 += NGW) {
        const int wu = wu2 >> 1, tbsel = wu2 & 1;
        const int bh = wu / nblk, blk = blk_lo + wu % nblk, b = bh >> 2, h = bh & 3;
        const int row0 = blk_row0(b, blk);
        LDS_WAIT();
#pragma unroll
        for (int it = 0; it < 8; ++it) { const int tok = (lane >> 3) + 8 * it, d = 8 * (lane & 7);
            *(LAS u32x4*)(wl + img_off(tok, d)) = *(const u32x4*)(PROJ + (size_t)(row0 + tok) * PP + PC_CV + 64 * h + d); }
#pragma unroll
        for (int dir = 0; dir < 2; ++dir) {
            const int c = chunk_of(dir, blk), chain = (b * 4 + h) * 2 + dir;
            const float gi = GATES[(size_t)(row0 + lane) * 16 + dir * 8 + h] + gb[dir * 8 + h];
            const float lf = logsigmoid(GATES[(size_t)(row0 + lane) * 16 + dir * 8 + 4 + h] + gb[dir * 8 + 4 + h]);
            const float cum = scan_add(lf, lane, dir);
            const float bb = gi - cum, pm = scan_max(bb, lane, dir), mc = MC[chain * NCHUNK + c];
            const float Apv = fmaxf(mc, pm);
            zl[dir * 64 + lane] = ZC[(size_t)(chain * NCHUNK + c) * 64 + lane];
            bvec[dir * 64 + lane] = bb; Apl[dir * 64 + lane] = Apv; efl[dir * 64 + lane] = __expf(mc - Apv); fll[dir * 64 + lane] = __expf(-(cum + Apv));
        }
        LDS_WAIT();
#pragma unroll 1
        for (int tb = tbsel; tb <= tbsel; ++tb) {
            int r32 = r32_, hi = hi_; asm volatile("" : "+v"(r32), "+v"(hi));
            const int t = 32 * tb + r32;
            bf16x8 qf[4];
#pragma unroll
            for (int d0 = 0; d0 < 4; ++d0) qf[d0] = *(const bf16x8*)(PROJ + (size_t)(row0 + t) * PP + PC_CQ + 64 * h + 16 * d0 + 8 * hi);
            f32x16 hs0 = {}, hs1 = {};
#pragma unroll 1
            for (int dir = 0; dir < 2; ++dir) {
                const int c = chunk_of(dir, blk), chain = (b * 4 + h) * 2 + dir;
                const bf16_t* Sp = SBF + (size_t)(chain * NCHUNK + c) * 4096; const LAS float* zp = zl + dir * 64;
                int r32 = r32_, hi = hi_; asm volatile("" : "+v"(r32), "+v"(hi));
                const float Ap_t = Apl[dir * 64 + t], e_t = efl[dir * 64 + t], fl_t = fll[dir * 64 + t];
                f32x16 P0 = {}, P1 = {};
#pragma unroll
                for (int d0 = 0; d0 < 4; ++d0) {
                    const bf16x8 k0 = *(const bf16x8*)(PROJ + (size_t)(row0 + r32) * PP + PC_CK + 64 * h + 16 * d0 + 8 * hi), k1 = *(const bf16x8*)(PROJ + (size_t)(row0 + 32 + r32) * PP + PC_CK + 64 * h + 16 * d0 + 8 * hi);
                    P0 = __builtin_amdgcn_mfma_f32_32x32x16_bf16(k0, qf[d0], P0, 0, 0, 0); P1 = __builtin_amdgcn_mfma_f32_32x32x16_bf16(k1, qf[d0], P1, 0, 0, 0); }
                float den = 0.f;
#pragma unroll
                for (int r = 0; r < 16; ++r) { const int s0 = att::crow(r, hi), s1 = 32 + s0; const bool ok0 = dir ? (s0 >= t) : (s0 <= t), ok1 = dir ? (s1 >= t) : (s1 <= t);
                    const float w0 = ok0 ? __expf(bvec[dir * 64 + s0] - Ap_t) : 0.f, w1 = ok1 ? __expf(bvec[dir * 64 + s1] - Ap_t) : 0.f;
                    P0[r] *= w0; P1[r] *= w1; den += P0[r] + P1[r]; }
                u32x4 pw[4];
#pragma unroll
                for (int k = 0; k < 4; ++k) { pw[0][k] = cvtpk(P0[2 * k], P0[2 * k + 1]); pw[1][k] = cvtpk(P0[8 + 2 * k], P0[9 + 2 * k]); pw[2][k] = cvtpk(P1[2 * k], P1[2 * k + 1]); pw[3][k] = cvtpk(P1[8 + 2 * k], P1[9 + 2 * k]); }

                f32x16 n0 = {}, n1 = {}; float zq = 0.f;
#pragma unroll
                for (int d0 = 0; d0 < 4; ++d0) { const u32x4 qw = __builtin_bit_cast(u32x4, qf[d0]); u32x4 o;
                    const f32x4 za = *(const LAS f32x4*)(zp + 16 * d0 + 8 * hi), zb = *(const LAS f32x4*)(zp + 16 * d0 + 8 * hi + 4);
                    const float q0 = bflo(qw.x), q1 = bfhi(qw.x), q2 = bflo(qw.y), q3 = bfhi(qw.y), q4 = bflo(qw.z), q5 = bfhi(qw.z), q6 = bflo(qw.w), q7 = bfhi(qw.w);
                    zq += (q0 * za[0] + q1 * za[1]) + (q2 * za[2] + q3 * za[3]) + (q4 * zb[0] + q5 * zb[1]) + (q6 * zb[2] + q7 * zb[3]);
                    o.x = cvtpk(q0 * e_t, q1 * e_t); o.y = cvtpk(q2 * e_t, q3 * e_t); o.z = cvtpk(q4 * e_t, q5 * e_t); o.w = cvtpk(q6 * e_t, q7 * e_t);
                    const bf16x8 qs = __builtin_bit_cast(bf16x8, o);
                    const bf16x8 s0 = *(const bf16x8*)(Sp + (size_t)r32 * 64 + 16 * d0 + 8 * hi), s1 = *(const bf16x8*)(Sp + (size_t)(32 + r32) * 64 + 16 * d0 + 8 * hi);
                    n0 = __builtin_amdgcn_mfma_f32_32x32x16_bf16(qs, s0, n0, 0, 0, 0); n1 = __builtin_amdgcn_mfma_f32_32x32x16_bf16(qs, s1, n1, 0, 0, 0); }

                den = att::halfsum(den) + e_t * att::halfsum(zq);
                const float rd = 1.f / fmaxf(fabsf(den), fl_t);
                LDS_WAIT(); if (hi == 0) rden[r32] = rd; LDS_WAIT();
#pragma unroll
                for (int ks = 0; ks < 4; ++ks) {
                    const s16x4 a0 = att::vtr(wl + vp0 + ks * 1024), a1 = att::vtr(wl + vp0 + ks * 1024 + 512), c0 = att::vtr(wl + vp0 + 4096 + ks * 1024), c1 = att::vtr(wl + vp0 + 4096 + ks * 1024 + 512);
                    const bf16x8 v0 = {a0[0], a0[1], a0[2], a0[3], a1[0], a1[1], a1[2], a1[3]}, v1 = {c0[0], c0[1], c0[2], c0[3], c1[0], c1[1], c1[2], c1[3]};
                    n0 = __builtin_amdgcn_mfma_f32_32x32x16_bf16(__builtin_bit_cast(bf16x8, pw[ks]), v0, n0, 0, 0, 0);
                    n1 = __builtin_amdgcn_mfma_f32_32x32x16_bf16(__builtin_bit_cast(bf16x8, pw[ks]), v1, n1, 0, 0, 0); }
#pragma unroll
                for (int r = 0; r < 16; ++r) { const float rr = rden[att::crow(r, hi)]; hs0[r] += n0[r] * rr; hs1[r] += n1[r] * rr; }
            }
            LDS_WAIT();
#pragma unroll
            for (int r = 0; r < 16; ++r) { st[att::crow(r, hi) * 64 + r32] = hs0[r]; st[att::crow(r, hi) * 64 + 32 + r32] = hs1[r]; }
            LDS_WAIT();
#pragma unroll
            for (int it = 0; it < 4; ++it) { const int tk = (lane >> 3) + 8 * it, d = 8 * (lane & 7);
                const u32x4 ow = *(const u32x4*)(PROJ + (size_t)(row0 + 32 * tb + tk) * PP + PC_CO + 64 * h + d);
                const f32x4 ha = *(const LAS f32x4*)(st + tk * 64 + d), hb = *(const LAS f32x4*)(st + tk * 64 + d + 4);
                const float og[8] = {bflo(ow.x), bfhi(ow.x), bflo(ow.y), bfhi(ow.y), bflo(ow.z), bfhi(ow.z), bflo(ow.w), bfhi(ow.w)};
                float yv[8];
#pragma unroll
                for (int j = 0; j < 8; ++j) yv[j] = (j < 4 ? ha[j] : hb[j - 4]) / (1.f + __expf(-og[j]));
                u32x4 w; w.x = cvtpk(yv[0], yv[1]); w.y = cvtpk(yv[2], yv[3]); w.z = cvtpk(yv[4], yv[5]); w.w = cvtpk(yv[6], yv[7]);
                *(u32x4*)(Y + (size_t)(row0 + 32 * tb + tk) * DM + 512 + 64 * h + d) = w; }
            LDS_WAIT();
        }
    }
}
}

namespace attp {
typedef __attribute__((address_space(3))) const char* lds_cptr;
#define SBAR() __builtin_amdgcn_sched_barrier(0)
__device__ __forceinline__ int crow(int r,int hi){return (r&3)+8*(r>>2)+4*hi;}
constexpr int NSLOT=3, SLOTB=8192;
constexpr int NW=8, QBLK=32, KVBLK=64; constexpr int LDS_K=0, LDS_V=NSLOT*SLOTB, LDS_WS=2*NSLOT*SLOTB, LDS_OST=LDS_WS+NW*64*4, LDS_BYTES=LDS_OST+NW*4096;
__device__ __forceinline__ void glds16(const void*gsrc,unsigned lds_dst){unsigned keep;
  asm volatile("s_mov_b32 %0, m0\n\ts_mov_b32 m0, %2\n\ts_nop 0\n\tglobal_load_lds_dwordx4 %1, off\n\ts_mov_b32 m0, %0":"=&s"(keep):"v"(gsrc),"s"(lds_dst):"memory");}
__device__ __forceinline__ float max3f(float a,float b,float c){float r;asm("v_max3_f32 %0, %1, %2, %3":"=v"(r):"v"(a),"v"(b),"v"(c));return r;}
__device__ __forceinline__ float max2f(float a,float b){float r;asm("v_max_f32_e32 %0, %1, %2":"=v"(r):"v"(a),"v"(b));return r;}
__device__ __forceinline__ float fadd_s(float a,float b){float r;asm("v_add_f32_e32 %0, %1, %2":"=v"(r):"v"(a),"v"(b));return r;}
__device__ __forceinline__ float fsub_s(float a,float b){float r;asm("v_sub_f32_e32 %0, %1, %2":"=v"(r):"v"(a),"v"(b));return r;}
__device__ __forceinline__ unsigned cvtpk_s(float lo,float hi){return cvtpk(lo,hi);}
#define WAIT_BAR(N) asm volatile("s_waitcnt vmcnt(" #N ") lgkmcnt(0)\n\ts_barrier":::"memory")

template<bool ZC> __device__ __forceinline__ void qkt(f32x16&p0,f32x16&p1,lds_cptr Kslot,const bf16x8*qr,const f32x16&negm,int r32,int hi){
  lds_cptr kb=Kslot+hi*1024+r32*16;
  #pragma unroll
  for(int d0=0;d0<4;++d0){
    const bf16x8 b0=*(const __attribute__((address_space(3))) bf16x8*)(kb+d0*2048);
    const bf16x8 b1=*(const __attribute__((address_space(3))) bf16x8*)(kb+d0*2048+512);
    if(d0==0){ if(ZC){p0=__builtin_amdgcn_mfma_f32_32x32x16_bf16(b0,qr[0],(f32x16){},0,0,0);p1=__builtin_amdgcn_mfma_f32_32x32x16_bf16(b1,qr[0],(f32x16){},0,0,0);} else {p0=__builtin_amdgcn_mfma_f32_32x32x16_bf16(b0,qr[0],negm,0,0,0);p1=__builtin_amdgcn_mfma_f32_32x32x16_bf16(b1,qr[0],negm,0,0,0);} }
    else{p0=__builtin_amdgcn_mfma_f32_32x32x16_bf16(b0,qr[d0],p0,0,0,0);p1=__builtin_amdgcn_mfma_f32_32x32x16_bf16(b1,qr[d0],p1,0,0,0);}}
}
__device__ __forceinline__ void kload8(bf16x8*kf,lds_cptr kp){
  kf[0]=*(const __attribute__((address_space(3))) bf16x8*)(kp);      kf[1]=*(const __attribute__((address_space(3))) bf16x8*)(kp+512);
  kf[2]=*(const __attribute__((address_space(3))) bf16x8*)(kp+2048); kf[3]=*(const __attribute__((address_space(3))) bf16x8*)(kp+2560);
  kf[4]=*(const __attribute__((address_space(3))) bf16x8*)(kp+4096); kf[5]=*(const __attribute__((address_space(3))) bf16x8*)(kp+4608);
  kf[6]=*(const __attribute__((address_space(3))) bf16x8*)(kp+6144); kf[7]=*(const __attribute__((address_space(3))) bf16x8*)(kp+6656);
}
__device__ __forceinline__ void kload2(bf16x8*kf,lds_cptr kp,int j){ kf[2*j]=*(const __attribute__((address_space(3))) bf16x8*)(kp+j*2048); kf[2*j+1]=*(const __attribute__((address_space(3))) bf16x8*)(kp+j*2048+512); }
__device__ __forceinline__ s16x4 vtr(lds_cptr p){ return __builtin_bit_cast(s16x4,__builtin_amdgcn_ds_read_tr16_b64_v4i16((__attribute__((address_space(3))) v4i16_t*)p)); }
__device__ __forceinline__ float rowmax(const f32x16&p0,const f32x16&p1){
  float a=max3f(p0[0],p0[1],p1[0]),b=max3f(p0[2],p0[3],p1[1]);a=max3f(a,p1[2],p1[3]);
  #pragma unroll
  for(int r=4;r<16;r+=4){a=max3f(a,p0[r],p0[r+1]);b=max3f(b,p0[r+2],p0[r+3]);a=max3f(a,p1[r],p1[r+1]);b=max3f(b,p1[r+2],p1[r+3]);}
  const float m=max2f(a,b);
  auto rr=__builtin_amdgcn_permlane32_swap(__float_as_uint(m),__float_as_uint(m),false,false);
  return max2f(__uint_as_float(rr[0]),__uint_as_float(rr[1]));
}
__device__ __forceinline__ void pv(f32x16*o,int vb,bf16x8 pa0,bf16x8 pa1,bf16x8 pa2,bf16x8 pa3){
  #pragma unroll
  for(int d0=0;d0<2;++d0){s16x4 lo[4],hi[4];
    #pragma unroll
    for(int ks=0;ks<4;++ks){
      asm volatile("ds_read_b64_tr_b16 %0,%1 offset:%c2":"=&v"(lo[ks]):"v"(vb),"i"(d0*4096+ks*1024):"memory");
      asm volatile("ds_read_b64_tr_b16 %0,%1 offset:%c2":"=&v"(hi[ks]):"v"(vb),"i"(d0*4096+ks*1024+512):"memory");}
    asm volatile("s_waitcnt lgkmcnt(0)":::"memory");SBAR();
    #define PK(k) (bf16x8){lo[k][0],lo[k][1],lo[k][2],lo[k][3],hi[k][0],hi[k][1],hi[k][2],hi[k][3]}
    o[d0]=__builtin_amdgcn_mfma_f32_32x32x16_bf16(pa0,PK(0),o[d0],0,0,0);
    o[d0]=__builtin_amdgcn_mfma_f32_32x32x16_bf16(pa1,PK(1),o[d0],0,0,0);
    o[d0]=__builtin_amdgcn_mfma_f32_32x32x16_bf16(pa2,PK(2),o[d0],0,0,0);
    o[d0]=__builtin_amdgcn_mfma_f32_32x32x16_bf16(pa3,PK(3),o[d0],0,0,0);
    #undef PK
  }
}


template<int THRL,int MODE> __device__ __forceinline__ void attn_unit_pipe(Frame& F,int b,int h,int qb,int qcol,int kcol,int vcol,int ycol,float sink2,const float*rpb){
  constexpr bool NOMAX=(MODE==0), USE_NEGM=false;
  int lane_=F.lane; asm volatile("":"+v"(lane_));
  const int lane=lane_,r32=lane&31,hi=lane>>5; const int wid=F.wave; (void)h;
  const bf16_t*PROJ=(const bf16_t*)(F.ws+WS_PROJ); bf16_t*Yb=(bf16_t*)(F.ws+WS_H);
  const int ctxrow=NLAT+CTXL*b,latrow=SEQ*b; LAS unsigned char*shm=F.lds;
  const int qrow0=(MODE==3)?ctxrow:latrow+256*qb;
  int lt_lo=0,nloc=0;
  if(MODE==0){nloc=128;}
  if(MODE==1){const int a_=(256*qb-128)>>6,e_=(256*qb+255+128)>>6; lt_lo=a_<0?0:a_; nloc=(e_>127?127:e_)-lt_lo+1;}
  if(MODE==2){const int a_=4*qb-4,e0_=4*qb-1; lt_lo=a_<0?0:(a_>120?120:a_); int e_=(e0_<0?0:(e0_>120?120:e0_))+7; nloc=e_-lt_lo+1; if(nloc&1)++nloc;}
  const int qw0=256*qb+32*wid;
  const int rw=4*qb+(wid>>1); const int rs=rw-4<0?0:(rw-4>120?120:rw-4);
  const int qc=32*(wid&1)+r32; const int cs=qc-8<0?0:(qc-8>48?48:qc-8);
  LAS float*rpbL=(LAS float*)(shm+LDS_BYTES);
  if(MODE==2){ for(int i=wid*64+lane;i<465;i+=512) rpbL[i]=rpb[i]*LOG2E; }
  unsigned vm0=0u,vm1=0u;
  if(MODE==2){ _Pragma("unroll") for(int r=0;r<16;++r){ const int kc_=crow(r,hi); if(kc_>=cs&&kc_<cs+16)vm0|=1u<<r; if(kc_+32>=cs&&kc_+32<cs+16)vm1|=1u<<r; } }
  const bf16_t*Qw=PROJ+(size_t)(qrow0+wid*QBLK)*PP+qcol;
  const unsigned lds0=(unsigned)(uintptr_t)shm;
  LAS float*wsf=(LAS float*)(shm+LDS_WS)+wid*64;
  const bf16_t*ksrc=PROJ+(size_t)lane*PP+kcol+wid*8;
  const bf16_t*vsrc=PROJ+(size_t)(16*(wid&3)+(lane>>2))*PP+vcol+(wid>>2)*32+(lane&3)*8;
  #define KROW(t) ((size_t)((t)<4?ctxrow+64*(t):latrow+64*(lt_lo+(t)-4))*PP)
  const unsigned kdst=lds0+LDS_K+wid*1024, vdst=lds0+LDS_V+wid*1024;
  #define DMA_K(t,slot) glds16(ksrc+KROW(t),(unsigned)__builtin_amdgcn_readfirstlane(kdst+(slot)))
  #define DMA_V(t,slot) glds16(vsrc+KROW(t),(unsigned)__builtin_amdgcn_readfirstlane(vdst+(slot)))
  const int vb0=(int)(lds0+LDS_V)+((lane>>4)&1)*32+(lane&3)*8+(4*hi+((lane&15)>>2))*64;
  const lds_cptr Kbase=(lds_cptr)shm+LDS_K; bf16x8 kf[8];
  const lds_cptr shm3=(lds_cptr)shm; const lds_cptr kp0=shm3+LDS_K+hi*1024+r32*16; const lds_cptr vp0=shm3+LDS_V+((lane>>4)&1)*32+(lane&3)*8+(4*hi+((lane&15)>>2))*64;
  const int NT=4+nloc;
  DMA_K(0,0);DMA_V(0,0);DMA_K(1,SLOTB);
  bf16x8 qr[4];
  #pragma unroll
  for(int d0=0;d0<4;++d0)qr[d0]=*reinterpret_cast<const bf16x8*>(&Qw[(size_t)r32*PP+d0*16+hi*8]);
  float mhat=0.f,l_reg=0.f;f32x16 o[2],negm;
  { float z_=0.f; asm volatile("":"+v"(z_));
    _Pragma("unroll") for(int r=0;r<16;++r){o[0][r]=z_;o[1][r]=z_;if(USE_NEGM)negm[r]=z_;} }
  if(USE_NEGM)asm volatile("":"+v"(negm));
  #define NEGMC (USE_NEGM?negm:(f32x16){})
  #define CMASK(P0,P1,t) do{ if(MODE==1&&(t)>=4){ const int dq_=64*(lt_lo+(t)-4)-(qw0+r32); \
      _Pragma("unroll") for(int r=0;r<16;++r){ const int d0_=dq_+crow(r,hi),d1_=d0_+32; if(d0_>128||d0_<-128)P0[r]=-INFINITY; if(d1_>128||d1_<-128)P1[r]=-INFINITY; } } \
    if(MODE==2&&(t)>=4){ const int gr_=lt_lo+(t)-4; const bool rel_=(gr_>=rs)&&(gr_<rs+8); const LAS float*bt_=rpbL+(rel_?gr_-rw+7:7)*31+(15-qc)+4*hi; const unsigned m0_=rel_?vm0:0u,m1_=rel_?vm1:0u; \
      _Pragma("unroll") for(int r=0;r<16;++r){ const int kc_=(r&3)+8*(r>>2);   \
        P0[r]=((m0_>>r)&1u)?P0[r]+bt_[kc_]:-INFINITY; P1[r]=((m1_>>r)&1u)?P1[r]+bt_[kc_+32]:-INFINITY; } } }while(0)
  bool resc=false;
  #define START(P0,P1) do{ resc=false; \
    if(!NOMAX){ const float rm=rowmax(P0,P1); const float dl=rm; mhat=fadd_s(mhat,dl); \
      _Pragma("unroll") for(int r=0;r<16;++r){P0[r]=fsub_s(P0[r],dl);P1[r]=fsub_s(P1[r],dl);} \
      if(USE_NEGM){ _Pragma("unroll") for(int r=0;r<16;++r)negm[r]=-mhat; asm volatile("":"+v"(negm)); } } \
    _Pragma("unroll") for(int r=0;r<16;++r)P0[r]=__builtin_amdgcn_exp2f(P0[r]); }while(0)
  #define RESC() do{ if(resc){ asm volatile("s_waitcnt lgkmcnt(0)":::"memory"); \
      _Pragma("unroll") for(int d_=0;d_<2;++d_) _Pragma("unroll") for(int r=0;r<16;++r)o[d_][r]*=wsf[crow(r,hi)]; } }while(0)
  f32x16 pA0,pA1,pB0,pB1;
  int sl_prev=0,sl_cur=0,sl_next=SLOTB;
  #define ROT() do{sl_prev=sl_cur;sl_cur=sl_next;sl_next=(sl_next==(NSLOT-1)*SLOTB)?0:sl_next+SLOTB;}while(0)
  DMA_K(2,2*SLOTB);
  WAIT_BAR(3);
  qkt<!USE_NEGM>(pA0,pA1,Kbase,qr,negm,r32,hi);asm volatile("s_nop 15\n\ts_nop 7":"+v"(pA0),"+v"(pA1));CMASK(pA0,pA1,0);
  START(pA0,pA1);
  _Pragma("unroll") for(int r=0;r<16;++r)pA1[r]=__builtin_amdgcn_exp2f(pA1[r]);
  WAIT_BAR(0);
  DMA_K(3,0);DMA_V(1,SLOTB);
  ROT();
  kload8(kf,kp0+sl_cur);
  WAIT_BAR(2);
  s16x4 vlo[8],vhi[8]; u32x4 pw0,pw1,pw2,pw3;
  #define PKW(P,B) cvtpk_s(P[B],P[B+1])
  #define PAF(k) __builtin_bit_cast(bf16x8,pw##k)
  #define VFR(i) (bf16x8){vlo[i][0],vlo[i][1],vlo[i][2],vlo[i][3],vhi[i][0],vhi[i][1],vhi[i][2],vhi[i][3]}
  #define PIN(x) asm volatile("":"+v"(x))
  #define MX3(a,b,c) __builtin_fmaxf(__builtin_fmaxf((a),(b)),(c))
  #define GAPA(MF,A0,A1,A2,A3,W0,W1,PW) do{ MF; sacc+=A0; sacc+=A1; sacc+=A2; sacc+=A3; PIN(sacc); W0; W1; PIN(PW); SBAR(); }while(0)
  #define EX(v) __builtin_amdgcn_exp2f(v)
  #define GAPB(MF,X,B) do{ MF; X[B]=EX(X[B]); X[B+1]=EX(X[B+1]); X[B+2]=EX(X[B+2]); X[B+3]=EX(X[B+3]); PIN(X); SBAR(); }while(0)
  #define VRD(i) do{ vlo[i]=vtr(vp_+(((i)>>2)*4096+((i)&3)*1024)); vhi[i]=vtr(vp_+(((i)>>2)*4096+((i)&3)*1024+512)); }while(0)
  #define KRD(G,j) do{ if(G){ kload2(kf,kp0+sl_next,j); SBAR(); } }while(0)
  #define STEP(C0,C1,P0,P1,t,GK,GV,GL) do{ SBAR(); \
    const lds_cptr vp_=vp0+sl_prev; \
    VRD(0); SBAR(); float sacc=(P0[0]+P0[1]); \
    GAPA(C0=__builtin_amdgcn_mfma_f32_32x32x16_bf16(kf[0],qr[0],NEGMC,0,0,0), P0[2],P0[3],P0[4],P0[5],     pw0[0]=PKW(P0,0), pw0[1]=PKW(P0,2), pw0); \
    VRD(4); SBAR(); GAPA(C1=__builtin_amdgcn_mfma_f32_32x32x16_bf16(kf[1],qr[0],NEGMC,0,0,0), P0[6],P0[7],P0[8],P0[9],     pw0[2]=PKW(P0,4), pw0[3]=PKW(P0,6), pw0); \
    VRD(1); SBAR(); GAPA(C0=__builtin_amdgcn_mfma_f32_32x32x16_bf16(kf[2],qr[1],C0,0,0,0),   P0[10],P0[11],P0[12],P0[13], pw1[0]=PKW(P0,8), pw1[1]=PKW(P0,10), pw1); \
    VRD(5); SBAR(); GAPA(C1=__builtin_amdgcn_mfma_f32_32x32x16_bf16(kf[3],qr[1],C1,0,0,0),   P0[14],P0[15],P1[0],P1[1],   pw1[2]=PKW(P0,12),pw1[3]=PKW(P0,14), pw1); \
    VRD(2); SBAR(); GAPA(C0=__builtin_amdgcn_mfma_f32_32x32x16_bf16(kf[4],qr[2],C0,0,0,0),   P1[2],P1[3],P1[4],P1[5],     pw2[0]=PKW(P1,0), pw2[1]=PKW(P1,2), pw2); \
    VRD(6); SBAR(); GAPA(C1=__builtin_amdgcn_mfma_f32_32x32x16_bf16(kf[5],qr[2],C1,0,0,0),   P1[6],P1[7],P1[8],P1[9],     pw2[2]=PKW(P1,4), pw2[3]=PKW(P1,6), pw2); \
    VRD(3); SBAR(); GAPA(C0=__builtin_amdgcn_mfma_f32_32x32x16_bf16(kf[6],qr[3],C0,0,0,0),   P1[10],P1[11],P1[12],P1[13], pw3[0]=PKW(P1,8), pw3[1]=PKW(P1,10), pw3); \
    VRD(7); SBAR(); GAPA(C1=__builtin_amdgcn_mfma_f32_32x32x16_bf16(kf[7],qr[3],C1,0,0,0),   P1[14],P1[15],0.f,0.f,       pw3[2]=PKW(P1,12),pw3[3]=PKW(P1,14), pw3); \
    l_reg+=sacc; \
    if(GK){DMA_K((t)+3,sl_cur);} if(GV){DMA_V((t)+1,sl_next);} \
    if(!USE_NEGM&&!NOMAX){ _Pragma("unroll") for(int r=0;r<16;++r){C0[r]-=mhat;C1[r]-=mhat;} } \
    CMASK(C0,C1,t); \
    if(!NOMAX){ float a=MX3(C0[0],C0[1],C1[0]),b=MX3(C0[2],C0[3],C1[1]); a=MX3(a,C1[2],C1[3]); \
      _Pragma("unroll") for(int r=4;r<16;r+=4){a=MX3(a,C0[r],C0[r+1]);b=MX3(b,C0[r+2],C0[r+3]);a=MX3(a,C1[r],C1[r+1]);b=MX3(b,C1[r+2],C1[r+3]);} \
      float rm=__builtin_fmaxf(a,b); { auto rr=__builtin_amdgcn_permlane32_swap(__float_as_uint(rm),__float_as_uint(rm),false,false); rm=__builtin_fmaxf(__uint_as_float(rr[0]),__uint_as_float(rr[1])); } \
      resc=false; \
      if(__builtin_expect(__any(rm>(float)THRL),0)){ const float dl=__builtin_fmaxf(rm,0.f); mhat+=dl; \
        _Pragma("unroll") for(int r=0;r<16;++r){C0[r]-=dl;C1[r]-=dl;} \
        if(USE_NEGM){ _Pragma("unroll") for(int r=0;r<16;++r)negm[r]=-mhat; asm volatile("":"+v"(negm)); } \
        const float f=__builtin_amdgcn_exp2f(-dl); l_reg*=f; if(hi==0)wsf[r32]=f; resc=true; } } \
    SBAR(); \
    GAPB(o[0]=__builtin_amdgcn_mfma_f32_32x32x16_bf16(PAF(0),VFR(0),o[0],0,0,0), C0,0); \
    GAPB(o[1]=__builtin_amdgcn_mfma_f32_32x32x16_bf16(PAF(0),VFR(4),o[1],0,0,0), C0,4); \
    KRD(GL,0); GAPB(o[0]=__builtin_amdgcn_mfma_f32_32x32x16_bf16(PAF(1),VFR(1),o[0],0,0,0), C0,8); \
    KRD(GL,1); GAPB(o[1]=__builtin_amdgcn_mfma_f32_32x32x16_bf16(PAF(1),VFR(5),o[1],0,0,0), C0,12); \
    KRD(GL,2); GAPB(o[0]=__builtin_amdgcn_mfma_f32_32x32x16_bf16(PAF(2),VFR(2),o[0],0,0,0), C1,0); \
    KRD(GL,3); GAPB(o[1]=__builtin_amdgcn_mfma_f32_32x32x16_bf16(PAF(2),VFR(6),o[1],0,0,0), C1,4); \
    GAPB(o[0]=__builtin_amdgcn_mfma_f32_32x32x16_bf16(PAF(3),VFR(3),o[0],0,0,0), C1,8); \
    GAPB(o[1]=__builtin_amdgcn_mfma_f32_32x32x16_bf16(PAF(3),VFR(7),o[1],0,0,0), C1,12); \
    }while(0)
  int t=1;
  for(;t+5<NT;t+=2){
    STEP(pB0,pB1,pA0,pA1,t,true,true,true);     WAIT_BAR(2); RESC(); ROT();
    STEP(pA0,pA1,pB0,pB1,t+1,true,true,true);   WAIT_BAR(2); RESC(); ROT();
  }
  #define ENDW(tt) do{ if((tt)+3<NT){WAIT_BAR(2);} else if((tt)+2<NT){WAIT_BAR(1);} else {WAIT_BAR(0);} }while(0)
  for(;t+1<NT;t+=2){
    STEP(pB0,pB1,pA0,pA1,t,(t+3<NT),(t+1<NT),(t+1<NT));       ENDW(t);   RESC(); ROT();
    STEP(pA0,pA1,pB0,pB1,t+1,(t+4<NT),(t+2<NT),(t+2<NT));     ENDW(t+1); RESC(); ROT();
  }
  STEP(pB0,pB1,pA0,pA1,NT-1,false,false,false); RESC();
  { float sacc=pB0[0]+pB0[1]; _Pragma("unroll") for(int r=2;r<16;++r)sacc+=pB0[r]; _Pragma("unroll") for(int r=0;r<16;++r)sacc+=pB1[r]; l_reg+=sacc;
    pw0=(u32x4){PKW(pB0,0),PKW(pB0,2),PKW(pB0,4),PKW(pB0,6)};pw1=(u32x4){PKW(pB0,8),PKW(pB0,10),PKW(pB0,12),PKW(pB0,14)};pw2=(u32x4){PKW(pB1,0),PKW(pB1,2),PKW(pB1,4),PKW(pB1,6)};pw3=(u32x4){PKW(pB1,8),PKW(pB1,10),PKW(pB1,12),PKW(pB1,14)};
    SBAR(); pv(o,vb0+sl_cur,PAF(0),PAF(1),PAF(2),PAF(3)); }
  #undef PKW
  #undef PAF
  #undef VFR
  #undef PIN
  #undef MX3
  #undef GAPA
  #undef GAPB
  #undef EX
  #undef VRD
  #undef KRD
  #undef STEP
  #undef ENDW
  {auto rr=__builtin_amdgcn_permlane32_swap(__float_as_uint(l_reg),__float_as_uint(l_reg),false,false);l_reg=__uint_as_float(rr[0])+__uint_as_float(rr[1]);}
  if(MODE==1||MODE==3)l_reg+=__builtin_amdgcn_exp2f(sink2-mhat);
  if(hi==0)wsf[32+r32]=l_reg;asm volatile("s_waitcnt lgkmcnt(0)":::"memory");
  float rli[16];
  #pragma unroll
  for(int r=0;r<16;++r)rli[r]=__builtin_amdgcn_rcpf(wsf[32+crow(r,hi)]);
  bf16_t*Ow=Yb+(size_t)(qrow0+wid*QBLK)*DM+ycol;
  { LAS bf16_t*stg=(LAS bf16_t*)(shm+LDS_OST)+wid*2048;
    #pragma unroll
    for(int r=0;r<16;++r){const int orow=crow(r,hi);
      #pragma unroll
      for(int d0=0;d0<2;++d0)stg[orow*64+d0*32+r32]=(bf16_t)(cvtpk(o[d0][r]*rli[r],0.f)&0xffffu);}
    asm volatile("s_waitcnt lgkmcnt(0)":::"memory");
    #pragma unroll
    for(int i=0;i<4;++i){const int row=i*8+(lane>>3),ch=lane&7; const u32x4 v=*(const LAS u32x4*)(stg+row*64+ch*8); *(u32x4*)(Ow+(size_t)row*DM+ch*8)=v;} }
  asm volatile("s_waitcnt lgkmcnt(0)\n\ts_barrier":::"memory");
  #undef DMA_K
  #undef DMA_V
  #undef KROW
  #undef NEGMC
  #undef CMASK
  #undef START
  #undef RESC
  #undef ROT
}

#undef SBAR
#undef WAIT_BAR
}

constexpr int NPHASE = 19;
__device__ __forceinline__ void ph_decode(int ph, int& l, int& k) { const unsigned tab = 0xA9864321u;
    if (ph == 1) { l = 0; k = 0; } else { const int j = ph - 2; l = j >= 8 ? 1 : 0; k = (int)((tab >> (4 * (j >= 8 ? j - 8 : j))) & 15u); } }

__device__ __forceinline__ void fill_rtab(Frame& F, const pg8::StaticOrder& S, const float* ssq, const float* ssqc) {
    LAS float* tab = (LAS float*)(F.lds + pg8::RTAB_OFF); pg8::Unit u;
#pragma unroll
    for (int i = 0; i < 8; ++i) if (S.next(i, u) && F.tid < 256) { float s = 0.f;
        if (u.pm < 64) { const float* p = ssq + (size_t)(u.pm * 256 + F.tid) * 16; const f32x4 a = *(const f32x4*)p, b = *(const f32x4*)(p + 4), c = *(const f32x4*)(p + 8), d = *(const f32x4*)(p + 12);
            s = ((a[0] + a[1]) + (a[2] + a[3])) + ((b[0] + b[1]) + (b[2] + b[3])) + ((c[0] + c[1]) + (c[2] + c[3])) + ((d[0] + d[1]) + (d[2] + d[3])); }
        else { const float* p = ssqc + (size_t)((u.pm - 64) * 256 + F.tid) * 64;
#pragma unroll
            for (int j = 0; j < 16; ++j) { const f32x4 a = *(const f32x4*)(p + 4 * j); s += (a[0] + a[1]) + (a[2] + a[3]); } }
        tab[i * 256 + F.tid] = rsqrtf(s * (1.f / DM) + EPS); }
    __syncthreads();
}
__device__ __forceinline__ void phase_ids(Frame& F) {
    int lane_;
    asm volatile("v_mbcnt_lo_u32_b32 %0, -1, 0\n\tv_mbcnt_hi_u32_b32 %0, -1, %0" : "=v"(lane_));
    F.lane = lane_; F.tid = F.wave * 64 + lane_;
}
__device__ __forceinline__ void run_phase(const Frame& F0, int ph) {
    Frame F = F0;
    unsigned char* ws = F.ws;
#define H ((bf16_t*)(F.ws + WS_H))
#define PROJ ((bf16_t*)(F.ws + WS_PROJ))
#define XC ((float*)(F.ws + WS_XC))
#define MOD ((const float*)(F.ws + WS_MOD))
#define vcu ((F.G % 8 == 0) ? (F.bid % 8) * (F.G / 8) + F.bid / 8 : F.bid)
#ifdef ONLYK
    if (ONLYK == 100) { if (ph == 0) { phase_ids(F); p0_prologue(F); } return; }
    if (ONLYK == 101) { if (ph == NPHASE - 1) { phase_ids(F); final_phase(F); } return; }
    if (ph == 0 || ph == NPHASE - 1) return;
    int l, k; ph_decode(ph, l, k);
    if (k != ONLYK) return;
#else
    if (ph == 0) { phase_ids(F); p0_prologue(F); return; }
    if (ph == NPHASE - 1) { phase_ids(F); final_phase(F); return; }
    int l, k; ph_decode(ph, l, k);
#endif
    const int M = (l == 0) ? NROWS : NLAT;
    switch (k) {
    case 0: phase_ids(F); norm_phase(F, l); break;
    case 1: { phase_ids(F); pg8::Gemm g{H, (const bf16_t*)(ws + WS_WIN) + (size_t)l * PP * 1024, NROWS, PP, 1024}; pg8::StaticOrder S; S.init(NROWS, PP, F.G, F.bid);
              gates_phase(F, l); if (l > 0) fill_rtab(F, S, (const float*)(ws + WS_SSQ1), (const float*)(ws + WS_SSQC1));
              pg8::EpiProj E{PROJ, PP, l == 0 ? nullptr : (const LAS float*)(F.lds + pg8::RTAB_OFF), (const float*)(ws + WS_BIASIN)}; pg8::gemm_phase<pg8::EpiProj, pg8::StaticOrder, true, true>(F.lds, g, S, E, F.tid); } break;
    case 2: phase_ids(F); postproj_phase(F, l); ml::pass1(F, l); break;
    case 3: {
        phase_ids(F);
        ml::pass2(F); PROBE_PT(F.lds, 1);
#ifndef NO_B
        for (int u = vcu; u < 256; u += F.G) { const int b = u >> 7, h = (u >> 5) & 3, qb = u & 31;
            attp::attn_unit_pipe<8, 1>(F, b, h, qb, PC_BQ + 64 * h, PC_BK + 64 * (h >> 1), PC_BV + 64 * (h >> 1), 256 + 64 * h, F.ka->in[IN_SINK][l * 4 + h] * LOG2E, nullptr); }
#endif
        PROBE_PT(F.lds, 2);
#ifndef NO_D
        for (int u = vcu; u < 256; u += F.G) { const int b = u >> 7, h = (u >> 5) & 3, qb = u & 31;
            attp::attn_unit_pipe<8, 2>(F, b, h, qb, PC_DQ + 64 * h, PC_DK + 64 * h, PC_DV + 64 * h, 768 + 64 * h, 0.f, F.ka->in[IN_RPB] + (size_t)(l * 4 + h) * 465); }
#endif
        PROBE_PT(F.lds, 3);
#ifndef NO_C3
        if (l == 0) for (int cu = vcu; cu < 24; cu += F.G) { const int mx = cu >> 3, b = (cu >> 2) & 1, h = cu & 3;
            const int qc = mx == 0 ? PC_AQ + 64 * h : (mx == 1 ? PC_BQ + 64 * h : PC_DQ + 64 * h);
            const int kc = mx == 0 ? PC_AK + 64 * (h >> 1) : (mx == 1 ? PC_BK + 64 * (h >> 1) : PC_DK + 64 * h);
            const int vc = mx == 0 ? PC_AV + 64 * (h >> 1) : (mx == 1 ? PC_BV + 64 * (h >> 1) : PC_DV + 64 * h);
            const int yc = (mx == 0 ? 0 : (mx == 1 ? 256 : 768)) + 64 * h;
            const float s2 = mx == 1 ? F.ka->in[IN_SINK][l * 4 + h] * LOG2E : -INFINITY;
            attp::attn_unit_pipe<8, 3>(F, b, h, 0, qc, kc, vc, yc, s2, nullptr); }
#endif
        PROBE_PT(F.lds, 5);
        if (l == 0) bias_phase(F, vcu >= 24 ? vcu - 24 : -1, F.G - 24);
    } break;
    case 4: {
        phase_ids(F);
#ifndef NO_ATTN0
        for (int u = vcu; u < 256; u += F.G) { const int b = u >> 7, h = (u >> 5) & 3, qb = u & 31;
            attp::attn_unit_pipe<8, 0>(F, b, h, qb, PC_AQ + 64 * h, PC_AK + 64 * (h >> 1), PC_AV + 64 * (h >> 1), 64 * h, 0.f, nullptr); }
#endif
        __syncthreads();
#ifndef NO_PASS3
        ml::pass3(F, l, l == 0 ? 0 : 4);
#endif
    } break;
    case 6: { phase_ids(F); pg8::Gemm g{PROJ  , (const bf16_t*)(ws + WS_WOUT) + (size_t)l * 1024 * 1024, NLAT, 1024, 1024}; pg8::StaticOrder S; S.init(NLAT, 1024, F.G, F.bid);
              { pg8::Unit u;
                if (F.G >= 256) { if (S.next(0, u)) {
                    groupnorm_rows<true>(F, l, u.pm * 256 + u.pn * 64, 64, F.wave, NWAVES);
                    asm volatile("s_waitcnt vmcnt(0)" ::: "memory"); __syncthreads();
                    if (F.tid == 0) { unsigned* cnt = (unsigned*)(ws + WS_CTL + 40960) + l * 64 + u.pm;
                        __hip_atomic_fetch_add(cnt, 1u, __ATOMIC_RELAXED, __HIP_MEMORY_SCOPE_AGENT);
                        unsigned sp = 0; while (__hip_atomic_load(cnt, __ATOMIC_RELAXED, __HIP_MEMORY_SCOPE_AGENT) < 4u && ++sp < (1u << 22)) __builtin_amdgcn_s_sleep(1);
                        __builtin_amdgcn_fence(__ATOMIC_ACQUIRE, "agent"); asm volatile("s_waitcnt vmcnt(0)" ::: "memory"); }
                    __syncthreads(); } }
                else { for (int i = 0; S.next(i, u); ++i) groupnorm_rows<false>(F, l, u.pm * 256, 256, F.wave, NWAVES); VM_WAIT(); __syncthreads(); } }
              pg8::EpiResid E{l == 0 ? F.ka->in[IN_X] : F.out, l == 0 ? F.ka->in[IN_CTX] : XC, F.out, XC, MOD + (size_t)l * 3 * 6144 + 2 * 1024,
                               (bf16_t*)(ws + WS_XG), F.ka->in[IN_G2] + l * 1024, MOD + (size_t)l * 3 * 6144 + 4 * 1024, (float*)(ws + WS_SSQ2)};
              if (F.G >= 256) { pg8::EpiResidStaged E2{E.xin_lat, E.xin_ctx, E.xout_lat, E.xout_ctx, E.gate, E.xg, E.gn, E.scn, E.ssq}; pg8::gemm_phase<pg8::EpiResidStaged, pg8::StaticOrder, true, true>(F.lds, g, S, E2, F.tid); }
              else pg8::gemm_phase<pg8::EpiResid, pg8::StaticOrder, true, true>(F.lds, g, S, E, F.tid);
              PROBE_PT(F.lds, 5);
              if (l == 0) skinny_ctx<1024>(F, PROJ + (size_t)NLAT * DM, (const bf16_t*)(ws + WS_WOUT), F.ka->in[IN_CTX], XC, MOD + 2 * 6144 + 2 * 1024,
                                           (bf16_t*)(ws + WS_XG) + (size_t)NLAT * DM, F.ka->in[IN_G2], MOD + 2 * 6144 + 4 * 1024, (float*)(ws + WS_SSQC2)); } break;
    case 8: { phase_ids(F); pg8::Gemm g{(const bf16_t*)(ws + WS_XG), (const bf16_t*)(ws + WS_WUP) + (size_t)l * DFF2 * 1024, M, DFF2, 1024}; pg8::StaticOrder S; S.init(M, DFF2, F.G, F.bid);
              fill_rtab(F, S, (const float*)(ws + WS_SSQ2), (const float*)(ws + WS_SSQC2));
              pg8::EpiUp E{PROJ, F.ka->in[IN_CONVW] + (size_t)l * 3 * DFF2, F.ka->in[IN_CONVB] + (size_t)l * DFF2, (float*)(ws + WS_EDGE), (const LAS float*)(F.lds + pg8::RTAB_OFF), (const float*)(ws + WS_BIASUP) + (size_t)l * 3 * DFF2};
              pg8::gemm_phase<pg8::EpiUp, pg8::StaticOrder, true, true>(F.lds, g, S, E, F.tid); } break;
    case 9: phase_ids(F); for (int ht = F.bid; ht < M / 128; ht += F.G) fixup_hts(F, l, ht, 1); break;
    case 10: { phase_ids(F); pg8::Gemm g{PROJ, (const bf16_t*)(ws + WS_WDN) + (size_t)l * 1024 * DFF, NLAT, 1024, DFF}; pg8::StaticOrder S; S.init(NLAT, 1024, F.G, F.bid);
              pg8::EpiResid E{F.out, XC, F.out, XC, MOD + (size_t)l * 3 * 6144 + 5 * 1024,
                               l == 0 ? H : nullptr, F.ka->in[IN_G1] + 1024, MOD + (size_t)3 * 6144 + 1 * 1024, (float*)(ws + WS_SSQ1)};
              if (F.G >= 256) { pg8::EpiResidStaged E2{E.xin_lat, E.xin_ctx, E.xout_lat, E.xout_ctx, E.gate, E.xg, E.gn, E.scn, E.ssq}; pg8::gemm_phase<pg8::EpiResidStaged, pg8::StaticOrder, true, true>(F.lds, g, S, E2, F.tid); }
              else pg8::gemm_phase<pg8::EpiResid, pg8::StaticOrder, true, true>(F.lds, g, S, E, F.tid);
              PROBE_PT(F.lds, 5);
              if (l == 0) skinny_ctx<DFF>(F, PROJ + (size_t)NLAT * DFF, (const bf16_t*)(ws + WS_WDN), XC, XC, MOD + 2 * 6144 + 5 * 1024,
                                          H + (size_t)NLAT * DM, F.ka->in[IN_G1] + 1024, MOD + (size_t)(3 + 2) * 6144 + 1 * 1024, (float*)(ws + WS_SSQC1)); } break;
    default: break;
    }
#undef H
#undef PROJ
#undef XC
#undef MOD
#undef vcu
}

__global__ void __launch_bounds__(NTHREADS, 2) fwd_kernel(Args args) {
    extern __shared__ __attribute__((aligned(16))) unsigned char lds_raw[];
    Frame F;
    F.lds = (LAS unsigned char*)lds_raw;
    const int wave0 = __builtin_amdgcn_readfirstlane((int)threadIdx.x >> 6);
    F.tid = 0; F.lane = 0; F.wave = wave0;
    F.G = gridDim.x; F.bid = blockIdx.x;
    F.ka = (const __attribute__((address_space(4))) Args*)__builtin_amdgcn_kernarg_segment_ptr();
    F.out = args.out; F.ws = args.ws;
#define MK_LANE(x) int x; asm volatile("v_mbcnt_lo_u32_b32 %0, -1, 0\n\tv_mbcnt_hi_u32_b32 %0, -1, %0" : "=v"(x))
#if !MK_MULTI
    { MK_LANE(l0_); if (wave0 == 0) ((LAS unsigned*)(F.lds + LDSCTL_OFF))[l0_] = 0u; }
    __syncthreads();
    XcdBarrier bar;
    { MK_LANE(l0_); bar = xcd_barrier_post((unsigned*)(args.ws + WS_CTL) + CW_BAR, (volatile LAS unsigned*)(F.lds + LDSCTL_OFF) + 8, wave0 == 0 && l0_ == 0); }
#endif
#ifdef PROBE_MASK
    unsigned long long pr_acc = 0ull;
#endif
    for (int ph = args.ph_lo; ph < args.ph_hi; ++ph) {
#ifdef PROBE_MASK
        const unsigned long long pr_t0 = __builtin_amdgcn_s_memrealtime();
#endif
#ifdef PROBE_PH
        *(volatile LAS unsigned*)(F.lds + LDSCTL_OFF + 64) = (ph == PROBE_PH) ? 1u : 0u; __syncthreads();
        PROBE_PT(F.lds, 0);
#endif
        {
            Frame P = F;
            int wave_ = wave0, bid_ = F.bid, g_ = F.G; unsigned char* ws_ = F.ws; float* out_ = F.out; const __attribute__((address_space(4))) Args* ka_ = F.ka;
            asm volatile("" : "+s"(wave_), "+s"(bid_), "+s"(g_), "+s"(ws_), "+s"(out_), "+s"(ka_));
            P.ka = ka_; P.lane = 0; P.wave = wave_; P.tid = 0; P.bid = bid_; P.G = g_; P.ws = ws_; P.out = out_;
            run_phase(P, ph);
#ifdef DUP_PH
            if (DUP_PH(ph)) { asm volatile("s_waitcnt vmcnt(0) lgkmcnt(0)" ::: "memory"); __syncthreads(); run_phase(P, ph); }
#endif
        }
#if !MK_MULTI
        if (ph + 1 < args.ph_hi) {
            if (args.ph_lo < 0) cg::this_grid().sync();
            else { MK_LANE(l1_); xcd_barrier(bar, wave0 == 0 && l1_ == 0); }
        }
#endif
#ifdef PROBE_PH
        PROBE_PT(F.lds, 4);
#endif
#ifdef PROBE_MASK
        if ((PROBE_MASK >> ph) & 1u) pr_acc += __builtin_amdgcn_s_memrealtime() - pr_t0;
#endif
    }
#ifdef PROBE_PH
    if (blockIdx.x == 0) { __syncthreads(); const unsigned long long d_ = *(volatile LAS unsigned long long*)(F.lds + LDSCTL_OFF + 72 + 8 * PROBE_B) - *(volatile LAS unsigned long long*)(F.lds + LDSCTL_OFF + 72 + 8 * PROBE_A);
        const unsigned long long t1 = __builtin_amdgcn_s_memrealtime(); while (__builtin_amdgcn_s_memrealtime() - t1 < d_) __builtin_amdgcn_s_sleep(8); }
#endif
#ifdef PROBE_MASK
    if (blockIdx.x == 0) { const unsigned long long t1 = __builtin_amdgcn_s_memrealtime(); while (__builtin_amdgcn_s_memrealtime() - t1 < pr_acc) __builtin_amdgcn_s_sleep(8); }
#endif
}

extern "C" void kernel_launch(void* const* d_in, const int* in_sizes, int n_in, void* d_out, int out_size, void* d_ws, size_t ws_size, hipStream_t stream) {
    static int grid = 0;
    if (grid == 0) {
        if (n_in != 21 || out_size != NLAT * DM || ws_size < WS_END) { fprintf(stderr, "kernel_launch: unexpected shapes (n_in %d out %d ws %zu)\n", n_in, out_size, ws_size); grid = -1; return; }
        int dev = 0, cus = 0, per_cu = 0;
        if (hipGetDevice(&dev) != hipSuccess || hipDeviceGetAttribute(&cus, hipDeviceAttributeMultiprocessorCount, dev) != hipSuccess) { grid = -1; return; }
        if (hipFuncSetAttribute((const void*)fwd_kernel, hipFuncAttributeMaxDynamicSharedMemorySize, LDS_BYTES) != hipSuccess) { fprintf(stderr, "kernel_launch: hipFuncSetAttribute failed\n"); grid = -1; return; }
        if (hipOccupancyMaxActiveBlocksPerMultiprocessor(&per_cu, (const void*)fwd_kernel, NTHREADS, LDS_BYTES) != hipSuccess || per_cu < 1) { fprintf(stderr, "kernel_launch: occupancy query says %d blocks per CU\n", per_cu); grid = -1; (void)hipGetLastError(); return; }
        grid = cus;
    }
    if (grid < 0) return;
#if !MK_MULTI
    if (hipMemsetAsync((char*)d_ws + WS_CTL, 0, 65536, stream) != hipSuccess) { fprintf(stderr, "kernel_launch: hipMemsetAsync failed\n"); return; }
#endif
    Args a{};
    for (int i = 0; i < 21; ++i) a.in[i] = (const float*)d_in[i];
    a.out = (float*)d_out; a.ws = (unsigned char*)d_ws;
#if MK_MULTI
    for (int ph = 0; ph < NPHASE; ++ph) { a.ph_lo = ph; a.ph_hi = ph + 1; hipLaunchKernelGGL(fwd_kernel, dim3(grid), dim3(NTHREADS), LDS_BYTES, stream, a); }
#else
    a.ph_lo = 0; a.ph_hi = NPHASE;
    void* kargs[] = {&a};
    hipError_t e = hipLaunchCooperativeKernel((void*)fwd_kernel, dim3(grid), dim3(NTHREADS), kargs, LDS_BYTES, stream);
    if (e != hipSuccess) fprintf(stderr, "kernel_launch: cooperative launch failed: %s (grid %d)\n", hipGetErrorString(e), grid);
#endif
}
```

```cpp
#include <hip/hip_runtime.h>
#include <hip/hip_cooperative_groups.h>
#include <cstdio>
#include <cstdint>
namespace cg = cooperative_groups;

#ifndef MK_MULTI
#define MK_MULTI 0
#endif

constexpr int DM = 1024, SEQ = 8192, NBATCH = 2, CTXL = 256, NLAT = NBATCH * SEQ, NROWS = NLAT + NBATCH * CTXL;
constexpr int PP = 2816;
constexpr int DFF = 2816, DFF2 = 5632, DIN = 2832, NLAYER = 2;
constexpr float EPS = 1e-6f;
constexpr float LOG2E = 1.4426950408889634f;
constexpr float QSCALE2 = 0.125f * LOG2E;
constexpr int PC_AQ = 0, PC_AK = 256, PC_AV = 384, PC_BQ = 512, PC_BK = 768, PC_BV = 896, PC_CQ = 1024, PC_CK = 1280, PC_CV = 1536, PC_CO = 1792, PC_DQ = 2048, PC_DK = 2304, PC_DV = 2560;
constexpr int NCHUNK = 132, NCHAIN = 16;

constexpr size_t MiB = 1u << 20;
constexpr size_t WS_CTL = 0, CTL_ZERO_BYTES = 1 * MiB;
constexpr size_t WS_MOD = 1 * MiB;
constexpr size_t WS_ROPE = 1 * MiB + 192 * 1024;
constexpr size_t WS_WG = 1 * MiB + 512 * 1024;
constexpr size_t WS_XC = 2 * MiB;
constexpr size_t WS_WIN = 4 * MiB;
constexpr size_t WS_WOUT = 15 * MiB;
constexpr size_t WS_WUP = 19 * MiB;
constexpr size_t WS_WDN = 41 * MiB;
constexpr size_t WS_H = 52 * MiB;
constexpr size_t WS_PROJ = 85 * MiB;
constexpr size_t WS_GATES = 176 * MiB;
constexpr size_t WS_DS = 178 * MiB;
constexpr size_t WS_SBF = 211 * MiB;
constexpr size_t WS_ZD = 228 * MiB;
constexpr size_t WS_ZC = WS_ZD + 1 * MiB;
constexpr size_t WS_GC = WS_ZC + 1 * MiB;
constexpr size_t WS_ML = WS_GC + 16384;
constexpr size_t WS_MC = WS_ML + 16384;
constexpr size_t WS_SSQ1 = 231 * MiB;
constexpr size_t WS_SSQ2 = 232 * MiB + 512 * 1024;
constexpr size_t WS_BIASUP = 234 * MiB;
constexpr size_t WS_BIASIN = 234 * MiB + 256 * 1024;
constexpr size_t WS_XG = WS_DS;
constexpr size_t WS_EDGE = WS_SBF;
constexpr size_t WS_SSQC1 = 234 * MiB + 512 * 1024;
constexpr size_t WS_SSQC2 = 234 * MiB + 768 * 1024;
constexpr size_t WS_END = 237 * MiB;

#define LAS __attribute__((address_space(3)))
#define GAS __attribute__((address_space(1)))
typedef unsigned short bf16_t;
typedef short bf16x8 __attribute__((ext_vector_type(8)));
typedef short s16x4 __attribute__((ext_vector_type(4)));
typedef float f32x4 __attribute__((ext_vector_type(4)));
typedef float f32x16 __attribute__((ext_vector_type(16)));
typedef float f32x2 __attribute__((ext_vector_type(2)));
typedef unsigned u32x4 __attribute__((ext_vector_type(4)));
typedef unsigned u32x2 __attribute__((ext_vector_type(2)));
typedef __bf16 bf16x2_t __attribute__((ext_vector_type(2)));
typedef short v4i16_t __attribute__((ext_vector_type(4)));

__device__ __forceinline__ unsigned cvtpk(float lo, float hi) { f32x2 v = {lo, hi}; bf16x2_t b = __builtin_convertvector(v, bf16x2_t); return __builtin_bit_cast(unsigned, b); }
__device__ __forceinline__ float bf2f(unsigned short b) { return __uint_as_float((unsigned)b << 16); }
__device__ __forceinline__ float bflo(unsigned w) { return __uint_as_float(w << 16); }
__device__ __forceinline__ float bfhi(unsigned w) { return __uint_as_float(w & 0xffff0000u); }
__device__ __forceinline__ float shfl_idx(float v, int src) { return __int_as_float(__builtin_amdgcn_ds_bpermute(src << 2, __float_as_int(v))); }
__device__ __forceinline__ float shfl_x(float v, int o, int lane) { return shfl_idx(v, lane ^ o); }
__device__ __forceinline__ float wave_sum(float v, int lane) {
#pragma unroll
    for (int o = 1; o < 64; o <<= 1) v += shfl_x(v, o, lane);
    return v;
}
__device__ __forceinline__ float wave_max(float v, int lane) {
#pragma unroll
    for (int o = 1; o < 64; o <<= 1) v = fmaxf(v, shfl_x(v, o, lane));
    return v;
}
#ifdef PROBE_PH
#define PROBE_PT(ldsbase, id) do { if (*(volatile LAS unsigned*)((ldsbase) + 155648 + 64)) *(volatile LAS unsigned long long*)((ldsbase) + 155648 + 72 + 8 * (id)) = __builtin_amdgcn_s_memrealtime(); } while (0)
#else
#define PROBE_PT(ldsbase, id) do { } while (0)
#endif
#define LDS_WAIT() asm volatile("s_waitcnt lgkmcnt(0)" ::: "memory")
#define VM_WAIT() asm volatile("s_waitcnt vmcnt(0)" ::: "memory")

namespace pg8 {
#define PG8_LAS __attribute__((address_space(3)))
constexpr int BM = 256, BK = 64, HALF = 128, HTB = HALF * BK * 2  , STAGE_BYTES = 8 * HTB, NXCD = 8, WGM = 8;
__host__ __device__ __forceinline__ int lds_byte(int r, int c) { const int st = (r >> 4) * 2 + (c >> 5), rr = r & 15, cc = c & 31, ob = rr * 64 + cc * 2; return st * 1024 + (ob ^ (((ob >> 9) & 1) << 5)); }
__host__ __device__ __forceinline__ void stage_rc(int b, int& R, int& C) { const int st = b / 1024, sb = b % 1024, swz = sb ^ (((sb >> 9) & 1) << 5); R = (st >> 1) * 16 + swz / 64; C = (st & 1) * 32 + (swz % 64) / 2; }
__host__ __device__ __forceinline__ int perm32(int rho) { const int n = rho >> 4, i = rho & 15; return 8 * (i >> 2) + 4 * n + (i & 3); }

struct Unit { int pm, pn, ui; };
struct Gemm { const bf16_t* A; const bf16_t* Bt; int M, N, K; };

struct StaticOrder {
    int nM, nN, nwg, G, c;
    __host__ __device__ __forceinline__ void init(int M, int N, int G_, int c_) { nM = M / BM; nN = N / BM; nwg = nM * nN; G = G_; c = c_; }
    __host__ __device__ __forceinline__ bool next(int i, Unit& u) const {
        const long L = (long)i * G + c; if (L >= nwg) return false;
        int wgid = (int)L; { const int q = nwg / NXCD, r = nwg % NXCD, xcd = wgid % NXCD, off = wgid / NXCD; wgid = (xcd < r ? xcd * (q + 1) : r * (q + 1) + (xcd - r) * q) + off; }
        const int nig = WGM * nN, gid = wgid / nig, fm = gid * WGM, gsz = (nM - fm) < WGM ? (nM - fm) : WGM;
        u.pm = fm + ((wgid % nig) % gsz); u.pn = (wgid % nig) / gsz; u.ui = i; return true;
    }
    __device__ __forceinline__ void a_ready(const Unit&) const {}
    __device__ __forceinline__ void done(const Unit&) const {}
};

constexpr int RTAB_OFF = 131072;
struct EpiProj {
    static constexpr bool PERM = true, AFTER_DRAIN = false, ROWPERM = false;
    bf16_t* O; int ldc; const LAS float* rtab; const float* bias;
    const float* gq; const float* gk; const float* rope;
    __device__ __forceinline__ void operator()(const f32x4 (&acc)[2][2][4][2], const Unit& u, int wr, int wc, int fr, int fq) const {
        asm volatile("" : "+v"(fr), "+v"(fq));
        const int row0 = u.pm * BM + wr * 64 + fr, col0 = u.pn * BM + wc * 32 + 8 * fq;
        const float sc = (u.pn == 2 || u.pn == 8) ? QSCALE2 : (u.pn == 4 ? 0.125f : 1.f);
        float rs[8] = {1.f, 1.f, 1.f, 1.f, 1.f, 1.f, 1.f, 1.f}; f32x4 bv[2][2] = {};
        if (rtab) {
#pragma unroll
            for (int i = 0; i < 8; ++i) rs[i] = rtab[u.ui * 256 + wr * 64 + fr + (i >> 2) * HALF + (i & 3) * 16];
            const int id = u.pm < 32 ? 0 : (u.pm < 64 ? 1 : 2);
#pragma unroll
            for (int bj = 0; bj < 2; ++bj)
#pragma unroll
                for (int n = 0; n < 2; ++n) bv[bj][n] = *(const f32x4*)(bias + id * PP + col0 + bj * HALF + 4 * n); }
        if (u.pn >= 4) {
#pragma unroll
            for (int ai = 0; ai < 2; ++ai)
#pragma unroll
                for (int m = 0; m < 4; ++m) { bf16_t* rowp = O + (size_t)(row0 + ai * HALF + m * 16) * ldc + col0; const float r = rs[ai * 4 + m];
#pragma unroll
                    for (int bj = 0; bj < 2; ++bj) { const f32x4 v0 = (acc[ai][bj][m][0] * r + bv[bj][0]) * sc, v1 = (acc[ai][bj][m][1] * r + bv[bj][1]) * sc;
                        u32x4 w; w.x = cvtpk(v0[0], v0[1]); w.y = cvtpk(v0[2], v0[3]); w.z = cvtpk(v1[0], v1[1]); w.w = cvtpk(v1[2], v1[3]);
                        *(u32x4*)(rowp + bj * HALF) = w; } }
            return;
        }
        const bool lat = u.pm < 64;
        const bool khead = (u.pn & 1) && wc < 2;
        const bool donorm = u.pn == 0 || (u.pn == 1 && wc < 2);
        const bool dorope = lat && (!(u.pn & 1) || khead);
        const float* gp = u.pn == 0 ? gq : gk;
        f32x4 gg[2][2];
#pragma unroll
        for (int bj = 0; bj < 2; ++bj)
#pragma unroll
            for (int n = 0; n < 2; ++n) gg[bj][n] = donorm ? *(const f32x4*)(gp + 32 * bj + 16 * n + 4 * fq) : (f32x4){1.f, 1.f, 1.f, 1.f};
        const float qs = u.pn == 0 ? QSCALE2 : 1.f;
#pragma unroll
        for (int ai = 0; ai < 2; ++ai)
#pragma unroll
            for (int m = 0; m < 4; ++m) { const int row = row0 + ai * HALF + m * 16; const float r = rs[ai * 4 + m];
                f32x4 v[2][2]; float ss = 0.f;
#pragma unroll
                for (int bj = 0; bj < 2; ++bj)
#pragma unroll
                    for (int n = 0; n < 2; ++n) { v[bj][n] = (acc[ai][bj][m][n] * r + bv[bj][n]) * sc; ss += (v[bj][n][0] * v[bj][n][0] + v[bj][n][1] * v[bj][n][1]) + (v[bj][n][2] * v[bj][n][2] + v[bj][n][3] * v[bj][n][3]); }
                if (donorm) { ss += shfl_idx(ss, (fq * 16 + fr) ^ 16); ss += shfl_idx(ss, (fq * 16 + fr) ^ 32); const float rstd = rsqrtf(ss * (1.f / 64.f) + EPS) * qs;
#pragma unroll
                    for (int bj = 0; bj < 2; ++bj)
#pragma unroll
                        for (int n = 0; n < 2; ++n) v[bj][n] = v[bj][n] * rstd * gg[bj][n]; }
                bf16_t* rowp = O + (size_t)row * ldc + u.pn * BM + 64 * wc + 4 * fq;
                const int t = row & (SEQ - 1);
#pragma unroll
                for (int bj = 0; bj < 2; ++bj) { f32x4 o1 = v[bj][0], o2 = v[bj][1];
                    if (dorope) { const float* rp = rope + ((size_t)(bj ? 128 + (t & 63) : (t >> 6)) * 16 + 4 * fq) * 2; const f32x4 c0 = *(const f32x4*)rp, c1 = *(const f32x4*)(rp + 4);
                        const f32x4 cz = {c0[0], c0[2], c1[0], c1[2]}, sz = {c0[1], c0[3], c1[1], c1[3]};
                        o1 = v[bj][0] * cz - v[bj][1] * sz; o2 = v[bj][0] * sz + v[bj][1] * cz; }
                    u32x2 w1, w2; w1.x = cvtpk(o1[0], o1[1]); w1.y = cvtpk(o1[2], o1[3]); w2.x = cvtpk(o2[0], o2[1]); w2.y = cvtpk(o2[2], o2[3]);
                    *(u32x2*)(rowp + 32 * bj) = w1; *(u32x2*)(rowp + 32 * bj + 16) = w2; } }
    }
};
struct EpiResid {
    static constexpr bool PERM = true, AFTER_DRAIN = false, ROWPERM = false;
    const float* xin_lat; const float* xin_ctx; float* xout_lat; float* xout_ctx; const float* gate;
    bf16_t* xg; const float* gn; const float* scn; float* ssq;
    __device__ __forceinline__ void operator()(const f32x4 (&acc)[2][2][4][2], const Unit& u, int wr, int wc, int fr, int fq) const {
        asm volatile("" : "+v"(fr), "+v"(fq));
        const int id = u.pm < 32 ? 0 : (u.pm < 64 ? 1 : 2);
        const float* xin = u.pm < 64 ? xin_lat + (size_t)u.pm * BM * DM : xin_ctx + (size_t)(u.pm - 64) * BM * DM;
        float* xout = u.pm < 64 ? xout_lat + (size_t)u.pm * BM * DM : xout_ctx + (size_t)(u.pm - 64) * BM * DM;
        const int rl = wr * 64 + fr, col0 = u.pn * BM + wc * 32 + 8 * fq;
        f32x4 g[2][2], gs[2][2];
#pragma unroll
        for (int bj = 0; bj < 2; ++bj)
#pragma unroll
            for (int n = 0; n < 2; ++n) { g[bj][n] = *(const f32x4*)(gate + id * 6144 + col0 + bj * HALF + 4 * n);
                if (xg) gs[bj][n] = *(const f32x4*)(gn + col0 + bj * HALF + 4 * n) * (1.f + *(const f32x4*)(scn + id * 6144 + col0 + bj * HALF + 4 * n)); }
#pragma unroll
        for (int ai = 0; ai < 2; ++ai)
#pragma unroll
            for (int m = 0; m < 4; ++m) { const size_t off = (size_t)(rl + ai * HALF + m * 16) * DM + col0; float s = 0.f;
#pragma unroll
                for (int bj = 0; bj < 2; ++bj) { f32x4 o[2];
#pragma unroll
                    for (int n = 0; n < 2; ++n) { const f32x4 xv = *(const f32x4*)(xin + off + bj * HALF + 4 * n); o[n] = xv + g[bj][n] * acc[ai][bj][m][n];
                        *(f32x4*)(xout + off + bj * HALF + 4 * n) = o[n]; s += (o[n][0] * o[n][0] + o[n][1] * o[n][1]) + (o[n][2] * o[n][2] + o[n][3] * o[n][3]); }
                    if (xg) { const f32x4 a = o[0] * gs[bj][0], b = o[1] * gs[bj][1]; u32x4 w; w.x = cvtpk(a[0], a[1]); w.y = cvtpk(a[2], a[3]); w.z = cvtpk(b[0], b[1]); w.w = cvtpk(b[2], b[3]);
                        *(u32x4*)(xg + (size_t)u.pm * BM * DM + off + bj * HALF) = w; } }
                if (xg) { s += shfl_idx(s, (fq * 16 + fr) ^ 16); s += shfl_idx(s, (fq * 16 + fr) ^ 32);
                    if (fq == 0) ssq[(size_t)(u.pm * BM + rl + ai * HALF + m * 16) * 16 + u.pn * 4 + wc] = s; } }
    }
};
struct EpiResidStaged {
    static constexpr bool PERM = true, AFTER_DRAIN = true, ROWPERM = false;
    const float* xin_lat; const float* xin_ctx; float* xout_lat; float* xout_ctx; const float* gate;
    bf16_t* xg; const float* gn; const float* scn; float* ssq;
    static constexpr int RS = 1040;
    __device__ __forceinline__ void operator()(const f32x4 (&)[2][2][4][2], const Unit&, int, int, int, int) const {}
    __device__ __forceinline__ void fused(const f32x4 (&acc)[2][2][4][2], const Unit& u, int wr, int wc, int fr, int fq, PG8_LAS unsigned char* lds, int wid, int lane) const {
        const int id = u.pm < 32 ? 0 : (u.pm < 64 ? 1 : 2);
        const float* xin = u.pm < 64 ? xin_lat + (size_t)u.pm * BM * DM : xin_ctx + (size_t)(u.pm - 64) * BM * DM;
        float* xout = u.pm < 64 ? xout_lat + (size_t)u.pm * BM * DM : xout_ctx + (size_t)(u.pm - 64) * BM * DM;
        const int colg = u.pn * BM + 4 * lane;
        const f32x4 gv = *(const f32x4*)(gate + id * 6144 + colg);
        f32x4 gsv = {0.f, 0.f, 0.f, 0.f}; if (xg) gsv = *(const f32x4*)(gn + colg) * (1.f + *(const f32x4*)(scn + id * 6144 + colg));
#pragma unroll
        for (int ai = 0; ai < 2; ++ai) {
#pragma unroll
            for (int m = 0; m < 4; ++m)
#pragma unroll
                for (int bj = 0; bj < 2; ++bj)
#pragma unroll
                    for (int n = 0; n < 2; ++n) *(PG8_LAS f32x4*)(lds + (wr * 64 + m * 16 + fr) * RS + (bj * HALF + wc * 32 + 8 * fq + 4 * n) * 4) = acc[ai][bj][m][n];
            asm volatile("s_waitcnt lgkmcnt(0)\n\ts_barrier" ::: "memory");
#pragma unroll
            for (int r8 = 0; r8 < 2; ++r8) {
                f32x4 xv[8], av[8]; float s[8];
#pragma unroll
                for (int q = 0; q < 8; ++q) { const int row = wid * 16 + r8 * 8 + q; xv[q] = *(const f32x4*)(xin + (size_t)(ai * HALF + row) * DM + colg); av[q] = *(const PG8_LAS f32x4*)(lds + row * RS + lane * 16); }
#pragma unroll
                for (int q = 0; q < 8; ++q) { const int row = wid * 16 + r8 * 8 + q; const f32x4 o = xv[q] + gv * av[q];
                    *(f32x4*)(xout + (size_t)(ai * HALF + row) * DM + colg) = o; s[q] = (o[0] * o[0] + o[1] * o[1]) + (o[2] * o[2] + o[3] * o[3]);
                    if (xg) { const f32x4 a = o * gsv; u32x2 w; w.x = cvtpk(a[0], a[1]); w.y = cvtpk(a[2], a[3]); *(u32x2*)(xg + (size_t)(u.pm * BM + ai * HALF + row) * DM + colg) = w; } }
                if (xg) {
#pragma unroll
                    for (int o_ = 1; o_ < 64; o_ <<= 1)
#pragma unroll
                        for (int q = 0; q < 8; ++q) s[q] += shfl_x(s[q], o_, lane);
                    float sv = s[0];
#pragma unroll
                    for (int q = 1; q < 8; ++q) sv = lane == q ? s[q] : sv;
                    if (lane < 8) *(f32x4*)(ssq + (size_t)(u.pm * BM + ai * HALF + wid * 16 + r8 * 8 + lane) * 16 + u.pn * 4) = (f32x4){sv, 0.f, 0.f, 0.f}; }
            }
            asm volatile("s_waitcnt lgkmcnt(0)\n\ts_barrier" ::: "memory");
        }
    }
};
struct EpiUp {
    static constexpr bool PERM = true, AFTER_DRAIN = false, ROWPERM = true;
    bf16_t* act; const float* convw; const float* convb; float* edge; const LAS float* rtab; const float* bias;
    __device__ __forceinline__ void operator()(f32x4 (&acc)[2][2][4][2], const Unit& u, int wr, int wc, int fr, int fq) const {
        asm volatile("" : "+v"(fr), "+v"(fq));
        const int chb = u.pn * 128 + wc * 32 + 8 * fq;
        const int ht = 2 * u.pm + wr;
        {
            const f32x4 ra = *(const LAS f32x4*)(rtab + u.ui * 256 + (wr * 16 + fr) * 8), rb = *(const LAS f32x4*)(rtab + u.ui * 256 + (wr * 16 + fr) * 8 + 4);
            const float rs[8] = {ra[0], ra[1], ra[2], ra[3], rb[0], rb[1], rb[2], rb[3]};
            const int id = u.pm < 32 ? 0 : (u.pm < 64 ? 1 : 2);
#pragma unroll
            for (int bj = 0; bj < 2; ++bj)
#pragma unroll
                for (int n = 0; n < 2; ++n) { const f32x4 bv = *(const f32x4*)(bias + id * DFF2 + bj * DFF + chb + 4 * n);
#pragma unroll
                    for (int sl = 0; sl < 8; ++sl) { acc[sl >> 2][bj][sl & 3][n] = acc[sl >> 2][bj][sl & 3][n] * rs[sl] + bv; asm volatile("" : "+v"(acc[sl >> 2][bj][sl & 3][n])); } }
        }
        const int lm1 = (fq * 16 + fr - 1) & 63, lp1 = (fq * 16 + fr + 1) & 63;
#pragma unroll
        for (int bj = 0; bj < 2; ++bj)
#pragma unroll
            for (int n = 0; n < 2; ++n) {
                const int uc = bj * DFF + chb + 4 * n;
                if (fr == 0) { *(f32x4*)(edge + ((size_t)ht * 4 + 0) * DFF2 + uc) = acc[0][bj][0][n]; *(f32x4*)(edge + ((size_t)ht * 4 + 1) * DFF2 + uc) = acc[0][bj][1][n]; }
                if (fr == 15) { *(f32x4*)(edge + ((size_t)ht * 4 + 2) * DFF2 + uc) = acc[1][bj][2][n]; *(f32x4*)(edge + ((size_t)ht * 4 + 3) * DFF2 + uc) = acc[1][bj][3][n]; }
#pragma unroll
                for (int j = 0; j < 4; ++j) {
                    const float w0 = convw[uc + j], w1 = convw[DFF2 + uc + j], w2 = convw[2 * DFF2 + uc + j], bb = convb[uc + j];
                    float pv = shfl_idx(acc[1][bj][3][n][j], lm1); const float nx = shfl_idx(acc[0][bj][0][n][j], lp1);
#pragma unroll
                    for (int sl = 0; sl < 8; ++sl) { const float cur = acc[sl >> 2][bj][sl & 3][n][j]; const float nxt = sl < 7 ? acc[(sl + 1) >> 2][bj][(sl + 1) & 3][n][j] : nx;
                        acc[sl >> 2][bj][sl & 3][n][j] = w0 * pv + w1 * cur + w2 * nxt + bb; pv = cur; }
                }
#pragma unroll
                for (int sl = 0; sl < 8; ++sl) asm volatile("" : "+v"(acc[sl >> 2][bj][sl & 3][n]));
            }
        bf16_t* base = act + (size_t)(u.pm * BM + (wr * 16 + fr) * 8) * DFF + chb;
#pragma unroll
        for (int sl = 0; sl < 8; ++sl) {
            const f32x4 g0 = acc[sl >> 2][0][sl & 3][0], g1 = acc[sl >> 2][0][sl & 3][1], v0 = acc[sl >> 2][1][sl & 3][0], v1 = acc[sl >> 2][1][sl & 3][1];
            f32x4 o0, o1;
#pragma unroll
            for (int j = 0; j < 4; ++j) { o0[j] = g0[j] * __builtin_amdgcn_rcpf(1.f + __builtin_amdgcn_exp2f(-LOG2E * g0[j])) * v0[j]; o1[j] = g1[j] * __builtin_amdgcn_rcpf(1.f + __builtin_amdgcn_exp2f(-LOG2E * g1[j])) * v1[j]; }
            u32x4 w; w.x = cvtpk(o0[0], o0[1]); w.y = cvtpk(o0[2], o0[3]); w.z = cvtpk(o1[0], o1[1]); w.w = cvtpk(o1[2], o1[3]);
            const bool skip = (fr == 0 && sl == 0) || (fr == 15 && sl == 7);
            if (!skip) *(u32x4*)(base + (size_t)sl * DFF) = w;
        }
    }
};
template <class Epi, class Sched, bool ALIGN_EPI = false, bool SP2 = false>
__device__ __forceinline__ void gemm_phase(PG8_LAS unsigned char* lds, const Gemm g, const Sched& S, const Epi& E, const int tid) {
    const int wid = __builtin_amdgcn_readfirstlane(tid >> 6), lane = tid & 63, wr = wid >> 2, wc = wid & 3, fr = lane & 15, fq = lane >> 4;
    const int K = g.K, nt = K / BK;
    unsigned voffA[2], voffB[2];
#pragma unroll
    for (int i = 0; i < 2; ++i) { int R, C; stage_rc(tid * 16 + i * 8192, R, C); const int Rb = Epi::PERM ? ((R & ~31) + perm32(R & 31)) : R;
        const int Ra = Epi::ROWPERM ? (((((R >> 6) & 1) * 16 + (R & 15)) << 3) + ((R >> 4) & 3)) : R;
        voffA[i] = (unsigned)(Ra * K + C) * 2u; voffB[i] = (unsigned)(Rb * K + C) * 2u; }
    const size_t kstep = (size_t)(BK * 2);
    const size_t hstep = (size_t)HALF * K * 2;
    const size_t hstepA = Epi::ROWPERM ? (size_t)4 * K * 2 : hstep;
    const size_t tstep = 2 * hstep;
    const unsigned ldsw = (unsigned)wid * 1024u;
    const int aoff = lds_byte(wr * 64 + fr, fq * 8), boff = lds_byte(wc * 32 + fr, fq * 8);
#define PG8_SA(b, h) (((b) * 2 + (h)) * HTB)
#define PG8_SB(b, h) ((4 + (b) * 2 + (h)) * HTB)
#define PG8_STAGE(bufoff, gbase, voff) do { _Pragma("unroll") for (int _i = 0; _i < 2; ++_i) \
        __builtin_amdgcn_global_load_lds((const unsigned*)((const char*)(gbase) + (voff)[_i]), (PG8_LAS unsigned*)(lds + (bufoff) + ldsw + _i * 8192), 16, 0, 0); } while (0)
#define PG8_LDA(dst, b, h) do { _Pragma("unroll") for (int m = 0; m < 4; ++m) _Pragma("unroll") for (int k = 0; k < 2; ++k) dst[m][k] = *(const PG8_LAS bf16x8*)(lds + PG8_SA(b, h) + aoff + m * 2048 + k * 1024); } while (0)
#define PG8_LDB(dst, b, h) do { _Pragma("unroll") for (int n = 0; n < 2; ++n) _Pragma("unroll") for (int k = 0; k < 2; ++k) dst[n][k] = *(const PG8_LAS bf16x8*)(lds + PG8_SB(b, h) + boff + n * 2048 + k * 1024); } while (0)
#define PG8_MMA(ai, bj, At, Bt) do { __builtin_amdgcn_s_setprio(1); _Pragma("unroll") for (int m = 0; m < 4; ++m) _Pragma("unroll") for (int n = 0; n < 2; ++n) _Pragma("unroll") for (int k = 0; k < 2; ++k) \
        acc[ai][bj][m][n] = __builtin_amdgcn_mfma_f32_16x16x32_bf16(Bt[n][k], At[m][k], acc[ai][bj][m][n], 0, 0, 0); __builtin_amdgcn_s_setprio(0); } while (0)
#define PG8_WAIT_V(n) asm volatile("s_waitcnt vmcnt(" #n ")" ::: "memory")
#define PG8_WAIT_L(n) asm volatile("s_waitcnt lgkmcnt(" #n ")" ::: "memory")
#define PG8_BAR __builtin_amdgcn_s_barrier()
#define PG8_SCHED __builtin_amdgcn_sched_barrier(0)
    Unit cur, nxt; int ui = 0;
    if (!S.next(0, cur)) return;
    f32x4 acc[2][2][4][2];
#pragma unroll
    for (int a = 0; a < 2; ++a)
#pragma unroll
        for (int b = 0; b < 2; ++b)
#pragma unroll
            for (int m = 0; m < 4; ++m)
#pragma unroll
                for (int n = 0; n < 2; ++n) acc[a][b][m][n] = (f32x4){0.f, 0.f, 0.f, 0.f};
    bf16x8 At[4][2], B0[2][2], B1[2][2];
    const char* cA = (const char*)g.A + (size_t)cur.pm * tstep; const char* cB = (const char*)g.Bt + (size_t)cur.pn * tstep;
    S.a_ready(cur);
    if constexpr (SP2) {
        PG8_STAGE(PG8_SB(0, 0), cB, voffB); PG8_STAGE(PG8_SB(0, 1), cB + hstep, voffB); PG8_STAGE(PG8_SA(0, 0), cA, voffA); PG8_STAGE(PG8_SA(0, 1), cA + hstepA, voffA);
        if (wr == 1) PG8_BAR;
        PG8_WAIT_V(2); PG8_BAR;
        PG8_STAGE(PG8_SB(1, 0), cB + kstep, voffB); PG8_STAGE(PG8_SA(1, 0), cA + kstep, voffA); PG8_STAGE(PG8_SB(1, 1), cB + hstep + kstep, voffB);
        PG8_WAIT_V(6); PG8_BAR;
    } else {
        PG8_STAGE(PG8_SB(0, 0), cB, voffB); PG8_STAGE(PG8_SA(0, 0), cA, voffA); PG8_STAGE(PG8_SB(0, 1), cB + hstep, voffB); PG8_STAGE(PG8_SA(0, 1), cA + hstepA, voffA);
        if (wr == 1) PG8_BAR;
        PG8_WAIT_V(4); PG8_BAR;
        PG8_STAGE(PG8_SB(1, 0), cB + kstep, voffB); PG8_STAGE(PG8_SA(1, 0), cA + kstep, voffA); PG8_STAGE(PG8_SB(1, 1), cB + hstep + kstep, voffB);
        PG8_WAIT_V(6); PG8_BAR;
    }
    PROBE_PT(lds, 1);
    for (;;) {
        const bool has_next = S.next(ui + 1, nxt);
        const char* nA = has_next ? (const char*)g.A + (size_t)nxt.pm * tstep : cA; const char* nB = has_next ? (const char*)g.Bt + (size_t)nxt.pn * tstep : cB;
        for (int t = 0; t < nt; t += 2) {
            const bool last = (t == nt - 2);
            const char* a1 = cA + (size_t)(t + 1) * kstep;
            const char* a2 = last ? nA : cA + (size_t)(t + 2) * kstep; const char* b2 = last ? nB : cB + (size_t)(t + 2) * kstep;
            const char* a3 = a2 + kstep; const char* b3 = b2 + kstep;
            if (last && has_next) S.a_ready(nxt);
            if constexpr (SP2) {
            PG8_LDB(B0, 0, 0); PG8_LDB(B1, 0, 1); PG8_SCHED; PG8_LDA(At, 0, 0); PG8_STAGE(PG8_SA(1, 1), a1 + hstepA, voffA);
            PG8_WAIT_V(8); PG8_WAIT_L(0); PG8_BAR; PG8_MMA(0, 0, At, B0); PG8_MMA(0, 1, At, B1); PG8_BAR; PG8_SCHED;
            PG8_LDA(At, 0, 1); PG8_STAGE(PG8_SB(0, 0), b2, voffB); PG8_STAGE(PG8_SB(0, 1), b2 + hstep, voffB); PG8_STAGE(PG8_SA(0, 0), a2, voffA);
            PG8_WAIT_V(8); PG8_WAIT_L(0); PG8_BAR; PG8_MMA(1, 0, At, B0); PG8_MMA(1, 1, At, B1); PG8_BAR; PG8_SCHED;
            PG8_LDB(B0, 1, 0); PG8_LDB(B1, 1, 1); PG8_SCHED; PG8_LDA(At, 1, 0); PG8_STAGE(PG8_SA(0, 1), a2 + hstepA, voffA);
            PG8_WAIT_V(8); PG8_WAIT_L(0); PG8_BAR; PG8_MMA(0, 0, At, B0); PG8_MMA(0, 1, At, B1); PG8_BAR; PG8_SCHED;
            PG8_LDA(At, 1, 1); PG8_STAGE(PG8_SB(1, 0), b3, voffB); PG8_STAGE(PG8_SB(1, 1), b3 + hstep, voffB); PG8_STAGE(PG8_SA(1, 0), a3, voffA);
            PG8_WAIT_V(8); PG8_WAIT_L(0); PG8_BAR; PG8_MMA(1, 0, At, B0); PG8_MMA(1, 1, At, B1); PG8_BAR; PG8_SCHED;
            } else {
            PG8_LDB(B0, 0, 0); PG8_SCHED; PG8_LDA(At, 0, 0); PG8_STAGE(PG8_SA(1, 1), a1 + hstepA, voffA);
            PG8_WAIT_L(8); PG8_BAR; PG8_WAIT_L(0); PG8_MMA(0, 0, At, B0); PG8_BAR; PG8_SCHED;
            PG8_LDB(B1, 0, 1); PG8_STAGE(PG8_SB(0, 0), b2, voffB);
            PG8_BAR; PG8_WAIT_L(0); PG8_MMA(0, 1, At, B1); PG8_BAR;
            PG8_LDA(At, 0, 1); PG8_STAGE(PG8_SA(0, 0), a2, voffA);
            PG8_BAR; PG8_WAIT_L(0); PG8_MMA(1, 0, At, B0); PG8_BAR; PG8_SCHED;
            PG8_STAGE(PG8_SB(0, 1), b2 + hstep, voffB);
            PG8_WAIT_V(6); PG8_BAR; PG8_MMA(1, 1, At, B1); PG8_BAR;
            PG8_LDB(B0, 1, 0); PG8_SCHED; PG8_LDA(At, 1, 0); PG8_STAGE(PG8_SA(0, 1), a2 + hstepA, voffA);
            PG8_WAIT_L(8); PG8_BAR; PG8_WAIT_L(0); PG8_MMA(0, 0, At, B0); PG8_BAR; PG8_SCHED;
            PG8_LDB(B1, 1, 1); PG8_STAGE(PG8_SB(1, 0), b3, voffB);
            PG8_BAR; PG8_WAIT_L(0); PG8_MMA(0, 1, At, B1); PG8_BAR;
            PG8_LDA(At, 1, 1); PG8_STAGE(PG8_SA(1, 0), a3, voffA);
            PG8_BAR; PG8_WAIT_L(0); PG8_MMA(1, 0, At, B0); PG8_BAR; PG8_SCHED;
            PG8_STAGE(PG8_SB(1, 1), b3 + hstep, voffB);
            PG8_WAIT_V(6); PG8_BAR; PG8_MMA(1, 1, At, B1); PG8_BAR;
            }
        }
        PROBE_PT(lds, 2);
        if constexpr (ALIGN_EPI) { if (wr == 0) PG8_BAR; }
        if constexpr (!Epi::AFTER_DRAIN) { E(acc, cur, wr, wc, fr, fq); S.done(cur); }
        PROBE_PT(lds, 3);
        if (!has_next) break;
#pragma unroll
        for (int a = 0; a < 2; ++a)
#pragma unroll
            for (int b = 0; b < 2; ++b)
#pragma unroll
                for (int m = 0; m < 4; ++m)
#pragma unroll
                    for (int n = 0; n < 2; ++n) acc[a][b][m][n] = (f32x4){0.f, 0.f, 0.f, 0.f};
        cur = nxt; cA = nA; cB = nB; ++ui;
        if constexpr (ALIGN_EPI) { if (wr == 1) PG8_BAR; }
    }
    PG8_WAIT_V(0);
    if constexpr (!ALIGN_EPI) { if (wr == 0) PG8_BAR; }
    PG8_BAR;
    if constexpr (Epi::AFTER_DRAIN) { E.fused(acc, cur, wr, wc, fr, fq, lds, wid, lane); S.done(cur); }
#undef PG8_SA
#undef PG8_SB
#undef PG8_STAGE
#undef PG8_LDA
#undef PG8_LDB
#undef PG8_MMA
#undef PG8_WAIT_V
#undef PG8_WAIT_L
#undef PG8_BAR
#undef PG8_SCHED
}
}

constexpr size_t WS_WGB = WS_WG + 192 * 1024;
constexpr size_t WS_MODP = 235 * MiB;
constexpr int NWAVES = 8, NTHREADS = 512;
constexpr int LDSCTL_OFF = 155648;
constexpr int LDS_BYTES = LDSCTL_OFF + 256;
struct Args {
    const float* in[21]; float* out; unsigned char* ws; int ph_lo, ph_hi;
};
struct Frame {
    LAS unsigned char* lds;
    int tid, lane, wave, G, bid;
    const __attribute__((address_space(4))) Args* ka;
    float* out; unsigned char* ws;
};
enum { IN_X = 0, IN_C, IN_CTX, IN_CCTX, IN_WMOD, IN_BMOD, IN_G1, IN_G2, IN_WIN, IN_AQG, IN_AKG, IN_SINK, IN_CGB, IN_RPB, IN_GGRP, IN_WOUT, IN_WUP, IN_CONVW, IN_CONVB, IN_WDN, IN_GFIN };

template <class MapFn>
__device__ __forceinline__ void transpose_item(const float* W, int K, int N, bf16_t* WT, LAS float* scr, int item, int lane, MapFn map) {
    const int nblk = (N + 63) / 64, kb = item / nblk, nb = item % nblk, k0 = 64 * kb, n0 = 64 * nb;
    const int nc = n0 + 4 * (lane & 15);
    f32x4 v[16];
#pragma unroll
    for (int i = 0; i < 16; ++i) { const int kk = (lane >> 4) + 4 * i; v[i] = nc < N ? *(const f32x4*)(W + (size_t)(k0 + kk) * N + nc) : (f32x4){0.f, 0.f, 0.f, 0.f}; }
#pragma unroll
    for (int i = 0; i < 16; ++i) { const int kk = (lane >> 4) + 4 * i; LAS float* d = scr + kk * 65 + 4 * (lane & 15); d[0] = v[i][0]; d[1] = v[i][1]; d[2] = v[i][2]; d[3] = v[i][3]; }
    LDS_WAIT(); asm volatile("" ::: "memory");
    const int c = lane & 7;
#pragma unroll
    for (int j = 0; j < 8; ++j) { const int n = (lane >> 3) + 8 * j; const LAS float* s = scr + (8 * c) * 65 + n;
        u32x4 o; o.x = cvtpk(s[0 * 65], s[1 * 65]); o.y = cvtpk(s[2 * 65], s[3 * 65]); o.z = cvtpk(s[4 * 65], s[5 * 65]); o.w = cvtpk(s[6 * 65], s[7 * 65]);
        const int sc = n0 + n; const int dr = sc < N ? map(sc) : -1;
        if (dr >= 0) *(u32x4*)(WT + (size_t)dr * K + k0 + 8 * c) = o; }
    LDS_WAIT(); asm volatile("" ::: "memory");
}
__device__ __forceinline__ void p0_prologue(Frame& F) {
    const float* c = F.ka->in[IN_C]; const float* cctx = F.ka->in[IN_CCTX];
    const int gw = F.bid * NWAVES + F.wave, NGW = F.G * NWAVES;
    if (F.bid < NLAYER * 48 || F.G < NLAYER * 48 + 8) {
        LAS float* sv = (LAS float*)F.lds;
        LAS float* red = (LAS float*)(F.lds + 12288);
        for (int i = F.tid; i < 3 * 1024; i += NTHREADS) { const int id = i >> 10, k = i & 1023; const float v = id < 2 ? c[id * 1024 + k] : cctx[k]; sv[i] = v / (1.f + __expf(-v)); }
        __syncthreads();
        float* MOD = (float*)(F.ws + WS_MOD);
        for (int it = F.bid; it < NLAYER * 48; it += F.G) {
            const int l = it / 48, nb = it % 48, n = nb * 128 + 2 * F.lane;
            const float* w = F.ka->in[IN_WMOD] + ((size_t)l * 1024 + F.wave * 128) * 6144 + n;
            f32x2 a0 = {0.f, 0.f}, a1 = {0.f, 0.f}, a2 = {0.f, 0.f};
#pragma unroll 32
            for (int k = 0; k < 128; ++k) { const f32x2 wv = *(const f32x2*)(w + (size_t)k * 6144); const int kk = F.wave * 128 + k; a0 += sv[kk] * wv; a1 += sv[1024 + kk] * wv; a2 += sv[2048 + kk] * wv; }
            *(LAS f32x2*)(red + (F.wave * 3 + 0) * 128 + 2 * F.lane) = a0; *(LAS f32x2*)(red + (F.wave * 3 + 1) * 128 + 2 * F.lane) = a1; *(LAS f32x2*)(red + (F.wave * 3 + 2) * 128 + 2 * F.lane) = a2;
            __syncthreads();
            if (F.tid < 384) { const int id = F.tid >> 7, ln = F.tid & 127; float s = F.ka->in[IN_BMOD][l * 6144 + nb * 128 + ln];
#pragma unroll
                for (int w8 = 0; w8 < 8; ++w8) s += red[(w8 * 3 + id) * 128 + ln];
                MOD[((size_t)l * 3 + id) * 6144 + nb * 128 + ln] = s; }
            __syncthreads();
        }
    }
    PROBE_PT(F.lds, 1);
    { const int b0 = F.G >= NLAYER * 48 + 8 ? NLAYER * 48 : 0, nb_ = F.G - b0;
      if (F.bid >= b0) { const int gt2 = (F.bid - b0) * NTHREADS + F.tid, NGT2 = nb_ * NTHREADS;
        float* ROPE = (float*)(F.ws + WS_ROPE); float* WG = (float*)(F.ws + WS_WG); bf16_t* WGB = (bf16_t*)(F.ws + WS_WGB);
        for (int e = gt2; e < 192 * 16 + NLAYER * 16 * 1024; e += NGT2) {
            if (e < 192 * 16) { const int idx = e >> 4, i = e & 15; const float pos = (float)(idx < 128 ? idx : idx - 128);
                const float freq = powf(10000.0f, -(float)i / 16.0f); const float ang = pos * freq; ROPE[2 * e] = cosf(ang); ROPE[2 * e + 1] = sinf(ang); }
            else { const int e2 = e - 192 * 16, l = e2 >> 14, o = (e2 >> 10) & 15, k = e2 & 1023; const float v = F.ka->in[IN_WIN][((size_t)l * 1024 + k) * DIN + 2048 + o]; WG[e2] = v; WGB[e2] = (bf16_t)(cvtpk(v, 0.f) & 0xffffu); } } } }
    PROBE_PT(F.lds, 2);
    LAS float* scr = (LAS float*)(F.lds + F.wave * 16896);
    constexpr int I_IN = 16 * 45, I_OUT = 16 * 16, I_UP = 16 * 88, I_DN = 44 * 16, I_L = I_IN + I_OUT + I_UP + I_DN;
    for (int it = gw; it < NLAYER * I_L; it += NGW) {
        const int l = it / I_L; int r = it % I_L;
        if (r < I_IN) { transpose_item(F.ka->in[IN_WIN] + (size_t)l * 1024 * DIN, 1024, DIN, (bf16_t*)(F.ws + WS_WIN) + (size_t)l * PP * 1024, scr, r, F.lane,
                                       [](int n) { if (n < 1024) { const int d = n & 63, hh = (n >> 6) & 3; return (n & ~255) + 128 * (d >> 5) + 32 * hh + 8 * ((d & 15) >> 2) + 4 * ((d >> 4) & 1) + (d & 3); }
                                                   return n < 2048 ? n : (n < 2064 ? -1 : n - 16); }); continue; } r -= I_IN;
        if (r < I_OUT) { transpose_item(F.ka->in[IN_WOUT] + (size_t)l * 1024 * 1024, 1024, 1024, (bf16_t*)(F.ws + WS_WOUT) + (size_t)l * 1024 * 1024, scr, r, F.lane, [](int n) { return n; }); continue; } r -= I_OUT;
        if (r < I_UP) { transpose_item(F.ka->in[IN_WUP] + (size_t)l * 1024 * DFF2, 1024, DFF2, (bf16_t*)(F.ws + WS_WUP) + (size_t)l * DFF2 * 1024, scr, r, F.lane,
                                       [](int n) { const int m = n < DFF ? n : n - DFF; return (m >> 7) * 256 + (n < DFF ? 0 : 128) + (m & 127); }); continue; } r -= I_UP;
        transpose_item(F.ka->in[IN_WDN] + (size_t)l * DFF * 1024, DFF, 1024, (bf16_t*)(F.ws + WS_WDN) + (size_t)l * 1024 * DFF, scr, r, F.lane, [](int n) { return n; });
    }
}

template <int R>
__device__ __forceinline__ void norm_rows(Frame& F, const float* xbase, int row0, const float* sh, const float* sc, const f32x4 (&gv)[4]) {
    bf16_t* H = (bf16_t*)(F.ws + WS_H);
    f32x4 hv[R][4]; float ss[R];
#pragma unroll
    for (int r = 0; r < R; ++r)
#pragma unroll
        for (int j = 0; j < 4; ++j) hv[r][j] = *(const f32x4*)(xbase + (size_t)r * DM + 4 * F.lane + 256 * j);
#pragma unroll
    for (int r = 0; r < R; ++r) { float s = 0.f;
#pragma unroll
        for (int j = 0; j < 4; ++j) s += (hv[r][j][0] * hv[r][j][0] + hv[r][j][1] * hv[r][j][1]) + (hv[r][j][2] * hv[r][j][2] + hv[r][j][3] * hv[r][j][3]);
        ss[r] = s; }
#pragma unroll
    for (int o = 1; o < 64; o <<= 1)
#pragma unroll
        for (int r = 0; r < R; ++r) ss[r] += shfl_x(ss[r], o, F.lane);
#pragma unroll
    for (int j = 0; j < 4; ++j) { const f32x4 scv = 1.f + *(const f32x4*)(sc + 4 * F.lane + 256 * j), shv = *(const f32x4*)(sh + 4 * F.lane + 256 * j);
#pragma unroll
        for (int r = 0; r < R; ++r) { const f32x4 v = hv[r][j] * rsqrtf(ss[r] * (1.f / DM) + EPS) * gv[j] * scv + shv;
            u32x2 w; w.x = cvtpk(v[0], v[1]); w.y = cvtpk(v[2], v[3]);
            *(u32x2*)(H + (size_t)(row0 + r) * DM + 4 * F.lane + 256 * j) = w; } }
}
__device__ __forceinline__ void norm_phase(Frame& F, int layer) {
    const int gw = F.bid * NWAVES + F.wave, NGW = F.G * NWAVES;
    const float* gvec = F.ka->in[IN_G1] + layer * 1024;
    const float* mod = (const float*)(F.ws + WS_MOD) + (size_t)layer * 3 * 6144;
    const float* xl = F.ka->in[IN_X]; const float* xc = F.ka->in[IN_CTX];
    f32x4 gv[4];
#pragma unroll
    for (int j = 0; j < 4; ++j) gv[j] = *(const f32x4*)(gvec + 4 * F.lane + 256 * j);
    for (int rg = gw; rg < NLAT / 8; rg += NGW) { const int row0 = rg * 8, id = row0 < SEQ ? 0 : 1; norm_rows<8>(F, xl + (size_t)row0 * DM, row0, mod + id * 6144, mod + id * 6144 + 1024, gv); }
    for (int rg = gw; rg < NBATCH * CTXL / 2; rg += NGW) { const int row0 = rg * 2; norm_rows<2>(F, xc + (size_t)row0 * DM, NLAT + row0, mod + 2 * 6144, mod + 2 * 6144 + 1024, gv); }
}

constexpr size_t WS_BIASG = WS_BIASIN + 64 * 1024;
__device__ __forceinline__ void bias_phase(Frame& F, int bslot, int nslots) {
    if (bslot < 0 && nslots > 0) return;
    if (nslots <= 0) { bslot = F.bid; nslots = F.G; }
    const int gw = bslot * NWAVES + F.wave, NGW = nslots * NWAVES, lane = F.lane, fr = lane & 15, fq = lane >> 4;
    const float* MOD = (const float*)(F.ws + WS_MOD);
    float* BUP = (float*)(F.ws + WS_BIASUP); float* BIN = (float*)(F.ws + WS_BIASIN); float* BG = (float*)(F.ws + WS_BIASG);
    constexpr int J_UP = DFF2 / 16, J_IN = PP / 16;
    for (int job = gw; job < 2 * J_UP + J_IN + 1; job += NGW) {
        const bool isup = job < 2 * J_UP, isin = !isup && job < 2 * J_UP + J_IN; const int l = isup ? job / J_UP : 1, r0 = 16 * (isup ? job % J_UP : (isin ? job - 2 * J_UP : 0));
        const bf16_t* wrow = isup ? (const bf16_t*)(F.ws + WS_WUP) + ((size_t)l * DFF2 + r0 + fr) * 1024 : (isin ? (const bf16_t*)(F.ws + WS_WIN) + ((size_t)PP + r0 + fr) * 1024 : (const bf16_t*)(F.ws + WS_WGB) + (size_t)(16 + fr) * 1024);
        const float* sh = MOD + ((size_t)l * 3 + (fr < 3 ? fr : 0)) * 6144 + (isup ? 3 * 1024 : 0) + 8 * fq;
        const bf16_t* bp = wrow + 8 * fq;
        f32x4 acc = {0.f, 0.f, 0.f, 0.f};
        for (int k0 = 0; k0 < DM / 32; k0 += 8) { f32x4 a0[8], a1[8]; bf16x8 bv[8];
#pragma unroll
            for (int j = 0; j < 8; ++j) { a0[j] = *(const f32x4*)(sh + 32 * (k0 + j)); a1[j] = *(const f32x4*)(sh + 32 * (k0 + j) + 4); bv[j] = *(const bf16x8*)(bp + 32 * (k0 + j)); }
#pragma unroll
            for (int j = 0; j < 8; ++j) { u32x4 aw; aw.x = cvtpk(a0[j][0], a0[j][1]); aw.y = cvtpk(a0[j][2], a0[j][3]); aw.z = cvtpk(a1[j][0], a1[j][1]); aw.w = cvtpk(a1[j][2], a1[j][3]);
                acc = __builtin_amdgcn_mfma_f32_16x16x32_bf16(__builtin_bit_cast(bf16x8, aw), bv[j], acc, 0, 0, 0); } }
        if (fq == 0) { const int r = r0 + fr;
            if (isup) { const int pn = r >> 8, i = r & 255; const int uc = i < 128 ? pn * 128 + i : DFF + pn * 128 + (i - 128);
                BUP[((size_t)l * 3 + 0) * DFF2 + uc] = acc[0]; BUP[((size_t)l * 3 + 1) * DFF2 + uc] = acc[1]; BUP[((size_t)l * 3 + 2) * DFF2 + uc] = acc[2]; }
            else if (isin) { BIN[r] = acc[0]; BIN[PP + r] = acc[1]; BIN[2 * PP + r] = acc[2]; }
            else { BG[fr] = acc[0]; BG[16 + fr] = acc[1]; BG[32 + fr] = acc[2]; } }
    }
}
__device__ __forceinline__ void gates_phase(Frame& F, int layer) {
    const int gw = F.bid * NWAVES + F.wave, NGW = F.G * NWAVES, lane = F.lane, fr = lane & 15, fq = lane >> 4;
    const bf16_t* H = (const bf16_t*)(F.ws + WS_H); const float* SSQ = (const float*)(F.ws + WS_SSQ1); const float* SSQC = (const float*)(F.ws + WS_SSQC1);
    const bf16_t* WGB = (const bf16_t*)(F.ws + WS_WGB) + (size_t)layer * 16 * 1024; const float* BG = (const float*)(F.ws + WS_BIASG);
    float* GATES = (float*)(F.ws + WS_GATES);
    for (int job = gw; job < NROWS / 16; job += NGW) {
        const int r0 = 16 * job; const int id = r0 < SEQ ? 0 : (r0 < NLAT ? 1 : 2);
        const bf16_t* ap = H + (size_t)(r0 + fr) * DM + 8 * fq; const bf16_t* bp = WGB + (size_t)fr * DM + 8 * fq;
        f32x4 acc = {0.f, 0.f, 0.f, 0.f};
        for (int k0 = 0; k0 < DM / 32; k0 += 16) { bf16x8 av[16], bv[16];
#pragma unroll
            for (int j = 0; j < 16; ++j) { av[j] = *(const bf16x8*)(ap + 32 * (k0 + j)); bv[j] = *(const bf16x8*)(bp + 32 * (k0 + j)); }
#pragma unroll
            for (int j = 0; j < 16; ++j) acc = __builtin_amdgcn_mfma_f32_16x16x32_bf16(av[j], bv[j], acc, 0, 0, 0); }
        float rs[4] = {1.f, 1.f, 1.f, 1.f}, bo = 0.f;
        if (layer > 0) {
            float s = 0.f;
            if (r0 < NLAT) { const f32x4 a = *(const f32x4*)(SSQ + (size_t)(r0 + (lane >> 2)) * 16 + 4 * (lane & 3)); s = (a[0] + a[1]) + (a[2] + a[3]); }
            else { const float* p = SSQC + (size_t)(r0 - NLAT + (lane >> 2)) * 64 + 16 * (lane & 3);
#pragma unroll
                for (int j = 0; j < 4; ++j) { const f32x4 a = *(const f32x4*)(p + 4 * j); s += (a[0] + a[1]) + (a[2] + a[3]); } }
            s += shfl_x(s, 1, lane); s += shfl_x(s, 2, lane);
            const float rr = rsqrtf(s * (1.f / DM) + EPS);
#pragma unroll
            for (int r = 0; r < 4; ++r) rs[r] = shfl_idx(rr, 4 * (4 * fq + r));
            bo = BG[id * 16 + fr];
        }
#pragma unroll
        for (int r = 0; r < 4; ++r) GATES[(size_t)(r0 + 4 * fq + r) * 16 + fr] = acc[r] * rs[r] + bo;
    }
}

__device__ __forceinline__ void postproj_phase(Frame& F, int layer) {
    const int gw = F.bid * NWAVES + F.wave, NGW = F.G * NWAVES;
    bf16_t* PROJ = (bf16_t*)(F.ws + WS_PROJ);
    const float* ROPE = (const float*)(F.ws + WS_ROPE);
    const int sub = F.lane >> 4, l16 = F.lane & 15, d = 4 * l16;
    const f32x4 gq = *(const f32x4*)(F.ka->in[IN_AQG] + layer * 64 + d), gk = *(const f32x4*)(F.ka->in[IN_AKG] + layer * 64 + d);
    const bool x2 = (l16 & 4) != 0;
    for (int rg = gw; rg < NROWS / 4; rg += NGW) {
        const int row0 = 4 * rg; const bool lat = row0 < NLAT;
        u32x2 w[4][3]; f32x4 cs0[4], cs1[4];
#pragma unroll
        for (int q = 0; q < 4; ++q) { const bf16_t* pr = PROJ + (size_t)(row0 + q) * PP; const int t = (row0 + q) & (SEQ - 1);
            cs0[q] = (f32x4){1.f, 0.f, 1.f, 0.f}; cs1[q] = cs0[q];
            if (lat) { const int idx = (d >> 5) ? 128 + (t & 63) : (t >> 6); const float* rp = ROPE + ((size_t)idx * 16 + (d & 15)) * 2; cs0[q] = *(const f32x4*)rp; cs1[q] = *(const f32x4*)(rp + 4); }
#pragma unroll
            for (int pass = 0; pass < 3; ++pass) { const int col = pass == 0 ? PC_AQ + 64 * sub + d : (pass == 1 ? (sub < 2 ? PC_AK + 64 * sub + d : PC_BK + 64 * (sub - 2) + d) : PC_BQ + 64 * sub + d);
                w[q][pass] = *(const u32x2*)(pr + col); } }
#pragma unroll
        for (int q = 0; q < 4; ++q) { bf16_t* pr = PROJ + (size_t)(row0 + q) * PP;
            const float cz[4] = {cs0[q][0], cs0[q][2], cs1[q][0], cs1[q][2]}, sz[4] = {cs0[q][1], cs0[q][3], cs1[q][1], cs1[q][3]};
#pragma unroll
            for (int pass = 0; pass < 3; ++pass) {
                const int col = pass == 0 ? PC_AQ + 64 * sub + d : (pass == 1 ? (sub < 2 ? PC_AK + 64 * sub + d : PC_BK + 64 * (sub - 2) + d) : PC_BQ + 64 * sub + d);
                const bool donorm = pass == 0 || (pass == 1 && sub < 2);
                const bool active = lat || donorm;
                if (!lat && pass == 2) continue;
                float v[4] = {bflo(w[q][pass].x), bfhi(w[q][pass].x), bflo(w[q][pass].y), bfhi(w[q][pass].y)};
                float ss = (v[0] * v[0] + v[1] * v[1]) + (v[2] * v[2] + v[3] * v[3]);
                ss += shfl_x(ss, 1, F.lane); ss += shfl_x(ss, 2, F.lane); ss += shfl_x(ss, 4, F.lane); ss += shfl_x(ss, 8, F.lane);
                if (donorm) { const float rstd = rsqrtf(ss * (1.f / 64.f) + EPS) * (pass == 0 ? QSCALE2 : 1.f); const f32x4 g = pass == 0 ? gq : gk;
#pragma unroll
                    for (int e = 0; e < 4; ++e) v[e] = v[e] * rstd * g[e]; }
                float o[4];
#pragma unroll
                for (int e = 0; e < 4; ++e) { const float p = shfl_x(v[e], 4, F.lane); o[e] = x2 ? (p * sz[e] + v[e] * cz[e]) : (v[e] * cz[e] - p * sz[e]); }
                if (active) { u32x2 ow; ow.x = cvtpk(o[0], o[1]); ow.y = cvtpk(o[2], o[3]); *(u32x2*)(pr + col) = ow; }
            } }
    }
}

template <bool WT = false>
__device__ __forceinline__ void groupnorm_rows(Frame& F, int layer, int row0, int nrows, int wv, int nw) {
    const bf16_t* H = (const bf16_t*)(F.ws + WS_H); bf16_t* YN = (bf16_t*)(F.ws + WS_PROJ);
    const float* gg = F.ka->in[IN_GGRP] + layer * 1024;
    f32x4 gv[4];
#pragma unroll
    for (int j = 0; j < 4; ++j) gv[j] = *(const f32x4*)(gg + 4 * F.lane + 256 * j);
    for (int r = 4 * wv; r < nrows; r += 4 * nw) {
        u32x2 w[4][4]; float ss[4][4];
#pragma unroll
        for (int q = 0; q < 4; ++q)
#pragma unroll
            for (int j = 0; j < 4; ++j) w[q][j] = *(const u32x2*)(H + (size_t)(row0 + r + q) * DM + 4 * F.lane + 256 * j);
#pragma unroll
        for (int q = 0; q < 4; ++q)
#pragma unroll
            for (int j = 0; j < 4; ++j) { const float v0 = bflo(w[q][j].x), v1 = bfhi(w[q][j].x), v2 = bflo(w[q][j].y), v3 = bfhi(w[q][j].y); ss[q][j] = (v0 * v0 + v1 * v1) + (v2 * v2 + v3 * v3); }
#pragma unroll
        for (int o = 1; o < 64; o <<= 1)
#pragma unroll
            for (int q = 0; q < 4; ++q)
#pragma unroll
                for (int j = 0; j < 4; ++j) ss[q][j] += shfl_x(ss[q][j], o, F.lane);
#pragma unroll
        for (int q = 0; q < 4; ++q)
#pragma unroll
            for (int j = 0; j < 4; ++j) { const float rstd = rsqrtf(ss[q][j] * (1.f / 256.f) + EPS);
                u32x2 o; o.x = cvtpk(bflo(w[q][j].x) * rstd * gv[j][0], bfhi(w[q][j].x) * rstd * gv[j][1]); o.y = cvtpk(bflo(w[q][j].y) * rstd * gv[j][2], bfhi(w[q][j].y) * rstd * gv[j][3]);
                if (WT) __hip_atomic_store((unsigned long long*)(YN + (size_t)(row0 + r + q) * DM + 4 * F.lane + 256 * j), (unsigned long long)o.x | ((unsigned long long)o.y << 32), __ATOMIC_RELAXED, __HIP_MEMORY_SCOPE_AGENT);
                else *(u32x2*)(YN + (size_t)(row0 + r + q) * DM + 4 * F.lane + 256 * j) = o; }
    }
}

__device__ __forceinline__ void fixup_hts(Frame& F, int layer, int ht0, int nht) {
    const float* edge = (const float*)(F.ws + WS_EDGE);
    const float* cw = F.ka->in[IN_CONVW] + (size_t)layer * 3 * DFF2; const float* cb = F.ka->in[IN_CONVB] + (size_t)layer * DFF2;
    bf16_t* act = (bf16_t*)(F.ws + WS_PROJ);
    const int per_row = DFF / 4;
    for (int it = F.tid; it < nht * 2 * per_row; it += NTHREADS) {
        const int ch = (it % per_row) * 4, rr = it / per_row, ht = ht0 + (rr >> 1), last = rr & 1;
        const bool seq_start = (ht == 0 || ht == 64 || ht == 128 || ht == 130), seq_end = (ht == 63 || ht == 127 || ht == 129 || ht == 131);
        const int row = ht * 128 + (last ? 127 : 0);
        f32x4 o;
        f32x4 res[2];
#pragma unroll
        for (int gvv = 0; gvv < 2; ++gvv) { const int uc = gvv * DFF + ch;
            const f32x4 z = {0.f, 0.f, 0.f, 0.f};
            f32x4 up, ucur, un;
            if (!last) { up = seq_start ? z : *(const f32x4*)(edge + ((size_t)(ht - 1) * 4 + 3) * DFF2 + uc); ucur = *(const f32x4*)(edge + ((size_t)ht * 4 + 0) * DFF2 + uc); un = *(const f32x4*)(edge + ((size_t)ht * 4 + 1) * DFF2 + uc); }
            else { up = *(const f32x4*)(edge + ((size_t)ht * 4 + 2) * DFF2 + uc); ucur = *(const f32x4*)(edge + ((size_t)ht * 4 + 3) * DFF2 + uc); un = seq_end ? z : *(const f32x4*)(edge + ((size_t)(ht + 1) * 4 + 0) * DFF2 + uc); }
            res[gvv] = *(const f32x4*)(cw + uc) * up + *(const f32x4*)(cw + DFF2 + uc) * ucur + *(const f32x4*)(cw + 2 * DFF2 + uc) * un + *(const f32x4*)(cb + uc); }
#pragma unroll
        for (int j = 0; j < 4; ++j) o[j] = res[0][j] / (1.f + __expf(-res[0][j])) * res[1][j];
        u32x2 w; w.x = cvtpk(o[0], o[1]); w.y = cvtpk(o[2], o[3]);
        *(u32x2*)(act + (size_t)row * DFF + ch) = w;
    }
}

template <int KDIM>
__device__ __forceinline__ void skinny_ctx(Frame& F, const bf16_t* A  , const bf16_t* Wt  , const float* xin, float* xout, const float* gate  ,
                                           bf16_t* xg  , const float* gn, const float* scn  , float* ssqc) {
    const int lane = F.lane, fr = lane & 15, fq = lane >> 4, t = F.tid, ldrow = t >> 3, chunk = t & 7;
    const int rf = F.wave >> 1, cp = F.wave & 1;
    constexpr int RSB = 144, BUFB = 64 * RSB, NKB = KDIM / 64;
    for (int p = F.bid; p < 128; p += F.G) {
        const int rg = p >> 4, cg = p & 15;
        if (KDIM == DM) { groupnorm_rows<false>(F, 0, NLAT + 64 * rg, 64, F.wave, NWAVES); VM_WAIT(); __syncthreads(); }
        const bf16_t* asrc = A + (size_t)(64 * rg + ldrow) * KDIM + 8 * chunk; const bf16_t* bsrc = Wt + (size_t)(64 * cg + ldrow) * KDIM + 8 * chunk;
        u32x4 ra[4], rb[4];
#pragma unroll
        for (int i = 0; i < 4; ++i) { ra[i] = *(const u32x4*)(asrc + 64 * i); rb[i] = *(const u32x4*)(bsrc + 64 * i); }
        f32x4 acc[2] = {{0.f, 0.f, 0.f, 0.f}, {0.f, 0.f, 0.f, 0.f}};
        __syncthreads();
        for (int kb0 = 0; kb0 < NKB; kb0 += 4) {
#pragma unroll
            for (int i = 0; i < 4; ++i) { const int kb = kb0 + i; LAS unsigned char* ba = F.lds + (kb & 1) * 2 * BUFB; LAS unsigned char* bb = ba + BUFB;
                *(LAS u32x4*)(ba + ldrow * RSB + 16 * chunk) = ra[i]; *(LAS u32x4*)(bb + ldrow * RSB + 16 * chunk) = rb[i];
                if (kb + 4 < NKB) { ra[i] = *(const u32x4*)(asrc + 64 * (kb + 4)); rb[i] = *(const u32x4*)(bsrc + 64 * (kb + 4)); }
                __syncthreads();
#pragma unroll
                for (int ks = 0; ks < 2; ++ks) { const bf16x8 af = *(const LAS bf16x8*)(ba + (16 * rf + fr) * RSB + 64 * ks + 16 * fq);
#pragma unroll
                    for (int j = 0; j < 2; ++j) { const bf16x8 bf = *(const LAS bf16x8*)(bb + (32 * cp + 16 * j + fr) * RSB + 64 * ks + 16 * fq); acc[j] = __builtin_amdgcn_mfma_f32_16x16x32_bf16(af, bf, acc[j], 0, 0, 0); } }
            }
        }
        float ss[4] = {0.f, 0.f, 0.f, 0.f};
#pragma unroll
        for (int j = 0; j < 2; ++j) { const int n = 64 * cg + 32 * cp + 16 * j + fr; const float g = gate[n], gs = gn[n] * (1.f + scn[n]);
#pragma unroll
            for (int r = 0; r < 4; ++r) { const int row = 64 * rg + 16 * rf + 4 * fq + r; const float o = xin[(size_t)row * DM + n] + g * acc[j][r];
                xout[(size_t)row * DM + n] = o; xg[(size_t)row * DM + n] = (bf16_t)(cvtpk(o * gs, 0.f) & 0xffffu); ss[r] += o * o; } }
#pragma unroll
        for (int r = 0; r < 4; ++r) { float s = ss[r]; s += shfl_x(s, 1, lane); s += shfl_x(s, 2, lane); s += shfl_x(s, 4, lane); s += shfl_x(s, 8, lane);
            if (fr == 0) { float* sp = ssqc + (size_t)(64 * rg + 16 * rf + 4 * fq + r) * 64 + cg * 2 + cp; sp[0] = s; sp[32] = 0.f; } }
        __syncthreads();
    }
}

__device__ __forceinline__ void final_phase(Frame& F) {
    const int gw = F.bid * NWAVES + F.wave, NGW = F.G * NWAVES;
    const float* gf = F.ka->in[IN_GFIN];
    f32x4 gv[4];
#pragma unroll
    for (int j = 0; j < 4; ++j) gv[j] = *(const f32x4*)(gf + 4 * F.lane + 256 * j);
    for (int rg = gw; rg < NLAT / 8; rg += NGW) {
        float* xr = F.out + (size_t)rg * 8 * DM + 4 * F.lane;
        f32x4 v[8][4]; float ss[8];
#pragma unroll
        for (int r = 0; r < 8; ++r)
#pragma unroll
            for (int j = 0; j < 4; ++j) v[r][j] = *(const f32x4*)(xr + (size_t)r * DM + 256 * j);
#pragma unroll
        for (int r = 0; r < 8; ++r) { float s = 0.f;
#pragma unroll
            for (int j = 0; j < 4; ++j) s += (v[r][j][0] * v[r][j][0] + v[r][j][1] * v[r][j][1]) + (v[r][j][2] * v[r][j][2] + v[r][j][3] * v[r][j][3]);
            ss[r] = s; }
#pragma unroll
        for (int o = 1; o < 64; o <<= 1)
#pragma unroll
            for (int r = 0; r < 8; ++r) ss[r] += shfl_x(ss[r], o, F.lane);
#pragma unroll
        for (int r = 0; r < 8; ++r) { const float rstd = rsqrtf(ss[r] * (1.f / DM) + EPS);
#pragma unroll
            for (int j = 0; j < 4; ++j) *(f32x4*)(xr + (size_t)r * DM + 256 * j) = v[r][j] * rstd * gv[j]; }
    }
}

typedef GAS unsigned gu32;
#define RLX_AGENT __ATOMIC_RELAXED, __HIP_MEMORY_SCOPE_AGENT
constexpr int CW_BAR = 4096;
#define XB_TMO      128
#define XB_XCNT(j)  (256  + 64 * (j))
#define XB_XSUB(j)  (1280 + 64 * (j))
#define XB_XGEN(j)  (2304 + 64 * (j))
#define XB_TOP      3328
#define XB_TOPGEN   3392
#define XCD_BAR_WORDS 3456
#define XB_SPIN_CAP (1u << 18)

__device__ __forceinline__ unsigned xb_ld(unsigned* p)              { return __hip_atomic_load(p, __ATOMIC_RELAXED, __HIP_MEMORY_SCOPE_AGENT); }
__device__ __forceinline__ unsigned xb_add(unsigned* p, unsigned v) { return __hip_atomic_fetch_add(p, v, __ATOMIC_RELAXED, __HIP_MEMORY_SCOPE_AGENT); }
__device__ __forceinline__ unsigned xb_xcc_id() { return (unsigned)__builtin_amdgcn_s_getreg((3 << 11) | 20) & 0xFu; }
#define XB_SPIN(cond, bar) do { unsigned _sp = 0; while (cond) { __builtin_amdgcn_s_sleep(1); \
    if ((++_sp & 255u) == 0u) { if (xb_ld(&(bar)[XB_TMO])) break; if (_sp > XB_SPIN_CAP) { atomicAdd(&(bar)[XB_TMO], 1u); break; } } } } while (0)

struct XcdBarrier {
    unsigned* bar; unsigned x;
    volatile LAS unsigned* st;
};

__device__ __forceinline__ XcdBarrier xcd_barrier_post(unsigned* bar, volatile LAS unsigned* st, bool is_t0) {
    XcdBarrier b; b.bar = bar; b.x = xb_xcc_id(); b.st = st;
    if (is_t0) (void)xb_add(&bar[XB_XCNT(b.x)], 1u);
    return b;
}
__device__ __forceinline__ void xcd_barrier_complete(unsigned* bar, unsigned x, unsigned& nloc, unsigned& nx) {
    const unsigned G = gridDim.x * gridDim.y * gridDim.z;
    unsigned sum, cnt, mine, sp = 0u;
    for (;;) {
        sum = 0u; cnt = 0u; mine = 0u;
#pragma unroll
        for (unsigned j = 0; j < 16; ++j) { const unsigned c = xb_ld(&bar[XB_XCNT(j)]); sum += c; cnt += (c > 0u) ? 1u : 0u; mine = (j == x) ? c : mine; }
        if (sum == G) break;
        __builtin_amdgcn_s_sleep(1);
        if ((++sp & 255u) == 0u) { if (xb_ld(&bar[XB_TMO])) break; if (sp > XB_SPIN_CAP) { atomicAdd(&bar[XB_TMO], 1u); break; } }
    }
    nloc = mine > 0u ? mine : 1u; nx = cnt > 0u ? cnt : 1u;
}

__device__ __forceinline__ void xcd_barrier(const XcdBarrier& b, bool is_t0) {
    asm volatile("s_waitcnt vmcnt(0)" ::: "memory");
    __syncthreads();
    if (is_t0) {
        unsigned* bar = b.bar;
        __builtin_amdgcn_s_waitcnt(0);
        unsigned nloc = b.st[0], nx = b.st[1];
        if (nloc == 0u) { xcd_barrier_complete(bar, b.x, nloc, nx); b.st[0] = nloc; b.st[1] = nx; }
        const unsigned old = xb_add(&bar[XB_XSUB(b.x)], 1u);
        const unsigned gen = old / nloc;
        if (old + 1u == (gen + 1u) * nloc) {
            __builtin_amdgcn_fence(__ATOMIC_RELEASE, "agent");
            asm volatile("s_waitcnt vmcnt(0)" ::: "memory");
            const unsigned og = xb_add(&bar[XB_TOP], 1u);
            const unsigned tg = og / nx;
            if (og + 1u == (tg + 1u) * nx) xb_add(&bar[XB_TOPGEN], 1u);
            else XB_SPIN(xb_ld(&bar[XB_TOPGEN]) == tg, bar);
            __builtin_amdgcn_fence(__ATOMIC_ACQUIRE, "agent");
            xb_add(&bar[XB_XGEN(b.x)], 1u);
            asm volatile("s_waitcnt vmcnt(0)" ::: "memory");
        } else {
            XB_SPIN(xb_ld(&bar[XB_XGEN(b.x)]) == gen, bar);
            __builtin_amdgcn_fence(__ATOMIC_ACQUIRE, "agent");
            asm volatile("s_waitcnt vmcnt(0)" ::: "memory");
        }
    }
    __syncthreads();
}

namespace att {
constexpr int SLOTB = 8192;
constexpr int L_K = 0, L_V = 2 * SLOTB, L_WS = 4 * SLOTB, L_OST = L_WS + 8 * 256, L_RPB = L_OST + 8 * 4096, L_END = L_RPB + 2048;
constexpr float THR = 8.0f;
__device__ __forceinline__ int crow(int r, int hi) { return (r & 3) + 8 * (r >> 2) + 4 * hi; }
__device__ __forceinline__ s16x4 vtr(const LAS unsigned char* p) { return __builtin_bit_cast(s16x4, __builtin_amdgcn_ds_read_tr16_b64_v4i16((LAS v4i16_t*)p)); }
__device__ __forceinline__ float rowmax32(const f32x16& p0, const f32x16& p1) {
    float a = fmaxf(p0[0], p1[0]);
#pragma unroll
    for (int r = 1; r < 16; ++r) a = fmaxf(a, fmaxf(p0[r], p1[r]));
    auto rr = __builtin_amdgcn_permlane32_swap(__float_as_uint(a), __float_as_uint(a), false, false);
    return fmaxf(__uint_as_float(rr[0]), __uint_as_float(rr[1]));
}
__device__ __forceinline__ float halfsum(float v) {
    auto rr = __builtin_amdgcn_permlane32_swap(__float_as_uint(v), __float_as_uint(v), false, false);
    return __uint_as_float(rr[0]) + __uint_as_float(rr[1]);
}
#define ATT_WAIT_BAR() asm volatile("s_waitcnt vmcnt(0) lgkmcnt(0)\n\ts_barrier" ::: "memory")

template <int MODE>
__device__ __forceinline__ void attn_unit(Frame& F, int b, int h, int qb, int qcol, int kcol, int vcol, int ycol, float sink2, const float* rpb) {
    LAS unsigned char* lds = F.lds;
    const int lane = F.lane, r32 = lane & 31, hi = lane >> 5, wid = F.wave;
    const bf16_t* PROJ = (const bf16_t*)(F.ws + WS_PROJ); bf16_t* Y = (bf16_t*)(F.ws + WS_H);
    const int ctxrow = NLAT + CTXL * b, latrow = SEQ * b;
    const int qrow0 = (MODE == 3) ? ctxrow : latrow + 256 * qb;
    const int qw0 = 256 * qb + 32 * wid;
    int lt_lo = 0, nloc = 0;
    if (MODE == 0) { lt_lo = 0; nloc = 128; }
    if (MODE == 1) { const int a = (256 * qb - 128) >> 6, e = (256 * qb + 255 + 128) >> 6; lt_lo = a < 0 ? 0 : a; nloc = (e > 127 ? 127 : e) - lt_lo + 1; }
    if (MODE == 2) { const int a = 4 * qb - 4, e0 = 4 * qb - 1; lt_lo = a < 0 ? 0 : (a > 120 ? 120 : a); const int e = (e0 < 0 ? 0 : (e0 > 120 ? 120 : e0)) + 7; nloc = e - lt_lo + 1; }
    const int NT = 4 + nloc;
    const int rw = 4 * qb + (wid >> 1); const int rs = rw - 4 < 0 ? 0 : (rw - 4 > 120 ? 120 : rw - 4);
    const int qc = 32 * (wid & 1) + r32; const int cs = qc - 8 < 0 ? 0 : (qc - 8 > 48 ? 48 : qc - 8);
    LAS float* wsf = (LAS float*)(lds + L_WS) + wid * 64;
    LAS float* rpbL = (LAS float*)(lds + L_RPB);
    if (MODE == 2) { for (int i = F.tid; i < 465; i += NTHREADS) rpbL[i] = rpb[i] * LOG2E; }
    const int vp0 = ((lane >> 4) & 1) * 32 + (lane & 3) * 8 + (4 * hi + ((lane & 15) >> 2)) * 64;
#define ATT_KROW(t) ((t) < 4 ? ctxrow + 64 * (t) : latrow + 64 * (lt_lo + (t) - 4))
#define ATT_DMA(t, slot) do { const int kr_ = ATT_KROW(t); \
        __builtin_amdgcn_global_load_lds((const unsigned*)(PROJ + (size_t)(kr_ + lane) * PP + kcol + wid * 8), (LAS unsigned*)(lds + L_K + (slot) * SLOTB + wid * 1024), 16, 0, 0); \
        __builtin_amdgcn_global_load_lds((const unsigned*)(PROJ + (size_t)(kr_ + 16 * (wid & 3) + (lane >> 2)) * PP + vcol + (wid >> 2) * 32 + (lane & 3) * 8), (LAS unsigned*)(lds + L_V + (slot) * SLOTB + wid * 1024), 16, 0, 0); } while (0)
    ATT_DMA(0, 0);
    bf16x8 qr[4];
#pragma unroll
    for (int d0 = 0; d0 < 4; ++d0) qr[d0] = *(const bf16x8*)(PROJ + (size_t)(qrow0 + 32 * wid + r32) * PP + qcol + d0 * 16 + hi * 8);
    float mhat = 0.f, l = 0.f; f32x16 o0 = {}, o1 = {}, negm = {};
    ATT_WAIT_BAR();
    for (int t = 0; t < NT; ++t) {
        const int slot = t & 1;
        if (t + 1 < NT) ATT_DMA(t + 1, slot ^ 1);
        bool rel = true; int kb0 = 0;
        if (MODE == 1 && t >= 4) { kb0 = 64 * (lt_lo + t - 4); rel = (kb0 + 63 >= qw0 - 128) && (kb0 <= qw0 + 31 + 128); }
        if (MODE == 2 && t >= 4) { kb0 = lt_lo + t - 4; rel = (kb0 >= rs) && (kb0 < rs + 8); }
        if (rel) {
            const LAS unsigned char* kb = lds + L_K + slot * SLOTB + hi * 1024 + r32 * 16;
            f32x16 p0 = negm, p1 = negm;
#pragma unroll
            for (int d0 = 0; d0 < 4; ++d0) {
                const bf16x8 b0 = *(const LAS bf16x8*)(kb + d0 * 2048), b1 = *(const LAS bf16x8*)(kb + d0 * 2048 + 512);
                p0 = __builtin_amdgcn_mfma_f32_32x32x16_bf16(b0, qr[d0], p0, 0, 0, 0);
                p1 = __builtin_amdgcn_mfma_f32_32x32x16_bf16(b1, qr[d0], p1, 0, 0, 0);
            }
            if (MODE == 1 && t >= 4) {
                const int dq = kb0 - (qw0 + r32);
#pragma unroll
                for (int r = 0; r < 16; ++r) { const int kc = crow(r, hi); const int d0_ = dq + kc, d1_ = d0_ + 32;
                    if (d0_ > 128 || d0_ < -128) p0[r] = -INFINITY; if (d1_ > 128 || d1_ < -128) p1[r] = -INFINITY; }
            }
            if (MODE == 2 && t >= 4) {
                const LAS float* bt = rpbL + (kb0 - rw + 7) * 31 + (15 - qc);
#pragma unroll
                for (int r = 0; r < 16; ++r) { const int kc = crow(r, hi);
                    const bool v0 = (kc >= cs) && (kc < cs + 16), v1 = (kc + 32 >= cs) && (kc + 32 < cs + 16);
                    p0[r] = v0 ? p0[r] + bt[v0 ? kc : qc] : -INFINITY; p1[r] = v1 ? p1[r] + bt[v1 ? kc + 32 : qc] : -INFINITY; }
            }
            const float rm = rowmax32(p0, p1);
            if (t == 0 || __any(rm > THR)) {
                const float dl = (t == 0) ? rm : fmaxf(rm, 0.f);
                mhat += dl;
#pragma unroll
                for (int r = 0; r < 16; ++r) { p0[r] -= dl; p1[r] -= dl; negm[r] = -mhat; }
                if (t > 0) { const float f = __builtin_amdgcn_exp2f(-dl); l *= f; if (hi == 0) wsf[r32] = f; LDS_WAIT();
#pragma unroll
                    for (int r = 0; r < 16; ++r) { const float fr_ = wsf[crow(r, hi)]; o0[r] *= fr_; o1[r] *= fr_; }
                    LDS_WAIT(); }
            }
            float ls = 0.f;
#pragma unroll
            for (int r = 0; r < 16; ++r) { p0[r] = __builtin_amdgcn_exp2f(p0[r]); p1[r] = __builtin_amdgcn_exp2f(p1[r]); ls += p0[r] + p1[r]; }
            l += ls;
            u32x4 pw[4];
#pragma unroll
            for (int k = 0; k < 4; ++k) { pw[0][k] = cvtpk(p0[2 * k], p0[2 * k + 1]); pw[1][k] = cvtpk(p0[8 + 2 * k], p0[9 + 2 * k]); pw[2][k] = cvtpk(p1[2 * k], p1[2 * k + 1]); pw[3][k] = cvtpk(p1[8 + 2 * k], p1[9 + 2 * k]); }
            const LAS unsigned char* vb = lds + L_V + slot * SLOTB + vp0;
#pragma unroll
            for (int ks = 0; ks < 4; ++ks) {
                const s16x4 a0 = vtr(vb + ks * 1024), a1 = vtr(vb + ks * 1024 + 512), c0 = vtr(vb + 4096 + ks * 1024), c1 = vtr(vb + 4096 + ks * 1024 + 512);
                const bf16x8 v0 = {a0[0], a0[1], a0[2], a0[3], a1[0], a1[1], a1[2], a1[3]}, v1 = {c0[0], c0[1], c0[2], c0[3], c1[0], c1[1], c1[2], c1[3]};
                o0 = __builtin_amdgcn_mfma_f32_32x32x16_bf16(__builtin_bit_cast(bf16x8, pw[ks]), v0, o0, 0, 0, 0);
                o1 = __builtin_amdgcn_mfma_f32_32x32x16_bf16(__builtin_bit_cast(bf16x8, pw[ks]), v1, o1, 0, 0, 0);
            }
        }
        ATT_WAIT_BAR();
    }
    l = halfsum(l);
    if (MODE == 1 || MODE == 3) l += __builtin_amdgcn_exp2f(sink2 - mhat);
    if (hi == 0) wsf[32 + r32] = l;
    LDS_WAIT();
    bf16_t* stg = (bf16_t*)(lds + L_OST + wid * 4096);
    LAS bf16_t* stgl = (LAS bf16_t*)(lds + L_OST + wid * 4096);
#pragma unroll
    for (int r = 0; r < 16; ++r) { const int orow = crow(r, hi); const float rl = __builtin_amdgcn_rcpf(wsf[32 + orow]);
        stgl[orow * 64 + r32] = (bf16_t)(cvtpk(o0[r] * rl, 0.f) & 0xffffu); stgl[orow * 64 + 32 + r32] = (bf16_t)(cvtpk(o1[r] * rl, 0.f) & 0xffffu); }
    LDS_WAIT();
    (void)stg;
#pragma unroll
    for (int i = 0; i < 4; ++i) { const int row = i * 8 + (lane >> 3), ch = lane & 7; const u32x4 v = *(const LAS u32x4*)(stgl + row * 64 + ch * 8);
        *(u32x4*)(Y + (size_t)(qrow0 + 32 * wid + row) * DM + ycol + ch * 8) = v; }
    LDS_WAIT();
#undef ATT_KROW
#undef ATT_DMA
}
}

namespace ml {
__device__ __forceinline__ float scan_add(float v, int lane, int dir) {
#pragma unroll
    for (int o = 1; o < 64; o <<= 1) { const float t = shfl_idx(v, (dir ? lane + o : lane - o) & 63); const bool ok = dir ? (lane + o < 64) : (lane >= o); v += ok ? t : 0.f; }
    return v;
}
__device__ __forceinline__ float scan_max(float v, int lane, int dir) {
#pragma unroll
    for (int o = 1; o < 64; o <<= 1) { const float t = shfl_idx(v, (dir ? lane + o : lane - o) & 63); const bool ok = dir ? (lane + o < 64) : (lane >= o); v = ok ? fmaxf(v, t) : v; }
    return v;
}
__device__ __forceinline__ float logsigmoid(float x) { return fminf(x, 0.f) - log1pf(__expf(-fabsf(x))); }
__device__ __forceinline__ int img_off(int tok, int d) { return (d >> 5) * 4096 + (tok >> 4) * 1024 + (tok & 15) * 64 + (d & 31) * 2; }
__device__ __forceinline__ int blk_row0(int b, int blk) { return blk < 4 ? NLAT + CTXL * b + 64 * blk : SEQ * b + 64 * (blk - 4); }
__device__ __forceinline__ int chunk_of(int dir, int blk) { return dir == 0 ? blk : (blk < 4 ? 3 - blk : 4 + 127 - (blk - 4)); }

__device__ __forceinline__ void pass1(Frame& F, int layer) {
    const int gw = F.bid * NWAVES + F.wave, NGW = F.G * NWAVES, lane = F.lane, r32 = lane & 31, hi = lane >> 5;
    LAS unsigned char* wl = F.lds + F.wave * 16384;
    const bf16_t* PROJ = (const bf16_t*)(F.ws + WS_PROJ); const float* GATES = (const float*)(F.ws + WS_GATES);
    const float* gb = F.ka->in[IN_CGB] + layer * 16;
    float* DS = (float*)(F.ws + WS_DS); float* ZD = (float*)(F.ws + WS_ZD); float* GC = (float*)(F.ws + WS_GC); float* ML = (float*)(F.ws + WS_ML);
    const int vp0 = ((lane >> 4) & 1) * 32 + (lane & 3) * 8 + (4 * hi + ((lane & 15) >> 2)) * 64;
    for (int wu = gw; wu < NCHAIN * NCHUNK; wu += NGW) {
        const int chain = wu / NCHUNK, c = wu % NCHUNK, dir = chain & 1, h = (chain >> 1) & 3, b = chain >> 3;
        const int row0 = blk_row0(b, chunk_of(dir, c));
        const float gi = GATES[(size_t)(row0 + lane) * 16 + dir * 8 + h] + gb[dir * 8 + h];
        const float lf = logsigmoid(GATES[(size_t)(row0 + lane) * 16 + dir * 8 + 4 + h] + gb[dir * 8 + 4 + h]);
        const float cum = scan_add(lf, lane, dir);
        const float G = wave_sum(lf, lane);
        const float bb = gi - cum, mloc = wave_max(bb, lane), w = __expf(bb - mloc);
#pragma unroll
        for (int it = 0; it < 8; ++it) { const int tok = (lane >> 3) + 8 * it, d = 8 * (lane & 7);
            const u32x4 kv = *(const u32x4*)(PROJ + (size_t)(row0 + tok) * PP + PC_CK + 64 * h + d), vv = *(const u32x4*)(PROJ + (size_t)(row0 + tok) * PP + PC_CV + 64 * h + d);
            const float wt = shfl_idx(w, tok);
            u32x4 ko; ko.x = cvtpk(bflo(kv.x) * wt, bfhi(kv.x) * wt); ko.y = cvtpk(bflo(kv.y) * wt, bfhi(kv.y) * wt); ko.z = cvtpk(bflo(kv.z) * wt, bfhi(kv.z) * wt); ko.w = cvtpk(bflo(kv.w) * wt, bfhi(kv.w) * wt);
            *(LAS u32x4*)(wl + img_off(tok, d)) = vv; *(LAS u32x4*)(wl + 8192 + img_off(tok, d)) = ko; }
        LDS_WAIT();
        f32x16 acc[2][2] = {};
#pragma unroll
        for (int s = 0; s < 4; ++s) {
            bf16x8 af[2], bfr[2];
#pragma unroll
            for (int x = 0; x < 2; ++x) { const s16x4 a0 = att::vtr(wl + vp0 + x * 4096 + s * 1024), a1 = att::vtr(wl + vp0 + x * 4096 + s * 1024 + 512);
                const s16x4 c0 = att::vtr(wl + 8192 + vp0 + x * 4096 + s * 1024), c1 = att::vtr(wl + 8192 + vp0 + x * 4096 + s * 1024 + 512);
                af[x] = (bf16x8){a0[0], a0[1], a0[2], a0[3], a1[0], a1[1], a1[2], a1[3]}; bfr[x] = (bf16x8){c0[0], c0[1], c0[2], c0[3], c1[0], c1[1], c1[2], c1[3]}; }
#pragma unroll
            for (int vb = 0; vb < 2; ++vb)
#pragma unroll
                for (int kb = 0; kb < 2; ++kb) acc[vb][kb] = __builtin_amdgcn_mfma_f32_32x32x16_bf16(af[vb], bfr[kb], acc[vb][kb], 0, 0, 0);
        }
        float* dsp = DS + (size_t)(chain * NCHUNK + c) * 4096;
#pragma unroll
        for (int vb = 0; vb < 2; ++vb)
#pragma unroll
            for (int kb = 0; kb < 2; ++kb)
#pragma unroll
                for (int r = 0; r < 16; ++r) dsp[(32 * vb + att::crow(r, hi)) * 64 + 32 * kb + r32] = acc[vb][kb][r];
        float z = 0.f;
#pragma unroll 8
        for (int tok = 0; tok < 64; ++tok) z += bf2f(*(const LAS bf16_t*)(wl + 8192 + img_off(tok, lane)));
        ZD[(size_t)(chain * NCHUNK + c) * 64 + lane] = z;
        if (lane == 0) { GC[chain * NCHUNK + c] = G; ML[chain * NCHUNK + c] = mloc; }
        LDS_WAIT();
    }
}

__device__ __forceinline__ void pass2(Frame& F) {
    const float* DS = (const float*)(F.ws + WS_DS); const float* ZD = (const float*)(F.ws + WS_ZD); const float* GC = (const float*)(F.ws + WS_GC); const float* ML = (const float*)(F.ws + WS_ML);
    bf16_t* SBF = (bf16_t*)(F.ws + WS_SBF); float* ZC = (float*)(F.ws + WS_ZC); float* MC = (float*)(F.ws + WS_MC);
    LAS float* cf = (LAS float*)F.lds;
    for (int it = F.bid; it < NCHAIN * 16; it += F.G) {
        const int chain = it >> 4, part = it & 15;
        __syncthreads();
        if (F.wave == 0) {
            const int ln = F.lane; const bool valid = ln < 44; float g[3], mlv[3];
#pragma unroll
            for (int j = 0; j < 3; ++j) { g[j] = valid ? GC[chain * NCHUNK + 3 * ln + j] : 0.f; mlv[j] = valid ? ML[chain * NCHUNK + 3 * ln + j] : -INFINITY; }
            const float tot = g[0] + g[1] + g[2]; const float excl = ml::scan_add(tot, ln, 0) - tot;
            const float pg[3] = {excl, excl + g[0], excl + g[0] + g[1]};
            const float a0 = mlv[0] - pg[0], a1 = mlv[1] - pg[1], a2 = mlv[2] - pg[2];
            const float inclm = ml::scan_max(fmaxf(a0, fmaxf(a1, a2)), ln, 0); float exclm = shfl_idx(inclm, (ln - 1) & 63); if (ln == 0) exclm = -INFINITY;
            const float em[3] = {exclm, fmaxf(exclm, a0), fmaxf(fmaxf(exclm, a0), a1)};
#pragma unroll
            for (int j = 0; j < 3; ++j) { const int c = 3 * ln + j; const float m = pg[j] + fmaxf(0.f, em[j]); const float mn = fmaxf(g[j] + m, g[j] + mlv[j]);
                if (valid) { cf[2 * c] = __expf(g[j] + m - mn); cf[2 * c + 1] = __expf(g[j] + mlv[j] - mn); if (part == 0) MC[chain * NCHUNK + c] = m; } }
        }
        __syncthreads();
        if (F.tid < 256) {
            const int e = part * 256 + F.tid; const float* dp = DS + (size_t)chain * NCHUNK * 4096 + e; bf16_t* sp = SBF + (size_t)chain * NCHUNK * 4096 + e;
            float s = 0.f;
            for (int c0 = 0; c0 < NCHUNK; c0 += 66) { float d[66];
#pragma unroll
                for (int j = 0; j < 66; ++j) d[j] = dp[(size_t)(c0 + j) * 4096];
#pragma unroll
                for (int j = 0; j < 66; ++j) { sp[(size_t)(c0 + j) * 4096] = (bf16_t)(cvtpk(s, 0.f) & 0xffffu); s = cf[2 * (c0 + j)] * s + cf[2 * (c0 + j) + 1] * d[j]; } }
        } else if (F.tid < 260) {
            const int e = part * 4 + (F.tid - 256); const float* dp = ZD + (size_t)chain * NCHUNK * 64 + e; float* zp = ZC + (size_t)chain * NCHUNK * 64 + e;
            float s = 0.f;
            for (int c0 = 0; c0 < NCHUNK; c0 += 66) { float d[66];
#pragma unroll
                for (int j = 0; j < 66; ++j) d[j] = dp[(size_t)(c0 + j) * 64];
#pragma unroll
                for (int j = 0; j < 66; ++j) { zp[(size_t)(c0 + j) * 64] = s; s = cf[2 * (c0 + j)] * s + cf[2 * (c0 + j) + 1] * d[j]; } }
        }
    }
    __syncthreads();
}

__device__ __forceinline__ void pass3(Frame& F, int layer, int blk_lo) {
    const int gw = F.bid * NWAVES + F.wave, NGW = F.G * NWAVES, lane = F.lane, r32_ = lane & 31, hi_ = lane >> 5;
    LAS unsigned char* wl = F.lds + F.wave * 19456;
    LAS float* bvec = (LAS float*)(wl + 16384); LAS float* Apl = bvec + 128; LAS float* efl = bvec + 256; LAS float* fll = bvec + 384; LAS float* zl = bvec + 512; LAS float* rden = bvec + 640;
    LAS float* st = (LAS float*)(wl + 8192);
    const bf16_t* PROJ = (const bf16_t*)(F.ws + WS_PROJ); const float* GATES = (const float*)(F.ws + WS_GATES);
    const float* gb = F.ka->in[IN_CGB] + layer * 16;
    const bf16_t* SBF = (const bf16_t*)(F.ws + WS_SBF); const float* ZC = (const float*)(F.ws + WS_ZC); const float* MC = (const float*)(F.ws + WS_MC);
    bf16_t* Y = (bf16_t*)(F.ws + WS_H);
    const int vp0 = ((lane >> 4) & 1) * 32 + (lane & 3) * 8 + (4 * hi_ + ((lane & 15) >> 2)) * 64;
    const int nblk = NCHUNK - blk_lo;
    for (int wu2 = gw; wu2 < 16 * nblk; wu2 += NGW) {
        const int wu = wu2 >> 1, tbsel = wu2 & 1;
        const int bh = wu / nblk, blk = blk_lo + wu % nblk, b = bh >> 2, h = bh & 3;
        const int row0 = blk_row0(b, blk);
        LDS_WAIT();
#pragma unroll
        for (int it = 0; it < 8; ++it) { const int tok = (lane >> 3) + 8 * it, d = 8 * (lane & 7);
            *(LAS u32x4*)(wl + img_off(tok, d)) = *(const u32x4*)(PROJ + (size_t)(row0 + tok) * PP + PC_CV + 64 * h + d); }
#pragma unroll
        for (int dir = 0; dir < 2; ++dir) {
            const int c = chunk_of(dir, blk), chain = (b * 4 + h) * 2 + dir;
            const float gi = GATES[(size_t)(row0 + lane) * 16 + dir * 8 + h] + gb[dir * 8 + h];
            const float lf = logsigmoid(GATES[(size_t)(row0 + lane) * 16 + dir * 8 + 4 + h] + gb[dir * 8 + 4 + h]);
            const float cum = scan_add(lf, lane, dir);
            const float bb = gi - cum, pm = scan_max(bb, lane, dir), mc = MC[chain * NCHUNK + c];
            const float Apv = fmaxf(mc, pm);
            zl[dir * 64 + lane] = ZC[(size_t)(chain * NCHUNK + c) * 64 + lane];
            bvec[dir * 64 + lane] = bb; Apl[dir * 64 + lane] = Apv; efl[dir * 64 + lane] = __expf(mc - Apv); fll[dir * 64 + lane] = __expf(-(cum + Apv));
        }
        LDS_WAIT();
#pragma unroll 1
        for (int tb = tbsel; tb <= tbsel; ++tb) {
            int r32 = r32_, hi = hi_; asm volatile("" : "+v"(r32), "+v"(hi));
            const int t = 32 * tb + r32;
            bf16x8 qf[4];
#pragma unroll
            for (int d0 = 0; d0 < 4; ++d0) qf[d0] = *(const bf16x8*)(PROJ + (size_t)(row0 + t) * PP + PC_CQ + 64 * h + 16 * d0 + 8 * hi);
            f32x16 hs0 = {}, hs1 = {};
#pragma unroll 1
            for (int dir = 0; dir < 2; ++dir) {
                const int c = chunk_of(dir, blk), chain = (b * 4 + h) * 2 + dir;
                const bf16_t* Sp = SBF + (size_t)(chain * NCHUNK + c) * 4096; const LAS float* zp = zl + dir * 64;
                int r32 = r32_, hi = hi_; asm volatile("" : "+v"(r32), "+v"(hi));
                const float Ap_t = Apl[dir * 64 + t], e_t = efl[dir * 64 + t], fl_t = fll[dir * 64 + t];
                f32x16 P0 = {}, P1 = {};
#pragma unroll
                for (int d0 = 0; d0 < 4; ++d0) {
                    const bf16x8 k0 = *(const bf16x8*)(PROJ + (size_t)(row0 + r32) * PP + PC_CK + 64 * h + 16 * d0 + 8 * hi), k1 = *(const bf16x8*)(PROJ + (size_t)(row0 + 32 + r32) * PP + PC_CK + 64 * h + 16 * d0 + 8 * hi);
                    P0 = __builtin_amdgcn_mfma_f32_32x32x16_bf16(k0, qf[d0], P0, 0, 0, 0); P1 = __builtin_amdgcn_mfma_f32_32x32x16_bf16(k1, qf[d0], P1, 0, 0, 0); }
                float den = 0.f;
#pragma unroll
                for (int r = 0; r < 16; ++r) { const int s0 = att::crow(r, hi), s1 = 32 + s0; const bool ok0 = dir ? (s0 >= t) : (s0 <= t), ok1 = dir ? (s1 >= t) : (s1 <= t);
                    const float w0 = ok0 ? __expf(bvec[dir * 64 + s0] - Ap_t) : 0.f, w1 = ok1 ? __expf(bvec[dir * 64 + s1] - Ap_t) : 0.f;
                    P0[r] *= w0; P1[r] *= w1; den += P0[r] + P1[r]; }
                u32x4 pw[4];
#pragma unroll
                for (int k = 0; k < 4; ++k) { pw[0][k] = cvtpk(P0[2 * k], P0[2 * k + 1]); pw[1][k] = cvtpk(P0[8 + 2 * k], P0[9 + 2 * k]); pw[2][k] = cvtpk(P1[2 * k], P1[2 * k + 1]); pw[3][k] = cvtpk(P1[8 + 2 * k], P1[9 + 2 * k]); }

                f32x16 n0 = {}, n1 = {}; float zq = 0.f;
#pragma unroll
                for (int d0 = 0; d0 < 4; ++d0) { const u32x4 qw = __builtin_bit_cast(u32x4, qf[d0]); u32x4 o;
                    const f32x4 za = *(const LAS f32x4*)(zp + 16 * d0 + 8 * hi), zb = *(const LAS f32x4*)(zp + 16 * d0 + 8 * hi + 4);
                    const float q0 = bflo(qw.x), q1 = bfhi(qw.x), q2 = bflo(qw.y), q3 = bfhi(qw.y), q4 = bflo(qw.z), q5 = bfhi(qw.z), q6 = bflo(qw.w), q7 = bfhi(qw.w);
                    zq += (q0 * za[0] + q1 * za[1]) + (q2 * za[2] + q3 * za[3]) + (q4 * zb[0] + q5 * zb[1]) + (q6 * zb[2] + q7 * zb[3]);
                    o.x = cvtpk(q0 * e_t, q1 * e_t); o.y = cvtpk(q2 * e_t, q3 * e_t); o.z = cvtpk(q4 * e_t, q5 * e_t); o.w = cvtpk(q6 * e_t, q7 * e_t);
                    const bf16x8 qs = __builtin_bit_cast(bf16x8, o);
                    const bf16x8 s0 = *(const bf16x8*)(Sp + (size_t)r32 * 64 + 16 * d0 + 8 * hi), s1 = *(const bf16x8*)(Sp + (size_t)(32 + r32) * 64 + 16 * d0 + 8 * hi);
                    n0 = __builtin_amdgcn_mfma_f32_32x32x16_bf16(qs, s0, n0, 0, 0, 0); n1 = __builtin_amdgcn_mfma_f32_32x32x16_bf16(qs, s1, n1, 0, 0, 0); }

                den = att::halfsum(den) + e_t * att::halfsum(zq);
                const float rd = 1.f / fmaxf(fabsf(den), fl_t);
                LDS_WAIT(); if (hi == 0) rden[r32] = rd; LDS_WAIT();
#pragma unroll
                for (int ks = 0; ks < 4; ++ks) {
                    const s16x4 a0 = att::vtr(wl + vp0 + ks * 1024), a1 = att::vtr(wl + vp0 + ks * 1024 + 512), c0 = att::vtr(wl + vp0 + 4096 + ks * 1024), c1 = att::vtr(wl + vp0 + 4096 + ks * 1024 + 512);
                    const bf16x8 v0 = {a0[0], a0[1], a0[2], a0[3], a1[0], a1[1], a1[2], a1[3]}, v1 = {c0[0], c0[1], c0[2], c0[3], c1[0], c1[1], c1[2], c1[3]};
                    n0 = __builtin_amdgcn_mfma_f32_32x32x16_bf16(__builtin_bit_cast(bf16x8, pw[ks]), v0, n0, 0, 0, 0);
                    n1 = __builtin_amdgcn_mfma_f32_32x32x16_bf16(__builtin_bit_cast(bf16x8, pw[ks]), v1, n1, 0, 0, 0); }
#pragma unroll
                for (int r = 0; r < 16; ++r) { const float rr = rden[att::crow(r, hi)]; hs0[r] += n0[r] * rr; hs1[r] += n1[r] * rr; }
            }
            LDS_WAIT();
#pragma unroll
            for (int r = 0; r < 16; ++r) { st[att::crow(r, hi) * 64 + r32] = hs0[r]; st[att::crow(r, hi) * 64 + 32 + r32] = hs1[r]; }
            LDS_WAIT();
#pragma unroll
            for (int it = 0; it < 4; ++it) { const int tk = (lane >> 3) + 8 * it, d = 8 * (lane & 7);
                const u32x4 ow = *(const u32x4*)(PROJ + (size_t)(row0 + 32 * tb + tk) * PP + PC_CO + 64 * h + d);
                const f32x4 ha = *(const LAS f32x4*)(st + tk * 64 + d), hb = *(const LAS f32x4*)(st + tk * 64 + d + 4);
                const float og[8] = {bflo(ow.x), bfhi(ow.x), bflo(ow.y), bfhi(ow.y), bflo(ow.z), bfhi(ow.z), bflo(ow.w), bfhi(ow.w)};
                float yv[8];
#pragma unroll
                for (int j = 0; j < 8; ++j) yv[j] = (j < 4 ? ha[j] : hb[j - 4]) / (1.f + __expf(-og[j]));
                u32x4 w; w.x = cvtpk(yv[0], yv[1]); w.y = cvtpk(yv[2], yv[3]); w.z = cvtpk(yv[4], yv[5]); w.w = cvtpk(yv[6], yv[7]);
                *(u32x4*)(Y + (size_t)(row0 + 32 * tb + tk) * DM + 512 + 64 * h + d) = w; }
            LDS_WAIT();
        }
    }
}
}

namespace attp {
typedef __attribute__((address_space(3))) const char* lds_cptr;
#define SBAR() __builtin_amdgcn_sched_barrier(0)
__device__ __forceinline__ int crow(int r,int hi){return (r&3)+8*(r>>2)+4*hi;}
constexpr int NSLOT=3, SLOTB=8192;
constexpr int NW=8, QBLK=32, KVBLK=64; constexpr int LDS_K=0, LDS_V=NSLOT*SLOTB, LDS_WS=2*NSLOT*SLOTB, LDS_OST=LDS_WS+NW*64*4, LDS_BYTES=LDS_OST+NW*4096;
__device__ __forceinline__ void glds16(const void*gsrc,unsigned lds_dst){unsigned keep;
  asm volatile("s_mov_b32 %0, m0\n\ts_mov_b32 m0, %2\n\ts_nop 0\n\tglobal_load_lds_dwordx4 %1, off\n\ts_mov_b32 m0, %0":"=&s"(keep):"v"(gsrc),"s"(lds_dst):"memory");}
__device__ __forceinline__ float max3f(float a,float b,float c){float r;asm("v_max3_f32 %0, %1, %2, %3":"=v"(r):"v"(a),"v"(b),"v"(c));return r;}
__device__ __forceinline__ float max2f(float a,float b){float r;asm("v_max_f32_e32 %0, %1, %2":"=v"(r):"v"(a),"v"(b));return r;}
__device__ __forceinline__ float fadd_s(float a,float b){float r;asm("v_add_f32_e32 %0, %1, %2":"=v"(r):"v"(a),"v"(b));return r;}
__device__ __forceinline__ float fsub_s(float a,float b){float r;asm("v_sub_f32_e32 %0, %1, %2":"=v"(r):"v"(a),"v"(b));return r;}
__device__ __forceinline__ unsigned cvtpk_s(float lo,float hi){return cvtpk(lo,hi);}
#define WAIT_BAR(N) asm volatile("s_waitcnt vmcnt(" #N ") lgkmcnt(0)\n\ts_barrier":::"memory")

template<bool ZC> __device__ __forceinline__ void qkt(f32x16&p0,f32x16&p1,lds_cptr Kslot,const bf16x8*qr,const f32x16&negm,int r32,int hi){
  lds_cptr kb=Kslot+hi*1024+r32*16;
  #pragma unroll
  for(int d0=0;d0<4;++d0){
    const bf16x8 b0=*(const __attribute__((address_space(3))) bf16x8*)(kb+d0*2048);
    const bf16x8 b1=*(const __attribute__((address_space(3))) bf16x8*)(kb+d0*2048+512);
    if(d0==0){ if(ZC){p0=__builtin_amdgcn_mfma_f32_32x32x16_bf16(b0,qr[0],(f32x16){},0,0,0);p1=__builtin_amdgcn_mfma_f32_32x32x16_bf16(b1,qr[0],(f32x16){},0,0,0);} else {p0=__builtin_amdgcn_mfma_f32_32x32x16_bf16(b0,qr[0],negm,0,0,0);p1=__builtin_amdgcn_mfma_f32_32x32x16_bf16(b1,qr[0],negm,0,0,0);} }
    else{p0=__builtin_amdgcn_mfma_f32_32x32x16_bf16(b0,qr[d0],p0,0,0,0);p1=__builtin_amdgcn_mfma_f32_32x32x16_bf16(b1,qr[d0],p1,0,0,0);}}
}
__device__ __forceinline__ void kload8(bf16x8*kf,lds_cptr kp){
  kf[0]=*(const __attribute__((address_space(3))) bf16x8*)(kp);      kf[1]=*(const __attribute__((address_space(3))) bf16x8*)(kp+512);
  kf[2]=*(const __attribute__((address_space(3))) bf16x8*)(kp+2048); kf[3]=*(const __attribute__((address_space(3))) bf16x8*)(kp+2560);
  kf[4]=*(const __attribute__((address_space(3))) bf16x8*)(kp+4096); kf[5]=*(const __attribute__((address_space(3))) bf16x8*)(kp+4608);
  kf[6]=*(const __attribute__((address_space(3))) bf16x8*)(kp+6144); kf[7]=*(const __attribute__((address_space(3))) bf16x8*)(kp+6656);
}
__device__ __forceinline__ void kload2(bf16x8*kf,lds_cptr kp,int j){ kf[2*j]=*(const __attribute__((address_space(3))) bf16x8*)(kp+j*2048); kf[2*j+1]=*(const __attribute__((address_space(3))) bf16x8*)(kp+j*2048+512); }
__device__ __forceinline__ s16x4 vtr(lds_cptr p){ return __builtin_bit_cast(s16x4,__builtin_amdgcn_ds_read_tr16_b64_v4i16((__attribute__((address_space(3))) v4i16_t*)p)); }
__device__ __forceinline__ float rowmax(const f32x16&p0,const f32x16&p1){
  float a=max3f(p0[0],p0[1],p1[0]),b=max3f(p0[2],p0[3],p1[1]);a=max3f(a,p1[2],p1[3]);
  #pragma unroll
  for(int r=4;r<16;r+=4){a=max3f(a,p0[r],p0[r+1]);b=max3f(b,p0[r+2],p0[r+3]);a=max3f(a,p1[r],p1[r+1]);b=max3f(b,p1[r+2],p1[r+3]);}
  const float m=max2f(a,b);
  auto rr=__builtin_amdgcn_permlane32_swap(__float_as_uint(m),__float_as_uint(m),false,false);
  return max2f(__uint_as_float(rr[0]),__uint_as_float(rr[1]));
}
__device__ __forceinline__ void pv(f32x16*o,int vb,bf16x8 pa0,bf16x8 pa1,bf16x8 pa2,bf16x8 pa3){
  #pragma unroll
  for(int d0=0;d0<2;++d0){s16x4 lo[4],hi[4];
    #pragma unroll
    for(int ks=0;ks<4;++ks){
      asm volatile("ds_read_b64_tr_b16 %0,%1 offset:%c2":"=&v"(lo[ks]):"v"(vb),"i"(d0*4096+ks*1024):"memory");
      asm volatile("ds_read_b64_tr_b16 %0,%1 offset:%c2":"=&v"(hi[ks]):"v"(vb),"i"(d0*4096+ks*1024+512):"memory");}
    asm volatile("s_waitcnt lgkmcnt(0)":::"memory");SBAR();
    #define PK(k) (bf16x8){lo[k][0],lo[k][1],lo[k][2],lo[k][3],hi[k][0],hi[k][1],hi[k][2],hi[k][3]}
    o[d0]=__builtin_amdgcn_mfma_f32_32x32x16_bf16(pa0,PK(0),o[d0],0,0,0);
    o[d0]=__builtin_amdgcn_mfma_f32_32x32x16_bf16(pa1,PK(1),o[d0],0,0,0);
    o[d0]=__builtin_amdgcn_mfma_f32_32x32x16_bf16(pa2,PK(2),o[d0],0,0,0);
    o[d0]=__builtin_amdgcn_mfma_f32_32x32x16_bf16(pa3,PK(3),o[d0],0,0,0);
    #undef PK
  }
}


template<int THRL,int MODE> __device__ __forceinline__ void attn_unit_pipe(Frame& F,int b,int h,int qb,int qcol,int kcol,int vcol,int ycol,float sink2,const float*rpb){
  constexpr bool NOMAX=(MODE==0), USE_NEGM=false;
  int lane_=F.lane; asm volatile("":"+v"(lane_));
  const int lane=lane_,r32=lane&31,hi=lane>>5; const int wid=F.wave; (void)h;
  const bf16_t*PROJ=(const bf16_t*)(F.ws+WS_PROJ); bf16_t*Yb=(bf16_t*)(F.ws+WS_H);
  const int ctxrow=NLAT+CTXL*b,latrow=SEQ*b; LAS unsigned char*shm=F.lds;
  const int qrow0=(MODE==3)?ctxrow:latrow+256*qb;
  int lt_lo=0,nloc=0;
  if(MODE==0){nloc=128;}
  if(MODE==1){const int a_=(256*qb-128)>>6,e_=(256*qb+255+128)>>6; lt_lo=a_<0?0:a_; nloc=(e_>127?127:e_)-lt_lo+1;}
  if(MODE==2){const int a_=4*qb-4,e0_=4*qb-1; lt_lo=a_<0?0:(a_>120?120:a_); int e_=(e0_<0?0:(e0_>120?120:e0_))+7; nloc=e_-lt_lo+1; if(nloc&1)++nloc;}
  const int qw0=256*qb+32*wid;
  const int rw=4*qb+(wid>>1); const int rs=rw-4<0?0:(rw-4>120?120:rw-4);
  const int qc=32*(wid&1)+r32; const int cs=qc-8<0?0:(qc-8>48?48:qc-8);
  LAS float*rpbL=(LAS float*)(shm+LDS_BYTES);
  if(MODE==2){ for(int i=wid*64+lane;i<465;i+=512) rpbL[i]=rpb[i]*LOG2E; }
  unsigned vm0=0u,vm1=0u;
  if(MODE==2){ _Pragma("unroll") for(int r=0;r<16;++r){ const int kc_=crow(r,hi); if(kc_>=cs&&kc_<cs+16)vm0|=1u<<r; if(kc_+32>=cs&&kc_+32<cs+16)vm1|=1u<<r; } }
  const bf16_t*Qw=PROJ+(size_t)(qrow0+wid*QBLK)*PP+qcol;
  const unsigned lds0=(unsigned)(uintptr_t)shm;
  LAS float*wsf=(LAS float*)(shm+LDS_WS)+wid*64;
  const bf16_t*ksrc=PROJ+(size_t)lane*PP+kcol+wid*8;
  const bf16_t*vsrc=PROJ+(size_t)(16*(wid&3)+(lane>>2))*PP+vcol+(wid>>2)*32+(lane&3)*8;
  #define KROW(t) ((size_t)((t)<4?ctxrow+64*(t):latrow+64*(lt_lo+(t)-4))*PP)
  const unsigned kdst=lds0+LDS_K+wid*1024, vdst=lds0+LDS_V+wid*1024;
  #define DMA_K(t,slot) glds16(ksrc+KROW(t),(unsigned)__builtin_amdgcn_readfirstlane(kdst+(slot)))
  #define DMA_V(t,slot) glds16(vsrc+KROW(t),(unsigned)__builtin_amdgcn_readfirstlane(vdst+(slot)))
  const int vb0=(int)(lds0+LDS_V)+((lane>>4)&1)*32+(lane&3)*8+(4*hi+((lane&15)>>2))*64;
  const lds_cptr Kbase=(lds_cptr)shm+LDS_K; bf16x8 kf[8];
  const lds_cptr shm3=(lds_cptr)shm; const lds_cptr kp0=shm3+LDS_K+hi*1024+r32*16; const lds_cptr vp0=shm3+LDS_V+((lane>>4)&1)*32+(lane&3)*8+(4*hi+((lane&15)>>2))*64;
  const int NT=4+nloc;
  DMA_K(0,0);DMA_V(0,0);DMA_K(1,SLOTB);
  bf16x8 qr[4];
  #pragma unroll
  for(int d0=0;d0<4;++d0)qr[d0]=*reinterpret_cast<const bf16x8*>(&Qw[(size_t)r32*PP+d0*16+hi*8]);
  float mhat=0.f,l_reg=0.f;f32x16 o[2],negm;
  { float z_=0.f; asm volatile("":"+v"(z_));
    _Pragma("unroll") for(int r=0;r<16;++r){o[0][r]=z_;o[1][r]=z_;if(USE_NEGM)negm[r]=z_;} }
  if(USE_NEGM)asm volatile("":"+v"(negm));
  #define NEGMC (USE_NEGM?negm:(f32x16){})
  #define CMASK(P0,P1,t) do{ if(MODE==1&&(t)>=4){ const int dq_=64*(lt_lo+(t)-4)-(qw0+r32); \
      _Pragma("unroll") for(int r=0;r<16;++r){ const int d0_=dq_+crow(r,hi),d1_=d0_+32; if(d0_>128||d0_<-128)P0[r]=-INFINITY; if(d1_>128||d1_<-128)P1[r]=-INFINITY; } } \
    if(MODE==2&&(t)>=4){ const int gr_=lt_lo+(t)-4; const bool rel_=(gr_>=rs)&&(gr_<rs+8); const LAS float*bt_=rpbL+(rel_?gr_-rw+7:7)*31+(15-qc)+4*hi; const unsigned m0_=rel_?vm0:0u,m1_=rel_?vm1:0u; \
      _Pragma("unroll") for(int r=0;r<16;++r){ const int kc_=(r&3)+8*(r>>2);   \
        P0[r]=((m0_>>r)&1u)?P0[r]+bt_[kc_]:-INFINITY; P1[r]=((m1_>>r)&1u)?P1[r]+bt_[kc_+32]:-INFINITY; } } }while(0)
  bool resc=false;
  #define START(P0,P1) do{ resc=false; \
    if(!NOMAX){ const float rm=rowmax(P0,P1); const float dl=rm; mhat=fadd_s(mhat,dl); \
      _Pragma("unroll") for(int r=0;r<16;++r){P0[r]=fsub_s(P0[r],dl);P1[r]=fsub_s(P1[r],dl);} \
      if(USE_NEGM){ _Pragma("unroll") for(int r=0;r<16;++r)negm[r]=-mhat; asm volatile("":"+v"(negm)); } } \
    _Pragma("unroll") for(int r=0;r<16;++r)P0[r]=__builtin_amdgcn_exp2f(P0[r]); }while(0)
  #define RESC() do{ if(resc){ asm volatile("s_waitcnt lgkmcnt(0)":::"memory"); \
      _Pragma("unroll") for(int d_=0;d_<2;++d_) _Pragma("unroll") for(int r=0;r<16;++r)o[d_][r]*=wsf[crow(r,hi)]; } }while(0)
  f32x16 pA0,pA1,pB0,pB1;
  int sl_prev=0,sl_cur=0,sl_next=SLOTB;
  #define ROT() do{sl_prev=sl_cur;sl_cur=sl_next;sl_next=(sl_next==(NSLOT-1)*SLOTB)?0:sl_next+SLOTB;}while(0)
  DMA_K(2,2*SLOTB);
  WAIT_BAR(3);
  qkt<!USE_NEGM>(pA0,pA1,Kbase,qr,negm,r32,hi);asm volatile("s_nop 15\n\ts_nop 7":"+v"(pA0),"+v"(pA1));CMASK(pA0,pA1,0);
  START(pA0,pA1);
  _Pragma("unroll") for(int r=0;r<16;++r)pA1[r]=__builtin_amdgcn_exp2f(pA1[r]);
  WAIT_BAR(0);
  DMA_K(3,0);DMA_V(1,SLOTB);
  ROT();
  kload8(kf,kp0+sl_cur);
  WAIT_BAR(2);
  s16x4 vlo[8],vhi[8]; u32x4 pw0,pw1,pw2,pw3;
  #define PKW(P,B) cvtpk_s(P[B],P[B+1])
  #define PAF(k) __builtin_bit_cast(bf16x8,pw##k)
  #define VFR(i) (bf16x8){vlo[i][0],vlo[i][1],vlo[i][2],vlo[i][3],vhi[i][0],vhi[i][1],vhi[i][2],vhi[i][3]}
  #define PIN(x) asm volatile("":"+v"(x))
  #define MX3(a,b,c) __builtin_fmaxf(__builtin_fmaxf((a),(b)),(c))
  #define GAPA(MF,A0,A1,A2,A3,W0,W1,PW) do{ MF; sacc+=A0; sacc+=A1; sacc+=A2; sacc+=A3; PIN(sacc); W0; W1; PIN(PW); SBAR(); }while(0)
  #define EX(v) __builtin_amdgcn_exp2f(v)
  #define GAPB(MF,X,B) do{ MF; X[B]=EX(X[B]); X[B+1]=EX(X[B+1]); X[B+2]=EX(X[B+2]); X[B+3]=EX(X[B+3]); PIN(X); SBAR(); }while(0)
  #define VRD(i) do{ vlo[i]=vtr(vp_+(((i)>>2)*4096+((i)&3)*1024)); vhi[i]=vtr(vp_+(((i)>>2)*4096+((i)&3)*1024+512)); }while(0)
  #define KRD(G,j) do{ if(G){ kload2(kf,kp0+sl_next,j); SBAR(); } }while(0)
  #define STEP(C0,C1,P0,P1,t,GK,GV,GL) do{ SBAR(); \
    const lds_cptr vp_=vp0+sl_prev; \
    VRD(0); SBAR(); float sacc=(P0[0]+P0[1]); \
    GAPA(C0=__builtin_amdgcn_mfma_f32_32x32x16_bf16(kf[0],qr[0],NEGMC,0,0,0), P0[2],P0[3],P0[4],P0[5],     pw0[0]=PKW(P0,0), pw0[1]=PKW(P0,2), pw0); \
    VRD(4); SBAR(); GAPA(C1=__builtin_amdgcn_mfma_f32_32x32x16_bf16(kf[1],qr[0],NEGMC,0,0,0), P0[6],P0[7],P0[8],P0[9],     pw0[2]=PKW(P0,4), pw0[3]=PKW(P0,6), pw0); \
    VRD(1); SBAR(); GAPA(C0=__builtin_amdgcn_mfma_f32_32x32x16_bf16(kf[2],qr[1],C0,0,0,0),   P0[10],P0[11],P0[12],P0[13], pw1[0]=PKW(P0,8), pw1[1]=PKW(P0,10), pw1); \
    VRD(5); SBAR(); GAPA(C1=__builtin_amdgcn_mfma_f32_32x32x16_bf16(kf[3],qr[1],C1,0,0,0),   P0[14],P0[15],P1[0],P1[1],   pw1[2]=PKW(P0,12),pw1[3]=PKW(P0,14), pw1); \
    VRD(2); SBAR(); GAPA(C0=__builtin_amdgcn_mfma_f32_32x32x16_bf16(kf[4],qr[2],C0,0,0,0),   P1[2],P1[3],P1[4],P1[5],     pw2[0]=PKW(P1,0), pw2[1]=PKW(P1,2), pw2); \
    VRD(6); SBAR(); GAPA(C1=__builtin_amdgcn_mfma_f32_32x32x16_bf16(kf[5],qr[2],C1,0,0,0),   P1[6],P1[7],P1[8],P1[9],     pw2[2]=PKW(P1,4), pw2[3]=PKW(P1,6), pw2); \
    VRD(3); SBAR(); GAPA(C0=__builtin_amdgcn_mfma_f32_32x32x16_bf16(kf[6],qr[3],C0,0,0,0),   P1[10],P1[11],P1[12],P1[13], pw3[0]=PKW(P1,8), pw3[1]=PKW(P1,10), pw3); \
    VRD(7); SBAR(); GAPA(C1=__builtin_amdgcn_mfma_f32_32x32x16_bf16(kf[7],qr[3],C1,0,0,0),   P1[14],P1[15],0.f,0.f,       pw3[2]=PKW(P1,12),pw3[3]=PKW(P1,14), pw3); \
    l_reg+=sacc; \
    if(GK){DMA_K((t)+3,sl_cur);} if(GV){DMA_V((t)+1,sl_next);} \
    if(!USE_NEGM&&!NOMAX){ _Pragma("unroll") for(int r=0;r<16;++r){C0[r]-=mhat;C1[r]-=mhat;} } \
    CMASK(C0,C1,t); \
    if(!NOMAX){ float a=MX3(C0[0],C0[1],C1[0]),b=MX3(C0[2],C0[3],C1[1]); a=MX3(a,C1[2],C1[3]); \
      _Pragma("unroll") for(int r=4;r<16;r+=4){a=MX3(a,C0[r],C0[r+1]);b=MX3(b,C0[r+2],C0[r+3]);a=MX3(a,C1[r],C1[r+1]);b=MX3(b,C1[r+2],C1[r+3]);} \
      float rm=__builtin_fmaxf(a,b); { auto rr=__builtin_amdgcn_permlane32_swap(__float_as_uint(rm),__float_as_uint(rm),false,false); rm=__builtin_fmaxf(__uint_as_float(rr[0]),__uint_as_float(rr[1])); } \
      resc=false; \
      if(__builtin_expect(__any(rm>(float)THRL),0)){ const float dl=__builtin_fmaxf(rm,0.f); mhat+=dl; \
        _Pragma("unroll") for(int r=0;r<16;++r){C0[r]-=dl;C1[r]-=dl;} \
        if(USE_NEGM){ _Pragma("unroll") for(int r=0;r<16;++r)negm[r]=-mhat; asm volatile("":"+v"(negm)); } \
        const float f=__builtin_amdgcn_exp2f(-dl); l_reg*=f; if(hi==0)wsf[r32]=f; resc=true; } } \
    SBAR(); \
    GAPB(o[0]=__builtin_amdgcn_mfma_f32_32x32x16_bf16(PAF(0),VFR(0),o[0],0,0,0), C0,0); \
    GAPB(o[1]=__builtin_amdgcn_mfma_f32_32x32x16_bf16(PAF(0),VFR(4),o[1],0,0,0), C0,4); \
    KRD(GL,0); GAPB(o[0]=__builtin_amdgcn_mfma_f32_32x32x16_bf16(PAF(1),VFR(1),o[0],0,0,0), C0,8); \
    KRD(GL,1); GAPB(o[1]=__builtin_amdgcn_mfma_f32_32x32x16_bf16(PAF(1),VFR(5),o[1],0,0,0), C0,12); \
    KRD(GL,2); GAPB(o[0]=__builtin_amdgcn_mfma_f32_32x32x16_bf16(PAF(2),VFR(2),o[0],0,0,0), C1,0); \
    KRD(GL,3); GAPB(o[1]=__builtin_amdgcn_mfma_f32_32x32x16_bf16(PAF(2),VFR(6),o[1],0,0,0), C1,4); \
    GAPB(o[0]=__builtin_amdgcn_mfma_f32_32x32x16_bf16(PAF(3),VFR(3),o[0],0,0,0), C1,8); \
    GAPB(o[1]=__builtin_amdgcn_mfma_f32_32x32x16_bf16(PAF(3),VFR(7),o[1],0,0,0), C1,12); \
    }while(0)
  int t=1;
  for(;t+5<NT;t+=2){
    STEP(pB0,pB1,pA0,pA1,t,true,true,true);     WAIT_BAR(2); RESC(); ROT();
    STEP(pA0,pA1,pB0,pB1,t+1,true,true,true);   WAIT_BAR(2); RESC(); ROT();
  }
  #define ENDW(tt) do{ if((tt)+3<NT){WAIT_BAR(2);} else if((tt)+2<NT){WAIT_BAR(1);} else {WAIT_BAR(0);} }while(0)
  for(;t+1<NT;t+=2){
    STEP(pB0,pB1,pA0,pA1,t,(t+3<NT),(t+1<NT),(t+1<NT));       ENDW(t);   RESC(); ROT();
    STEP(pA0,pA1,pB0,pB1,t+1,(t+4<NT),(t+2<NT),(t+2<NT));     ENDW(t+1); RESC(); ROT();
  }
  STEP(pB0,pB1,pA0,pA1,NT-1,false,false,false); RESC();
  { float sacc=pB0[0]+pB0[1]; _Pragma("unroll") for(int r=2;r<16;++r)sacc+=pB0[r]; _Pragma("unroll") for(int r=0;r<16;++r)sacc+=pB1[r]; l_reg+=sacc;
    pw0=(u32x4){PKW(pB0,0),PKW(pB0,2),PKW(pB0,4),PKW(pB0,6)};pw1=(u32x4){PKW(pB0,8),PKW(pB0,10),PKW(pB0,12),PKW(pB0,14)};pw2=(u32x4){PKW(pB1,0),PKW(pB1,2),PKW(pB1,4),PKW(pB1,6)};pw3=(u32x4){PKW(pB1,8),PKW(pB1,10),PKW(pB1,12),PKW(pB1,14)};
    SBAR(); pv(o,vb0+sl_cur,PAF(0),PAF(1),PAF(2),PAF(3)); }
  #undef PKW
  #undef PAF
  #undef VFR
  #undef PIN
  #undef MX3
  #undef GAPA
  #undef GAPB
  #undef EX
  #undef VRD
  #undef KRD
  #undef STEP
  #undef ENDW
  {auto rr=__builtin_amdgcn_permlane32_swap(__float_as_uint(l_reg),__float_as_uint(l_reg),false,false);l_reg=__uint_as_float(rr[0])+__uint_as_float(rr[1]);}
  if(MODE==1||MODE==3)l_reg+=__builtin_amdgcn_exp2f(sink2-mhat);
  if(hi==0)wsf[32+r32]=l_reg;asm volatile("s_waitcnt lgkmcnt(0)":::"memory");
  float rli[16];
  #pragma unroll
  for(int r=0;r<16;++r)rli[r]=__builtin_amdgcn_rcpf(wsf[32+crow(r,hi)]);
  bf16_t*Ow=Yb+(size_t)(qrow0+wid*QBLK)*DM+ycol;
  { LAS bf16_t*stg=(LAS bf16_t*)(shm+LDS_OST)+wid*2048;
    #pragma unroll
    for(int r=0;r<16;++r){const int orow=crow(r,hi);
      #pragma unroll
      for(int d0=0;d0<2;++d0)stg[orow*64+d0*32+r32]=(bf16_t)(cvtpk(o[d0][r]*rli[r],0.f)&0xffffu);}
    asm volatile("s_waitcnt lgkmcnt(0)":::"memory");
    #pragma unroll
    for(int i=0;i<4;++i){const int row=i*8+(lane>>3),ch=lane&7; const u32x4 v=*(const LAS u32x4*)(stg+row*64+ch*8); *(u32x4*)(Ow+(size_t)row*DM+ch*8)=v;} }
  asm volatile("s_waitcnt lgkmcnt(0)\n\ts_barrier":::"memory");
  #undef DMA_K
  #undef DMA_V
  #undef KROW
  #undef NEGMC
  #undef CMASK
  #undef START
  #undef RESC
  #undef ROT
}

#undef SBAR
#undef WAIT_BAR
}

constexpr int NPHASE = 19;
__device__ __forceinline__ void ph_decode(int ph, int& l, int& k) { const unsigned tab = 0xA9864321u;
    if (ph == 1) { l = 0; k = 0; } else { const int j = ph - 2; l = j >= 8 ? 1 : 0; k = (int)((tab >> (4 * (j >= 8 ? j - 8 : j))) & 15u); } }

__device__ __forceinline__ void fill_rtab(Frame& F, const pg8::StaticOrder& S, const float* ssq, const float* ssqc) {
    LAS float* tab = (LAS float*)(F.lds + pg8::RTAB_OFF); pg8::Unit u;
#pragma unroll
    for (int i = 0; i < 8; ++i) if (S.next(i, u) && F.tid < 256) { float s = 0.f;
        if (u.pm < 64) { const float* p = ssq + (size_t)(u.pm * 256 + F.tid) * 16; const f32x4 a = *(const f32x4*)p, b = *(const f32x4*)(p + 4), c = *(const f32x4*)(p + 8), d = *(const f32x4*)(p + 12);
            s = ((a[0] + a[1]) + (a[2] + a[3])) + ((b[0] + b[1]) + (b[2] + b[3])) + ((c[0] + c[1]) + (c[2] + c[3])) + ((d[0] + d[1]) + (d[2] + d[3])); }
        else { const float* p = ssqc + (size_t)((u.pm - 64) * 256 + F.tid) * 64;
#pragma unroll
            for (int j = 0; j < 16; ++j) { const f32x4 a = *(const f32x4*)(p + 4 * j); s += (a[0] + a[1]) + (a[2] + a[3]); } }
        tab[i * 256 + F.tid] = rsqrtf(s * (1.f / DM) + EPS); }
    __syncthreads();
}
__device__ __forceinline__ void phase_ids(Frame& F) {
    int lane_;
    asm volatile("v_mbcnt_lo_u32_b32 %0, -1, 0\n\tv_mbcnt_hi_u32_b32 %0, -1, %0" : "=v"(lane_));
    F.lane = lane_; F.tid = F.wave * 64 + lane_;
}
__device__ __forceinline__ void run_phase(const Frame& F0, int ph) {
    Frame F = F0;
    unsigned char* ws = F.ws;
#define H ((bf16_t*)(F.ws + WS_H))
#define PROJ ((bf16_t*)(F.ws + WS_PROJ))
#define XC ((float*)(F.ws + WS_XC))
#define MOD ((const float*)(F.ws + WS_MOD))
#define vcu ((F.G % 8 == 0) ? (F.bid % 8) * (F.G / 8) + F.bid / 8 : F.bid)
#ifdef ONLYK
    if (ONLYK == 100) { if (ph == 0) { phase_ids(F); p0_prologue(F); } return; }
    if (ONLYK == 101) { if (ph == NPHASE - 1) { phase_ids(F); final_phase(F); } return; }
    if (ph == 0 || ph == NPHASE - 1) return;
    int l, k; ph_decode(ph, l, k);
    if (k != ONLYK) return;
#else
    if (ph == 0) { phase_ids(F); p0_prologue(F); return; }
    if (ph == NPHASE - 1) { phase_ids(F); final_phase(F); return; }
    int l, k; ph_decode(ph, l, k);
#endif
    const int M = (l == 0) ? NROWS : NLAT;
    switch (k) {
    case 0: phase_ids(F); norm_phase(F, l); break;
    case 1: { phase_ids(F); pg8::Gemm g{H, (const bf16_t*)(ws + WS_WIN) + (size_t)l * PP * 1024, NROWS, PP, 1024}; pg8::StaticOrder S; S.init(NROWS, PP, F.G, F.bid);
              gates_phase(F, l); if (l > 0) fill_rtab(F, S, (const float*)(ws + WS_SSQ1), (const float*)(ws + WS_SSQC1));
              pg8::EpiProj E{PROJ, PP, l == 0 ? nullptr : (const LAS float*)(F.lds + pg8::RTAB_OFF), (const float*)(ws + WS_BIASIN), F.ka->in[IN_AQG] + l * 64, F.ka->in[IN_AKG] + l * 64, (const float*)(ws + WS_ROPE)}; pg8::gemm_phase<pg8::EpiProj, pg8::StaticOrder, true, true>(F.lds, g, S, E, F.tid); } break;
    case 2: phase_ids(F); ml::pass1(F, l); break;
    case 3: {
        phase_ids(F);
        ml::pass2(F); PROBE_PT(F.lds, 1);
#ifndef NO_B
        for (int u = vcu; u < 256; u += F.G) { const int b = u >> 7, h = (u >> 5) & 3, qb = u & 31;
            attp::attn_unit_pipe<8, 1>(F, b, h, qb, PC_BQ + 64 * h, PC_BK + 64 * (h >> 1), PC_BV + 64 * (h >> 1), 256 + 64 * h, F.ka->in[IN_SINK][l * 4 + h] * LOG2E, nullptr); }
#endif
        PROBE_PT(F.lds, 2);
#ifndef NO_D
        for (int u = vcu; u < 256; u += F.G) { const int b = u >> 7, h = (u >> 5) & 3, qb = u & 31;
            attp::attn_unit_pipe<8, 2>(F, b, h, qb, PC_DQ + 64 * h, PC_DK + 64 * h, PC_DV + 64 * h, 768 + 64 * h, 0.f, F.ka->in[IN_RPB] + (size_t)(l * 4 + h) * 465); }
#endif
        PROBE_PT(F.lds, 3);
#ifndef NO_C3
        if (l == 0) for (int cu = vcu; cu < 24; cu += F.G) { const int mx = cu >> 3, b = (cu >> 2) & 1, h = cu & 3;
            const int qc = mx == 0 ? PC_AQ + 64 * h : (mx == 1 ? PC_BQ + 64 * h : PC_DQ + 64 * h);
            const int kc = mx == 0 ? PC_AK + 64 * (h >> 1) : (mx == 1 ? PC_BK + 64 * (h >> 1) : PC_DK + 64 * h);
            const int vc = mx == 0 ? PC_AV + 64 * (h >> 1) : (mx == 1 ? PC_BV + 64 * (h >> 1) : PC_DV + 64 * h);
            const int yc = (mx == 0 ? 0 : (mx == 1 ? 256 : 768)) + 64 * h;
            const float s2 = mx == 1 ? F.ka->in[IN_SINK][l * 4 + h] * LOG2E : -INFINITY;
            attp::attn_unit_pipe<8, 3>(F, b, h, 0, qc, kc, vc, yc, s2, nullptr); }
#endif
        PROBE_PT(F.lds, 5);
        if (l == 0) bias_phase(F, vcu >= 24 ? vcu - 24 : -1, F.G - 24);
    } break;
    case 4: {
        phase_ids(F);
#ifndef NO_ATTN0
        for (int u = vcu; u < 256; u += F.G) { const int b = u >> 7, h = (u >> 5) & 3, qb = u & 31;
            attp::attn_unit_pipe<8, 0>(F, b, h, qb, PC_AQ + 64 * h, PC_AK + 64 * (h >> 1), PC_AV + 64 * (h >> 1), 64 * h, 0.f, nullptr); }
#endif
        __syncthreads();
#ifndef NO_PASS3
        ml::pass3(F, l, l == 0 ? 0 : 4);
#endif
    } break;
    case 6: { phase_ids(F); pg8::Gemm g{PROJ  , (const bf16_t*)(ws + WS_WOUT) + (size_t)l * 1024 * 1024, NLAT, 1024, 1024}; pg8::StaticOrder S; S.init(NLAT, 1024, F.G, F.bid);
              { pg8::Unit u;
                if (F.G >= 256) { if (S.next(0, u)) {
                    groupnorm_rows<true>(F, l, u.pm * 256 + u.pn * 64, 64, F.wave, NWAVES);
                    asm volatile("s_waitcnt vmcnt(0)" ::: "memory"); __syncthreads();
                    if (F.tid == 0) { unsigned* cnt = (unsigned*)(ws + WS_CTL + 40960) + l * 64 + u.pm;
                        __hip_atomic_fetch_add(cnt, 1u, __ATOMIC_RELAXED, __HIP_MEMORY_SCOPE_AGENT);
                        unsigned sp = 0; while (__hip_atomic_load(cnt, __ATOMIC_RELAXED, __HIP_MEMORY_SCOPE_AGENT) < 4u && ++sp < (1u << 22)) __builtin_amdgcn_s_sleep(1);
                        __builtin_amdgcn_fence(__ATOMIC_ACQUIRE, "agent"); asm volatile("s_waitcnt vmcnt(0)" ::: "memory"); }
                    __syncthreads(); } }
                else { for (int i = 0; S.next(i, u); ++i) groupnorm_rows<false>(F, l, u.pm * 256, 256, F.wave, NWAVES); VM_WAIT(); __syncthreads(); } }
              pg8::EpiResid E{l == 0 ? F.ka->in[IN_X] : F.out, l == 0 ? F.ka->in[IN_CTX] : XC, F.out, XC, MOD + (size_t)l * 3 * 6144 + 2 * 1024,
                               (bf16_t*)(ws + WS_XG), F.ka->in[IN_G2] + l * 1024, MOD + (size_t)l * 3 * 6144 + 4 * 1024, (float*)(ws + WS_SSQ2)};
              if (F.G >= 256) { pg8::EpiResidStaged E2{E.xin_lat, E.xin_ctx, E.xout_lat, E.xout_ctx, E.gate, E.xg, E.gn, E.scn, E.ssq}; pg8::gemm_phase<pg8::EpiResidStaged, pg8::StaticOrder, true, true>(F.lds, g, S, E2, F.tid); }
              else pg8::gemm_phase<pg8::EpiResid, pg8::StaticOrder, true, true>(F.lds, g, S, E, F.tid);
              PROBE_PT(F.lds, 5);
              if (l == 0) skinny_ctx<1024>(F, PROJ + (size_t)NLAT * DM, (const bf16_t*)(ws + WS_WOUT), F.ka->in[IN_CTX], XC, MOD + 2 * 6144 + 2 * 1024,
                                           (bf16_t*)(ws + WS_XG) + (size_t)NLAT * DM, F.ka->in[IN_G2], MOD + 2 * 6144 + 4 * 1024, (float*)(ws + WS_SSQC2)); } break;
    case 8: { phase_ids(F); pg8::Gemm g{(const bf16_t*)(ws + WS_XG), (const bf16_t*)(ws + WS_WUP) + (size_t)l * DFF2 * 1024, M, DFF2, 1024}; pg8::StaticOrder S; S.init(M, DFF2, F.G, F.bid);
              fill_rtab(F, S, (const float*)(ws + WS_SSQ2), (const float*)(ws + WS_SSQC2));
              pg8::EpiUp E{PROJ, F.ka->in[IN_CONVW] + (size_t)l * 3 * DFF2, F.ka->in[IN_CONVB] + (size_t)l * DFF2, (float*)(ws + WS_EDGE), (const LAS float*)(F.lds + pg8::RTAB_OFF), (const float*)(ws + WS_BIASUP) + (size_t)l * 3 * DFF2};
              pg8::gemm_phase<pg8::EpiUp, pg8::StaticOrder, true, true>(F.lds, g, S, E, F.tid); } break;
    case 9: phase_ids(F); for (int ht = F.bid; ht < M / 128; ht += F.G) fixup_hts(F, l, ht, 1); break;
    case 10: { phase_ids(F); pg8::Gemm g{PROJ, (const bf16_t*)(ws + WS_WDN) + (size_t)l * 1024 * DFF, NLAT, 1024, DFF}; pg8::StaticOrder S; S.init(NLAT, 1024, F.G, F.bid);
              pg8::EpiResid E{F.out, XC, F.out, XC, MOD + (size_t)l * 3 * 6144 + 5 * 1024,
                               l == 0 ? H : nullptr, F.ka->in[IN_G1] + 1024, MOD + (size_t)3 * 6144 + 1 * 1024, (float*)(ws + WS_SSQ1)};
              if (F.G >= 256) { pg8::EpiResidStaged E2{E.xin_lat, E.xin_ctx, E.xout_lat, E.xout_ctx, E.gate, E.xg, E.gn, E.scn, E.ssq}; pg8::gemm_phase<pg8::EpiResidStaged, pg8::StaticOrder, true, true>(F.lds, g, S, E2, F.tid); }
              else pg8::gemm_phase<pg8::EpiResid, pg8::StaticOrder, true, true>(F.lds, g, S, E, F.tid);
              PROBE_PT(F.lds, 5);
              if (l == 0) skinny_ctx<DFF>(F, PROJ + (size_t)NLAT * DFF, (const bf16_t*)(ws + WS_WDN), XC, XC, MOD + 2 * 6144 + 5 * 1024,
                                          H + (size_t)NLAT * DM, F.ka->in[IN_G1] + 1024, MOD + (size_t)(3 + 2) * 6144 + 1 * 1024, (float*)(ws + WS_SSQC1)); } break;
    default: break;
    }
#undef H
#undef PROJ
#undef XC
#undef MOD
#undef vcu
}

__global__ void __launch_bounds__(NTHREADS, 2) fwd_kernel(Args args) {
    extern __shared__ __attribute__((aligned(16))) unsigned char lds_raw[];
    Frame F;
    F.lds = (LAS unsigned char*)lds_raw;
    const int wave0 = __builtin_amdgcn_readfirstlane((int)threadIdx.x >> 6);
    F.tid = 0; F.lane = 0; F.wave = wave0;
    F.G = gridDim.x; F.bid = blockIdx.x;
    F.ka = (const __attribute__((address_space(4))) Args*)__builtin_amdgcn_kernarg_segment_ptr();
    F.out = args.out; F.ws = args.ws;
#define MK_LANE(x) int x; asm volatile("v_mbcnt_lo_u32_b32 %0, -1, 0\n\tv_mbcnt_hi_u32_b32 %0, -1, %0" : "=v"(x))
#if !MK_MULTI
    { MK_LANE(l0_); if (wave0 == 0) ((LAS unsigned*)(F.lds + LDSCTL_OFF))[l0_] = 0u; }
    __syncthreads();
    XcdBarrier bar;
    { MK_LANE(l0_); bar = xcd_barrier_post((unsigned*)(args.ws + WS_CTL) + CW_BAR, (volatile LAS unsigned*)(F.lds + LDSCTL_OFF) + 8, wave0 == 0 && l0_ == 0); }
#endif
#ifdef PROBE_MASK
    unsigned long long pr_acc = 0ull;
#endif
    for (int ph = args.ph_lo; ph < args.ph_hi; ++ph) {
#ifdef PROBE_MASK
        const unsigned long long pr_t0 = __builtin_amdgcn_s_memrealtime();
#endif
#ifdef PROBE_PH
        *(volatile LAS unsigned*)(F.lds + LDSCTL_OFF + 64) = (ph == PROBE_PH) ? 1u : 0u; __syncthreads();
        PROBE_PT(F.lds, 0);
#endif
        {
            Frame P = F;
            int wave_ = wave0, bid_ = F.bid, g_ = F.G; unsigned char* ws_ = F.ws; float* out_ = F.out; const __attribute__((address_space(4))) Args* ka_ = F.ka;
            asm volatile("" : "+s"(wave_), "+s"(bid_), "+s"(g_), "+s"(ws_), "+s"(out_), "+s"(ka_));
            P.ka = ka_; P.lane = 0; P.wave = wave_; P.tid = 0; P.bid = bid_; P.G = g_; P.ws = ws_; P.out = out_;
            run_phase(P, ph);
#ifdef DUP_PH
            if (DUP_PH(ph)) { asm volatile("s_waitcnt vmcnt(0) lgkmcnt(0)" ::: "memory"); __syncthreads(); run_phase(P, ph); }
#endif
        }
#if !MK_MULTI
        if (ph + 1 < args.ph_hi) {
            if (args.ph_lo < 0) cg::this_grid().sync();
            else { MK_LANE(l1_); xcd_barrier(bar, wave0 == 0 && l1_ == 0); }
        }
#endif
#ifdef PROBE_PH
        PROBE_PT(F.lds, 4);
#endif
#ifdef PROBE_MASK
        if ((PROBE_MASK >> ph) & 1u) pr_acc += __builtin_amdgcn_s_memrealtime() - pr_t0;
#endif
    }
#ifdef PROBE_PH
    if (blockIdx.x == 0) { __syncthreads(); const unsigned long long d_ = *(volatile LAS unsigned long long*)(F.lds + LDSCTL_OFF + 72 + 8 * PROBE_B) - *(volatile LAS unsigned long long*)(F.lds + LDSCTL_OFF + 72 + 8 * PROBE_A);
        const unsigned long long t1 = __builtin_amdgcn_s_memrealtime(); while (__builtin_amdgcn_s_memrealtime() - t1 < d_) __builtin_amdgcn_s_sleep(8); }
#endif
#ifdef PROBE_MASK
    if (blockIdx.x == 0) { const unsigned long long t1 = __builtin_amdgcn_s_memrealtime(); while (__builtin_amdgcn_s_memrealtime() - t1 < pr_acc) __builtin_amdgcn_s_sleep(8); }
#endif
}

extern "C" void kernel_launch(void* const* d_in, const int* in_sizes, int n_in, void* d_out, int out_size, void* d_ws, size_t ws_size, hipStream_t stream) {
    static int grid = 0;
    if (grid == 0) {
        if (n_in != 21 || out_size != NLAT * DM || ws_size < WS_END) { fprintf(stderr, "kernel_launch: unexpected shapes (n_in %d out %d ws %zu)\n", n_in, out_size, ws_size); grid = -1; return; }
        int dev = 0, cus = 0, per_cu = 0;
        if (hipGetDevice(&dev) != hipSuccess || hipDeviceGetAttribute(&cus, hipDeviceAttributeMultiprocessorCount, dev) != hipSuccess) { grid = -1; return; }
        if (hipFuncSetAttribute((const void*)fwd_kernel, hipFuncAttributeMaxDynamicSharedMemorySize, LDS_BYTES) != hipSuccess) { fprintf(stderr, "kernel_launch: hipFuncSetAttribute failed\n"); grid = -1; return; }
        if (hipOccupancyMaxActiveBlocksPerMultiprocessor(&per_cu, (const void*)fwd_kernel, NTHREADS, LDS_BYTES) != hipSuccess || per_cu < 1) { fprintf(stderr, "kernel_launch: occupancy query says %d blocks per CU\n", per_cu); grid = -1; (void)hipGetLastError(); return; }
        grid = cus;
    }
    if (grid < 0) return;
#if !MK_MULTI
    if (hipMemsetAsync((char*)d_ws + WS_CTL, 0, 65536, stream) != hipSuccess) { fprintf(stderr, "kernel_launch: hipMemsetAsync failed\n"); return; }
#endif
    Args a{};
    for (int i = 0; i < 21; ++i) a.in[i] = (const float*)d_in[i];
    a.out = (float*)d_out; a.ws = (unsigned char*)d_ws;
#if MK_MULTI
    for (int ph = 0; ph < NPHASE; ++ph) { a.ph_lo = ph; a.ph_hi = ph + 1; hipLaunchKernelGGL(fwd_kernel, dim3(grid), dim3(NTHREADS), LDS_BYTES, stream, a); }
#else
    a.ph_lo = 0; a.ph_hi = NPHASE;
    void* kargs[] = {&a};
    hipError_t e = hipLaunchCooperativeKernel((void*)fwd_kernel, dim3(grid), dim3(NTHREADS), kargs, LDS_BYTES, stream);
    if (e != hipSuccess) fprintf(stderr, "kernel_launch: cooperative launch failed: %s (grid %d)\n", hipGetErrorString(e), grid);
#endif
}
```

```cpp
#include <hip/hip_runtime.h>
#include <hip/hip_cooperative_groups.h>
#include <cstdio>
#include <cstdint>
namespace cg = cooperative_groups;

#ifndef MK_MULTI
#define MK_MULTI 0
#endif

constexpr int DM = 1024, SEQ = 8192, NBATCH = 2, CTXL = 256, NLAT = NBATCH * SEQ, NROWS = NLAT + NBATCH * CTXL;
constexpr int PP = 2816;
constexpr int DFF = 2816, DFF2 = 5632, DIN = 2832, NLAYER = 2;
constexpr float EPS = 1e-6f;
constexpr float LOG2E = 1.4426950408889634f;
constexpr float QSCALE2 = 0.125f * LOG2E;
constexpr int PC_AQ = 0, PC_AK = 256, PC_AV = 384, PC_BQ = 512, PC_BK = 768, PC_BV = 896, PC_CQ = 1024, PC_CK = 1280, PC_CV = 1536, PC_CO = 1792, PC_DQ = 2048, PC_DK = 2304, PC_DV = 2560;
constexpr int NCHUNK = 132, NCHAIN = 16;

constexpr size_t MiB = 1u << 20;
constexpr size_t WS_CTL = 0, CTL_ZERO_BYTES = 1 * MiB;
constexpr size_t WS_MOD = 1 * MiB;
constexpr size_t WS_ROPE = 1 * MiB + 192 * 1024;
constexpr size_t WS_WG = 1 * MiB + 512 * 1024;
constexpr size_t WS_XC = 2 * MiB;
constexpr size_t WS_WIN = 4 * MiB;
constexpr size_t WS_WOUT = 15 * MiB;
constexpr size_t WS_WUP = 19 * MiB;
constexpr size_t WS_WDN = 41 * MiB;
constexpr size_t WS_H = 52 * MiB;
constexpr size_t WS_PROJ = 85 * MiB;
constexpr size_t WS_GATES = 176 * MiB;
constexpr size_t WS_DS = 178 * MiB;
constexpr size_t WS_SBF = 211 * MiB;
constexpr size_t WS_ZD = 228 * MiB;
constexpr size_t WS_ZC = WS_ZD + 1 * MiB;
constexpr size_t WS_GC = WS_ZC + 1 * MiB;
constexpr size_t WS_ML = WS_GC + 16384;
constexpr size_t WS_MC = WS_ML + 16384;
constexpr size_t WS_SSQ1 = 231 * MiB;
constexpr size_t WS_SSQ2 = 232 * MiB + 512 * 1024;
constexpr size_t WS_BIASUP = 234 * MiB;
constexpr size_t WS_BIASIN = 234 * MiB + 256 * 1024;
constexpr size_t WS_XG = WS_DS;
constexpr size_t WS_EDGE = WS_SBF;
constexpr size_t WS_SSQC1 = 234 * MiB + 512 * 1024;
constexpr size_t WS_SSQC2 = 234 * MiB + 768 * 1024;
constexpr size_t WS_END = 237 * MiB;

#define LAS __attribute__((address_space(3)))
#define GAS __attribute__((address_space(1)))
typedef unsigned short bf16_t;
typedef short bf16x8 __attribute__((ext_vector_type(8)));
typedef short s16x4 __attribute__((ext_vector_type(4)));
typedef float f32x4 __attribute__((ext_vector_type(4)));
typedef float f32x16 __attribute__((ext_vector_type(16)));
typedef float f32x2 __attribute__((ext_vector_type(2)));
typedef unsigned u32x4 __attribute__((ext_vector_type(4)));
typedef unsigned u32x2 __attribute__((ext_vector_type(2)));
typedef __bf16 bf16x2_t __attribute__((ext_vector_type(2)));
typedef short v4i16_t __attribute__((ext_vector_type(4)));

__device__ __forceinline__ unsigned cvtpk(float lo, float hi) { f32x2 v = {lo, hi}; bf16x2_t b = __builtin_convertvector(v, bf16x2_t); return __builtin_bit_cast(unsigned, b); }
__device__ __forceinline__ float bf2f(unsigned short b) { return __uint_as_float((unsigned)b << 16); }
__device__ __forceinline__ float bflo(unsigned w) { return __uint_as_float(w << 16); }
__device__ __forceinline__ float bfhi(unsigned w) { return __uint_as_float(w & 0xffff0000u); }
__device__ __forceinline__ float shfl_idx(float v, int src) { return __int_as_float(__builtin_amdgcn_ds_bpermute(src << 2, __float_as_int(v))); }
__device__ __forceinline__ float shfl_x(float v, int o, int lane) { return shfl_idx(v, lane ^ o); }
__device__ __forceinline__ float wave_sum(float v, int lane) {
#pragma unroll
    for (int o = 1; o < 64; o <<= 1) v += shfl_x(v, o, lane);
    return v;
}
__device__ __forceinline__ float wave_max(float v, int lane) {
#pragma unroll
    for (int o = 1; o < 64; o <<= 1) v = fmaxf(v, shfl_x(v, o, lane));
    return v;
}
#ifdef PROBE_PH
#define PROBE_PT(ldsbase, id) do { if (*(volatile LAS unsigned*)((ldsbase) + 155648 + 64)) *(volatile LAS unsigned long long*)((ldsbase) + 155648 + 72 + 8 * (id)) = __builtin_amdgcn_s_memrealtime(); } while (0)
#else
#define PROBE_PT(ldsbase, id) do { } while (0)
#endif
#define LDS_WAIT() asm volatile("s_waitcnt lgkmcnt(0)" ::: "memory")
#define VM_WAIT() asm volatile("s_waitcnt vmcnt(0)" ::: "memory")

namespace pg8 {
#define PG8_LAS __attribute__((address_space(3)))
constexpr int BM = 256, BK = 64, HALF = 128, HTB = HALF * BK * 2  , STAGE_BYTES = 8 * HTB, NXCD = 8, WGM = 8;
__host__ __device__ __forceinline__ int lds_byte(int r, int c) { const int st = (r >> 4) * 2 + (c >> 5), rr = r & 15, cc = c & 31, ob = rr * 64 + cc * 2; return st * 1024 + (ob ^ (((ob >> 9) & 1) << 5)); }
__host__ __device__ __forceinline__ void stage_rc(int b, int& R, int& C) { const int st = b / 1024, sb = b % 1024, swz = sb ^ (((sb >> 9) & 1) << 5); R = (st >> 1) * 16 + swz / 64; C = (st & 1) * 32 + (swz % 64) / 2; }
__host__ __device__ __forceinline__ int perm32(int rho) { const int n = rho >> 4, i = rho & 15; return 8 * (i >> 2) + 4 * n + (i & 3); }

struct Unit { int pm, pn, ui; };
struct Gemm { const bf16_t* A; const bf16_t* Bt; int M, N, K; };

struct StaticOrder {
    int nM, nN, nwg, G, c;
    __host__ __device__ __forceinline__ void init(int M, int N, int G_, int c_) { nM = M / BM; nN = N / BM; nwg = nM * nN; G = G_; c = c_; }
    __host__ __device__ __forceinline__ bool next(int i, Unit& u) const {
        const long L = (long)i * G + c; if (L >= nwg) return false;
        int wgid = (int)L; { const int q = nwg / NXCD, r = nwg % NXCD, xcd = wgid % NXCD, off = wgid / NXCD; wgid = (xcd < r ? xcd * (q + 1) : r * (q + 1) + (xcd - r) * q) + off; }
        const int nig = WGM * nN, gid = wgid / nig, fm = gid * WGM, gsz = (nM - fm) < WGM ? (nM - fm) : WGM;
        u.pm = fm + ((wgid % nig) % gsz); u.pn = (wgid % nig) / gsz; u.ui = i; return true;
    }
    __device__ __forceinline__ void a_ready(const Unit&) const {}
    __device__ __forceinline__ void done(const Unit&) const {}
};

constexpr int RTAB_OFF = 131072;
struct EpiProj {
    static constexpr bool PERM = true, AFTER_DRAIN = false, ROWPERM = false;
    bf16_t* O; int ldc; const LAS float* rtab; const float* bias;
    const float* gq; const float* gk; const float* rope;
    __device__ __forceinline__ void operator()(const f32x4 (&acc)[2][2][4][2], const Unit& u, int wr, int wc, int fr, int fq) const {
        asm volatile("" : "+v"(fr), "+v"(fq));
        const int row0 = u.pm * BM + wr * 64 + fr, col0 = u.pn * BM + wc * 32 + 8 * fq;
        const float sc = (u.pn == 2 || u.pn == 8) ? QSCALE2 : (u.pn == 4 ? 0.125f : 1.f);
        float rs[8] = {1.f, 1.f, 1.f, 1.f, 1.f, 1.f, 1.f, 1.f}; f32x4 bv[2][2] = {};
        if (rtab) {
#pragma unroll
            for (int i = 0; i < 8; ++i) rs[i] = rtab[u.ui * 256 + wr * 64 + fr + (i >> 2) * HALF + (i & 3) * 16];
            const int id = u.pm < 32 ? 0 : (u.pm < 64 ? 1 : 2);
#pragma unroll
            for (int bj = 0; bj < 2; ++bj)
#pragma unroll
                for (int n = 0; n < 2; ++n) bv[bj][n] = *(const f32x4*)(bias + id * PP + col0 + bj * HALF + 4 * n); }
        if (u.pn >= 4) {
#pragma unroll
            for (int ai = 0; ai < 2; ++ai)
#pragma unroll
                for (int m = 0; m < 4; ++m) { bf16_t* rowp = O + (size_t)(row0 + ai * HALF + m * 16) * ldc + col0; const float r = rs[ai * 4 + m];
#pragma unroll
                    for (int bj = 0; bj < 2; ++bj) { const f32x4 v0 = (acc[ai][bj][m][0] * r + bv[bj][0]) * sc, v1 = (acc[ai][bj][m][1] * r + bv[bj][1]) * sc;
                        u32x4 w; w.x = cvtpk(v0[0], v0[1]); w.y = cvtpk(v0[2], v0[3]); w.z = cvtpk(v1[0], v1[1]); w.w = cvtpk(v1[2], v1[3]);
                        *(u32x4*)(rowp + bj * HALF) = w; } }
            return;
        }
        const bool lat = u.pm < 64;
        const bool khead = (u.pn & 1) && wc < 2;
        const bool donorm = u.pn == 0 || (u.pn == 1 && wc < 2);
        const bool dorope = lat && (!(u.pn & 1) || khead);
        const float* gp = u.pn == 0 ? gq : gk;
        f32x4 gg[2][2];
#pragma unroll
        for (int bj = 0; bj < 2; ++bj)
#pragma unroll
            for (int n = 0; n < 2; ++n) gg[bj][n] = donorm ? *(const f32x4*)(gp + 32 * bj + 16 * n + 4 * fq) : (f32x4){1.f, 1.f, 1.f, 1.f};
        const float qs = u.pn == 0 ? QSCALE2 : 1.f;
#pragma unroll
        for (int ai = 0; ai < 2; ++ai)
#pragma unroll
            for (int m = 0; m < 4; ++m) { const int row = row0 + ai * HALF + m * 16; const float r = rs[ai * 4 + m];
                f32x4 v[2][2]; float ss = 0.f;
#pragma unroll
                for (int bj = 0; bj < 2; ++bj)
#pragma unroll
                    for (int n = 0; n < 2; ++n) { v[bj][n] = (acc[ai][bj][m][n] * r + bv[bj][n]) * sc; ss += (v[bj][n][0] * v[bj][n][0] + v[bj][n][1] * v[bj][n][1]) + (v[bj][n][2] * v[bj][n][2] + v[bj][n][3] * v[bj][n][3]); }
                if (donorm) { ss += shfl_idx(ss, (fq * 16 + fr) ^ 16); ss += shfl_idx(ss, (fq * 16 + fr) ^ 32); const float rstd = rsqrtf(ss * (1.f / 64.f) + EPS) * qs;
#pragma unroll
                    for (int bj = 0; bj < 2; ++bj)
#pragma unroll
                        for (int n = 0; n < 2; ++n) v[bj][n] = v[bj][n] * rstd * gg[bj][n]; }
                bf16_t* rowp = O + (size_t)row * ldc + u.pn * BM + 64 * wc + 4 * fq;
                const int t = row & (SEQ - 1);
#pragma unroll
                for (int bj = 0; bj < 2; ++bj) { f32x4 o1 = v[bj][0], o2 = v[bj][1];
                    if (dorope) { const float* rp = rope + ((size_t)(bj ? 128 + (t & 63) : (t >> 6)) * 16 + 4 * fq) * 2; const f32x4 c0 = *(const f32x4*)rp, c1 = *(const f32x4*)(rp + 4);
                        const f32x4 cz = {c0[0], c0[2], c1[0], c1[2]}, sz = {c0[1], c0[3], c1[1], c1[3]};
                        o1 = v[bj][0] * cz - v[bj][1] * sz; o2 = v[bj][0] * sz + v[bj][1] * cz; }
                    u32x2 w1, w2; w1.x = cvtpk(o1[0], o1[1]); w1.y = cvtpk(o1[2], o1[3]); w2.x = cvtpk(o2[0], o2[1]); w2.y = cvtpk(o2[2], o2[3]);
                    *(u32x2*)(rowp + 32 * bj) = w1; *(u32x2*)(rowp + 32 * bj + 16) = w2; } }
    }
};
struct EpiResid {
    static constexpr bool PERM = true, AFTER_DRAIN = false, ROWPERM = false;
    const float* xin_lat; const float* xin_ctx; float* xout_lat; float* xout_ctx; const float* gate;
    bf16_t* xg; const float* gn; const float* scn; float* ssq;
    __device__ __forceinline__ void operator()(const f32x4 (&acc)[2][2][4][2], const Unit& u, int wr, int wc, int fr, int fq) const {
        asm volatile("" : "+v"(fr), "+v"(fq));
        const int id = u.pm < 32 ? 0 : (u.pm < 64 ? 1 : 2);
        const float* xin = u.pm < 64 ? xin_lat + (size_t)u.pm * BM * DM : xin_ctx + (size_t)(u.pm - 64) * BM * DM;
        float* xout = u.pm < 64 ? xout_lat + (size_t)u.pm * BM * DM : xout_ctx + (size_t)(u.pm - 64) * BM * DM;
        const int rl = wr * 64 + fr, col0 = u.pn * BM + wc * 32 + 8 * fq;
        f32x4 g[2][2], gs[2][2];
#pragma unroll
        for (int bj = 0; bj < 2; ++bj)
#pragma unroll
            for (int n = 0; n < 2; ++n) { g[bj][n] = *(const f32x4*)(gate + id * 6144 + col0 + bj * HALF + 4 * n);
                if (xg) gs[bj][n] = *(const f32x4*)(gn + col0 + bj * HALF + 4 * n) * (1.f + *(const f32x4*)(scn + id * 6144 + col0 + bj * HALF + 4 * n)); }
#pragma unroll
        for (int ai = 0; ai < 2; ++ai)
#pragma unroll
            for (int m = 0; m < 4; ++m) { const size_t off = (size_t)(rl + ai * HALF + m * 16) * DM + col0; float s = 0.f;
#pragma unroll
                for (int bj = 0; bj < 2; ++bj) { f32x4 o[2];
#pragma unroll
                    for (int n = 0; n < 2; ++n) { const f32x4 xv = *(const f32x4*)(xin + off + bj * HALF + 4 * n); o[n] = xv + g[bj][n] * acc[ai][bj][m][n];
                        *(f32x4*)(xout + off + bj * HALF + 4 * n) = o[n]; s += (o[n][0] * o[n][0] + o[n][1] * o[n][1]) + (o[n][2] * o[n][2] + o[n][3] * o[n][3]); }
                    if (xg) { const f32x4 a = o[0] * gs[bj][0], b = o[1] * gs[bj][1]; u32x4 w; w.x = cvtpk(a[0], a[1]); w.y = cvtpk(a[2], a[3]); w.z = cvtpk(b[0], b[1]); w.w = cvtpk(b[2], b[3]);
                        *(u32x4*)(xg + (size_t)u.pm * BM * DM + off + bj * HALF) = w; } }
                if (xg) { s += shfl_idx(s, (fq * 16 + fr) ^ 16); s += shfl_idx(s, (fq * 16 + fr) ^ 32);
                    if (fq == 0) ssq[(size_t)(u.pm * BM + rl + ai * HALF + m * 16) * 16 + u.pn * 4 + wc] = s; } }
    }
};
struct EpiResidStaged {
    static constexpr bool PERM = true, AFTER_DRAIN = true, ROWPERM = false;
    const float* xin_lat; const float* xin_ctx; float* xout_lat; float* xout_ctx; const float* gate;
    bf16_t* xg; const float* gn; const float* scn; float* ssq;
    static constexpr int RS = 1040;
    __device__ __forceinline__ void operator()(const f32x4 (&)[2][2][4][2], const Unit&, int, int, int, int) const {}
    __device__ __forceinline__ void fused(const f32x4 (&acc)[2][2][4][2], const Unit& u, int wr, int wc, int fr, int fq, PG8_LAS unsigned char* lds, int wid, int lane) const {
        const int id = u.pm < 32 ? 0 : (u.pm < 64 ? 1 : 2);
        const float* xin = u.pm < 64 ? xin_lat + (size_t)u.pm * BM * DM : xin_ctx + (size_t)(u.pm - 64) * BM * DM;
        float* xout = u.pm < 64 ? xout_lat + (size_t)u.pm * BM * DM : xout_ctx + (size_t)(u.pm - 64) * BM * DM;
        const int colg = u.pn * BM + 4 * lane;
        const f32x4 gv = *(const f32x4*)(gate + id * 6144 + colg);
        f32x4 gsv = {0.f, 0.f, 0.f, 0.f}; if (xg) gsv = *(const f32x4*)(gn + colg) * (1.f + *(const f32x4*)(scn + id * 6144 + colg));
#pragma unroll
        for (int ai = 0; ai < 2; ++ai) {
#pragma unroll
            for (int m = 0; m < 4; ++m)
#pragma unroll
                for (int bj = 0; bj < 2; ++bj)
#pragma unroll
                    for (int n = 0; n < 2; ++n) *(PG8_LAS f32x4*)(lds + (wr * 64 + m * 16 + fr) * RS + (bj * HALF + wc * 32 + 8 * fq + 4 * n) * 4) = acc[ai][bj][m][n];
            asm volatile("s_waitcnt lgkmcnt(0)\n\ts_barrier" ::: "memory");
#pragma unroll
            for (int r8 = 0; r8 < 2; ++r8) {
                f32x4 xv[8], av[8]; float s[8];
#pragma unroll
                for (int q = 0; q < 8; ++q) { const int row = wid * 16 + r8 * 8 + q; xv[q] = *(const f32x4*)(xin + (size_t)(ai * HALF + row) * DM + colg); av[q] = *(const PG8_LAS f32x4*)(lds + row * RS + lane * 16); }
#pragma unroll
                for (int q = 0; q < 8; ++q) { const int row = wid * 16 + r8 * 8 + q; const f32x4 o = xv[q] + gv * av[q];
                    *(f32x4*)(xout + (size_t)(ai * HALF + row) * DM + colg) = o; s[q] = (o[0] * o[0] + o[1] * o[1]) + (o[2] * o[2] + o[3] * o[3]);
                    if (xg) { const f32x4 a = o * gsv; u32x2 w; w.x = cvtpk(a[0], a[1]); w.y = cvtpk(a[2], a[3]); *(u32x2*)(xg + (size_t)(u.pm * BM + ai * HALF + row) * DM + colg) = w; } }
                if (xg) {
#pragma unroll
                    for (int o_ = 1; o_ < 64; o_ <<= 1)
#pragma unroll
                        for (int q = 0; q < 8; ++q) s[q] += shfl_x(s[q], o_, lane);
                    float sv = s[0];
#pragma unroll
                    for (int q = 1; q < 8; ++q) sv = lane == q ? s[q] : sv;
                    if (lane < 8) *(f32x4*)(ssq + (size_t)(u.pm * BM + ai * HALF + wid * 16 + r8 * 8 + lane) * 16 + u.pn * 4) = (f32x4){sv, 0.f, 0.f, 0.f}; }
            }
            asm volatile("s_waitcnt lgkmcnt(0)\n\ts_barrier" ::: "memory");
        }
    }
};
struct EpiUp {
    static constexpr bool PERM = true, AFTER_DRAIN = false, ROWPERM = true;
    bf16_t* act; const float* convw; const float* convb; float* edge; const LAS float* rtab; const float* bias;
    __device__ __forceinline__ void operator()(f32x4 (&acc)[2][2][4][2], const Unit& u, int wr, int wc, int fr, int fq) const {
        asm volatile("" : "+v"(fr), "+v"(fq));
        const int chb = u.pn * 128 + wc * 32 + 8 * fq;
        const int ht = 2 * u.pm + wr;
        {
            const f32x4 ra = *(const LAS f32x4*)(rtab + u.ui * 256 + (wr * 16 + fr) * 8), rb = *(const LAS f32x4*)(rtab + u.ui * 256 + (wr * 16 + fr) * 8 + 4);
            const float rs[8] = {ra[0], ra[1], ra[2], ra[3], rb[0], rb[1], rb[2], rb[3]};
            const int id = u.pm < 32 ? 0 : (u.pm < 64 ? 1 : 2);
#pragma unroll
            for (int bj = 0; bj < 2; ++bj)
#pragma unroll
                for (int n = 0; n < 2; ++n) { const f32x4 bv = *(const f32x4*)(bias + id * DFF2 + bj * DFF + chb + 4 * n);
#pragma unroll
                    for (int sl = 0; sl < 8; ++sl) { acc[sl >> 2][bj][sl & 3][n] = acc[sl >> 2][bj][sl & 3][n] * rs[sl] + bv; asm volatile("" : "+v"(acc[sl >> 2][bj][sl & 3][n])); } }
        }
        const int lm1 = (fq * 16 + fr - 1) & 63, lp1 = (fq * 16 + fr + 1) & 63;
#pragma unroll
        for (int bj = 0; bj < 2; ++bj)
#pragma unroll
            for (int n = 0; n < 2; ++n) {
                const int uc = bj * DFF + chb + 4 * n;
                if (fr == 0) { *(f32x4*)(edge + ((size_t)ht * 4 + 0) * DFF2 + uc) = acc[0][bj][0][n]; *(f32x4*)(edge + ((size_t)ht * 4 + 1) * DFF2 + uc) = acc[0][bj][1][n]; }
                if (fr == 15) { *(f32x4*)(edge + ((size_t)ht * 4 + 2) * DFF2 + uc) = acc[1][bj][2][n]; *(f32x4*)(edge + ((size_t)ht * 4 + 3) * DFF2 + uc) = acc[1][bj][3][n]; }
#pragma unroll
                for (int j = 0; j < 4; ++j) {
                    const float w0 = convw[uc + j], w1 = convw[DFF2 + uc + j], w2 = convw[2 * DFF2 + uc + j], bb = convb[uc + j];
                    float pv = shfl_idx(acc[1][bj][3][n][j], lm1); const float nx = shfl_idx(acc[0][bj][0][n][j], lp1);
#pragma unroll
                    for (int sl = 0; sl < 8; ++sl) { const float cur = acc[sl >> 2][bj][sl & 3][n][j]; const float nxt = sl < 7 ? acc[(sl + 1) >> 2][bj][(sl + 1) & 3][n][j] : nx;
                        acc[sl >> 2][bj][sl & 3][n][j] = w0 * pv + w1 * cur + w2 * nxt + bb; pv = cur; }
                }
#pragma unroll
                for (int sl = 0; sl < 8; ++sl) asm volatile("" : "+v"(acc[sl >> 2][bj][sl & 3][n]));
            }
        bf16_t* base = act + (size_t)(u.pm * BM + (wr * 16 + fr) * 8) * DFF + chb;
#pragma unroll
        for (int sl = 0; sl < 8; ++sl) {
            const f32x4 g0 = acc[sl >> 2][0][sl & 3][0], g1 = acc[sl >> 2][0][sl & 3][1], v0 = acc[sl >> 2][1][sl & 3][0], v1 = acc[sl >> 2][1][sl & 3][1];
            f32x4 o0, o1;
#pragma unroll
            for (int j = 0; j < 4; ++j) { o0[j] = g0[j] * __builtin_amdgcn_rcpf(1.f + __builtin_amdgcn_exp2f(-LOG2E * g0[j])) * v0[j]; o1[j] = g1[j] * __builtin_amdgcn_rcpf(1.f + __builtin_amdgcn_exp2f(-LOG2E * g1[j])) * v1[j]; }
            u32x4 w; w.x = cvtpk(o0[0], o0[1]); w.y = cvtpk(o0[2], o0[3]); w.z = cvtpk(o1[0], o1[1]); w.w = cvtpk(o1[2], o1[3]);
            const bool skip = (fr == 0 && sl == 0) || (fr == 15 && sl == 7);
            if (!skip) *(u32x4*)(base + (size_t)sl * DFF) = w;
        }
    }
};
template <class Epi, class Sched, bool ALIGN_EPI = false, bool SP2 = false>
__device__ __forceinline__ void gemm_phase(PG8_LAS unsigned char* lds, const Gemm g, const Sched& S, const Epi& E, const int tid) {
    const int wid = __builtin_amdgcn_readfirstlane(tid >> 6), lane = tid & 63, wr = wid >> 2, wc = wid & 3, fr = lane & 15, fq = lane >> 4;
    const int K = g.K, nt = K / BK;
    unsigned voffA[2], voffB[2];
#pragma unroll
    for (int i = 0; i < 2; ++i) { int R, C; stage_rc(tid * 16 + i * 8192, R, C); const int Rb = Epi::PERM ? ((R & ~31) + perm32(R & 31)) : R;
        const int Ra = Epi::ROWPERM ? (((((R >> 6) & 1) * 16 + (R & 15)) << 3) + ((R >> 4) & 3)) : R;
        voffA[i] = (unsigned)(Ra * K + C) * 2u; voffB[i] = (unsigned)(Rb * K + C) * 2u; }
    const size_t kstep = (size_t)(BK * 2);
    const size_t hstep = (size_t)HALF * K * 2;
    const size_t hstepA = Epi::ROWPERM ? (size_t)4 * K * 2 : hstep;
    const size_t tstep = 2 * hstep;
    const unsigned ldsw = (unsigned)wid * 1024u;
    const int aoff = lds_byte(wr * 64 + fr, fq * 8), boff = lds_byte(wc * 32 + fr, fq * 8);
#define PG8_SA(b, h) (((b) * 2 + (h)) * HTB)
#define PG8_SB(b, h) ((4 + (b) * 2 + (h)) * HTB)
#define PG8_STAGE(bufoff, gbase, voff) do { _Pragma("unroll") for (int _i = 0; _i < 2; ++_i) \
        __builtin_amdgcn_global_load_lds((const unsigned*)((const char*)(gbase) + (voff)[_i]), (PG8_LAS unsigned*)(lds + (bufoff) + ldsw + _i * 8192), 16, 0, 0); } while (0)
#define PG8_LDA(dst, b, h) do { _Pragma("unroll") for (int m = 0; m < 4; ++m) _Pragma("unroll") for (int k = 0; k < 2; ++k) dst[m][k] = *(const PG8_LAS bf16x8*)(lds + PG8_SA(b, h) + aoff + m * 2048 + k * 1024); } while (0)
#define PG8_LDB(dst, b, h) do { _Pragma("unroll") for (int n = 0; n < 2; ++n) _Pragma("unroll") for (int k = 0; k < 2; ++k) dst[n][k] = *(const PG8_LAS bf16x8*)(lds + PG8_SB(b, h) + boff + n * 2048 + k * 1024); } while (0)
#define PG8_MMA(ai, bj, At, Bt) do { __builtin_amdgcn_s_setprio(1); _Pragma("unroll") for (int m = 0; m < 4; ++m) _Pragma("unroll") for (int n = 0; n < 2; ++n) _Pragma("unroll") for (int k = 0; k < 2; ++k) \
        acc[ai][bj][m][n] = __builtin_amdgcn_mfma_f32_16x16x32_bf16(Bt[n][k], At[m][k], acc[ai][bj][m][n], 0, 0, 0); __builtin_amdgcn_s_setprio(0); } while (0)
#define PG8_WAIT_V(n) asm volatile("s_waitcnt vmcnt(" #n ")" ::: "memory")
#define PG8_WAIT_L(n) asm volatile("s_waitcnt lgkmcnt(" #n ")" ::: "memory")
#define PG8_BAR __builtin_amdgcn_s_barrier()
#define PG8_SCHED __builtin_amdgcn_sched_barrier(0)
    Unit cur, nxt; int ui = 0;
    if (!S.next(0, cur)) return;
    f32x4 acc[2][2][4][2];
#pragma unroll
    for (int a = 0; a < 2; ++a)
#pragma unroll
        for (int b = 0; b < 2; ++b)
#pragma unroll
            for (int m = 0; m < 4; ++m)
#pragma unroll
                for (int n = 0; n < 2; ++n) acc[a][b][m][n] = (f32x4){0.f, 0.f, 0.f, 0.f};
    bf16x8 At[4][2], B0[2][2], B1[2][2];
    const char* cA = (const char*)g.A + (size_t)cur.pm * tstep; const char* cB = (const char*)g.Bt + (size_t)cur.pn * tstep;
    S.a_ready(cur);
    if constexpr (SP2) {
        PG8_STAGE(PG8_SB(0, 0), cB, voffB); PG8_STAGE(PG8_SB(0, 1), cB + hstep, voffB); PG8_STAGE(PG8_SA(0, 0), cA, voffA); PG8_STAGE(PG8_SA(0, 1), cA + hstepA, voffA);
        if (wr == 1) PG8_BAR;
        PG8_WAIT_V(2); PG8_BAR;
        PG8_STAGE(PG8_SB(1, 0), cB + kstep, voffB); PG8_STAGE(PG8_SA(1, 0), cA + kstep, voffA); PG8_STAGE(PG8_SB(1, 1), cB + hstep + kstep, voffB);
        PG8_WAIT_V(6); PG8_BAR;
    } else {
        PG8_STAGE(PG8_SB(0, 0), cB, voffB); PG8_STAGE(PG8_SA(0, 0), cA, voffA); PG8_STAGE(PG8_SB(0, 1), cB + hstep, voffB); PG8_STAGE(PG8_SA(0, 1), cA + hstepA, voffA);
        if (wr == 1) PG8_BAR;
        PG8_WAIT_V(4); PG8_BAR;
        PG8_STAGE(PG8_SB(1, 0), cB + kstep, voffB); PG8_STAGE(PG8_SA(1, 0), cA + kstep, voffA); PG8_STAGE(PG8_SB(1, 1), cB + hstep + kstep, voffB);
        PG8_WAIT_V(6); PG8_BAR;
    }
    PROBE_PT(lds, 1);
    for (;;) {
        const bool has_next = S.next(ui + 1, nxt);
        const char* nA = has_next ? (const char*)g.A + (size_t)nxt.pm * tstep : cA; const char* nB = has_next ? (const char*)g.Bt + (size_t)nxt.pn * tstep : cB;
        for (int t = 0; t < nt; t += 2) {
            const bool last = (t == nt - 2);
            const char* a1 = cA + (size_t)(t + 1) * kstep;
            const char* a2 = last ? nA : cA + (size_t)(t + 2) * kstep; const char* b2 = last ? nB : cB + (size_t)(t + 2) * kstep;
            const char* a3 = a2 + kstep; const char* b3 = b2 + kstep;
            if (last && has_next) S.a_ready(nxt);
            if constexpr (SP2) {
            PG8_LDB(B0, 0, 0); PG8_LDB(B1, 0, 1); PG8_SCHED; PG8_LDA(At, 0, 0); PG8_STAGE(PG8_SA(1, 1), a1 + hstepA, voffA);
            PG8_WAIT_V(8); PG8_WAIT_L(0); PG8_BAR; PG8_MMA(0, 0, At, B0); PG8_MMA(0, 1, At, B1); PG8_BAR; PG8_SCHED;
            PG8_LDA(At, 0, 1); PG8_STAGE(PG8_SB(0, 0), b2, voffB); PG8_STAGE(PG8_SB(0, 1), b2 + hstep, voffB); PG8_STAGE(PG8_SA(0, 0), a2, voffA);
            PG8_WAIT_V(8); PG8_WAIT_L(0); PG8_BAR; PG8_MMA(1, 0, At, B0); PG8_MMA(1, 1, At, B1); PG8_BAR; PG8_SCHED;
            PG8_LDB(B0, 1, 0); PG8_LDB(B1, 1, 1); PG8_SCHED; PG8_LDA(At, 1, 0); PG8_STAGE(PG8_SA(0, 1), a2 + hstepA, voffA);
            PG8_WAIT_V(8); PG8_WAIT_L(0); PG8_BAR; PG8_MMA(0, 0, At, B0); PG8_MMA(0, 1, At, B1); PG8_BAR; PG8_SCHED;
            PG8_LDA(At, 1, 1); PG8_STAGE(PG8_SB(1, 0), b3, voffB); PG8_STAGE(PG8_SB(1, 1), b3 + hstep, voffB); PG8_STAGE(PG8_SA(1, 0), a3, voffA);
            PG8_WAIT_V(8); PG8_WAIT_L(0); PG8_BAR; PG8_MMA(1, 0, At, B0); PG8_MMA(1, 1, At, B1); PG8_BAR; PG8_SCHED;
            } else {
            PG8_LDB(B0, 0, 0); PG8_SCHED; PG8_LDA(At, 0, 0); PG8_STAGE(PG8_SA(1, 1), a1 + hstepA, voffA);
            PG8_WAIT_L(8); PG8_BAR; PG8_WAIT_L(0); PG8_MMA(0, 0, At, B0); PG8_BAR; PG8_SCHED;
            PG8_LDB(B1, 0, 1); PG8_STAGE(PG8_SB(0, 0), b2, voffB);
            PG8_BAR; PG8_WAIT_L(0); PG8_MMA(0, 1, At, B1); PG8_BAR;
            PG8_LDA(At, 0, 1); PG8_STAGE(PG8_SA(0, 0), a2, voffA);
            PG8_BAR; PG8_WAIT_L(0); PG8_MMA(1, 0, At, B0); PG8_BAR; PG8_SCHED;
            PG8_STAGE(PG8_SB(0, 1), b2 + hstep, voffB);
            PG8_WAIT_V(6); PG8_BAR; PG8_MMA(1, 1, At, B1); PG8_BAR;
            PG8_LDB(B0, 1, 0); PG8_SCHED; PG8_LDA(At, 1, 0); PG8_STAGE(PG8_SA(0, 1), a2 + hstepA, voffA);
            PG8_WAIT_L(8); PG8_BAR; PG8_WAIT_L(0); PG8_MMA(0, 0, At, B0); PG8_BAR; PG8_SCHED;
            PG8_LDB(B1, 1, 1); PG8_STAGE(PG8_SB(1, 0), b3, voffB);
            PG8_BAR; PG8_WAIT_L(0); PG8_MMA(0, 1, At, B1); PG8_BAR;
            PG8_LDA(At, 1, 1); PG8_STAGE(PG8_SA(1, 0), a3, voffA);
            PG8_BAR; PG8_WAIT_L(0); PG8_MMA(1, 0, At, B0); PG8_BAR; PG8_SCHED;
            PG8_STAGE(PG8_SB(1, 1), b3 + hstep, voffB);
            PG8_WAIT_V(6); PG8_BAR; PG8_MMA(1, 1, At, B1); PG8_BAR;
            }
        }
        PROBE_PT(lds, 2);
        if constexpr (ALIGN_EPI) { if (wr == 0) PG8_BAR; }
        if constexpr (!Epi::AFTER_DRAIN) { E(acc, cur, wr, wc, fr, fq); S.done(cur); }
        PROBE_PT(lds, 3);
        if (!has_next) break;
#pragma unroll
        for (int a = 0; a < 2; ++a)
#pragma unroll
            for (int b = 0; b < 2; ++b)
#pragma unroll
                for (int m = 0; m < 4; ++m)
#pragma unroll
                    for (int n = 0; n < 2; ++n) acc[a][b][m][n] = (f32x4){0.f, 0.f, 0.f, 0.f};
        cur = nxt; cA = nA; cB = nB; ++ui;
        if constexpr (ALIGN_EPI) { if (wr == 1) PG8_BAR; }
    }
    PG8_WAIT_V(0);
    if constexpr (!ALIGN_EPI) { if (wr == 0) PG8_BAR; }
    PG8_BAR;
    if constexpr (Epi::AFTER_DRAIN) { E.fused(acc, cur, wr, wc, fr, fq, lds, wid, lane); S.done(cur); }
#undef PG8_SA
#undef PG8_SB
#undef PG8_STAGE
#undef PG8_LDA
#undef PG8_LDB
#undef PG8_MMA
#undef PG8_WAIT_V
#undef PG8_WAIT_L
#undef PG8_BAR
#undef PG8_SCHED
}
}

constexpr size_t WS_WGB = WS_WG + 192 * 1024;
constexpr size_t WS_MODP = 235 * MiB;
constexpr int NWAVES = 8, NTHREADS = 512;
constexpr int LDSCTL_OFF = 155648;
constexpr int LDS_BYTES = LDSCTL_OFF + 256;
struct Args {
    const float* in[21]; float* out; unsigned char* ws; int ph_lo, ph_hi;
};
struct Frame {
    LAS unsigned char* lds;
    int tid, lane, wave, G, bid;
    const __attribute__((address_space(4))) Args* ka;
    float* out; unsigned char* ws;
};
enum { IN_X = 0, IN_C, IN_CTX, IN_CCTX, IN_WMOD, IN_BMOD, IN_G1, IN_G2, IN_WIN, IN_AQG, IN_AKG, IN_SINK, IN_CGB, IN_RPB, IN_GGRP, IN_WOUT, IN_WUP, IN_CONVW, IN_CONVB, IN_WDN, IN_GFIN };

struct TItem { const float* W; bf16_t* WT; int K, N, kind, item; };
__device__ __forceinline__ int tmap(int kind, int n) {
    if (kind == 0) { if (n < 1024) { const int d = n & 63, hh = (n >> 6) & 3; return (n & ~255) + 128 * (d >> 5) + 32 * hh + 8 * ((d & 15) >> 2) + 4 * ((d >> 4) & 1) + (d & 3); }
                     return n < 2048 ? n : (n < 2064 ? -1 : n - 16); }
    if (kind == 2) { const int m = n < DFF ? n : n - DFF; return (m >> 7) * 256 + (n < DFF ? 0 : 128) + (m & 127); }
    return n;
}
__device__ __forceinline__ void tload(const TItem& t, int lane, f32x4 (&v)[16]) {
    const int nblk = (t.N + 63) / 64, kb = t.item / nblk, nb = t.item % nblk, k0 = 64 * kb, nc = 64 * nb + 4 * (lane & 15);
#pragma unroll
    for (int i = 0; i < 16; ++i) { const int kk = (lane >> 4) + 4 * i; v[i] = nc < t.N ? *(const f32x4*)(t.W + (size_t)(k0 + kk) * t.N + nc) : (f32x4){0.f, 0.f, 0.f, 0.f}; }
}
__device__ __forceinline__ void tproc(const TItem& t, LAS float* scr, int lane, const f32x4 (&v)[16]) {
    const int nblk = (t.N + 63) / 64, kb = t.item / nblk, nb = t.item % nblk, k0 = 64 * kb, n0 = 64 * nb;
#pragma unroll
    for (int i = 0; i < 16; ++i) { const int kk = (lane >> 4) + 4 * i; LAS float* d = scr + kk * 65 + 4 * (lane & 15); d[0] = v[i][0]; d[1] = v[i][1]; d[2] = v[i][2]; d[3] = v[i][3]; }
    LDS_WAIT(); asm volatile("" ::: "memory");
    const int c = lane & 7;
#pragma unroll
    for (int j = 0; j < 8; ++j) { const int n = (lane >> 3) + 8 * j; const LAS float* s = scr + (8 * c) * 65 + n;
        u32x4 o; o.x = cvtpk(s[0 * 65], s[1 * 65]); o.y = cvtpk(s[2 * 65], s[3 * 65]); o.z = cvtpk(s[4 * 65], s[5 * 65]); o.w = cvtpk(s[6 * 65], s[7 * 65]);
        const int sc = n0 + n; const int dr = sc < t.N ? tmap(t.kind, sc) : -1;
        if (dr >= 0) *(u32x4*)(t.WT + (size_t)dr * t.K + k0 + 8 * c) = o; }
    LDS_WAIT(); asm volatile("" ::: "memory");
}
__device__ __forceinline__ void p0_prologue(Frame& F) {
    const float* c = F.ka->in[IN_C]; const float* cctx = F.ka->in[IN_CCTX];
    const int gw = F.bid * NWAVES + F.wave, NGW = F.G * NWAVES;
    if (F.bid < NLAYER * 48 || F.G < NLAYER * 48 + 8) {
        LAS float* sv = (LAS float*)F.lds;
        LAS float* red = (LAS float*)(F.lds + 12288);
        for (int i = F.tid; i < 3 * 1024; i += NTHREADS) { const int id = i >> 10, k = i & 1023; const float v = id < 2 ? c[id * 1024 + k] : cctx[k]; sv[i] = v / (1.f + __expf(-v)); }
        __syncthreads();
        float* MOD = (float*)(F.ws + WS_MOD);
        for (int it = F.bid; it < NLAYER * 48; it += F.G) {
            const int l = it / 48, nb = it % 48, n = nb * 128 + 2 * F.lane;
            const float* w = F.ka->in[IN_WMOD] + ((size_t)l * 1024 + F.wave * 128) * 6144 + n;
            f32x2 a0 = {0.f, 0.f}, a1 = {0.f, 0.f}, a2 = {0.f, 0.f};
#pragma unroll 32
            for (int k = 0; k < 128; ++k) { const f32x2 wv = *(const f32x2*)(w + (size_t)k * 6144); const int kk = F.wave * 128 + k; a0 += sv[kk] * wv; a1 += sv[1024 + kk] * wv; a2 += sv[2048 + kk] * wv; }
            *(LAS f32x2*)(red + (F.wave * 3 + 0) * 128 + 2 * F.lane) = a0; *(LAS f32x2*)(red + (F.wave * 3 + 1) * 128 + 2 * F.lane) = a1; *(LAS f32x2*)(red + (F.wave * 3 + 2) * 128 + 2 * F.lane) = a2;
            __syncthreads();
            if (F.tid < 384) { const int id = F.tid >> 7, ln = F.tid & 127; float s = F.ka->in[IN_BMOD][l * 6144 + nb * 128 + ln];
#pragma unroll
                for (int w8 = 0; w8 < 8; ++w8) s += red[(w8 * 3 + id) * 128 + ln];
                MOD[((size_t)l * 3 + id) * 6144 + nb * 128 + ln] = s; }
            __syncthreads();
        }
    }
    PROBE_PT(F.lds, 1);
    { const int b0 = F.G >= NLAYER * 48 + 8 ? NLAYER * 48 : 0, nb_ = F.G - b0;
      if (F.bid >= b0) { const int gt2 = (F.bid - b0) * NTHREADS + F.tid, NGT2 = nb_ * NTHREADS;
        float* ROPE = (float*)(F.ws + WS_ROPE); float* WG = (float*)(F.ws + WS_WG); bf16_t* WGB = (bf16_t*)(F.ws + WS_WGB);
        for (int e = gt2; e < 192 * 16 + NLAYER * 16 * 1024; e += NGT2) {
            if (e < 192 * 16) { const int idx = e >> 4, i = e & 15; const float pos = (float)(idx < 128 ? idx : idx - 128);
                const float freq = powf(10000.0f, -(float)i / 16.0f); const float ang = pos * freq; ROPE[2 * e] = cosf(ang); ROPE[2 * e + 1] = sinf(ang); }
            else { const int e2 = e - 192 * 16, l = e2 >> 14, o = (e2 >> 10) & 15, k = e2 & 1023; const float v = F.ka->in[IN_WIN][((size_t)l * 1024 + k) * DIN + 2048 + o]; WG[e2] = v; WGB[e2] = (bf16_t)(cvtpk(v, 0.f) & 0xffffu); } } } }
    PROBE_PT(F.lds, 2);
    LAS float* scr = (LAS float*)(F.lds + F.wave * 16896);
    constexpr int I_IN = 16 * 45, I_OUT = 16 * 16, I_UP = 16 * 88, I_DN = 44 * 16, I_L = I_IN + I_OUT + I_UP + I_DN;
    auto decode = [&](int it) { TItem t; const int l = it / I_L; int r = it % I_L;
        if (r < I_IN) { t.W = F.ka->in[IN_WIN] + (size_t)l * 1024 * DIN; t.WT = (bf16_t*)(F.ws + WS_WIN) + (size_t)l * PP * 1024; t.K = 1024; t.N = DIN; t.kind = 0; t.item = r; return t; } r -= I_IN;
        if (r < I_OUT) { t.W = F.ka->in[IN_WOUT] + (size_t)l * 1024 * 1024; t.WT = (bf16_t*)(F.ws + WS_WOUT) + (size_t)l * 1024 * 1024; t.K = 1024; t.N = 1024; t.kind = 1; t.item = r; return t; } r -= I_OUT;
        if (r < I_UP) { t.W = F.ka->in[IN_WUP] + (size_t)l * 1024 * DFF2; t.WT = (bf16_t*)(F.ws + WS_WUP) + (size_t)l * DFF2 * 1024; t.K = 1024; t.N = DFF2; t.kind = 2; t.item = r; return t; } r -= I_UP;
        t.W = F.ka->in[IN_WDN] + (size_t)l * DFF * 1024; t.WT = (bf16_t*)(F.ws + WS_WDN) + (size_t)l * 1024 * DFF; t.K = DFF; t.N = 1024; t.kind = 1; t.item = r; return t; };
    constexpr int NIT = NLAYER * I_L;
    int it = gw;
    if (it < NIT) { TItem ta = decode(it), tb = ta; f32x4 va[16], vb[16]; tload(ta, F.lane, va);
        for (;;) {
            const int i1 = it + NGW; if (i1 < NIT) { tb = decode(i1); tload(tb, F.lane, vb); }
            tproc(ta, scr, F.lane, va); if (i1 >= NIT) break;
            const int i2 = i1 + NGW; if (i2 < NIT) { ta = decode(i2); tload(ta, F.lane, va); }
            tproc(tb, scr, F.lane, vb); if (i2 >= NIT) break;
            it = i2; } }
}

template <int R>
__device__ __forceinline__ void norm_rows(Frame& F, const float* xbase, int row0, const float* sh, const float* sc, const f32x4 (&gv)[4]) {
    bf16_t* H = (bf16_t*)(F.ws + WS_H);
    f32x4 hv[R][4]; float ss[R];
#pragma unroll
    for (int r = 0; r < R; ++r)
#pragma unroll
        for (int j = 0; j < 4; ++j) hv[r][j] = *(const f32x4*)(xbase + (size_t)r * DM + 4 * F.lane + 256 * j);
#pragma unroll
    for (int r = 0; r < R; ++r) { float s = 0.f;
#pragma unroll
        for (int j = 0; j < 4; ++j) s += (hv[r][j][0] * hv[r][j][0] + hv[r][j][1] * hv[r][j][1]) + (hv[r][j][2] * hv[r][j][2] + hv[r][j][3] * hv[r][j][3]);
        ss[r] = s; }
#pragma unroll
    for (int o = 1; o < 64; o <<= 1)
#pragma unroll
        for (int r = 0; r < R; ++r) ss[r] += shfl_x(ss[r], o, F.lane);
#pragma unroll
    for (int j = 0; j < 4; ++j) { const f32x4 scv = 1.f + *(const f32x4*)(sc + 4 * F.lane + 256 * j), shv = *(const f32x4*)(sh + 4 * F.lane + 256 * j);
#pragma unroll
        for (int r = 0; r < R; ++r) { const f32x4 v = hv[r][j] * rsqrtf(ss[r] * (1.f / DM) + EPS) * gv[j] * scv + shv;
            u32x2 w; w.x = cvtpk(v[0], v[1]); w.y = cvtpk(v[2], v[3]);
            *(u32x2*)(H + (size_t)(row0 + r) * DM + 4 * F.lane + 256 * j) = w; } }
}
__device__ __forceinline__ void norm_phase(Frame& F, int layer) {
    const int gw = F.bid * NWAVES + F.wave, NGW = F.G * NWAVES;
    const float* gvec = F.ka->in[IN_G1] + layer * 1024;
    const float* mod = (const float*)(F.ws + WS_MOD) + (size_t)layer * 3 * 6144;
    const float* xl = F.ka->in[IN_X]; const float* xc = F.ka->in[IN_CTX];
    f32x4 gv[4];
#pragma unroll
    for (int j = 0; j < 4; ++j) gv[j] = *(const f32x4*)(gvec + 4 * F.lane + 256 * j);
    for (int rg = gw; rg < NLAT / 8; rg += NGW) { const int row0 = rg * 8, id = row0 < SEQ ? 0 : 1; norm_rows<8>(F, xl + (size_t)row0 * DM, row0, mod + id * 6144, mod + id * 6144 + 1024, gv); }
    for (int rg = gw; rg < NBATCH * CTXL / 2; rg += NGW) { const int row0 = rg * 2; norm_rows<2>(F, xc + (size_t)row0 * DM, NLAT + row0, mod + 2 * 6144, mod + 2 * 6144 + 1024, gv); }
}

constexpr size_t WS_BIASG = WS_BIASIN + 64 * 1024;
__device__ __forceinline__ void bias_phase(Frame& F, int bslot, int nslots) {
    if (bslot < 0 && nslots > 0) return;
    if (nslots <= 0) { bslot = F.bid; nslots = F.G; }
    const int gw = bslot * NWAVES + F.wave, NGW = nslots * NWAVES, lane = F.lane, fr = lane & 15, fq = lane >> 4;
    const float* MOD = (const float*)(F.ws + WS_MOD);
    float* BUP = (float*)(F.ws + WS_BIASUP); float* BIN = (float*)(F.ws + WS_BIASIN); float* BG = (float*)(F.ws + WS_BIASG);
    constexpr int J_UP = DFF2 / 16, J_IN = PP / 16;
    for (int job = gw; job < 2 * J_UP + J_IN + 1; job += NGW) {
        const bool isup = job < 2 * J_UP, isin = !isup && job < 2 * J_UP + J_IN; const int l = isup ? job / J_UP : 1, r0 = 16 * (isup ? job % J_UP : (isin ? job - 2 * J_UP : 0));
        const bf16_t* wrow = isup ? (const bf16_t*)(F.ws + WS_WUP) + ((size_t)l * DFF2 + r0 + fr) * 1024 : (isin ? (const bf16_t*)(F.ws + WS_WIN) + ((size_t)PP + r0 + fr) * 1024 : (const bf16_t*)(F.ws + WS_WGB) + (size_t)(16 + fr) * 1024);
        const float* sh = MOD + ((size_t)l * 3 + (fr < 3 ? fr : 0)) * 6144 + (isup ? 3 * 1024 : 0) + 8 * fq;
        const bf16_t* bp = wrow + 8 * fq;
        f32x4 acc = {0.f, 0.f, 0.f, 0.f};
        for (int k0 = 0; k0 < DM / 32; k0 += 8) { f32x4 a0[8], a1[8]; bf16x8 bv[8];
#pragma unroll
            for (int j = 0; j < 8; ++j) { a0[j] = *(const f32x4*)(sh + 32 * (k0 + j)); a1[j] = *(const f32x4*)(sh + 32 * (k0 + j) + 4); bv[j] = *(const bf16x8*)(bp + 32 * (k0 + j)); }
#pragma unroll
            for (int j = 0; j < 8; ++j) { u32x4 aw; aw.x = cvtpk(a0[j][0], a0[j][1]); aw.y = cvtpk(a0[j][2], a0[j][3]); aw.z = cvtpk(a1[j][0], a1[j][1]); aw.w = cvtpk(a1[j][2], a1[j][3]);
                acc = __builtin_amdgcn_mfma_f32_16x16x32_bf16(__builtin_bit_cast(bf16x8, aw), bv[j], acc, 0, 0, 0); } }
        if (fq == 0) { const int r = r0 + fr;
            if (isup) { const int pn = r >> 8, i = r & 255; const int uc = i < 128 ? pn * 128 + i : DFF + pn * 128 + (i - 128);
                BUP[((size_t)l * 3 + 0) * DFF2 + uc] = acc[0]; BUP[((size_t)l * 3 + 1) * DFF2 + uc] = acc[1]; BUP[((size_t)l * 3 + 2) * DFF2 + uc] = acc[2]; }
            else if (isin) { BIN[r] = acc[0]; BIN[PP + r] = acc[1]; BIN[2 * PP + r] = acc[2]; }
            else { BG[fr] = acc[0]; BG[16 + fr] = acc[1]; BG[32 + fr] = acc[2]; } }
    }
}
__device__ __forceinline__ void gates_phase(Frame& F, int layer) {
    const int gw = F.bid * NWAVES + F.wave, NGW = F.G * NWAVES, lane = F.lane, fr = lane & 15, fq = lane >> 4;
    const bf16_t* H = (const bf16_t*)(F.ws + WS_H); const float* SSQ = (const float*)(F.ws + WS_SSQ1); const float* SSQC = (const float*)(F.ws + WS_SSQC1);
    const bf16_t* WGB = (const bf16_t*)(F.ws + WS_WGB) + (size_t)layer * 16 * 1024; const float* BG = (const float*)(F.ws + WS_BIASG);
    float* GATES = (float*)(F.ws + WS_GATES);
    for (int job = gw; job < NROWS / 16; job += NGW) {
        const int r0 = 16 * job; const int id = r0 < SEQ ? 0 : (r0 < NLAT ? 1 : 2);
        const bf16_t* ap = H + (size_t)(r0 + fr) * DM + 8 * fq; const bf16_t* bp = WGB + (size_t)fr * DM + 8 * fq;
        f32x4 acc = {0.f, 0.f, 0.f, 0.f};
        for (int k0 = 0; k0 < DM / 32; k0 += 16) { bf16x8 av[16], bv[16];
#pragma unroll
            for (int j = 0; j < 16; ++j) { av[j] = *(const bf16x8*)(ap + 32 * (k0 + j)); bv[j] = *(const bf16x8*)(bp + 32 * (k0 + j)); }
#pragma unroll
            for (int j = 0; j < 16; ++j) acc = __builtin_amdgcn_mfma_f32_16x16x32_bf16(av[j], bv[j], acc, 0, 0, 0); }
        float rs[4] = {1.f, 1.f, 1.f, 1.f}, bo = 0.f;
        if (layer > 0) {
            float s = 0.f;
            if (r0 < NLAT) { const f32x4 a = *(const f32x4*)(SSQ + (size_t)(r0 + (lane >> 2)) * 16 + 4 * (lane & 3)); s = (a[0] + a[1]) + (a[2] + a[3]); }
            else { const float* p = SSQC + (size_t)(r0 - NLAT + (lane >> 2)) * 64 + 16 * (lane & 3);
#pragma unroll
                for (int j = 0; j < 4; ++j) { const f32x4 a = *(const f32x4*)(p + 4 * j); s += (a[0] + a[1]) + (a[2] + a[3]); } }
            s += shfl_x(s, 1, lane); s += shfl_x(s, 2, lane);
            const float rr = rsqrtf(s * (1.f / DM) + EPS);
#pragma unroll
            for (int r = 0; r < 4; ++r) rs[r] = shfl_idx(rr, 4 * (4 * fq + r));
            bo = BG[id * 16 + fr];
        }
#pragma unroll
        for (int r = 0; r < 4; ++r) GATES[(size_t)(r0 + 4 * fq + r) * 16 + fr] = acc[r] * rs[r] + bo;
    }
}

__device__ __forceinline__ void postproj_phase(Frame& F, int layer) {
    const int gw = F.bid * NWAVES + F.wave, NGW = F.G * NWAVES;
    bf16_t* PROJ = (bf16_t*)(F.ws + WS_PROJ);
    const float* ROPE = (const float*)(F.ws + WS_ROPE);
    const int sub = F.lane >> 4, l16 = F.lane & 15, d = 4 * l16;
    const f32x4 gq = *(const f32x4*)(F.ka->in[IN_AQG] + layer * 64 + d), gk = *(const f32x4*)(F.ka->in[IN_AKG] + layer * 64 + d);
    const bool x2 = (l16 & 4) != 0;
    for (int rg = gw; rg < NROWS / 4; rg += NGW) {
        const int row0 = 4 * rg; const bool lat = row0 < NLAT;
        u32x2 w[4][3]; f32x4 cs0[4], cs1[4];
#pragma unroll
        for (int q = 0; q < 4; ++q) { const bf16_t* pr = PROJ + (size_t)(row0 + q) * PP; const int t = (row0 + q) & (SEQ - 1);
            cs0[q] = (f32x4){1.f, 0.f, 1.f, 0.f}; cs1[q] = cs0[q];
            if (lat) { const int idx = (d >> 5) ? 128 + (t & 63) : (t >> 6); const float* rp = ROPE + ((size_t)idx * 16 + (d & 15)) * 2; cs0[q] = *(const f32x4*)rp; cs1[q] = *(const f32x4*)(rp + 4); }
#pragma unroll
            for (int pass = 0; pass < 3; ++pass) { const int col = pass == 0 ? PC_AQ + 64 * sub + d : (pass == 1 ? (sub < 2 ? PC_AK + 64 * sub + d : PC_BK + 64 * (sub - 2) + d) : PC_BQ + 64 * sub + d);
                w[q][pass] = *(const u32x2*)(pr + col); } }
#pragma unroll
        for (int q = 0; q < 4; ++q) { bf16_t* pr = PROJ + (size_t)(row0 + q) * PP;
            const float cz[4] = {cs0[q][0], cs0[q][2], cs1[q][0], cs1[q][2]}, sz[4] = {cs0[q][1], cs0[q][3], cs1[q][1], cs1[q][3]};
#pragma unroll
            for (int pass = 0; pass < 3; ++pass) {
                const int col = pass == 0 ? PC_AQ + 64 * sub + d : (pass == 1 ? (sub < 2 ? PC_AK + 64 * sub + d : PC_BK + 64 * (sub - 2) + d) : PC_BQ + 64 * sub + d);
                const bool donorm = pass == 0 || (pass == 1 && sub < 2);
                const bool active = lat || donorm;
                if (!lat && pass == 2) continue;
                float v[4] = {bflo(w[q][pass].x), bfhi(w[q][pass].x), bflo(w[q][pass].y), bfhi(w[q][pass].y)};
                float ss = (v[0] * v[0] + v[1] * v[1]) + (v[2] * v[2] + v[3] * v[3]);
                ss += shfl_x(ss, 1, F.lane); ss += shfl_x(ss, 2, F.lane); ss += shfl_x(ss, 4, F.lane); ss += shfl_x(ss, 8, F.lane);
                if (donorm) { const float rstd = rsqrtf(ss * (1.f / 64.f) + EPS) * (pass == 0 ? QSCALE2 : 1.f); const f32x4 g = pass == 0 ? gq : gk;
#pragma unroll
                    for (int e = 0; e < 4; ++e) v[e] = v[e] * rstd * g[e]; }
                float o[4];
#pragma unroll
                for (int e = 0; e < 4; ++e) { const float p = shfl_x(v[e], 4, F.lane); o[e] = x2 ? (p * sz[e] + v[e] * cz[e]) : (v[e] * cz[e] - p * sz[e]); }
                if (active) { u32x2 ow; ow.x = cvtpk(o[0], o[1]); ow.y = cvtpk(o[2], o[3]); *(u32x2*)(pr + col) = ow; }
            } }
    }
}

template <bool WT = false>
__device__ __forceinline__ void groupnorm_rows(Frame& F, int layer, int row0, int nrows, int wv, int nw) {
    const bf16_t* H = (const bf16_t*)(F.ws + WS_H); bf16_t* YN = (bf16_t*)(F.ws + WS_PROJ);
    const float* gg = F.ka->in[IN_GGRP] + layer * 1024;
    f32x4 gv[4];
#pragma unroll
    for (int j = 0; j < 4; ++j) gv[j] = *(const f32x4*)(gg + 4 * F.lane + 256 * j);
    for (int r = 4 * wv; r < nrows; r += 4 * nw) {
        u32x2 w[4][4]; float ss[4][4];
#pragma unroll
        for (int q = 0; q < 4; ++q)
#pragma unroll
            for (int j = 0; j < 4; ++j) w[q][j] = *(const u32x2*)(H + (size_t)(row0 + r + q) * DM + 4 * F.lane + 256 * j);
#pragma unroll
        for (int q = 0; q < 4; ++q)
#pragma unroll
            for (int j = 0; j < 4; ++j) { const float v0 = bflo(w[q][j].x), v1 = bfhi(w[q][j].x), v2 = bflo(w[q][j].y), v3 = bfhi(w[q][j].y); ss[q][j] = (v0 * v0 + v1 * v1) + (v2 * v2 + v3 * v3); }
#pragma unroll
        for (int o = 1; o < 64; o <<= 1)
#pragma unroll
            for (int q = 0; q < 4; ++q)
#pragma unroll
                for (int j = 0; j < 4; ++j) ss[q][j] += shfl_x(ss[q][j], o, F.lane);
#pragma unroll
        for (int q = 0; q < 4; ++q)
#pragma unroll
            for (int j = 0; j < 4; ++j) { const float rstd = rsqrtf(ss[q][j] * (1.f / 256.f) + EPS);
                u32x2 o; o.x = cvtpk(bflo(w[q][j].x) * rstd * gv[j][0], bfhi(w[q][j].x) * rstd * gv[j][1]); o.y = cvtpk(bflo(w[q][j].y) * rstd * gv[j][2], bfhi(w[q][j].y) * rstd * gv[j][3]);
                if (WT) __hip_atomic_store((unsigned long long*)(YN + (size_t)(row0 + r + q) * DM + 4 * F.lane + 256 * j), (unsigned long long)o.x | ((unsigned long long)o.y << 32), __ATOMIC_RELAXED, __HIP_MEMORY_SCOPE_AGENT);
                else *(u32x2*)(YN + (size_t)(row0 + r + q) * DM + 4 * F.lane + 256 * j) = o; }
    }
}

__device__ __forceinline__ void fixup_hts(Frame& F, int layer, int ht0, int nht) {
    const float* edge = (const float*)(F.ws + WS_EDGE);
    const float* cw = F.ka->in[IN_CONVW] + (size_t)layer * 3 * DFF2; const float* cb = F.ka->in[IN_CONVB] + (size_t)layer * DFF2;
    bf16_t* act = (bf16_t*)(F.ws + WS_PROJ);
    const int per_row = DFF / 4;
    for (int it = F.tid; it < nht * 2 * per_row; it += NTHREADS) {
        const int ch = (it % per_row) * 4, rr = it / per_row, ht = ht0 + (rr >> 1), last = rr & 1;
        const bool seq_start = (ht == 0 || ht == 64 || ht == 128 || ht == 130), seq_end = (ht == 63 || ht == 127 || ht == 129 || ht == 131);
        const int row = ht * 128 + (last ? 127 : 0);
        f32x4 o;
        f32x4 res[2];
#pragma unroll
        for (int gvv = 0; gvv < 2; ++gvv) { const int uc = gvv * DFF + ch;
            const f32x4 z = {0.f, 0.f, 0.f, 0.f};
            f32x4 up, ucur, un;
            if (!last) { up = seq_start ? z : *(const f32x4*)(edge + ((size_t)(ht - 1) * 4 + 3) * DFF2 + uc); ucur = *(const f32x4*)(edge + ((size_t)ht * 4 + 0) * DFF2 + uc); un = *(const f32x4*)(edge + ((size_t)ht * 4 + 1) * DFF2 + uc); }
            else { up = *(const f32x4*)(edge + ((size_t)ht * 4 + 2) * DFF2 + uc); ucur = *(const f32x4*)(edge + ((size_t)ht * 4 + 3) * DFF2 + uc); un = seq_end ? z : *(const f32x4*)(edge + ((size_t)(ht + 1) * 4 + 0) * DFF2 + uc); }
            res[gvv] = *(const f32x4*)(cw + uc) * up + *(const f32x4*)(cw + DFF2 + uc) * ucur + *(const f32x4*)(cw + 2 * DFF2 + uc) * un + *(const f32x4*)(cb + uc); }
#pragma unroll
        for (int j = 0; j < 4; ++j) o[j] = res[0][j] / (1.f + __expf(-res[0][j])) * res[1][j];
        u32x2 w; w.x = cvtpk(o[0], o[1]); w.y = cvtpk(o[2], o[3]);
        *(u32x2*)(act + (size_t)row * DFF + ch) = w;
    }
}

template <int KDIM>
__device__ __forceinline__ void skinny_ctx(Frame& F, const bf16_t* A  , const bf16_t* Wt  , const float* xin, float* xout, const float* gate  ,
                                           bf16_t* xg  , const float* gn, const float* scn  , float* ssqc) {
    const int lane = F.lane, fr = lane & 15, fq = lane >> 4, t = F.tid, ldrow = t >> 3, chunk = t & 7;
    const int rf = F.wave >> 1, cp = F.wave & 1;
    constexpr int RSB = 144, BUFB = 64 * RSB, NKB = KDIM / 64;
    for (int p = F.bid; p < 128; p += F.G) {
        const int rg = p >> 4, cg = p & 15;
        if (KDIM == DM) { groupnorm_rows<false>(F, 0, NLAT + 64 * rg, 64, F.wave, NWAVES); VM_WAIT(); __syncthreads(); }
        const bf16_t* asrc = A + (size_t)(64 * rg + ldrow) * KDIM + 8 * chunk; const bf16_t* bsrc = Wt + (size_t)(64 * cg + ldrow) * KDIM + 8 * chunk;
        u32x4 ra[4], rb[4];
#pragma unroll
        for (int i = 0; i < 4; ++i) { ra[i] = *(const u32x4*)(asrc + 64 * i); rb[i] = *(const u32x4*)(bsrc + 64 * i); }
        f32x4 acc[2] = {{0.f, 0.f, 0.f, 0.f}, {0.f, 0.f, 0.f, 0.f}};
        __syncthreads();
        for (int kb0 = 0; kb0 < NKB; kb0 += 4) {
#pragma unroll
            for (int i = 0; i < 4; ++i) { const int kb = kb0 + i; LAS unsigned char* ba = F.lds + (kb & 1) * 2 * BUFB; LAS unsigned char* bb = ba + BUFB;
                *(LAS u32x4*)(ba + ldrow * RSB + 16 * chunk) = ra[i]; *(LAS u32x4*)(bb + ldrow * RSB + 16 * chunk) = rb[i];
                if (kb + 4 < NKB) { ra[i] = *(const u32x4*)(asrc + 64 * (kb + 4)); rb[i] = *(const u32x4*)(bsrc + 64 * (kb + 4)); }
                __syncthreads();
#pragma unroll
                for (int ks = 0; ks < 2; ++ks) { const bf16x8 af = *(const LAS bf16x8*)(ba + (16 * rf + fr) * RSB + 64 * ks + 16 * fq);
#pragma unroll
                    for (int j = 0; j < 2; ++j) { const bf16x8 bf = *(const LAS bf16x8*)(bb + (32 * cp + 16 * j + fr) * RSB + 64 * ks + 16 * fq); acc[j] = __builtin_amdgcn_mfma_f32_16x16x32_bf16(af, bf, acc[j], 0, 0, 0); } }
            }
        }
        float ss[4] = {0.f, 0.f, 0.f, 0.f};
#pragma unroll
        for (int j = 0; j < 2; ++j) { const int n = 64 * cg + 32 * cp + 16 * j + fr; const float g = gate[n], gs = gn[n] * (1.f + scn[n]);
#pragma unroll
            for (int r = 0; r < 4; ++r) { const int row = 64 * rg + 16 * rf + 4 * fq + r; const float o = xin[(size_t)row * DM + n] + g * acc[j][r];
                xout[(size_t)row * DM + n] = o; xg[(size_t)row * DM + n] = (bf16_t)(cvtpk(o * gs, 0.f) & 0xffffu); ss[r] += o * o; } }
#pragma unroll
        for (int r = 0; r < 4; ++r) { float s = ss[r]; s += shfl_x(s, 1, lane); s += shfl_x(s, 2, lane); s += shfl_x(s, 4, lane); s += shfl_x(s, 8, lane);
            if (fr == 0) { float* sp = ssqc + (size_t)(64 * rg + 16 * rf + 4 * fq + r) * 64 + cg * 2 + cp; sp[0] = s; sp[32] = 0.f; } }
        __syncthreads();
    }
}

__device__ __forceinline__ void final_phase(Frame& F) {
    const int gw = F.bid * NWAVES + F.wave, NGW = F.G * NWAVES;
    const float* gf = F.ka->in[IN_GFIN];
    f32x4 gv[4];
#pragma unroll
    for (int j = 0; j < 4; ++j) gv[j] = *(const f32x4*)(gf + 4 * F.lane + 256 * j);
    for (int rg = gw; rg < NLAT / 8; rg += NGW) {
        float* xr = F.out + (size_t)rg * 8 * DM + 4 * F.lane;
        f32x4 v[8][4]; float ss[8];
#pragma unroll
        for (int r = 0; r < 8; ++r)
#pragma unroll
            for (int j = 0; j < 4; ++j) v[r][j] = *(const f32x4*)(xr + (size_t)r * DM + 256 * j);
#pragma unroll
        for (int r = 0; r < 8; ++r) { float s = 0.f;
#pragma unroll
            for (int j = 0; j < 4; ++j) s += (v[r][j][0] * v[r][j][0] + v[r][j][1] * v[r][j][1]) + (v[r][j][2] * v[r][j][2] + v[r][j][3] * v[r][j][3]);
            ss[r] = s; }
#pragma unroll
        for (int o = 1; o < 64; o <<= 1)
#pragma unroll
            for (int r = 0; r < 8; ++r) ss[r] += shfl_x(ss[r], o, F.lane);
#pragma unroll
        for (int r = 0; r < 8; ++r) { const float rstd = rsqrtf(ss[r] * (1.f / DM) + EPS);
#pragma unroll
            for (int j = 0; j < 4; ++j) *(f32x4*)(xr + (size_t)r * DM + 256 * j) = v[r][j] * rstd * gv[j]; }
    }
}

typedef GAS unsigned gu32;
#define RLX_AGENT __ATOMIC_RELAXED, __HIP_MEMORY_SCOPE_AGENT
constexpr int CW_BAR = 4096;
#define XB_TMO      128
#define XB_XCNT(j)  (256  + 64 * (j))
#define XB_XSUB(j)  (1280 + 64 * (j))
#define XB_XGEN(j)  (2304 + 64 * (j))
#define XB_TOP      3328
#define XB_TOPGEN   3392
#define XCD_BAR_WORDS 3456
#define XB_SPIN_CAP (1u << 18)

__device__ __forceinline__ unsigned xb_ld(unsigned* p)              { return __hip_atomic_load(p, __ATOMIC_RELAXED, __HIP_MEMORY_SCOPE_AGENT); }
__device__ __forceinline__ unsigned xb_add(unsigned* p, unsigned v) { return __hip_atomic_fetch_add(p, v, __ATOMIC_RELAXED, __HIP_MEMORY_SCOPE_AGENT); }
__device__ __forceinline__ unsigned xb_xcc_id() { return (unsigned)__builtin_amdgcn_s_getreg((3 << 11) | 20) & 0xFu; }
#define XB_SPIN(cond, bar) do { unsigned _sp = 0; while (cond) { __builtin_amdgcn_s_sleep(1); \
    if ((++_sp & 255u) == 0u) { if (xb_ld(&(bar)[XB_TMO])) break; if (_sp > XB_SPIN_CAP) { atomicAdd(&(bar)[XB_TMO], 1u); break; } } } } while (0)

struct XcdBarrier {
    unsigned* bar; unsigned x;
    volatile LAS unsigned* st;
};

__device__ __forceinline__ XcdBarrier xcd_barrier_post(unsigned* bar, volatile LAS unsigned* st, bool is_t0) {
    XcdBarrier b; b.bar = bar; b.x = xb_xcc_id(); b.st = st;
    if (is_t0) (void)xb_add(&bar[XB_XCNT(b.x)], 1u);
    return b;
}
__device__ __forceinline__ void xcd_barrier_complete(unsigned* bar, unsigned x, unsigned& nloc, unsigned& nx) {
    const unsigned G = gridDim.x * gridDim.y * gridDim.z;
    unsigned sum, cnt, mine, sp = 0u;
    for (;;) {
        sum = 0u; cnt = 0u; mine = 0u;
#pragma unroll
        for (unsigned j = 0; j < 16; ++j) { const unsigned c = xb_ld(&bar[XB_XCNT(j)]); sum += c; cnt += (c > 0u) ? 1u : 0u; mine = (j == x) ? c : mine; }
        if (sum == G) break;
        __builtin_amdgcn_s_sleep(1);
        if ((++sp & 255u) == 0u) { if (xb_ld(&bar[XB_TMO])) break; if (sp > XB_SPIN_CAP) { atomicAdd(&bar[XB_TMO], 1u); break; } }
    }
    nloc = mine > 0u ? mine : 1u; nx = cnt > 0u ? cnt : 1u;
}

__device__ __forceinline__ void xcd_barrier(const XcdBarrier& b, bool is_t0) {
    asm volatile("s_waitcnt vmcnt(0)" ::: "memory");
    __syncthreads();
    if (is_t0) {
        unsigned* bar = b.bar;
        __builtin_amdgcn_s_waitcnt(0);
        unsigned nloc = b.st[0], nx = b.st[1];
        if (nloc == 0u) { xcd_barrier_complete(bar, b.x, nloc, nx); b.st[0] = nloc; b.st[1] = nx; }
        const unsigned old = xb_add(&bar[XB_XSUB(b.x)], 1u);
        const unsigned gen = old / nloc;
        if (old + 1u == (gen + 1u) * nloc) {
            __builtin_amdgcn_fence(__ATOMIC_RELEASE, "agent");
            asm volatile("s_waitcnt vmcnt(0)" ::: "memory");
            const unsigned og = xb_add(&bar[XB_TOP], 1u);
            const unsigned tg = og / nx;
            if (og + 1u == (tg + 1u) * nx) xb_add(&bar[XB_TOPGEN], 1u);
            else XB_SPIN(xb_ld(&bar[XB_TOPGEN]) == tg, bar);
            __builtin_amdgcn_fence(__ATOMIC_ACQUIRE, "agent");
            xb_add(&bar[XB_XGEN(b.x)], 1u);
            asm volatile("s_waitcnt vmcnt(0)" ::: "memory");
        } else {
            XB_SPIN(xb_ld(&bar[XB_XGEN(b.x)]) == gen, bar);
            __builtin_amdgcn_fence(__ATOMIC_ACQUIRE, "agent");
            asm volatile("s_waitcnt vmcnt(0)" ::: "memory");
        }
    }
    __syncthreads();
}

namespace att {
constexpr int SLOTB = 8192;
constexpr int L_K = 0, L_V = 2 * SLOTB, L_WS = 4 * SLOTB, L_OST = L_WS + 8 * 256, L_RPB = L_OST + 8 * 4096, L_END = L_RPB + 2048;
constexpr float THR = 8.0f;
__device__ __forceinline__ int crow(int r, int hi) { return (r & 3) + 8 * (r >> 2) + 4 * hi; }
__device__ __forceinline__ s16x4 vtr(const LAS unsigned char* p) { return __builtin_bit_cast(s16x4, __builtin_amdgcn_ds_read_tr16_b64_v4i16((LAS v4i16_t*)p)); }
__device__ __forceinline__ float rowmax32(const f32x16& p0, const f32x16& p1) {
    float a = fmaxf(p0[0], p1[0]);
#pragma unroll
    for (int r = 1; r < 16; ++r) a = fmaxf(a, fmaxf(p0[r], p1[r]));
    auto rr = __builtin_amdgcn_permlane32_swap(__float_as_uint(a), __float_as_uint(a), false, false);
    return fmaxf(__uint_as_float(rr[0]), __uint_as_float(rr[1]));
}
__device__ __forceinline__ float halfsum(float v) {
    auto rr = __builtin_amdgcn_permlane32_swap(__float_as_uint(v), __float_as_uint(v), false, false);
    return __uint_as_float(rr[0]) + __uint_as_float(rr[1]);
}
#define ATT_WAIT_BAR() asm volatile("s_waitcnt vmcnt(0) lgkmcnt(0)\n\ts_barrier" ::: "memory")

template <int MODE>
__device__ __forceinline__ void attn_unit(Frame& F, int b, int h, int qb, int qcol, int kcol, int vcol, int ycol, float sink2, const float* rpb) {
    LAS unsigned char* lds = F.lds;
    const int lane = F.lane, r32 = lane & 31, hi = lane >> 5, wid = F.wave;
    const bf16_t* PROJ = (const bf16_t*)(F.ws + WS_PROJ); bf16_t* Y = (bf16_t*)(F.ws + WS_H);
    const int ctxrow = NLAT + CTXL * b, latrow = SEQ * b;
    const int qrow0 = (MODE == 3) ? ctxrow : latrow + 256 * qb;
    const int qw0 = 256 * qb + 32 * wid;
    int lt_lo = 0, nloc = 0;
    if (MODE == 0) { lt_lo = 0; nloc = 128; }
    if (MODE == 1) { const int a = (256 * qb - 128) >> 6, e = (256 * qb + 255 + 128) >> 6; lt_lo = a < 0 ? 0 : a; nloc = (e > 127 ? 127 : e) - lt_lo + 1; }
    if (MODE == 2) { const int a = 4 * qb - 4, e0 = 4 * qb - 1; lt_lo = a < 0 ? 0 : (a > 120 ? 120 : a); const int e = (e0 < 0 ? 0 : (e0 > 120 ? 120 : e0)) + 7; nloc = e - lt_lo + 1; }
    const int NT = 4 + nloc;
    const int rw = 4 * qb + (wid >> 1); const int rs = rw - 4 < 0 ? 0 : (rw - 4 > 120 ? 120 : rw - 4);
    const int qc = 32 * (wid & 1) + r32; const int cs = qc - 8 < 0 ? 0 : (qc - 8 > 48 ? 48 : qc - 8);
    LAS float* wsf = (LAS float*)(lds + L_WS) + wid * 64;
    LAS float* rpbL = (LAS float*)(lds + L_RPB);
    if (MODE == 2) { for (int i = F.tid; i < 465; i += NTHREADS) rpbL[i] = rpb[i] * LOG2E; }
    const int vp0 = ((lane >> 4) & 1) * 32 + (lane & 3) * 8 + (4 * hi + ((lane & 15) >> 2)) * 64;
#define ATT_KROW(t) ((t) < 4 ? ctxrow + 64 * (t) : latrow + 64 * (lt_lo + (t) - 4))
#define ATT_DMA(t, slot) do { const int kr_ = ATT_KROW(t); \
        __builtin_amdgcn_global_load_lds((const unsigned*)(PROJ + (size_t)(kr_ + lane) * PP + kcol + wid * 8), (LAS unsigned*)(lds + L_K + (slot) * SLOTB + wid * 1024), 16, 0, 0); \
        __builtin_amdgcn_global_load_lds((const unsigned*)(PROJ + (size_t)(kr_ + 16 * (wid & 3) + (lane >> 2)) * PP + vcol + (wid >> 2) * 32 + (lane & 3) * 8), (LAS unsigned*)(lds + L_V + (slot) * SLOTB + wid * 1024), 16, 0, 0); } while (0)
    ATT_DMA(0, 0);
    bf16x8 qr[4];
#pragma unroll
    for (int d0 = 0; d0 < 4; ++d0) qr[d0] = *(const bf16x8*)(PROJ + (size_t)(qrow0 + 32 * wid + r32) * PP + qcol + d0 * 16 + hi * 8);
    float mhat = 0.f, l = 0.f; f32x16 o0 = {}, o1 = {}, negm = {};
    ATT_WAIT_BAR();
    for (int t = 0; t < NT; ++t) {
        const int slot = t & 1;
        if (t + 1 < NT) ATT_DMA(t + 1, slot ^ 1);
        bool rel = true; int kb0 = 0;
        if (MODE == 1 && t >= 4) { kb0 = 64 * (lt_lo + t - 4); rel = (kb0 + 63 >= qw0 - 128) && (kb0 <= qw0 + 31 + 128); }
        if (MODE == 2 && t >= 4) { kb0 = lt_lo + t - 4; rel = (kb0 >= rs) && (kb0 < rs + 8); }
        if (rel) {
            const LAS unsigned char* kb = lds + L_K + slot * SLOTB + hi * 1024 + r32 * 16;
            f32x16 p0 = negm, p1 = negm;
#pragma unroll
            for (int d0 = 0; d0 < 4; ++d0) {
                const bf16x8 b0 = *(const LAS bf16x8*)(kb + d0 * 2048), b1 = *(const LAS bf16x8*)(kb + d0 * 2048 + 512);
                p0 = __builtin_amdgcn_mfma_f32_32x32x16_bf16(b0, qr[d0], p0, 0, 0, 0);
                p1 = __builtin_amdgcn_mfma_f32_32x32x16_bf16(b1, qr[d0], p1, 0, 0, 0);
            }
            if (MODE == 1 && t >= 4) {
                const int dq = kb0 - (qw0 + r32);
#pragma unroll
                for (int r = 0; r < 16; ++r) { const int kc = crow(r, hi); const int d0_ = dq + kc, d1_ = d0_ + 32;
                    if (d0_ > 128 || d0_ < -128) p0[r] = -INFINITY; if (d1_ > 128 || d1_ < -128) p1[r] = -INFINITY; }
            }
            if (MODE == 2 && t >= 4) {
                const LAS float* bt = rpbL + (kb0 - rw + 7) * 31 + (15 - qc);
#pragma unroll
                for (int r = 0; r < 16; ++r) { const int kc = crow(r, hi);
                    const bool v0 = (kc >= cs) && (kc < cs + 16), v1 = (kc + 32 >= cs) && (kc + 32 < cs + 16);
                    p0[r] = v0 ? p0[r] + bt[v0 ? kc : qc] : -INFINITY; p1[r] = v1 ? p1[r] + bt[v1 ? kc + 32 : qc] : -INFINITY; }
            }
            const float rm = rowmax32(p0, p1);
            if (t == 0 || __any(rm > THR)) {
                const float dl = (t == 0) ? rm : fmaxf(rm, 0.f);
                mhat += dl;
#pragma unroll
                for (int r = 0; r < 16; ++r) { p0[r] -= dl; p1[r] -= dl; negm[r] = -mhat; }
                if (t > 0) { const float f = __builtin_amdgcn_exp2f(-dl); l *= f; if (hi == 0) wsf[r32] = f; LDS_WAIT();
#pragma unroll
                    for (int r = 0; r < 16; ++r) { const float fr_ = wsf[crow(r, hi)]; o0[r] *= fr_; o1[r] *= fr_; }
                    LDS_WAIT(); }
            }
            float ls = 0.f;
#pragma unroll
            for (int r = 0; r < 16; ++r) { p0[r] = __builtin_amdgcn_exp2f(p0[r]); p1[r] = __builtin_amdgcn_exp2f(p1[r]); ls += p0[r] + p1[r]; }
            l += ls;
            u32x4 pw[4];
#pragma unroll
            for (int k = 0; k < 4; ++k) { pw[0][k] = cvtpk(p0[2 * k], p0[2 * k + 1]); pw[1][k] = cvtpk(p0[8 + 2 * k], p0[9 + 2 * k]); pw[2][k] = cvtpk(p1[2 * k], p1[2 * k + 1]); pw[3][k] = cvtpk(p1[8 + 2 * k], p1[9 + 2 * k]); }
            const LAS unsigned char* vb = lds + L_V + slot * SLOTB + vp0;
#pragma unroll
            for (int ks = 0; ks < 4; ++ks) {
                const s16x4 a0 = vtr(vb + ks * 1024), a1 = vtr(vb + ks * 1024 + 512), c0 = vtr(vb + 4096 + ks * 1024), c1 = vtr(vb + 4096 + ks * 1024 + 512);
                const bf16x8 v0 = {a0[0], a0[1], a0[2], a0[3], a1[0], a1[1], a1[2], a1[3]}, v1 = {c0[0], c0[1], c0[2], c0[3], c1[0], c1[1], c1[2], c1[3]};
                o0 = __builtin_amdgcn_mfma_f32_32x32x16_bf16(__builtin_bit_cast(bf16x8, pw[ks]), v0, o0, 0, 0, 0);
                o1 = __builtin_amdgcn_mfma_f32_32x32x16_bf16(__builtin_bit_cast(bf16x8, pw[ks]), v1, o1, 0, 0, 0);
            }
        }
        ATT_WAIT_BAR();
    }
    l = halfsum(l);
    if (MODE == 1 || MODE == 3) l += __builtin_amdgcn_exp2f(sink2 - mhat);
    if (hi == 0) wsf[32 + r32] = l;
    LDS_WAIT();
    bf16_t* stg = (bf16_t*)(lds + L_OST + wid * 4096);
    LAS bf16_t* stgl = (LAS bf16_t*)(lds + L_OST + wid * 4096);
#pragma unroll
    for (int r = 0; r < 16; ++r) { const int orow = crow(r, hi); const float rl = __builtin_amdgcn_rcpf(wsf[32 + orow]);
        stgl[orow * 64 + r32] = (bf16_t)(cvtpk(o0[r] * rl, 0.f) & 0xffffu); stgl[orow * 64 + 32 + r32] = (bf16_t)(cvtpk(o1[r] * rl, 0.f) & 0xffffu); }
    LDS_WAIT();
    (void)stg;
#pragma unroll
    for (int i = 0; i < 4; ++i) { const int row = i * 8 + (lane >> 3), ch = lane & 7; const u32x4 v = *(const LAS u32x4*)(stgl + row * 64 + ch * 8);
        *(u32x4*)(Y + (size_t)(qrow0 + 32 * wid + row) * DM + ycol + ch * 8) = v; }
    LDS_WAIT();
#undef ATT_KROW
#undef ATT_DMA
}
}

namespace ml {
__device__ __forceinline__ float scan_add(float v, int lane, int dir) {
#pragma unroll
    for (int o = 1; o < 64; o <<= 1) { const float t = shfl_idx(v, (dir ? lane + o : lane - o) & 63); const bool ok = dir ? (lane + o < 64) : (lane >= o); v += ok ? t : 0.f; }
    return v;
}
__device__ __forceinline__ float scan_max(float v, int lane, int dir) {
#pragma unroll
    for (int o = 1; o < 64; o <<= 1) { const float t = shfl_idx(v, (dir ? lane + o : lane - o) & 63); const bool ok = dir ? (lane + o < 64) : (lane >= o); v = ok ? fmaxf(v, t) : v; }
    return v;
}
__device__ __forceinline__ float logsigmoid(float x) { return fminf(x, 0.f) - log1pf(__expf(-fabsf(x))); }
__device__ __forceinline__ int img_off(int tok, int d) { return (d >> 5) * 4096 + (tok >> 4) * 1024 + (tok & 15) * 64 + (d & 31) * 2; }
__device__ __forceinline__ int blk_row0(int b, int blk) { return blk < 4 ? NLAT + CTXL * b + 64 * blk : SEQ * b + 64 * (blk - 4); }
__device__ __forceinline__ int chunk_of(int dir, int blk) { return dir == 0 ? blk : (blk < 4 ? 3 - blk : 4 + 127 - (blk - 4)); }

__device__ __forceinline__ void pass1(Frame& F, int layer) {
    const int gw = F.bid * NWAVES + F.wave, NGW = F.G * NWAVES, lane = F.lane, r32 = lane & 31, hi = lane >> 5;
    LAS unsigned char* wl = F.lds + F.wave * 16384;
    const bf16_t* PROJ = (const bf16_t*)(F.ws + WS_PROJ); const float* GATES = (const float*)(F.ws + WS_GATES);
    const float* gb = F.ka->in[IN_CGB] + layer * 16;
    float* DS = (float*)(F.ws + WS_DS); float* ZD = (float*)(F.ws + WS_ZD); float* GC = (float*)(F.ws + WS_GC); float* ML = (float*)(F.ws + WS_ML);
    const int vp0 = ((lane >> 4) & 1) * 32 + (lane & 3) * 8 + (4 * hi + ((lane & 15) >> 2)) * 64;
    for (int wu = gw; wu < NCHAIN * NCHUNK; wu += NGW) {
        const int chain = wu / NCHUNK, c = wu % NCHUNK, dir = chain & 1, h = (chain >> 1) & 3, b = chain >> 3;
        const int row0 = blk_row0(b, chunk_of(dir, c));
        const float gi = GATES[(size_t)(row0 + lane) * 16 + dir * 8 + h] + gb[dir * 8 + h];
        const float lf = logsigmoid(GATES[(size_t)(row0 + lane) * 16 + dir * 8 + 4 + h] + gb[dir * 8 + 4 + h]);
        const float cum = scan_add(lf, lane, dir);
        const float G = wave_sum(lf, lane);
        const float bb = gi - cum, mloc = wave_max(bb, lane), w = __expf(bb - mloc);
#pragma unroll
        for (int it = 0; it < 8; ++it) { const int tok = (lane >> 3) + 8 * it, d = 8 * (lane & 7);
            const u32x4 kv = *(const u32x4*)(PROJ + (size_t)(row0 + tok) * PP + PC_CK + 64 * h + d), vv = *(const u32x4*)(PROJ + (size_t)(row0 + tok) * PP + PC_CV + 64 * h + d);
            const float wt = shfl_idx(w, tok);
            u32x4 ko; ko.x = cvtpk(bflo(kv.x) * wt, bfhi(kv.x) * wt); ko.y = cvtpk(bflo(kv.y) * wt, bfhi(kv.y) * wt); ko.z = cvtpk(bflo(kv.z) * wt, bfhi(kv.z) * wt); ko.w = cvtpk(bflo(kv.w) * wt, bfhi(kv.w) * wt);
            *(LAS u32x4*)(wl + img_off(tok, d)) = vv; *(LAS u32x4*)(wl + 8192 + img_off(tok, d)) = ko; }
        LDS_WAIT();
        f32x16 acc[2][2] = {};
#pragma unroll
        for (int s = 0; s < 4; ++s) {
            bf16x8 af[2], bfr[2];
#pragma unroll
            for (int x = 0; x < 2; ++x) { const s16x4 a0 = att::vtr(wl + vp0 + x * 4096 + s * 1024), a1 = att::vtr(wl + vp0 + x * 4096 + s * 1024 + 512);
                const s16x4 c0 = att::vtr(wl + 8192 + vp0 + x * 4096 + s * 1024), c1 = att::vtr(wl + 8192 + vp0 + x * 4096 + s * 1024 + 512);
                af[x] = (bf16x8){a0[0], a0[1], a0[2], a0[3], a1[0], a1[1], a1[2], a1[3]}; bfr[x] = (bf16x8){c0[0], c0[1], c0[2], c0[3], c1[0], c1[1], c1[2], c1[3]}; }
#pragma unroll
            for (int vb = 0; vb < 2; ++vb)
#pragma unroll
                for (int kb = 0; kb < 2; ++kb) acc[vb][kb] = __builtin_amdgcn_mfma_f32_32x32x16_bf16(af[vb], bfr[kb], acc[vb][kb], 0, 0, 0);
        }
        float* dsp = DS + (size_t)(chain * NCHUNK + c) * 4096;
#pragma unroll
        for (int vb = 0; vb < 2; ++vb)
#pragma unroll
            for (int kb = 0; kb < 2; ++kb)
#pragma unroll
                for (int r = 0; r < 16; ++r) dsp[(32 * vb + att::crow(r, hi)) * 64 + 32 * kb + r32] = acc[vb][kb][r];
        float z = 0.f;
#pragma unroll 8
        for (int tok = 0; tok < 64; ++tok) z += bf2f(*(const LAS bf16_t*)(wl + 8192 + img_off(tok, lane)));
        ZD[(size_t)(chain * NCHUNK + c) * 64 + lane] = z;
        if (lane == 0) { GC[chain * NCHUNK + c] = G; ML[chain * NCHUNK + c] = mloc; }
        LDS_WAIT();
    }
}

__device__ __forceinline__ void pass2(Frame& F) {
    const float* DS = (const float*)(F.ws + WS_DS); const float* ZD = (const float*)(F.ws + WS_ZD); const float* GC = (const float*)(F.ws + WS_GC); const float* ML = (const float*)(F.ws + WS_ML);
    bf16_t* SBF = (bf16_t*)(F.ws + WS_SBF); float* ZC = (float*)(F.ws + WS_ZC); float* MC = (float*)(F.ws + WS_MC);
    LAS float* cf = (LAS float*)F.lds;
    for (int it = F.bid; it < NCHAIN * 16; it += F.G) {
        const int chain = it >> 4, part = it & 15;
        __syncthreads();
        if (F.wave == 0) {
            const int ln = F.lane; const bool valid = ln < 44; float g[3], mlv[3];
#pragma unroll
            for (int j = 0; j < 3; ++j) { g[j] = valid ? GC[chain * NCHUNK + 3 * ln + j] : 0.f; mlv[j] = valid ? ML[chain * NCHUNK + 3 * ln + j] : -INFINITY; }
            const float tot = g[0] + g[1] + g[2]; const float excl = ml::scan_add(tot, ln, 0) - tot;
            const float pg[3] = {excl, excl + g[0], excl + g[0] + g[1]};
            const float a0 = mlv[0] - pg[0], a1 = mlv[1] - pg[1], a2 = mlv[2] - pg[2];
            const float inclm = ml::scan_max(fmaxf(a0, fmaxf(a1, a2)), ln, 0); float exclm = shfl_idx(inclm, (ln - 1) & 63); if (ln == 0) exclm = -INFINITY;
            const float em[3] = {exclm, fmaxf(exclm, a0), fmaxf(fmaxf(exclm, a0), a1)};
#pragma unroll
            for (int j = 0; j < 3; ++j) { const int c = 3 * ln + j; const float m = pg[j] + fmaxf(0.f, em[j]); const float mn = fmaxf(g[j] + m, g[j] + mlv[j]);
                if (valid) { cf[2 * c] = __expf(g[j] + m - mn); cf[2 * c + 1] = __expf(g[j] + mlv[j] - mn); if (part == 0) __hip_atomic_store(MC + chain * NCHUNK + c, m, __ATOMIC_RELAXED, __HIP_MEMORY_SCOPE_AGENT); } }
        }
        __syncthreads();
        if (F.tid < 128) {
            const int e = part * 256 + 2 * F.tid; const float* dp = DS + (size_t)chain * NCHUNK * 4096 + e; unsigned* sp = (unsigned*)(SBF + (size_t)chain * NCHUNK * 4096 + e);
            float s0 = 0.f, s1 = 0.f;
            for (int c0 = 0; c0 < NCHUNK; c0 += 44) { f32x2 d[44];
#pragma unroll
                for (int j = 0; j < 44; ++j) d[j] = *(const f32x2*)(dp + (size_t)(c0 + j) * 4096);
#pragma unroll
                for (int j = 0; j < 44; ++j) { __hip_atomic_store(sp + (size_t)(c0 + j) * 2048, cvtpk(s0, s1), __ATOMIC_RELAXED, __HIP_MEMORY_SCOPE_AGENT);
                    s0 = cf[2 * (c0 + j)] * s0 + cf[2 * (c0 + j) + 1] * d[j][0]; s1 = cf[2 * (c0 + j)] * s1 + cf[2 * (c0 + j) + 1] * d[j][1]; } }
        } else if (F.tid >= 256 && F.tid < 260) {
            const int e = part * 4 + (F.tid - 256); const float* dp = ZD + (size_t)chain * NCHUNK * 64 + e; float* zp = ZC + (size_t)chain * NCHUNK * 64 + e;
            float sz = 0.f;
            for (int c0 = 0; c0 < NCHUNK; c0 += 66) { float d[66];
#pragma unroll
                for (int j = 0; j < 66; ++j) d[j] = dp[(size_t)(c0 + j) * 64];
#pragma unroll
                for (int j = 0; j < 66; ++j) { __hip_atomic_store(zp + (size_t)(c0 + j) * 64, sz, __ATOMIC_RELAXED, __HIP_MEMORY_SCOPE_AGENT); sz = cf[2 * (c0 + j)] * sz + cf[2 * (c0 + j) + 1] * d[j]; } }
        }
    }
    __syncthreads();
}

__device__ __forceinline__ void pass3(Frame& F, int layer, int blk_lo) {
    const int gw = F.bid * NWAVES + F.wave, NGW = F.G * NWAVES, lane = F.lane, r32_ = lane & 31, hi_ = lane >> 5;
    LAS unsigned char* wl = F.lds + F.wave * 19456;
    LAS float* bvec = (LAS float*)(wl + 16384); LAS float* Apl = bvec + 128; LAS float* efl = bvec + 256; LAS float* fll = bvec + 384; LAS float* zl = bvec + 512; LAS float* rden = bvec + 640;
    LAS float* st = (LAS float*)(wl + 8192);
    const bf16_t* PROJ = (const bf16_t*)(F.ws + WS_PROJ); const float* GATES = (const float*)(F.ws + WS_GATES);
    const float* gb = F.ka->in[IN_CGB] + layer * 16;
    const bf16_t* SBF = (const bf16_t*)(F.ws + WS_SBF); const float* ZC = (const float*)(F.ws + WS_ZC); const float* MC = (const float*)(F.ws + WS_MC);
    bf16_t* Y = (bf16_t*)(F.ws + WS_H);
    const int vp0 = ((lane >> 4) & 1) * 32 + (lane & 3) * 8 + (4 * hi_ + ((lane & 15) >> 2)) * 64;
    const int nblk = NCHUNK - blk_lo;
    for (int wu2 = gw; wu2 < 16 * nblk; wu2 += NGW) {
        const int wu = wu2 >> 1, tbsel = wu2 & 1;
        const int bh = wu / nblk, blk = blk_lo + wu % nblk, b = bh >> 2, h = bh & 3;
        const int row0 = blk_row0(b, blk);
        LDS_WAIT();
#pragma unroll
        for (int it = 0; it < 8; ++it) { const int tok = (lane >> 3) + 8 * it, d = 8 * (lane & 7);
            *(LAS u32x4*)(wl + img_off(tok, d)) = *(const u32x4*)(PROJ + (size_t)(row0 + tok) * PP + PC_CV + 64 * h + d); }
#pragma unroll
        for (int dir = 0; dir < 2; ++dir) {
            const int c = chunk_of(dir, blk), chain = (b * 4 + h) * 2 + dir;
            const float gi = GATES[(size_t)(row0 + lane) * 16 + dir * 8 + h] + gb[dir * 8 + h];
            const float lf = logsigmoid(GATES[(size_t)(row0 + lane) * 16 + dir * 8 + 4 + h] + gb[dir * 8 + 4 + h]);
            const float cum = scan_add(lf, lane, dir);
            const float bb = gi - cum, pm = scan_max(bb, lane, dir), mc = MC[chain * NCHUNK + c];
            const float Apv = fmaxf(mc, pm);
            zl[dir * 64 + lane] = ZC[(size_t)(chain * NCHUNK + c) * 64 + lane];
            bvec[dir * 64 + lane] = bb; Apl[dir * 64 + lane] = Apv; efl[dir * 64 + lane] = __expf(mc - Apv); fll[dir * 64 + lane] = __expf(-(cum + Apv));
        }
        LDS_WAIT();
#pragma unroll 1
        for (int tb = tbsel; tb <= tbsel; ++tb) {
            int r32 = r32_, hi = hi_; asm volatile("" : "+v"(r32), "+v"(hi));
            const int t = 32 * tb + r32;
            bf16x8 qf[4];
#pragma unroll
            for (int d0 = 0; d0 < 4; ++d0) qf[d0] = *(const bf16x8*)(PROJ + (size_t)(row0 + t) * PP + PC_CQ + 64 * h + 16 * d0 + 8 * hi);
            f32x16 hs0 = {}, hs1 = {};
#pragma unroll 1
            for (int dir = 0; dir < 2; ++dir) {
                const int c = chunk_of(dir, blk), chain = (b * 4 + h) * 2 + dir;
                const bf16_t* Sp = SBF + (size_t)(chain * NCHUNK + c) * 4096; const LAS float* zp = zl + dir * 64;
                int r32 = r32_, hi = hi_; asm volatile("" : "+v"(r32), "+v"(hi));
                const float Ap_t = Apl[dir * 64 + t], e_t = efl[dir * 64 + t], fl_t = fll[dir * 64 + t];
                f32x16 P0 = {}, P1 = {};
#pragma unroll
                for (int d0 = 0; d0 < 4; ++d0) {
                    const bf16x8 k0 = *(const bf16x8*)(PROJ + (size_t)(row0 + r32) * PP + PC_CK + 64 * h + 16 * d0 + 8 * hi), k1 = *(const bf16x8*)(PROJ + (size_t)(row0 + 32 + r32) * PP + PC_CK + 64 * h + 16 * d0 + 8 * hi);
                    P0 = __builtin_amdgcn_mfma_f32_32x32x16_bf16(k0, qf[d0], P0, 0, 0, 0); P1 = __builtin_amdgcn_mfma_f32_32x32x16_bf16(k1, qf[d0], P1, 0, 0, 0); }
                float den = 0.f;
#pragma unroll
                for (int r = 0; r < 16; ++r) { const int s0 = att::crow(r, hi), s1 = 32 + s0; const bool ok0 = dir ? (s0 >= t) : (s0 <= t), ok1 = dir ? (s1 >= t) : (s1 <= t);
                    const float w0 = ok0 ? __expf(bvec[dir * 64 + s0] - Ap_t) : 0.f, w1 = ok1 ? __expf(bvec[dir * 64 + s1] - Ap_t) : 0.f;
                    P0[r] *= w0; P1[r] *= w1; den += P0[r] + P1[r]; }
                u32x4 pw[4];
#pragma unroll
                for (int k = 0; k < 4; ++k) { pw[0][k] = cvtpk(P0[2 * k], P0[2 * k + 1]); pw[1][k] = cvtpk(P0[8 + 2 * k], P0[9 + 2 * k]); pw[2][k] = cvtpk(P1[2 * k], P1[2 * k + 1]); pw[3][k] = cvtpk(P1[8 + 2 * k], P1[9 + 2 * k]); }

                f32x16 n0 = {}, n1 = {}; float zq = 0.f;
#pragma unroll
                for (int d0 = 0; d0 < 4; ++d0) { const u32x4 qw = __builtin_bit_cast(u32x4, qf[d0]); u32x4 o;
                    const f32x4 za = *(const LAS f32x4*)(zp + 16 * d0 + 8 * hi), zb = *(const LAS f32x4*)(zp + 16 * d0 + 8 * hi + 4);
                    const float q0 = bflo(qw.x), q1 = bfhi(qw.x), q2 = bflo(qw.y), q3 = bfhi(qw.y), q4 = bflo(qw.z), q5 = bfhi(qw.z), q6 = bflo(qw.w), q7 = bfhi(qw.w);
                    zq += (q0 * za[0] + q1 * za[1]) + (q2 * za[2] + q3 * za[3]) + (q4 * zb[0] + q5 * zb[1]) + (q6 * zb[2] + q7 * zb[3]);
                    o.x = cvtpk(q0 * e_t, q1 * e_t); o.y = cvtpk(q2 * e_t, q3 * e_t); o.z = cvtpk(q4 * e_t, q5 * e_t); o.w = cvtpk(q6 * e_t, q7 * e_t);
                    const bf16x8 qs = __builtin_bit_cast(bf16x8, o);
                    const bf16x8 s0 = *(const bf16x8*)(Sp + (size_t)r32 * 64 + 16 * d0 + 8 * hi), s1 = *(const bf16x8*)(Sp + (size_t)(32 + r32) * 64 + 16 * d0 + 8 * hi);
                    n0 = __builtin_amdgcn_mfma_f32_32x32x16_bf16(qs, s0, n0, 0, 0, 0); n1 = __builtin_amdgcn_mfma_f32_32x32x16_bf16(qs, s1, n1, 0, 0, 0); }

                den = att::halfsum(den) + e_t * att::halfsum(zq);
                const float rd = 1.f / fmaxf(fabsf(den), fl_t);
                LDS_WAIT(); if (hi == 0) rden[r32] = rd; LDS_WAIT();
#pragma unroll
                for (int ks = 0; ks < 4; ++ks) {
                    const s16x4 a0 = att::vtr(wl + vp0 + ks * 1024), a1 = att::vtr(wl + vp0 + ks * 1024 + 512), c0 = att::vtr(wl + vp0 + 4096 + ks * 1024), c1 = att::vtr(wl + vp0 + 4096 + ks * 1024 + 512);
                    const bf16x8 v0 = {a0[0], a0[1], a0[2], a0[3], a1[0], a1[1], a1[2], a1[3]}, v1 = {c0[0], c0[1], c0[2], c0[3], c1[0], c1[1], c1[2], c1[3]};
                    n0 = __builtin_amdgcn_mfma_f32_32x32x16_bf16(__builtin_bit_cast(bf16x8, pw[ks]), v0, n0, 0, 0, 0);
                    n1 = __builtin_amdgcn_mfma_f32_32x32x16_bf16(__builtin_bit_cast(bf16x8, pw[ks]), v1, n1, 0, 0, 0); }
#pragma unroll
                for (int r = 0; r < 16; ++r) { const float rr = rden[att::crow(r, hi)]; hs0[r] += n0[r] * rr; hs1[r] += n1[r] * rr; }
            }
            LDS_WAIT();
#pragma unroll
            for (int r = 0; r < 16; ++r) { st[att::crow(r, hi) * 64 + r32] = hs0[r]; st[att::crow(r, hi) * 64 + 32 + r32] = hs1[r]; }
            LDS_WAIT();
#pragma unroll
            for (int it = 0; it < 4; ++it) { const int tk = (lane >> 3) + 8 * it, d = 8 * (lane & 7);
                const u32x4 ow = *(const u32x4*)(PROJ + (size_t)(row0 + 32 * tb + tk) * PP + PC_CO + 64 * h + d);
                const f32x4 ha = *(const LAS f32x4*)(st + tk * 64 + d), hb = *(const LAS f32x4*)(st + tk * 64 + d + 4);
                const float og[8] = {bflo(ow.x), bfhi(ow.x), bflo(ow.y), bfhi(ow.y), bflo(ow.z), bfhi(ow.z), bflo(ow.w), bfhi(ow.w)};
                float yv[8];
#pragma unroll
                for (int j = 0; j < 8; ++j) yv[j] = (j < 4 ? ha[j] : hb[j - 4]) / (1.f + __expf(-og[j]));
                u32x4 w; w.x = cvtpk(yv[0], yv[1]); w.y = cvtpk(yv[2], yv[3]); w.z = cvtpk(yv[4], yv[5]); w.w = cvtpk(yv[6], yv[7]);
                *(u32x4*)(Y + (size_t)(row0 + 32 * tb + tk) * DM + 512 + 64 * h + d) = w; }
            LDS_WAIT();
        }
    }
}
}

namespace attp {
typedef __attribute__((address_space(3))) const char* lds_cptr;
#define SBAR() __builtin_amdgcn_sched_barrier(0)
__device__ __forceinline__ int crow(int r,int hi){return (r&3)+8*(r>>2)+4*hi;}
constexpr int NSLOT=3, SLOTB=8192;
constexpr int NW=8, QBLK=32, KVBLK=64; constexpr int LDS_K=0, LDS_V=NSLOT*SLOTB, LDS_WS=2*NSLOT*SLOTB, LDS_OST=LDS_WS+NW*64*4, LDS_BYTES=LDS_OST+NW*4096;
__device__ __forceinline__ void glds16(const void*gsrc,unsigned lds_dst){unsigned keep;
  asm volatile("s_mov_b32 %0, m0\n\ts_mov_b32 m0, %2\n\ts_nop 0\n\tglobal_load_lds_dwordx4 %1, off\n\ts_mov_b32 m0, %0":"=&s"(keep):"v"(gsrc),"s"(lds_dst):"memory");}
__device__ __forceinline__ float max3f(float a,float b,float c){float r;asm("v_max3_f32 %0, %1, %2, %3":"=v"(r):"v"(a),"v"(b),"v"(c));return r;}
__device__ __forceinline__ float max2f(float a,float b){float r;asm("v_max_f32_e32 %0, %1, %2":"=v"(r):"v"(a),"v"(b));return r;}
__device__ __forceinline__ float fadd_s(float a,float b){float r;asm("v_add_f32_e32 %0, %1, %2":"=v"(r):"v"(a),"v"(b));return r;}
__device__ __forceinline__ float fsub_s(float a,float b){float r;asm("v_sub_f32_e32 %0, %1, %2":"=v"(r):"v"(a),"v"(b));return r;}
__device__ __forceinline__ unsigned cvtpk_s(float lo,float hi){return cvtpk(lo,hi);}
#define WAIT_BAR(N) asm volatile("s_waitcnt vmcnt(" #N ") lgkmcnt(0)\n\ts_barrier":::"memory")

template<bool ZC> __device__ __forceinline__ void qkt(f32x16&p0,f32x16&p1,lds_cptr Kslot,const bf16x8*qr,const f32x16&negm,int r32,int hi){
  lds_cptr kb=Kslot+hi*1024+r32*16;
  #pragma unroll
  for(int d0=0;d0<4;++d0){
    const bf16x8 b0=*(const __attribute__((address_space(3))) bf16x8*)(kb+d0*2048);
    const bf16x8 b1=*(const __attribute__((address_space(3))) bf16x8*)(kb+d0*2048+512);
    if(d0==0){ if(ZC){p0=__builtin_amdgcn_mfma_f32_32x32x16_bf16(b0,qr[0],(f32x16){},0,0,0);p1=__builtin_amdgcn_mfma_f32_32x32x16_bf16(b1,qr[0],(f32x16){},0,0,0);} else {p0=__builtin_amdgcn_mfma_f32_32x32x16_bf16(b0,qr[0],negm,0,0,0);p1=__builtin_amdgcn_mfma_f32_32x32x16_bf16(b1,qr[0],negm,0,0,0);} }
    else{p0=__builtin_amdgcn_mfma_f32_32x32x16_bf16(b0,qr[d0],p0,0,0,0);p1=__builtin_amdgcn_mfma_f32_32x32x16_bf16(b1,qr[d0],p1,0,0,0);}}
}
__device__ __forceinline__ void kload8(bf16x8*kf,lds_cptr kp){
  kf[0]=*(const __attribute__((address_space(3))) bf16x8*)(kp);      kf[1]=*(const __attribute__((address_space(3))) bf16x8*)(kp+512);
  kf[2]=*(const __attribute__((address_space(3))) bf16x8*)(kp+2048); kf[3]=*(const __attribute__((address_space(3))) bf16x8*)(kp+2560);
  kf[4]=*(const __attribute__((address_space(3))) bf16x8*)(kp+4096); kf[5]=*(const __attribute__((address_space(3))) bf16x8*)(kp+4608);
  kf[6]=*(const __attribute__((address_space(3))) bf16x8*)(kp+6144); kf[7]=*(const __attribute__((address_space(3))) bf16x8*)(kp+6656);
}
__device__ __forceinline__ void kload2(bf16x8*kf,lds_cptr kp,int j){ kf[2*j]=*(const __attribute__((address_space(3))) bf16x8*)(kp+j*2048); kf[2*j+1]=*(const __attribute__((address_space(3))) bf16x8*)(kp+j*2048+512); }
__device__ __forceinline__ s16x4 vtr(lds_cptr p){ return __builtin_bit_cast(s16x4,__builtin_amdgcn_ds_read_tr16_b64_v4i16((__attribute__((address_space(3))) v4i16_t*)p)); }
__device__ __forceinline__ float rowmax(const f32x16&p0,const f32x16&p1){
  float a=max3f(p0[0],p0[1],p1[0]),b=max3f(p0[2],p0[3],p1[1]);a=max3f(a,p1[2],p1[3]);
  #pragma unroll
  for(int r=4;r<16;r+=4){a=max3f(a,p0[r],p0[r+1]);b=max3f(b,p0[r+2],p0[r+3]);a=max3f(a,p1[r],p1[r+1]);b=max3f(b,p1[r+2],p1[r+3]);}
  const float m=max2f(a,b);
  auto rr=__builtin_amdgcn_permlane32_swap(__float_as_uint(m),__float_as_uint(m),false,false);
  return max2f(__uint_as_float(rr[0]),__uint_as_float(rr[1]));
}
__device__ __forceinline__ void pv(f32x16*o,int vb,bf16x8 pa0,bf16x8 pa1,bf16x8 pa2,bf16x8 pa3){
  #pragma unroll
  for(int d0=0;d0<2;++d0){s16x4 lo[4],hi[4];
    #pragma unroll
    for(int ks=0;ks<4;++ks){
      asm volatile("ds_read_b64_tr_b16 %0,%1 offset:%c2":"=&v"(lo[ks]):"v"(vb),"i"(d0*4096+ks*1024):"memory");
      asm volatile("ds_read_b64_tr_b16 %0,%1 offset:%c2":"=&v"(hi[ks]):"v"(vb),"i"(d0*4096+ks*1024+512):"memory");}
    asm volatile("s_waitcnt lgkmcnt(0)":::"memory");SBAR();
    #define PK(k) (bf16x8){lo[k][0],lo[k][1],lo[k][2],lo[k][3],hi[k][0],hi[k][1],hi[k][2],hi[k][3]}
    o[d0]=__builtin_amdgcn_mfma_f32_32x32x16_bf16(pa0,PK(0),o[d0],0,0,0);
    o[d0]=__builtin_amdgcn_mfma_f32_32x32x16_bf16(pa1,PK(1),o[d0],0,0,0);
    o[d0]=__builtin_amdgcn_mfma_f32_32x32x16_bf16(pa2,PK(2),o[d0],0,0,0);
    o[d0]=__builtin_amdgcn_mfma_f32_32x32x16_bf16(pa3,PK(3),o[d0],0,0,0);
    #undef PK
  }
}


template<int THRL,int MODE> __device__ __forceinline__ void attn_unit_pipe(Frame& F,int b,int h,int qb,int qcol,int kcol,int vcol,int ycol,float sink2,const float*rpb){
  constexpr bool NOMAX=(MODE==0), USE_NEGM=false;
  int lane_=F.lane; asm volatile("":"+v"(lane_));
  const int lane=lane_,r32=lane&31,hi=lane>>5; const int wid=F.wave; (void)h;
  const bf16_t*PROJ=(const bf16_t*)(F.ws+WS_PROJ); bf16_t*Yb=(bf16_t*)(F.ws+WS_H);
  const int ctxrow=NLAT+CTXL*b,latrow=SEQ*b; LAS unsigned char*shm=F.lds;
  const int qrow0=(MODE==3)?ctxrow:latrow+256*qb;
  int lt_lo=0,nloc=0;
  if(MODE==0){nloc=128;}
  if(MODE==1){const int a_=(256*qb-128)>>6,e_=(256*qb+255+128)>>6; lt_lo=a_<0?0:a_; nloc=(e_>127?127:e_)-lt_lo+1;}
  if(MODE==2){const int a_=4*qb-4,e0_=4*qb-1; lt_lo=a_<0?0:(a_>120?120:a_); int e_=(e0_<0?0:(e0_>120?120:e0_))+7; nloc=e_-lt_lo+1; if(nloc&1)++nloc;}
  const int qw0=256*qb+32*wid;
  const int rw=4*qb+(wid>>1); const int rs=rw-4<0?0:(rw-4>120?120:rw-4);
  const int qc=32*(wid&1)+r32; const int cs=qc-8<0?0:(qc-8>48?48:qc-8);
  LAS float*rpbL=(LAS float*)(shm+LDS_BYTES);
  if(MODE==2){ for(int i=wid*64+lane;i<465;i+=512) rpbL[i]=rpb[i]*LOG2E; }
  unsigned vm0=0u,vm1=0u;
  if(MODE==2){ _Pragma("unroll") for(int r=0;r<16;++r){ const int kc_=crow(r,hi); if(kc_>=cs&&kc_<cs+16)vm0|=1u<<r; if(kc_+32>=cs&&kc_+32<cs+16)vm1|=1u<<r; } }
  const bf16_t*Qw=PROJ+(size_t)(qrow0+wid*QBLK)*PP+qcol;
  const unsigned lds0=(unsigned)(uintptr_t)shm;
  LAS float*wsf=(LAS float*)(shm+LDS_WS)+wid*64;
  const bf16_t*ksrc=PROJ+(size_t)lane*PP+kcol+wid*8;
  const bf16_t*vsrc=PROJ+(size_t)(16*(wid&3)+(lane>>2))*PP+vcol+(wid>>2)*32+(lane&3)*8;
  #define KROW(t) ((size_t)((t)<4?ctxrow+64*(t):latrow+64*(lt_lo+(t)-4))*PP)
  const unsigned kdst=lds0+LDS_K+wid*1024, vdst=lds0+LDS_V+wid*1024;
  #define DMA_K(t,slot) glds16(ksrc+KROW(t),(unsigned)__builtin_amdgcn_readfirstlane(kdst+(slot)))
  #define DMA_V(t,slot) glds16(vsrc+KROW(t),(unsigned)__builtin_amdgcn_readfirstlane(vdst+(slot)))
  const int vb0=(int)(lds0+LDS_V)+((lane>>4)&1)*32+(lane&3)*8+(4*hi+((lane&15)>>2))*64;
  const lds_cptr Kbase=(lds_cptr)shm+LDS_K; bf16x8 kf[8];
  const lds_cptr shm3=(lds_cptr)shm; const lds_cptr kp0=shm3+LDS_K+hi*1024+r32*16; const lds_cptr vp0=shm3+LDS_V+((lane>>4)&1)*32+(lane&3)*8+(4*hi+((lane&15)>>2))*64;
  const int NT=4+nloc;
  DMA_K(0,0);DMA_V(0,0);DMA_K(1,SLOTB);
  bf16x8 qr[4];
  #pragma unroll
  for(int d0=0;d0<4;++d0)qr[d0]=*reinterpret_cast<const bf16x8*>(&Qw[(size_t)r32*PP+d0*16+hi*8]);
  float mhat=0.f,l_reg=0.f;f32x16 o[2],negm;
  { float z_=0.f; asm volatile("":"+v"(z_));
    _Pragma("unroll") for(int r=0;r<16;++r){o[0][r]=z_;o[1][r]=z_;if(USE_NEGM)negm[r]=z_;} }
  if(USE_NEGM)asm volatile("":"+v"(negm));
  #define NEGMC (USE_NEGM?negm:(f32x16){})
  #define CMASK(P0,P1,t) do{ if(MODE==1&&(t)>=4){ const int dq_=64*(lt_lo+(t)-4)-(qw0+r32); \
      _Pragma("unroll") for(int r=0;r<16;++r){ const int d0_=dq_+crow(r,hi),d1_=d0_+32; if(d0_>128||d0_<-128)P0[r]=-INFINITY; if(d1_>128||d1_<-128)P1[r]=-INFINITY; } } \
    if(MODE==2&&(t)>=4){ const int gr_=lt_lo+(t)-4; const bool rel_=(gr_>=rs)&&(gr_<rs+8); const LAS float*bt_=rpbL+(rel_?gr_-rw+7:7)*31+(15-qc)+4*hi; const unsigned m0_=rel_?vm0:0u,m1_=rel_?vm1:0u; \
      _Pragma("unroll") for(int r=0;r<16;++r){ const int kc_=(r&3)+8*(r>>2);   \
        P0[r]=((m0_>>r)&1u)?P0[r]+bt_[kc_]:-INFINITY; P1[r]=((m1_>>r)&1u)?P1[r]+bt_[kc_+32]:-INFINITY; } } }while(0)
  bool resc=false;
  #define START(P0,P1) do{ resc=false; \
    if(!NOMAX){ const float rm=rowmax(P0,P1); const float dl=rm; mhat=fadd_s(mhat,dl); \
      _Pragma("unroll") for(int r=0;r<16;++r){P0[r]=fsub_s(P0[r],dl);P1[r]=fsub_s(P1[r],dl);} \
      if(USE_NEGM){ _Pragma("unroll") for(int r=0;r<16;++r)negm[r]=-mhat; asm volatile("":"+v"(negm)); } } \
    _Pragma("unroll") for(int r=0;r<16;++r)P0[r]=__builtin_amdgcn_exp2f(P0[r]); }while(0)
  #define RESC() do{ if(resc){ asm volatile("s_waitcnt lgkmcnt(0)":::"memory"); \
      _Pragma("unroll") for(int d_=0;d_<2;++d_) _Pragma("unroll") for(int r=0;r<16;++r)o[d_][r]*=wsf[crow(r,hi)]; } }while(0)
  f32x16 pA0,pA1,pB0,pB1;
  int sl_prev=0,sl_cur=0,sl_next=SLOTB;
  #define ROT() do{sl_prev=sl_cur;sl_cur=sl_next;sl_next=(sl_next==(NSLOT-1)*SLOTB)?0:sl_next+SLOTB;}while(0)
  DMA_K(2,2*SLOTB);
  WAIT_BAR(3);
  qkt<!USE_NEGM>(pA0,pA1,Kbase,qr,negm,r32,hi);asm volatile("s_nop 15\n\ts_nop 7":"+v"(pA0),"+v"(pA1));CMASK(pA0,pA1,0);
  START(pA0,pA1);
  _Pragma("unroll") for(int r=0;r<16;++r)pA1[r]=__builtin_amdgcn_exp2f(pA1[r]);
  WAIT_BAR(0);
  DMA_K(3,0);DMA_V(1,SLOTB);
  ROT();
  kload8(kf,kp0+sl_cur);
  WAIT_BAR(2);
  s16x4 vlo[8],vhi[8]; u32x4 pw0,pw1,pw2,pw3;
  #define PKW(P,B) cvtpk_s(P[B],P[B+1])
  #define PAF(k) __builtin_bit_cast(bf16x8,pw##k)
  #define VFR(i) (bf16x8){vlo[i][0],vlo[i][1],vlo[i][2],vlo[i][3],vhi[i][0],vhi[i][1],vhi[i][2],vhi[i][3]}
  #define PIN(x) asm volatile("":"+v"(x))
  #define MX3(a,b,c) __builtin_fmaxf(__builtin_fmaxf((a),(b)),(c))
  #define GAPA(MF,A0,A1,A2,A3,W0,W1,PW) do{ MF; sacc+=A0; sacc+=A1; sacc+=A2; sacc+=A3; PIN(sacc); W0; W1; PIN(PW); SBAR(); }while(0)
  #define EX(v) __builtin_amdgcn_exp2f(v)
  #define GAPB(MF,X,B) do{ MF; X[B]=EX(X[B]); X[B+1]=EX(X[B+1]); X[B+2]=EX(X[B+2]); X[B+3]=EX(X[B+3]); PIN(X); SBAR(); }while(0)
  #define VRD(i) do{ vlo[i]=vtr(vp_+(((i)>>2)*4096+((i)&3)*1024)); vhi[i]=vtr(vp_+(((i)>>2)*4096+((i)&3)*1024+512)); }while(0)
  #define KRD(G,j) do{ if(G){ kload2(kf,kp0+sl_next,j); SBAR(); } }while(0)
  #define STEP(C0,C1,P0,P1,t,GK,GV,GL) do{ SBAR(); \
    const lds_cptr vp_=vp0+sl_prev; \
    VRD(0); SBAR(); float sacc=(P0[0]+P0[1]); \
    GAPA(C0=__builtin_amdgcn_mfma_f32_32x32x16_bf16(kf[0],qr[0],NEGMC,0,0,0), P0[2],P0[3],P0[4],P0[5],     pw0[0]=PKW(P0,0), pw0[1]=PKW(P0,2), pw0); \
    VRD(4); SBAR(); GAPA(C1=__builtin_amdgcn_mfma_f32_32x32x16_bf16(kf[1],qr[0],NEGMC,0,0,0), P0[6],P0[7],P0[8],P0[9],     pw0[2]=PKW(P0,4), pw0[3]=PKW(P0,6), pw0); \
    VRD(1); SBAR(); GAPA(C0=__builtin_amdgcn_mfma_f32_32x32x16_bf16(kf[2],qr[1],C0,0,0,0),   P0[10],P0[11],P0[12],P0[13], pw1[0]=PKW(P0,8), pw1[1]=PKW(P0,10), pw1); \
    VRD(5); SBAR(); GAPA(C1=__builtin_amdgcn_mfma_f32_32x32x16_bf16(kf[3],qr[1],C1,0,0,0),   P0[14],P0[15],P1[0],P1[1],   pw1[2]=PKW(P0,12),pw1[3]=PKW(P0,14), pw1); \
    VRD(2); SBAR(); GAPA(C0=__builtin_amdgcn_mfma_f32_32x32x16_bf16(kf[4],qr[2],C0,0,0,0),   P1[2],P1[3],P1[4],P1[5],     pw2[0]=PKW(P1,0), pw2[1]=PKW(P1,2), pw2); \
    VRD(6); SBAR(); GAPA(C1=__builtin_amdgcn_mfma_f32_32x32x16_bf16(kf[5],qr[2],C1,0,0,0),   P1[6],P1[7],P1[8],P1[9],     pw2[2]=PKW(P1,4), pw2[3]=PKW(P1,6), pw2); \
    VRD(3); SBAR(); GAPA(C0=__builtin_amdgcn_mfma_f32_32x32x16_bf16(kf[6],qr[3],C0,0,0,0),   P1[10],P1[11],P1[12],P1[13], pw3[0]=PKW(P1,8), pw3[1]=PKW(P1,10), pw3); \
    VRD(7); SBAR(); GAPA(C1=__builtin_amdgcn_mfma_f32_32x32x16_bf16(kf[7],qr[3],C1,0,0,0),   P1[14],P1[15],0.f,0.f,       pw3[2]=PKW(P1,12),pw3[3]=PKW(P1,14), pw3); \
    l_reg+=sacc; \
    if(GK){DMA_K((t)+3,sl_cur);} if(GV){DMA_V((t)+1,sl_next);} \
    if(!USE_NEGM&&!NOMAX){ _Pragma("unroll") for(int r=0;r<16;++r){C0[r]-=mhat;C1[r]-=mhat;} } \
    CMASK(C0,C1,t); \
    if(!NOMAX){ float a=MX3(C0[0],C0[1],C1[0]),b=MX3(C0[2],C0[3],C1[1]); a=MX3(a,C1[2],C1[3]); \
      _Pragma("unroll") for(int r=4;r<16;r+=4){a=MX3(a,C0[r],C0[r+1]);b=MX3(b,C0[r+2],C0[r+3]);a=MX3(a,C1[r],C1[r+1]);b=MX3(b,C1[r+2],C1[r+3]);} \
      float rm=__builtin_fmaxf(a,b); { auto rr=__builtin_amdgcn_permlane32_swap(__float_as_uint(rm),__float_as_uint(rm),false,false); rm=__builtin_fmaxf(__uint_as_float(rr[0]),__uint_as_float(rr[1])); } \
      resc=false; \
      if(__builtin_expect(__any(rm>(float)THRL),0)){ const float dl=__builtin_fmaxf(rm,0.f); mhat+=dl; \
        _Pragma("unroll") for(int r=0;r<16;++r){C0[r]-=dl;C1[r]-=dl;} \
        if(USE_NEGM){ _Pragma("unroll") for(int r=0;r<16;++r)negm[r]=-mhat; asm volatile("":"+v"(negm)); } \
        const float f=__builtin_amdgcn_exp2f(-dl); l_reg*=f; if(hi==0)wsf[r32]=f; resc=true; } } \
    SBAR(); \
    GAPB(o[0]=__builtin_amdgcn_mfma_f32_32x32x16_bf16(PAF(0),VFR(0),o[0],0,0,0), C0,0); \
    GAPB(o[1]=__builtin_amdgcn_mfma_f32_32x32x16_bf16(PAF(0),VFR(4),o[1],0,0,0), C0,4); \
    KRD(GL,0); GAPB(o[0]=__builtin_amdgcn_mfma_f32_32x32x16_bf16(PAF(1),VFR(1),o[0],0,0,0), C0,8); \
    KRD(GL,1); GAPB(o[1]=__builtin_amdgcn_mfma_f32_32x32x16_bf16(PAF(1),VFR(5),o[1],0,0,0), C0,12); \
    KRD(GL,2); GAPB(o[0]=__builtin_amdgcn_mfma_f32_32x32x16_bf16(PAF(2),VFR(2),o[0],0,0,0), C1,0); \
    KRD(GL,3); GAPB(o[1]=__builtin_amdgcn_mfma_f32_32x32x16_bf16(PAF(2),VFR(6),o[1],0,0,0), C1,4); \
    GAPB(o[0]=__builtin_amdgcn_mfma_f32_32x32x16_bf16(PAF(3),VFR(3),o[0],0,0,0), C1,8); \
    GAPB(o[1]=__builtin_amdgcn_mfma_f32_32x32x16_bf16(PAF(3),VFR(7),o[1],0,0,0), C1,12); \
    }while(0)
  int t=1;
  for(;t+5<NT;t+=2){
    STEP(pB0,pB1,pA0,pA1,t,true,true,true);     WAIT_BAR(2); RESC(); ROT();
    STEP(pA0,pA1,pB0,pB1,t+1,true,true,true);   WAIT_BAR(2); RESC(); ROT();
  }
  #define ENDW(tt) do{ if((tt)+3<NT){WAIT_BAR(2);} else if((tt)+2<NT){WAIT_BAR(1);} else {WAIT_BAR(0);} }while(0)
  for(;t+1<NT;t+=2){
    STEP(pB0,pB1,pA0,pA1,t,(t+3<NT),(t+1<NT),(t+1<NT));       ENDW(t);   RESC(); ROT();
    STEP(pA0,pA1,pB0,pB1,t+1,(t+4<NT),(t+2<NT),(t+2<NT));     ENDW(t+1); RESC(); ROT();
  }
  STEP(pB0,pB1,pA0,pA1,NT-1,false,false,false); RESC();
  { float sacc=pB0[0]+pB0[1]; _Pragma("unroll") for(int r=2;r<16;++r)sacc+=pB0[r]; _Pragma("unroll") for(int r=0;r<16;++r)sacc+=pB1[r]; l_reg+=sacc;
    pw0=(u32x4){PKW(pB0,0),PKW(pB0,2),PKW(pB0,4),PKW(pB0,6)};pw1=(u32x4){PKW(pB0,8),PKW(pB0,10),PKW(pB0,12),PKW(pB0,14)};pw2=(u32x4){PKW(pB1,0),PKW(pB1,2),PKW(pB1,4),PKW(pB1,6)};pw3=(u32x4){PKW(pB1,8),PKW(pB1,10),PKW(pB1,12),PKW(pB1,14)};
    SBAR(); pv(o,vb0+sl_cur,PAF(0),PAF(1),PAF(2),PAF(3)); }
  #undef PKW
  #undef PAF
  #undef VFR
  #undef PIN
  #undef MX3
  #undef GAPA
  #undef GAPB
  #undef EX
  #undef VRD
  #undef KRD
  #undef STEP
  #undef ENDW
  {auto rr=__builtin_amdgcn_permlane32_swap(__float_as_uint(l_reg),__float_as_uint(l_reg),false,false);l_reg=__uint_as_float(rr[0])+__uint_as_float(rr[1]);}
  if(MODE==1||MODE==3)l_reg+=__builtin_amdgcn_exp2f(sink2-mhat);
  if(hi==0)wsf[32+r32]=l_reg;asm volatile("s_waitcnt lgkmcnt(0)":::"memory");
  float rli[16];
  #pragma unroll
  for(int r=0;r<16;++r)rli[r]=__builtin_amdgcn_rcpf(wsf[32+crow(r,hi)]);
  bf16_t*Ow=Yb+(size_t)(qrow0+wid*QBLK)*DM+ycol;
  { LAS bf16_t*stg=(LAS bf16_t*)(shm+LDS_OST)+wid*2048;
    #pragma unroll
    for(int r=0;r<16;++r){const int orow=crow(r,hi);
      #pragma unroll
      for(int d0=0;d0<2;++d0)stg[orow*64+d0*32+r32]=(bf16_t)(cvtpk(o[d0][r]*rli[r],0.f)&0xffffu);}
    asm volatile("s_waitcnt lgkmcnt(0)":::"memory");
    #pragma unroll
    for(int i=0;i<4;++i){const int row=i*8+(lane>>3),ch=lane&7; const u32x4 v=*(const LAS u32x4*)(stg+row*64+ch*8); *(u32x4*)(Ow+(size_t)row*DM+ch*8)=v;} }
  asm volatile("s_waitcnt lgkmcnt(0)\n\ts_barrier":::"memory");
  #undef DMA_K
  #undef DMA_V
  #undef KROW
  #undef NEGMC
  #undef CMASK
  #undef START
  #undef RESC
  #undef ROT
}

#undef SBAR
#undef WAIT_BAR
}

constexpr int NPHASE = 17;
__device__ __forceinline__ void ph_decode(int ph, int& l, int& k) { const unsigned tab = 0x0A986321u;
    if (ph == 1) { l = 0; k = 0; } else { const int j = ph - 2; l = j >= 7 ? 1 : 0; k = (int)((tab >> (4 * (j >= 7 ? j - 7 : j))) & 15u); } }

__device__ __forceinline__ void fill_rtab(Frame& F, const pg8::StaticOrder& S, const float* ssq, const float* ssqc) {
    LAS float* tab = (LAS float*)(F.lds + pg8::RTAB_OFF); pg8::Unit u;
#pragma unroll
    for (int i = 0; i < 8; ++i) if (S.next(i, u) && F.tid < 256) { float s = 0.f;
        if (u.pm < 64) { const float* p = ssq + (size_t)(u.pm * 256 + F.tid) * 16; const f32x4 a = *(const f32x4*)p, b = *(const f32x4*)(p + 4), c = *(const f32x4*)(p + 8), d = *(const f32x4*)(p + 12);
            s = ((a[0] + a[1]) + (a[2] + a[3])) + ((b[0] + b[1]) + (b[2] + b[3])) + ((c[0] + c[1]) + (c[2] + c[3])) + ((d[0] + d[1]) + (d[2] + d[3])); }
        else { const float* p = ssqc + (size_t)((u.pm - 64) * 256 + F.tid) * 64;
#pragma unroll
            for (int j = 0; j < 16; ++j) { const f32x4 a = *(const f32x4*)(p + 4 * j); s += (a[0] + a[1]) + (a[2] + a[3]); } }
        tab[i * 256 + F.tid] = rsqrtf(s * (1.f / DM) + EPS); }
    __syncthreads();
}
__device__ __forceinline__ void phase_ids(Frame& F) {
    int lane_;
    asm volatile("v_mbcnt_lo_u32_b32 %0, -1, 0\n\tv_mbcnt_hi_u32_b32 %0, -1, %0" : "=v"(lane_));
    F.lane = lane_; F.tid = F.wave * 64 + lane_;
}
__device__ __forceinline__ void run_phase(const Frame& F0, int ph) {
    Frame F = F0;
    unsigned char* ws = F.ws;
#define H ((bf16_t*)(F.ws + WS_H))
#define PROJ ((bf16_t*)(F.ws + WS_PROJ))
#define XC ((float*)(F.ws + WS_XC))
#define MOD ((const float*)(F.ws + WS_MOD))
#define vcu ((F.G % 8 == 0) ? (F.bid % 8) * (F.G / 8) + F.bid / 8 : F.bid)
#ifdef ONLYK
    if (ONLYK == 100) { if (ph == 0) { phase_ids(F); p0_prologue(F); } return; }
    if (ONLYK == 101) { if (ph == NPHASE - 1) { phase_ids(F); final_phase(F); } return; }
    if (ph == 0 || ph == NPHASE - 1) return;
    int l, k; ph_decode(ph, l, k);
    if (k != ONLYK) return;
#else
    if (ph == 0) { phase_ids(F); p0_prologue(F); return; }
    if (ph == NPHASE - 1) { phase_ids(F); final_phase(F); return; }
    int l, k; ph_decode(ph, l, k);
#endif
    const int M = (l == 0) ? NROWS : NLAT;
    switch (k) {
    case 0: phase_ids(F); norm_phase(F, l); break;
    case 1: { phase_ids(F); pg8::Gemm g{H, (const bf16_t*)(ws + WS_WIN) + (size_t)l * PP * 1024, NROWS, PP, 1024}; pg8::StaticOrder S; S.init(NROWS, PP, F.G, F.bid);
              gates_phase(F, l); if (l > 0) fill_rtab(F, S, (const float*)(ws + WS_SSQ1), (const float*)(ws + WS_SSQC1));
              pg8::EpiProj E{PROJ, PP, l == 0 ? nullptr : (const LAS float*)(F.lds + pg8::RTAB_OFF), (const float*)(ws + WS_BIASIN), F.ka->in[IN_AQG] + l * 64, F.ka->in[IN_AKG] + l * 64, (const float*)(ws + WS_ROPE)}; pg8::gemm_phase<pg8::EpiProj, pg8::StaticOrder, true, true>(F.lds, g, S, E, F.tid); } break;
    case 2: {
        phase_ids(F);
        ml::pass1(F, l);
        __syncthreads();
#ifndef NO_B
        for (int u = vcu; u < 256; u += F.G) { const int b = u >> 7, h = (u >> 5) & 3, qb = u & 31;
            attp::attn_unit_pipe<8, 1>(F, b, h, qb, PC_BQ + 64 * h, PC_BK + 64 * (h >> 1), PC_BV + 64 * (h >> 1), 256 + 64 * h, F.ka->in[IN_SINK][l * 4 + h] * LOG2E, nullptr); }
#endif
#ifndef NO_D
        for (int u = vcu; u < 256; u += F.G) { const int b = u >> 7, h = (u >> 5) & 3, qb = u & 31;
            attp::attn_unit_pipe<8, 2>(F, b, h, qb, PC_DQ + 64 * h, PC_DK + 64 * h, PC_DV + 64 * h, 768 + 64 * h, 0.f, F.ka->in[IN_RPB] + (size_t)(l * 4 + h) * 465); }
#endif
#ifndef NO_C3
        if (l == 0) for (int cu = vcu; cu < 24; cu += F.G) { const int mx = cu >> 3, b = (cu >> 2) & 1, h = cu & 3;
            const int qc = mx == 0 ? PC_AQ + 64 * h : (mx == 1 ? PC_BQ + 64 * h : PC_DQ + 64 * h);
            const int kc = mx == 0 ? PC_AK + 64 * (h >> 1) : (mx == 1 ? PC_BK + 64 * (h >> 1) : PC_DK + 64 * h);
            const int vc = mx == 0 ? PC_AV + 64 * (h >> 1) : (mx == 1 ? PC_BV + 64 * (h >> 1) : PC_DV + 64 * h);
            const int yc = (mx == 0 ? 0 : (mx == 1 ? 256 : 768)) + 64 * h;
            const float s2 = mx == 1 ? F.ka->in[IN_SINK][l * 4 + h] * LOG2E : -INFINITY;
            attp::attn_unit_pipe<8, 3>(F, b, h, 0, qc, kc, vc, yc, s2, nullptr); }
#endif
        if (l == 0) bias_phase(F, vcu >= 24 ? vcu - 24 : -1, F.G - 24);
    } break;
    case 3: {
        phase_ids(F);
        ml::pass2(F);
        asm volatile("s_waitcnt vmcnt(0)" ::: "memory"); __syncthreads();
        if (F.tid == 0) __hip_atomic_fetch_add((unsigned*)(ws + WS_CTL + 43008) + l, 1u, __ATOMIC_RELAXED, __HIP_MEMORY_SCOPE_AGENT);
#ifndef NO_ATTN0
        for (int u = vcu; u < 256; u += F.G) { const int b = u >> 7, h = (u >> 5) & 3, qb = u & 31;
            attp::attn_unit_pipe<8, 0>(F, b, h, qb, PC_AQ + 64 * h, PC_AK + 64 * (h >> 1), PC_AV + 64 * (h >> 1), 64 * h, 0.f, nullptr); }
#endif
        if (F.tid == 0) { unsigned* cnt = (unsigned*)(ws + WS_CTL + 43008) + l; unsigned sp = 0;
            while (__hip_atomic_load(cnt, __ATOMIC_RELAXED, __HIP_MEMORY_SCOPE_AGENT) < (unsigned)F.G && ++sp < (1u << 22)) __builtin_amdgcn_s_sleep(1);
            __builtin_amdgcn_fence(__ATOMIC_ACQUIRE, "agent"); asm volatile("s_waitcnt vmcnt(0)" ::: "memory"); }
        __syncthreads();
#ifndef NO_PASS3
        ml::pass3(F, l, l == 0 ? 0 : 4);
#endif
    } break;
    case 6: { phase_ids(F); pg8::Gemm g{PROJ  , (const bf16_t*)(ws + WS_WOUT) + (size_t)l * 1024 * 1024, NLAT, 1024, 1024}; pg8::StaticOrder S; S.init(NLAT, 1024, F.G, F.bid);
              { pg8::Unit u;
                if (F.G >= 256) { if (S.next(0, u)) {
                    groupnorm_rows<true>(F, l, u.pm * 256 + u.pn * 64, 64, F.wave, NWAVES);
                    asm volatile("s_waitcnt vmcnt(0)" ::: "memory"); __syncthreads();
                    if (F.tid == 0) { unsigned* cnt = (unsigned*)(ws + WS_CTL + 40960) + l * 64 + u.pm;
                        __hip_atomic_fetch_add(cnt, 1u, __ATOMIC_RELAXED, __HIP_MEMORY_SCOPE_AGENT);
                        unsigned sp = 0; while (__hip_atomic_load(cnt, __ATOMIC_RELAXED, __HIP_MEMORY_SCOPE_AGENT) < 4u && ++sp < (1u << 22)) __builtin_amdgcn_s_sleep(1);
                        __builtin_amdgcn_fence(__ATOMIC_ACQUIRE, "agent"); asm volatile("s_waitcnt vmcnt(0)" ::: "memory"); }
                    __syncthreads(); } }
                else { for (int i = 0; S.next(i, u); ++i) groupnorm_rows<false>(F, l, u.pm * 256, 256, F.wave, NWAVES); VM_WAIT(); __syncthreads(); } }
              pg8::EpiResid E{l == 0 ? F.ka->in[IN_X] : F.out, l == 0 ? F.ka->in[IN_CTX] : XC, F.out, XC, MOD + (size_t)l * 3 * 6144 + 2 * 1024,
                               (bf16_t*)(ws + WS_XG), F.ka->in[IN_G2] + l * 1024, MOD + (size_t)l * 3 * 6144 + 4 * 1024, (float*)(ws + WS_SSQ2)};
              if (F.G >= 256) { pg8::EpiResidStaged E2{E.xin_lat, E.xin_ctx, E.xout_lat, E.xout_ctx, E.gate, E.xg, E.gn, E.scn, E.ssq}; pg8::gemm_phase<pg8::EpiResidStaged, pg8::StaticOrder, true, true>(F.lds, g, S, E2, F.tid); }
              else pg8::gemm_phase<pg8::EpiResid, pg8::StaticOrder, true, true>(F.lds, g, S, E, F.tid);
              PROBE_PT(F.lds, 5);
              if (l == 0) skinny_ctx<1024>(F, PROJ + (size_t)NLAT * DM, (const bf16_t*)(ws + WS_WOUT), F.ka->in[IN_CTX], XC, MOD + 2 * 6144 + 2 * 1024,
                                           (bf16_t*)(ws + WS_XG) + (size_t)NLAT * DM, F.ka->in[IN_G2], MOD + 2 * 6144 + 4 * 1024, (float*)(ws + WS_SSQC2)); } break;
    case 8: { phase_ids(F); pg8::Gemm g{(const bf16_t*)(ws + WS_XG), (const bf16_t*)(ws + WS_WUP) + (size_t)l * DFF2 * 1024, M, DFF2, 1024}; pg8::StaticOrder S; S.init(M, DFF2, F.G, F.bid);
              fill_rtab(F, S, (const float*)(ws + WS_SSQ2), (const float*)(ws + WS_SSQC2));
              pg8::EpiUp E{PROJ, F.ka->in[IN_CONVW] + (size_t)l * 3 * DFF2, F.ka->in[IN_CONVB] + (size_t)l * DFF2, (float*)(ws + WS_EDGE), (const LAS float*)(F.lds + pg8::RTAB_OFF), (const float*)(ws + WS_BIASUP) + (size_t)l * 3 * DFF2};
              pg8::gemm_phase<pg8::EpiUp, pg8::StaticOrder, true, true>(F.lds, g, S, E, F.tid); } break;
    case 9: phase_ids(F); for (int ht = F.bid; ht < M / 128; ht += F.G) fixup_hts(F, l, ht, 1); break;
    case 10: { phase_ids(F); pg8::Gemm g{PROJ, (const bf16_t*)(ws + WS_WDN) + (size_t)l * 1024 * DFF, NLAT, 1024, DFF}; pg8::StaticOrder S; S.init(NLAT, 1024, F.G, F.bid);
              pg8::EpiResid E{F.out, XC, F.out, XC, MOD + (size_t)l * 3 * 6144 + 5 * 1024,
                               l == 0 ? H : nullptr, F.ka->in[IN_G1] + 1024, MOD + (size_t)3 * 6144 + 1 * 1024, (float*)(ws + WS_SSQ1)};
              if (F.G >= 256) { pg8::EpiResidStaged E2{E.xin_lat, E.xin_ctx, E.xout_lat, E.xout_ctx, E.gate, E.xg, E.gn, E.scn, E.ssq}; pg8::gemm_phase<pg8::EpiResidStaged, pg8::StaticOrder, true, true>(F.lds, g, S, E2, F.tid); }
              else pg8::gemm_phase<pg8::EpiResid, pg8::StaticOrder, true, true>(F.lds, g, S, E, F.tid);
              PROBE_PT(F.lds, 5);
              if (l == 0) skinny_ctx<DFF>(F, PROJ + (size_t)NLAT * DFF, (const bf16_t*)(ws + WS_WDN), XC, XC, MOD + 2 * 6144 + 5 * 1024,
                                          H + (size_t)NLAT * DM, F.ka->in[IN_G1] + 1024, MOD + (size_t)(3 + 2) * 6144 + 1 * 1024, (float*)(ws + WS_SSQC1)); } break;
    default: break;
    }
#undef H
#undef PROJ
#undef XC
#undef MOD
#undef vcu
}

__global__ void __launch_bounds__(NTHREADS, 2) fwd_kernel(Args args) {
    extern __shared__ __attribute__((aligned(16))) unsigned char lds_raw[];
    Frame F;
    F.lds = (LAS unsigned char*)lds_raw;
    const int wave0 = __builtin_amdgcn_readfirstlane((int)threadIdx.x >> 6);
    F.tid = 0; F.lane = 0; F.wave = wave0;
    F.G = gridDim.x; F.bid = blockIdx.x;
    F.ka = (const __attribute__((address_space(4))) Args*)__builtin_amdgcn_kernarg_segment_ptr();
    F.out = args.out; F.ws = args.ws;
#define MK_LANE(x) int x; asm volatile("v_mbcnt_lo_u32_b32 %0, -1, 0\n\tv_mbcnt_hi_u32_b32 %0, -1, %0" : "=v"(x))
#if !MK_MULTI
    { MK_LANE(l0_); if (wave0 == 0) ((LAS unsigned*)(F.lds + LDSCTL_OFF))[l0_] = 0u; }
    __syncthreads();
    XcdBarrier bar;
    { MK_LANE(l0_); bar = xcd_barrier_post((unsigned*)(args.ws + WS_CTL) + CW_BAR, (volatile LAS unsigned*)(F.lds + LDSCTL_OFF) + 8, wave0 == 0 && l0_ == 0); }
#endif
#ifdef PROBE_MASK
    unsigned long long pr_acc = 0ull;
#endif
    for (int ph = args.ph_lo; ph < args.ph_hi; ++ph) {
#ifdef PROBE_MASK
        const unsigned long long pr_t0 = __builtin_amdgcn_s_memrealtime();
#endif
#ifdef PROBE_PH
        *(volatile LAS unsigned*)(F.lds + LDSCTL_OFF + 64) = (ph == PROBE_PH) ? 1u : 0u; __syncthreads();
        PROBE_PT(F.lds, 0);
#endif
        {
            Frame P = F;
            int wave_ = wave0, bid_ = F.bid, g_ = F.G; unsigned char* ws_ = F.ws; float* out_ = F.out; const __attribute__((address_space(4))) Args* ka_ = F.ka;
            asm volatile("" : "+s"(wave_), "+s"(bid_), "+s"(g_), "+s"(ws_), "+s"(out_), "+s"(ka_));
            P.ka = ka_; P.lane = 0; P.wave = wave_; P.tid = 0; P.bid = bid_; P.G = g_; P.ws = ws_; P.out = out_;
            run_phase(P, ph);
#ifdef DUP_PH
            if (DUP_PH(ph)) { asm volatile("s_waitcnt vmcnt(0) lgkmcnt(0)" ::: "memory"); __syncthreads(); run_phase(P, ph); }
#endif
        }
#if !MK_MULTI
        if (ph + 1 < args.ph_hi) {
            if (args.ph_lo < 0) cg::this_grid().sync();
            else { MK_LANE(l1_); xcd_barrier(bar, wave0 == 0 && l1_ == 0); }
        }
#endif
#ifdef PROBE_PH
        PROBE_PT(F.lds, 4);
#endif
#ifdef PROBE_MASK
        if ((PROBE_MASK >> ph) & 1u) pr_acc += __builtin_amdgcn_s_memrealtime() - pr_t0;
#endif
    }
#ifdef PROBE_PH
    if (blockIdx.x == 0) { __syncthreads(); const unsigned long long d_ = *(volatile LAS unsigned long long*)(F.lds + LDSCTL_OFF + 72 + 8 * PROBE_B) - *(volatile LAS unsigned long long*)(F.lds + LDSCTL_OFF + 72 + 8 * PROBE_A);
        const unsigned long long t1 = __builtin_amdgcn_s_memrealtime(); while (__builtin_amdgcn_s_memrealtime() - t1 < d_) __builtin_amdgcn_s_sleep(8); }
#endif
#ifdef PROBE_MASK
    if (blockIdx.x == 0) { const unsigned long long t1 = __builtin_amdgcn_s_memrealtime(); while (__builtin_amdgcn_s_memrealtime() - t1 < pr_acc) __builtin_amdgcn_s_sleep(8); }
#endif
}

extern "C" void kernel_launch(void* const* d_in, const int* in_sizes, int n_in, void* d_out, int out_size, void* d_ws, size_t ws_size, hipStream_t stream) {
    static int grid = 0;
    if (grid == 0) {
        if (n_in != 21 || out_size != NLAT * DM || ws_size < WS_END) { fprintf(stderr, "kernel_launch: unexpected shapes (n_in %d out %d ws %zu)\n", n_in, out_size, ws_size); grid = -1; return; }
        int dev = 0, cus = 0, per_cu = 0;
        if (hipGetDevice(&dev) != hipSuccess || hipDeviceGetAttribute(&cus, hipDeviceAttributeMultiprocessorCount, dev) != hipSuccess) { grid = -1; return; }
        if (hipFuncSetAttribute((const void*)fwd_kernel, hipFuncAttributeMaxDynamicSharedMemorySize, LDS_BYTES) != hipSuccess) { fprintf(stderr, "kernel_launch: hipFuncSetAttribute failed\n"); grid = -1; return; }
        if (hipOccupancyMaxActiveBlocksPerMultiprocessor(&per_cu, (const void*)fwd_kernel, NTHREADS, LDS_BYTES) != hipSuccess || per_cu < 1) { fprintf(stderr, "kernel_launch: occupancy query says %d blocks per CU\n", per_cu); grid = -1; (void)hipGetLastError(); return; }
        grid = cus;
    }
    if (grid < 0) return;
#if !MK_MULTI
    if (hipMemsetAsync((char*)d_ws + WS_CTL, 0, 65536, stream) != hipSuccess) { fprintf(stderr, "kernel_launch: hipMemsetAsync failed\n"); return; }
#endif
    Args a{};
    for (int i = 0; i < 21; ++i) a.in[i] = (const float*)d_in[i];
    a.out = (float*)d_out; a.ws = (unsigned char*)d_ws;
#if MK_MULTI
    for (int ph = 0; ph < NPHASE; ++ph) { a.ph_lo = ph; a.ph_hi = ph + 1; hipLaunchKernelGGL(fwd_kernel, dim3(grid), dim3(NTHREADS), LDS_BYTES, stream, a); }
#else
    a.ph_lo = 0; a.ph_hi = NPHASE;
    void* kargs[] = {&a};
    hipError_t e = hipLaunchCooperativeKernel((void*)fwd_kernel, dim3(grid), dim3(NTHREADS), kargs, LDS_BYTES, stream);
    if (e != hipSuccess) fprintf(stderr, "kernel_launch: cooperative launch failed: %s (grid %d)\n", hipGetErrorString(e), grid);
#endif
}
```

```cpp
#include <hip/hip_runtime.h>
#include <hip/hip_cooperative_groups.h>
#include <cstdio>
#include <cstdint>
namespace cg = cooperative_groups;

#ifndef MK_MULTI
#define MK_MULTI 0
#endif

constexpr int DM = 1024, SEQ = 8192, NBATCH = 2, CTXL = 256, NLAT = NBATCH * SEQ, NROWS = NLAT + NBATCH * CTXL;
constexpr int PP = 2816;
constexpr int DFF = 2816, DFF2 = 5632, DIN = 2832, NLAYER = 2;
constexpr float EPS = 1e-6f;
constexpr float LOG2E = 1.4426950408889634f;
constexpr float QSCALE2 = 0.125f * LOG2E;
constexpr int PC_AQ = 0, PC_AK = 256, PC_AV = 384, PC_BQ = 512, PC_BK = 768, PC_BV = 896, PC_CQ = 1024, PC_CK = 1280, PC_CV = 1536, PC_CO = 1792, PC_DQ = 2048, PC_DK = 2304, PC_DV = 2560;
constexpr int NCHUNK = 132, NCHAIN = 16;

constexpr size_t MiB = 1u << 20;
constexpr size_t WS_CTL = 0, CTL_ZERO_BYTES = 1 * MiB;
constexpr size_t WS_MOD = 1 * MiB;
constexpr size_t WS_ROPE = 1 * MiB + 192 * 1024;
constexpr size_t WS_WG = 1 * MiB + 512 * 1024;
constexpr size_t WS_XC = 2 * MiB;
constexpr size_t WS_WIN = 4 * MiB;
constexpr size_t WS_WOUT = 15 * MiB;
constexpr size_t WS_WUP = 19 * MiB;
constexpr size_t WS_WDN = 41 * MiB;
constexpr size_t WS_H = 52 * MiB;
constexpr size_t WS_PROJ = 85 * MiB;
constexpr size_t WS_GATES = 176 * MiB;
constexpr size_t WS_DS = 178 * MiB;
constexpr size_t WS_SBF = 211 * MiB;
constexpr size_t WS_ZD = 228 * MiB;
constexpr size_t WS_ZC = WS_ZD + 1 * MiB;
constexpr size_t WS_GC = WS_ZC + 1 * MiB;
constexpr size_t WS_ML = WS_GC + 16384;
constexpr size_t WS_MC = WS_ML + 16384;
constexpr size_t WS_SSQ1 = 231 * MiB;
constexpr size_t WS_SSQ2 = 232 * MiB + 512 * 1024;
constexpr size_t WS_BIASUP = 234 * MiB;
constexpr size_t WS_BIASIN = 234 * MiB + 256 * 1024;
constexpr size_t WS_XG = WS_DS;
constexpr size_t WS_EDGE = WS_SBF;
constexpr size_t WS_SSQC1 = 234 * MiB + 512 * 1024;
constexpr size_t WS_SSQC2 = 234 * MiB + 768 * 1024;
constexpr size_t WS_END = 237 * MiB;

#define LAS __attribute__((address_space(3)))
#define GAS __attribute__((address_space(1)))
typedef unsigned short bf16_t;
typedef short bf16x8 __attribute__((ext_vector_type(8)));
typedef short s16x4 __attribute__((ext_vector_type(4)));
typedef float f32x4 __attribute__((ext_vector_type(4)));
typedef float f32x16 __attribute__((ext_vector_type(16)));
typedef float f32x2 __attribute__((ext_vector_type(2)));
typedef unsigned u32x4 __attribute__((ext_vector_type(4)));
typedef unsigned u32x2 __attribute__((ext_vector_type(2)));
typedef __bf16 bf16x2_t __attribute__((ext_vector_type(2)));
typedef short v4i16_t __attribute__((ext_vector_type(4)));

__device__ __forceinline__ unsigned cvtpk(float lo, float hi) { f32x2 v = {lo, hi}; bf16x2_t b = __builtin_convertvector(v, bf16x2_t); return __builtin_bit_cast(unsigned, b); }
__device__ __forceinline__ float bf2f(unsigned short b) { return __uint_as_float((unsigned)b << 16); }
__device__ __forceinline__ float bflo(unsigned w) { return __uint_as_float(w << 16); }
__device__ __forceinline__ float bfhi(unsigned w) { return __uint_as_float(w & 0xffff0000u); }
__device__ __forceinline__ float shfl_idx(float v, int src) { return __int_as_float(__builtin_amdgcn_ds_bpermute(src << 2, __float_as_int(v))); }
__device__ __forceinline__ float shfl_x(float v, int o, int lane) { return shfl_idx(v, lane ^ o); }
__device__ __forceinline__ float wave_sum(float v, int lane) {
#pragma unroll
    for (int o = 1; o < 64; o <<= 1) v += shfl_x(v, o, lane);
    return v;
}
__device__ __forceinline__ float wave_max(float v, int lane) {
#pragma unroll
    for (int o = 1; o < 64; o <<= 1) v = fmaxf(v, shfl_x(v, o, lane));
    return v;
}
#ifdef PROBE_PH
#define PROBE_PT(ldsbase, id) do { if (*(volatile LAS unsigned*)((ldsbase) + 155648 + 64)) *(volatile LAS unsigned long long*)((ldsbase) + 155648 + 72 + 8 * (id)) = __builtin_amdgcn_s_memrealtime(); } while (0)
#else
#define PROBE_PT(ldsbase, id) do { } while (0)
#endif
#define LDS_WAIT() asm volatile("s_waitcnt lgkmcnt(0)" ::: "memory")
#define VM_WAIT() asm volatile("s_waitcnt vmcnt(0)" ::: "memory")

namespace pg8 {
#define PG8_LAS __attribute__((address_space(3)))
constexpr int BM = 256, BK = 64, HALF = 128, HTB = HALF * BK * 2  , STAGE_BYTES = 8 * HTB, NXCD = 8, WGM = 8;
__host__ __device__ __forceinline__ int lds_byte(int r, int c) { const int st = (r >> 4) * 2 + (c >> 5), rr = r & 15, cc = c & 31, ob = rr * 64 + cc * 2; return st * 1024 + (ob ^ (((ob >> 9) & 1) << 5)); }
__host__ __device__ __forceinline__ void stage_rc(int b, int& R, int& C) { const int st = b / 1024, sb = b % 1024, swz = sb ^ (((sb >> 9) & 1) << 5); R = (st >> 1) * 16 + swz / 64; C = (st & 1) * 32 + (swz % 64) / 2; }
__host__ __device__ __forceinline__ int perm32(int rho) { const int n = rho >> 4, i = rho & 15; return 8 * (i >> 2) + 4 * n + (i & 3); }

struct Unit { int pm, pn, ui; };
struct Gemm { const bf16_t* A; const bf16_t* Bt; int M, N, K; };

struct StaticOrder {
    int nM, nN, nwg, G, c;
    __host__ __device__ __forceinline__ void init(int M, int N, int G_, int c_) { nM = M / BM; nN = N / BM; nwg = nM * nN; G = G_; c = c_; }
    __host__ __device__ __forceinline__ bool next(int i, Unit& u) const {
        const long L = (long)i * G + c; if (L >= nwg) return false;
        int wgid = (int)L; { const int q = nwg / NXCD, r = nwg % NXCD, xcd = wgid % NXCD, off = wgid / NXCD; wgid = (xcd < r ? xcd * (q + 1) : r * (q + 1) + (xcd - r) * q) + off; }
        const int nig = WGM * nN, gid = wgid / nig, fm = gid * WGM, gsz = (nM - fm) < WGM ? (nM - fm) : WGM;
        u.pm = fm + ((wgid % nig) % gsz); u.pn = (wgid % nig) / gsz; u.ui = i; return true;
    }
    __device__ __forceinline__ void a_ready(const Unit&) const {}
    __device__ __forceinline__ void done(const Unit&) const {}
};

constexpr int RTAB_OFF = 131072;
struct EpiProj {
    static constexpr bool PERM = true, AFTER_DRAIN = false, ROWPERM = false;
    bf16_t* O; int ldc; const LAS float* rtab; const float* bias;
    const float* gq; const float* gk; const float* rope;
    __device__ __forceinline__ void operator()(const f32x4 (&acc)[2][2][4][2], const Unit& u, int wr, int wc, int fr, int fq) const {
        asm volatile("" : "+v"(fr), "+v"(fq));
        const int row0 = u.pm * BM + wr * 64 + fr, col0 = u.pn * BM + wc * 32 + 8 * fq;
        const float sc = (u.pn == 2 || u.pn == 8) ? QSCALE2 : (u.pn == 4 ? 0.125f : 1.f);
        float rs[8] = {1.f, 1.f, 1.f, 1.f, 1.f, 1.f, 1.f, 1.f}; f32x4 bv[2][2] = {};
        if (rtab) {
#pragma unroll
            for (int i = 0; i < 8; ++i) rs[i] = rtab[u.ui * 256 + wr * 64 + fr + (i >> 2) * HALF + (i & 3) * 16];
            const int id = u.pm < 32 ? 0 : (u.pm < 64 ? 1 : 2);
#pragma unroll
            for (int bj = 0; bj < 2; ++bj)
#pragma unroll
                for (int n = 0; n < 2; ++n) bv[bj][n] = *(const f32x4*)(bias + id * PP + col0 + bj * HALF + 4 * n); }
        if (u.pn >= 4) {
#pragma unroll
            for (int ai = 0; ai < 2; ++ai)
#pragma unroll
                for (int m = 0; m < 4; ++m) { bf16_t* rowp = O + (size_t)(row0 + ai * HALF + m * 16) * ldc + col0; const float r = rs[ai * 4 + m];
#pragma unroll
                    for (int bj = 0; bj < 2; ++bj) { const f32x4 v0 = (acc[ai][bj][m][0] * r + bv[bj][0]) * sc, v1 = (acc[ai][bj][m][1] * r + bv[bj][1]) * sc;
                        u32x4 w; w.x = cvtpk(v0[0], v0[1]); w.y = cvtpk(v0[2], v0[3]); w.z = cvtpk(v1[0], v1[1]); w.w = cvtpk(v1[2], v1[3]);
                        *(u32x4*)(rowp + bj * HALF) = w; } }
            return;
        }
        const bool lat = u.pm < 64;
        const bool khead = (u.pn & 1) && wc < 2;
        const bool donorm = u.pn == 0 || (u.pn == 1 && wc < 2);
        const bool dorope = lat && (!(u.pn & 1) || khead);
        const float* gp = u.pn == 0 ? gq : gk;
        f32x4 gg[2][2];
#pragma unroll
        for (int bj = 0; bj < 2; ++bj)
#pragma unroll
            for (int n = 0; n < 2; ++n) gg[bj][n] = donorm ? *(const f32x4*)(gp + 32 * bj + 16 * n + 4 * fq) : (f32x4){1.f, 1.f, 1.f, 1.f};
        const float qs = u.pn == 0 ? QSCALE2 : 1.f;
#pragma unroll
        for (int ai = 0; ai < 2; ++ai)
#pragma unroll
            for (int m = 0; m < 4; ++m) { const int row = row0 + ai * HALF + m * 16; const float r = rs[ai * 4 + m];
                f32x4 v[2][2]; float ss = 0.f;
#pragma unroll
                for (int bj = 0; bj < 2; ++bj)
#pragma unroll
                    for (int n = 0; n < 2; ++n) { v[bj][n] = (acc[ai][bj][m][n] * r + bv[bj][n]) * sc; ss += (v[bj][n][0] * v[bj][n][0] + v[bj][n][1] * v[bj][n][1]) + (v[bj][n][2] * v[bj][n][2] + v[bj][n][3] * v[bj][n][3]); }
                if (donorm) { ss += shfl_idx(ss, (fq * 16 + fr) ^ 16); ss += shfl_idx(ss, (fq * 16 + fr) ^ 32); const float rstd = rsqrtf(ss * (1.f / 64.f) + EPS) * qs;
#pragma unroll
                    for (int bj = 0; bj < 2; ++bj)
#pragma unroll
                        for (int n = 0; n < 2; ++n) v[bj][n] = v[bj][n] * rstd * gg[bj][n]; }
                bf16_t* rowp = O + (size_t)row * ldc + u.pn * BM + 64 * wc + 4 * fq;
                const int t = row & (SEQ - 1);
#pragma unroll
                for (int bj = 0; bj < 2; ++bj) { f32x4 o1 = v[bj][0], o2 = v[bj][1];
                    if (dorope) { const float* rp = rope + ((size_t)(bj ? 128 + (t & 63) : (t >> 6)) * 16 + 4 * fq) * 2; const f32x4 c0 = *(const f32x4*)rp, c1 = *(const f32x4*)(rp + 4);
                        const f32x4 cz = {c0[0], c0[2], c1[0], c1[2]}, sz = {c0[1], c0[3], c1[1], c1[3]};
                        o1 = v[bj][0] * cz - v[bj][1] * sz; o2 = v[bj][0] * sz + v[bj][1] * cz; }
                    u32x2 w1, w2; w1.x = cvtpk(o1[0], o1[1]); w1.y = cvtpk(o1[2], o1[3]); w2.x = cvtpk(o2[0], o2[1]); w2.y = cvtpk(o2[2], o2[3]);
                    *(u32x2*)(rowp + 32 * bj) = w1; *(u32x2*)(rowp + 32 * bj + 16) = w2; } }
    }
};
struct EpiResid {
    static constexpr bool PERM = true, AFTER_DRAIN = false, ROWPERM = false;
    const float* xin_lat; const float* xin_ctx; float* xout_lat; float* xout_ctx; const float* gate;
    bf16_t* xg; const float* gn; const float* scn; float* ssq;
    __device__ __forceinline__ void operator()(const f32x4 (&acc)[2][2][4][2], const Unit& u, int wr, int wc, int fr, int fq) const {
        asm volatile("" : "+v"(fr), "+v"(fq));
        const int id = u.pm < 32 ? 0 : (u.pm < 64 ? 1 : 2);
        const float* xin = u.pm < 64 ? xin_lat + (size_t)u.pm * BM * DM : xin_ctx + (size_t)(u.pm - 64) * BM * DM;
        float* xout = u.pm < 64 ? xout_lat + (size_t)u.pm * BM * DM : xout_ctx + (size_t)(u.pm - 64) * BM * DM;
        const int rl = wr * 64 + fr, col0 = u.pn * BM + wc * 32 + 8 * fq;
        f32x4 g[2][2], gs[2][2];
#pragma unroll
        for (int bj = 0; bj < 2; ++bj)
#pragma unroll
            for (int n = 0; n < 2; ++n) { g[bj][n] = *(const f32x4*)(gate + id * 6144 + col0 + bj * HALF + 4 * n);
                if (xg) gs[bj][n] = *(const f32x4*)(gn + col0 + bj * HALF + 4 * n) * (1.f + *(const f32x4*)(scn + id * 6144 + col0 + bj * HALF + 4 * n)); }
#pragma unroll
        for (int ai = 0; ai < 2; ++ai)
#pragma unroll
            for (int m = 0; m < 4; ++m) { const size_t off = (size_t)(rl + ai * HALF + m * 16) * DM + col0; float s = 0.f;
#pragma unroll
                for (int bj = 0; bj < 2; ++bj) { f32x4 o[2];
#pragma unroll
                    for (int n = 0; n < 2; ++n) { const f32x4 xv = *(const f32x4*)(xin + off + bj * HALF + 4 * n); o[n] = xv + g[bj][n] * acc[ai][bj][m][n];
                        *(f32x4*)(xout + off + bj * HALF + 4 * n) = o[n]; s += (o[n][0] * o[n][0] + o[n][1] * o[n][1]) + (o[n][2] * o[n][2] + o[n][3] * o[n][3]); }
                    if (xg) { const f32x4 a = o[0] * gs[bj][0], b = o[1] * gs[bj][1]; u32x4 w; w.x = cvtpk(a[0], a[1]); w.y = cvtpk(a[2], a[3]); w.z = cvtpk(b[0], b[1]); w.w = cvtpk(b[2], b[3]);
                        *(u32x4*)(xg + (size_t)u.pm * BM * DM + off + bj * HALF) = w; } }
                if (xg) { s += shfl_idx(s, (fq * 16 + fr) ^ 16); s += shfl_idx(s, (fq * 16 + fr) ^ 32);
                    if (fq == 0) ssq[(size_t)(u.pm * BM + rl + ai * HALF + m * 16) * 16 + u.pn * 4 + wc] = s; } }
    }
};
struct EpiResidStaged {
    static constexpr bool PERM = true, AFTER_DRAIN = true, ROWPERM = false;
    const float* xin_lat; const float* xin_ctx; float* xout_lat; float* xout_ctx; const float* gate;
    bf16_t* xg; const float* gn; const float* scn; float* ssq;
    static constexpr int RS = 1040;
    __device__ __forceinline__ void operator()(const f32x4 (&)[2][2][4][2], const Unit&, int, int, int, int) const {}
    __device__ __forceinline__ void fused(const f32x4 (&acc)[2][2][4][2], const Unit& u, int wr, int wc, int fr, int fq, PG8_LAS unsigned char* lds, int wid, int lane) const {
        const int id = u.pm < 32 ? 0 : (u.pm < 64 ? 1 : 2);
        const float* xin = u.pm < 64 ? xin_lat + (size_t)u.pm * BM * DM : xin_ctx + (size_t)(u.pm - 64) * BM * DM;
        float* xout = u.pm < 64 ? xout_lat + (size_t)u.pm * BM * DM : xout_ctx + (size_t)(u.pm - 64) * BM * DM;
        const int colg = u.pn * BM + 4 * lane;
        const f32x4 gv = *(const f32x4*)(gate + id * 6144 + colg);
        f32x4 gsv = {0.f, 0.f, 0.f, 0.f}; if (xg) gsv = *(const f32x4*)(gn + colg) * (1.f + *(const f32x4*)(scn + id * 6144 + colg));
#pragma unroll
        for (int ai = 0; ai < 2; ++ai) {
#pragma unroll
            for (int m = 0; m < 4; ++m)
#pragma unroll
                for (int bj = 0; bj < 2; ++bj)
#pragma unroll
                    for (int n = 0; n < 2; ++n) *(PG8_LAS f32x4*)(lds + (wr * 64 + m * 16 + fr) * RS + (bj * HALF + wc * 32 + 8 * fq + 4 * n) * 4) = acc[ai][bj][m][n];
            asm volatile("s_waitcnt lgkmcnt(0)\n\ts_barrier" ::: "memory");
#pragma unroll
            for (int r8 = 0; r8 < 2; ++r8) {
                f32x4 xv[8], av[8]; float s[8];
#pragma unroll
                for (int q = 0; q < 8; ++q) { const int row = wid * 16 + r8 * 8 + q; xv[q] = *(const f32x4*)(xin + (size_t)(ai * HALF + row) * DM + colg); av[q] = *(const PG8_LAS f32x4*)(lds + row * RS + lane * 16); }
#pragma unroll
                for (int q = 0; q < 8; ++q) { const int row = wid * 16 + r8 * 8 + q; const f32x4 o = xv[q] + gv * av[q];
                    *(f32x4*)(xout + (size_t)(ai * HALF + row) * DM + colg) = o; s[q] = (o[0] * o[0] + o[1] * o[1]) + (o[2] * o[2] + o[3] * o[3]);
                    if (xg) { const f32x4 a = o * gsv; u32x2 w; w.x = cvtpk(a[0], a[1]); w.y = cvtpk(a[2], a[3]); *(u32x2*)(xg + (size_t)(u.pm * BM + ai * HALF + row) * DM + colg) = w; } }
                if (xg) {
#pragma unroll
                    for (int o_ = 1; o_ < 64; o_ <<= 1)
#pragma unroll
                        for (int q = 0; q < 8; ++q) s[q] += shfl_x(s[q], o_, lane);
                    float sv = s[0];
#pragma unroll
                    for (int q = 1; q < 8; ++q) sv = lane == q ? s[q] : sv;
                    if (lane < 8) *(f32x4*)(ssq + (size_t)(u.pm * BM + ai * HALF + wid * 16 + r8 * 8 + lane) * 16 + u.pn * 4) = (f32x4){sv, 0.f, 0.f, 0.f}; }
            }
            asm volatile("s_waitcnt lgkmcnt(0)\n\ts_barrier" ::: "memory");
        }
    }
};
struct EpiUp {
    static constexpr bool PERM = true, AFTER_DRAIN = false, ROWPERM = true;
    bf16_t* act; const float* convw; const float* convb; float* edge; const LAS float* rtab; const float* bias;
    __device__ __forceinline__ void operator()(f32x4 (&acc)[2][2][4][2], const Unit& u, int wr, int wc, int fr, int fq) const {
        asm volatile("" : "+v"(fr), "+v"(fq));
        const int chb = u.pn * 128 + wc * 32 + 8 * fq;
        const int ht = 2 * u.pm + wr;
        {
            const f32x4 ra = *(const LAS f32x4*)(rtab + u.ui * 256 + (wr * 16 + fr) * 8), rb = *(const LAS f32x4*)(rtab + u.ui * 256 + (wr * 16 + fr) * 8 + 4);
            const float rs[8] = {ra[0], ra[1], ra[2], ra[3], rb[0], rb[1], rb[2], rb[3]};
            const int id = u.pm < 32 ? 0 : (u.pm < 64 ? 1 : 2);
#pragma unroll
            for (int bj = 0; bj < 2; ++bj)
#pragma unroll
                for (int n = 0; n < 2; ++n) { const f32x4 bv = *(const f32x4*)(bias + id * DFF2 + bj * DFF + chb + 4 * n);
#pragma unroll
                    for (int sl = 0; sl < 8; ++sl) { acc[sl >> 2][bj][sl & 3][n] = acc[sl >> 2][bj][sl & 3][n] * rs[sl] + bv; asm volatile("" : "+v"(acc[sl >> 2][bj][sl & 3][n])); } }
        }
        const int lm1 = (fq * 16 + fr - 1) & 63, lp1 = (fq * 16 + fr + 1) & 63;
#pragma unroll
        for (int bj = 0; bj < 2; ++bj)
#pragma unroll
            for (int n = 0; n < 2; ++n) {
                const int uc = bj * DFF + chb + 4 * n;
                if (fr == 0) { *(f32x4*)(edge + ((size_t)ht * 4 + 0) * DFF2 + uc) = acc[0][bj][0][n]; *(f32x4*)(edge + ((size_t)ht * 4 + 1) * DFF2 + uc) = acc[0][bj][1][n]; }
                if (fr == 15) { *(f32x4*)(edge + ((size_t)ht * 4 + 2) * DFF2 + uc) = acc[1][bj][2][n]; *(f32x4*)(edge + ((size_t)ht * 4 + 3) * DFF2 + uc) = acc[1][bj][3][n]; }
#pragma unroll
                for (int j = 0; j < 4; ++j) {
                    const float w0 = convw[uc + j], w1 = convw[DFF2 + uc + j], w2 = convw[2 * DFF2 + uc + j], bb = convb[uc + j];
                    float pv = shfl_idx(acc[1][bj][3][n][j], lm1); const float nx = shfl_idx(acc[0][bj][0][n][j], lp1);
#pragma unroll
                    for (int sl = 0; sl < 8; ++sl) { const float cur = acc[sl >> 2][bj][sl & 3][n][j]; const float nxt = sl < 7 ? acc[(sl + 1) >> 2][bj][(sl + 1) & 3][n][j] : nx;
                        acc[sl >> 2][bj][sl & 3][n][j] = w0 * pv + w1 * cur + w2 * nxt + bb; pv = cur; }
                }
#pragma unroll
                for (int sl = 0; sl < 8; ++sl) asm volatile("" : "+v"(acc[sl >> 2][bj][sl & 3][n]));
            }
        bf16_t* base = act + (size_t)(u.pm * BM + (wr * 16 + fr) * 8) * DFF + chb;
#pragma unroll
        for (int sl = 0; sl < 8; ++sl) {
            const f32x4 g0 = acc[sl >> 2][0][sl & 3][0], g1 = acc[sl >> 2][0][sl & 3][1], v0 = acc[sl >> 2][1][sl & 3][0], v1 = acc[sl >> 2][1][sl & 3][1];
            f32x4 o0, o1;
#pragma unroll
            for (int j = 0; j < 4; ++j) { o0[j] = g0[j] * __builtin_amdgcn_rcpf(1.f + __builtin_amdgcn_exp2f(-LOG2E * g0[j])) * v0[j]; o1[j] = g1[j] * __builtin_amdgcn_rcpf(1.f + __builtin_amdgcn_exp2f(-LOG2E * g1[j])) * v1[j]; }
            u32x4 w; w.x = cvtpk(o0[0], o0[1]); w.y = cvtpk(o0[2], o0[3]); w.z = cvtpk(o1[0], o1[1]); w.w = cvtpk(o1[2], o1[3]);
            const bool skip = (fr == 0 && sl == 0) || (fr == 15 && sl == 7);
            if (!skip) *(u32x4*)(base + (size_t)sl * DFF) = w;
        }
    }
};
template <class Epi, class Sched, bool ALIGN_EPI = false, bool SP2 = false>
__device__ __forceinline__ void gemm_phase(PG8_LAS unsigned char* lds, const Gemm g, const Sched& S, const Epi& E, const int tid) {
    const int wid = __builtin_amdgcn_readfirstlane(tid >> 6), lane = tid & 63, wr = wid >> 2, wc = wid & 3, fr = lane & 15, fq = lane >> 4;
    const int K = g.K, nt = K / BK;
    unsigned voffA[2], voffB[2];
#pragma unroll
    for (int i = 0; i < 2; ++i) { int R, C; stage_rc(tid * 16 + i * 8192, R, C); const int Rb = Epi::PERM ? ((R & ~31) + perm32(R & 31)) : R;
        const int Ra = Epi::ROWPERM ? (((((R >> 6) & 1) * 16 + (R & 15)) << 3) + ((R >> 4) & 3)) : R;
        voffA[i] = (unsigned)(Ra * K + C) * 2u; voffB[i] = (unsigned)(Rb * K + C) * 2u; }
    const size_t kstep = (size_t)(BK * 2);
    const size_t hstep = (size_t)HALF * K * 2;
    const size_t hstepA = Epi::ROWPERM ? (size_t)4 * K * 2 : hstep;
    const size_t tstep = 2 * hstep;
    const unsigned ldsw = (unsigned)wid * 1024u;
    const int aoff = lds_byte(wr * 64 + fr, fq * 8), boff = lds_byte(wc * 32 + fr, fq * 8);
#define PG8_SA(b, h) (((b) * 2 + (h)) * HTB)
#define PG8_SB(b, h) ((4 + (b) * 2 + (h)) * HTB)
#define PG8_STAGE(bufoff, gbase, voff) do { _Pragma("unroll") for (int _i = 0; _i < 2; ++_i) \
        __builtin_amdgcn_global_load_lds((const unsigned*)((const char*)(gbase) + (voff)[_i]), (PG8_LAS unsigned*)(lds + (bufoff) + ldsw + _i * 8192), 16, 0, 0); } while (0)
#define PG8_LDA(dst, b, h) do { _Pragma("unroll") for (int m = 0; m < 4; ++m) _Pragma("unroll") for (int k = 0; k < 2; ++k) dst[m][k] = *(const PG8_LAS bf16x8*)(lds + PG8_SA(b, h) + aoff + m * 2048 + k * 1024); } while (0)
#define PG8_LDB(dst, b, h) do { _Pragma("unroll") for (int n = 0; n < 2; ++n) _Pragma("unroll") for (int k = 0; k < 2; ++k) dst[n][k] = *(const PG8_LAS bf16x8*)(lds + PG8_SB(b, h) + boff + n * 2048 + k * 1024); } while (0)
#define PG8_MMA(ai, bj, At, Bt) do { __builtin_amdgcn_s_setprio(1); _Pragma("unroll") for (int m = 0; m < 4; ++m) _Pragma("unroll") for (int n = 0; n < 2; ++n) _Pragma("unroll") for (int k = 0; k < 2; ++k) \
        acc[ai][bj][m][n] = __builtin_amdgcn_mfma_f32_16x16x32_bf16(Bt[n][k], At[m][k], acc[ai][bj][m][n], 0, 0, 0); __builtin_amdgcn_s_setprio(0); } while (0)
#define PG8_WAIT_V(n) asm volatile("s_waitcnt vmcnt(" #n ")" ::: "memory")
#define PG8_WAIT_L(n) asm volatile("s_waitcnt lgkmcnt(" #n ")" ::: "memory")
#define PG8_BAR __builtin_amdgcn_s_barrier()
#define PG8_SCHED __builtin_amdgcn_sched_barrier(0)
    Unit cur, nxt; int ui = 0;
    if (!S.next(0, cur)) return;
    f32x4 acc[2][2][4][2];
#pragma unroll
    for (int a = 0; a < 2; ++a)
#pragma unroll
        for (int b = 0; b < 2; ++b)
#pragma unroll
            for (int m = 0; m < 4; ++m)
#pragma unroll
                for (int n = 0; n < 2; ++n) acc[a][b][m][n] = (f32x4){0.f, 0.f, 0.f, 0.f};
    bf16x8 At[4][2], B0[2][2], B1[2][2];
    const char* cA = (const char*)g.A + (size_t)cur.pm * tstep; const char* cB = (const char*)g.Bt + (size_t)cur.pn * tstep;
    S.a_ready(cur);
    if constexpr (SP2) {
        PG8_STAGE(PG8_SB(0, 0), cB, voffB); PG8_STAGE(PG8_SB(0, 1), cB + hstep, voffB); PG8_STAGE(PG8_SA(0, 0), cA, voffA); PG8_STAGE(PG8_SA(0, 1), cA + hstepA, voffA);
        if (wr == 1) PG8_BAR;
        PG8_WAIT_V(2); PG8_BAR;
        PG8_STAGE(PG8_SB(1, 0), cB + kstep, voffB); PG8_STAGE(PG8_SA(1, 0), cA + kstep, voffA); PG8_STAGE(PG8_SB(1, 1), cB + hstep + kstep, voffB);
        PG8_WAIT_V(6); PG8_BAR;
    } else {
        PG8_STAGE(PG8_SB(0, 0), cB, voffB); PG8_STAGE(PG8_SA(0, 0), cA, voffA); PG8_STAGE(PG8_SB(0, 1), cB + hstep, voffB); PG8_STAGE(PG8_SA(0, 1), cA + hstepA, voffA);
        if (wr == 1) PG8_BAR;
        PG8_WAIT_V(4); PG8_BAR;
        PG8_STAGE(PG8_SB(1, 0), cB + kstep, voffB); PG8_STAGE(PG8_SA(1, 0), cA + kstep, voffA); PG8_STAGE(PG8_SB(1, 1), cB + hstep + kstep, voffB);
        PG8_WAIT_V(6); PG8_BAR;
    }
    PROBE_PT(lds, 1);
    for (;;) {
        const bool has_next = S.next(ui + 1, nxt);
        const char* nA = has_next ? (const char*)g.A + (size_t)nxt.pm * tstep : cA; const char* nB = has_next ? (const char*)g.Bt + (size_t)nxt.pn * tstep : cB;
        for (int t = 0; t < nt; t += 2) {
            const bool last = (t == nt - 2);
            const char* a1 = cA + (size_t)(t + 1) * kstep;
            const char* a2 = last ? nA : cA + (size_t)(t + 2) * kstep; const char* b2 = last ? nB : cB + (size_t)(t + 2) * kstep;
            const char* a3 = a2 + kstep; const char* b3 = b2 + kstep;
            if (last && has_next) S.a_ready(nxt);
            if constexpr (SP2) {
            PG8_LDB(B0, 0, 0); PG8_LDB(B1, 0, 1); PG8_SCHED; PG8_LDA(At, 0, 0); PG8_STAGE(PG8_SA(1, 1), a1 + hstepA, voffA);
            PG8_WAIT_V(8); PG8_WAIT_L(0); PG8_BAR; PG8_MMA(0, 0, At, B0); PG8_MMA(0, 1, At, B1); PG8_BAR; PG8_SCHED;
            PG8_LDA(At, 0, 1); PG8_STAGE(PG8_SB(0, 0), b2, voffB); PG8_STAGE(PG8_SB(0, 1), b2 + hstep, voffB); PG8_STAGE(PG8_SA(0, 0), a2, voffA);
            PG8_WAIT_V(8); PG8_WAIT_L(0); PG8_BAR; PG8_MMA(1, 0, At, B0); PG8_MMA(1, 1, At, B1); PG8_BAR; PG8_SCHED;
            PG8_LDB(B0, 1, 0); PG8_LDB(B1, 1, 1); PG8_SCHED; PG8_LDA(At, 1, 0); PG8_STAGE(PG8_SA(0, 1), a2 + hstepA, voffA);
            PG8_WAIT_V(8); PG8_WAIT_L(0); PG8_BAR; PG8_MMA(0, 0, At, B0); PG8_MMA(0, 1, At, B1); PG8_BAR; PG8_SCHED;
            PG8_LDA(At, 1, 1); PG8_STAGE(PG8_SB(1, 0), b3, voffB); PG8_STAGE(PG8_SB(1, 1), b3 + hstep, voffB); PG8_STAGE(PG8_SA(1, 0), a3, voffA);
            PG8_WAIT_V(8); PG8_WAIT_L(0); PG8_BAR; PG8_MMA(1, 0, At, B0); PG8_MMA(1, 1, At, B1); PG8_BAR; PG8_SCHED;
            } else {
            PG8_LDB(B0, 0, 0); PG8_SCHED; PG8_LDA(At, 0, 0); PG8_STAGE(PG8_SA(1, 1), a1 + hstepA, voffA);
            PG8_WAIT_L(8); PG8_BAR; PG8_WAIT_L(0); PG8_MMA(0, 0, At, B0); PG8_BAR; PG8_SCHED;
            PG8_LDB(B1, 0, 1); PG8_STAGE(PG8_SB(0, 0), b2, voffB);
            PG8_BAR; PG8_WAIT_L(0); PG8_MMA(0, 1, At, B1); PG8_BAR;
            PG8_LDA(At, 0, 1); PG8_STAGE(PG8_SA(0, 0), a2, voffA);
            PG8_BAR; PG8_WAIT_L(0); PG8_MMA(1, 0, At, B0); PG8_BAR; PG8_SCHED;
            PG8_STAGE(PG8_SB(0, 1), b2 + hstep, voffB);
            PG8_WAIT_V(6); PG8_BAR; PG8_MMA(1, 1, At, B1); PG8_BAR;
            PG8_LDB(B0, 1, 0); PG8_SCHED; PG8_LDA(At, 1, 0); PG8_STAGE(PG8_SA(0, 1), a2 + hstepA, voffA);
            PG8_WAIT_L(8); PG8_BAR; PG8_WAIT_L(0); PG8_MMA(0, 0, At, B0); PG8_BAR; PG8_SCHED;
            PG8_LDB(B1, 1, 1); PG8_STAGE(PG8_SB(1, 0), b3, voffB);
            PG8_BAR; PG8_WAIT_L(0); PG8_MMA(0, 1, At, B1); PG8_BAR;
            PG8_LDA(At, 1, 1); PG8_STAGE(PG8_SA(1, 0), a3, voffA);
            PG8_BAR; PG8_WAIT_L(0); PG8_MMA(1, 0, At, B0); PG8_BAR; PG8_SCHED;
            PG8_STAGE(PG8_SB(1, 1), b3 + hstep, voffB);
            PG8_WAIT_V(6); PG8_BAR; PG8_MMA(1, 1, At, B1); PG8_BAR;
            }
        }
        PROBE_PT(lds, 2);
        if constexpr (ALIGN_EPI) { if (wr == 0) PG8_BAR; }
        if constexpr (!Epi::AFTER_DRAIN) { E(acc, cur, wr, wc, fr, fq); S.done(cur); }
        PROBE_PT(lds, 3);
        if (!has_next) break;
#pragma unroll
        for (int a = 0; a < 2; ++a)
#pragma unroll
            for (int b = 0; b < 2; ++b)
#pragma unroll
                for (int m = 0; m < 4; ++m)
#pragma unroll
                    for (int n = 0; n < 2; ++n) acc[a][b][m][n] = (f32x4){0.f, 0.f, 0.f, 0.f};
        cur = nxt; cA = nA; cB = nB; ++ui;
        if constexpr (ALIGN_EPI) { if (wr == 1) PG8_BAR; }
    }
    PG8_WAIT_V(0);
    if constexpr (!ALIGN_EPI) { if (wr == 0) PG8_BAR; }
    PG8_BAR;
    if constexpr (Epi::AFTER_DRAIN) { E.fused(acc, cur, wr, wc, fr, fq, lds, wid, lane); S.done(cur); }
#undef PG8_SA
#undef PG8_SB
#undef PG8_STAGE
#undef PG8_LDA
#undef PG8_LDB
#undef PG8_MMA
#undef PG8_WAIT_V
#undef PG8_WAIT_L
#undef PG8_BAR
#undef PG8_SCHED
}
}

constexpr size_t WS_WGB = WS_WG + 192 * 1024;
constexpr size_t WS_MODP = 235 * MiB;
constexpr int NWAVES = 8, NTHREADS = 512;
constexpr int LDSCTL_OFF = 155648;
constexpr int LDS_BYTES = LDSCTL_OFF + 256;
struct Args {
    const float* in[21]; float* out; unsigned char* ws; int ph_lo, ph_hi;
};
struct Frame {
    LAS unsigned char* lds;
    int tid, lane, wave, G, bid;
    const __attribute__((address_space(4))) Args* ka;
    float* out; unsigned char* ws;
};
enum { IN_X = 0, IN_C, IN_CTX, IN_CCTX, IN_WMOD, IN_BMOD, IN_G1, IN_G2, IN_WIN, IN_AQG, IN_AKG, IN_SINK, IN_CGB, IN_RPB, IN_GGRP, IN_WOUT, IN_WUP, IN_CONVW, IN_CONVB, IN_WDN, IN_GFIN };

struct TItem { const float* W; bf16_t* WT; int K, N, kind, item; };
__device__ __forceinline__ int tmap(int kind, int n) {
    if (kind == 0) { if (n < 1024) { const int d = n & 63, hh = (n >> 6) & 3; return (n & ~255) + 128 * (d >> 5) + 32 * hh + 8 * ((d & 15) >> 2) + 4 * ((d >> 4) & 1) + (d & 3); }
                     return n < 2048 ? n : (n < 2064 ? -1 : n - 16); }
    if (kind == 2) { const int m = n < DFF ? n : n - DFF; return (m >> 7) * 256 + (n < DFF ? 0 : 128) + (m & 127); }
    return n;
}
__device__ __forceinline__ void tload(const TItem& t, int lane, f32x4 (&v)[16]) {
    const int nblk = (t.N + 63) / 64, kb = t.item / nblk, nb = t.item % nblk, k0 = 64 * kb, nc = 64 * nb + 4 * (lane & 15);
#pragma unroll
    for (int i = 0; i < 16; ++i) { const int kk = (lane >> 4) + 4 * i; v[i] = nc < t.N ? *(const f32x4*)(t.W + (size_t)(k0 + kk) * t.N + nc) : (f32x4){0.f, 0.f, 0.f, 0.f}; }
}
__device__ __forceinline__ void tproc(const TItem& t, LAS float* scr, int lane, const f32x4 (&v)[16]) {
    const int nblk = (t.N + 63) / 64, kb = t.item / nblk, nb = t.item % nblk, k0 = 64 * kb, n0 = 64 * nb;
#pragma unroll
    for (int i = 0; i < 16; ++i) { const int kk = (lane >> 4) + 4 * i; LAS float* d = scr + kk * 65 + 4 * (lane & 15); d[0] = v[i][0]; d[1] = v[i][1]; d[2] = v[i][2]; d[3] = v[i][3]; }
    LDS_WAIT(); asm volatile("" ::: "memory");
    const int c = lane & 7;
#pragma unroll
    for (int j = 0; j < 8; ++j) { const int n = (lane >> 3) + 8 * j; const LAS float* s = scr + (8 * c) * 65 + n;
        u32x4 o; o.x = cvtpk(s[0 * 65], s[1 * 65]); o.y = cvtpk(s[2 * 65], s[3 * 65]); o.z = cvtpk(s[4 * 65], s[5 * 65]); o.w = cvtpk(s[6 * 65], s[7 * 65]);
        const int sc = n0 + n; const int dr = sc < t.N ? tmap(t.kind, sc) : -1;
        if (dr >= 0) *(u32x4*)(t.WT + (size_t)dr * t.K + k0 + 8 * c) = o; }
    LDS_WAIT(); asm volatile("" ::: "memory");
}
__device__ __forceinline__ void p0_prologue(Frame& F) {
    const float* c = F.ka->in[IN_C]; const float* cctx = F.ka->in[IN_CCTX];
    const int gw = F.bid * NWAVES + F.wave, NGW = F.G * NWAVES;
    if (F.bid < NLAYER * 48 || F.G < NLAYER * 48 + 8) {
        LAS float* sv = (LAS float*)F.lds;
        LAS float* red = (LAS float*)(F.lds + 12288);
        for (int i = F.tid; i < 3 * 1024; i += NTHREADS) { const int id = i >> 10, k = i & 1023; const float v = id < 2 ? c[id * 1024 + k] : cctx[k]; sv[i] = v / (1.f + __expf(-v)); }
        __syncthreads();
        float* MOD = (float*)(F.ws + WS_MOD);
        for (int it = F.bid; it < NLAYER * 48; it += F.G) {
            const int l = it / 48, nb = it % 48, n = nb * 128 + 2 * F.lane;
            const float* w = F.ka->in[IN_WMOD] + ((size_t)l * 1024 + F.wave * 128) * 6144 + n;
            f32x2 a0 = {0.f, 0.f}, a1 = {0.f, 0.f}, a2 = {0.f, 0.f};
#pragma unroll 32
            for (int k = 0; k < 128; ++k) { const f32x2 wv = *(const f32x2*)(w + (size_t)k * 6144); const int kk = F.wave * 128 + k; a0 += sv[kk] * wv; a1 += sv[1024 + kk] * wv; a2 += sv[2048 + kk] * wv; }
            *(LAS f32x2*)(red + (F.wave * 3 + 0) * 128 + 2 * F.lane) = a0; *(LAS f32x2*)(red + (F.wave * 3 + 1) * 128 + 2 * F.lane) = a1; *(LAS f32x2*)(red + (F.wave * 3 + 2) * 128 + 2 * F.lane) = a2;
            __syncthreads();
            if (F.tid < 384) { const int id = F.tid >> 7, ln = F.tid & 127; float s = F.ka->in[IN_BMOD][l * 6144 + nb * 128 + ln];
#pragma unroll
                for (int w8 = 0; w8 < 8; ++w8) s += red[(w8 * 3 + id) * 128 + ln];
                MOD[((size_t)l * 3 + id) * 6144 + nb * 128 + ln] = s; }
            __syncthreads();
        }
    }
    PROBE_PT(F.lds, 1);
    { const int b0 = F.G >= NLAYER * 48 + 8 ? NLAYER * 48 : 0, nb_ = F.G - b0;
      if (F.bid >= b0) { const int gt2 = (F.bid - b0) * NTHREADS + F.tid, NGT2 = nb_ * NTHREADS;
        float* ROPE = (float*)(F.ws + WS_ROPE); float* WG = (float*)(F.ws + WS_WG); bf16_t* WGB = (bf16_t*)(F.ws + WS_WGB);
        for (int e = gt2; e < 192 * 16 + NLAYER * 16 * 1024; e += NGT2) {
            if (e < 192 * 16) { const int idx = e >> 4, i = e & 15; const float pos = (float)(idx < 128 ? idx : idx - 128);
                const float freq = powf(10000.0f, -(float)i / 16.0f); const float ang = pos * freq; ROPE[2 * e] = cosf(ang); ROPE[2 * e + 1] = sinf(ang); }
            else { const int e2 = e - 192 * 16, l = e2 >> 14, o = (e2 >> 10) & 15, k = e2 & 1023; const float v = F.ka->in[IN_WIN][((size_t)l * 1024 + k) * DIN + 2048 + o]; WG[e2] = v; WGB[e2] = (bf16_t)(cvtpk(v, 0.f) & 0xffffu); } } } }
    PROBE_PT(F.lds, 2);
    LAS float* scr = (LAS float*)(F.lds + F.wave * 16896);
    constexpr int I_IN = 16 * 45, I_OUT = 16 * 16, I_UP = 16 * 88, I_DN = 44 * 16, I_L = I_IN + I_OUT + I_UP + I_DN;
    auto decode = [&](int it) { TItem t; const int l = it / I_L; int r = it % I_L;
        if (r < I_IN) { t.W = F.ka->in[IN_WIN] + (size_t)l * 1024 * DIN; t.WT = (bf16_t*)(F.ws + WS_WIN) + (size_t)l * PP * 1024; t.K = 1024; t.N = DIN; t.kind = 0; t.item = r; return t; } r -= I_IN;
        if (r < I_OUT) { t.W = F.ka->in[IN_WOUT] + (size_t)l * 1024 * 1024; t.WT = (bf16_t*)(F.ws + WS_WOUT) + (size_t)l * 1024 * 1024; t.K = 1024; t.N = 1024; t.kind = 1; t.item = r; return t; } r -= I_OUT;
        if (r < I_UP) { t.W = F.ka->in[IN_WUP] + (size_t)l * 1024 * DFF2; t.WT = (bf16_t*)(F.ws + WS_WUP) + (size_t)l * DFF2 * 1024; t.K = 1024; t.N = DFF2; t.kind = 2; t.item = r; return t; } r -= I_UP;
        t.W = F.ka->in[IN_WDN] + (size_t)l * DFF * 1024; t.WT = (bf16_t*)(F.ws + WS_WDN) + (size_t)l * 1024 * DFF; t.K = DFF; t.N = 1024; t.kind = 1; t.item = r; return t; };
    constexpr int NIT = NLAYER * I_L;
    int it = gw;
    if (it < NIT) { TItem ta = decode(it), tb = ta; f32x4 va[16], vb[16]; tload(ta, F.lane, va);
        for (;;) {
            const int i1 = it + NGW; if (i1 < NIT) { tb = decode(i1); tload(tb, F.lane, vb); }
            tproc(ta, scr, F.lane, va); if (i1 >= NIT) break;
            const int i2 = i1 + NGW; if (i2 < NIT) { ta = decode(i2); tload(ta, F.lane, va); }
            tproc(tb, scr, F.lane, vb); if (i2 >= NIT) break;
            it = i2; } }
}

template <int R>
__device__ __forceinline__ void norm_rows(Frame& F, const float* xbase, int row0, const float* sh, const float* sc, const f32x4 (&gv)[4]) {
    bf16_t* H = (bf16_t*)(F.ws + WS_H);
    f32x4 hv[R][4]; float ss[R];
#pragma unroll
    for (int r = 0; r < R; ++r)
#pragma unroll
        for (int j = 0; j < 4; ++j) hv[r][j] = *(const f32x4*)(xbase + (size_t)r * DM + 4 * F.lane + 256 * j);
#pragma unroll
    for (int r = 0; r < R; ++r) { float s = 0.f;
#pragma unroll
        for (int j = 0; j < 4; ++j) s += (hv[r][j][0] * hv[r][j][0] + hv[r][j][1] * hv[r][j][1]) + (hv[r][j][2] * hv[r][j][2] + hv[r][j][3] * hv[r][j][3]);
        ss[r] = s; }
#pragma unroll
    for (int o = 1; o < 64; o <<= 1)
#pragma unroll
        for (int r = 0; r < R; ++r) ss[r] += shfl_x(ss[r], o, F.lane);
#pragma unroll
    for (int j = 0; j < 4; ++j) { const f32x4 scv = 1.f + *(const f32x4*)(sc + 4 * F.lane + 256 * j), shv = *(const f32x4*)(sh + 4 * F.lane + 256 * j);
#pragma unroll
        for (int r = 0; r < R; ++r) { const f32x4 v = hv[r][j] * rsqrtf(ss[r] * (1.f / DM) + EPS) * gv[j] * scv + shv;
            u32x2 w; w.x = cvtpk(v[0], v[1]); w.y = cvtpk(v[2], v[3]);
            *(u32x2*)(H + (size_t)(row0 + r) * DM + 4 * F.lane + 256 * j) = w; } }
}
__device__ __forceinline__ void norm_phase(Frame& F, int layer) {
    const int gw = F.bid * NWAVES + F.wave, NGW = F.G * NWAVES;
    const float* gvec = F.ka->in[IN_G1] + layer * 1024;
    const float* mod = (const float*)(F.ws + WS_MOD) + (size_t)layer * 3 * 6144;
    const float* xl = F.ka->in[IN_X]; const float* xc = F.ka->in[IN_CTX];
    f32x4 gv[4];
#pragma unroll
    for (int j = 0; j < 4; ++j) gv[j] = *(const f32x4*)(gvec + 4 * F.lane + 256 * j);
    for (int rg = gw; rg < NLAT / 8; rg += NGW) { const int row0 = rg * 8, id = row0 < SEQ ? 0 : 1; norm_rows<8>(F, xl + (size_t)row0 * DM, row0, mod + id * 6144, mod + id * 6144 + 1024, gv); }
    for (int rg = gw; rg < NBATCH * CTXL / 2; rg += NGW) { const int row0 = rg * 2; norm_rows<2>(F, xc + (size_t)row0 * DM, NLAT + row0, mod + 2 * 6144, mod + 2 * 6144 + 1024, gv); }
}

constexpr size_t WS_BIASG = WS_BIASIN + 64 * 1024;
__device__ __forceinline__ void bias_phase(Frame& F, int bslot, int nslots) {
    if (bslot < 0 && nslots > 0) return;
    if (nslots <= 0) { bslot = F.bid; nslots = F.G; }
    const int gw = bslot * NWAVES + F.wave, NGW = nslots * NWAVES, lane = F.lane, fr = lane & 15, fq = lane >> 4;
    const float* MOD = (const float*)(F.ws + WS_MOD);
    float* BUP = (float*)(F.ws + WS_BIASUP); float* BIN = (float*)(F.ws + WS_BIASIN); float* BG = (float*)(F.ws + WS_BIASG);
    constexpr int J_UP = DFF2 / 16, J_IN = PP / 16;
    for (int job = gw; job < 2 * J_UP + J_IN + 1; job += NGW) {
        const bool isup = job < 2 * J_UP, isin = !isup && job < 2 * J_UP + J_IN; const int l = isup ? job / J_UP : 1, r0 = 16 * (isup ? job % J_UP : (isin ? job - 2 * J_UP : 0));
        const bf16_t* wrow = isup ? (const bf16_t*)(F.ws + WS_WUP) + ((size_t)l * DFF2 + r0 + fr) * 1024 : (isin ? (const bf16_t*)(F.ws + WS_WIN) + ((size_t)PP + r0 + fr) * 1024 : (const bf16_t*)(F.ws + WS_WGB) + (size_t)(16 + fr) * 1024);
        const float* sh = MOD + ((size_t)l * 3 + (fr < 3 ? fr : 0)) * 6144 + (isup ? 3 * 1024 : 0) + 8 * fq;
        const bf16_t* bp = wrow + 8 * fq;
        f32x4 acc = {0.f, 0.f, 0.f, 0.f};
        for (int k0 = 0; k0 < DM / 32; k0 += 8) { f32x4 a0[8], a1[8]; bf16x8 bv[8];
#pragma unroll
            for (int j = 0; j < 8; ++j) { a0[j] = *(const f32x4*)(sh + 32 * (k0 + j)); a1[j] = *(const f32x4*)(sh + 32 * (k0 + j) + 4); bv[j] = *(const bf16x8*)(bp + 32 * (k0 + j)); }
#pragma unroll
            for (int j = 0; j < 8; ++j) { u32x4 aw; aw.x = cvtpk(a0[j][0], a0[j][1]); aw.y = cvtpk(a0[j][2], a0[j][3]); aw.z = cvtpk(a1[j][0], a1[j][1]); aw.w = cvtpk(a1[j][2], a1[j][3]);
                acc = __builtin_amdgcn_mfma_f32_16x16x32_bf16(__builtin_bit_cast(bf16x8, aw), bv[j], acc, 0, 0, 0); } }
        if (fq == 0) { const int r = r0 + fr;
            if (isup) { const int pn = r >> 8, i = r & 255; const int uc = i < 128 ? pn * 128 + i : DFF + pn * 128 + (i - 128);
                BUP[((size_t)l * 3 + 0) * DFF2 + uc] = acc[0]; BUP[((size_t)l * 3 + 1) * DFF2 + uc] = acc[1]; BUP[((size_t)l * 3 + 2) * DFF2 + uc] = acc[2]; }
            else if (isin) { BIN[r] = acc[0]; BIN[PP + r] = acc[1]; BIN[2 * PP + r] = acc[2]; }
            else { BG[fr] = acc[0]; BG[16 + fr] = acc[1]; BG[32 + fr] = acc[2]; } }
    }
}
__device__ __forceinline__ void gates_phase(Frame& F, int layer) {
    const int gw = F.bid * NWAVES + F.wave, NGW = F.G * NWAVES, lane = F.lane, fr = lane & 15, fq = lane >> 4;
    const bf16_t* H = (const bf16_t*)(F.ws + WS_H); const float* SSQ = (const float*)(F.ws + WS_SSQ1); const float* SSQC = (const float*)(F.ws + WS_SSQC1);
    const bf16_t* WGB = (const bf16_t*)(F.ws + WS_WGB) + (size_t)layer * 16 * 1024; const float* BG = (const float*)(F.ws + WS_BIASG);
    float* GATES = (float*)(F.ws + WS_GATES);
    for (int job = gw; job < NROWS / 16; job += NGW) {
        const int r0 = 16 * job; const int id = r0 < SEQ ? 0 : (r0 < NLAT ? 1 : 2);
        const bf16_t* ap = H + (size_t)(r0 + fr) * DM + 8 * fq; const bf16_t* bp = WGB + (size_t)fr * DM + 8 * fq;
        f32x4 acc = {0.f, 0.f, 0.f, 0.f};
        for (int k0 = 0; k0 < DM / 32; k0 += 16) { bf16x8 av[16], bv[16];
#pragma unroll
            for (int j = 0; j < 16; ++j) { av[j] = *(const bf16x8*)(ap + 32 * (k0 + j)); bv[j] = *(const bf16x8*)(bp + 32 * (k0 + j)); }
#pragma unroll
            for (int j = 0; j < 16; ++j) acc = __builtin_amdgcn_mfma_f32_16x16x32_bf16(av[j], bv[j], acc, 0, 0, 0); }
        float rs[4] = {1.f, 1.f, 1.f, 1.f}, bo = 0.f;
        if (layer > 0) {
            float s = 0.f;
            if (r0 < NLAT) { const f32x4 a = *(const f32x4*)(SSQ + (size_t)(r0 + (lane >> 2)) * 16 + 4 * (lane & 3)); s = (a[0] + a[1]) + (a[2] + a[3]); }
            else { const float* p = SSQC + (size_t)(r0 - NLAT + (lane >> 2)) * 64 + 16 * (lane & 3);
#pragma unroll
                for (int j = 0; j < 4; ++j) { const f32x4 a = *(const f32x4*)(p + 4 * j); s += (a[0] + a[1]) + (a[2] + a[3]); } }
            s += shfl_x(s, 1, lane); s += shfl_x(s, 2, lane);
            const float rr = rsqrtf(s * (1.f / DM) + EPS);
#pragma unroll
            for (int r = 0; r < 4; ++r) rs[r] = shfl_idx(rr, 4 * (4 * fq + r));
            bo = BG[id * 16 + fr];
        }
#pragma unroll
        for (int r = 0; r < 4; ++r) GATES[(size_t)(r0 + 4 * fq + r) * 16 + fr] = acc[r] * rs[r] + bo;
    }
}

__device__ __forceinline__ void postproj_phase(Frame& F, int layer) {
    const int gw = F.bid * NWAVES + F.wave, NGW = F.G * NWAVES;
    bf16_t* PROJ = (bf16_t*)(F.ws + WS_PROJ);
    const float* ROPE = (const float*)(F.ws + WS_ROPE);
    const int sub = F.lane >> 4, l16 = F.lane & 15, d = 4 * l16;
    const f32x4 gq = *(const f32x4*)(F.ka->in[IN_AQG] + layer * 64 + d), gk = *(const f32x4*)(F.ka->in[IN_AKG] + layer * 64 + d);
    const bool x2 = (l16 & 4) != 0;
    for (int rg = gw; rg < NROWS / 4; rg += NGW) {
        const int row0 = 4 * rg; const bool lat = row0 < NLAT;
        u32x2 w[4][3]; f32x4 cs0[4], cs1[4];
#pragma unroll
        for (int q = 0; q < 4; ++q) { const bf16_t* pr = PROJ + (size_t)(row0 + q) * PP; const int t = (row0 + q) & (SEQ - 1);
            cs0[q] = (f32x4){1.f, 0.f, 1.f, 0.f}; cs1[q] = cs0[q];
            if (lat) { const int idx = (d >> 5) ? 128 + (t & 63) : (t >> 6); const float* rp = ROPE + ((size_t)idx * 16 + (d & 15)) * 2; cs0[q] = *(const f32x4*)rp; cs1[q] = *(const f32x4*)(rp + 4); }
#pragma unroll
            for (int pass = 0; pass < 3; ++pass) { const int col = pass == 0 ? PC_AQ + 64 * sub + d : (pass == 1 ? (sub < 2 ? PC_AK + 64 * sub + d : PC_BK + 64 * (sub - 2) + d) : PC_BQ + 64 * sub + d);
                w[q][pass] = *(const u32x2*)(pr + col); } }
#pragma unroll
        for (int q = 0; q < 4; ++q) { bf16_t* pr = PROJ + (size_t)(row0 + q) * PP;
            const float cz[4] = {cs0[q][0], cs0[q][2], cs1[q][0], cs1[q][2]}, sz[4] = {cs0[q][1], cs0[q][3], cs1[q][1], cs1[q][3]};
#pragma unroll
            for (int pass = 0; pass < 3; ++pass) {
                const int col = pass == 0 ? PC_AQ + 64 * sub + d : (pass == 1 ? (sub < 2 ? PC_AK + 64 * sub + d : PC_BK + 64 * (sub - 2) + d) : PC_BQ + 64 * sub + d);
                const bool donorm = pass == 0 || (pass == 1 && sub < 2);
                const bool active = lat || donorm;
                if (!lat && pass == 2) continue;
                float v[4] = {bflo(w[q][pass].x), bfhi(w[q][pass].x), bflo(w[q][pass].y), bfhi(w[q][pass].y)};
                float ss = (v[0] * v[0] + v[1] * v[1]) + (v[2] * v[2] + v[3] * v[3]);
                ss += shfl_x(ss, 1, F.lane); ss += shfl_x(ss, 2, F.lane); ss += shfl_x(ss, 4, F.lane); ss += shfl_x(ss, 8, F.lane);
                if (donorm) { const float rstd = rsqrtf(ss * (1.f / 64.f) + EPS) * (pass == 0 ? QSCALE2 : 1.f); const f32x4 g = pass == 0 ? gq : gk;
#pragma unroll
                    for (int e = 0; e < 4; ++e) v[e] = v[e] * rstd * g[e]; }
                float o[4];
#pragma unroll
                for (int e = 0; e < 4; ++e) { const float p = shfl_x(v[e], 4, F.lane); o[e] = x2 ? (p * sz[e] + v[e] * cz[e]) : (v[e] * cz[e] - p * sz[e]); }
                if (active) { u32x2 ow; ow.x = cvtpk(o[0], o[1]); ow.y = cvtpk(o[2], o[3]); *(u32x2*)(pr + col) = ow; }
            } }
    }
}

template <bool WT = false>
__device__ __forceinline__ void groupnorm_rows(Frame& F, int layer, int row0, int nrows, int wv, int nw) {
    const bf16_t* H = (const bf16_t*)(F.ws + WS_H); bf16_t* YN = (bf16_t*)(F.ws + WS_PROJ);
    const float* gg = F.ka->in[IN_GGRP] + layer * 1024;
    f32x4 gv[4];
#pragma unroll
    for (int j = 0; j < 4; ++j) gv[j] = *(const f32x4*)(gg + 4 * F.lane + 256 * j);
    for (int r = 4 * wv; r < nrows; r += 4 * nw) {
        u32x2 w[4][4]; float ss[4][4];
#pragma unroll
        for (int q = 0; q < 4; ++q)
#pragma unroll
            for (int j = 0; j < 4; ++j) w[q][j] = *(const u32x2*)(H + (size_t)(row0 + r + q) * DM + 4 * F.lane + 256 * j);
#pragma unroll
        for (int q = 0; q < 4; ++q)
#pragma unroll
            for (int j = 0; j < 4; ++j) { const float v0 = bflo(w[q][j].x), v1 = bfhi(w[q][j].x), v2 = bflo(w[q][j].y), v3 = bfhi(w[q][j].y); ss[q][j] = (v0 * v0 + v1 * v1) + (v2 * v2 + v3 * v3); }
#pragma unroll
        for (int o = 1; o < 64; o <<= 1)
#pragma unroll
            for (int q = 0; q < 4; ++q)
#pragma unroll
                for (int j = 0; j < 4; ++j) ss[q][j] += shfl_x(ss[q][j], o, F.lane);
#pragma unroll
        for (int q = 0; q < 4; ++q)
#pragma unroll
            for (int j = 0; j < 4; ++j) { const float rstd = rsqrtf(ss[q][j] * (1.f / 256.f) + EPS);
                u32x2 o; o.x = cvtpk(bflo(w[q][j].x) * rstd * gv[j][0], bfhi(w[q][j].x) * rstd * gv[j][1]); o.y = cvtpk(bflo(w[q][j].y) * rstd * gv[j][2], bfhi(w[q][j].y) * rstd * gv[j][3]);
                if (WT) __hip_atomic_store((unsigned long long*)(YN + (size_t)(row0 + r + q) * DM + 4 * F.lane + 256 * j), (unsigned long long)o.x | ((unsigned long long)o.y << 32), __ATOMIC_RELAXED, __HIP_MEMORY_SCOPE_AGENT);
                else *(u32x2*)(YN + (size_t)(row0 + r + q) * DM + 4 * F.lane + 256 * j) = o; }
    }
}

__device__ __forceinline__ void fixup_hts(Frame& F, int layer, int ht0, int nht) {
    const float* edge = (const float*)(F.ws + WS_EDGE);
    const float* cw = F.ka->in[IN_CONVW] + (size_t)layer * 3 * DFF2; const float* cb = F.ka->in[IN_CONVB] + (size_t)layer * DFF2;
    bf16_t* act = (bf16_t*)(F.ws + WS_PROJ);
    const int per_row = DFF / 4;
    for (int it = F.tid; it < nht * 2 * per_row; it += NTHREADS) {
        const int ch = (it % per_row) * 4, rr = it / per_row, ht = ht0 + (rr >> 1), last = rr & 1;
        const bool seq_start = (ht == 0 || ht == 64 || ht == 128 || ht == 130), seq_end = (ht == 63 || ht == 127 || ht == 129 || ht == 131);
        const int row = ht * 128 + (last ? 127 : 0);
        f32x4 o;
        f32x4 res[2];
#pragma unroll
        for (int gvv = 0; gvv < 2; ++gvv) { const int uc = gvv * DFF + ch;
            const f32x4 z = {0.f, 0.f, 0.f, 0.f};
            f32x4 up, ucur, un;
            if (!last) { up = seq_start ? z : *(const f32x4*)(edge + ((size_t)(ht - 1) * 4 + 3) * DFF2 + uc); ucur = *(const f32x4*)(edge + ((size_t)ht * 4 + 0) * DFF2 + uc); un = *(const f32x4*)(edge + ((size_t)ht * 4 + 1) * DFF2 + uc); }
            else { up = *(const f32x4*)(edge + ((size_t)ht * 4 + 2) * DFF2 + uc); ucur = *(const f32x4*)(edge + ((size_t)ht * 4 + 3) * DFF2 + uc); un = seq_end ? z : *(const f32x4*)(edge + ((size_t)(ht + 1) * 4 + 0) * DFF2 + uc); }
            res[gvv] = *(const f32x4*)(cw + uc) * up + *(const f32x4*)(cw + DFF2 + uc) * ucur + *(const f32x4*)(cw + 2 * DFF2 + uc) * un + *(const f32x4*)(cb + uc); }
#pragma unroll
        for (int j = 0; j < 4; ++j) o[j] = res[0][j] / (1.f + __expf(-res[0][j])) * res[1][j];
        u32x2 w; w.x = cvtpk(o[0], o[1]); w.y = cvtpk(o[2], o[3]);
        *(u32x2*)(act + (size_t)row * DFF + ch) = w;
    }
}

template <int KDIM>
__device__ __forceinline__ void skinny_ctx(Frame& F, const bf16_t* A  , const bf16_t* Wt  , const float* xin, float* xout, const float* gate  ,
                                           bf16_t* xg  , const float* gn, const float* scn  , float* ssqc) {
    const int lane = F.lane, fr = lane & 15, fq = lane >> 4, t = F.tid, ldrow = t >> 3, chunk = t & 7;
    const int rf = F.wave >> 1, cp = F.wave & 1;
    constexpr int RSB = 144, BUFB = 64 * RSB, NKB = KDIM / 64;
    for (int p = F.bid; p < 128; p += F.G) {
        const int rg = p >> 4, cg = p & 15;
        if (KDIM == DM) { groupnorm_rows<false>(F, 0, NLAT + 64 * rg, 64, F.wave, NWAVES); VM_WAIT(); __syncthreads(); }
        const bf16_t* asrc = A + (size_t)(64 * rg + ldrow) * KDIM + 8 * chunk; const bf16_t* bsrc = Wt + (size_t)(64 * cg + ldrow) * KDIM + 8 * chunk;
        u32x4 ra[4], rb[4];
#pragma unroll
        for (int i = 0; i < 4; ++i) { ra[i] = *(const u32x4*)(asrc + 64 * i); rb[i] = *(const u32x4*)(bsrc + 64 * i); }
        f32x4 acc[2] = {{0.f, 0.f, 0.f, 0.f}, {0.f, 0.f, 0.f, 0.f}};
        __syncthreads();
        for (int kb0 = 0; kb0 < NKB; kb0 += 4) {
#pragma unroll
            for (int i = 0; i < 4; ++i) { const int kb = kb0 + i; LAS unsigned char* ba = F.lds + (kb & 1) * 2 * BUFB; LAS unsigned char* bb = ba + BUFB;
                *(LAS u32x4*)(ba + ldrow * RSB + 16 * chunk) = ra[i]; *(LAS u32x4*)(bb + ldrow * RSB + 16 * chunk) = rb[i];
                if (kb + 4 < NKB) { ra[i] = *(const u32x4*)(asrc + 64 * (kb + 4)); rb[i] = *(const u32x4*)(bsrc + 64 * (kb + 4)); }
                __syncthreads();
#pragma unroll
                for (int ks = 0; ks < 2; ++ks) { const bf16x8 af = *(const LAS bf16x8*)(ba + (16 * rf + fr) * RSB + 64 * ks + 16 * fq);
#pragma unroll
                    for (int j = 0; j < 2; ++j) { const bf16x8 bf = *(const LAS bf16x8*)(bb + (32 * cp + 16 * j + fr) * RSB + 64 * ks + 16 * fq); acc[j] = __builtin_amdgcn_mfma_f32_16x16x32_bf16(af, bf, acc[j], 0, 0, 0); } }
            }
        }
        float ss[4] = {0.f, 0.f, 0.f, 0.f};
#pragma unroll
        for (int j = 0; j < 2; ++j) { const int n = 64 * cg + 32 * cp + 16 * j + fr; const float g = gate[n], gs = gn[n] * (1.f + scn[n]);
#pragma unroll
            for (int r = 0; r < 4; ++r) { const int row = 64 * rg + 16 * rf + 4 * fq + r; const float o = xin[(size_t)row * DM + n] + g * acc[j][r];
                xout[(size_t)row * DM + n] = o; xg[(size_t)row * DM + n] = (bf16_t)(cvtpk(o * gs, 0.f) & 0xffffu); ss[r] += o * o; } }
#pragma unroll
        for (int r = 0; r < 4; ++r) { float s = ss[r]; s += shfl_x(s, 1, lane); s += shfl_x(s, 2, lane); s += shfl_x(s, 4, lane); s += shfl_x(s, 8, lane);
            if (fr == 0) { float* sp = ssqc + (size_t)(64 * rg + 16 * rf + 4 * fq + r) * 64 + cg * 2 + cp; sp[0] = s; sp[32] = 0.f; } }
        __syncthreads();
    }
}

__device__ __forceinline__ void final_phase(Frame& F) {
    const int gw = F.bid * NWAVES + F.wave, NGW = F.G * NWAVES;
    const float* gf = F.ka->in[IN_GFIN];
    f32x4 gv[4];
#pragma unroll
    for (int j = 0; j < 4; ++j) gv[j] = *(const f32x4*)(gf + 4 * F.lane + 256 * j);
    for (int rg = gw; rg < NLAT / 8; rg += NGW) {
        float* xr = F.out + (size_t)rg * 8 * DM + 4 * F.lane;
        f32x4 v[8][4]; float ss[8];
#pragma unroll
        for (int r = 0; r < 8; ++r)
#pragma unroll
            for (int j = 0; j < 4; ++j) v[r][j] = *(const f32x4*)(xr + (size_t)r * DM + 256 * j);
#pragma unroll
        for (int r = 0; r < 8; ++r) { float s = 0.f;
#pragma unroll
            for (int j = 0; j < 4; ++j) s += (v[r][j][0] * v[r][j][0] + v[r][j][1] * v[r][j][1]) + (v[r][j][2] * v[r][j][2] + v[r][j][3] * v[r][j][3]);
            ss[r] = s; }
#pragma unroll
        for (int o = 1; o < 64; o <<= 1)
#pragma unroll
            for (int r = 0; r < 8; ++r) ss[r] += shfl_x(ss[r], o, F.lane);
#pragma unroll
        for (int r = 0; r < 8; ++r) { const float rstd = rsqrtf(ss[r] * (1.f / DM) + EPS);
#pragma unroll
            for (int j = 0; j < 4; ++j) *(f32x4*)(xr + (size_t)r * DM + 256 * j) = v[r][j] * rstd * gv[j]; }
    }
}

typedef GAS unsigned gu32;
#define RLX_AGENT __ATOMIC_RELAXED, __HIP_MEMORY_SCOPE_AGENT
constexpr int CW_BAR = 4096;
#define XB_TMO      128
#define XB_XCNT(j)  (256  + 64 * (j))
#define XB_XSUB(j)  (1280 + 64 * (j))
#define XB_XGEN(j)  (2304 + 64 * (j))
#define XB_TOP      3328
#define XB_TOPGEN   3392
#define XCD_BAR_WORDS 3456
#define XB_SPIN_CAP (1u << 18)

__device__ __forceinline__ unsigned xb_ld(unsigned* p)              { return __hip_atomic_load(p, __ATOMIC_RELAXED, __HIP_MEMORY_SCOPE_AGENT); }
__device__ __forceinline__ unsigned xb_add(unsigned* p, unsigned v) { return __hip_atomic_fetch_add(p, v, __ATOMIC_RELAXED, __HIP_MEMORY_SCOPE_AGENT); }
__device__ __forceinline__ unsigned xb_xcc_id() { return (unsigned)__builtin_amdgcn_s_getreg((3 << 11) | 20) & 0xFu; }
#define XB_SPIN(cond, bar) do { unsigned _sp = 0; while (cond) { __builtin_amdgcn_s_sleep(1); \
    if ((++_sp & 255u) == 0u) { if (xb_ld(&(bar)[XB_TMO])) break; if (_sp > XB_SPIN_CAP) { atomicAdd(&(bar)[XB_TMO], 1u); break; } } } } while (0)

struct XcdBarrier {
    unsigned* bar; unsigned x;
    volatile LAS unsigned* st;
};

__device__ __forceinline__ XcdBarrier xcd_barrier_post(unsigned* bar, volatile LAS unsigned* st, bool is_t0) {
    XcdBarrier b; b.bar = bar; b.x = xb_xcc_id(); b.st = st;
    if (is_t0) (void)xb_add(&bar[XB_XCNT(b.x)], 1u);
    return b;
}
__device__ __forceinline__ void xcd_barrier_complete(unsigned* bar, unsigned x, unsigned& nloc, unsigned& nx) {
    const unsigned G = gridDim.x * gridDim.y * gridDim.z;
    unsigned sum, cnt, mine, sp = 0u;
    for (;;) {
        sum = 0u; cnt = 0u; mine = 0u;
#pragma unroll
        for (unsigned j = 0; j < 16; ++j) { const unsigned c = xb_ld(&bar[XB_XCNT(j)]); sum += c; cnt += (c > 0u) ? 1u : 0u; mine = (j == x) ? c : mine; }
        if (sum == G) break;
        __builtin_amdgcn_s_sleep(1);
        if ((++sp & 255u) == 0u) { if (xb_ld(&bar[XB_TMO])) break; if (sp > XB_SPIN_CAP) { atomicAdd(&bar[XB_TMO], 1u); break; } }
    }
    nloc = mine > 0u ? mine : 1u; nx = cnt > 0u ? cnt : 1u;
}

__device__ __forceinline__ void xcd_barrier(const XcdBarrier& b, bool is_t0) {
    asm volatile("s_waitcnt vmcnt(0)" ::: "memory");
    __syncthreads();
    if (is_t0) {
        unsigned* bar = b.bar;
        __builtin_amdgcn_s_waitcnt(0);
        unsigned nloc = b.st[0], nx = b.st[1];
        if (nloc == 0u) { xcd_barrier_complete(bar, b.x, nloc, nx); b.st[0] = nloc; b.st[1] = nx; }
        const unsigned old = xb_add(&bar[XB_XSUB(b.x)], 1u);
        const unsigned gen = old / nloc;
        if (old + 1u == (gen + 1u) * nloc) {
            __builtin_amdgcn_fence(__ATOMIC_RELEASE, "agent");
            asm volatile("s_waitcnt vmcnt(0)" ::: "memory");
            const unsigned og = xb_add(&bar[XB_TOP], 1u);
            const unsigned tg = og / nx;
            if (og + 1u == (tg + 1u) * nx) xb_add(&bar[XB_TOPGEN], 1u);
            else XB_SPIN(xb_ld(&bar[XB_TOPGEN]) == tg, bar);
            __builtin_amdgcn_fence(__ATOMIC_ACQUIRE, "agent");
            xb_add(&bar[XB_XGEN(b.x)], 1u);
            asm volatile("s_waitcnt vmcnt(0)" ::: "memory");
        } else {
            XB_SPIN(xb_ld(&bar[XB_XGEN(b.x)]) == gen, bar);
            __builtin_amdgcn_fence(__ATOMIC_ACQUIRE, "agent");
            asm volatile("s_waitcnt vmcnt(0)" ::: "memory");
        }
    }
    __syncthreads();
}

namespace att {
constexpr int SLOTB = 8192;
constexpr int L_K = 0, L_V = 2 * SLOTB, L_WS = 4 * SLOTB, L_OST = L_WS + 8 * 256, L_RPB = L_OST + 8 * 4096, L_END = L_RPB + 2048;
constexpr float THR = 8.0f;
__device__ __forceinline__ int crow(int r, int hi) { return (r & 3) + 8 * (r >> 2) + 4 * hi; }
__device__ __forceinline__ s16x4 vtr(const LAS unsigned char* p) { return __builtin_bit_cast(s16x4, __builtin_amdgcn_ds_read_tr16_b64_v4i16((LAS v4i16_t*)p)); }
__device__ __forceinline__ float rowmax32(const f32x16& p0, const f32x16& p1) {
    float a = fmaxf(p0[0], p1[0]);
#pragma unroll
    for (int r = 1; r < 16; ++r) a = fmaxf(a, fmaxf(p0[r], p1[r]));
    auto rr = __builtin_amdgcn_permlane32_swap(__float_as_uint(a), __float_as_uint(a), false, false);
    return fmaxf(__uint_as_float(rr[0]), __uint_as_float(rr[1]));
}
__device__ __forceinline__ float halfsum(float v) {
    auto rr = __builtin_amdgcn_permlane32_swap(__float_as_uint(v), __float_as_uint(v), false, false);
    return __uint_as_float(rr[0]) + __uint_as_float(rr[1]);
}
#define ATT_WAIT_BAR() asm volatile("s_waitcnt vmcnt(0) lgkmcnt(0)\n\ts_barrier" ::: "memory")

template <int MODE>
__device__ __forceinline__ void attn_unit(Frame& F, int b, int h, int qb, int qcol, int kcol, int vcol, int ycol, float sink2, const float* rpb) {
    LAS unsigned char* lds = F.lds;
    const int lane = F.lane, r32 = lane & 31, hi = lane >> 5, wid = F.wave;
    const bf16_t* PROJ = (const bf16_t*)(F.ws + WS_PROJ); bf16_t* Y = (bf16_t*)(F.ws + WS_H);
    const int ctxrow = NLAT + CTXL * b, latrow = SEQ * b;
    const int qrow0 = (MODE == 3) ? ctxrow : latrow + 256 * qb;
    const int qw0 = 256 * qb + 32 * wid;
    int lt_lo = 0, nloc = 0;
    if (MODE == 0) { lt_lo = 0; nloc = 128; }
    if (MODE == 1) { const int a = (256 * qb - 128) >> 6, e = (256 * qb + 255 + 128) >> 6; lt_lo = a < 0 ? 0 : a; nloc = (e > 127 ? 127 : e) - lt_lo + 1; }
    if (MODE == 2) { const int a = 4 * qb - 4, e0 = 4 * qb - 1; lt_lo = a < 0 ? 0 : (a > 120 ? 120 : a); const int e = (e0 < 0 ? 0 : (e0 > 120 ? 120 : e0)) + 7; nloc = e - lt_lo + 1; }
    const int NT = 4 + nloc;
    const int rw = 4 * qb + (wid >> 1); const int rs = rw - 4 < 0 ? 0 : (rw - 4 > 120 ? 120 : rw - 4);
    const int qc = 32 * (wid & 1) + r32; const int cs = qc - 8 < 0 ? 0 : (qc - 8 > 48 ? 48 : qc - 8);
    LAS float* wsf = (LAS float*)(lds + L_WS) + wid * 64;
    LAS float* rpbL = (LAS float*)(lds + L_RPB);
    if (MODE == 2) { for (int i = F.tid; i < 465; i += NTHREADS) rpbL[i] = rpb[i] * LOG2E; }
    const int vp0 = ((lane >> 4) & 1) * 32 + (lane & 3) * 8 + (4 * hi + ((lane & 15) >> 2)) * 64;
#define ATT_KROW(t) ((t) < 4 ? ctxrow + 64 * (t) : latrow + 64 * (lt_lo + (t) - 4))
#define ATT_DMA(t, slot) do { const int kr_ = ATT_KROW(t); \
        __builtin_amdgcn_global_load_lds((const unsigned*)(PROJ + (size_t)(kr_ + lane) * PP + kcol + wid * 8), (LAS unsigned*)(lds + L_K + (slot) * SLOTB + wid * 1024), 16, 0, 0); \
        __builtin_amdgcn_global_load_lds((const unsigned*)(PROJ + (size_t)(kr_ + 16 * (wid & 3) + (lane >> 2)) * PP + vcol + (wid >> 2) * 32 + (lane & 3) * 8), (LAS unsigned*)(lds + L_V + (slot) * SLOTB + wid * 1024), 16, 0, 0); } while (0)
    ATT_DMA(0, 0);
    bf16x8 qr[4];
#pragma unroll
    for (int d0 = 0; d0 < 4; ++d0) qr[d0] = *(const bf16x8*)(PROJ + (size_t)(qrow0 + 32 * wid + r32) * PP + qcol + d0 * 16 + hi * 8);
    float mhat = 0.f, l = 0.f; f32x16 o0 = {}, o1 = {}, negm = {};
    ATT_WAIT_BAR();
    for (int t = 0; t < NT; ++t) {
        const int slot = t & 1;
        if (t + 1 < NT) ATT_DMA(t + 1, slot ^ 1);
        bool rel = true; int kb0 = 0;
        if (MODE == 1 && t >= 4) { kb0 = 64 * (lt_lo + t - 4); rel = (kb0 + 63 >= qw0 - 128) && (kb0 <= qw0 + 31 + 128); }
        if (MODE == 2 && t >= 4) { kb0 = lt_lo + t - 4; rel = (kb0 >= rs) && (kb0 < rs + 8); }
        if (rel) {
            const LAS unsigned char* kb = lds + L_K + slot * SLOTB + hi * 1024 + r32 * 16;
            f32x16 p0 = negm, p1 = negm;
#pragma unroll
            for (int d0 = 0; d0 < 4; ++d0) {
                const bf16x8 b0 = *(const LAS bf16x8*)(kb + d0 * 2048), b1 = *(const LAS bf16x8*)(kb + d0 * 2048 + 512);
                p0 = __builtin_amdgcn_mfma_f32_32x32x16_bf16(b0, qr[d0], p0, 0, 0, 0);
                p1 = __builtin_amdgcn_mfma_f32_32x32x16_bf16(b1, qr[d0], p1, 0, 0, 0);
            }
            if (MODE == 1 && t >= 4) {
                const int dq = kb0 - (qw0 + r32);
#pragma unroll
                for (int r = 0; r < 16; ++r) { const int kc = crow(r, hi); const int d0_ = dq + kc, d1_ = d0_ + 32;
                    if (d0_ > 128 || d0_ < -128) p0[r] = -INFINITY; if (d1_ > 128 || d1_ < -128) p1[r] = -INFINITY; }
            }
            if (MODE == 2 && t >= 4) {
                const LAS float* bt = rpbL + (kb0 - rw + 7) * 31 + (15 - qc);
#pragma unroll
                for (int r = 0; r < 16; ++r) { const int kc = crow(r, hi);
                    const bool v0 = (kc >= cs) && (kc < cs + 16), v1 = (kc + 32 >= cs) && (kc + 32 < cs + 16);
                    p0[r] = v0 ? p0[r] + bt[v0 ? kc : qc] : -INFINITY; p1[r] = v1 ? p1[r] + bt[v1 ? kc + 32 : qc] : -INFINITY; }
            }
            const float rm = rowmax32(p0, p1);
            if (t == 0 || __any(rm > THR)) {
                const float dl = (t == 0) ? rm : fmaxf(rm, 0.f);
                mhat += dl;
#pragma unroll
                for (int r = 0; r < 16; ++r) { p0[r] -= dl; p1[r] -= dl; negm[r] = -mhat; }
                if (t > 0) { const float f = __builtin_amdgcn_exp2f(-dl); l *= f; if (hi == 0) wsf[r32] = f; LDS_WAIT();
#pragma unroll
                    for (int r = 0; r < 16; ++r) { const float fr_ = wsf[crow(r, hi)]; o0[r] *= fr_; o1[r] *= fr_; }
                    LDS_WAIT(); }
            }
            float ls = 0.f;
#pragma unroll
            for (int r = 0; r < 16; ++r) { p0[r] = __builtin_amdgcn_exp2f(p0[r]); p1[r] = __builtin_amdgcn_exp2f(p1[r]); ls += p0[r] + p1[r]; }
            l += ls;
            u32x4 pw[4];
#pragma unroll
            for (int k = 0; k < 4; ++k) { pw[0][k] = cvtpk(p0[2 * k], p0[2 * k + 1]); pw[1][k] = cvtpk(p0[8 + 2 * k], p0[9 + 2 * k]); pw[2][k] = cvtpk(p1[2 * k], p1[2 * k + 1]); pw[3][k] = cvtpk(p1[8 + 2 * k], p1[9 + 2 * k]); }
            const LAS unsigned char* vb = lds + L_V + slot * SLOTB + vp0;
#pragma unroll
            for (int ks = 0; ks < 4; ++ks) {
                const s16x4 a0 = vtr(vb + ks * 1024), a1 = vtr(vb + ks * 1024 + 512), c0 = vtr(vb + 4096 + ks * 1024), c1 = vtr(vb + 4096 + ks * 1024 + 512);
                const bf16x8 v0 = {a0[0], a0[1], a0[2], a0[3], a1[0], a1[1], a1[2], a1[3]}, v1 = {c0[0], c0[1], c0[2], c0[3], c1[0], c1[1], c1[2], c1[3]};
                o0 = __builtin_amdgcn_mfma_f32_32x32x16_bf16(__builtin_bit_cast(bf16x8, pw[ks]), v0, o0, 0, 0, 0);
                o1 = __builtin_amdgcn_mfma_f32_32x32x16_bf16(__builtin_bit_cast(bf16x8, pw[ks]), v1, o1, 0, 0, 0);
            }
        }
        ATT_WAIT_BAR();
    }
    l = halfsum(l);
    if (MODE == 1 || MODE == 3) l += __builtin_amdgcn_exp2f(sink2 - mhat);
    if (hi == 0) wsf[32 + r32] = l;
    LDS_WAIT();
    bf16_t* stg = (bf16_t*)(lds + L_OST + wid * 4096);
    LAS bf16_t* stgl = (LAS bf16_t*)(lds + L_OST + wid * 4096);
#pragma unroll
    for (int r = 0; r < 16; ++r) { const int orow = crow(r, hi); const float rl = __builtin_amdgcn_rcpf(wsf[32 + orow]);
        stgl[orow * 64 + r32] = (bf16_t)(cvtpk(o0[r] * rl, 0.f) & 0xffffu); stgl[orow * 64 + 32 + r32] = (bf16_t)(cvtpk(o1[r] * rl, 0.f) & 0xffffu); }
    LDS_WAIT();
    (void)stg;
#pragma unroll
    for (int i = 0; i < 4; ++i) { const int row = i * 8 + (lane >> 3), ch = lane & 7; const u32x4 v = *(const LAS u32x4*)(stgl + row * 64 + ch * 8);
        *(u32x4*)(Y + (size_t)(qrow0 + 32 * wid + row) * DM + ycol + ch * 8) = v; }
    LDS_WAIT();
#undef ATT_KROW
#undef ATT_DMA
}
}

namespace ml {
__device__ __forceinline__ float scan_add(float v, int lane, int dir) {
#pragma unroll
    for (int o = 1; o < 64; o <<= 1) { const float t = shfl_idx(v, (dir ? lane + o : lane - o) & 63); const bool ok = dir ? (lane + o < 64) : (lane >= o); v += ok ? t : 0.f; }
    return v;
}
__device__ __forceinline__ float scan_max(float v, int lane, int dir) {
#pragma unroll
    for (int o = 1; o < 64; o <<= 1) { const float t = shfl_idx(v, (dir ? lane + o : lane - o) & 63); const bool ok = dir ? (lane + o < 64) : (lane >= o); v = ok ? fmaxf(v, t) : v; }
    return v;
}
__device__ __forceinline__ float logsigmoid(float x) { return fminf(x, 0.f) - log1pf(__expf(-fabsf(x))); }
__device__ __forceinline__ int img_off(int tok, int d) { return (d >> 5) * 4096 + (tok >> 4) * 1024 + (tok & 15) * 64 + (d & 31) * 2; }
__device__ __forceinline__ int blk_row0(int b, int blk) { return blk < 4 ? NLAT + CTXL * b + 64 * blk : SEQ * b + 64 * (blk - 4); }
__device__ __forceinline__ int chunk_of(int dir, int blk) { return dir == 0 ? blk : (blk < 4 ? 3 - blk : 4 + 127 - (blk - 4)); }

__device__ __forceinline__ void pass1(Frame& F, int layer) {
    int lane_o = F.lane; asm volatile("" : "+v"(lane_o));
    const int gw = F.bid * NWAVES + F.wave, NGW = F.G * NWAVES, lane = lane_o, r32 = lane & 31, hi = lane >> 5;
    LAS unsigned char* wl = F.lds + F.wave * 16384;
    const bf16_t* PROJ = (const bf16_t*)(F.ws + WS_PROJ); const float* GATES = (const float*)(F.ws + WS_GATES);
    const float* gb = F.ka->in[IN_CGB] + layer * 16;
    float* DS = (float*)(F.ws + WS_DS); float* ZD = (float*)(F.ws + WS_ZD); float* GC = (float*)(F.ws + WS_GC); float* ML = (float*)(F.ws + WS_ML);
    const int vp0 = ((lane >> 4) & 1) * 32 + (lane & 3) * 8 + (4 * hi + ((lane & 15) >> 2)) * 64;
    for (int wu = gw; wu < NCHAIN * NCHUNK; wu += NGW) {
        const int chain = wu / NCHUNK, c = wu % NCHUNK, dir = chain & 1, h = (chain >> 1) & 3, b = chain >> 3;
        const int row0 = blk_row0(b, chunk_of(dir, c));
        const float gi = GATES[(size_t)(row0 + lane) * 16 + dir * 8 + h] + gb[dir * 8 + h];
        const float lf = logsigmoid(GATES[(size_t)(row0 + lane) * 16 + dir * 8 + 4 + h] + gb[dir * 8 + 4 + h]);
        const float cum = scan_add(lf, lane, dir);
        const float G = wave_sum(lf, lane);
        const float bb = gi - cum, mloc = wave_max(bb, lane), w = __expf(bb - mloc);
#pragma unroll
        for (int it = 0; it < 8; ++it) { const int tok = (lane >> 3) + 8 * it, d = 8 * (lane & 7);
            const u32x4 kv = *(const u32x4*)(PROJ + (size_t)(row0 + tok) * PP + PC_CK + 64 * h + d), vv = *(const u32x4*)(PROJ + (size_t)(row0 + tok) * PP + PC_CV + 64 * h + d);
            const float wt = shfl_idx(w, tok);
            u32x4 ko; ko.x = cvtpk(bflo(kv.x) * wt, bfhi(kv.x) * wt); ko.y = cvtpk(bflo(kv.y) * wt, bfhi(kv.y) * wt); ko.z = cvtpk(bflo(kv.z) * wt, bfhi(kv.z) * wt); ko.w = cvtpk(bflo(kv.w) * wt, bfhi(kv.w) * wt);
            *(LAS u32x4*)(wl + img_off(tok, d)) = vv; *(LAS u32x4*)(wl + 8192 + img_off(tok, d)) = ko; }
        LDS_WAIT();
        f32x16 acc[2][2] = {};
#pragma unroll
        for (int s = 0; s < 4; ++s) {
            bf16x8 af[2], bfr[2];
#pragma unroll
            for (int x = 0; x < 2; ++x) { const s16x4 a0 = att::vtr(wl + vp0 + x * 4096 + s * 1024), a1 = att::vtr(wl + vp0 + x * 4096 + s * 1024 + 512);
                const s16x4 c0 = att::vtr(wl + 8192 + vp0 + x * 4096 + s * 1024), c1 = att::vtr(wl + 8192 + vp0 + x * 4096 + s * 1024 + 512);
                af[x] = (bf16x8){a0[0], a0[1], a0[2], a0[3], a1[0], a1[1], a1[2], a1[3]}; bfr[x] = (bf16x8){c0[0], c0[1], c0[2], c0[3], c1[0], c1[1], c1[2], c1[3]}; }
#pragma unroll
            for (int vb = 0; vb < 2; ++vb)
#pragma unroll
                for (int kb = 0; kb < 2; ++kb) acc[vb][kb] = __builtin_amdgcn_mfma_f32_32x32x16_bf16(af[vb], bfr[kb], acc[vb][kb], 0, 0, 0);
        }
        float* dsp = DS + (size_t)(chain * NCHUNK + c) * 4096;
#pragma unroll
        for (int vb = 0; vb < 2; ++vb)
#pragma unroll
            for (int kb = 0; kb < 2; ++kb)
#pragma unroll
                for (int r = 0; r < 16; ++r) dsp[(32 * vb + att::crow(r, hi)) * 64 + 32 * kb + r32] = acc[vb][kb][r];
        float z = 0.f;
#pragma unroll 8
        for (int tok = 0; tok < 64; ++tok) z += bf2f(*(const LAS bf16_t*)(wl + 8192 + img_off(tok, lane)));
        ZD[(size_t)(chain * NCHUNK + c) * 64 + lane] = z;
        if (lane == 0) { GC[chain * NCHUNK + c] = G; ML[chain * NCHUNK + c] = mloc; }
        LDS_WAIT();
    }
}

__device__ __forceinline__ void pass2(Frame& F) {
    const float* DS = (const float*)(F.ws + WS_DS); const float* ZD = (const float*)(F.ws + WS_ZD); const float* GC = (const float*)(F.ws + WS_GC); const float* ML = (const float*)(F.ws + WS_ML);
    bf16_t* SBF = (bf16_t*)(F.ws + WS_SBF); float* ZC = (float*)(F.ws + WS_ZC); float* MC = (float*)(F.ws + WS_MC);
    LAS float* cf = (LAS float*)F.lds;
    for (int it = F.bid; it < NCHAIN * 16; it += F.G) {
        const int chain = it >> 4, part = it & 15;
        __syncthreads();
        if (F.wave == 0) {
            const int ln = F.lane; const bool valid = ln < 44; float g[3], mlv[3];
#pragma unroll
            for (int j = 0; j < 3; ++j) { g[j] = valid ? GC[chain * NCHUNK + 3 * ln + j] : 0.f; mlv[j] = valid ? ML[chain * NCHUNK + 3 * ln + j] : -INFINITY; }
            const float tot = g[0] + g[1] + g[2]; const float excl = ml::scan_add(tot, ln, 0) - tot;
            const float pg[3] = {excl, excl + g[0], excl + g[0] + g[1]};
            const float a0 = mlv[0] - pg[0], a1 = mlv[1] - pg[1], a2 = mlv[2] - pg[2];
            const float inclm = ml::scan_max(fmaxf(a0, fmaxf(a1, a2)), ln, 0); float exclm = shfl_idx(inclm, (ln - 1) & 63); if (ln == 0) exclm = -INFINITY;
            const float em[3] = {exclm, fmaxf(exclm, a0), fmaxf(fmaxf(exclm, a0), a1)};
#pragma unroll
            for (int j = 0; j < 3; ++j) { const int c = 3 * ln + j; const float m = pg[j] + fmaxf(0.f, em[j]); const float mn = fmaxf(g[j] + m, g[j] + mlv[j]);
                if (valid) { cf[2 * c] = __expf(g[j] + m - mn); cf[2 * c + 1] = __expf(g[j] + mlv[j] - mn); if (part == 0) __hip_atomic_store(MC + chain * NCHUNK + c, m, __ATOMIC_RELAXED, __HIP_MEMORY_SCOPE_AGENT); } }
        }
        __syncthreads();
        if (F.tid < 128) {
            const int e = part * 256 + 2 * F.tid; const float* dp = DS + (size_t)chain * NCHUNK * 4096 + e; unsigned* sp = (unsigned*)(SBF + (size_t)chain * NCHUNK * 4096 + e);
            float s0 = 0.f, s1 = 0.f;
            for (int c0 = 0; c0 < NCHUNK; c0 += 44) { f32x2 d[44];
#pragma unroll
                for (int j = 0; j < 44; ++j) d[j] = *(const f32x2*)(dp + (size_t)(c0 + j) * 4096);
#pragma unroll
                for (int j = 0; j < 44; ++j) { __hip_atomic_store(sp + (size_t)(c0 + j) * 2048, cvtpk(s0, s1), __ATOMIC_RELAXED, __HIP_MEMORY_SCOPE_AGENT);
                    s0 = cf[2 * (c0 + j)] * s0 + cf[2 * (c0 + j) + 1] * d[j][0]; s1 = cf[2 * (c0 + j)] * s1 + cf[2 * (c0 + j) + 1] * d[j][1]; } }
        } else if (F.tid >= 256 && F.tid < 260) {
            const int e = part * 4 + (F.tid - 256); const float* dp = ZD + (size_t)chain * NCHUNK * 64 + e; float* zp = ZC + (size_t)chain * NCHUNK * 64 + e;
            float sz = 0.f;
            for (int c0 = 0; c0 < NCHUNK; c0 += 66) { float d[66];
#pragma unroll
                for (int j = 0; j < 66; ++j) d[j] = dp[(size_t)(c0 + j) * 64];
#pragma unroll
                for (int j = 0; j < 66; ++j) { __hip_atomic_store(zp + (size_t)(c0 + j) * 64, sz, __ATOMIC_RELAXED, __HIP_MEMORY_SCOPE_AGENT); sz = cf[2 * (c0 + j)] * sz + cf[2 * (c0 + j) + 1] * d[j]; } }
        }
    }
    __syncthreads();
}

__device__ __forceinline__ void pass3(Frame& F, int layer, int blk_lo) {
    int lane_o = F.lane; asm volatile("" : "+v"(lane_o));
    const int gw = F.bid * NWAVES + F.wave, NGW = F.G * NWAVES, lane = lane_o, r32_ = lane & 31, hi_ = lane >> 5;
    LAS unsigned char* wl = F.lds + F.wave * 19456;
    LAS float* bvec = (LAS float*)(wl + 16384); LAS float* Apl = bvec + 128; LAS float* efl = bvec + 256; LAS float* fll = bvec + 384; LAS float* zl = bvec + 512; LAS float* rden = bvec + 640;
    LAS float* st = (LAS float*)(wl + 8192);
    const bf16_t* PROJ = (const bf16_t*)(F.ws + WS_PROJ); const float* GATES = (const float*)(F.ws + WS_GATES);
    const float* gb = F.ka->in[IN_CGB] + layer * 16;
    const bf16_t* SBF = (const bf16_t*)(F.ws + WS_SBF); const float* ZC = (const float*)(F.ws + WS_ZC); const float* MC = (const float*)(F.ws + WS_MC);
    bf16_t* Y = (bf16_t*)(F.ws + WS_H);
    const int vp0 = ((lane >> 4) & 1) * 32 + (lane & 3) * 8 + (4 * hi_ + ((lane & 15) >> 2)) * 64;
    const int nblk = NCHUNK - blk_lo;
    for (int wu2 = gw; wu2 < 16 * nblk; wu2 += NGW) {
        const int wu = wu2 >> 1, tbsel = wu2 & 1;
        const int bh = wu / nblk, blk = blk_lo + wu % nblk, b = bh >> 2, h = bh & 3;
        const int row0 = blk_row0(b, blk);
        LDS_WAIT();
#pragma unroll
        for (int it = 0; it < 8; ++it) { const int tok = (lane >> 3) + 8 * it, d = 8 * (lane & 7);
            *(LAS u32x4*)(wl + img_off(tok, d)) = *(const u32x4*)(PROJ + (size_t)(row0 + tok) * PP + PC_CV + 64 * h + d); }
#pragma unroll
        for (int dir = 0; dir < 2; ++dir) {
            const int c = chunk_of(dir, blk), chain = (b * 4 + h) * 2 + dir;
            const float gi = GATES[(size_t)(row0 + lane) * 16 + dir * 8 + h] + gb[dir * 8 + h];
            const float lf = logsigmoid(GATES[(size_t)(row0 + lane) * 16 + dir * 8 + 4 + h] + gb[dir * 8 + 4 + h]);
            const float cum = scan_add(lf, lane, dir);
            const float bb = gi - cum, pm = scan_max(bb, lane, dir), mc = MC[chain * NCHUNK + c];
            const float Apv = fmaxf(mc, pm);
            zl[dir * 64 + lane] = ZC[(size_t)(chain * NCHUNK + c) * 64 + lane];
            bvec[dir * 64 + lane] = bb; Apl[dir * 64 + lane] = Apv; efl[dir * 64 + lane] = __expf(mc - Apv); fll[dir * 64 + lane] = __expf(-(cum + Apv));
        }
        LDS_WAIT();
#pragma unroll 1
        for (int tb = tbsel; tb <= tbsel; ++tb) {
            int r32 = r32_, hi = hi_; asm volatile("" : "+v"(r32), "+v"(hi));
            const int t = 32 * tb + r32;
            bf16x8 qf[4];
#pragma unroll
            for (int d0 = 0; d0 < 4; ++d0) qf[d0] = *(const bf16x8*)(PROJ + (size_t)(row0 + t) * PP + PC_CQ + 64 * h + 16 * d0 + 8 * hi);
            f32x16 hs0 = {}, hs1 = {};
#pragma unroll 1
            for (int dir = 0; dir < 2; ++dir) {
                const int c = chunk_of(dir, blk), chain = (b * 4 + h) * 2 + dir;
                const bf16_t* Sp = SBF + (size_t)(chain * NCHUNK + c) * 4096; const LAS float* zp = zl + dir * 64;
                int r32 = r32_, hi = hi_; asm volatile("" : "+v"(r32), "+v"(hi));
                const float Ap_t = Apl[dir * 64 + t], e_t = efl[dir * 64 + t], fl_t = fll[dir * 64 + t];
                f32x16 P0 = {}, P1 = {};
#pragma unroll
                for (int d0 = 0; d0 < 4; ++d0) {
                    const bf16x8 k0 = *(const bf16x8*)(PROJ + (size_t)(row0 + r32) * PP + PC_CK + 64 * h + 16 * d0 + 8 * hi), k1 = *(const bf16x8*)(PROJ + (size_t)(row0 + 32 + r32) * PP + PC_CK + 64 * h + 16 * d0 + 8 * hi);
                    P0 = __builtin_amdgcn_mfma_f32_32x32x16_bf16(k0, qf[d0], P0, 0, 0, 0); P1 = __builtin_amdgcn_mfma_f32_32x32x16_bf16(k1, qf[d0], P1, 0, 0, 0); }
                float den = 0.f;
#pragma unroll
                for (int r = 0; r < 16; ++r) { const int s0 = att::crow(r, hi), s1 = 32 + s0; const bool ok0 = dir ? (s0 >= t) : (s0 <= t), ok1 = dir ? (s1 >= t) : (s1 <= t);
                    const float w0 = ok0 ? __expf(bvec[dir * 64 + s0] - Ap_t) : 0.f, w1 = ok1 ? __expf(bvec[dir * 64 + s1] - Ap_t) : 0.f;
                    P0[r] *= w0; P1[r] *= w1; den += P0[r] + P1[r]; }
                u32x4 pw[4];
#pragma unroll
                for (int k = 0; k < 4; ++k) { pw[0][k] = cvtpk(P0[2 * k], P0[2 * k + 1]); pw[1][k] = cvtpk(P0[8 + 2 * k], P0[9 + 2 * k]); pw[2][k] = cvtpk(P1[2 * k], P1[2 * k + 1]); pw[3][k] = cvtpk(P1[8 + 2 * k], P1[9 + 2 * k]); }

                f32x16 n0 = {}, n1 = {}; float zq = 0.f;
#pragma unroll
                for (int d0 = 0; d0 < 4; ++d0) { const u32x4 qw = __builtin_bit_cast(u32x4, qf[d0]); u32x4 o;
                    const f32x4 za = *(const LAS f32x4*)(zp + 16 * d0 + 8 * hi), zb = *(const LAS f32x4*)(zp + 16 * d0 + 8 * hi + 4);
                    const float q0 = bflo(qw.x), q1 = bfhi(qw.x), q2 = bflo(qw.y), q3 = bfhi(qw.y), q4 = bflo(qw.z), q5 = bfhi(qw.z), q6 = bflo(qw.w), q7 = bfhi(qw.w);
                    zq += (q0 * za[0] + q1 * za[1]) + (q2 * za[2] + q3 * za[3]) + (q4 * zb[0] + q5 * zb[1]) + (q6 * zb[2] + q7 * zb[3]);
                    o.x = cvtpk(q0 * e_t, q1 * e_t); o.y = cvtpk(q2 * e_t, q3 * e_t); o.z = cvtpk(q4 * e_t, q5 * e_t); o.w = cvtpk(q6 * e_t, q7 * e_t);
                    const bf16x8 qs = __builtin_bit_cast(bf16x8, o);
                    const bf16x8 s0 = *(const bf16x8*)(Sp + (size_t)r32 * 64 + 16 * d0 + 8 * hi), s1 = *(const bf16x8*)(Sp + (size_t)(32 + r32) * 64 + 16 * d0 + 8 * hi);
                    n0 = __builtin_amdgcn_mfma_f32_32x32x16_bf16(qs, s0, n0, 0, 0, 0); n1 = __builtin_amdgcn_mfma_f32_32x32x16_bf16(qs, s1, n1, 0, 0, 0); }

                den = att::halfsum(den) + e_t * att::halfsum(zq);
                const float rd = 1.f / fmaxf(fabsf(den), fl_t);
                LDS_WAIT(); if (hi == 0) rden[r32] = rd; LDS_WAIT();
#pragma unroll
                for (int ks = 0; ks < 4; ++ks) {
                    const s16x4 a0 = att::vtr(wl + vp0 + ks * 1024), a1 = att::vtr(wl + vp0 + ks * 1024 + 512), c0 = att::vtr(wl + vp0 + 4096 + ks * 1024), c1 = att::vtr(wl + vp0 + 4096 + ks * 1024 + 512);
                    const bf16x8 v0 = {a0[0], a0[1], a0[2], a0[3], a1[0], a1[1], a1[2], a1[3]}, v1 = {c0[0], c0[1], c0[2], c0[3], c1[0], c1[1], c1[2], c1[3]};
                    n0 = __builtin_amdgcn_mfma_f32_32x32x16_bf16(__builtin_bit_cast(bf16x8, pw[ks]), v0, n0, 0, 0, 0);
                    n1 = __builtin_amdgcn_mfma_f32_32x32x16_bf16(__builtin_bit_cast(bf16x8, pw[ks]), v1, n1, 0, 0, 0); }
#pragma unroll
                for (int r = 0; r < 16; ++r) { const float rr = rden[att::crow(r, hi)]; hs0[r] += n0[r] * rr; hs1[r] += n1[r] * rr; }
            }
            LDS_WAIT();
#pragma unroll
            for (int r = 0; r < 16; ++r) { st[att::crow(r, hi) * 64 + r32] = hs0[r]; st[att::crow(r, hi) * 64 + 32 + r32] = hs1[r]; }
            LDS_WAIT();
#pragma unroll
            for (int it = 0; it < 4; ++it) { const int tk = (lane >> 3) + 8 * it, d = 8 * (lane & 7);
                const u32x4 ow = *(const u32x4*)(PROJ + (size_t)(row0 + 32 * tb + tk) * PP + PC_CO + 64 * h + d);
                const f32x4 ha = *(const LAS f32x4*)(st + tk * 64 + d), hb = *(const LAS f32x4*)(st + tk * 64 + d + 4);
                const float og[8] = {bflo(ow.x), bfhi(ow.x), bflo(ow.y), bfhi(ow.y), bflo(ow.z), bfhi(ow.z), bflo(ow.w), bfhi(ow.w)};
                float yv[8];
#pragma unroll
                for (int j = 0; j < 8; ++j) yv[j] = (j < 4 ? ha[j] : hb[j - 4]) / (1.f + __expf(-og[j]));
                u32x4 w; w.x = cvtpk(yv[0], yv[1]); w.y = cvtpk(yv[2], yv[3]); w.z = cvtpk(yv[4], yv[5]); w.w = cvtpk(yv[6], yv[7]);
                *(u32x4*)(Y + (size_t)(row0 + 32 * tb + tk) * DM + 512 + 64 * h + d) = w; }
            LDS_WAIT();
        }
    }
}
}

namespace attp {
typedef __attribute__((address_space(3))) const char* lds_cptr;
#define SBAR() __builtin_amdgcn_sched_barrier(0)
__device__ __forceinline__ int crow(int r,int hi){return (r&3)+8*(r>>2)+4*hi;}
constexpr int NSLOT=3, SLOTB=8192;
constexpr int NW=8, QBLK=32, KVBLK=64; constexpr int LDS_K=0, LDS_V=NSLOT*SLOTB, LDS_WS=2*NSLOT*SLOTB, LDS_OST=LDS_WS+NW*64*4, LDS_BYTES=LDS_OST+NW*4096;
__device__ __forceinline__ void glds16(const void*gsrc,unsigned lds_dst){unsigned keep;
  asm volatile("s_mov_b32 %0, m0\n\ts_mov_b32 m0, %2\n\ts_nop 0\n\tglobal_load_lds_dwordx4 %1, off\n\ts_mov_b32 m0, %0":"=&s"(keep):"v"(gsrc),"s"(lds_dst):"memory");}
__device__ __forceinline__ float max3f(float a,float b,float c){float r;asm("v_max3_f32 %0, %1, %2, %3":"=v"(r):"v"(a),"v"(b),"v"(c));return r;}
__device__ __forceinline__ float max2f(float a,float b){float r;asm("v_max_f32_e32 %0, %1, %2":"=v"(r):"v"(a),"v"(b));return r;}
__device__ __forceinline__ float fadd_s(float a,float b){float r;asm("v_add_f32_e32 %0, %1, %2":"=v"(r):"v"(a),"v"(b));return r;}
__device__ __forceinline__ float fsub_s(float a,float b){float r;asm("v_sub_f32_e32 %0, %1, %2":"=v"(r):"v"(a),"v"(b));return r;}
__device__ __forceinline__ unsigned cvtpk_s(float lo,float hi){return cvtpk(lo,hi);}
#define WAIT_BAR(N) asm volatile("s_waitcnt vmcnt(" #N ") lgkmcnt(0)\n\ts_barrier":::"memory")

template<bool ZC> __device__ __forceinline__ void qkt(f32x16&p0,f32x16&p1,lds_cptr Kslot,const bf16x8*qr,const f32x16&negm,int r32,int hi){
  lds_cptr kb=Kslot+hi*1024+r32*16;
  #pragma unroll
  for(int d0=0;d0<4;++d0){
    const bf16x8 b0=*(const __attribute__((address_space(3))) bf16x8*)(kb+d0*2048);
    const bf16x8 b1=*(const __attribute__((address_space(3))) bf16x8*)(kb+d0*2048+512);
    if(d0==0){ if(ZC){p0=__builtin_amdgcn_mfma_f32_32x32x16_bf16(b0,qr[0],(f32x16){},0,0,0);p1=__builtin_amdgcn_mfma_f32_32x32x16_bf16(b1,qr[0],(f32x16){},0,0,0);} else {p0=__builtin_amdgcn_mfma_f32_32x32x16_bf16(b0,qr[0],negm,0,0,0);p1=__builtin_amdgcn_mfma_f32_32x32x16_bf16(b1,qr[0],negm,0,0,0);} }
    else{p0=__builtin_amdgcn_mfma_f32_32x32x16_bf16(b0,qr[d0],p0,0,0,0);p1=__builtin_amdgcn_mfma_f32_32x32x16_bf16(b1,qr[d0],p1,0,0,0);}}
}
__device__ __forceinline__ void kload8(bf16x8*kf,lds_cptr kp){
  kf[0]=*(const __attribute__((address_space(3))) bf16x8*)(kp);      kf[1]=*(const __attribute__((address_space(3))) bf16x8*)(kp+512);
  kf[2]=*(const __attribute__((address_space(3))) bf16x8*)(kp+2048); kf[3]=*(const __attribute__((address_space(3))) bf16x8*)(kp+2560);
  kf[4]=*(const __attribute__((address_space(3))) bf16x8*)(kp+4096); kf[5]=*(const __attribute__((address_space(3))) bf16x8*)(kp+4608);
  kf[6]=*(const __attribute__((address_space(3))) bf16x8*)(kp+6144); kf[7]=*(const __attribute__((address_space(3))) bf16x8*)(kp+6656);
}
__device__ __forceinline__ void kload2(bf16x8*kf,lds_cptr kp,int j){ kf[2*j]=*(const __attribute__((address_space(3))) bf16x8*)(kp+j*2048); kf[2*j+1]=*(const __attribute__((address_space(3))) bf16x8*)(kp+j*2048+512); }
__device__ __forceinline__ s16x4 vtr(lds_cptr p){ return __builtin_bit_cast(s16x4,__builtin_amdgcn_ds_read_tr16_b64_v4i16((__attribute__((address_space(3))) v4i16_t*)p)); }
__device__ __forceinline__ float rowmax(const f32x16&p0,const f32x16&p1){
  float a=max3f(p0[0],p0[1],p1[0]),b=max3f(p0[2],p0[3],p1[1]);a=max3f(a,p1[2],p1[3]);
  #pragma unroll
  for(int r=4;r<16;r+=4){a=max3f(a,p0[r],p0[r+1]);b=max3f(b,p0[r+2],p0[r+3]);a=max3f(a,p1[r],p1[r+1]);b=max3f(b,p1[r+2],p1[r+3]);}
  const float m=max2f(a,b);
  auto rr=__builtin_amdgcn_permlane32_swap(__float_as_uint(m),__float_as_uint(m),false,false);
  return max2f(__uint_as_float(rr[0]),__uint_as_float(rr[1]));
}
__device__ __forceinline__ void pv(f32x16*o,int vb,bf16x8 pa0,bf16x8 pa1,bf16x8 pa2,bf16x8 pa3){
  #pragma unroll
  for(int d0=0;d0<2;++d0){s16x4 lo[4],hi[4];
    #pragma unroll
    for(int ks=0;ks<4;++ks){
      asm volatile("ds_read_b64_tr_b16 %0,%1 offset:%c2":"=&v"(lo[ks]):"v"(vb),"i"(d0*4096+ks*1024):"memory");
      asm volatile("ds_read_b64_tr_b16 %0,%1 offset:%c2":"=&v"(hi[ks]):"v"(vb),"i"(d0*4096+ks*1024+512):"memory");}
    asm volatile("s_waitcnt lgkmcnt(0)":::"memory");SBAR();
    #define PK(k) (bf16x8){lo[k][0],lo[k][1],lo[k][2],lo[k][3],hi[k][0],hi[k][1],hi[k][2],hi[k][3]}
    o[d0]=__builtin_amdgcn_mfma_f32_32x32x16_bf16(pa0,PK(0),o[d0],0,0,0);
    o[d0]=__builtin_amdgcn_mfma_f32_32x32x16_bf16(pa1,PK(1),o[d0],0,0,0);
    o[d0]=__builtin_amdgcn_mfma_f32_32x32x16_bf16(pa2,PK(2),o[d0],0,0,0);
    o[d0]=__builtin_amdgcn_mfma_f32_32x32x16_bf16(pa3,PK(3),o[d0],0,0,0);
    #undef PK
  }
}


template<int THRL,int MODE> __device__ __forceinline__ void attn_unit_pipe(Frame& F,int b,int h,int qb,int qcol,int kcol,int vcol,int ycol,float sink2,const float*rpb){
  constexpr bool NOMAX=(MODE==0), USE_NEGM=false;
  int lane_=F.lane; asm volatile("":"+v"(lane_));
  const int lane=lane_,r32=lane&31,hi=lane>>5; const int wid=F.wave; (void)h;
  const bf16_t*PROJ=(const bf16_t*)(F.ws+WS_PROJ); bf16_t*Yb=(bf16_t*)(F.ws+WS_H);
  const int ctxrow=NLAT+CTXL*b,latrow=SEQ*b; LAS unsigned char*shm=F.lds;
  const int qrow0=(MODE==3)?ctxrow:latrow+256*qb;
  int lt_lo=0,nloc=0;
  if(MODE==0){nloc=128;}
  if(MODE==1){const int a_=(256*qb-128)>>6,e_=(256*qb+255+128)>>6; lt_lo=a_<0?0:a_; nloc=(e_>127?127:e_)-lt_lo+1;}
  if(MODE==2){const int a_=4*qb-4,e0_=4*qb-1; lt_lo=a_<0?0:(a_>120?120:a_); int e_=(e0_<0?0:(e0_>120?120:e0_))+7; nloc=e_-lt_lo+1; if(nloc&1)++nloc;}
  const int qw0=256*qb+32*wid;
  const int rw=4*qb+(wid>>1); const int rs=rw-4<0?0:(rw-4>120?120:rw-4);
  const int qc=32*(wid&1)+r32; const int cs=qc-8<0?0:(qc-8>48?48:qc-8);
  LAS float*rpbL=(LAS float*)(shm+LDS_BYTES);
  if(MODE==2){ for(int i=wid*64+lane;i<465;i+=512) rpbL[i]=rpb[i]*LOG2E; }
  unsigned vm0=0u,vm1=0u;
  if(MODE==2){ _Pragma("unroll") for(int r=0;r<16;++r){ const int kc_=crow(r,hi); if(kc_>=cs&&kc_<cs+16)vm0|=1u<<r; if(kc_+32>=cs&&kc_+32<cs+16)vm1|=1u<<r; } }
  const bf16_t*Qw=PROJ+(size_t)(qrow0+wid*QBLK)*PP+qcol;
  const unsigned lds0=(unsigned)(uintptr_t)shm;
  LAS float*wsf=(LAS float*)(shm+LDS_WS)+wid*64;
  const bf16_t*ksrc=PROJ+(size_t)lane*PP+kcol+wid*8;
  const bf16_t*vsrc=PROJ+(size_t)(16*(wid&3)+(lane>>2))*PP+vcol+(wid>>2)*32+(lane&3)*8;
  #define KROW(t) ((size_t)((t)<4?ctxrow+64*(t):latrow+64*(lt_lo+(t)-4))*PP)
  const unsigned kdst=lds0+LDS_K+wid*1024, vdst=lds0+LDS_V+wid*1024;
  #define DMA_K(t,slot) glds16(ksrc+KROW(t),(unsigned)__builtin_amdgcn_readfirstlane(kdst+(slot)))
  #define DMA_V(t,slot) glds16(vsrc+KROW(t),(unsigned)__builtin_amdgcn_readfirstlane(vdst+(slot)))
  const int vb0=(int)(lds0+LDS_V)+((lane>>4)&1)*32+(lane&3)*8+(4*hi+((lane&15)>>2))*64;
  const lds_cptr Kbase=(lds_cptr)shm+LDS_K; bf16x8 kf[8];
  const lds_cptr shm3=(lds_cptr)shm; const lds_cptr kp0=shm3+LDS_K+hi*1024+r32*16; const lds_cptr vp0=shm3+LDS_V+((lane>>4)&1)*32+(lane&3)*8+(4*hi+((lane&15)>>2))*64;
  const int NT=4+nloc;
  DMA_K(0,0);DMA_V(0,0);DMA_K(1,SLOTB);
  bf16x8 qr[4];
  #pragma unroll
  for(int d0=0;d0<4;++d0)qr[d0]=*reinterpret_cast<const bf16x8*>(&Qw[(size_t)r32*PP+d0*16+hi*8]);
  float mhat=0.f,l_reg=0.f;f32x16 o[2],negm;
  { float z_=0.f; asm volatile("":"+v"(z_));
    _Pragma("unroll") for(int r=0;r<16;++r){o[0][r]=z_;o[1][r]=z_;if(USE_NEGM)negm[r]=z_;} }
  if(USE_NEGM)asm volatile("":"+v"(negm));
  #define NEGMC (USE_NEGM?negm:(f32x16){})
  #define CMASK(P0,P1,t) do{ if(MODE==1&&(t)>=4){ const int dq_=64*(lt_lo+(t)-4)-(qw0+r32); \
      _Pragma("unroll") for(int r=0;r<16;++r){ const int d0_=dq_+crow(r,hi),d1_=d0_+32; if(d0_>128||d0_<-128)P0[r]=-INFINITY; if(d1_>128||d1_<-128)P1[r]=-INFINITY; } } \
    if(MODE==2&&(t)>=4){ const int gr_=lt_lo+(t)-4; const bool rel_=(gr_>=rs)&&(gr_<rs+8); const LAS float*bt_=rpbL+(rel_?gr_-rw+7:7)*31+(15-qc)+4*hi; const unsigned m0_=rel_?vm0:0u,m1_=rel_?vm1:0u; \
      _Pragma("unroll") for(int r=0;r<16;++r){ const int kc_=(r&3)+8*(r>>2);   \
        P0[r]=((m0_>>r)&1u)?P0[r]+bt_[kc_]:-INFINITY; P1[r]=((m1_>>r)&1u)?P1[r]+bt_[kc_+32]:-INFINITY; } } }while(0)
  bool resc=false;
  #define START(P0,P1) do{ resc=false; \
    if(!NOMAX){ const float rm=rowmax(P0,P1); const float dl=rm; mhat=fadd_s(mhat,dl); \
      _Pragma("unroll") for(int r=0;r<16;++r){P0[r]=fsub_s(P0[r],dl);P1[r]=fsub_s(P1[r],dl);} \
      if(USE_NEGM){ _Pragma("unroll") for(int r=0;r<16;++r)negm[r]=-mhat; asm volatile("":"+v"(negm)); } } \
    _Pragma("unroll") for(int r=0;r<16;++r)P0[r]=__builtin_amdgcn_exp2f(P0[r]); }while(0)
  #define RESC() do{ if(resc){ asm volatile("s_waitcnt lgkmcnt(0)":::"memory"); \
      _Pragma("unroll") for(int d_=0;d_<2;++d_) _Pragma("unroll") for(int r=0;r<16;++r)o[d_][r]*=wsf[crow(r,hi)]; } }while(0)
  f32x16 pA0,pA1,pB0,pB1;
  int sl_prev=0,sl_cur=0,sl_next=SLOTB;
  #define ROT() do{sl_prev=sl_cur;sl_cur=sl_next;sl_next=(sl_next==(NSLOT-1)*SLOTB)?0:sl_next+SLOTB;}while(0)
  DMA_K(2,2*SLOTB);
  WAIT_BAR(3);
  qkt<!USE_NEGM>(pA0,pA1,Kbase,qr,negm,r32,hi);asm volatile("s_nop 15\n\ts_nop 7":"+v"(pA0),"+v"(pA1));CMASK(pA0,pA1,0);
  START(pA0,pA1);
  _Pragma("unroll") for(int r=0;r<16;++r)pA1[r]=__builtin_amdgcn_exp2f(pA1[r]);
  WAIT_BAR(0);
  DMA_K(3,0);DMA_V(1,SLOTB);
  ROT();
  kload8(kf,kp0+sl_cur);
  WAIT_BAR(2);
  s16x4 vlo[8],vhi[8]; u32x4 pw0,pw1,pw2,pw3;
  #define PKW(P,B) cvtpk_s(P[B],P[B+1])
  #define PAF(k) __builtin_bit_cast(bf16x8,pw##k)
  #define VFR(i) (bf16x8){vlo[i][0],vlo[i][1],vlo[i][2],vlo[i][3],vhi[i][0],vhi[i][1],vhi[i][2],vhi[i][3]}
  #define PIN(x) asm volatile("":"+v"(x))
  #define MX3(a,b,c) __builtin_fmaxf(__builtin_fmaxf((a),(b)),(c))
  #define GAPA(MF,A0,A1,A2,A3,W0,W1,PW) do{ MF; sacc+=A0; sacc+=A1; sacc+=A2; sacc+=A3; PIN(sacc); W0; W1; PIN(PW); SBAR(); }while(0)
  #define EX(v) __builtin_amdgcn_exp2f(v)
  #define GAPB(MF,X,B) do{ MF; X[B]=EX(X[B]); X[B+1]=EX(X[B+1]); X[B+2]=EX(X[B+2]); X[B+3]=EX(X[B+3]); PIN(X); SBAR(); }while(0)
  #define VRD(i) do{ vlo[i]=vtr(vp_+(((i)>>2)*4096+((i)&3)*1024)); vhi[i]=vtr(vp_+(((i)>>2)*4096+((i)&3)*1024+512)); }while(0)
  #define KRD(G,j) do{ if(G){ kload2(kf,kp0+sl_next,j); SBAR(); } }while(0)
  #define STEP(C0,C1,P0,P1,t,GK,GV,GL) do{ SBAR(); \
    const lds_cptr vp_=vp0+sl_prev; \
    VRD(0); SBAR(); float sacc=(P0[0]+P0[1]); \
    GAPA(C0=__builtin_amdgcn_mfma_f32_32x32x16_bf16(kf[0],qr[0],NEGMC,0,0,0), P0[2],P0[3],P0[4],P0[5],     pw0[0]=PKW(P0,0), pw0[1]=PKW(P0,2), pw0); \
    VRD(4); SBAR(); GAPA(C1=__builtin_amdgcn_mfma_f32_32x32x16_bf16(kf[1],qr[0],NEGMC,0,0,0), P0[6],P0[7],P0[8],P0[9],     pw0[2]=PKW(P0,4), pw0[3]=PKW(P0,6), pw0); \
    VRD(1); SBAR(); GAPA(C0=__builtin_amdgcn_mfma_f32_32x32x16_bf16(kf[2],qr[1],C0,0,0,0),   P0[10],P0[11],P0[12],P0[13], pw1[0]=PKW(P0,8), pw1[1]=PKW(P0,10), pw1); \
    VRD(5); SBAR(); GAPA(C1=__builtin_amdgcn_mfma_f32_32x32x16_bf16(kf[3],qr[1],C1,0,0,0),   P0[14],P0[15],P1[0],P1[1],   pw1[2]=PKW(P0,12),pw1[3]=PKW(P0,14), pw1); \
    VRD(2); SBAR(); GAPA(C0=__builtin_amdgcn_mfma_f32_32x32x16_bf16(kf[4],qr[2],C0,0,0,0),   P1[2],P1[3],P1[4],P1[5],     pw2[0]=PKW(P1,0), pw2[1]=PKW(P1,2), pw2); \
    VRD(6); SBAR(); GAPA(C1=__builtin_amdgcn_mfma_f32_32x32x16_bf16(kf[5],qr[2],C1,0,0,0),   P1[6],P1[7],P1[8],P1[9],     pw2[2]=PKW(P1,4), pw2[3]=PKW(P1,6), pw2); \
    VRD(3); SBAR(); GAPA(C0=__builtin_amdgcn_mfma_f32_32x32x16_bf16(kf[6],qr[3],C0,0,0,0),   P1[10],P1[11],P1[12],P1[13], pw3[0]=PKW(P1,8), pw3[1]=PKW(P1,10), pw3); \
    VRD(7); SBAR(); GAPA(C1=__builtin_amdgcn_mfma_f32_32x32x16_bf16(kf[7],qr[3],C1,0,0,0),   P1[14],P1[15],0.f,0.f,       pw3[2]=PKW(P1,12),pw3[3]=PKW(P1,14), pw3); \
    l_reg+=sacc; \
    if(GK){DMA_K((t)+3,sl_cur);} if(GV){DMA_V((t)+1,sl_next);} \
    if(!USE_NEGM&&!NOMAX){ _Pragma("unroll") for(int r=0;r<16;++r){C0[r]-=mhat;C1[r]-=mhat;} } \
    CMASK(C0,C1,t); \
    if(!NOMAX){ float a=MX3(C0[0],C0[1],C1[0]),b=MX3(C0[2],C0[3],C1[1]); a=MX3(a,C1[2],C1[3]); \
      _Pragma("unroll") for(int r=4;r<16;r+=4){a=MX3(a,C0[r],C0[r+1]);b=MX3(b,C0[r+2],C0[r+3]);a=MX3(a,C1[r],C1[r+1]);b=MX3(b,C1[r+2],C1[r+3]);} \
      float rm=__builtin_fmaxf(a,b); { auto rr=__builtin_amdgcn_permlane32_swap(__float_as_uint(rm),__float_as_uint(rm),false,false); rm=__builtin_fmaxf(__uint_as_float(rr[0]),__uint_as_float(rr[1])); } \
      resc=false; \
      if(__builtin_expect(__any(rm>(float)THRL),0)){ const float dl=__builtin_fmaxf(rm,0.f); mhat+=dl; \
        _Pragma("unroll") for(int r=0;r<16;++r){C0[r]-=dl;C1[r]-=dl;} \
        if(USE_NEGM){ _Pragma("unroll") for(int r=0;r<16;++r)negm[r]=-mhat; asm volatile("":"+v"(negm)); } \
        const float f=__builtin_amdgcn_exp2f(-dl); l_reg*=f; if(hi==0)wsf[r32]=f; resc=true; } } \
    SBAR(); \
    GAPB(o[0]=__builtin_amdgcn_mfma_f32_32x32x16_bf16(PAF(0),VFR(0),o[0],0,0,0), C0,0); \
    GAPB(o[1]=__builtin_amdgcn_mfma_f32_32x32x16_bf16(PAF(0),VFR(4),o[1],0,0,0), C0,4); \
    KRD(GL,0); GAPB(o[0]=__builtin_amdgcn_mfma_f32_32x32x16_bf16(PAF(1),VFR(1),o[0],0,0,0), C0,8); \
    KRD(GL,1); GAPB(o[1]=__builtin_amdgcn_mfma_f32_32x32x16_bf16(PAF(1),VFR(5),o[1],0,0,0), C0,12); \
    KRD(GL,2); GAPB(o[0]=__builtin_amdgcn_mfma_f32_32x32x16_bf16(PAF(2),VFR(2),o[0],0,0,0), C1,0); \
    KRD(GL,3); GAPB(o[1]=__builtin_amdgcn_mfma_f32_32x32x16_bf16(PAF(2),VFR(6),o[1],0,0,0), C1,4); \
    GAPB(o[0]=__builtin_amdgcn_mfma_f32_32x32x16_bf16(PAF(3),VFR(3),o[0],0,0,0), C1,8); \
    GAPB(o[1]=__builtin_amdgcn_mfma_f32_32x32x16_bf16(PAF(3),VFR(7),o[1],0,0,0), C1,12); \
    }while(0)
  int t=1;
  for(;t+5<NT;t+=2){
    STEP(pB0,pB1,pA0,pA1,t,true,true,true);     WAIT_BAR(2); RESC(); ROT();
    STEP(pA0,pA1,pB0,pB1,t+1,true,true,true);   WAIT_BAR(2); RESC(); ROT();
  }
  #define ENDW(tt) do{ if((tt)+3<NT){WAIT_BAR(2);} else if((tt)+2<NT){WAIT_BAR(1);} else {WAIT_BAR(0);} }while(0)
  for(;t+1<NT;t+=2){
    STEP(pB0,pB1,pA0,pA1,t,(t+3<NT),(t+1<NT),(t+1<NT));       ENDW(t);   RESC(); ROT();
    STEP(pA0,pA1,pB0,pB1,t+1,(t+4<NT),(t+2<NT),(t+2<NT));     ENDW(t+1); RESC(); ROT();
  }
  STEP(pB0,pB1,pA0,pA1,NT-1,false,false,false); RESC();
  { float sacc=pB0[0]+pB0[1]; _Pragma("unroll") for(int r=2;r<16;++r)sacc+=pB0[r]; _Pragma("unroll") for(int r=0;r<16;++r)sacc+=pB1[r]; l_reg+=sacc;
    pw0=(u32x4){PKW(pB0,0),PKW(pB0,2),PKW(pB0,4),PKW(pB0,6)};pw1=(u32x4){PKW(pB0,8),PKW(pB0,10),PKW(pB0,12),PKW(pB0,14)};pw2=(u32x4){PKW(pB1,0),PKW(pB1,2),PKW(pB1,4),PKW(pB1,6)};pw3=(u32x4){PKW(pB1,8),PKW(pB1,10),PKW(pB1,12),PKW(pB1,14)};
    SBAR(); pv(o,vb0+sl_cur,PAF(0),PAF(1),PAF(2),PAF(3)); }
  #undef PKW
  #undef PAF
  #undef VFR
  #undef PIN
  #undef MX3
  #undef GAPA
  #undef GAPB
  #undef EX
  #undef VRD
  #undef KRD
  #undef STEP
  #undef ENDW
  {auto rr=__builtin_amdgcn_permlane32_swap(__float_as_uint(l_reg),__float_as_uint(l_reg),false,false);l_reg=__uint_as_float(rr[0])+__uint_as_float(rr[1]);}
  if(MODE==1||MODE==3)l_reg+=__builtin_amdgcn_exp2f(sink2-mhat);
  if(hi==0)wsf[32+r32]=l_reg;asm volatile("s_waitcnt lgkmcnt(0)":::"memory");
  float rli[16];
  #pragma unroll
  for(int r=0;r<16;++r)rli[r]=__builtin_amdgcn_rcpf(wsf[32+crow(r,hi)]);
  bf16_t*Ow=Yb+(size_t)(qrow0+wid*QBLK)*DM+ycol;
  { LAS bf16_t*stg=(LAS bf16_t*)(shm+LDS_OST)+wid*2048;
    #pragma unroll
    for(int r=0;r<16;++r){const int orow=crow(r,hi);
      #pragma unroll
      for(int d0=0;d0<2;++d0)stg[orow*64+d0*32+r32]=(bf16_t)(cvtpk(o[d0][r]*rli[r],0.f)&0xffffu);}
    asm volatile("s_waitcnt lgkmcnt(0)":::"memory");
    #pragma unroll
    for(int i=0;i<4;++i){const int row=i*8+(lane>>3),ch=lane&7; const u32x4 v=*(const LAS u32x4*)(stg+row*64+ch*8); *(u32x4*)(Ow+(size_t)row*DM+ch*8)=v;} }
  asm volatile("s_waitcnt lgkmcnt(0)\n\ts_barrier":::"memory");
  #undef DMA_K
  #undef DMA_V
  #undef KROW
  #undef NEGMC
  #undef CMASK
  #undef START
  #undef RESC
  #undef ROT
}

#undef SBAR
#undef WAIT_BAR
}

constexpr int NPHASE = 15;
__device__ __forceinline__ void ph_decode(int ph, int& l, int& k) { const unsigned tab = 0x00A98621u;
    if (ph == 1) { l = 0; k = 0; } else { const int j = ph - 2; l = j >= 6 ? 1 : 0; k = (int)((tab >> (4 * (j >= 6 ? j - 6 : j))) & 15u); } }

__device__ __forceinline__ void fill_rtab(Frame& F, const pg8::StaticOrder& S, const float* ssq, const float* ssqc) {
    LAS float* tab = (LAS float*)(F.lds + pg8::RTAB_OFF); pg8::Unit u;
#pragma unroll
    for (int i = 0; i < 8; ++i) if (S.next(i, u) && F.tid < 256) { float s = 0.f;
        if (u.pm < 64) { const float* p = ssq + (size_t)(u.pm * 256 + F.tid) * 16; const f32x4 a = *(const f32x4*)p, b = *(const f32x4*)(p + 4), c = *(const f32x4*)(p + 8), d = *(const f32x4*)(p + 12);
            s = ((a[0] + a[1]) + (a[2] + a[3])) + ((b[0] + b[1]) + (b[2] + b[3])) + ((c[0] + c[1]) + (c[2] + c[3])) + ((d[0] + d[1]) + (d[2] + d[3])); }
        else { const float* p = ssqc + (size_t)((u.pm - 64) * 256 + F.tid) * 64;
#pragma unroll
            for (int j = 0; j < 16; ++j) { const f32x4 a = *(const f32x4*)(p + 4 * j); s += (a[0] + a[1]) + (a[2] + a[3]); } }
        tab[i * 256 + F.tid] = rsqrtf(s * (1.f / DM) + EPS); }
    __syncthreads();
}
__device__ __forceinline__ void phase_ids(Frame& F) {
    int lane_;
    asm volatile("v_mbcnt_lo_u32_b32 %0, -1, 0\n\tv_mbcnt_hi_u32_b32 %0, -1, %0" : "=v"(lane_));
    F.lane = lane_; F.tid = F.wave * 64 + lane_;
}
__device__ __forceinline__ void run_phase(const Frame& F0, int ph) {
    Frame F = F0;
    unsigned char* ws = F.ws;
#define H ((bf16_t*)(F.ws + WS_H))
#define PROJ ((bf16_t*)(F.ws + WS_PROJ))
#define XC ((float*)(F.ws + WS_XC))
#define MOD ((const float*)(F.ws + WS_MOD))
#define vcu ((F.G % 8 == 0) ? (F.bid % 8) * (F.G / 8) + F.bid / 8 : F.bid)
#ifdef ONLYK
    if (ONLYK == 100) { if (ph == 0) { phase_ids(F); p0_prologue(F); } return; }
    if (ONLYK == 101) { if (ph == NPHASE - 1) { phase_ids(F); final_phase(F); } return; }
    if (ph == 0 || ph == NPHASE - 1) return;
    int l, k; ph_decode(ph, l, k);
    if (k != ONLYK) return;
#else
    if (ph == 0) { phase_ids(F); p0_prologue(F); return; }
    if (ph == NPHASE - 1) { phase_ids(F); final_phase(F); return; }
    int l, k; ph_decode(ph, l, k);
#endif
    const int M = (l == 0) ? NROWS : NLAT;
    switch (k) {
    case 0: phase_ids(F); norm_phase(F, l); break;
    case 1: { phase_ids(F); pg8::Gemm g{H, (const bf16_t*)(ws + WS_WIN) + (size_t)l * PP * 1024, NROWS, PP, 1024}; pg8::StaticOrder S; S.init(NROWS, PP, F.G, F.bid);
              gates_phase(F, l); if (l > 0) fill_rtab(F, S, (const float*)(ws + WS_SSQ1), (const float*)(ws + WS_SSQC1));
              pg8::EpiProj E{PROJ, PP, l == 0 ? nullptr : (const LAS float*)(F.lds + pg8::RTAB_OFF), (const float*)(ws + WS_BIASIN), F.ka->in[IN_AQG] + l * 64, F.ka->in[IN_AKG] + l * 64, (const float*)(ws + WS_ROPE)}; pg8::gemm_phase<pg8::EpiProj, pg8::StaticOrder, true, true>(F.lds, g, S, E, F.tid); } break;
    case 2: {
        phase_ids(F);
        ml::pass1(F, l);
        asm volatile("s_waitcnt vmcnt(0)" ::: "memory"); __syncthreads();
        if (F.tid == 0) { __builtin_amdgcn_fence(__ATOMIC_RELEASE, "agent"); asm volatile("s_waitcnt vmcnt(0)" ::: "memory");
            __hip_atomic_fetch_add((unsigned*)(ws + WS_CTL + 43008) + 8 + l, 1u, __ATOMIC_RELAXED, __HIP_MEMORY_SCOPE_AGENT); }
#ifndef NO_B
        for (int u = vcu; u < 256; u += F.G) { const int b = u >> 7, h = (u >> 5) & 3, qb = u & 31;
            attp::attn_unit_pipe<8, 1>(F, b, h, qb, PC_BQ + 64 * h, PC_BK + 64 * (h >> 1), PC_BV + 64 * (h >> 1), 256 + 64 * h, F.ka->in[IN_SINK][l * 4 + h] * LOG2E, nullptr); }
#endif
#ifndef NO_D
        for (int u = vcu; u < 256; u += F.G) { const int b = u >> 7, h = (u >> 5) & 3, qb = u & 31;
            attp::attn_unit_pipe<8, 2>(F, b, h, qb, PC_DQ + 64 * h, PC_DK + 64 * h, PC_DV + 64 * h, 768 + 64 * h, 0.f, F.ka->in[IN_RPB] + (size_t)(l * 4 + h) * 465); }
#endif
#ifndef NO_C3
        if (l == 0) for (int cu = vcu; cu < 24; cu += F.G) { const int mx = cu >> 3, b = (cu >> 2) & 1, h = cu & 3;
            const int qc = mx == 0 ? PC_AQ + 64 * h : (mx == 1 ? PC_BQ + 64 * h : PC_DQ + 64 * h);
            const int kc = mx == 0 ? PC_AK + 64 * (h >> 1) : (mx == 1 ? PC_BK + 64 * (h >> 1) : PC_DK + 64 * h);
            const int vc = mx == 0 ? PC_AV + 64 * (h >> 1) : (mx == 1 ? PC_BV + 64 * (h >> 1) : PC_DV + 64 * h);
            const int yc = (mx == 0 ? 0 : (mx == 1 ? 256 : 768)) + 64 * h;
            const float s2 = mx == 1 ? F.ka->in[IN_SINK][l * 4 + h] * LOG2E : -INFINITY;
            attp::attn_unit_pipe<8, 3>(F, b, h, 0, qc, kc, vc, yc, s2, nullptr); }
#endif
        if (l == 0) bias_phase(F, vcu >= 24 ? vcu - 24 : -1, F.G - 24);
        if (F.tid == 0) { unsigned* cnt = (unsigned*)(ws + WS_CTL + 43008) + 8 + l; unsigned sp = 0;
            while (__hip_atomic_load(cnt, __ATOMIC_RELAXED, __HIP_MEMORY_SCOPE_AGENT) < (unsigned)F.G && ++sp < (1u << 22)) __builtin_amdgcn_s_sleep(1);
            __builtin_amdgcn_fence(__ATOMIC_ACQUIRE, "agent"); asm volatile("s_waitcnt vmcnt(0)" ::: "memory"); }
        __syncthreads();
        ml::pass2(F);
        asm volatile("s_waitcnt vmcnt(0)" ::: "memory"); __syncthreads();
        if (F.tid == 0) __hip_atomic_fetch_add((unsigned*)(ws + WS_CTL + 43008) + l, 1u, __ATOMIC_RELAXED, __HIP_MEMORY_SCOPE_AGENT);
#ifndef NO_ATTN0
        for (int u = vcu; u < 256; u += F.G) { const int b = u >> 7, h = (u >> 5) & 3, qb = u & 31;
            attp::attn_unit_pipe<8, 0>(F, b, h, qb, PC_AQ + 64 * h, PC_AK + 64 * (h >> 1), PC_AV + 64 * (h >> 1), 64 * h, 0.f, nullptr); }
#endif
        if (F.tid == 0) { unsigned* cnt = (unsigned*)(ws + WS_CTL + 43008) + l; unsigned sp = 0;
            while (__hip_atomic_load(cnt, __ATOMIC_RELAXED, __HIP_MEMORY_SCOPE_AGENT) < (unsigned)F.G && ++sp < (1u << 22)) __builtin_amdgcn_s_sleep(1);
            __builtin_amdgcn_fence(__ATOMIC_ACQUIRE, "agent"); asm volatile("s_waitcnt vmcnt(0)" ::: "memory"); }
        __syncthreads();
#ifndef NO_PASS3
        ml::pass3(F, l, l == 0 ? 0 : 4);
#endif
    } break;
    case 6: { phase_ids(F); pg8::Gemm g{PROJ  , (const bf16_t*)(ws + WS_WOUT) + (size_t)l * 1024 * 1024, NLAT, 1024, 1024}; pg8::StaticOrder S; S.init(NLAT, 1024, F.G, F.bid);
              { pg8::Unit u;
                if (F.G >= 256) { if (S.next(0, u)) {
                    groupnorm_rows<true>(F, l, u.pm * 256 + u.pn * 64, 64, F.wave, NWAVES);
                    asm volatile("s_waitcnt vmcnt(0)" ::: "memory"); __syncthreads();
                    if (F.tid == 0) { unsigned* cnt = (unsigned*)(ws + WS_CTL + 40960) + l * 64 + u.pm;
                        __hip_atomic_fetch_add(cnt, 1u, __ATOMIC_RELAXED, __HIP_MEMORY_SCOPE_AGENT);
                        unsigned sp = 0; while (__hip_atomic_load(cnt, __ATOMIC_RELAXED, __HIP_MEMORY_SCOPE_AGENT) < 4u && ++sp < (1u << 22)) __builtin_amdgcn_s_sleep(1);
                        __builtin_amdgcn_fence(__ATOMIC_ACQUIRE, "agent"); asm volatile("s_waitcnt vmcnt(0)" ::: "memory"); }
                    __syncthreads(); } }
                else { for (int i = 0; S.next(i, u); ++i) groupnorm_rows<false>(F, l, u.pm * 256, 256, F.wave, NWAVES); VM_WAIT(); __syncthreads(); } }
              pg8::EpiResid E{l == 0 ? F.ka->in[IN_X] : F.out, l == 0 ? F.ka->in[IN_CTX] : XC, F.out, XC, MOD + (size_t)l * 3 * 6144 + 2 * 1024,
                               (bf16_t*)(ws + WS_XG), F.ka->in[IN_G2] + l * 1024, MOD + (size_t)l * 3 * 6144 + 4 * 1024, (float*)(ws + WS_SSQ2)};
              if (F.G >= 256) { pg8::EpiResidStaged E2{E.xin_lat, E.xin_ctx, E.xout_lat, E.xout_ctx, E.gate, E.xg, E.gn, E.scn, E.ssq}; pg8::gemm_phase<pg8::EpiResidStaged, pg8::StaticOrder, true, true>(F.lds, g, S, E2, F.tid); }
              else pg8::gemm_phase<pg8::EpiResid, pg8::StaticOrder, true, true>(F.lds, g, S, E, F.tid);
              PROBE_PT(F.lds, 5);
              if (l == 0) skinny_ctx<1024>(F, PROJ + (size_t)NLAT * DM, (const bf16_t*)(ws + WS_WOUT), F.ka->in[IN_CTX], XC, MOD + 2 * 6144 + 2 * 1024,
                                           (bf16_t*)(ws + WS_XG) + (size_t)NLAT * DM, F.ka->in[IN_G2], MOD + 2 * 6144 + 4 * 1024, (float*)(ws + WS_SSQC2)); } break;
    case 8: { phase_ids(F); pg8::Gemm g{(const bf16_t*)(ws + WS_XG), (const bf16_t*)(ws + WS_WUP) + (size_t)l * DFF2 * 1024, M, DFF2, 1024}; pg8::StaticOrder S; S.init(M, DFF2, F.G, F.bid);
              fill_rtab(F, S, (const float*)(ws + WS_SSQ2), (const float*)(ws + WS_SSQC2));
              pg8::EpiUp E{PROJ, F.ka->in[IN_CONVW] + (size_t)l * 3 * DFF2, F.ka->in[IN_CONVB] + (size_t)l * DFF2, (float*)(ws + WS_EDGE), (const LAS float*)(F.lds + pg8::RTAB_OFF), (const float*)(ws + WS_BIASUP) + (size_t)l * 3 * DFF2};
              pg8::gemm_phase<pg8::EpiUp, pg8::StaticOrder, true, true>(F.lds, g, S, E, F.tid); } break;
    case 9: phase_ids(F); for (int ht = F.bid; ht < M / 128; ht += F.G) fixup_hts(F, l, ht, 1); break;
    case 10: { phase_ids(F); pg8::Gemm g{PROJ, (const bf16_t*)(ws + WS_WDN) + (size_t)l * 1024 * DFF, NLAT, 1024, DFF}; pg8::StaticOrder S; S.init(NLAT, 1024, F.G, F.bid);
              pg8::EpiResid E{F.out, XC, F.out, XC, MOD + (size_t)l * 3 * 6144 + 5 * 1024,
                               l == 0 ? H : nullptr, F.ka->in[IN_G1] + 1024, MOD + (size_t)3 * 6144 + 1 * 1024, (float*)(ws + WS_SSQ1)};
              if (F.G >= 256) { pg8::EpiResidStaged E2{E.xin_lat, E.xin_ctx, E.xout_lat, E.xout_ctx, E.gate, E.xg, E.gn, E.scn, E.ssq}; pg8::gemm_phase<pg8::EpiResidStaged, pg8::StaticOrder, true, true>(F.lds, g, S, E2, F.tid); }
              else pg8::gemm_phase<pg8::EpiResid, pg8::StaticOrder, true, true>(F.lds, g, S, E, F.tid);
              PROBE_PT(F.lds, 5);
              if (l == 0) skinny_ctx<DFF>(F, PROJ + (size_t)NLAT * DFF, (const bf16_t*)(ws + WS_WDN), XC, XC, MOD + 2 * 6144 + 5 * 1024,
                                          H + (size_t)NLAT * DM, F.ka->in[IN_G1] + 1024, MOD + (size_t)(3 + 2) * 6144 + 1 * 1024, (float*)(ws + WS_SSQC1)); } break;
    default: break;
    }
#undef H
#undef PROJ
#undef XC
#undef MOD
#undef vcu
}

__global__ void __launch_bounds__(NTHREADS, 2) fwd_kernel(Args args) {
    extern __shared__ __attribute__((aligned(16))) unsigned char lds_raw[];
    Frame F;
    F.lds = (LAS unsigned char*)lds_raw;
    const int wave0 = __builtin_amdgcn_readfirstlane((int)threadIdx.x >> 6);
    F.tid = 0; F.lane = 0; F.wave = wave0;
    F.G = gridDim.x; F.bid = blockIdx.x;
    F.ka = (const __attribute__((address_space(4))) Args*)__builtin_amdgcn_kernarg_segment_ptr();
    F.out = args.out; F.ws = args.ws;
#define MK_LANE(x) int x; asm volatile("v_mbcnt_lo_u32_b32 %0, -1, 0\n\tv_mbcnt_hi_u32_b32 %0, -1, %0" : "=v"(x))
#if !MK_MULTI
    { MK_LANE(l0_); if (wave0 == 0) ((LAS unsigned*)(F.lds + LDSCTL_OFF))[l0_] = 0u; }
    __syncthreads();
    XcdBarrier bar;
    { MK_LANE(l0_); bar = xcd_barrier_post((unsigned*)(args.ws + WS_CTL) + CW_BAR, (volatile LAS unsigned*)(F.lds + LDSCTL_OFF) + 8, wave0 == 0 && l0_ == 0); }
#endif
#ifdef PROBE_MASK
    unsigned long long pr_acc = 0ull;
#endif
    for (int ph = args.ph_lo; ph < args.ph_hi; ++ph) {
#ifdef PROBE_MASK
        const unsigned long long pr_t0 = __builtin_amdgcn_s_memrealtime();
#endif
#ifdef PROBE_PH
        *(volatile LAS unsigned*)(F.lds + LDSCTL_OFF + 64) = (ph == PROBE_PH) ? 1u : 0u; __syncthreads();
        PROBE_PT(F.lds, 0);
#endif
        {
            Frame P = F;
            int wave_ = wave0, bid_ = F.bid, g_ = F.G; unsigned char* ws_ = F.ws; float* out_ = F.out; const __attribute__((address_space(4))) Args* ka_ = F.ka;
            asm volatile("" : "+s"(wave_), "+s"(bid_), "+s"(g_), "+s"(ws_), "+s"(out_), "+s"(ka_));
            P.ka = ka_; P.lane = 0; P.wave = wave_; P.tid = 0; P.bid = bid_; P.G = g_; P.ws = ws_; P.out = out_;
            run_phase(P, ph);
#ifdef DUP_PH
            if (DUP_PH(ph)) { asm volatile("s_waitcnt vmcnt(0) lgkmcnt(0)" ::: "memory"); __syncthreads(); run_phase(P, ph); }
#endif
        }
#if !MK_MULTI
        if (ph + 1 < args.ph_hi) {
            if (args.ph_lo < 0) cg::this_grid().sync();
            else { MK_LANE(l1_); xcd_barrier(bar, wave0 == 0 && l1_ == 0); }
        }
#endif
#ifdef PROBE_PH
        PROBE_PT(F.lds, 4);
#endif
#ifdef PROBE_MASK
        if ((PROBE_MASK >> ph) & 1u) pr_acc += __builtin_amdgcn_s_memrealtime() - pr_t0;
#endif
    }
#ifdef PROBE_PH
    if (blockIdx.x == 0) { __syncthreads(); const unsigned long long d_ = *(volatile LAS unsigned long long*)(F.lds + LDSCTL_OFF + 72 + 8 * PROBE_B) - *(volatile LAS unsigned long long*)(F.lds + LDSCTL_OFF + 72 + 8 * PROBE_A);
        const unsigned long long t1 = __builtin_amdgcn_s_memrealtime(); while (__builtin_amdgcn_s_memrealtime() - t1 < d_) __builtin_amdgcn_s_sleep(8); }
#endif
#ifdef PROBE_MASK
    if (blockIdx.x == 0) { const unsigned long long t1 = __builtin_amdgcn_s_memrealtime(); while (__builtin_amdgcn_s_memrealtime() - t1 < pr_acc) __builtin_amdgcn_s_sleep(8); }
#endif
}

extern "C" void kernel_launch(void* const* d_in, const int* in_sizes, int n_in, void* d_out, int out_size, void* d_ws, size_t ws_size, hipStream_t stream) {
    static int grid = 0;
    if (grid == 0) {
        if (n_in != 21 || out_size != NLAT * DM || ws_size < WS_END) { fprintf(stderr, "kernel_launch: unexpected shapes (n_in %d out %d ws %zu)\n", n_in, out_size, ws_size); grid = -1; return; }
        int dev = 0, cus = 0, per_cu = 0;
        if (hipGetDevice(&dev) != hipSuccess || hipDeviceGetAttribute(&cus, hipDeviceAttributeMultiprocessorCount, dev) != hipSuccess) { grid = -1; return; }
        if (hipFuncSetAttribute((const void*)fwd_kernel, hipFuncAttributeMaxDynamicSharedMemorySize, LDS_BYTES) != hipSuccess) { fprintf(stderr, "kernel_launch: hipFuncSetAttribute failed\n"); grid = -1; return; }
        if (hipOccupancyMaxActiveBlocksPerMultiprocessor(&per_cu, (const void*)fwd_kernel, NTHREADS, LDS_BYTES) != hipSuccess || per_cu < 1) { fprintf(stderr, "kernel_launch: occupancy query says %d blocks per CU\n", per_cu); grid = -1; (void)hipGetLastError(); return; }
        grid = cus;
    }
    if (grid < 0) return;
#if !MK_MULTI
    if (hipMemsetAsync((char*)d_ws + WS_CTL, 0, 65536, stream) != hipSuccess) { fprintf(stderr, "kernel_launch: hipMemsetAsync failed\n"); return; }
#endif
    Args a{};
    for (int i = 0; i < 21; ++i) a.in[i] = (const float*)d_in[i];
    a.out = (float*)d_out; a.ws = (unsigned char*)d_ws;
#if MK_MULTI
    for (int ph = 0; ph < NPHASE; ++ph) { a.ph_lo = ph; a.ph_hi = ph + 1; hipLaunchKernelGGL(fwd_kernel, dim3(grid), dim3(NTHREADS), LDS_BYTES, stream, a); }
#else
    a.ph_lo = 0; a.ph_hi = NPHASE;
    void* kargs[] = {&a};
    hipError_t e = hipLaunchCooperativeKernel((void*)fwd_kernel, dim3(grid), dim3(NTHREADS), kargs, LDS_BYTES, stream);
    if (e != hipSuccess) fprintf(stderr, "kernel_launch: cooperative launch failed: %s (grid %d)\n", hipGetErrorString(e), grid);
#endif
}
```

```cpp
#include <hip/hip_runtime.h>
#include <hip/hip_cooperative_groups.h>
#include <cstdio>
#include <cstdint>
namespace cg = cooperative_groups;

#ifndef MK_MULTI
#define MK_MULTI 0
#endif

constexpr int DM = 1024, SEQ = 8192, NBATCH = 2, CTXL = 256, NLAT = NBATCH * SEQ, NROWS = NLAT + NBATCH * CTXL;
constexpr int PP = 2816;
constexpr int DFF = 2816, DFF2 = 5632, DIN = 2832, NLAYER = 2;
constexpr float EPS = 1e-6f;
constexpr float LOG2E = 1.4426950408889634f;
constexpr float QSCALE2 = 0.125f * LOG2E;
constexpr int PC_AQ = 0, PC_AK = 256, PC_AV = 384, PC_BQ = 512, PC_BK = 768, PC_BV = 896, PC_CQ = 1024, PC_CK = 1280, PC_CV = 1536, PC_CO = 1792, PC_DQ = 2048, PC_DK = 2304, PC_DV = 2560;
constexpr int NCHUNK = 132, NCHAIN = 16;

constexpr size_t MiB = 1u << 20;
constexpr size_t WS_CTL = 0, CTL_ZERO_BYTES = 1 * MiB;
constexpr size_t WS_MOD = 1 * MiB;
constexpr size_t WS_ROPE = 1 * MiB + 192 * 1024;
constexpr size_t WS_WG = 1 * MiB + 512 * 1024;
constexpr size_t WS_WIN = 4 * MiB;
constexpr size_t WS_WOUT = 15 * MiB;
constexpr size_t WS_WUP = 19 * MiB;
constexpr size_t WS_WDN = 41 * MiB;
constexpr size_t WS_H = 52 * MiB;
constexpr size_t WS_PROJ = 85 * MiB;
constexpr size_t WS_GATES = 176 * MiB;
constexpr size_t WS_XB = 178 * MiB;
constexpr size_t OUT_DS = 0;
constexpr size_t OUT_SBF = 33 * MiB;
constexpr size_t WS_ZD = 228 * MiB;
constexpr size_t WS_ZC = WS_ZD + 1 * MiB;
constexpr size_t WS_GC = WS_ZC + 1 * MiB;
constexpr size_t WS_ML = WS_GC + 16384;
constexpr size_t WS_MC = WS_ML + 16384;
constexpr size_t WS_SSQ1 = 231 * MiB;
constexpr size_t WS_SSQ2 = 232 * MiB + 512 * 1024;
constexpr size_t WS_BIASUP = 234 * MiB;
constexpr size_t WS_BIASIN = 234 * MiB + 256 * 1024;
constexpr size_t OUT_XG = OUT_DS;
constexpr size_t OUT_EDGE = OUT_SBF;
constexpr size_t WS_SSQC1 = 234 * MiB + 512 * 1024;
constexpr size_t WS_SSQC2 = 234 * MiB + 768 * 1024;
constexpr size_t WS_END = 237 * MiB;

#define LAS __attribute__((address_space(3)))
#define GAS __attribute__((address_space(1)))
typedef unsigned short bf16_t;
typedef short bf16x8 __attribute__((ext_vector_type(8)));
typedef short s16x4 __attribute__((ext_vector_type(4)));
typedef float f32x4 __attribute__((ext_vector_type(4)));
typedef float f32x16 __attribute__((ext_vector_type(16)));
typedef float f32x2 __attribute__((ext_vector_type(2)));
typedef unsigned u32x4 __attribute__((ext_vector_type(4)));
typedef unsigned u32x2 __attribute__((ext_vector_type(2)));
typedef __bf16 bf16x2_t __attribute__((ext_vector_type(2)));
typedef short v4i16_t __attribute__((ext_vector_type(4)));

__device__ __forceinline__ unsigned cvtpk(float lo, float hi) { f32x2 v = {lo, hi}; bf16x2_t b = __builtin_convertvector(v, bf16x2_t); return __builtin_bit_cast(unsigned, b); }
__device__ __forceinline__ float bf2f(unsigned short b) { return __uint_as_float((unsigned)b << 16); }
__device__ __forceinline__ float bflo(unsigned w) { return __uint_as_float(w << 16); }
__device__ __forceinline__ float bfhi(unsigned w) { return __uint_as_float(w & 0xffff0000u); }
__device__ __forceinline__ float shfl_idx(float v, int src) { return __int_as_float(__builtin_amdgcn_ds_bpermute(src << 2, __float_as_int(v))); }
__device__ __forceinline__ float shfl_x(float v, int o, int lane) { return shfl_idx(v, lane ^ o); }
__device__ __forceinline__ float wave_sum(float v, int lane) {
#pragma unroll
    for (int o = 1; o < 64; o <<= 1) v += shfl_x(v, o, lane);
    return v;
}
__device__ __forceinline__ float wave_max(float v, int lane) {
#pragma unroll
    for (int o = 1; o < 64; o <<= 1) v = fmaxf(v, shfl_x(v, o, lane));
    return v;
}
#ifndef PROBE_BLK
#define PROBE_BLK 0
#endif
#ifdef PROBE_PH
#define PROBE_PT(ldsbase, id) do { if (*(volatile LAS unsigned*)((ldsbase) + 155648 + 64)) *(volatile LAS unsigned long long*)((ldsbase) + 155648 + 72 + 8 * (id)) = __builtin_amdgcn_s_memrealtime(); } while (0)
#else
#define PROBE_PT(ldsbase, id) do { } while (0)
#endif
#define LDS_WAIT() asm volatile("s_waitcnt lgkmcnt(0)" ::: "memory")
#define VM_WAIT() asm volatile("s_waitcnt vmcnt(0)" ::: "memory")

namespace pg8 {
#define PG8_LAS __attribute__((address_space(3)))
constexpr int BM = 256, BK = 64, HALF = 128, HTB = HALF * BK * 2  , STAGE_BYTES = 8 * HTB, NXCD = 8, WGM = 8;
__host__ __device__ __forceinline__ int lds_byte(int r, int c) { const int st = (r >> 4) * 2 + (c >> 5), rr = r & 15, cc = c & 31, ob = rr * 64 + cc * 2; return st * 1024 + (ob ^ (((ob >> 9) & 1) << 5)); }
__host__ __device__ __forceinline__ void stage_rc(int b, int& R, int& C) { const int st = b / 1024, sb = b % 1024, swz = sb ^ (((sb >> 9) & 1) << 5); R = (st >> 1) * 16 + swz / 64; C = (st & 1) * 32 + (swz % 64) / 2; }
__host__ __device__ __forceinline__ int perm32(int rho) { const int n = rho >> 4, i = rho & 15; return 8 * (i >> 2) + 4 * n + (i & 3); }

struct Unit { int pm, pn, ui; };
struct Gemm { const bf16_t* A; const bf16_t* Bt; int M, N, K; };

struct StaticOrder {
    int nM, nN, nwg, G, c;
    __host__ __device__ __forceinline__ void init(int M, int N, int G_, int c_) { nM = M / BM; nN = N / BM; nwg = nM * nN; G = G_; c = c_; }
    __host__ __device__ __forceinline__ bool next(int i, Unit& u) const {
        const long L = (long)i * G + c; if (L >= nwg) return false;
        int wgid = (int)L; { const int q = nwg / NXCD, r = nwg % NXCD, xcd = wgid % NXCD, off = wgid / NXCD; wgid = (xcd < r ? xcd * (q + 1) : r * (q + 1) + (xcd - r) * q) + off; }
        const int nig = WGM * nN, gid = wgid / nig, fm = gid * WGM, gsz = (nM - fm) < WGM ? (nM - fm) : WGM;
        u.pm = fm + ((wgid % nig) % gsz); u.pn = (wgid % nig) / gsz; u.ui = i; return true;
    }
    __device__ __forceinline__ void a_ready(const Unit&) const {}
    __device__ __forceinline__ void done(const Unit&) const {}
};
struct ProjOrder {
    int nM, nN, nwg, G, c;
    __host__ __device__ __forceinline__ void init(int M, int N, int G_, int c_) { nM = M / BM; nN = N / BM; nwg = nM * nN; G = G_; c = c_; }
    static __host__ __device__ __forceinline__ void map(int wgid, int nM_, int nN_, int& pm, int& pn) {
        const int n = nM_ * nN_; { const int q = n / NXCD, r = n % NXCD, xcd = wgid % NXCD, off = wgid / NXCD; wgid = (xcd < r ? xcd * (q + 1) : r * (q + 1) + (xcd - r) * q) + off; }
        const int nig = WGM * nN_, gid = wgid / nig, fm = gid * WGM, gsz = (nM_ - fm) < WGM ? (nM_ - fm) : WGM;
        pm = fm + ((wgid % nig) % gsz); pn = (wgid % nig) / gsz; }
    __host__ __device__ __forceinline__ bool next(int i, Unit& u) const {
        const long L = (long)i * G + c; if (L >= nwg) return false;
        const int l = (int)L; u.ui = i;
        if (!(G == 256 && nM == 66 && nN == 11)) { map(l, nM, nN, u.pm, u.pn); return true; }
        if (l < 256) map(l, 66, 4, u.pm, u.pn);
        else if (l >= 470 && l < 478) map(l - 214, 66, 4, u.pm, u.pn);
        else { map(l < 470 ? l - 256 : l - 264, 66, 7, u.pm, u.pn); u.pn += 4; }
        return true;
    }
    __device__ __forceinline__ void a_ready(const Unit&) const {}
    __device__ __forceinline__ void done(const Unit&) const {}
};

constexpr int ROPEL_OFF = 131072 + 8192;
constexpr int RTAB_OFF = 131072;
struct EpiProj {
    static constexpr bool PERM = true, AFTER_DRAIN = false, ROWPERM = false, KSEG = false;
    bf16_t* O; int ldc; const LAS float* rtab; const float* bias;
    const float* gq; const float* gk; const LAS float* ropeL;
    __device__ __forceinline__ void operator()(const f32x4 (&acc)[2][2][4][2], const Unit& u, int wr, int wc, int fr, int fq) const {
        asm volatile("" : "+v"(fr), "+v"(fq));
        const int row0 = u.pm * BM + wr * 64 + fr, col0 = u.pn * BM + wc * 32 + 8 * fq;
        const float sc = (u.pn == 2 || u.pn == 8) ? QSCALE2 : (u.pn == 4 ? 0.125f : 1.f);
        float rs[8] = {1.f, 1.f, 1.f, 1.f, 1.f, 1.f, 1.f, 1.f}; f32x4 bv[2][2] = {};
        if (rtab) {
#pragma unroll
            for (int i = 0; i < 8; ++i) rs[i] = rtab[u.ui * 256 + wr * 64 + fr + (i >> 2) * HALF + (i & 3) * 16];
            const int id = u.pm < 32 ? 0 : (u.pm < 64 ? 1 : 2);
#pragma unroll
            for (int bj = 0; bj < 2; ++bj)
#pragma unroll
                for (int n = 0; n < 2; ++n) bv[bj][n] = *(const f32x4*)(bias + id * PP + col0 + bj * HALF + 4 * n); }
        if (u.pn >= 4) {
#pragma unroll
            for (int ai = 0; ai < 2; ++ai)
#pragma unroll
                for (int m = 0; m < 4; ++m) { bf16_t* rowp = O + (size_t)(row0 + ai * HALF + m * 16) * ldc + col0; const float r = rs[ai * 4 + m];
#pragma unroll
                    for (int bj = 0; bj < 2; ++bj) { const f32x4 v0 = (acc[ai][bj][m][0] * r + bv[bj][0]) * sc, v1 = (acc[ai][bj][m][1] * r + bv[bj][1]) * sc;
                        u32x4 w; w.x = cvtpk(v0[0], v0[1]); w.y = cvtpk(v0[2], v0[3]); w.z = cvtpk(v1[0], v1[1]); w.w = cvtpk(v1[2], v1[3]);
                        *(u32x4*)(rowp + bj * HALF) = w; } }
            return;
        }
        const bool lat = u.pm < 64;
        const bool khead = (u.pn & 1) && wc < 2;
        const bool donorm = u.pn == 0 || (u.pn == 1 && wc < 2);
        const bool dorope = lat && (!(u.pn & 1) || khead);
        const float* gp = u.pn == 0 ? gq : gk;
        f32x4 gg[2][2];
#pragma unroll
        for (int bj = 0; bj < 2; ++bj)
#pragma unroll
            for (int n = 0; n < 2; ++n) gg[bj][n] = donorm ? *(const f32x4*)(gp + 32 * bj + 16 * n + 4 * fq) : (f32x4){1.f, 1.f, 1.f, 1.f};
        const float qs = u.pn == 0 ? QSCALE2 : 1.f;
#pragma unroll
        for (int ai = 0; ai < 2; ++ai)
#pragma unroll
            for (int m = 0; m < 4; ++m) { const int row = row0 + ai * HALF + m * 16; const float r = rs[ai * 4 + m];
                f32x4 v[2][2]; float ss = 0.f;
#pragma unroll
                for (int bj = 0; bj < 2; ++bj)
#pragma unroll
                    for (int n = 0; n < 2; ++n) { v[bj][n] = (acc[ai][bj][m][n] * r + bv[bj][n]) * sc; ss += (v[bj][n][0] * v[bj][n][0] + v[bj][n][1] * v[bj][n][1]) + (v[bj][n][2] * v[bj][n][2] + v[bj][n][3] * v[bj][n][3]); }
                if (donorm) { { auto r16 = __builtin_amdgcn_permlane16_swap(__float_as_uint(ss), __float_as_uint(ss), false, false); ss = __uint_as_float(r16[0]) + __uint_as_float(r16[1]); }
                              { auto r32 = __builtin_amdgcn_permlane32_swap(__float_as_uint(ss), __float_as_uint(ss), false, false); ss = __uint_as_float(r32[0]) + __uint_as_float(r32[1]); } const float rstd = rsqrtf(ss * (1.f / 64.f) + EPS) * qs;
#pragma unroll
                    for (int bj = 0; bj < 2; ++bj)
#pragma unroll
                        for (int n = 0; n < 2; ++n) v[bj][n] = v[bj][n] * rstd * gg[bj][n]; }
                bf16_t* rowp = O + (size_t)row * ldc + u.pn * BM + 64 * wc + 4 * fq;
                const int t = row & (SEQ - 1);
#pragma unroll
                for (int bj = 0; bj < 2; ++bj) { f32x4 o1 = v[bj][0], o2 = v[bj][1];
                    if (dorope) { const LAS float* rp = ropeL + (bj ? (t & 63) * 32 : 2048 + u.ui * 128 + (wr + 2 * ai) * 32) + 8 * fq; const f32x4 c0 = *(const LAS f32x4*)rp, c1 = *(const LAS f32x4*)(rp + 4);
                        const f32x4 cz = {c0[0], c0[2], c1[0], c1[2]}, sz = {c0[1], c0[3], c1[1], c1[3]};
                        o1 = v[bj][0] * cz - v[bj][1] * sz; o2 = v[bj][0] * sz + v[bj][1] * cz; }
                    u32x2 w1, w2; w1.x = cvtpk(o1[0], o1[1]); w1.y = cvtpk(o1[2], o1[3]); w2.x = cvtpk(o2[0], o2[1]); w2.y = cvtpk(o2[2], o2[3]);
                    *(u32x2*)(rowp + 32 * bj) = w1; *(u32x2*)(rowp + 32 * bj + 16) = w2; } }
    }
};
template <bool XF32>
struct EpiResidT {
    static constexpr bool PERM = true, AFTER_DRAIN = false, ROWPERM = false, KSEG = false;
    const float* xin_lat; const float* xin_ctx; bf16_t* xb; const float* gate;
    bf16_t* xg; const float* gn; const float* scn; float* ssq;
    __device__ __forceinline__ void operator()(const f32x4 (&acc)[2][2][4][2], const Unit& u, int wr, int wc, int fr, int fq) const {
        asm volatile("" : "+v"(fr), "+v"(fq));
        const int id = u.pm < 32 ? 0 : (u.pm < 64 ? 1 : 2);
        const float* xin = u.pm < 64 ? xin_lat + (size_t)u.pm * BM * DM : xin_ctx + (size_t)(u.pm - 64) * BM * DM;
        bf16_t* xo = xb + (size_t)u.pm * BM * DM;
        const int rl = wr * 64 + fr, col0 = u.pn * BM + wc * 32 + 8 * fq;
        f32x4 g[2][2], gs[2][2];
#pragma unroll
        for (int bj = 0; bj < 2; ++bj)
#pragma unroll
            for (int n = 0; n < 2; ++n) { g[bj][n] = *(const f32x4*)(gate + id * 6144 + col0 + bj * HALF + 4 * n);
                if (xg) gs[bj][n] = *(const f32x4*)(gn + col0 + bj * HALF + 4 * n) * (1.f + *(const f32x4*)(scn + id * 6144 + col0 + bj * HALF + 4 * n)); }
#pragma unroll
        for (int ai = 0; ai < 2; ++ai)
#pragma unroll
            for (int m = 0; m < 4; ++m) { const size_t off = (size_t)(rl + ai * HALF + m * 16) * DM + col0; float s = 0.f;
#pragma unroll
                for (int bj = 0; bj < 2; ++bj) { f32x4 o[2]; u32x4 xw;
                    if constexpr (!XF32) xw = *(const u32x4*)(xo + off + bj * HALF);
#pragma unroll
                    for (int n = 0; n < 2; ++n) { f32x4 xv;
                        if constexpr (XF32) xv = *(const f32x4*)(xin + off + bj * HALF + 4 * n);
                        else { const unsigned lo = n ? xw.z : xw.x, hi = n ? xw.w : xw.y; xv = (f32x4){bflo(lo), bfhi(lo), bflo(hi), bfhi(hi)}; }
                        o[n] = xv + g[bj][n] * acc[ai][bj][m][n];
                        s += (o[n][0] * o[n][0] + o[n][1] * o[n][1]) + (o[n][2] * o[n][2] + o[n][3] * o[n][3]); }
                    { u32x4 w; w.x = cvtpk(o[0][0], o[0][1]); w.y = cvtpk(o[0][2], o[0][3]); w.z = cvtpk(o[1][0], o[1][1]); w.w = cvtpk(o[1][2], o[1][3]); *(u32x4*)(xo + off + bj * HALF) = w; }
                    if (xg) { const f32x4 a = o[0] * gs[bj][0], b = o[1] * gs[bj][1]; u32x4 w; w.x = cvtpk(a[0], a[1]); w.y = cvtpk(a[2], a[3]); w.z = cvtpk(b[0], b[1]); w.w = cvtpk(b[2], b[3]);
                        *(u32x4*)(xg + (size_t)u.pm * BM * DM + off + bj * HALF) = w; } }
                if (xg) { s += shfl_idx(s, (fq * 16 + fr) ^ 16); s += shfl_idx(s, (fq * 16 + fr) ^ 32);
                    if (fq == 0) ssq[(size_t)(u.pm * BM + rl + ai * HALF + m * 16) * 16 + u.pn * 4 + wc] = s; } }
    }
};
constexpr int GNTAB_OFF = RTAB_OFF + 8192;
template <bool KS, bool XF32>
struct EpiResidStagedT {
    static constexpr bool PERM = true, AFTER_DRAIN = true, ROWPERM = false, KSEG = KS;
    __device__ __forceinline__ void kseg(f32x4 (&acc)[2][2][4][2], int seg, int wr, int fr, PG8_LAS unsigned char* lds) const {
        const PG8_LAS float* rt = (const PG8_LAS float*)(lds + GNTAB_OFF) + seg * 256 + wr * 64 + fr;
#pragma unroll
        for (int ai = 0; ai < 2; ++ai)
#pragma unroll
            for (int m = 0; m < 4; ++m) { const float f = rt[ai * 128 + m * 16];
#pragma unroll
                for (int bj = 0; bj < 2; ++bj)
#pragma unroll
                    for (int n = 0; n < 2; ++n) acc[ai][bj][m][n] *= f; }
    }
    const float* xin_lat; const float* xin_ctx; bf16_t* xb; const float* gate;
    bf16_t* xg; const float* gn; const float* scn; float* ssq;
    static constexpr int RS = 1040;
    __device__ __forceinline__ void operator()(const f32x4 (&)[2][2][4][2], const Unit&, int, int, int, int) const {}
    __device__ __forceinline__ void fused(const f32x4 (&acc)[2][2][4][2], const Unit& u, int wr, int wc, int fr, int fq, PG8_LAS unsigned char* lds, int wid, int lane) const {
        const int id = u.pm < 32 ? 0 : (u.pm < 64 ? 1 : 2);
        const float* xin = u.pm < 64 ? xin_lat + (size_t)u.pm * BM * DM : xin_ctx + (size_t)(u.pm - 64) * BM * DM;
        bf16_t* xo = xb + (size_t)u.pm * BM * DM;
        const int colg = u.pn * BM + 4 * lane;
        const f32x4 gv = *(const f32x4*)(gate + id * 6144 + colg);
        f32x4 gsv = {0.f, 0.f, 0.f, 0.f}; if (xg) gsv = *(const f32x4*)(gn + colg) * (1.f + *(const f32x4*)(scn + id * 6144 + colg));
#pragma unroll
        for (int ai = 0; ai < 2; ++ai) {
#pragma unroll
            for (int m = 0; m < 4; ++m)
#pragma unroll
                for (int bj = 0; bj < 2; ++bj)
#pragma unroll
                    for (int n = 0; n < 2; ++n) *(PG8_LAS f32x4*)(lds + (wr * 64 + m * 16 + fr) * RS + (bj * HALF + wc * 32 + 8 * fq + 4 * n) * 4) = acc[ai][bj][m][n];
            asm volatile("s_waitcnt lgkmcnt(0)\n\ts_barrier" ::: "memory");
#pragma unroll
            for (int r8 = 0; r8 < 2; ++r8) {
                f32x4 xv[8], av[8]; float s[8];
#pragma unroll
                for (int q = 0; q < 8; ++q) { const int row = wid * 16 + r8 * 8 + q;
                    if constexpr (XF32) xv[q] = *(const f32x4*)(xin + (size_t)(ai * HALF + row) * DM + colg);
                    else { const u32x2 w = *(const u32x2*)(xo + (size_t)(ai * HALF + row) * DM + colg); xv[q] = (f32x4){bflo(w.x), bfhi(w.x), bflo(w.y), bfhi(w.y)}; }
                    av[q] = *(const PG8_LAS f32x4*)(lds + row * RS + lane * 16); }
#pragma unroll
                for (int q = 0; q < 8; ++q) { const int row = wid * 16 + r8 * 8 + q; const f32x4 o = xv[q] + gv * av[q];
                    { u32x2 w; w.x = cvtpk(o[0], o[1]); w.y = cvtpk(o[2], o[3]); *(u32x2*)(xo + (size_t)(ai * HALF + row) * DM + colg) = w; } s[q] = (o[0] * o[0] + o[1] * o[1]) + (o[2] * o[2] + o[3] * o[3]);
                    if (xg) { const f32x4 a = o * gsv; u32x2 w; w.x = cvtpk(a[0], a[1]); w.y = cvtpk(a[2], a[3]); *(u32x2*)(xg + (size_t)(u.pm * BM + ai * HALF + row) * DM + colg) = w; } }
                if (xg) {
#pragma unroll
                    for (int o_ = 1; o_ < 64; o_ <<= 1)
#pragma unroll
                        for (int q = 0; q < 8; ++q) s[q] += shfl_x(s[q], o_, lane);
                    float sv = s[0];
#pragma unroll
                    for (int q = 1; q < 8; ++q) sv = lane == q ? s[q] : sv;
                    if (lane < 8) *(f32x4*)(ssq + (size_t)(u.pm * BM + ai * HALF + wid * 16 + r8 * 8 + lane) * 16 + u.pn * 4) = (f32x4){sv, 0.f, 0.f, 0.f}; }
            }
            asm volatile("s_waitcnt lgkmcnt(0)\n\ts_barrier" ::: "memory");
        }
    }
};
struct EpiUp {
    static constexpr bool PERM = true, AFTER_DRAIN = false, ROWPERM = true, KSEG = false;
    bf16_t* act; const float* convw; const float* convb; float* edge; const LAS float* rtab; const float* bias;
    __device__ __forceinline__ void operator()(f32x4 (&acc)[2][2][4][2], const Unit& u, int wr, int wc, int fr, int fq) const {
        asm volatile("" : "+v"(fr), "+v"(fq));
        const int chb = u.pn * 128 + wc * 32 + 8 * fq;
        const int ht = 2 * u.pm + wr;
        {
            const f32x4 ra = *(const LAS f32x4*)(rtab + u.ui * 256 + (wr * 16 + fr) * 8), rb = *(const LAS f32x4*)(rtab + u.ui * 256 + (wr * 16 + fr) * 8 + 4);
            const float rs[8] = {ra[0], ra[1], ra[2], ra[3], rb[0], rb[1], rb[2], rb[3]};
            const int id = u.pm < 32 ? 0 : (u.pm < 64 ? 1 : 2);
#pragma unroll
            for (int bj = 0; bj < 2; ++bj)
#pragma unroll
                for (int n = 0; n < 2; ++n) { const f32x4 bv = *(const f32x4*)(bias + id * DFF2 + bj * DFF + chb + 4 * n);
#pragma unroll
                    for (int sl = 0; sl < 8; ++sl) { acc[sl >> 2][bj][sl & 3][n] = acc[sl >> 2][bj][sl & 3][n] * rs[sl] + bv; asm volatile("" : "+v"(acc[sl >> 2][bj][sl & 3][n])); } }
        }
        const int lm1 = (fq * 16 + fr - 1) & 63, lp1 = (fq * 16 + fr + 1) & 63;
#pragma unroll
        for (int bj = 0; bj < 2; ++bj)
#pragma unroll
            for (int n = 0; n < 2; ++n) {
                const int uc = bj * DFF + chb + 4 * n;
                if (fr == 0) { *(f32x4*)(edge + ((size_t)ht * 4 + 0) * DFF2 + uc) = acc[0][bj][0][n]; *(f32x4*)(edge + ((size_t)ht * 4 + 1) * DFF2 + uc) = acc[0][bj][1][n]; }
                if (fr == 15) { *(f32x4*)(edge + ((size_t)ht * 4 + 2) * DFF2 + uc) = acc[1][bj][2][n]; *(f32x4*)(edge + ((size_t)ht * 4 + 3) * DFF2 + uc) = acc[1][bj][3][n]; }
#pragma unroll
                for (int j = 0; j < 4; ++j) {
                    const float w0 = convw[uc + j], w1 = convw[DFF2 + uc + j], w2 = convw[2 * DFF2 + uc + j], bb = convb[uc + j];
                    float pv = shfl_idx(acc[1][bj][3][n][j], lm1); const float nx = shfl_idx(acc[0][bj][0][n][j], lp1);
#pragma unroll
                    for (int sl = 0; sl < 8; ++sl) { const float cur = acc[sl >> 2][bj][sl & 3][n][j]; const float nxt = sl < 7 ? acc[(sl + 1) >> 2][bj][(sl + 1) & 3][n][j] : nx;
                        acc[sl >> 2][bj][sl & 3][n][j] = w0 * pv + w1 * cur + w2 * nxt + bb; pv = cur; }
                }
#pragma unroll
                for (int sl = 0; sl < 8; ++sl) asm volatile("" : "+v"(acc[sl >> 2][bj][sl & 3][n]));
            }
        bf16_t* base = act + (size_t)(u.pm * BM + (wr * 16 + fr) * 8) * DFF + chb;
#pragma unroll
        for (int sl = 0; sl < 8; ++sl) {
            const f32x4 g0 = acc[sl >> 2][0][sl & 3][0], g1 = acc[sl >> 2][0][sl & 3][1], v0 = acc[sl >> 2][1][sl & 3][0], v1 = acc[sl >> 2][1][sl & 3][1];
            f32x4 o0, o1;
#pragma unroll
            for (int j = 0; j < 4; ++j) { o0[j] = g0[j] * __builtin_amdgcn_rcpf(1.f + __builtin_amdgcn_exp2f(-LOG2E * g0[j])) * v0[j]; o1[j] = g1[j] * __builtin_amdgcn_rcpf(1.f + __builtin_amdgcn_exp2f(-LOG2E * g1[j])) * v1[j]; }
            u32x4 w; w.x = cvtpk(o0[0], o0[1]); w.y = cvtpk(o0[2], o0[3]); w.z = cvtpk(o1[0], o1[1]); w.w = cvtpk(o1[2], o1[3]);
            const bool skip = (fr == 0 && sl == 0) || (fr == 15 && sl == 7);
            if (!skip) *(u32x4*)(base + (size_t)sl * DFF) = w;
        }
    }
};
template <class Epi, class Sched, bool ALIGN_EPI = false, bool SP2 = false>
__device__ __forceinline__ void gemm_phase(PG8_LAS unsigned char* lds, const Gemm g, const Sched& S, const Epi& E, const int tid) {
    const int wid = __builtin_amdgcn_readfirstlane(tid >> 6), lane = tid & 63, wr = wid >> 2, wc = wid & 3, fr = lane & 15, fq = lane >> 4;
    const int K = g.K, nt = K / BK;
    unsigned voffA[2], voffB[2];
#pragma unroll
    for (int i = 0; i < 2; ++i) { int R, C; stage_rc(tid * 16 + i * 8192, R, C); const int Rb = Epi::PERM ? ((R & ~31) + perm32(R & 31)) : R;
        const int Ra = Epi::ROWPERM ? (((((R >> 6) & 1) * 16 + (R & 15)) << 3) + ((R >> 4) & 3)) : R;
        voffA[i] = (unsigned)(Ra * K + C) * 2u; voffB[i] = (unsigned)(Rb * K + C) * 2u; }
    const size_t kstep = (size_t)(BK * 2);
    const size_t hstep = (size_t)HALF * K * 2;
    const size_t hstepA = Epi::ROWPERM ? (size_t)4 * K * 2 : hstep;
    const size_t tstep = 2 * hstep;
    const unsigned ldsw = (unsigned)wid * 1024u;
    const int aoff = lds_byte(wr * 64 + fr, fq * 8), boff = lds_byte(wc * 32 + fr, fq * 8);
#define PG8_SA(b, h) (((b) * 2 + (h)) * HTB)
#define PG8_SB(b, h) ((4 + (b) * 2 + (h)) * HTB)
#define PG8_STAGE(bufoff, gbase, voff) do { _Pragma("unroll") for (int _i = 0; _i < 2; ++_i) \
        __builtin_amdgcn_global_load_lds((const unsigned*)((const char*)(gbase) + (voff)[_i]), (PG8_LAS unsigned*)(lds + (bufoff) + ldsw + _i * 8192), 16, 0, 0); } while (0)
#define PG8_LDA(dst, b, h) do { _Pragma("unroll") for (int m = 0; m < 4; ++m) _Pragma("unroll") for (int k = 0; k < 2; ++k) dst[m][k] = *(const PG8_LAS bf16x8*)(lds + PG8_SA(b, h) + aoff + m * 2048 + k * 1024); } while (0)
#define PG8_LDB(dst, b, h) do { _Pragma("unroll") for (int n = 0; n < 2; ++n) _Pragma("unroll") for (int k = 0; k < 2; ++k) dst[n][k] = *(const PG8_LAS bf16x8*)(lds + PG8_SB(b, h) + boff + n * 2048 + k * 1024); } while (0)
#define PG8_MMA(ai, bj, At, Bt) do { __builtin_amdgcn_s_setprio(1); _Pragma("unroll") for (int m = 0; m < 4; ++m) _Pragma("unroll") for (int n = 0; n < 2; ++n) _Pragma("unroll") for (int k = 0; k < 2; ++k) \
        acc[ai][bj][m][n] = __builtin_amdgcn_mfma_f32_16x16x32_bf16(Bt[n][k], At[m][k], acc[ai][bj][m][n], 0, 0, 0); __builtin_amdgcn_s_setprio(0); } while (0)
#define PG8_WAIT_V(n) asm volatile("s_waitcnt vmcnt(" #n ")" ::: "memory")
#define PG8_WAIT_L(n) asm volatile("s_waitcnt lgkmcnt(" #n ")" ::: "memory")
#define PG8_BAR __builtin_amdgcn_s_barrier()
#define PG8_SCHED __builtin_amdgcn_sched_barrier(0)
    Unit cur, nxt; int ui = 0;
    if (!S.next(0, cur)) return;
    f32x4 acc[2][2][4][2];
#pragma unroll
    for (int a = 0; a < 2; ++a)
#pragma unroll
        for (int b = 0; b < 2; ++b)
#pragma unroll
            for (int m = 0; m < 4; ++m)
#pragma unroll
                for (int n = 0; n < 2; ++n) acc[a][b][m][n] = (f32x4){0.f, 0.f, 0.f, 0.f};
    bf16x8 At[4][2], B0[2][2], B1[2][2];
    const char* cA = (const char*)g.A + (size_t)cur.pm * tstep; const char* cB = (const char*)g.Bt + (size_t)cur.pn * tstep;
    S.a_ready(cur);
    if constexpr (SP2) {
        PG8_STAGE(PG8_SB(0, 0), cB, voffB); PG8_STAGE(PG8_SB(0, 1), cB + hstep, voffB); PG8_STAGE(PG8_SA(0, 0), cA, voffA); PG8_STAGE(PG8_SA(0, 1), cA + hstepA, voffA);
        if (wr == 1) PG8_BAR;
        PG8_WAIT_V(2); PG8_BAR;
        PG8_STAGE(PG8_SB(1, 0), cB + kstep, voffB); PG8_STAGE(PG8_SA(1, 0), cA + kstep, voffA); PG8_STAGE(PG8_SB(1, 1), cB + hstep + kstep, voffB);
        PG8_WAIT_V(6); PG8_BAR;
    } else {
        PG8_STAGE(PG8_SB(0, 0), cB, voffB); PG8_STAGE(PG8_SA(0, 0), cA, voffA); PG8_STAGE(PG8_SB(0, 1), cB + hstep, voffB); PG8_STAGE(PG8_SA(0, 1), cA + hstepA, voffA);
        if (wr == 1) PG8_BAR;
        PG8_WAIT_V(4); PG8_BAR;
        PG8_STAGE(PG8_SB(1, 0), cB + kstep, voffB); PG8_STAGE(PG8_SA(1, 0), cA + kstep, voffA); PG8_STAGE(PG8_SB(1, 1), cB + hstep + kstep, voffB);
        PG8_WAIT_V(6); PG8_BAR;
    }
    PROBE_PT(lds, 1);
    for (;;) {
        const bool has_next = S.next(ui + 1, nxt);
        const char* nA = has_next ? (const char*)g.A + (size_t)nxt.pm * tstep : cA; const char* nB = has_next ? (const char*)g.Bt + (size_t)nxt.pn * tstep : cB;
        for (int t = 0; t < nt; t += 2) {
            const bool last = (t == nt - 2);
            const char* a1 = cA + (size_t)(t + 1) * kstep;
            const char* a2 = last ? nA : cA + (size_t)(t + 2) * kstep; const char* b2 = last ? nB : cB + (size_t)(t + 2) * kstep;
            const char* a3 = a2 + kstep; const char* b3 = b2 + kstep;
            if (last && has_next) S.a_ready(nxt);
            if constexpr (SP2) {
            PG8_LDB(B0, 0, 0); PG8_LDB(B1, 0, 1); PG8_SCHED; PG8_LDA(At, 0, 0); PG8_STAGE(PG8_SA(1, 1), a1 + hstepA, voffA);
            PG8_WAIT_V(8); PG8_WAIT_L(0); PG8_BAR; PG8_MMA(0, 0, At, B0); PG8_MMA(0, 1, At, B1); PG8_BAR; PG8_SCHED;
            PG8_LDA(At, 0, 1); PG8_STAGE(PG8_SB(0, 0), b2, voffB); PG8_STAGE(PG8_SB(0, 1), b2 + hstep, voffB); PG8_STAGE(PG8_SA(0, 0), a2, voffA);
            PG8_WAIT_V(8); PG8_WAIT_L(0); PG8_BAR; PG8_MMA(1, 0, At, B0); PG8_MMA(1, 1, At, B1); PG8_BAR; PG8_SCHED;
            PG8_LDB(B0, 1, 0); PG8_LDB(B1, 1, 1); PG8_SCHED; PG8_LDA(At, 1, 0); PG8_STAGE(PG8_SA(0, 1), a2 + hstepA, voffA);
            PG8_WAIT_V(8); PG8_WAIT_L(0); PG8_BAR; PG8_MMA(0, 0, At, B0); PG8_MMA(0, 1, At, B1); PG8_BAR; PG8_SCHED;
            PG8_LDA(At, 1, 1); PG8_STAGE(PG8_SB(1, 0), b3, voffB); PG8_STAGE(PG8_SB(1, 1), b3 + hstep, voffB); PG8_STAGE(PG8_SA(1, 0), a3, voffA);
            PG8_WAIT_V(8); PG8_WAIT_L(0); PG8_BAR; PG8_MMA(1, 0, At, B0); PG8_MMA(1, 1, At, B1); PG8_BAR; PG8_SCHED;
            if constexpr (Epi::KSEG) { if (t & 2) E.kseg(acc, t >> 2, wr, fr, lds); }
            } else {
            PG8_LDB(B0, 0, 0); PG8_SCHED; PG8_LDA(At, 0, 0); PG8_STAGE(PG8_SA(1, 1), a1 + hstepA, voffA);
            PG8_WAIT_L(8); PG8_BAR; PG8_WAIT_L(0); PG8_MMA(0, 0, At, B0); PG8_BAR; PG8_SCHED;
            PG8_LDB(B1, 0, 1); PG8_STAGE(PG8_SB(0, 0), b2, voffB);
            PG8_BAR; PG8_WAIT_L(0); PG8_MMA(0, 1, At, B1); PG8_BAR;
            PG8_LDA(At, 0, 1); PG8_STAGE(PG8_SA(0, 0), a2, voffA);
            PG8_BAR; PG8_WAIT_L(0); PG8_MMA(1, 0, At, B0); PG8_BAR; PG8_SCHED;
            PG8_STAGE(PG8_SB(0, 1), b2 + hstep, voffB);
            PG8_WAIT_V(6); PG8_BAR; PG8_MMA(1, 1, At, B1); PG8_BAR;
            PG8_LDB(B0, 1, 0); PG8_SCHED; PG8_LDA(At, 1, 0); PG8_STAGE(PG8_SA(0, 1), a2 + hstepA, voffA);
            PG8_WAIT_L(8); PG8_BAR; PG8_WAIT_L(0); PG8_MMA(0, 0, At, B0); PG8_BAR; PG8_SCHED;
            PG8_LDB(B1, 1, 1); PG8_STAGE(PG8_SB(1, 0), b3, voffB);
            PG8_BAR; PG8_WAIT_L(0); PG8_MMA(0, 1, At, B1); PG8_BAR;
            PG8_LDA(At, 1, 1); PG8_STAGE(PG8_SA(1, 0), a3, voffA);
            PG8_BAR; PG8_WAIT_L(0); PG8_MMA(1, 0, At, B0); PG8_BAR; PG8_SCHED;
            PG8_STAGE(PG8_SB(1, 1), b3 + hstep, voffB);
            PG8_WAIT_V(6); PG8_BAR; PG8_MMA(1, 1, At, B1); PG8_BAR;
            }
        }
        PROBE_PT(lds, 2);
        if constexpr (ALIGN_EPI) { if (wr == 0) PG8_BAR; }
        if constexpr (!Epi::AFTER_DRAIN) { E(acc, cur, wr, wc, fr, fq); S.done(cur); }
        PROBE_PT(lds, 3);
        if (!has_next) break;
#pragma unroll
        for (int a = 0; a < 2; ++a)
#pragma unroll
            for (int b = 0; b < 2; ++b)
#pragma unroll
                for (int m = 0; m < 4; ++m)
#pragma unroll
                    for (int n = 0; n < 2; ++n) acc[a][b][m][n] = (f32x4){0.f, 0.f, 0.f, 0.f};
        cur = nxt; cA = nA; cB = nB; ++ui;
        if constexpr (ALIGN_EPI) { if (wr == 1) PG8_BAR; }
    }
    PG8_WAIT_V(0);
    if constexpr (!ALIGN_EPI) { if (wr == 0) PG8_BAR; }
    PG8_BAR;
    if constexpr (Epi::AFTER_DRAIN) { E.fused(acc, cur, wr, wc, fr, fq, lds, wid, lane); S.done(cur); }
#undef PG8_SA
#undef PG8_SB
#undef PG8_STAGE
#undef PG8_LDA
#undef PG8_LDB
#undef PG8_MMA
#undef PG8_WAIT_V
#undef PG8_WAIT_L
#undef PG8_BAR
#undef PG8_SCHED
}
}

constexpr size_t WS_WGB = WS_WG + 192 * 1024;
constexpr size_t WS_SSQY = 235 * MiB;
constexpr int NWAVES = 8, NTHREADS = 512;
constexpr int LDSCTL_OFF = 155648;
constexpr int LDS_BYTES = LDSCTL_OFF + 256;
struct Args {
    const float* in[21]; float* out; unsigned char* ws; int ph_lo, ph_hi;
};
struct Frame {
    LAS unsigned char* lds;
    int tid, lane, wave, G, bid;
    const __attribute__((address_space(4))) Args* ka;
    float* out; unsigned char* ws;
};
enum { IN_X = 0, IN_C, IN_CTX, IN_CCTX, IN_WMOD, IN_BMOD, IN_G1, IN_G2, IN_WIN, IN_AQG, IN_AKG, IN_SINK, IN_CGB, IN_RPB, IN_GGRP, IN_WOUT, IN_WUP, IN_CONVW, IN_CONVB, IN_WDN, IN_GFIN };

struct TItem { const float* W; bf16_t* WT; int K, N, kind, item; const float* kscale; };
__device__ __forceinline__ int tmap(int kind, int n) {
    if (kind == 0) { if (n < 1024) { const int d = n & 63, hh = (n >> 6) & 3; return (n & ~255) + 128 * (d >> 5) + 32 * hh + 8 * ((d & 15) >> 2) + 4 * ((d >> 4) & 1) + (d & 3); }
                     return n < 2048 ? n : (n < 2064 ? -1 : n - 16); }
    if (kind == 2) { const int m = n < DFF ? n : n - DFF; return (m >> 7) * 256 + (n < DFF ? 0 : 128) + (m & 127); }
    return n;
}
__device__ __forceinline__ void tload(const TItem& t, int lane, f32x4 (&v)[16]) {
    const int nblk = (t.N + 63) / 64, kb = t.item / nblk, nb = t.item % nblk, k0 = 64 * kb, nc = 64 * nb + 4 * (lane & 15);
#pragma unroll
    for (int i = 0; i < 16; ++i) { const int kk = (lane >> 4) + 4 * i; v[i] = nc < t.N ? *(const f32x4*)(t.W + (size_t)(k0 + kk) * t.N + nc) : (f32x4){0.f, 0.f, 0.f, 0.f}; if (t.kscale) v[i] *= t.kscale[k0 + kk]; }
}
__device__ __forceinline__ void tproc(const TItem& t, LAS float* scr, int lane, const f32x4 (&v)[16]) {
    const int nblk = (t.N + 63) / 64, kb = t.item / nblk, nb = t.item % nblk, k0 = 64 * kb, n0 = 64 * nb;
#pragma unroll
    for (int i = 0; i < 16; ++i) { const int kk = (lane >> 4) + 4 * i; LAS float* d = scr + kk * 65 + 4 * (lane & 15); d[0] = v[i][0]; d[1] = v[i][1]; d[2] = v[i][2]; d[3] = v[i][3]; }
    LDS_WAIT(); asm volatile("" ::: "memory");
    const int c = lane & 7;
#pragma unroll
    for (int j = 0; j < 8; ++j) { const int n = (lane >> 3) + 8 * j; const LAS float* s = scr + (8 * c) * 65 + n;
        u32x4 o; o.x = cvtpk(s[0 * 65], s[1 * 65]); o.y = cvtpk(s[2 * 65], s[3 * 65]); o.z = cvtpk(s[4 * 65], s[5 * 65]); o.w = cvtpk(s[6 * 65], s[7 * 65]);
        const int sc = n0 + n; const int dr = sc < t.N ? tmap(t.kind, sc) : -1;
        if (dr >= 0) *(u32x4*)(t.WT + (size_t)dr * t.K + k0 + 8 * c) = o; }
    LDS_WAIT(); asm volatile("" ::: "memory");
}
constexpr int DN0_MIN_G = 144;
constexpr int UP1_UP0 = 400, UP1_LATE = 1100;
constexpr int I_IN = 16 * 45, I_OUT = 16 * 16, I_UP = 16 * 88, I_DN = 44 * 16, I_L = I_IN + I_OUT + I_UP + I_DN;
__device__ __forceinline__ TItem tdecode(const Frame& F, int it) { TItem t; t.kscale = nullptr; const int l = it / I_L; int r = it % I_L;
    if (r < I_IN) { t.W = F.ka->in[IN_WIN] + (size_t)l * 1024 * DIN; t.WT = (bf16_t*)(F.ws + WS_WIN) + (size_t)l * PP * 1024; t.K = 1024; t.N = DIN; t.kind = 0; t.item = r; return t; } r -= I_IN;
    if (r < I_OUT) { t.W = F.ka->in[IN_WOUT] + (size_t)l * 1024 * 1024; t.WT = (bf16_t*)(F.ws + WS_WOUT) + (size_t)l * 1024 * 1024; t.K = 1024; t.N = 1024; t.kind = 1; t.item = r; t.kscale = F.ka->in[IN_GGRP] + l * 1024; return t; } r -= I_OUT;
    if (r < I_UP) { t.W = F.ka->in[IN_WUP] + (size_t)l * 1024 * DFF2; t.WT = (bf16_t*)(F.ws + WS_WUP) + (size_t)l * DFF2 * 1024; t.K = 1024; t.N = DFF2; t.kind = 2; t.item = r; return t; } r -= I_UP;
    t.W = F.ka->in[IN_WDN] + (size_t)l * DFF * 1024; t.WT = (bf16_t*)(F.ws + WS_WDN) + (size_t)l * 1024 * DFF; t.K = DFF; t.N = 1024; t.kind = 1; t.item = r; return t; }
__device__ __forceinline__ void tr_items(Frame& F, int first, int stride, int end) {
    LAS float* scr = (LAS float*)(F.lds + F.wave * 16896);
    int it = first;
    if (it < end) { TItem ta = tdecode(F, it), tb = ta; f32x4 va[16], vb[16]; tload(ta, F.lane, va);
        for (;;) {
            const int i1 = it + stride; if (i1 < end) { tb = tdecode(F, i1); tload(tb, F.lane, vb); }
            tproc(ta, scr, F.lane, va); if (i1 >= end) break;
            const int i2 = i1 + stride; if (i2 < end) { ta = tdecode(F, i2); tload(ta, F.lane, va); }
            tproc(tb, scr, F.lane, vb); if (i2 >= end) break;
            it = i2; } }
}
__device__ __forceinline__ void idle_transposes(Frame& F, int nwg, int lo, int hi) {
    const int nfull = nwg % F.G; int rank = F.bid, n = F.G;
    if (nfull) { if (F.bid < nfull) return; rank = F.bid - nfull; n = F.G - nfull; }
    tr_items(F, lo + rank * NWAVES + F.wave, n * NWAVES, hi);
}
__device__ __forceinline__ void p0_prologue(Frame& F) {
    const float* c = F.ka->in[IN_C]; const float* cctx = F.ka->in[IN_CCTX];
    const int gw = F.bid * NWAVES + F.wave, NGW = F.G * NWAVES;
    if (F.bid < NLAYER * 48 || F.G < NLAYER * 48 + 8) {
        LAS float* sv = (LAS float*)F.lds;
        LAS float* red = (LAS float*)(F.lds + 12288);
        for (int i = F.tid; i < 3 * 1024; i += NTHREADS) { const int id = i >> 10, k = i & 1023; const float v = id < 2 ? c[id * 1024 + k] : cctx[k]; sv[i] = v / (1.f + __expf(-v)); }
        __syncthreads();
        float* MOD = (float*)(F.ws + WS_MOD);
        for (int it = F.bid; it < NLAYER * 48; it += F.G) {
            const int l = it / 48, nb = it % 48, n = nb * 128 + 2 * F.lane;
            const float* w = F.ka->in[IN_WMOD] + ((size_t)l * 1024 + F.wave * 128) * 6144 + n;
            f32x2 a0 = {0.f, 0.f}, a1 = {0.f, 0.f}, a2 = {0.f, 0.f};
#pragma unroll 32
            for (int k = 0; k < 128; ++k) { const f32x2 wv = *(const f32x2*)(w + (size_t)k * 6144); const int kk = F.wave * 128 + k; a0 += sv[kk] * wv; a1 += sv[1024 + kk] * wv; a2 += sv[2048 + kk] * wv; }
            *(LAS f32x2*)(red + (F.wave * 3 + 0) * 128 + 2 * F.lane) = a0; *(LAS f32x2*)(red + (F.wave * 3 + 1) * 128 + 2 * F.lane) = a1; *(LAS f32x2*)(red + (F.wave * 3 + 2) * 128 + 2 * F.lane) = a2;
            __syncthreads();
            if (F.tid < 384) { const int id = F.tid >> 7, ln = F.tid & 127; float s = F.ka->in[IN_BMOD][l * 6144 + nb * 128 + ln];
#pragma unroll
                for (int w8 = 0; w8 < 8; ++w8) s += red[(w8 * 3 + id) * 128 + ln];
                MOD[((size_t)l * 3 + id) * 6144 + nb * 128 + ln] = s; }
            __syncthreads();
        }
    }
    PROBE_PT(F.lds, 1);
    { const int b0 = F.G >= NLAYER * 48 + 8 ? NLAYER * 48 : 0, nb_ = F.G - b0;
      if (F.bid >= b0) { const int gt2 = (F.bid - b0) * NTHREADS + F.tid, NGT2 = nb_ * NTHREADS;
        float* ROPE = (float*)(F.ws + WS_ROPE); float* WG = (float*)(F.ws + WS_WG); bf16_t* WGB = (bf16_t*)(F.ws + WS_WGB);
        for (int e = gt2; e < 192 * 16 + NLAYER * 16 * 1024; e += NGT2) {
            if (e < 192 * 16) { const int idx = e >> 4, i = e & 15; const float pos = (float)(idx < 128 ? idx : idx - 128);
                const float freq = powf(10000.0f, -(float)i / 16.0f); const float ang = pos * freq; ROPE[2 * e] = cosf(ang); ROPE[2 * e + 1] = sinf(ang); }
            else { const int e2 = e - 192 * 16, l = e2 >> 14, o = (e2 >> 10) & 15, k = e2 & 1023; const float v = F.ka->in[IN_WIN][((size_t)l * 1024 + k) * DIN + 2048 + o]; WG[e2] = v; WGB[e2] = (bf16_t)(cvtpk(v, 0.f) & 0xffffu); } } } }
    PROBE_PT(F.lds, 2);
    { const int nm = NLAYER * 48, rk = F.G >= nm + 8 ? (F.bid >= nm ? F.bid - nm : F.bid + (F.G - nm)) : F.bid;
      tr_items(F, rk * NWAVES + F.wave, NGW, F.G >= DN0_MIN_G ? I_IN + I_OUT + I_UP : I_L); }
}

template <int R>
__device__ __forceinline__ void norm_rows(Frame& F, const float* xbase, int row0, const float* sh, const float* sc, const f32x4 (&gv)[4]) {
    bf16_t* H = (bf16_t*)(F.ws + WS_H);
    f32x4 hv[R][4]; float ss[R];
#pragma unroll
    for (int r = 0; r < R; ++r)
#pragma unroll
        for (int j = 0; j < 4; ++j) hv[r][j] = *(const f32x4*)(xbase + (size_t)r * DM + 4 * F.lane + 256 * j);
#pragma unroll
    for (int r = 0; r < R; ++r) { float s = 0.f;
#pragma unroll
        for (int j = 0; j < 4; ++j) s += (hv[r][j][0] * hv[r][j][0] + hv[r][j][1] * hv[r][j][1]) + (hv[r][j][2] * hv[r][j][2] + hv[r][j][3] * hv[r][j][3]);
        ss[r] = s; }
#pragma unroll
    for (int o = 1; o < 64; o <<= 1)
#pragma unroll
        for (int r = 0; r < R; ++r) ss[r] += shfl_x(ss[r], o, F.lane);
#pragma unroll
    for (int j = 0; j < 4; ++j) { const f32x4 scv = 1.f + *(const f32x4*)(sc + 4 * F.lane + 256 * j), shv = *(const f32x4*)(sh + 4 * F.lane + 256 * j);
#pragma unroll
        for (int r = 0; r < R; ++r) { const f32x4 v = hv[r][j] * rsqrtf(ss[r] * (1.f / DM) + EPS) * gv[j] * scv + shv;
            u32x2 w; w.x = cvtpk(v[0], v[1]); w.y = cvtpk(v[2], v[3]);
            *(u32x2*)(H + (size_t)(row0 + r) * DM + 4 * F.lane + 256 * j) = w; } }
}
__device__ __forceinline__ void norm_phase(Frame& F, int layer) {
    const int gw = F.bid * NWAVES + F.wave, NGW = F.G * NWAVES;
    const float* gvec = F.ka->in[IN_G1] + layer * 1024;
    const float* mod = (const float*)(F.ws + WS_MOD) + (size_t)layer * 3 * 6144;
    const float* xl = F.ka->in[IN_X]; const float* xc = F.ka->in[IN_CTX];
    f32x4 gv[4];
#pragma unroll
    for (int j = 0; j < 4; ++j) gv[j] = *(const f32x4*)(gvec + 4 * F.lane + 256 * j);
    for (int rg = gw; rg < NLAT / 8; rg += NGW) { const int row0 = rg * 8, id = row0 < SEQ ? 0 : 1; norm_rows<8>(F, xl + (size_t)row0 * DM, row0, mod + id * 6144, mod + id * 6144 + 1024, gv); }
    for (int rg = gw; rg < NBATCH * CTXL / 2; rg += NGW) { const int row0 = rg * 2; norm_rows<2>(F, xc + (size_t)row0 * DM, NLAT + row0, mod + 2 * 6144, mod + 2 * 6144 + 1024, gv); }
}

constexpr size_t WS_BIASG = WS_BIASIN + 64 * 1024;
__device__ __forceinline__ void bias_phase(Frame& F, int bslot, int nslots, int which) {
    if (bslot < 0 && nslots > 0) return;
    if (nslots <= 0) { bslot = F.bid; nslots = F.G; }
    const int gw = bslot * NWAVES + F.wave, NGW = nslots * NWAVES, lane = F.lane, fr = lane & 15, fq = lane >> 4;
    const float* MOD = (const float*)(F.ws + WS_MOD);
    float* BUP = (float*)(F.ws + WS_BIASUP); float* BIN = (float*)(F.ws + WS_BIASIN); float* BG = (float*)(F.ws + WS_BIASG);
    constexpr int J_UP = DFF2 / 16, J_IN = PP / 16;
    for (int job = gw; job < 2 * J_UP + J_IN + 1; job += NGW) {
        if ((job >= J_UP && job < 2 * J_UP) != (which == 1)) continue;
        const bool isup = job < 2 * J_UP, isin = !isup && job < 2 * J_UP + J_IN; const int l = isup ? job / J_UP : 1, r0 = 16 * (isup ? job % J_UP : (isin ? job - 2 * J_UP : 0));
        const bf16_t* wrow = isup ? (const bf16_t*)(F.ws + WS_WUP) + ((size_t)l * DFF2 + r0 + fr) * 1024 : (isin ? (const bf16_t*)(F.ws + WS_WIN) + ((size_t)PP + r0 + fr) * 1024 : (const bf16_t*)(F.ws + WS_WGB) + (size_t)(16 + fr) * 1024);
        const float* sh = MOD + ((size_t)l * 3 + (fr < 3 ? fr : 0)) * 6144 + (isup ? 3 * 1024 : 0) + 8 * fq;
        const bf16_t* bp = wrow + 8 * fq;
        f32x4 acc = {0.f, 0.f, 0.f, 0.f};
        for (int k0 = 0; k0 < DM / 32; k0 += 8) { f32x4 a0[8], a1[8]; bf16x8 bv[8];
#pragma unroll
            for (int j = 0; j < 8; ++j) { a0[j] = *(const f32x4*)(sh + 32 * (k0 + j)); a1[j] = *(const f32x4*)(sh + 32 * (k0 + j) + 4); bv[j] = *(const bf16x8*)(bp + 32 * (k0 + j)); }
#pragma unroll
            for (int j = 0; j < 8; ++j) { u32x4 aw; aw.x = cvtpk(a0[j][0], a0[j][1]); aw.y = cvtpk(a0[j][2], a0[j][3]); aw.z = cvtpk(a1[j][0], a1[j][1]); aw.w = cvtpk(a1[j][2], a1[j][3]);
                acc = __builtin_amdgcn_mfma_f32_16x16x32_bf16(__builtin_bit_cast(bf16x8, aw), bv[j], acc, 0, 0, 0); } }
        if (fq == 0) { const int r = r0 + fr;
            if (isup) { const int pn = r >> 8, i = r & 255; const int uc = i < 128 ? pn * 128 + i : DFF + pn * 128 + (i - 128);
                BUP[((size_t)l * 3 + 0) * DFF2 + uc] = acc[0]; BUP[((size_t)l * 3 + 1) * DFF2 + uc] = acc[1]; BUP[((size_t)l * 3 + 2) * DFF2 + uc] = acc[2]; }
            else if (isin) { BIN[r] = acc[0]; BIN[PP + r] = acc[1]; BIN[2 * PP + r] = acc[2]; }
            else { BG[fr] = acc[0]; BG[16 + fr] = acc[1]; BG[32 + fr] = acc[2]; } }
    }
}
__device__ __forceinline__ void gates_phase(Frame& F, int layer) {
    const int gw = F.bid * NWAVES + F.wave, NGW = F.G * NWAVES, lane = F.lane, fr = lane & 15, fq = lane >> 4;
    const bf16_t* H = (const bf16_t*)(F.ws + WS_H); const float* SSQ = (const float*)(F.ws + WS_SSQ1); const float* SSQC = (const float*)(F.ws + WS_SSQC1);
    const bf16_t* WGB = (const bf16_t*)(F.ws + WS_WGB) + (size_t)layer * 16 * 1024; const float* BG = (const float*)(F.ws + WS_BIASG);
    float* GATES = (float*)(F.ws + WS_GATES);
    for (int job = gw; job < NROWS / 16; job += NGW) {
        const int r0 = 16 * job; const int id = r0 < SEQ ? 0 : (r0 < NLAT ? 1 : 2);
        const bf16_t* ap = H + (size_t)(r0 + fr) * DM + 8 * fq; const bf16_t* bp = WGB + (size_t)fr * DM + 8 * fq;
        f32x4 acc = {0.f, 0.f, 0.f, 0.f};
        for (int k0 = 0; k0 < DM / 32; k0 += 16) { bf16x8 av[16], bv[16];
#pragma unroll
            for (int j = 0; j < 16; ++j) { av[j] = *(const bf16x8*)(ap + 32 * (k0 + j)); bv[j] = *(const bf16x8*)(bp + 32 * (k0 + j)); }
#pragma unroll
            for (int j = 0; j < 16; ++j) acc = __builtin_amdgcn_mfma_f32_16x16x32_bf16(av[j], bv[j], acc, 0, 0, 0); }
        float rs[4] = {1.f, 1.f, 1.f, 1.f}, bo = 0.f;
        if (layer > 0) {
            float s = 0.f;
            if (r0 < NLAT) { const f32x4 a = *(const f32x4*)(SSQ + (size_t)(r0 + (lane >> 2)) * 16 + 4 * (lane & 3)); s = (a[0] + a[1]) + (a[2] + a[3]); }
            else { const float* p = SSQC + (size_t)(r0 - NLAT + (lane >> 2)) * 64 + 16 * (lane & 3);
#pragma unroll
                for (int j = 0; j < 4; ++j) { const f32x4 a = *(const f32x4*)(p + 4 * j); s += (a[0] + a[1]) + (a[2] + a[3]); } }
            s += shfl_x(s, 1, lane); s += shfl_x(s, 2, lane);
            const float rr = rsqrtf(s * (1.f / DM) + EPS);
#pragma unroll
            for (int r = 0; r < 4; ++r) rs[r] = shfl_idx(rr, 4 * (4 * fq + r));
            bo = BG[id * 16 + fr];
        }
#pragma unroll
        for (int r = 0; r < 4; ++r) GATES[(size_t)(r0 + 4 * fq + r) * 16 + fr] = acc[r] * rs[r] + bo;
    }
}

__device__ __forceinline__ void postproj_phase(Frame& F, int layer) {
    const int gw = F.bid * NWAVES + F.wave, NGW = F.G * NWAVES;
    bf16_t* PROJ = (bf16_t*)(F.ws + WS_PROJ);
    const float* ROPE = (const float*)(F.ws + WS_ROPE);
    const int sub = F.lane >> 4, l16 = F.lane & 15, d = 4 * l16;
    const f32x4 gq = *(const f32x4*)(F.ka->in[IN_AQG] + layer * 64 + d), gk = *(const f32x4*)(F.ka->in[IN_AKG] + layer * 64 + d);
    const bool x2 = (l16 & 4) != 0;
    for (int rg = gw; rg < NROWS / 4; rg += NGW) {
        const int row0 = 4 * rg; const bool lat = row0 < NLAT;
        u32x2 w[4][3]; f32x4 cs0[4], cs1[4];
#pragma unroll
        for (int q = 0; q < 4; ++q) { const bf16_t* pr = PROJ + (size_t)(row0 + q) * PP; const int t = (row0 + q) & (SEQ - 1);
            cs0[q] = (f32x4){1.f, 0.f, 1.f, 0.f}; cs1[q] = cs0[q];
            if (lat) { const int idx = (d >> 5) ? 128 + (t & 63) : (t >> 6); const float* rp = ROPE + ((size_t)idx * 16 + (d & 15)) * 2; cs0[q] = *(const f32x4*)rp; cs1[q] = *(const f32x4*)(rp + 4); }
#pragma unroll
            for (int pass = 0; pass < 3; ++pass) { const int col = pass == 0 ? PC_AQ + 64 * sub + d : (pass == 1 ? (sub < 2 ? PC_AK + 64 * sub + d : PC_BK + 64 * (sub - 2) + d) : PC_BQ + 64 * sub + d);
                w[q][pass] = *(const u32x2*)(pr + col); } }
#pragma unroll
        for (int q = 0; q < 4; ++q) { bf16_t* pr = PROJ + (size_t)(row0 + q) * PP;
            const float cz[4] = {cs0[q][0], cs0[q][2], cs1[q][0], cs1[q][2]}, sz[4] = {cs0[q][1], cs0[q][3], cs1[q][1], cs1[q][3]};
#pragma unroll
            for (int pass = 0; pass < 3; ++pass) {
                const int col = pass == 0 ? PC_AQ + 64 * sub + d : (pass == 1 ? (sub < 2 ? PC_AK + 64 * sub + d : PC_BK + 64 * (sub - 2) + d) : PC_BQ + 64 * sub + d);
                const bool donorm = pass == 0 || (pass == 1 && sub < 2);
                const bool active = lat || donorm;
                if (!lat && pass == 2) continue;
                float v[4] = {bflo(w[q][pass].x), bfhi(w[q][pass].x), bflo(w[q][pass].y), bfhi(w[q][pass].y)};
                float ss = (v[0] * v[0] + v[1] * v[1]) + (v[2] * v[2] + v[3] * v[3]);
                ss += shfl_x(ss, 1, F.lane); ss += shfl_x(ss, 2, F.lane); ss += shfl_x(ss, 4, F.lane); ss += shfl_x(ss, 8, F.lane);
                if (donorm) { const float rstd = rsqrtf(ss * (1.f / 64.f) + EPS) * (pass == 0 ? QSCALE2 : 1.f); const f32x4 g = pass == 0 ? gq : gk;
#pragma unroll
                    for (int e = 0; e < 4; ++e) v[e] = v[e] * rstd * g[e]; }
                float o[4];
#pragma unroll
                for (int e = 0; e < 4; ++e) { const float p = shfl_x(v[e], 4, F.lane); o[e] = x2 ? (p * sz[e] + v[e] * cz[e]) : (v[e] * cz[e] - p * sz[e]); }
                if (active) { u32x2 ow; ow.x = cvtpk(o[0], o[1]); ow.y = cvtpk(o[2], o[3]); *(u32x2*)(pr + col) = ow; }
            } }
    }
}

template <bool WT = false>
__device__ __forceinline__ void groupnorm_rows(Frame& F, int layer, int row0, int nrows, int wv, int nw) {
    const bf16_t* H = (const bf16_t*)(F.ws + WS_H); bf16_t* YN = (bf16_t*)(F.ws + WS_PROJ);
    for (int r = 4 * wv; r < nrows; r += 4 * nw) {
        u32x2 w[4][4]; float ss[4][4];
#pragma unroll
        for (int q = 0; q < 4; ++q)
#pragma unroll
            for (int j = 0; j < 4; ++j) w[q][j] = *(const u32x2*)(H + (size_t)(row0 + r + q) * DM + 4 * F.lane + 256 * j);
#pragma unroll
        for (int q = 0; q < 4; ++q)
#pragma unroll
            for (int j = 0; j < 4; ++j) { const float v0 = bflo(w[q][j].x), v1 = bfhi(w[q][j].x), v2 = bflo(w[q][j].y), v3 = bfhi(w[q][j].y); ss[q][j] = (v0 * v0 + v1 * v1) + (v2 * v2 + v3 * v3); }
#pragma unroll
        for (int o = 1; o < 64; o <<= 1)
#pragma unroll
            for (int q = 0; q < 4; ++q)
#pragma unroll
                for (int j = 0; j < 4; ++j) ss[q][j] += shfl_x(ss[q][j], o, F.lane);
#pragma unroll
        for (int q = 0; q < 4; ++q)
#pragma unroll
            for (int j = 0; j < 4; ++j) { const float rstd = rsqrtf(ss[q][j] * (1.f / 256.f) + EPS);
                u32x2 o; o.x = cvtpk(bflo(w[q][j].x) * rstd, bfhi(w[q][j].x) * rstd); o.y = cvtpk(bflo(w[q][j].y) * rstd, bfhi(w[q][j].y) * rstd);
                if (WT) __hip_atomic_store((unsigned long long*)(YN + (size_t)(row0 + r + q) * DM + 4 * F.lane + 256 * j), (unsigned long long)o.x | ((unsigned long long)o.y << 32), __ATOMIC_RELAXED, __HIP_MEMORY_SCOPE_AGENT);
                else *(u32x2*)(YN + (size_t)(row0 + r + q) * DM + 4 * F.lane + 256 * j) = o; }
    }
}

__device__ __forceinline__ void fixup_hts(Frame& F, int layer, int ht0, int nht, int first = -1, int stride = NTHREADS) {
    const float* edge = (const float*)((const unsigned char*)F.out + OUT_EDGE);
    const float* cw = F.ka->in[IN_CONVW] + (size_t)layer * 3 * DFF2; const float* cb = F.ka->in[IN_CONVB] + (size_t)layer * DFF2;
    bf16_t* act = (bf16_t*)(F.ws + WS_PROJ);
    const int per_row = DFF / 4;
    for (int it = first >= 0 ? first : F.tid; it < nht * 2 * per_row; it += stride) {
        const int ch = (it % per_row) * 4, rr = it / per_row, ht = ht0 + (rr >> 1), last = rr & 1;
        const bool seq_start = (ht == 0 || ht == 64 || ht == 128 || ht == 130), seq_end = (ht == 63 || ht == 127 || ht == 129 || ht == 131);
        const int row = ht * 128 + (last ? 127 : 0);
        f32x4 o;
        f32x4 res[2];
#pragma unroll
        for (int gvv = 0; gvv < 2; ++gvv) { const int uc = gvv * DFF + ch;
            const f32x4 z = {0.f, 0.f, 0.f, 0.f};
            f32x4 up, ucur, un;
            if (!last) { up = seq_start ? z : *(const f32x4*)(edge + ((size_t)(ht - 1) * 4 + 3) * DFF2 + uc); ucur = *(const f32x4*)(edge + ((size_t)ht * 4 + 0) * DFF2 + uc); un = *(const f32x4*)(edge + ((size_t)ht * 4 + 1) * DFF2 + uc); }
            else { up = *(const f32x4*)(edge + ((size_t)ht * 4 + 2) * DFF2 + uc); ucur = *(const f32x4*)(edge + ((size_t)ht * 4 + 3) * DFF2 + uc); un = seq_end ? z : *(const f32x4*)(edge + ((size_t)(ht + 1) * 4 + 0) * DFF2 + uc); }
            res[gvv] = *(const f32x4*)(cw + uc) * up + *(const f32x4*)(cw + DFF2 + uc) * ucur + *(const f32x4*)(cw + 2 * DFF2 + uc) * un + *(const f32x4*)(cb + uc); }
#pragma unroll
        for (int j = 0; j < 4; ++j) o[j] = res[0][j] / (1.f + __expf(-res[0][j])) * res[1][j];
        u32x2 w; w.x = cvtpk(o[0], o[1]); w.y = cvtpk(o[2], o[3]);
        *(u32x2*)(act + (size_t)row * DFF + ch) = w;
    }
}

template <int KDIM>
__device__ __forceinline__ void skinny_ctx(Frame& F, const bf16_t* A  , const bf16_t* Wt  , const float* xin32  , bf16_t* xb  , const float* gate  ,
                                           bf16_t* xg  , const float* gn, const float* scn  , float* ssqc, unsigned* queue  , unsigned* ready  , unsigned need) {
    const int lane = F.lane, fr = lane & 15, fq = lane >> 4, t = F.tid, ldrow = t >> 3, chunk = t & 7;
    const int rf = F.wave >> 1, cp = F.wave & 1;
    constexpr int RSB = 272, BUFB = 64 * RSB, NKB = KDIM / 128;
    for (;;) {
        if (t == 0) *(volatile LAS unsigned*)(F.lds + LDSCTL_OFF + 192) = __hip_atomic_fetch_add(queue, 1u, __ATOMIC_RELAXED, __HIP_MEMORY_SCOPE_AGENT);
        __syncthreads();
        const int p = __builtin_amdgcn_readfirstlane((int)*(volatile LAS unsigned*)(F.lds + LDSCTL_OFF + 192));
        if (p >= 128) {
            if (KDIM == DM && F.G >= DN0_MIN_G && p < 128 + 120) tr_items(F, I_IN + I_OUT + I_UP + (p - 128) * NWAVES + F.wave, 120 * NWAVES, I_L);
            if (KDIM == DFF && F.G >= 256 && p < 256) tr_items(F, I_L + I_IN + I_OUT + UP1_UP0 + (p - 128) * NWAVES + F.wave, 128 * NWAVES, I_L + I_IN + I_OUT + UP1_LATE);
            break; }
        if (ready) { if (t == 0) { unsigned sp = 0; while (__hip_atomic_load(ready, __ATOMIC_RELAXED, __HIP_MEMORY_SCOPE_AGENT) < need && ++sp < (1u << 22)) __builtin_amdgcn_s_sleep(1);
                __builtin_amdgcn_fence(__ATOMIC_ACQUIRE, "agent"); asm volatile("s_waitcnt vmcnt(0)" ::: "memory"); }
            __syncthreads(); }
        const int rg = p >> 4, cg = p & 15;
        if (KDIM == DM) { groupnorm_rows<false>(F, 0, NLAT + 64 * rg, 64, F.wave, NWAVES); VM_WAIT(); __syncthreads(); }
        const bf16_t* asrc = A + (size_t)(64 * rg + ldrow) * KDIM + 8 * chunk; const bf16_t* bsrc = Wt + (size_t)(64 * cg + ldrow) * KDIM + 8 * chunk;
        u32x4 ra[4][2], rb[4][2];
#pragma unroll
        for (int i = 0; i < 4; ++i)
#pragma unroll
            for (int hh = 0; hh < 2; ++hh) { ra[i][hh] = *(const u32x4*)(asrc + 128 * i + 64 * hh); rb[i][hh] = *(const u32x4*)(bsrc + 128 * i + 64 * hh); }
        f32x4 acc[2] = {{0.f, 0.f, 0.f, 0.f}, {0.f, 0.f, 0.f, 0.f}};
        __syncthreads();
        for (int kb0 = 0; kb0 < NKB; kb0 += 4) {
#pragma unroll
            for (int i = 0; i < 4; ++i) { const int kb = kb0 + i; if (kb < NKB) { LAS unsigned char* ba = F.lds + (kb & 1) * 2 * BUFB; LAS unsigned char* bb = ba + BUFB;
#pragma unroll
                for (int hh = 0; hh < 2; ++hh) { *(LAS u32x4*)(ba + ldrow * RSB + 128 * hh + 16 * chunk) = ra[i][hh]; *(LAS u32x4*)(bb + ldrow * RSB + 128 * hh + 16 * chunk) = rb[i][hh]; }
                if (kb + 4 < NKB) {
#pragma unroll
                    for (int hh = 0; hh < 2; ++hh) { ra[i][hh] = *(const u32x4*)(asrc + 128 * (kb + 4) + 64 * hh); rb[i][hh] = *(const u32x4*)(bsrc + 128 * (kb + 4) + 64 * hh); } }
                __syncthreads();
#pragma unroll
                for (int ks = 0; ks < 4; ++ks) { const bf16x8 af = *(const LAS bf16x8*)(ba + (16 * rf + fr) * RSB + 64 * ks + 16 * fq);
#pragma unroll
                    for (int j = 0; j < 2; ++j) { const bf16x8 bf = *(const LAS bf16x8*)(bb + (32 * cp + 16 * j + fr) * RSB + 64 * ks + 16 * fq); acc[j] = __builtin_amdgcn_mfma_f32_16x16x32_bf16(af, bf, acc[j], 0, 0, 0); } }
            } }
        }
        float ss[4] = {0.f, 0.f, 0.f, 0.f};
#pragma unroll
        for (int j = 0; j < 2; ++j) { const int n = 64 * cg + 32 * cp + 16 * j + fr; const float g = gate[n], gs = gn[n] * (1.f + scn[n]);
#pragma unroll
            for (int r = 0; r < 4; ++r) { const int row = 64 * rg + 16 * rf + 4 * fq + r; const float xi = xin32 ? xin32[(size_t)row * DM + n] : __uint_as_float((unsigned)xb[(size_t)row * DM + n] << 16); const float o = xi + g * acc[j][r];
                xb[(size_t)row * DM + n] = (bf16_t)(cvtpk(o, 0.f) & 0xffffu); xg[(size_t)row * DM + n] = (bf16_t)(cvtpk(o * gs, 0.f) & 0xffffu); ss[r] += o * o; } }
#pragma unroll
        for (int r = 0; r < 4; ++r) { float s = ss[r]; s += shfl_x(s, 1, lane); s += shfl_x(s, 2, lane); s += shfl_x(s, 4, lane); s += shfl_x(s, 8, lane);
            if (fr == 0) { float* sp = ssqc + (size_t)(64 * rg + 16 * rf + 4 * fq + r) * 64 + cg * 2 + cp; sp[0] = s; sp[32] = 0.f; } }
        if (F.G >= 256) break;
        __syncthreads();
    }
}

__device__ __forceinline__ void final_phase(Frame& F) {
    const int gw = F.bid * NWAVES + F.wave, NGW = F.G * NWAVES;
    const float* gf = F.ka->in[IN_GFIN];
    f32x4 gv[4];
#pragma unroll
    for (int j = 0; j < 4; ++j) gv[j] = *(const f32x4*)(gf + 4 * F.lane + 256 * j);
    for (int rg = gw; rg < NLAT / 8; rg += NGW) {
        const bf16_t* xr = (const bf16_t*)(F.ws + WS_XB) + (size_t)rg * 8 * DM + 4 * F.lane; float* orow = F.out + (size_t)rg * 8 * DM + 4 * F.lane;
        u32x2 w[8][4]; float ss[8];
#pragma unroll
        for (int r = 0; r < 8; ++r)
#pragma unroll
            for (int j = 0; j < 4; ++j) w[r][j] = *(const u32x2*)(xr + (size_t)r * DM + 256 * j);
#pragma unroll
        for (int r = 0; r < 8; ++r) { float s = 0.f;
#pragma unroll
            for (int j = 0; j < 4; ++j) { const float v0 = bflo(w[r][j].x), v1 = bfhi(w[r][j].x), v2 = bflo(w[r][j].y), v3 = bfhi(w[r][j].y); s += (v0 * v0 + v1 * v1) + (v2 * v2 + v3 * v3); }
            ss[r] = s; }
#pragma unroll
        for (int o = 1; o < 64; o <<= 1)
#pragma unroll
            for (int r = 0; r < 8; ++r) ss[r] += shfl_x(ss[r], o, F.lane);
#pragma unroll
        for (int r = 0; r < 8; ++r) { const float rstd = rsqrtf(ss[r] * (1.f / DM) + EPS);
#pragma unroll
            for (int j = 0; j < 4; ++j) { const f32x4 v = {bflo(w[r][j].x), bfhi(w[r][j].x), bflo(w[r][j].y), bfhi(w[r][j].y)}; *(f32x4*)(orow + (size_t)r * DM + 256 * j) = v * rstd * gv[j]; } }
    }
}

typedef GAS unsigned gu32;
#define RLX_AGENT __ATOMIC_RELAXED, __HIP_MEMORY_SCOPE_AGENT
constexpr int CW_BAR = 4096;
#define XB_TMO      128
#define XB_XCNT(j)  (256  + 64 * (j))
#define XB_XSUB(j)  (1280 + 64 * (j))
#define XB_XGEN(j)  (2304 + 64 * (j))
#define XB_TOP      3328
#define XB_TOPGEN   3392
#define XCD_BAR_WORDS 3456
#define XB_SPIN_CAP (1u << 18)

__device__ __forceinline__ unsigned xb_ld(unsigned* p)              { return __hip_atomic_load(p, __ATOMIC_RELAXED, __HIP_MEMORY_SCOPE_AGENT); }
__device__ __forceinline__ unsigned xb_add(unsigned* p, unsigned v) { return __hip_atomic_fetch_add(p, v, __ATOMIC_RELAXED, __HIP_MEMORY_SCOPE_AGENT); }
__device__ __forceinline__ unsigned xb_xcc_id() { return (unsigned)__builtin_amdgcn_s_getreg((3 << 11) | 20) & 0xFu; }
#define XB_SPIN(cond, bar) do { unsigned _sp = 0; while (cond) { __builtin_amdgcn_s_sleep(1); \
    if ((++_sp & 255u) == 0u) { if (xb_ld(&(bar)[XB_TMO])) break; if (_sp > XB_SPIN_CAP) { atomicAdd(&(bar)[XB_TMO], 1u); break; } } } } while (0)

struct XcdBarrier {
    unsigned* bar; unsigned x;
    volatile LAS unsigned* st;
};

__device__ __forceinline__ XcdBarrier xcd_barrier_post(unsigned* bar, volatile LAS unsigned* st, bool is_t0) {
    XcdBarrier b; b.bar = bar; b.x = xb_xcc_id(); b.st = st;
    if (is_t0) (void)xb_add(&bar[XB_XCNT(b.x)], 1u);
    return b;
}
__device__ __forceinline__ void xcd_barrier_complete(unsigned* bar, unsigned x, unsigned& nloc, unsigned& nx) {
    const unsigned G = gridDim.x * gridDim.y * gridDim.z;
    unsigned sum, cnt, mine, sp = 0u;
    for (;;) {
        sum = 0u; cnt = 0u; mine = 0u;
#pragma unroll
        for (unsigned j = 0; j < 16; ++j) { const unsigned c = xb_ld(&bar[XB_XCNT(j)]); sum += c; cnt += (c > 0u) ? 1u : 0u; mine = (j == x) ? c : mine; }
        if (sum == G) break;
        __builtin_amdgcn_s_sleep(1);
        if ((++sp & 255u) == 0u) { if (xb_ld(&bar[XB_TMO])) break; if (sp > XB_SPIN_CAP) { atomicAdd(&bar[XB_TMO], 1u); break; } }
    }
    nloc = mine > 0u ? mine : 1u; nx = cnt > 0u ? cnt : 1u;
}

__device__ __forceinline__ void xcd_barrier(const XcdBarrier& b, bool is_t0) {
    asm volatile("s_waitcnt vmcnt(0)" ::: "memory");
    __syncthreads();
    if (is_t0) {
        unsigned* bar = b.bar;
        __builtin_amdgcn_s_waitcnt(0);
        unsigned nloc = b.st[0], nx = b.st[1];
        if (nloc == 0u) { xcd_barrier_complete(bar, b.x, nloc, nx); b.st[0] = nloc; b.st[1] = nx; }
        const unsigned old = xb_add(&bar[XB_XSUB(b.x)], 1u);
        const unsigned gen = old / nloc;
        if (old + 1u == (gen + 1u) * nloc) {
            __builtin_amdgcn_fence(__ATOMIC_RELEASE, "agent");
            asm volatile("s_waitcnt vmcnt(0)" ::: "memory");
            const unsigned og = xb_add(&bar[XB_TOP], 1u);
            const unsigned tg = og / nx;
            if (og + 1u == (tg + 1u) * nx) xb_add(&bar[XB_TOPGEN], 1u);
            else XB_SPIN(xb_ld(&bar[XB_TOPGEN]) == tg, bar);
            __builtin_amdgcn_fence(__ATOMIC_ACQUIRE, "agent");
            xb_add(&bar[XB_XGEN(b.x)], 1u);
            asm volatile("s_waitcnt vmcnt(0)" ::: "memory");
        } else {
            XB_SPIN(xb_ld(&bar[XB_XGEN(b.x)]) == gen, bar);
            __builtin_amdgcn_fence(__ATOMIC_ACQUIRE, "agent");
            asm volatile("s_waitcnt vmcnt(0)" ::: "memory");
        }
    }
    __syncthreads();
}

namespace att {
constexpr int SLOTB = 8192;
constexpr int L_K = 0, L_V = 2 * SLOTB, L_WS = 4 * SLOTB, L_OST = L_WS + 8 * 256, L_RPB = L_OST + 8 * 4096, L_END = L_RPB + 2048;
constexpr float THR = 8.0f;
__device__ __forceinline__ int crow(int r, int hi) { return (r & 3) + 8 * (r >> 2) + 4 * hi; }
__device__ __forceinline__ s16x4 vtr(const LAS unsigned char* p) { return __builtin_bit_cast(s16x4, __builtin_amdgcn_ds_read_tr16_b64_v4i16((LAS v4i16_t*)p)); }
__device__ __forceinline__ float rowmax32(const f32x16& p0, const f32x16& p1) {
    float a = fmaxf(p0[0], p1[0]);
#pragma unroll
    for (int r = 1; r < 16; ++r) a = fmaxf(a, fmaxf(p0[r], p1[r]));
    auto rr = __builtin_amdgcn_permlane32_swap(__float_as_uint(a), __float_as_uint(a), false, false);
    return fmaxf(__uint_as_float(rr[0]), __uint_as_float(rr[1]));
}
__device__ __forceinline__ float halfsum(float v) {
    auto rr = __builtin_amdgcn_permlane32_swap(__float_as_uint(v), __float_as_uint(v), false, false);
    return __uint_as_float(rr[0]) + __uint_as_float(rr[1]);
}
#define ATT_WAIT_BAR() asm volatile("s_waitcnt vmcnt(0) lgkmcnt(0)\n\ts_barrier" ::: "memory")

template <int MODE>
__device__ __forceinline__ void attn_unit(Frame& F, int b, int h, int qb, int qcol, int kcol, int vcol, int ycol, float sink2, const float* rpb) {
    LAS unsigned char* lds = F.lds;
    const int lane = F.lane, r32 = lane & 31, hi = lane >> 5, wid = F.wave;
    const bf16_t* PROJ = (const bf16_t*)(F.ws + WS_PROJ); bf16_t* Y = (bf16_t*)(F.ws + WS_H);
    const int ctxrow = NLAT + CTXL * b, latrow = SEQ * b;
    const int qrow0 = (MODE == 3) ? ctxrow : latrow + 256 * qb;
    const int qw0 = 256 * qb + 32 * wid;
    int lt_lo = 0, nloc = 0;
    if (MODE == 0) { lt_lo = 0; nloc = 128; }
    if (MODE == 1) { const int a = (256 * qb - 128) >> 6, e = (256 * qb + 255 + 128) >> 6; lt_lo = a < 0 ? 0 : a; nloc = (e > 127 ? 127 : e) - lt_lo + 1; }
    if (MODE == 2) { const int a = 4 * qb - 4, e0 = 4 * qb - 1; lt_lo = a < 0 ? 0 : (a > 120 ? 120 : a); const int e = (e0 < 0 ? 0 : (e0 > 120 ? 120 : e0)) + 7; nloc = e - lt_lo + 1; }
    const int NT = 4 + nloc;
    const int rw = 4 * qb + (wid >> 1); const int rs = rw - 4 < 0 ? 0 : (rw - 4 > 120 ? 120 : rw - 4);
    const int qc = 32 * (wid & 1) + r32; const int cs = qc - 8 < 0 ? 0 : (qc - 8 > 48 ? 48 : qc - 8);
    LAS float* wsf = (LAS float*)(lds + L_WS) + wid * 64;
    LAS float* rpbL = (LAS float*)(lds + L_RPB);
    if (MODE == 2) { for (int i = F.tid; i < 465; i += NTHREADS) rpbL[i] = rpb[i] * LOG2E; }
    const int vp0 = ((lane >> 4) & 1) * 32 + (lane & 3) * 8 + (4 * hi + ((lane & 15) >> 2)) * 64;
#define ATT_KROW(t) ((t) < 4 ? ctxrow + 64 * (t) : latrow + 64 * (lt_lo + (t) - 4))
#define ATT_DMA(t, slot) do { const int kr_ = ATT_KROW(t); \
        __builtin_amdgcn_global_load_lds((const unsigned*)(PROJ + (size_t)(kr_ + lane) * PP + kcol + wid * 8), (LAS unsigned*)(lds + L_K + (slot) * SLOTB + wid * 1024), 16, 0, 0); \
        __builtin_amdgcn_global_load_lds((const unsigned*)(PROJ + (size_t)(kr_ + 16 * (wid & 3) + (lane >> 2)) * PP + vcol + (wid >> 2) * 32 + (lane & 3) * 8), (LAS unsigned*)(lds + L_V + (slot) * SLOTB + wid * 1024), 16, 0, 0); } while (0)
    ATT_DMA(0, 0);
    bf16x8 qr[4];
#pragma unroll
    for (int d0 = 0; d0 < 4; ++d0) qr[d0] = *(const bf16x8*)(PROJ + (size_t)(qrow0 + 32 * wid + r32) * PP + qcol + d0 * 16 + hi * 8);
    float mhat = 0.f, l = 0.f; f32x16 o0 = {}, o1 = {}, negm = {};
    ATT_WAIT_BAR();
    for (int t = 0; t < NT; ++t) {
        const int slot = t & 1;
        if (t + 1 < NT) ATT_DMA(t + 1, slot ^ 1);
        bool rel = true; int kb0 = 0;
        if (MODE == 1 && t >= 4) { kb0 = 64 * (lt_lo + t - 4); rel = (kb0 + 63 >= qw0 - 128) && (kb0 <= qw0 + 31 + 128); }
        if (MODE == 2 && t >= 4) { kb0 = lt_lo + t - 4; rel = (kb0 >= rs) && (kb0 < rs + 8); }
        if (rel) {
            const LAS unsigned char* kb = lds + L_K + slot * SLOTB + hi * 1024 + r32 * 16;
            f32x16 p0 = negm, p1 = negm;
#pragma unroll
            for (int d0 = 0; d0 < 4; ++d0) {
                const bf16x8 b0 = *(const LAS bf16x8*)(kb + d0 * 2048), b1 = *(const LAS bf16x8*)(kb + d0 * 2048 + 512);
                p0 = __builtin_amdgcn_mfma_f32_32x32x16_bf16(b0, qr[d0], p0, 0, 0, 0);
                p1 = __builtin_amdgcn_mfma_f32_32x32x16_bf16(b1, qr[d0], p1, 0, 0, 0);
            }
            if (MODE == 1 && t >= 4) {
                const int dq = kb0 - (qw0 + r32);
#pragma unroll
                for (int r = 0; r < 16; ++r) { const int kc = crow(r, hi); const int d0_ = dq + kc, d1_ = d0_ + 32;
                    if (d0_ > 128 || d0_ < -128) p0[r] = -INFINITY; if (d1_ > 128 || d1_ < -128) p1[r] = -INFINITY; }
            }
            if (MODE == 2 && t >= 4) {
                const LAS float* bt = rpbL + (kb0 - rw + 7) * 31 + (15 - qc);
#pragma unroll
                for (int r = 0; r < 16; ++r) { const int kc = crow(r, hi);
                    const bool v0 = (kc >= cs) && (kc < cs + 16), v1 = (kc + 32 >= cs) && (kc + 32 < cs + 16);
                    p0[r] = v0 ? p0[r] + bt[v0 ? kc : qc] : -INFINITY; p1[r] = v1 ? p1[r] + bt[v1 ? kc + 32 : qc] : -INFINITY; }
            }
            const float rm = rowmax32(p0, p1);
            if (t == 0 || __any(rm > THR)) {
                const float dl = (t == 0) ? rm : fmaxf(rm, 0.f);
                mhat += dl;
#pragma unroll
                for (int r = 0; r < 16; ++r) { p0[r] -= dl; p1[r] -= dl; negm[r] = -mhat; }
                if (t > 0) { const float f = __builtin_amdgcn_exp2f(-dl); l *= f; if (hi == 0) wsf[r32] = f; LDS_WAIT();
#pragma unroll
                    for (int r = 0; r < 16; ++r) { const float fr_ = wsf[crow(r, hi)]; o0[r] *= fr_; o1[r] *= fr_; }
                    LDS_WAIT(); }
            }
            float ls = 0.f;
#pragma unroll
            for (int r = 0; r < 16; ++r) { p0[r] = __builtin_amdgcn_exp2f(p0[r]); p1[r] = __builtin_amdgcn_exp2f(p1[r]); ls += p0[r] + p1[r]; }
            l += ls;
            u32x4 pw[4];
#pragma unroll
            for (int k = 0; k < 4; ++k) { pw[0][k] = cvtpk(p0[2 * k], p0[2 * k + 1]); pw[1][k] = cvtpk(p0[8 + 2 * k], p0[9 + 2 * k]); pw[2][k] = cvtpk(p1[2 * k], p1[2 * k + 1]); pw[3][k] = cvtpk(p1[8 + 2 * k], p1[9 + 2 * k]); }
            const LAS unsigned char* vb = lds + L_V + slot * SLOTB + vp0;
#pragma unroll
            for (int ks = 0; ks < 4; ++ks) {
                const s16x4 a0 = vtr(vb + ks * 1024), a1 = vtr(vb + ks * 1024 + 512), c0 = vtr(vb + 4096 + ks * 1024), c1 = vtr(vb + 4096 + ks * 1024 + 512);
                const bf16x8 v0 = {a0[0], a0[1], a0[2], a0[3], a1[0], a1[1], a1[2], a1[3]}, v1 = {c0[0], c0[1], c0[2], c0[3], c1[0], c1[1], c1[2], c1[3]};
                o0 = __builtin_amdgcn_mfma_f32_32x32x16_bf16(__builtin_bit_cast(bf16x8, pw[ks]), v0, o0, 0, 0, 0);
                o1 = __builtin_amdgcn_mfma_f32_32x32x16_bf16(__builtin_bit_cast(bf16x8, pw[ks]), v1, o1, 0, 0, 0);
            }
        }
        ATT_WAIT_BAR();
    }
    l = halfsum(l);
    if (MODE == 1 || MODE == 3) l += __builtin_amdgcn_exp2f(sink2 - mhat);
    if (hi == 0) wsf[32 + r32] = l;
    LDS_WAIT();
    bf16_t* stg = (bf16_t*)(lds + L_OST + wid * 4096);
    LAS bf16_t* stgl = (LAS bf16_t*)(lds + L_OST + wid * 4096);
#pragma unroll
    for (int r = 0; r < 16; ++r) { const int orow = crow(r, hi); const float rl = __builtin_amdgcn_rcpf(wsf[32 + orow]);
        stgl[orow * 64 + r32] = (bf16_t)(cvtpk(o0[r] * rl, 0.f) & 0xffffu); stgl[orow * 64 + 32 + r32] = (bf16_t)(cvtpk(o1[r] * rl, 0.f) & 0xffffu); }
    LDS_WAIT();
    (void)stg;
#pragma unroll
    for (int i = 0; i < 4; ++i) { const int row = i * 8 + (lane >> 3), ch = lane & 7; const u32x4 v = *(const LAS u32x4*)(stgl + row * 64 + ch * 8);
        *(u32x4*)(Y + (size_t)(qrow0 + 32 * wid + row) * DM + ycol + ch * 8) = v; }
    LDS_WAIT();
#undef ATT_KROW
#undef ATT_DMA
}
}

namespace ml {
__device__ __forceinline__ float scan_add(float v, int lane, int dir) {
#pragma unroll
    for (int o = 1; o < 64; o <<= 1) { const float t = shfl_idx(v, (dir ? lane + o : lane - o) & 63); const bool ok = dir ? (lane + o < 64) : (lane >= o); v += ok ? t : 0.f; }
    return v;
}
__device__ __forceinline__ float scan_max(float v, int lane, int dir) {
#pragma unroll
    for (int o = 1; o < 64; o <<= 1) { const float t = shfl_idx(v, (dir ? lane + o : lane - o) & 63); const bool ok = dir ? (lane + o < 64) : (lane >= o); v = ok ? fmaxf(v, t) : v; }
    return v;
}
__device__ __forceinline__ float logsigmoid(float x) { return fminf(x, 0.f) - log1pf(__expf(-fabsf(x))); }
__device__ __forceinline__ int img_off(int tok, int d) { return (d >> 5) * 4096 + (tok >> 4) * 1024 + (tok & 15) * 64 + (d & 31) * 2; }
__device__ __forceinline__ int blk_row0(int b, int blk) { return blk < 4 ? NLAT + CTXL * b + 64 * blk : SEQ * b + 64 * (blk - 4); }
__device__ __forceinline__ int chunk_of(int dir, int blk) { return dir == 0 ? blk : (blk < 4 ? 3 - blk : 4 + 127 - (blk - 4)); }

__device__ __forceinline__ void pass1(Frame& F, int layer) {
    int lane_o = F.lane; asm volatile("" : "+v"(lane_o));
    const int gw = F.bid * NWAVES + F.wave, NGW = F.G * NWAVES, lane = lane_o, r32 = lane & 31, hi = lane >> 5;
    LAS unsigned char* wl = F.lds + F.wave * 16384;
    const bf16_t* PROJ = (const bf16_t*)(F.ws + WS_PROJ); const float* GATES = (const float*)(F.ws + WS_GATES);
    const float* gb = F.ka->in[IN_CGB] + layer * 16;
    float* DS = (float*)((unsigned char*)F.out + OUT_DS); float* ZD = (float*)(F.ws + WS_ZD); float* GC = (float*)(F.ws + WS_GC); float* ML = (float*)(F.ws + WS_ML);
    const int vp0 = ((lane >> 4) & 1) * 32 + (lane & 3) * 8 + (4 * hi + ((lane & 15) >> 2)) * 64;
    for (int wu = gw; wu < NCHAIN * NCHUNK; wu += NGW) {
        const int chain = wu / NCHUNK, c = wu % NCHUNK, dir = chain & 1, h = (chain >> 1) & 3, b = chain >> 3;
        const int row0 = blk_row0(b, chunk_of(dir, c));
        const float gi = GATES[(size_t)(row0 + lane) * 16 + dir * 8 + h] + gb[dir * 8 + h];
        const float lf = logsigmoid(GATES[(size_t)(row0 + lane) * 16 + dir * 8 + 4 + h] + gb[dir * 8 + 4 + h]);
        const float cum = scan_add(lf, lane, dir);
        const float G = wave_sum(lf, lane);
        const float bb = gi - cum, mloc = wave_max(bb, lane), w = __expf(bb - mloc);
#pragma unroll
        for (int it = 0; it < 8; ++it) { const int tok = (lane >> 3) + 8 * it, d = 8 * (lane & 7);
            const u32x4 kv = *(const u32x4*)(PROJ + (size_t)(row0 + tok) * PP + PC_CK + 64 * h + d), vv = *(const u32x4*)(PROJ + (size_t)(row0 + tok) * PP + PC_CV + 64 * h + d);
            const float wt = shfl_idx(w, tok);
            u32x4 ko; ko.x = cvtpk(bflo(kv.x) * wt, bfhi(kv.x) * wt); ko.y = cvtpk(bflo(kv.y) * wt, bfhi(kv.y) * wt); ko.z = cvtpk(bflo(kv.z) * wt, bfhi(kv.z) * wt); ko.w = cvtpk(bflo(kv.w) * wt, bfhi(kv.w) * wt);
            *(LAS u32x4*)(wl + img_off(tok, d)) = vv; *(LAS u32x4*)(wl + 8192 + img_off(tok, d)) = ko; }
        LDS_WAIT();
        f32x16 acc[2][2] = {};
#pragma unroll
        for (int s = 0; s < 4; ++s) {
            bf16x8 af[2], bfr[2];
#pragma unroll
            for (int x = 0; x < 2; ++x) { const s16x4 a0 = att::vtr(wl + vp0 + x * 4096 + s * 1024), a1 = att::vtr(wl + vp0 + x * 4096 + s * 1024 + 512);
                const s16x4 c0 = att::vtr(wl + 8192 + vp0 + x * 4096 + s * 1024), c1 = att::vtr(wl + 8192 + vp0 + x * 4096 + s * 1024 + 512);
                af[x] = (bf16x8){a0[0], a0[1], a0[2], a0[3], a1[0], a1[1], a1[2], a1[3]}; bfr[x] = (bf16x8){c0[0], c0[1], c0[2], c0[3], c1[0], c1[1], c1[2], c1[3]}; }
#pragma unroll
            for (int vb = 0; vb < 2; ++vb)
#pragma unroll
                for (int kb = 0; kb < 2; ++kb) acc[vb][kb] = __builtin_amdgcn_mfma_f32_32x32x16_bf16(af[vb], bfr[kb], acc[vb][kb], 0, 0, 0);
        }
        float* dsp = DS + (size_t)(chain * NCHUNK + c) * 4096;
#pragma unroll
        for (int vb = 0; vb < 2; ++vb)
#pragma unroll
            for (int kb = 0; kb < 2; ++kb)
#pragma unroll
                for (int r = 0; r < 16; ++r) dsp[(32 * vb + att::crow(r, hi)) * 64 + 32 * kb + r32] = acc[vb][kb][r];
        float z = 0.f;
#pragma unroll 8
        for (int tok = 0; tok < 64; ++tok) z += bf2f(*(const LAS bf16_t*)(wl + 8192 + img_off(tok, lane)));
        ZD[(size_t)(chain * NCHUNK + c) * 64 + lane] = z;
        if (lane == 0) { GC[chain * NCHUNK + c] = G; ML[chain * NCHUNK + c] = mloc; }
        LDS_WAIT();
    }
}

__device__ __forceinline__ void pass2(Frame& F) {
    const float* DS = (const float*)((const unsigned char*)F.out + OUT_DS); const float* ZD = (const float*)(F.ws + WS_ZD); const float* GC = (const float*)(F.ws + WS_GC); const float* ML = (const float*)(F.ws + WS_ML);
    bf16_t* SBF = (bf16_t*)((unsigned char*)F.out + OUT_SBF); float* ZC = (float*)(F.ws + WS_ZC); float* MC = (float*)(F.ws + WS_MC);
    LAS float* cf = (LAS float*)F.lds;
    for (int it = F.bid; it < NCHAIN * 16; it += F.G) {
        const int chain = it >> 4, part = it & 15;
        __syncthreads();
        if (F.wave == 0) {
            const int ln = F.lane; const bool valid = ln < 44; float g[3], mlv[3];
#pragma unroll
            for (int j = 0; j < 3; ++j) { g[j] = valid ? GC[chain * NCHUNK + 3 * ln + j] : 0.f; mlv[j] = valid ? ML[chain * NCHUNK + 3 * ln + j] : -INFINITY; }
            const float tot = g[0] + g[1] + g[2]; const float excl = ml::scan_add(tot, ln, 0) - tot;
            const float pg[3] = {excl, excl + g[0], excl + g[0] + g[1]};
            const float a0 = mlv[0] - pg[0], a1 = mlv[1] - pg[1], a2 = mlv[2] - pg[2];
            const float inclm = ml::scan_max(fmaxf(a0, fmaxf(a1, a2)), ln, 0); float exclm = shfl_idx(inclm, (ln - 1) & 63); if (ln == 0) exclm = -INFINITY;
            const float em[3] = {exclm, fmaxf(exclm, a0), fmaxf(fmaxf(exclm, a0), a1)};
#pragma unroll
            for (int j = 0; j < 3; ++j) { const int c = 3 * ln + j; const float m = pg[j] + fmaxf(0.f, em[j]); const float mn = fmaxf(g[j] + m, g[j] + mlv[j]);
                if (valid) { cf[2 * c] = __expf(g[j] + m - mn); cf[2 * c + 1] = __expf(g[j] + mlv[j] - mn); if (part == 0) __hip_atomic_store(MC + chain * NCHUNK + c, m, __ATOMIC_RELAXED, __HIP_MEMORY_SCOPE_AGENT); } }
        }
        __syncthreads();
        if (F.tid < 128) {
            const int e = part * 256 + 2 * F.tid; const float* dp = DS + (size_t)chain * NCHUNK * 4096 + e; unsigned* sp = (unsigned*)(SBF + (size_t)chain * NCHUNK * 4096 + e);
            float s0 = 0.f, s1 = 0.f;
            for (int c0 = 0; c0 < NCHUNK; c0 += 44) { f32x2 d[44];
#pragma unroll
                for (int j = 0; j < 44; ++j) d[j] = *(const f32x2*)(dp + (size_t)(c0 + j) * 4096);
#pragma unroll
                for (int j = 0; j < 44; ++j) { __hip_atomic_store(sp + (size_t)(c0 + j) * 2048, cvtpk(s0, s1), __ATOMIC_RELAXED, __HIP_MEMORY_SCOPE_AGENT);
                    s0 = cf[2 * (c0 + j)] * s0 + cf[2 * (c0 + j) + 1] * d[j][0]; s1 = cf[2 * (c0 + j)] * s1 + cf[2 * (c0 + j) + 1] * d[j][1]; } }
        } else if (F.tid >= 256 && F.tid < 260) {
            const int e = part * 4 + (F.tid - 256); const float* dp = ZD + (size_t)chain * NCHUNK * 64 + e; float* zp = ZC + (size_t)chain * NCHUNK * 64 + e;
            float sz = 0.f;
            for (int c0 = 0; c0 < NCHUNK; c0 += 66) { float d[66];
#pragma unroll
                for (int j = 0; j < 66; ++j) d[j] = dp[(size_t)(c0 + j) * 64];
#pragma unroll
                for (int j = 0; j < 66; ++j) { __hip_atomic_store(zp + (size_t)(c0 + j) * 64, sz, __ATOMIC_RELAXED, __HIP_MEMORY_SCOPE_AGENT); sz = cf[2 * (c0 + j)] * sz + cf[2 * (c0 + j) + 1] * d[j]; } }
        }
    }
    __syncthreads();
}

__device__ __forceinline__ void pass3(Frame& F, int layer, int blk_lo, int blk_hi) {
    int lane_o = F.lane; asm volatile("" : "+v"(lane_o));
    const int gw = F.bid * NWAVES + F.wave, NGW = F.G * NWAVES, lane = lane_o, r32_ = lane & 31, hi_ = lane >> 5;
    LAS unsigned char* wl = F.lds + F.wave * 19456;
    LAS float* bvec = (LAS float*)(wl + 16384); LAS float* Apl = bvec + 128; LAS float* efl = bvec + 256; LAS float* fll = bvec + 384; LAS float* zl = bvec + 512; LAS float* rden = bvec + 640;
    LAS float* st = (LAS float*)(wl + 8192);
    const bf16_t* PROJ = (const bf16_t*)(F.ws + WS_PROJ); const float* GATES = (const float*)(F.ws + WS_GATES);
    const float* gb = F.ka->in[IN_CGB] + layer * 16;
    const bf16_t* SBF = (const bf16_t*)((const unsigned char*)F.out + OUT_SBF); const float* ZC = (const float*)(F.ws + WS_ZC); const float* MC = (const float*)(F.ws + WS_MC);
    bf16_t* Y = (bf16_t*)(F.ws + WS_H);
    const int vp0 = ((lane >> 4) & 1) * 32 + (lane & 3) * 8 + (4 * hi_ + ((lane & 15) >> 2)) * 64;
    const int nblk = blk_hi - blk_lo;
    for (int wu2 = gw; wu2 < 16 * nblk; wu2 += NGW) {
        const int wu = wu2 >> 1, tbsel = wu2 & 1;
        const int bh = wu / nblk, blk = blk_lo + wu % nblk, b = bh >> 2, h = bh & 3;
        const int row0 = blk_row0(b, blk);
        LDS_WAIT();
#pragma unroll
        for (int it = 0; it < 8; ++it) { const int tok = (lane >> 3) + 8 * it, d = 8 * (lane & 7);
            *(LAS u32x4*)(wl + img_off(tok, d)) = *(const u32x4*)(PROJ + (size_t)(row0 + tok) * PP + PC_CV + 64 * h + d); }
#pragma unroll
        for (int dir = 0; dir < 2; ++dir) {
            const int c = chunk_of(dir, blk), chain = (b * 4 + h) * 2 + dir;
            const float gi = GATES[(size_t)(row0 + lane) * 16 + dir * 8 + h] + gb[dir * 8 + h];
            const float lf = logsigmoid(GATES[(size_t)(row0 + lane) * 16 + dir * 8 + 4 + h] + gb[dir * 8 + 4 + h]);
            const float cum = scan_add(lf, lane, dir);
            const float bb = gi - cum, pm = scan_max(bb, lane, dir), mc = MC[chain * NCHUNK + c];
            const float Apv = fmaxf(mc, pm);
            zl[dir * 64 + lane] = ZC[(size_t)(chain * NCHUNK + c) * 64 + lane];
            bvec[dir * 64 + lane] = bb; Apl[dir * 64 + lane] = Apv; efl[dir * 64 + lane] = __expf(mc - Apv); fll[dir * 64 + lane] = __expf(-(cum + Apv));
        }
        LDS_WAIT();
#pragma unroll 1
        for (int tb = tbsel; tb <= tbsel; ++tb) {
            int r32 = r32_, hi = hi_; asm volatile("" : "+v"(r32), "+v"(hi));
            const int t = 32 * tb + r32;
            bf16x8 qf[4];
#pragma unroll
            for (int d0 = 0; d0 < 4; ++d0) qf[d0] = *(const bf16x8*)(PROJ + (size_t)(row0 + t) * PP + PC_CQ + 64 * h + 16 * d0 + 8 * hi);
            f32x16 hs0 = {}, hs1 = {};
#pragma unroll 1
            for (int dir = 0; dir < 2; ++dir) {
                const int c = chunk_of(dir, blk), chain = (b * 4 + h) * 2 + dir;
                const bf16_t* Sp = SBF + (size_t)(chain * NCHUNK + c) * 4096; const LAS float* zp = zl + dir * 64;
                int r32 = r32_, hi = hi_; asm volatile("" : "+v"(r32), "+v"(hi));
                const float Ap_t = Apl[dir * 64 + t], e_t = efl[dir * 64 + t], fl_t = fll[dir * 64 + t];
                f32x16 P0 = {}, P1 = {};
#pragma unroll
                for (int d0 = 0; d0 < 4; ++d0) {
                    const bf16x8 k0 = *(const bf16x8*)(PROJ + (size_t)(row0 + r32) * PP + PC_CK + 64 * h + 16 * d0 + 8 * hi), k1 = *(const bf16x8*)(PROJ + (size_t)(row0 + 32 + r32) * PP + PC_CK + 64 * h + 16 * d0 + 8 * hi);
                    P0 = __builtin_amdgcn_mfma_f32_32x32x16_bf16(k0, qf[d0], P0, 0, 0, 0); P1 = __builtin_amdgcn_mfma_f32_32x32x16_bf16(k1, qf[d0], P1, 0, 0, 0); }
                float den = 0.f;
#pragma unroll
                for (int r = 0; r < 16; ++r) { const int s0 = att::crow(r, hi), s1 = 32 + s0; const bool ok0 = dir ? (s0 >= t) : (s0 <= t), ok1 = dir ? (s1 >= t) : (s1 <= t);
                    const float w0 = ok0 ? __expf(bvec[dir * 64 + s0] - Ap_t) : 0.f, w1 = ok1 ? __expf(bvec[dir * 64 + s1] - Ap_t) : 0.f;
                    P0[r] *= w0; P1[r] *= w1; den += P0[r] + P1[r]; }
                u32x4 pw[4];
#pragma unroll
                for (int k = 0; k < 4; ++k) { pw[0][k] = cvtpk(P0[2 * k], P0[2 * k + 1]); pw[1][k] = cvtpk(P0[8 + 2 * k], P0[9 + 2 * k]); pw[2][k] = cvtpk(P1[2 * k], P1[2 * k + 1]); pw[3][k] = cvtpk(P1[8 + 2 * k], P1[9 + 2 * k]); }

                f32x16 n0 = {}, n1 = {}; float zq = 0.f;
#pragma unroll
                for (int d0 = 0; d0 < 4; ++d0) { const u32x4 qw = __builtin_bit_cast(u32x4, qf[d0]); u32x4 o;
                    const f32x4 za = *(const LAS f32x4*)(zp + 16 * d0 + 8 * hi), zb = *(const LAS f32x4*)(zp + 16 * d0 + 8 * hi + 4);
                    const float q0 = bflo(qw.x), q1 = bfhi(qw.x), q2 = bflo(qw.y), q3 = bfhi(qw.y), q4 = bflo(qw.z), q5 = bfhi(qw.z), q6 = bflo(qw.w), q7 = bfhi(qw.w);
                    zq += (q0 * za[0] + q1 * za[1]) + (q2 * za[2] + q3 * za[3]) + (q4 * zb[0] + q5 * zb[1]) + (q6 * zb[2] + q7 * zb[3]);
                    o.x = cvtpk(q0 * e_t, q1 * e_t); o.y = cvtpk(q2 * e_t, q3 * e_t); o.z = cvtpk(q4 * e_t, q5 * e_t); o.w = cvtpk(q6 * e_t, q7 * e_t);
                    const bf16x8 qs = __builtin_bit_cast(bf16x8, o);
                    const bf16x8 s0 = *(const bf16x8*)(Sp + (size_t)r32 * 64 + 16 * d0 + 8 * hi), s1 = *(const bf16x8*)(Sp + (size_t)(32 + r32) * 64 + 16 * d0 + 8 * hi);
                    n0 = __builtin_amdgcn_mfma_f32_32x32x16_bf16(qs, s0, n0, 0, 0, 0); n1 = __builtin_amdgcn_mfma_f32_32x32x16_bf16(qs, s1, n1, 0, 0, 0); }

                den = att::halfsum(den) + e_t * att::halfsum(zq);
                const float rd = 1.f / fmaxf(fabsf(den), fl_t);
                LDS_WAIT(); if (hi == 0) rden[r32] = rd; LDS_WAIT();
#pragma unroll
                for (int ks = 0; ks < 4; ++ks) {
                    const s16x4 a0 = att::vtr(wl + vp0 + ks * 1024), a1 = att::vtr(wl + vp0 + ks * 1024 + 512), c0 = att::vtr(wl + vp0 + 4096 + ks * 1024), c1 = att::vtr(wl + vp0 + 4096 + ks * 1024 + 512);
                    const bf16x8 v0 = {a0[0], a0[1], a0[2], a0[3], a1[0], a1[1], a1[2], a1[3]}, v1 = {c0[0], c0[1], c0[2], c0[3], c1[0], c1[1], c1[2], c1[3]};
                    n0 = __builtin_amdgcn_mfma_f32_32x32x16_bf16(__builtin_bit_cast(bf16x8, pw[ks]), v0, n0, 0, 0, 0);
                    n1 = __builtin_amdgcn_mfma_f32_32x32x16_bf16(__builtin_bit_cast(bf16x8, pw[ks]), v1, n1, 0, 0, 0); }
#pragma unroll
                for (int r = 0; r < 16; ++r) { const float rr = rden[att::crow(r, hi)]; hs0[r] += n0[r] * rr; hs1[r] += n1[r] * rr; }
            }
            LDS_WAIT();
#pragma unroll
            for (int r = 0; r < 16; ++r) { st[att::crow(r, hi) * 64 + r32] = hs0[r]; st[att::crow(r, hi) * 64 + 32 + r32] = hs1[r]; }
            LDS_WAIT();
#pragma unroll
            for (int it = 0; it < 4; ++it) { const int tk = (lane >> 3) + 8 * it, d = 8 * (lane & 7);
                const u32x4 ow = *(const u32x4*)(PROJ + (size_t)(row0 + 32 * tb + tk) * PP + PC_CO + 64 * h + d);
                const f32x4 ha = *(const LAS f32x4*)(st + tk * 64 + d), hb = *(const LAS f32x4*)(st + tk * 64 + d + 4);
                const float og[8] = {bflo(ow.x), bfhi(ow.x), bflo(ow.y), bfhi(ow.y), bflo(ow.z), bfhi(ow.z), bflo(ow.w), bfhi(ow.w)};
                float yv[8];
#pragma unroll
                for (int j = 0; j < 8; ++j) yv[j] = (j < 4 ? ha[j] : hb[j - 4]) / (1.f + __expf(-og[j]));
                u32x4 w; w.x = cvtpk(yv[0], yv[1]); w.y = cvtpk(yv[2], yv[3]); w.z = cvtpk(yv[4], yv[5]); w.w = cvtpk(yv[6], yv[7]);
                *(u32x4*)(Y + (size_t)(row0 + 32 * tb + tk) * DM + 512 + 64 * h + d) = w;
                float s = (bflo(w.x) * bflo(w.x) + bfhi(w.x) * bfhi(w.x)) + (bflo(w.y) * bflo(w.y) + bfhi(w.y) * bfhi(w.y)) + (bflo(w.z) * bflo(w.z) + bfhi(w.z) * bfhi(w.z)) + (bflo(w.w) * bflo(w.w) + bfhi(w.w) * bfhi(w.w));
                s += shfl_x(s, 1, lane); s += shfl_x(s, 2, lane); s += shfl_x(s, 4, lane);
                if ((lane & 7) == 0) ((float*)(F.ws + WS_SSQY))[(size_t)(row0 + 32 * tb + tk) * 16 + 8 + h] = s; }
            LDS_WAIT();
        }
    }
}
}

namespace attp {
typedef __attribute__((address_space(3))) const char* lds_cptr;
#define SBAR() __builtin_amdgcn_sched_barrier(0)
__device__ __forceinline__ int crow(int r,int hi){return (r&3)+8*(r>>2)+4*hi;}
constexpr int NSLOT=3, SLOTB=8192;
constexpr int NW=8, QBLK=32, KVBLK=64; constexpr int LDS_K=0, LDS_V=NSLOT*SLOTB, LDS_WS=2*NSLOT*SLOTB, LDS_OST=LDS_WS+NW*64*4, LDS_BYTES=LDS_OST+NW*4096;
__device__ __forceinline__ void glds16(const void*gsrc,unsigned lds_dst){unsigned keep;
  asm volatile("s_mov_b32 %0, m0\n\ts_mov_b32 m0, %2\n\ts_nop 0\n\tglobal_load_lds_dwordx4 %1, off\n\ts_mov_b32 m0, %0":"=&s"(keep):"v"(gsrc),"s"(lds_dst):"memory");}
__device__ __forceinline__ float max3f(float a,float b,float c){float r;asm("v_max3_f32 %0, %1, %2, %3":"=v"(r):"v"(a),"v"(b),"v"(c));return r;}
__device__ __forceinline__ float max2f(float a,float b){float r;asm("v_max_f32_e32 %0, %1, %2":"=v"(r):"v"(a),"v"(b));return r;}
__device__ __forceinline__ float fadd_s(float a,float b){float r;asm("v_add_f32_e32 %0, %1, %2":"=v"(r):"v"(a),"v"(b));return r;}
__device__ __forceinline__ float fsub_s(float a,float b){float r;asm("v_sub_f32_e32 %0, %1, %2":"=v"(r):"v"(a),"v"(b));return r;}
__device__ __forceinline__ unsigned cvtpk_s(float lo,float hi){return cvtpk(lo,hi);}
#define WAIT_BAR(N) asm volatile("s_waitcnt vmcnt(" #N ") lgkmcnt(0)\n\ts_barrier":::"memory")

template<bool ZC> __device__ __forceinline__ void qkt(f32x16&p0,f32x16&p1,lds_cptr Kslot,const bf16x8*qr,const f32x16&negm,int r32,int hi){
  lds_cptr kb=Kslot+hi*1024+r32*16;
  #pragma unroll
  for(int d0=0;d0<4;++d0){
    const bf16x8 b0=*(const __attribute__((address_space(3))) bf16x8*)(kb+d0*2048);
    const bf16x8 b1=*(const __attribute__((address_space(3))) bf16x8*)(kb+d0*2048+512);
    if(d0==0){ if(ZC){p0=__builtin_amdgcn_mfma_f32_32x32x16_bf16(b0,qr[0],(f32x16){},0,0,0);p1=__builtin_amdgcn_mfma_f32_32x32x16_bf16(b1,qr[0],(f32x16){},0,0,0);} else {p0=__builtin_amdgcn_mfma_f32_32x32x16_bf16(b0,qr[0],negm,0,0,0);p1=__builtin_amdgcn_mfma_f32_32x32x16_bf16(b1,qr[0],negm,0,0,0);} }
    else{p0=__builtin_amdgcn_mfma_f32_32x32x16_bf16(b0,qr[d0],p0,0,0,0);p1=__builtin_amdgcn_mfma_f32_32x32x16_bf16(b1,qr[d0],p1,0,0,0);}}
}
__device__ __forceinline__ void kload8(bf16x8*kf,lds_cptr kp){
  kf[0]=*(const __attribute__((address_space(3))) bf16x8*)(kp);      kf[1]=*(const __attribute__((address_space(3))) bf16x8*)(kp+512);
  kf[2]=*(const __attribute__((address_space(3))) bf16x8*)(kp+2048); kf[3]=*(const __attribute__((address_space(3))) bf16x8*)(kp+2560);
  kf[4]=*(const __attribute__((address_space(3))) bf16x8*)(kp+4096); kf[5]=*(const __attribute__((address_space(3))) bf16x8*)(kp+4608);
  kf[6]=*(const __attribute__((address_space(3))) bf16x8*)(kp+6144); kf[7]=*(const __attribute__((address_space(3))) bf16x8*)(kp+6656);
}
__device__ __forceinline__ void kload2(bf16x8*kf,lds_cptr kp,int j){ kf[2*j]=*(const __attribute__((address_space(3))) bf16x8*)(kp+j*2048); kf[2*j+1]=*(const __attribute__((address_space(3))) bf16x8*)(kp+j*2048+512); }
__device__ __forceinline__ s16x4 vtr(lds_cptr p){ return __builtin_bit_cast(s16x4,__builtin_amdgcn_ds_read_tr16_b64_v4i16((__attribute__((address_space(3))) v4i16_t*)p)); }
__device__ __forceinline__ float rowmax(const f32x16&p0,const f32x16&p1){
  float a=max3f(p0[0],p0[1],p1[0]),b=max3f(p0[2],p0[3],p1[1]);a=max3f(a,p1[2],p1[3]);
  #pragma unroll
  for(int r=4;r<16;r+=4){a=max3f(a,p0[r],p0[r+1]);b=max3f(b,p0[r+2],p0[r+3]);a=max3f(a,p1[r],p1[r+1]);b=max3f(b,p1[r+2],p1[r+3]);}
  const float m=max2f(a,b);
  auto rr=__builtin_amdgcn_permlane32_swap(__float_as_uint(m),__float_as_uint(m),false,false);
  return max2f(__uint_as_float(rr[0]),__uint_as_float(rr[1]));
}
__device__ __forceinline__ void pv(f32x16*o,int vb,bf16x8 pa0,bf16x8 pa1,bf16x8 pa2,bf16x8 pa3){
  #pragma unroll
  for(int d0=0;d0<2;++d0){s16x4 lo[4],hi[4];
    #pragma unroll
    for(int ks=0;ks<4;++ks){
      asm volatile("ds_read_b64_tr_b16 %0,%1 offset:%c2":"=&v"(lo[ks]):"v"(vb),"i"(d0*4096+ks*1024):"memory");
      asm volatile("ds_read_b64_tr_b16 %0,%1 offset:%c2":"=&v"(hi[ks]):"v"(vb),"i"(d0*4096+ks*1024+512):"memory");}
    asm volatile("s_waitcnt lgkmcnt(0)":::"memory");SBAR();
    #define PK(k) (bf16x8){lo[k][0],lo[k][1],lo[k][2],lo[k][3],hi[k][0],hi[k][1],hi[k][2],hi[k][3]}
    o[d0]=__builtin_amdgcn_mfma_f32_32x32x16_bf16(pa0,PK(0),o[d0],0,0,0);
    o[d0]=__builtin_amdgcn_mfma_f32_32x32x16_bf16(pa1,PK(1),o[d0],0,0,0);
    o[d0]=__builtin_amdgcn_mfma_f32_32x32x16_bf16(pa2,PK(2),o[d0],0,0,0);
    o[d0]=__builtin_amdgcn_mfma_f32_32x32x16_bf16(pa3,PK(3),o[d0],0,0,0);
    #undef PK
  }
}


template<int THRL,int MODE> __device__ __forceinline__ void attn_unit_pipe(Frame& F,int b,int h,int qb,int qcol,int kcol,int vcol,int ycol,float sink2,const float*rpb){
  constexpr bool NOMAX=(MODE==0), USE_NEGM=false;
  int lane_=F.lane; asm volatile("":"+v"(lane_));
  const int lane=lane_,r32=lane&31,hi=lane>>5; const int wid=F.wave; (void)h;
  const bf16_t*PROJ=(const bf16_t*)(F.ws+WS_PROJ); bf16_t*Yb=(bf16_t*)(F.ws+WS_H);
  const int ctxrow=NLAT+CTXL*b,latrow=SEQ*b; LAS unsigned char*shm=F.lds;
  const int qrow0=(MODE==3)?ctxrow:latrow+256*qb;
  int lt_lo=0,nloc=0;
  if(MODE==0){nloc=128;}
  if(MODE==1){const int a_=(256*qb-128)>>6,e_=(256*qb+255+128)>>6; lt_lo=a_<0?0:a_; nloc=(e_>127?127:e_)-lt_lo+1;}
  if(MODE==2){const int a_=4*qb-4,e0_=4*qb-1; lt_lo=a_<0?0:(a_>120?120:a_); int e_=(e0_<0?0:(e0_>120?120:e0_))+7; nloc=e_-lt_lo+1; if(nloc&1)++nloc;}
  const int qw0=256*qb+32*wid;
  const int rw=4*qb+(wid>>1); const int rs=rw-4<0?0:(rw-4>120?120:rw-4);
  const int qc=32*(wid&1)+r32; const int cs=qc-8<0?0:(qc-8>48?48:qc-8);
  LAS float*rpbL=(LAS float*)(shm+LDS_BYTES);
  if(MODE==2){ for(int i=wid*64+lane;i<465;i+=512) rpbL[i]=rpb[i]*LOG2E; }
  unsigned vm0=0u,vm1=0u;
  if(MODE==2){ _Pragma("unroll") for(int r=0;r<16;++r){ const int kc_=crow(r,hi); if(kc_>=cs&&kc_<cs+16)vm0|=1u<<r; if(kc_+32>=cs&&kc_+32<cs+16)vm1|=1u<<r; } }
  const bf16_t*Qw=PROJ+(size_t)(qrow0+wid*QBLK)*PP+qcol;
  const unsigned lds0=(unsigned)(uintptr_t)shm;
  LAS float*wsf=(LAS float*)(shm+LDS_WS)+wid*64;
  const bf16_t*ksrc=PROJ+(size_t)lane*PP+kcol+wid*8;
  const bf16_t*vsrc=PROJ+(size_t)(16*(wid&3)+(lane>>2))*PP+vcol+(wid>>2)*32+(lane&3)*8;
  #define KROW(t) ((size_t)((t)<4?ctxrow+64*(t):latrow+64*(lt_lo+(t)-4))*PP)
  const unsigned kdst=lds0+LDS_K+wid*1024, vdst=lds0+LDS_V+wid*1024;
  #define DMA_K(t,slot) glds16(ksrc+KROW(t),(unsigned)__builtin_amdgcn_readfirstlane(kdst+(slot)))
  #define DMA_V(t,slot) glds16(vsrc+KROW(t),(unsigned)__builtin_amdgcn_readfirstlane(vdst+(slot)))
  const int vb0=(int)(lds0+LDS_V)+((lane>>4)&1)*32+(lane&3)*8+(4*hi+((lane&15)>>2))*64;
  const lds_cptr Kbase=(lds_cptr)shm+LDS_K; bf16x8 kf[8];
  const lds_cptr shm3=(lds_cptr)shm; const lds_cptr kp0=shm3+LDS_K+hi*1024+r32*16; const lds_cptr vp0=shm3+LDS_V+((lane>>4)&1)*32+(lane&3)*8+(4*hi+((lane&15)>>2))*64;
  const int NT=4+nloc;
  DMA_K(0,0);DMA_V(0,0);DMA_K(1,SLOTB);
  bf16x8 qr[4];
  #pragma unroll
  for(int d0=0;d0<4;++d0)qr[d0]=*reinterpret_cast<const bf16x8*>(&Qw[(size_t)r32*PP+d0*16+hi*8]);
  float mhat=0.f,l_reg=0.f;f32x16 o[2],negm;
  { float z_=0.f; asm volatile("":"+v"(z_));
    _Pragma("unroll") for(int r=0;r<16;++r){o[0][r]=z_;o[1][r]=z_;if(USE_NEGM)negm[r]=z_;} }
  if(USE_NEGM)asm volatile("":"+v"(negm));
  #define NEGMC (USE_NEGM?negm:(f32x16){})
  #define CMASK(P0,P1,t) do{ if(MODE==1&&(t)>=4){ const int dq_=64*(lt_lo+(t)-4)-(qw0+r32); \
      _Pragma("unroll") for(int r=0;r<16;++r){ const int d0_=dq_+crow(r,hi),d1_=d0_+32; if(d0_>128||d0_<-128)P0[r]=-INFINITY; if(d1_>128||d1_<-128)P1[r]=-INFINITY; } } \
    if(MODE==2&&(t)>=4){ const int gr_=lt_lo+(t)-4; const bool rel_=(gr_>=rs)&&(gr_<rs+8); const LAS float*bt_=rpbL+(rel_?gr_-rw+7:7)*31+(15-qc)+4*hi; const unsigned m0_=rel_?vm0:0u,m1_=rel_?vm1:0u; \
      _Pragma("unroll") for(int r=0;r<16;++r){ const int kc_=(r&3)+8*(r>>2);   \
        P0[r]=((m0_>>r)&1u)?P0[r]+bt_[kc_]:-INFINITY; P1[r]=((m1_>>r)&1u)?P1[r]+bt_[kc_+32]:-INFINITY; } } }while(0)
  bool resc=false;
  #define START(P0,P1) do{ resc=false; \
    if(!NOMAX){ const float rm=rowmax(P0,P1); const float dl=rm; mhat=fadd_s(mhat,dl); \
      _Pragma("unroll") for(int r=0;r<16;++r){P0[r]=fsub_s(P0[r],dl);P1[r]=fsub_s(P1[r],dl);} \
      if(USE_NEGM){ _Pragma("unroll") for(int r=0;r<16;++r)negm[r]=-mhat; asm volatile("":"+v"(negm)); } } \
    _Pragma("unroll") for(int r=0;r<16;++r)P0[r]=__builtin_amdgcn_exp2f(P0[r]); }while(0)
  #define RESC() do{ if(resc){ asm volatile("s_waitcnt lgkmcnt(0)":::"memory"); \
      _Pragma("unroll") for(int d_=0;d_<2;++d_) _Pragma("unroll") for(int r=0;r<16;++r)o[d_][r]*=wsf[crow(r,hi)]; } }while(0)
  f32x16 pA0,pA1,pB0,pB1;
  int sl_prev=0,sl_cur=0,sl_next=SLOTB;
  #define ROT() do{sl_prev=sl_cur;sl_cur=sl_next;sl_next=(sl_next==(NSLOT-1)*SLOTB)?0:sl_next+SLOTB;}while(0)
  DMA_K(2,2*SLOTB);
  WAIT_BAR(3);
  qkt<!USE_NEGM>(pA0,pA1,Kbase,qr,negm,r32,hi);asm volatile("s_nop 15\n\ts_nop 7":"+v"(pA0),"+v"(pA1));CMASK(pA0,pA1,0);
  START(pA0,pA1);
  _Pragma("unroll") for(int r=0;r<16;++r)pA1[r]=__builtin_amdgcn_exp2f(pA1[r]);
  WAIT_BAR(0);
  DMA_K(3,0);DMA_V(1,SLOTB);
  ROT();
  kload8(kf,kp0+sl_cur);
  WAIT_BAR(2);
  s16x4 vlo[8],vhi[8]; u32x4 pw0,pw1,pw2,pw3;
  #define PKW(P,B) cvtpk_s(P[B],P[B+1])
  #define PAF(k) __builtin_bit_cast(bf16x8,pw##k)
  #define VFR(i) (bf16x8){vlo[i][0],vlo[i][1],vlo[i][2],vlo[i][3],vhi[i][0],vhi[i][1],vhi[i][2],vhi[i][3]}
  #define PIN(x) asm volatile("":"+v"(x))
  #define MX3(a,b,c) __builtin_fmaxf(__builtin_fmaxf((a),(b)),(c))
  #define GAPA(MF,A0,A1,A2,A3,W0,W1,PW) do{ MF; sacc+=A0; sacc+=A1; sacc+=A2; sacc+=A3; PIN(sacc); W0; W1; PIN(PW); SBAR(); }while(0)
  #define EX(v) __builtin_amdgcn_exp2f(v)
  #define GAPB(MF,X,B) do{ MF; X[B]=EX(X[B]); X[B+1]=EX(X[B+1]); X[B+2]=EX(X[B+2]); X[B+3]=EX(X[B+3]); PIN(X); SBAR(); }while(0)
  #define VRD(i) do{ vlo[i]=vtr(vp_+(((i)>>2)*4096+((i)&3)*1024)); vhi[i]=vtr(vp_+(((i)>>2)*4096+((i)&3)*1024+512)); }while(0)
  #define KRD(G,j) do{ if(G){ kload2(kf,kp0+sl_next,j); SBAR(); } }while(0)
  #define STEP(C0,C1,P0,P1,t,GK,GV,GL) do{ SBAR(); \
    const lds_cptr vp_=vp0+sl_prev; \
    VRD(0); SBAR(); float sacc=(P0[0]+P0[1]); \
    GAPA(C0=__builtin_amdgcn_mfma_f32_32x32x16_bf16(kf[0],qr[0],NEGMC,0,0,0), P0[2],P0[3],P0[4],P0[5],     pw0[0]=PKW(P0,0), pw0[1]=PKW(P0,2), pw0); \
    VRD(4); SBAR(); GAPA(C1=__builtin_amdgcn_mfma_f32_32x32x16_bf16(kf[1],qr[0],NEGMC,0,0,0), P0[6],P0[7],P0[8],P0[9],     pw0[2]=PKW(P0,4), pw0[3]=PKW(P0,6), pw0); \
    VRD(1); SBAR(); GAPA(C0=__builtin_amdgcn_mfma_f32_32x32x16_bf16(kf[2],qr[1],C0,0,0,0),   P0[10],P0[11],P0[12],P0[13], pw1[0]=PKW(P0,8), pw1[1]=PKW(P0,10), pw1); \
    VRD(5); SBAR(); GAPA(C1=__builtin_amdgcn_mfma_f32_32x32x16_bf16(kf[3],qr[1],C1,0,0,0),   P0[14],P0[15],P1[0],P1[1],   pw1[2]=PKW(P0,12),pw1[3]=PKW(P0,14), pw1); \
    VRD(2); SBAR(); GAPA(C0=__builtin_amdgcn_mfma_f32_32x32x16_bf16(kf[4],qr[2],C0,0,0,0),   P1[2],P1[3],P1[4],P1[5],     pw2[0]=PKW(P1,0), pw2[1]=PKW(P1,2), pw2); \
    VRD(6); SBAR(); GAPA(C1=__builtin_amdgcn_mfma_f32_32x32x16_bf16(kf[5],qr[2],C1,0,0,0),   P1[6],P1[7],P1[8],P1[9],     pw2[2]=PKW(P1,4), pw2[3]=PKW(P1,6), pw2); \
    VRD(3); SBAR(); GAPA(C0=__builtin_amdgcn_mfma_f32_32x32x16_bf16(kf[6],qr[3],C0,0,0,0),   P1[10],P1[11],P1[12],P1[13], pw3[0]=PKW(P1,8), pw3[1]=PKW(P1,10), pw3); \
    VRD(7); SBAR(); GAPA(C1=__builtin_amdgcn_mfma_f32_32x32x16_bf16(kf[7],qr[3],C1,0,0,0),   P1[14],P1[15],0.f,0.f,       pw3[2]=PKW(P1,12),pw3[3]=PKW(P1,14), pw3); \
    l_reg+=sacc; \
    if(GK){DMA_K((t)+3,sl_cur);} if(GV){DMA_V((t)+1,sl_next);} \
    if(!USE_NEGM&&!NOMAX){ _Pragma("unroll") for(int r=0;r<16;++r){C0[r]-=mhat;C1[r]-=mhat;} } \
    CMASK(C0,C1,t); \
    if(!NOMAX){ float a=MX3(C0[0],C0[1],C1[0]),b=MX3(C0[2],C0[3],C1[1]); a=MX3(a,C1[2],C1[3]); \
      _Pragma("unroll") for(int r=4;r<16;r+=4){a=MX3(a,C0[r],C0[r+1]);b=MX3(b,C0[r+2],C0[r+3]);a=MX3(a,C1[r],C1[r+1]);b=MX3(b,C1[r+2],C1[r+3]);} \
      float rm=__builtin_fmaxf(a,b); { auto rr=__builtin_amdgcn_permlane32_swap(__float_as_uint(rm),__float_as_uint(rm),false,false); rm=__builtin_fmaxf(__uint_as_float(rr[0]),__uint_as_float(rr[1])); } \
      resc=false; \
      if(__builtin_expect(__any(rm>(float)THRL),0)){ const float dl=__builtin_fmaxf(rm,0.f); mhat+=dl; \
        _Pragma("unroll") for(int r=0;r<16;++r){C0[r]-=dl;C1[r]-=dl;} \
        if(USE_NEGM){ _Pragma("unroll") for(int r=0;r<16;++r)negm[r]=-mhat; asm volatile("":"+v"(negm)); } \
        const float f=__builtin_amdgcn_exp2f(-dl); l_reg*=f; if(hi==0)wsf[r32]=f; resc=true; } } \
    SBAR(); \
    GAPB(o[0]=__builtin_amdgcn_mfma_f32_32x32x16_bf16(PAF(0),VFR(0),o[0],0,0,0), C0,0); \
    GAPB(o[1]=__builtin_amdgcn_mfma_f32_32x32x16_bf16(PAF(0),VFR(4),o[1],0,0,0), C0,4); \
    KRD(GL,0); GAPB(o[0]=__builtin_amdgcn_mfma_f32_32x32x16_bf16(PAF(1),VFR(1),o[0],0,0,0), C0,8); \
    KRD(GL,1); GAPB(o[1]=__builtin_amdgcn_mfma_f32_32x32x16_bf16(PAF(1),VFR(5),o[1],0,0,0), C0,12); \
    KRD(GL,2); GAPB(o[0]=__builtin_amdgcn_mfma_f32_32x32x16_bf16(PAF(2),VFR(2),o[0],0,0,0), C1,0); \
    KRD(GL,3); GAPB(o[1]=__builtin_amdgcn_mfma_f32_32x32x16_bf16(PAF(2),VFR(6),o[1],0,0,0), C1,4); \
    GAPB(o[0]=__builtin_amdgcn_mfma_f32_32x32x16_bf16(PAF(3),VFR(3),o[0],0,0,0), C1,8); \
    GAPB(o[1]=__builtin_amdgcn_mfma_f32_32x32x16_bf16(PAF(3),VFR(7),o[1],0,0,0), C1,12); \
    }while(0)
  int t=1;
  for(;t+5<NT;t+=2){
    STEP(pB0,pB1,pA0,pA1,t,true,true,true);     WAIT_BAR(2); RESC(); ROT();
    STEP(pA0,pA1,pB0,pB1,t+1,true,true,true);   WAIT_BAR(2); RESC(); ROT();
  }
  #define ENDW(tt) do{ if((tt)+3<NT){WAIT_BAR(2);} else if((tt)+2<NT){WAIT_BAR(1);} else {WAIT_BAR(0);} }while(0)
  for(;t+1<NT;t+=2){
    STEP(pB0,pB1,pA0,pA1,t,(t+3<NT),(t+1<NT),(t+1<NT));       ENDW(t);   RESC(); ROT();
    STEP(pA0,pA1,pB0,pB1,t+1,(t+4<NT),(t+2<NT),(t+2<NT));     ENDW(t+1); RESC(); ROT();
  }
  STEP(pB0,pB1,pA0,pA1,NT-1,false,false,false); RESC();
  { float sacc=pB0[0]+pB0[1]; _Pragma("unroll") for(int r=2;r<16;++r)sacc+=pB0[r]; _Pragma("unroll") for(int r=0;r<16;++r)sacc+=pB1[r]; l_reg+=sacc;
    pw0=(u32x4){PKW(pB0,0),PKW(pB0,2),PKW(pB0,4),PKW(pB0,6)};pw1=(u32x4){PKW(pB0,8),PKW(pB0,10),PKW(pB0,12),PKW(pB0,14)};pw2=(u32x4){PKW(pB1,0),PKW(pB1,2),PKW(pB1,4),PKW(pB1,6)};pw3=(u32x4){PKW(pB1,8),PKW(pB1,10),PKW(pB1,12),PKW(pB1,14)};
    SBAR(); pv(o,vb0+sl_cur,PAF(0),PAF(1),PAF(2),PAF(3)); }
  #undef PKW
  #undef PAF
  #undef VFR
  #undef PIN
  #undef MX3
  #undef GAPA
  #undef GAPB
  #undef EX
  #undef VRD
  #undef KRD
  #undef STEP
  #undef ENDW
  {auto rr=__builtin_amdgcn_permlane32_swap(__float_as_uint(l_reg),__float_as_uint(l_reg),false,false);l_reg=__uint_as_float(rr[0])+__uint_as_float(rr[1]);}
  if(MODE==1||MODE==3)l_reg+=__builtin_amdgcn_exp2f(sink2-mhat);
  if(hi==0)wsf[32+r32]=l_reg;asm volatile("s_waitcnt lgkmcnt(0)":::"memory");
  float rli[16];
  #pragma unroll
  for(int r=0;r<16;++r)rli[r]=__builtin_amdgcn_rcpf(wsf[32+crow(r,hi)]);
  bf16_t*Ow=Yb+(size_t)(qrow0+wid*QBLK)*DM+ycol;
  { LAS bf16_t*stg=(LAS bf16_t*)(shm+LDS_OST)+wid*2048;
    #pragma unroll
    for(int r=0;r<16;++r){const int orow=crow(r,hi);
      #pragma unroll
      for(int d0=0;d0<2;++d0)stg[orow*64+d0*32+r32]=(bf16_t)(cvtpk(o[d0][r]*rli[r],0.f)&0xffffu);}
    asm volatile("s_waitcnt lgkmcnt(0)":::"memory");
    float*SQ=(float*)(F.ws+WS_SSQY)+(size_t)(qrow0+wid*QBLK)*16+(ycol>>6);
    #pragma unroll
    for(int i=0;i<4;++i){const int row=i*8+(lane>>3),ch=lane&7; const u32x4 v=*(const LAS u32x4*)(stg+row*64+ch*8); *(u32x4*)(Ow+(size_t)row*DM+ch*8)=v;
      float s=(bflo(v.x)*bflo(v.x)+bfhi(v.x)*bfhi(v.x))+(bflo(v.y)*bflo(v.y)+bfhi(v.y)*bfhi(v.y))+(bflo(v.z)*bflo(v.z)+bfhi(v.z)*bfhi(v.z))+(bflo(v.w)*bflo(v.w)+bfhi(v.w)*bfhi(v.w));
      s+=shfl_x(s,1,lane);s+=shfl_x(s,2,lane);s+=shfl_x(s,4,lane); if(ch==0)SQ[row*16]=s;} }
  asm volatile("s_waitcnt lgkmcnt(0)\n\ts_barrier":::"memory");
  #undef DMA_K
  #undef DMA_V
  #undef KROW
  #undef NEGMC
  #undef CMASK
  #undef START
  #undef RESC
  #undef ROT
}

#undef SBAR
#undef WAIT_BAR
}

constexpr int NPHASE = 15;
__device__ __forceinline__ void ph_decode(int ph, int& l, int& k) { const unsigned tab = 0x00A98621u;
    if (ph == 1) { l = 0; k = 0; } else { const int j = ph - 2; l = j >= 6 ? 1 : 0; k = (int)((tab >> (4 * (j >= 6 ? j - 6 : j))) & 15u); } }

constexpr int UP1_SPLIT = UP1_LATE;
template <class Order>
__device__ __forceinline__ void fill_rope(Frame& F, const Order& S) {
    const float* ROPE = (const float*)(F.ws + WS_ROPE); LAS float* tab = (LAS float*)(F.lds + pg8::ROPEL_OFF); pg8::Unit u;
    for (int i = F.tid; i < 2048; i += NTHREADS) tab[i] = ROPE[128 * 32 + i];
#pragma unroll
    for (int i = 0; i < 8; ++i) if (S.next(i, u) && F.tid < 128) tab[2048 + i * 128 + F.tid] = ROPE[((((u.pm * 256) & (SEQ - 1)) >> 6) + (F.tid >> 5)) * 32 + (F.tid & 31)];
    __syncthreads();
}
template <class Order>
__device__ __forceinline__ void fill_rtab(Frame& F, const Order& S, const float* ssq, const float* ssqc) {
    LAS float* tab = (LAS float*)(F.lds + pg8::RTAB_OFF); pg8::Unit u;
#pragma unroll
    for (int i = 0; i < 8; ++i) if (S.next(i, u) && F.tid < 256) { float s = 0.f;
        if (u.pm < 64) { const float* p = ssq + (size_t)(u.pm * 256 + F.tid) * 16; const f32x4 a = *(const f32x4*)p, b = *(const f32x4*)(p + 4), c = *(const f32x4*)(p + 8), d = *(const f32x4*)(p + 12);
            s = ((a[0] + a[1]) + (a[2] + a[3])) + ((b[0] + b[1]) + (b[2] + b[3])) + ((c[0] + c[1]) + (c[2] + c[3])) + ((d[0] + d[1]) + (d[2] + d[3])); }
        else { const float* p = ssqc + (size_t)((u.pm - 64) * 256 + F.tid) * 64;
#pragma unroll
            for (int j = 0; j < 16; ++j) { const f32x4 a = *(const f32x4*)(p + 4 * j); s += (a[0] + a[1]) + (a[2] + a[3]); } }
        tab[i * 256 + F.tid] = rsqrtf(s * (1.f / DM) + EPS); }
    __syncthreads();
}
__device__ __forceinline__ void phase_ids(Frame& F) {
    int lane_;
    asm volatile("v_mbcnt_lo_u32_b32 %0, -1, 0\n\tv_mbcnt_hi_u32_b32 %0, -1, %0" : "=v"(lane_));
    F.lane = lane_; F.tid = F.wave * 64 + lane_;
}
__device__ __forceinline__ void run_phase(const Frame& F0, int ph) {
    Frame F = F0;
    unsigned char* ws = F.ws;
#define H ((bf16_t*)(F.ws + WS_H))
#define PROJ ((bf16_t*)(F.ws + WS_PROJ))
#define XB ((bf16_t*)(F.ws + WS_XB))
#define XG ((bf16_t*)((unsigned char*)F.out + OUT_XG))
#define MOD ((const float*)(F.ws + WS_MOD))
#define vcu ((F.G % 8 == 0) ? (F.bid % 8) * (F.G / 8) + F.bid / 8 : F.bid)
#ifdef ONLYK
    if (ONLYK == 100) { if (ph == 0) { phase_ids(F); p0_prologue(F); } return; }
    if (ONLYK == 101) { if (ph == NPHASE - 1) { phase_ids(F); final_phase(F); } return; }
    if (ph == 0 || ph == NPHASE - 1) return;
    int l, k; ph_decode(ph, l, k);
    if (k != ONLYK) return;
#else
    if (ph == 0) { phase_ids(F); p0_prologue(F); return; }
    if (ph == NPHASE - 1) { phase_ids(F); final_phase(F); return; }
    int l, k; ph_decode(ph, l, k);
#endif
    const int M = (l == 0) ? NROWS : NLAT;
    switch (k) {
    case 0: phase_ids(F); norm_phase(F, l); break;
    case 1: { phase_ids(F); pg8::Gemm g{H, (const bf16_t*)(ws + WS_WIN) + (size_t)l * PP * 1024, NROWS, PP, 1024}; pg8::ProjOrder S; S.init(NROWS, PP, F.G, F.bid);
              gates_phase(F, l); fill_rope(F, S); if (l > 0) fill_rtab(F, S, (const float*)(ws + WS_SSQ1), (const float*)(ws + WS_SSQC1));
              pg8::EpiProj E{PROJ, PP, l == 0 ? nullptr : (const LAS float*)(F.lds + pg8::RTAB_OFF), (const float*)(ws + WS_BIASIN), F.ka->in[IN_AQG] + l * 64, F.ka->in[IN_AKG] + l * 64, (const LAS float*)(F.lds + pg8::ROPEL_OFF)}; pg8::gemm_phase<pg8::EpiProj, pg8::ProjOrder, true, true>(F.lds, g, S, E, F.tid);
              if (l == 0) idle_transposes(F, (NROWS / 256) * (PP / 256), I_L, I_L + I_IN);
              else { idle_transposes(F, (NROWS / 256) * (PP / 256), I_L + I_IN, I_L + I_IN + I_OUT); idle_transposes(F, (NROWS / 256) * (PP / 256), I_L + I_IN + I_OUT + UP1_SPLIT, I_L + I_IN + I_OUT + I_UP); } } break;
    case 2: {
        phase_ids(F);
        ml::pass1(F, l);
        asm volatile("s_waitcnt vmcnt(0)" ::: "memory"); __syncthreads();
        if (F.tid == 0) { __builtin_amdgcn_fence(__ATOMIC_RELEASE, "agent"); asm volatile("s_waitcnt vmcnt(0)" ::: "memory");
            __hip_atomic_fetch_add((unsigned*)(ws + WS_CTL + 43008) + 8 + l, 1u, __ATOMIC_RELAXED, __HIP_MEMORY_SCOPE_AGENT); }
        PROBE_PT(F.lds, 1);
#ifndef NO_B
        for (int u = vcu; u < 256; u += F.G) { const int b = u >> 7, h = (u >> 5) & 3, qb = u & 31;
            attp::attn_unit_pipe<8, 1>(F, b, h, qb, PC_BQ + 64 * h, PC_BK + 64 * (h >> 1), PC_BV + 64 * (h >> 1), 256 + 64 * h, F.ka->in[IN_SINK][l * 4 + h] * LOG2E, nullptr); }
#endif
        PROBE_PT(F.lds, 2);
#ifndef NO_D
        for (int u = vcu; u < 256; u += F.G) { const int b = u >> 7, h = (u >> 5) & 3, qb = u & 31;
            attp::attn_unit_pipe<8, 2>(F, b, h, qb, PC_DQ + 64 * h, PC_DK + 64 * h, PC_DV + 64 * h, 768 + 64 * h, 0.f, F.ka->in[IN_RPB] + (size_t)(l * 4 + h) * 465); }
#endif
        if (l == 1) bias_phase(F, vcu, F.G, 1);
        PROBE_PT(F.lds, 3);
        if (F.tid == 0) { unsigned* cnt = (unsigned*)(ws + WS_CTL + 43008) + 8 + l; unsigned sp = 0;
            while (__hip_atomic_load(cnt, __ATOMIC_RELAXED, __HIP_MEMORY_SCOPE_AGENT) < (unsigned)F.G && ++sp < (1u << 22)) __builtin_amdgcn_s_sleep(1);
            __builtin_amdgcn_fence(__ATOMIC_ACQUIRE, "agent"); asm volatile("s_waitcnt vmcnt(0)" ::: "memory"); }
        __syncthreads();
        ml::pass2(F);
        asm volatile("s_waitcnt vmcnt(0)" ::: "memory"); __syncthreads();
        if (F.tid == 0) __hip_atomic_fetch_add((unsigned*)(ws + WS_CTL + 43008) + l, 1u, __ATOMIC_RELAXED, __HIP_MEMORY_SCOPE_AGENT);
        PROBE_PT(F.lds, 5);
#ifndef NO_ATTN0
        for (int u = vcu; u < 256; u += F.G) { const int b = u >> 7, h = (u >> 5) & 3, qb = u & 31;
            attp::attn_unit_pipe<8, 0>(F, b, h, qb, PC_AQ + 64 * h, PC_AK + 64 * (h >> 1), PC_AV + 64 * (h >> 1), 64 * h, 0.f, nullptr); }
#endif
        if (F.tid == 0) { unsigned* cnt = (unsigned*)(ws + WS_CTL + 43008) + l; unsigned sp = 0;
            while (__hip_atomic_load(cnt, __ATOMIC_RELAXED, __HIP_MEMORY_SCOPE_AGENT) < (unsigned)F.G && ++sp < (1u << 22)) __builtin_amdgcn_s_sleep(1);
            __builtin_amdgcn_fence(__ATOMIC_ACQUIRE, "agent"); asm volatile("s_waitcnt vmcnt(0)" ::: "memory"); }
        __syncthreads();
        PROBE_PT(F.lds, 6);
#ifndef NO_PASS3
        ml::pass3(F, l, 4, NCHUNK);
#endif
        PROBE_PT(F.lds, 7);
    } break;
    case 6: { phase_ids(F); const bool ks = F.G >= 256;
              if (l == 0) {
                  ml::pass3(F, 0, 0, 4);
                  bool worked = F.bid * NWAVES < 64;
                  asm volatile("s_waitcnt vmcnt(0)" ::: "memory"); __syncthreads();
                  for (int cu = (F.bid + F.G - 8 % F.G) % F.G; cu < 24; cu += F.G) { const int mx = cu >> 3, b = (cu >> 2) & 1, h = cu & 3; worked = true;
                      const int qc = mx == 0 ? PC_AQ + 64 * h : (mx == 1 ? PC_BQ + 64 * h : PC_DQ + 64 * h);
                      const int kc = mx == 0 ? PC_AK + 64 * (h >> 1) : (mx == 1 ? PC_BK + 64 * (h >> 1) : PC_DK + 64 * h);
                      const int vc = mx == 0 ? PC_AV + 64 * (h >> 1) : (mx == 1 ? PC_BV + 64 * (h >> 1) : PC_DV + 64 * h);
                      const int yc = (mx == 0 ? 0 : (mx == 1 ? 256 : 768)) + 64 * h;
                      const float s2 = mx == 1 ? F.ka->in[IN_SINK][l * 4 + h] * LOG2E : -INFINITY;
                      attp::attn_unit_pipe<8, 3>(F, b, h, 0, qc, kc, vc, yc, s2, nullptr); }
                  if (F.G > 32) bias_phase(F, F.bid >= 32 ? F.bid - 32 : -1, F.G - 32, 0); else bias_phase(F, F.bid, F.G, 0);
                  asm volatile("s_waitcnt vmcnt(0)" ::: "memory"); __syncthreads();
                  if (F.tid == 0) { if (worked) { __builtin_amdgcn_fence(__ATOMIC_RELEASE, "agent"); asm volatile("s_waitcnt vmcnt(0)" ::: "memory"); }
                      __hip_atomic_fetch_add((unsigned*)(ws + WS_CTL + 44032) + 32, 1u, __ATOMIC_RELAXED, __HIP_MEMORY_SCOPE_AGENT); }
              }
              pg8::Gemm g{ks ? H : PROJ  , (const bf16_t*)(ws + WS_WOUT) + (size_t)l * 1024 * 1024, NLAT, 1024, 1024}; pg8::StaticOrder S; S.init(NLAT, 1024, F.G, F.bid);
              { pg8::Unit u;
                if (ks) { if (S.next(0, u) && F.tid < 256) {
                    const float* p = (const float*)(ws + WS_SSQY) + (size_t)(u.pm * 256 + F.tid) * 16; LAS float* tab = (LAS float*)(F.lds + pg8::GNTAB_OFF) + F.tid;
                    const f32x4 a = *(const f32x4*)p, b = *(const f32x4*)(p + 4), c = *(const f32x4*)(p + 8), d = *(const f32x4*)(p + 12);
                    const float r0 = rsqrtf(((a[0] + a[1]) + (a[2] + a[3])) * (1.f / 256.f) + EPS), r1 = rsqrtf(((b[0] + b[1]) + (b[2] + b[3])) * (1.f / 256.f) + EPS);
                    const float r2 = rsqrtf(((c[0] + c[1]) + (c[2] + c[3])) * (1.f / 256.f) + EPS), r3 = rsqrtf(((d[0] + d[1]) + (d[2] + d[3])) * (1.f / 256.f) + EPS);
                    tab[0] = r0 / r1; tab[256] = r1 / r2; tab[512] = r2 / r3; tab[768] = r3; }
                  __syncthreads(); }
                else { for (int i = 0; S.next(i, u); ++i) groupnorm_rows<false>(F, l, u.pm * 256, 256, F.wave, NWAVES); VM_WAIT(); __syncthreads(); } }
#define OUT_ARGS F.ka->in[IN_X], F.ka->in[IN_CTX], XB, MOD + (size_t)l * 3 * 6144 + 2 * 1024, XG, F.ka->in[IN_G2] + l * 1024, MOD + (size_t)l * 3 * 6144 + 4 * 1024, (float*)(ws + WS_SSQ2)
              if (ks) { if (l == 0) { pg8::EpiResidStagedT<true, true> E2{OUT_ARGS}; pg8::gemm_phase<pg8::EpiResidStagedT<true, true>, pg8::StaticOrder, true, true>(F.lds, g, S, E2, F.tid); }
                        else { pg8::EpiResidStagedT<true, false> E2{OUT_ARGS}; pg8::gemm_phase<pg8::EpiResidStagedT<true, false>, pg8::StaticOrder, true, true>(F.lds, g, S, E2, F.tid); } }
              else { if (l == 0) { pg8::EpiResidT<true> E{OUT_ARGS}; pg8::gemm_phase<pg8::EpiResidT<true>, pg8::StaticOrder, true, true>(F.lds, g, S, E, F.tid); }
                     else { pg8::EpiResidT<false> E{OUT_ARGS}; pg8::gemm_phase<pg8::EpiResidT<false>, pg8::StaticOrder, true, true>(F.lds, g, S, E, F.tid); } }
#undef OUT_ARGS
              PROBE_PT(F.lds, 5);
              if (l == 0) skinny_ctx<1024>(F, PROJ + (size_t)NLAT * DM, (const bf16_t*)(ws + WS_WOUT), F.ka->in[IN_CTX], XB + (size_t)NLAT * DM, MOD + 2 * 6144 + 2 * 1024,
                                           XG + (size_t)NLAT * DM, F.ka->in[IN_G2], MOD + 2 * 6144 + 4 * 1024, (float*)(ws + WS_SSQC2), (unsigned*)(ws + WS_CTL + 44032), (unsigned*)(ws + WS_CTL + 44032) + 32, (unsigned)F.G); } break;
    case 8: { phase_ids(F); pg8::Gemm g{XG, (const bf16_t*)(ws + WS_WUP) + (size_t)l * DFF2 * 1024, M, DFF2, 1024}; pg8::StaticOrder S; S.init(M, DFF2, F.G, F.bid);
              fill_rtab(F, S, (const float*)(ws + WS_SSQ2), (const float*)(ws + WS_SSQC2));
              pg8::EpiUp E{PROJ, F.ka->in[IN_CONVW] + (size_t)l * 3 * DFF2, F.ka->in[IN_CONVB] + (size_t)l * DFF2, (float*)((unsigned char*)F.out + OUT_EDGE), (const LAS float*)(F.lds + pg8::RTAB_OFF), (const float*)(ws + WS_BIASUP) + (size_t)l * 3 * DFF2};
              pg8::gemm_phase<pg8::EpiUp, pg8::StaticOrder, true, true>(F.lds, g, S, E, F.tid);
              if (l == 0) idle_transposes(F, (M / 256) * (DFF2 / 256), I_L + I_IN + I_OUT, I_L + I_IN + I_OUT + (F.G < 256 ? UP1_SPLIT : UP1_UP0)); else idle_transposes(F, (M / 256) * (DFF2 / 256), I_L + I_IN + I_OUT + I_UP, 2 * I_L); } break;
    case 9: phase_ids(F); fixup_hts(F, l, 0, M / 128, F.bid * NTHREADS + F.tid, F.G * NTHREADS); break;
    case 10: { phase_ids(F); pg8::Gemm g{PROJ, (const bf16_t*)(ws + WS_WDN) + (size_t)l * 1024 * DFF, NLAT, 1024, DFF}; pg8::StaticOrder S; S.init(NLAT, 1024, F.G, F.bid);
#define DN_ARGS nullptr, nullptr, XB, MOD + (size_t)l * 3 * 6144 + 5 * 1024, l == 0 ? H : nullptr, F.ka->in[IN_G1] + 1024, MOD + (size_t)3 * 6144 + 1 * 1024, (float*)(ws + WS_SSQ1)
              if (F.G >= 256) { pg8::EpiResidStagedT<false, false> E2{DN_ARGS}; pg8::gemm_phase<pg8::EpiResidStagedT<false, false>, pg8::StaticOrder, true, true>(F.lds, g, S, E2, F.tid); }
              else { pg8::EpiResidT<false> E{DN_ARGS}; pg8::gemm_phase<pg8::EpiResidT<false>, pg8::StaticOrder, true, true>(F.lds, g, S, E, F.tid); }
#undef DN_ARGS
              PROBE_PT(F.lds, 5);
              if (l == 0) skinny_ctx<DFF>(F, PROJ + (size_t)NLAT * DFF, (const bf16_t*)(ws + WS_WDN), nullptr, XB + (size_t)NLAT * DM, MOD + 2 * 6144 + 5 * 1024,
                                          H + (size_t)NLAT * DM, F.ka->in[IN_G1] + 1024, MOD + (size_t)(3 + 2) * 6144 + 1 * 1024, (float*)(ws + WS_SSQC1), (unsigned*)(ws + WS_CTL + 44032) + 16, nullptr, 0u); } break;
    default: break;
    }
#undef H
#undef PROJ
#undef XB
#undef XG
#undef MOD
#undef vcu
}

__global__ void __launch_bounds__(NTHREADS, 2) fwd_kernel(Args args) {
    extern __shared__ __attribute__((aligned(16))) unsigned char lds_raw[];
    Frame F;
    F.lds = (LAS unsigned char*)lds_raw;
    const int wave0 = __builtin_amdgcn_readfirstlane((int)threadIdx.x >> 6);
    F.tid = 0; F.lane = 0; F.wave = wave0;
    F.G = gridDim.x; F.bid = blockIdx.x;
    F.ka = (const __attribute__((address_space(4))) Args*)__builtin_amdgcn_kernarg_segment_ptr();
    F.out = args.out; F.ws = args.ws;
#define MK_LANE(x) int x; asm volatile("v_mbcnt_lo_u32_b32 %0, -1, 0\n\tv_mbcnt_hi_u32_b32 %0, -1, %0" : "=v"(x))
#if !MK_MULTI
    { MK_LANE(l0_); if (wave0 == 0) ((LAS unsigned*)(F.lds + LDSCTL_OFF))[l0_] = 0u; }
    __syncthreads();
    XcdBarrier bar;
    { MK_LANE(l0_); bar = xcd_barrier_post((unsigned*)(args.ws + WS_CTL) + CW_BAR, (volatile LAS unsigned*)(F.lds + LDSCTL_OFF) + 8, wave0 == 0 && l0_ == 0); }
#endif
#ifdef PROBE_MASK
    unsigned long long pr_acc = 0ull;
#endif
    for (int ph = args.ph_lo; ph < args.ph_hi; ++ph) {
#ifdef PROBE_MASK
        const unsigned long long pr_t0 = __builtin_amdgcn_s_memrealtime();
#endif
#ifdef PROBE_PH
        *(volatile LAS unsigned*)(F.lds + LDSCTL_OFF + 64) = (ph == PROBE_PH) ? 1u : 0u; __syncthreads();
        PROBE_PT(F.lds, 0);
#endif
        {
            Frame P = F;
            int wave_ = wave0, bid_ = F.bid, g_ = F.G; unsigned char* ws_ = F.ws; float* out_ = F.out; const __attribute__((address_space(4))) Args* ka_ = F.ka;
            asm volatile("" : "+s"(wave_), "+s"(bid_), "+s"(g_), "+s"(ws_), "+s"(out_), "+s"(ka_));
            P.ka = ka_; P.lane = 0; P.wave = wave_; P.tid = 0; P.bid = bid_; P.G = g_; P.ws = ws_; P.out = out_;
            run_phase(P, ph);
#ifdef DUP_PH
            if (DUP_PH(ph)) { asm volatile("s_waitcnt vmcnt(0) lgkmcnt(0)" ::: "memory"); __syncthreads(); run_phase(P, ph); }
#endif
        }
#if !MK_MULTI
        if (ph + 1 < args.ph_hi) {
            if (args.ph_lo < 0) cg::this_grid().sync();
            else { MK_LANE(l1_); xcd_barrier(bar, wave0 == 0 && l1_ == 0); }
        }
#endif
#ifdef PROBE_PH
        PROBE_PT(F.lds, 4);
#endif
#ifdef PROBE_MASK
        if ((PROBE_MASK >> ph) & 1u) pr_acc += __builtin_amdgcn_s_memrealtime() - pr_t0;
#endif
    }
#ifdef PROBE_PH
    if (blockIdx.x == PROBE_BLK) { __syncthreads(); const unsigned long long d_ = *(volatile LAS unsigned long long*)(F.lds + LDSCTL_OFF + 72 + 8 * PROBE_B) - *(volatile LAS unsigned long long*)(F.lds + LDSCTL_OFF + 72 + 8 * PROBE_A);
        const unsigned long long t1 = __builtin_amdgcn_s_memrealtime(); while (__builtin_amdgcn_s_memrealtime() - t1 < d_) __builtin_amdgcn_s_sleep(8); }
#endif
#ifdef PROBE_MASK
    if (blockIdx.x == 0) { const unsigned long long t1 = __builtin_amdgcn_s_memrealtime(); while (__builtin_amdgcn_s_memrealtime() - t1 < pr_acc) __builtin_amdgcn_s_sleep(8); }
#endif
}

extern "C" void kernel_launch(void* const* d_in, const int* in_sizes, int n_in, void* d_out, int out_size, void* d_ws, size_t ws_size, hipStream_t stream) {
    static int grid = 0;
    if (grid == 0) {
        if (n_in != 21 || out_size != NLAT * DM || ws_size < WS_END) { fprintf(stderr, "kernel_launch: unexpected shapes (n_in %d out %d ws %zu)\n", n_in, out_size, ws_size); grid = -1; return; }
        int dev = 0, cus = 0, per_cu = 0;
        if (hipGetDevice(&dev) != hipSuccess || hipDeviceGetAttribute(&cus, hipDeviceAttributeMultiprocessorCount, dev) != hipSuccess) { grid = -1; return; }
        if (hipFuncSetAttribute((const void*)fwd_kernel, hipFuncAttributeMaxDynamicSharedMemorySize, LDS_BYTES) != hipSuccess) { fprintf(stderr, "kernel_launch: hipFuncSetAttribute failed\n"); grid = -1; return; }
        if (hipOccupancyMaxActiveBlocksPerMultiprocessor(&per_cu, (const void*)fwd_kernel, NTHREADS, LDS_BYTES) != hipSuccess || per_cu < 1) { fprintf(stderr, "kernel_launch: occupancy query says %d blocks per CU\n", per_cu); grid = -1; (void)hipGetLastError(); return; }
        grid = cus;
    }
    if (grid < 0) return;
#if !MK_MULTI
    if (hipMemsetAsync((char*)d_ws + WS_CTL, 0, 65536, stream) != hipSuccess) { fprintf(stderr, "kernel_launch: hipMemsetAsync failed\n"); return; }
#endif
    Args a{};
    for (int i = 0; i < 21; ++i) a.in[i] = (const float*)d_in[i];
    a.out = (float*)d_out; a.ws = (unsigned char*)d_ws;
#if MK_MULTI
    for (int ph = 0; ph < NPHASE; ++ph) { a.ph_lo = ph; a.ph_hi = ph + 1; hipLaunchKernelGGL(fwd_kernel, dim3(grid), dim3(NTHREADS), LDS_BYTES, stream, a); }
#else
    a.ph_lo = 0; a.ph_hi = NPHASE;
    void* kargs[] = {&a};
    hipError_t e = hipLaunchCooperativeKernel((void*)fwd_kernel, dim3(grid), dim3(NTHREADS), kargs, LDS_BYTES, stream);
    if (e != hipSuccess) fprintf(stderr, "kernel_launch: cooperative launch failed: %s (grid %d)\n", hipGetErrorString(e), grid);
#endif
}
```
